# Optimizing an MI355X kernel written in HIP

```python
import math
import jax, jax.numpy as jnp
from jax import lax
import numpy as np

D_MODEL = 1024
BATCH = 16
SEQ = 2048
DEPTH = 2

HEAD_DIM = 64
EPS = 1e-6
NEG = -1e30
A_HEADS = 8
A_PATTERNS = ((128, 1), (512, 4), (2048, 16))
A_BLOCK = 128
B_HEADS = 4
B_VDIM = 2 * HEAD_DIM
Q_BLOCK = 128
ATT_IN = 3 * A_HEADS * HEAD_DIM + 2 * (2 * B_HEADS * HEAD_DIM) + B_HEADS * B_VDIM
ATT_OUT = A_HEADS * HEAD_DIM + B_HEADS * B_VDIM
C_CHUNK = 128
C_GROUPS = 8
C_WIDTH = 2 * D_MODEL
C_GROUP_DIM = C_WIDTH // C_GROUPS
PEER_HEADS = 8
PEER_NKEYS = 128
PEER_EXPERTS = PEER_NKEYS * PEER_NKEYS
PEER_TOPK = 16
PEER_DKEY = 256
PEER_TOKEN_BLOCK = 128

kernel_name = 'hybrid_dilated_diff_sgu_peer'


def rms_norm(x, g):
    xf = x.astype(jnp.float32)
    y = xf * lax.rsqrt(jnp.mean(xf * xf, axis=-1, keepdims=True) + EPS)
    return (y * g.astype(jnp.float32)).astype(x.dtype)


def dilated_branch(q, k, v, window, dilation):
    b, s, h, dh = q.shape
    L = s // dilation
    span = window // dilation
    nb = -(-L // A_BLOCK)
    Lp = nb * A_BLOCK

    def to_sub(t):
        t = t.reshape(b, L, dilation, h, dh).transpose(0, 2, 3, 1, 4)
        t = jnp.pad(t, ((0, 0), (0, 0), (0, 0), (0, Lp - L), (0, 0)))
        return t.reshape(b, dilation, h, nb, A_BLOCK, dh)

    def with_prev(t):
        prev = jnp.pad(t, ((0, 0), (0, 0), (0, 0), (1, 0), (0, 0), (0, 0)))[:, :, :, :-1]
        return jnp.concatenate([prev, t], axis=4)

    qb = to_sub(q)
    kw = with_prev(to_sub(k))
    vw = with_prev(to_sub(v))
    scores = jnp.einsum('brhnqd,brhnkd->brhnqk', qb, kw).astype(jnp.float32) * (dh ** -0.5)
    qi = jnp.arange(nb)[:, None, None] * A_BLOCK + jnp.arange(A_BLOCK)[None, :, None]
    ki = (jnp.arange(nb)[:, None, None] - 1) * A_BLOCK + jnp.arange(2 * A_BLOCK)[None, None, :]
    dist = qi - ki
    valid = (dist >= 0) & (dist <= span) & (ki >= 0)
    scores = jnp.where(valid, scores, NEG)
    m = jnp.max(scores, axis=-1, keepdims=True)
    p = jnp.exp(scores - m)
    den = jnp.sum(p, axis=-1, keepdims=True)
    out = jnp.einsum('brhnqk,brhnkd->brhnqd', p, vw.astype(jnp.float32)) / den
    lse = (m + jnp.log(den))[..., 0]
    out = out.reshape(b, dilation, h, Lp, dh)[:, :, :, :L].transpose(0, 3, 1, 2, 4).reshape(b, s, h, dh)
    lse = lse.reshape(b, dilation, h, Lp)[:, :, :, :L].transpose(0, 3, 1, 2).reshape(b, s, h)
    return out, lse


def diff_attention(q1, q2, k1, k2, v, lam):
    b, s, h, dh = q1.shape
    nq = s // Q_BLOCK
    scale = dh ** -0.5
    kpos = jnp.arange(s)
    vf = v.astype(jnp.float32)

    def blockify(t):
        return t.reshape(b, nq, Q_BLOCK, h, dh).transpose(1, 0, 2, 3, 4)

    def one_block(args):
        qb1, qb2, start = args
        qpos = start + jnp.arange(Q_BLOCK)
        mask = kpos[None, :] <= qpos[:, None]

        def probs(qb, kk):
            sc = jnp.einsum('bqhd,bkhd->bhqk', qb, kk).astype(jnp.float32) * scale
            return jax.nn.softmax(jnp.where(mask, sc, NEG), axis=-1)

        a = probs(qb1, k1) - lam * probs(qb2, k2)
        return jnp.einsum('bhqk,bkhe->bqhe', a, vf)

    starts = jnp.arange(nq) * Q_BLOCK
    out = lax.map(one_block, (blockify(q1), blockify(q2), starts))
    return out.transpose(1, 0, 2, 3, 4).reshape(b, s, h, 2 * dh)


def attention_layer(x, norm_g, w_in, a_q_gain, a_k_gain, b_q_gain, b_k_gain,
                    lam_q1, lam_k1, lam_q2, lam_k2, b_sub_gain, w_out, lambda_init):
    b, s, _ = x.shape
    proj = rms_norm(x, norm_g) @ w_in
    aw = A_HEADS * HEAD_DIM
    bw = 2 * B_HEADS * HEAD_DIM
    aq, ak, av, bq, bk, bv = jnp.split(proj, [aw, 2 * aw, 3 * aw, 3 * aw + bw, 3 * aw + 2 * bw], axis=-1)
    aq = rms_norm(aq.reshape(b, s, A_HEADS, HEAD_DIM), a_q_gain)
    ak = rms_norm(ak.reshape(b, s, A_HEADS, HEAD_DIM), a_k_gain)
    av = av.reshape(b, s, A_HEADS, HEAD_DIM)
    outs, lses = [], []
    for window, dilation in A_PATTERNS:
        o, l = dilated_branch(aq, ak, av, window, dilation)
        outs.append(o)
        lses.append(l)
    wts = jax.nn.softmax(jnp.stack(lses), axis=0)
    out_a = jnp.sum(wts[..., None] * jnp.stack(outs), axis=0)
    bq = rms_norm(bq.reshape(b, s, B_HEADS, 2, HEAD_DIM), b_q_gain)
    bk = rms_norm(bk.reshape(b, s, B_HEADS, 2, HEAD_DIM), b_k_gain)
    bv = bv.reshape(b, s, B_HEADS, B_VDIM)
    lam = (jnp.exp(jnp.sum((lam_q1 * lam_k1).astype(jnp.float32)))
           - jnp.exp(jnp.sum((lam_q2 * lam_k2).astype(jnp.float32))) + lambda_init)
    out_b = diff_attention(bq[..., 0, :], bq[..., 1, :], bk[..., 0, :], bk[..., 1, :], bv, lam)
    out_b = rms_norm(out_b, b_sub_gain) * (1.0 - lambda_init)
    mixed = jnp.concatenate([out_a.reshape(b, s, aw), out_b.reshape(b, s, B_HEADS * B_VDIM)], axis=-1)
    return x + mixed.astype(x.dtype) @ w_out


def sgu_layer(x, norm_g, w_in, v_gain, w_spatial, b_spatial, w_out):
    b, s, _ = x.shape
    nc = s // C_CHUNK
    z = jax.nn.gelu(rms_norm(x, norm_g) @ w_in)
    u, v = jnp.split(z, 2, axis=-1)
    v = rms_norm(v, v_gain).reshape(b, nc, C_CHUNK, C_GROUPS, C_GROUP_DIM)
    causal = jnp.tril(jnp.ones((C_CHUNK, C_CHUNK), dtype=bool))
    ws = jnp.where(causal, w_spatial, 0.0)
    gate = jnp.einsum('gts,bnsgc->bntgc', ws, v) + b_spatial.T[None, None, :, :, None]
    y = (u * gate.reshape(b, s, C_WIDTH)) @ w_out
    return x + y.astype(x.dtype)


def peer_layer(x, norm_g, w_query, sub_keys, expert_down, expert_up):
    b, s, d = x.shape
    hn = rms_norm(x, norm_g).reshape(b * s // PEER_TOKEN_BLOCK, PEER_TOKEN_BLOCK, d)

    def block(xb):
        q = (xb @ w_query).reshape(-1, PEER_HEADS, 2, PEER_DKEY // 2)
        sc = jnp.einsum('thpc,hpkc->thpk', q, sub_keys).astype(jnp.float32)
        s1, i1 = lax.top_k(sc[:, :, 0], PEER_TOPK)
        s2, i2 = lax.top_k(sc[:, :, 1], PEER_TOPK)
        cand = (s1[..., :, None] + s2[..., None, :]).reshape(-1, PEER_HEADS, PEER_TOPK * PEER_TOPK)
        top, ci = lax.top_k(cand, PEER_TOPK)
        e1 = jnp.take_along_axis(i1, ci // PEER_TOPK, axis=-1)
        e2 = jnp.take_along_axis(i2, ci % PEER_TOPK, axis=-1)
        idx = e1 * PEER_NKEYS + e2
        g = jax.nn.softmax(top, axis=-1)
        hid = jax.nn.gelu(jnp.einsum('td,thkd->thk', xb, expert_down[idx]).astype(jnp.float32))
        return jnp.einsum('thk,thkd->td', (g * hid).astype(xb.dtype), expert_up[idx])

    y = lax.map(block, hn).reshape(b, s, d)
    return x + y.astype(x.dtype)


def setup_inputs(seed: int = 0) -> dict:
    key = jax.random.key(seed)
    keys = list(jax.random.split(key, 32))
    ne = (DEPTH + 1) // 2
    no = DEPTH // 2

    def nrm(shape, scale):
        return jax.random.normal(keys.pop(), shape, jnp.float32) * scale

    def gain(shape):
        return 1.0 + nrm(shape, 0.02)

    return {
        'x': nrm((BATCH, SEQ, D_MODEL), 1.0),
        'attn_norm_g': gain((ne, D_MODEL)),
        'attn_w_in': nrm((ne, D_MODEL, ATT_IN), D_MODEL ** -0.5),
        'a_q_gain': gain((ne, HEAD_DIM)),
        'a_k_gain': gain((ne, HEAD_DIM)),
        'b_q_gain': gain((ne, 2, HEAD_DIM)),
        'b_k_gain': gain((ne, 2, HEAD_DIM)),
        'lam_q1': nrm((ne, HEAD_DIM), 0.1),
        'lam_k1': nrm((ne, HEAD_DIM), 0.1),
        'lam_q2': nrm((ne, HEAD_DIM), 0.1),
        'lam_k2': nrm((ne, HEAD_DIM), 0.1),
        'b_sub_gain': gain((ne, B_VDIM)),
        'attn_w_out': nrm((ne, ATT_OUT, D_MODEL), ATT_OUT ** -0.5),
        'sgu_norm_g': gain((no, D_MODEL)),
        'sgu_w_in': nrm((no, D_MODEL, 2 * C_WIDTH), D_MODEL ** -0.5),
        'sgu_v_gain': gain((no, C_WIDTH)),
        'sgu_w_spatial': nrm((no, C_GROUPS, C_CHUNK, C_CHUNK), 0.5 * C_CHUNK ** -0.5),
        'sgu_b_spatial': 1.0 + nrm((no, C_GROUPS, C_CHUNK), 0.1),
        'sgu_w_out': nrm((no, C_WIDTH, D_MODEL), C_WIDTH ** -0.5),
        'ffn_norm_g': gain((DEPTH, D_MODEL)),
        'peer_w_query': nrm((DEPTH, D_MODEL, PEER_HEADS * PEER_DKEY), D_MODEL ** -0.5),
        'peer_sub_keys': nrm((DEPTH, PEER_HEADS, 2, PEER_NKEYS, PEER_DKEY // 2), (PEER_DKEY // 2) ** -0.5),
        'peer_down': nrm((DEPTH, PEER_EXPERTS, D_MODEL), D_MODEL ** -0.5),
        'peer_up': nrm((DEPTH, PEER_EXPERTS, D_MODEL), PEER_HEADS ** -0.5),
    }


def reference(x, attn_norm_g, attn_w_in, a_q_gain, a_k_gain, b_q_gain, b_k_gain,
              lam_q1, lam_k1, lam_q2, lam_k2, b_sub_gain, attn_w_out,
              sgu_norm_g, sgu_w_in, sgu_v_gain, sgu_w_spatial, sgu_b_spatial, sgu_w_out,
              ffn_norm_g, peer_w_query, peer_sub_keys, peer_down, peer_up):
    for layer in range(DEPTH):
        i = layer // 2
        if layer % 2 == 0:
            lambda_init = 0.8 - 0.6 * math.exp(-0.3 * layer)
            x = attention_layer(x, attn_norm_g[i], attn_w_in[i], a_q_gain[i], a_k_gain[i],
                                b_q_gain[i], b_k_gain[i], lam_q1[i], lam_k1[i], lam_q2[i], lam_k2[i],
                                b_sub_gain[i], attn_w_out[i], lambda_init)
        else:
            x = sgu_layer(x, sgu_norm_g[i], sgu_w_in[i], sgu_v_gain[i], sgu_w_spatial[i],
                          sgu_b_spatial[i], sgu_w_out[i])
        x = peer_layer(x, ffn_norm_g[layer], peer_w_query[layer], peer_sub_keys[layer],
                       peer_down[layer], peer_up[layer])
    return x
```

```cpp
#include <hip/hip_runtime.h>
#include <stdint.h>
#include <stdio.h>

#define NTOK   32768
#define DM     1024
#define SEQ    2048
#define NB     16
#define ATT_IN 3072
#define CW     2048
#define NEXP   16384
#define EPSN   1e-6f

typedef unsigned short bf16_t;
typedef unsigned int u32;

#define DI __device__ __forceinline__

DI float bf2f(bf16_t v) { return __uint_as_float(((u32)v) << 16); }
DI bf16_t f2bf(float f) { u32 u = __float_as_uint(f); u += 0x7fffu + ((u >> 16) & 1u); return (bf16_t)(u >> 16); }
DI u32 pack2(float lo, float hi) { return (u32)f2bf(lo) | ((u32)f2bf(hi) << 16); }
DI float gelu_tanh(float x) {
    const float y = 0.7978845608028654f * (x + 0.044715f * x * x * x);
    const float e = __expf(2.f * y);
    const float t = 1.f - 2.f / (e + 1.f);
    return 0.5f * x * (1.f + t);
}
DI float wave_sum(float v) {
#pragma unroll
    for (int o = 1; o < 64; o <<= 1) v += __shfl_xor(v, o);
    return v;
}
DI float wave_max(float v) {
#pragma unroll
    for (int o = 1; o < 64; o <<= 1) v = fmaxf(v, __shfl_xor(v, o));
    return v;
}
DI u32 f2ord(float f) { u32 u = __float_as_uint(f); return (u & 0x80000000u) ? ~u : (u | 0x80000000u); }
DI float ord2f(u32 o) { u32 u = (o & 0x80000000u) ? (o & 0x7fffffffu) : ~o; return __uint_as_float(u); }

#define MiB ((size_t)1 << 20)
#define WS_CTL      ((size_t)0)
#define WS_W_ATTIN  (1 * MiB)
#define WS_W_ATTOUT (7 * MiB)
#define WS_W_SGUIN  (9 * MiB)
#define WS_W_SGUOUT (17 * MiB)
#define WS_W_PQ     (21 * MiB)
#define WS_W_SUBK   (29 * MiB)
#define WS_MISC     (30 * MiB)
#define WS_DOWN     (32 * MiB)
#define WS_UP       (96 * MiB)
#define WS_XN       (160 * MiB)
#define WS_BIG      (224 * MiB)
#define WS_PROJ     (WS_BIG)
#define WS_MIXED    (WS_BIG + 192 * MiB)
#define WS_Z_U      (WS_BIG)
#define WS_Z_VT     (WS_BIG + 128 * MiB)
#define WS_R1       (WS_BIG)
#define WS_RIDX     (WS_BIG + 32 * MiB)
#define WS_RG       (WS_BIG + 48 * MiB)
#define WS_QBUF     (WS_BIG + 64 * MiB)
#define WS_NEED     (512 * MiB)

struct Params {
    const float* in[24];
    float* out;
    unsigned char* ws;
};

__global__ void __launch_bounds__(256) k_transpose_bf16(const float* __restrict__ W, bf16_t* __restrict__ Wt, int K, int N) {
    __shared__ float tile[32][33];
    const int tx = threadIdx.x & 31, ty = threadIdx.x >> 5;
    const int n0 = blockIdx.x * 32, k0 = blockIdx.y * 32;
#pragma unroll
    for (int i = 0; i < 4; ++i) tile[ty + 8 * i][tx] = W[(size_t)(k0 + ty + 8 * i) * N + n0 + tx];
    __syncthreads();
#pragma unroll
    for (int i = 0; i < 4; ++i) Wt[(size_t)(n0 + ty + 8 * i) * K + k0 + tx] = f2bf(tile[tx][ty + 8 * i]);
}
__global__ void __launch_bounds__(256) k_cvt_bf16(const float* __restrict__ src, bf16_t* __restrict__ dst, size_t n4) {
    size_t i = (size_t)blockIdx.x * 256 + threadIdx.x;
    const size_t stride = (size_t)gridDim.x * 256;
    for (; i < n4; i += stride) {
        const float4 v = ((const float4*)src)[i];
        uint2 o; o.x = pack2(v.x, v.y); o.y = pack2(v.z, v.w);
        ((uint2*)dst)[i] = o;
    }
}
__global__ void __launch_bounds__(256) k_rmsnorm(const float* __restrict__ x, const float* __restrict__ g, bf16_t* __restrict__ o, int nrows) {
    const int lane = threadIdx.x & 63;
    int row = blockIdx.x * 4 + (threadIdx.x >> 6);
    const int stride = gridDim.x * 4;
    for (; row < nrows; row += stride) {
        const float4* xr = (const float4*)(x + (size_t)row * DM);
        float4 v[4]; float ss = 0.f;
#pragma unroll
        for (int j = 0; j < 4; ++j) { v[j] = xr[lane + 64 * j]; ss += v[j].x * v[j].x + v[j].y * v[j].y + v[j].z * v[j].z + v[j].w * v[j].w; }
        ss = wave_sum(ss);
        const float rinv = rsqrtf(ss * (1.f / DM) + EPSN);
        uint2* orow = (uint2*)(o + (size_t)row * DM);
#pragma unroll
        for (int j = 0; j < 4; ++j) {
            const float4 gg = ((const float4*)g)[lane + 64 * j];
            uint2 w; w.x = pack2(v[j].x * rinv * gg.x, v[j].y * rinv * gg.y); w.y = pack2(v[j].z * rinv * gg.z, v[j].w * rinv * gg.w);
            orow[lane + 64 * j] = w;
        }
    }
}

struct EpiProj { bf16_t* o; DI void operator()(int m, int n, float v) const { o[(size_t)m * ATT_IN + n] = f2bf(v); } };
struct EpiResid { const float* r; float* o; DI void operator()(int m, int n, float v) const { o[(size_t)m * DM + n] = r[(size_t)m * DM + n] + v; } };
struct EpiQ { bf16_t* o; DI void operator()(int m, int n, float v) const { o[(size_t)m * 2048 + n] = f2bf(v); } };
struct EpiSgu { bf16_t* u; bf16_t* vt; DI void operator()(int m, int n, float v) const {
    const float g = gelu_tanh(v);
    if (n < CW) u[(size_t)m * CW + n] = f2bf(g);
    else vt[((size_t)(m >> 7) * CW + (n - CW)) * 128 + (m & 127)] = f2bf(g); } };

template <class Epi>
__global__ void __launch_bounds__(256) k_gemm_ref(const bf16_t* __restrict__ A, const bf16_t* __restrict__ Bt, int M, int N, int K, Epi epi) {
    __shared__ float As[16][68];
    __shared__ float Bs[16][68];
    const int tid = threadIdx.x, tx = tid & 15, ty = tid >> 4;
    const int m0 = blockIdx.y * 64, n0 = blockIdx.x * 64;
    float acc[4][4];
#pragma unroll
    for (int i = 0; i < 4; ++i)
#pragma unroll
        for (int j = 0; j < 4; ++j) acc[i][j] = 0.f;
    const int lr = tid >> 2, lc = (tid & 3) * 4;
    for (int k0 = 0; k0 < K; k0 += 16) {
        const uint2 a = *(const uint2*)(A + (size_t)(m0 + lr) * K + k0 + lc);
        const uint2 b = *(const uint2*)(Bt + (size_t)(n0 + lr) * K + k0 + lc);
        As[lc + 0][lr] = bf2f((bf16_t)(a.x & 0xffff)); As[lc + 1][lr] = bf2f((bf16_t)(a.x >> 16));
        As[lc + 2][lr] = bf2f((bf16_t)(a.y & 0xffff)); As[lc + 3][lr] = bf2f((bf16_t)(a.y >> 16));
        Bs[lc + 0][lr] = bf2f((bf16_t)(b.x & 0xffff)); Bs[lc + 1][lr] = bf2f((bf16_t)(b.x >> 16));
        Bs[lc + 2][lr] = bf2f((bf16_t)(b.y & 0xffff)); Bs[lc + 3][lr] = bf2f((bf16_t)(b.y >> 16));
        __syncthreads();
#pragma unroll
        for (int kk = 0; kk < 16; ++kk) {
            const float4 av = *(const float4*)&As[kk][ty * 4];
            const float4 bv = *(const float4*)&Bs[kk][tx * 4];
            const float aa[4] = {av.x, av.y, av.z, av.w};
            const float bb[4] = {bv.x, bv.y, bv.z, bv.w};
#pragma unroll
            for (int i = 0; i < 4; ++i)
#pragma unroll
                for (int j = 0; j < 4; ++j) acc[i][j] += aa[i] * bb[j];
        }
        __syncthreads();
    }
#pragma unroll
    for (int i = 0; i < 4; ++i)
#pragma unroll
        for (int j = 0; j < 4; ++j) epi(m0 + ty * 4 + i, n0 + tx * 4 + j, acc[i][j]);
}

__global__ void __launch_bounds__(256) k_headnorm_ref(bf16_t* __restrict__ proj, const float* aq_g, const float* ak_g, const float* bq_g, const float* bk_g) {
    const size_t id = (size_t)blockIdx.x * 256 + threadIdx.x;
    const int tok = (int)(id >> 5), gi = (int)(id & 31);
    int col; const float* gain; float scale = 1.f;
    if (gi < 8) { col = gi * 64; gain = aq_g; scale = 0.125f; }
    else if (gi < 16) { col = gi * 64; gain = ak_g; }
    else if (gi < 24) { col = 1536 + (gi - 16) * 64; gain = bq_g + ((gi - 16) & 1) * 64; scale = 0.125f; }
    else { col = 2048 + (gi - 24) * 64; gain = bk_g + ((gi - 24) & 1) * 64; }
    bf16_t* p = proj + (size_t)tok * ATT_IN + col;
    float ss = 0.f;
    for (int d = 0; d < 64; ++d) { const float v = bf2f(p[d]); ss += v * v; }
    const float rinv = rsqrtf(ss * (1.f / 64.f) + EPSN) * scale;
    for (int d = 0; d < 64; ++d) p[d] = f2bf(bf2f(p[d]) * rinv * gain[d]);
}

__global__ void __launch_bounds__(256) k_attnA_ref(const bf16_t* __restrict__ proj, bf16_t* __restrict__ mixed) {
    __shared__ float s_sc[4][400];
    __shared__ int s_pos[4][400];
    __shared__ float s_q[4][64];
    const int w = threadIdx.x >> 6, lane = threadIdx.x & 63;
    const int item = blockIdx.x * 4 + w;
    const int tok = item >> 3, h = item & 7;
    const int b = tok / SEQ, t = tok % SEQ;
    s_q[w][lane] = bf2f(proj[(size_t)tok * ATT_IN + h * 64 + lane]);
    __syncthreads();
    float mx = -1e30f;
    for (int e = lane; e < 387; e += 64) {
        const int p = e / 129, m = e % 129;
        const int d = (p == 0) ? 1 : (p == 1 ? 4 : 16);
        const int pos = t - m * d;
        float s = -1e30f;
        if (pos >= 0) {
            const bf16_t* kr = proj + (size_t)(b * SEQ + pos) * ATT_IN + 512 + h * 64;
            s = 0.f;
            for (int dd = 0; dd < 64; ++dd) s += s_q[w][dd] * bf2f(kr[dd]);
        }
        s_sc[w][e] = s; s_pos[w][e] = pos;
        mx = fmaxf(mx, s);
    }
    mx = wave_max(mx);
    float sum = 0.f;
    for (int e = lane; e < 387; e += 64) {
        const float s = s_sc[w][e];
        const float pe = (s_pos[w][e] >= 0) ? __expf(s - mx) : 0.f;
        s_sc[w][e] = pe; sum += pe;
    }
    sum = wave_sum(sum);
    __syncthreads();
    float o = 0.f;
    for (int e = 0; e < 387; ++e) {
        const int pos = s_pos[w][e];
        if (pos >= 0) o += s_sc[w][e] * bf2f(proj[(size_t)(b * SEQ + pos) * ATT_IN + 1024 + h * 64 + lane]);
    }
    mixed[(size_t)tok * DM + h * 64 + lane] = f2bf(o / sum);
}

DI float compute_lam(const float* lq1, const float* lk1, const float* lq2, const float* lk2, int lane) {
    const float a = wave_sum(lq1[lane] * lk1[lane]);
    const float b = wave_sum(lq2[lane] * lk2[lane]);
    return __expf(a) - __expf(b) + 0.2f;
}
__global__ void __launch_bounds__(128) k_attnB_ref(const bf16_t* __restrict__ proj, bf16_t* __restrict__ mixed,
                                                   const float* lq1, const float* lk1, const float* lq2, const float* lk2, const float* subg) {
    __shared__ float s1[2][2048];
    __shared__ float s2[2][2048];
    __shared__ float sq[2][128];
    const int w = threadIdx.x >> 6, lane = threadIdx.x & 63;
    const int item = blockIdx.x * 2 + w;
    const int tok = item >> 2, h = item & 3;
    const int b = tok / SEQ, t = tok % SEQ;
    const float lam = compute_lam(lq1, lk1, lq2, lk2, lane);
    sq[w][lane] = bf2f(proj[(size_t)tok * ATT_IN + 1536 + h * 128 + lane]);
    sq[w][lane + 64] = bf2f(proj[(size_t)tok * ATT_IN + 1536 + h * 128 + 64 + lane]);
    __syncthreads();
    float m1 = -1e30f, m2 = -1e30f;
    for (int j = lane; j <= t; j += 64) {
        const bf16_t* kr = proj + (size_t)(b * SEQ + j) * ATT_IN + 2048 + h * 128;
        float a = 0.f, c = 0.f;
        for (int d = 0; d < 64; ++d) { a += sq[w][d] * bf2f(kr[d]); c += sq[w][64 + d] * bf2f(kr[64 + d]); }
        s1[w][j] = a; s2[w][j] = c; m1 = fmaxf(m1, a); m2 = fmaxf(m2, c);
    }
    m1 = wave_max(m1); m2 = wave_max(m2);
    float l1 = 0.f, l2 = 0.f;
    for (int j = lane; j <= t; j += 64) {
        const float p1 = __expf(s1[w][j] - m1), p2 = __expf(s2[w][j] - m2);
        s1[w][j] = p1; s2[w][j] = p2; l1 += p1; l2 += p2;
    }
    l1 = wave_sum(l1); l2 = wave_sum(l2);
    __syncthreads();
    const float i1 = 1.f / l1, i2 = lam / l2;
    float o0 = 0.f, o1 = 0.f;
    for (int j = 0; j <= t; ++j) {
        const float a = s1[w][j] * i1 - s2[w][j] * i2;
        const bf16_t* vr = proj + (size_t)(b * SEQ + j) * ATT_IN + 2560 + h * 128;
        o0 += a * bf2f(vr[lane]); o1 += a * bf2f(vr[lane + 64]);
    }
    const float ss = wave_sum(o0 * o0 + o1 * o1);
    const float rinv = rsqrtf(ss * (1.f / 128.f) + EPSN) * 0.8f;
    mixed[(size_t)tok * DM + 512 + h * 128 + lane] = f2bf(o0 * rinv * subg[lane]);
    mixed[(size_t)tok * DM + 512 + h * 128 + 64 + lane] = f2bf(o1 * rinv * subg[lane + 64]);
}

DI void top16_insert(u32 (&lst)[16], u32 x) {
#pragma unroll
    for (int j = 0; j < 16; ++j) { const u32 hi = max(lst[j], x); x = min(lst[j], x); lst[j] = hi; }
}
__global__ void __launch_bounds__(256) k_route1_ref(const bf16_t* __restrict__ qbuf, const bf16_t* __restrict__ subk, u32* __restrict__ r1) {
    __shared__ bf16_t sk[128 * 128];
    const int hp = blockIdx.y;
    const bf16_t* skg = subk + (size_t)hp * 128 * 128;
    for (int i = threadIdx.x; i < 128 * 128 / 2; i += 256) ((u32*)sk)[i] = ((const u32*)skg)[i];
    __syncthreads();
    const int tok = blockIdx.x * 256 + threadIdx.x;
    const bf16_t* q = qbuf + (size_t)tok * 2048 + hp * 128;
    u32 lst[16];
#pragma unroll
    for (int j = 0; j < 16; ++j) lst[j] = 0u;
    for (int k = 0; k < 128; ++k) {
        float s = 0.f;
        for (int c = 0; c < 128; c += 2) {
            const u32 qq = *(const u32*)(q + c);
            const u32 kk = *(const u32*)(sk + k * 128 + c);
            s += bf2f((bf16_t)(qq & 0xffff)) * bf2f((bf16_t)(kk & 0xffff)) + bf2f((bf16_t)(qq >> 16)) * bf2f((bf16_t)(kk >> 16));
        }
        top16_insert(lst, (f2ord(s) & ~127u) | (u32)(127 - k));
    }
    u32* o = r1 + ((size_t)tok * 16 + hp) * 16;
#pragma unroll
    for (int j = 0; j < 16; ++j) o[j] = lst[j];
}
DI void route2_item(const u32* __restrict__ r1, int tok, int h, int* __restrict__ ridx, float* __restrict__ rg) {
    const u32* k1 = r1 + ((size_t)tok * 16 + h * 2) * 16;
    const u32* k2 = k1 + 16;
    float s1[16], s2[16];
#pragma unroll
    for (int j = 0; j < 16; ++j) { s1[j] = ord2f(k1[j] & ~127u); s2[j] = ord2f(k2[j] & ~127u); }
    u32 lst[16];
#pragma unroll
    for (int j = 0; j < 16; ++j) lst[j] = 0u;
#pragma unroll
    for (int i = 0; i < 16; ++i)
#pragma unroll
        for (int j = 0; j < 16; ++j)
            if ((i + 1) * (j + 1) <= 16) top16_insert(lst, (f2ord(s1[i] + s2[j]) & ~255u) | (u32)(255 - (i * 16 + j)));
    float pv[16]; float sum = 0.f;
    const float mx = ord2f(lst[0] & ~255u);
#pragma unroll
    for (int j = 0; j < 16; ++j) { pv[j] = __expf(ord2f(lst[j] & ~255u) - mx); sum += pv[j]; }
    const float inv = 1.f / sum;
#pragma unroll
    for (int j = 0; j < 16; ++j) {
        const int ci = 255 - (int)(lst[j] & 255u);
        const int e1 = 127 - (int)(k1[ci >> 4] & 127u), e2 = 127 - (int)(k2[ci & 15] & 127u);
        ridx[(size_t)tok * 128 + h * 16 + j] = e1 * 128 + e2;
        rg[(size_t)tok * 128 + h * 16 + j] = pv[j] * inv;
    }
}
__global__ void __launch_bounds__(256) k_route2(const u32* __restrict__ r1, int* __restrict__ ridx, float* __restrict__ rg) {
    const int id = blockIdx.x * 256 + threadIdx.x;
    route2_item(r1, id >> 3, id & 7, ridx, rg);
}

DI void unpack8(const uint4 v, float (&f)[8]) {
    f[0] = __uint_as_float(v.x << 16); f[1] = __uint_as_float(v.x & 0xffff0000u);
    f[2] = __uint_as_float(v.y << 16); f[3] = __uint_as_float(v.y & 0xffff0000u);
    f[4] = __uint_as_float(v.z << 16); f[5] = __uint_as_float(v.z & 0xffff0000u);
    f[6] = __uint_as_float(v.w << 16); f[7] = __uint_as_float(v.w & 0xffff0000u);
}
template <bool NEXT_NORM>
__global__ void __launch_bounds__(256) k_peer_gather(bf16_t* __restrict__ hn, const int* __restrict__ ridx, const float* __restrict__ rg,
                                                     const bf16_t* __restrict__ down, const bf16_t* __restrict__ up,
                                                     float* __restrict__ res, const float* __restrict__ gnext) {
    const int lane = threadIdx.x & 63;
    const int tok = blockIdx.x * 4 + (threadIdx.x >> 6);
    float x[16], y[16];
    {
        const uint4* hr = (const uint4*)(hn + (size_t)tok * DM);
        float a[8], b[8];
        unpack8(hr[lane], a); unpack8(hr[64 + lane], b);
#pragma unroll
        for (int i = 0; i < 8; ++i) { x[i] = a[i]; x[8 + i] = b[i]; y[i] = 0.f; y[8 + i] = 0.f; }
    }
    const int my_e = ridx[(size_t)tok * 128 + lane], my_e2 = ridx[(size_t)tok * 128 + 64 + lane];
    const float my_g = rg[(size_t)tok * 128 + lane], my_g2 = rg[(size_t)tok * 128 + 64 + lane];
    for (int k = 0; k < 128; ++k) {
        const int e = __shfl(k < 64 ? my_e : my_e2, k & 63);
        const float g = __shfl(k < 64 ? my_g : my_g2, k & 63);
        const uint4* dr = (const uint4*)(down + (size_t)e * DM);
        const uint4* ur = (const uint4*)(up + (size_t)e * DM);
        const uint4 d0 = dr[lane], d1 = dr[64 + lane], u0 = ur[lane], u1 = ur[64 + lane];
        float a[8], b[8];
        unpack8(d0, a); unpack8(d1, b);
        float dot = 0.f;
#pragma unroll
        for (int i = 0; i < 8; ++i) dot += x[i] * a[i] + x[8 + i] * b[i];
        dot = wave_sum(dot);
        const float c = g * gelu_tanh(dot);
        unpack8(u0, a); unpack8(u1, b);
#pragma unroll
        for (int i = 0; i < 8; ++i) { y[i] += c * a[i]; y[8 + i] += c * b[i]; }
    }
    float4* rr = (float4*)(res + (size_t)tok * DM);
    float4 r0 = rr[2 * lane], r1 = rr[2 * lane + 1], r2 = rr[128 + 2 * lane], r3 = rr[128 + 2 * lane + 1];
    r0.x += y[0]; r0.y += y[1]; r0.z += y[2]; r0.w += y[3];
    r1.x += y[4]; r1.y += y[5]; r1.z += y[6]; r1.w += y[7];
    r2.x += y[8]; r2.y += y[9]; r2.z += y[10]; r2.w += y[11];
    r3.x += y[12]; r3.y += y[13]; r3.z += y[14]; r3.w += y[15];
    rr[2 * lane] = r0; rr[2 * lane + 1] = r1; rr[128 + 2 * lane] = r2; rr[128 + 2 * lane + 1] = r3;
    if (NEXT_NORM) {
        float ss = r0.x * r0.x + r0.y * r0.y + r0.z * r0.z + r0.w * r0.w + r1.x * r1.x + r1.y * r1.y + r1.z * r1.z + r1.w * r1.w
                 + r2.x * r2.x + r2.y * r2.y + r2.z * r2.z + r2.w * r2.w + r3.x * r3.x + r3.y * r3.y + r3.z * r3.z + r3.w * r3.w;
        ss = wave_sum(ss);
        const float rinv = rsqrtf(ss * (1.f / DM) + EPSN);
        const float4* gp = (const float4*)gnext;
        const float4 g0 = gp[2 * lane], g1 = gp[2 * lane + 1], g2 = gp[128 + 2 * lane], g3 = gp[128 + 2 * lane + 1];
        uint4 o0, o1;
        o0.x = pack2(r0.x * rinv * g0.x, r0.y * rinv * g0.y); o0.y = pack2(r0.z * rinv * g0.z, r0.w * rinv * g0.w);
        o0.z = pack2(r1.x * rinv * g1.x, r1.y * rinv * g1.y); o0.w = pack2(r1.z * rinv * g1.z, r1.w * rinv * g1.w);
        o1.x = pack2(r2.x * rinv * g2.x, r2.y * rinv * g2.y); o1.y = pack2(r2.z * rinv * g2.z, r2.w * rinv * g2.w);
        o1.z = pack2(r3.x * rinv * g3.x, r3.y * rinv * g3.y); o1.w = pack2(r3.z * rinv * g3.z, r3.w * rinv * g3.w);
        uint4* hw = (uint4*)(hn + (size_t)tok * DM);
        hw[lane] = o0; hw[64 + lane] = o1;
    }
}

__global__ void __launch_bounds__(128) k_ssq_ref(const bf16_t* __restrict__ vt, float* __restrict__ ssq) {
    const int chunk = blockIdx.x, j = blockIdx.y, s = threadIdx.x;
    float acc = 0.f;
    for (int c = 0; c < 128; ++c) { const float v = bf2f(vt[((size_t)chunk * CW + j * 128 + c) * 128 + s]); acc += v * v; }
    ssq[(size_t)(chunk * 128 + s) * 16 + j] = acc;
}
__global__ void __launch_bounds__(256) k_spatial_ref(bf16_t* __restrict__ u, const bf16_t* __restrict__ vt, const float* __restrict__ ssq,
                                                     const float* __restrict__ wsp, const float* __restrict__ bsp, const float* __restrict__ vgain) {
    __shared__ float rinv[128];
    __shared__ bf16_t vs[128][130];
    const int chunk = blockIdx.x, g = blockIdx.y, half = blockIdx.z;
    const int tid = threadIdx.x;
    if (tid < 128) {
        float s = 0.f;
        for (int j = 0; j < 16; ++j) s += ssq[(size_t)(chunk * 128 + tid) * 16 + j];
        rinv[tid] = rsqrtf(s * (1.f / CW) + EPSN);
    }
    const int c0 = g * 256 + half * 128;
    for (int i = tid; i < 128 * 128; i += 256) { const int c = i >> 7, s = i & 127; vs[c][s] = vt[((size_t)chunk * CW + c0 + c) * 128 + s]; }
    __syncthreads();
    const int cc = tid & 127, par = tid >> 7;
    const float gain = vgain[c0 + cc];
    for (int t = par; t < 128; t += 2) {
        const float* wr = wsp + ((size_t)g * 128 + t) * 128;
        float acc = 0.f;
        for (int s = 0; s <= t; ++s) acc += wr[s] * rinv[s] * bf2f(vs[cc][s]);
        const float gate = acc * gain + bsp[g * 128 + t];
        bf16_t* up = u + (size_t)(chunk * 128 + t) * CW + c0 + cc;
        *up = f2bf(bf2f(*up) * gate);
    }
}

extern "C" void kernel_launch(void* const* d_in, const int* in_sizes, int n_in, void* d_out, int out_size, void* d_ws, size_t ws_size, hipStream_t stream) {
    if (n_in != 24 || ws_size < WS_NEED) { fprintf(stderr, "kernel_launch: unexpected n_in %d or ws_size %zu\n", n_in, ws_size); return; }
    unsigned char* ws = (unsigned char*)d_ws;
    const float* x = (const float*)d_in[0];
    float* out = (float*)d_out;
    bf16_t* w_attin = (bf16_t*)(ws + WS_W_ATTIN);
    bf16_t* w_attout = (bf16_t*)(ws + WS_W_ATTOUT);
    bf16_t* w_sguin = (bf16_t*)(ws + WS_W_SGUIN);
    bf16_t* w_sguout = (bf16_t*)(ws + WS_W_SGUOUT);
    bf16_t* w_pq = (bf16_t*)(ws + WS_W_PQ);
    bf16_t* w_subk = (bf16_t*)(ws + WS_W_SUBK);
    float* ssq = (float*)(ws + WS_MISC);
    bf16_t* t_down = (bf16_t*)(ws + WS_DOWN);
    bf16_t* t_up = (bf16_t*)(ws + WS_UP);
    bf16_t* xn = (bf16_t*)(ws + WS_XN);
    bf16_t* proj = (bf16_t*)(ws + WS_PROJ);
    bf16_t* mixed = (bf16_t*)(ws + WS_MIXED);
    bf16_t* zu = (bf16_t*)(ws + WS_Z_U);
    bf16_t* zvt = (bf16_t*)(ws + WS_Z_VT);
    u32* r1 = (u32*)(ws + WS_R1);
    int* ridx = (int*)(ws + WS_RIDX);
    float* rg = (float*)(ws + WS_RG);
    bf16_t* qbuf = (bf16_t*)(ws + WS_QBUF);

    k_transpose_bf16<<<dim3(ATT_IN / 32, DM / 32), 256, 0, stream>>>((const float*)d_in[2], w_attin, DM, ATT_IN);
    k_transpose_bf16<<<dim3(DM / 32, DM / 32), 256, 0, stream>>>((const float*)d_in[12], w_attout, DM, DM);
    k_transpose_bf16<<<dim3(4096 / 32, DM / 32), 256, 0, stream>>>((const float*)d_in[14], w_sguin, DM, 4096);
    k_transpose_bf16<<<dim3(DM / 32, CW / 32), 256, 0, stream>>>((const float*)d_in[18], w_sguout, CW, DM);
    for (int l = 0; l < 2; ++l)
        k_transpose_bf16<<<dim3(2048 / 32, DM / 32), 256, 0, stream>>>((const float*)d_in[20] + (size_t)l * DM * 2048, w_pq + (size_t)l * 2048 * DM, DM, 2048);
    k_cvt_bf16<<<256, 256, 0, stream>>>((const float*)d_in[21], w_subk, (size_t)2 * 8 * 2 * 128 * 128 / 4);
    k_cvt_bf16<<<2048, 256, 0, stream>>>((const float*)d_in[22], t_down, (size_t)2 * NEXP * DM / 4);
    k_cvt_bf16<<<2048, 256, 0, stream>>>((const float*)d_in[23], t_up, (size_t)2 * NEXP * DM / 4);

    k_rmsnorm<<<2048, 256, 0, stream>>>(x, (const float*)d_in[1], xn, NTOK);
    k_gemm_ref<<<dim3(ATT_IN / 64, NTOK / 64), 256, 0, stream>>>(xn, w_attin, NTOK, ATT_IN, DM, EpiProj{proj});
    k_headnorm_ref<<<NTOK * 32 / 256, 256, 0, stream>>>(proj, (const float*)d_in[3], (const float*)d_in[4], (const float*)d_in[5], (const float*)d_in[6]);
    k_attnA_ref<<<NTOK * 8 / 4, 256, 0, stream>>>(proj, mixed);
    k_attnB_ref<<<NTOK * 4 / 2, 128, 0, stream>>>(proj, mixed, (const float*)d_in[7], (const float*)d_in[8], (const float*)d_in[9], (const float*)d_in[10], (const float*)d_in[11]);
    k_gemm_ref<<<dim3(DM / 64, NTOK / 64), 256, 0, stream>>>(mixed, w_attout, NTOK, DM, DM, EpiResid{x, out});

    for (int l = 0; l < 2; ++l) {
        if (l == 1) {
            k_gemm_ref<<<dim3(4096 / 64, NTOK / 64), 256, 0, stream>>>(xn, w_sguin, NTOK, 4096, DM, EpiSgu{zu, zvt});
            k_ssq_ref<<<dim3(256, 16), 128, 0, stream>>>(zvt, ssq);
            k_spatial_ref<<<dim3(256, 8, 2), 256, 0, stream>>>(zu, zvt, ssq, (const float*)d_in[16], (const float*)d_in[17], (const float*)d_in[15]);
            k_gemm_ref<<<dim3(DM / 64, NTOK / 64), 256, 0, stream>>>(zu, w_sguout, NTOK, DM, CW, EpiResid{out, out});
        }
        k_rmsnorm<<<2048, 256, 0, stream>>>(out, (const float*)d_in[19] + l * DM, xn, NTOK);
        k_gemm_ref<<<dim3(2048 / 64, NTOK / 64), 256, 0, stream>>>(xn, w_pq + (size_t)l * 2048 * DM, NTOK, 2048, DM, EpiQ{qbuf});
        k_route1_ref<<<dim3(NTOK / 256, 16), 256, 0, stream>>>(qbuf, w_subk + (size_t)l * 16 * 128 * 128, r1);
        k_route2<<<NTOK * 8 / 256, 256, 0, stream>>>(r1, ridx, rg);
        if (l == 0)
            k_peer_gather<true><<<NTOK / 4, 256, 0, stream>>>(xn, ridx, rg, t_down + (size_t)l * NEXP * DM, t_up + (size_t)l * NEXP * DM, out, (const float*)d_in[13]);
        else
            k_peer_gather<false><<<NTOK / 4, 256, 0, stream>>>(xn, ridx, rg, t_down + (size_t)l * NEXP * DM, t_up + (size_t)l * NEXP * DM, out, nullptr);
    }
}
```

```cpp
#include <hip/hip_runtime.h>
#include <stdint.h>
#include <stdio.h>

#define NTOK   32768
#define DM     1024
#define SEQ    2048
#define NB     16
#define ATT_IN 3072
#define CW     2048
#define NEXP   16384
#define EPSN   1e-6f

typedef unsigned short bf16_t;
typedef unsigned int u32;

#define DI __device__ __forceinline__
#define LAS __attribute__((address_space(3)))

DI int otid() { int t = threadIdx.x & 255; asm volatile("" : "+v"(t)); return t; }
DI int otid512() { int t = threadIdx.x; asm volatile("" : "+v"(t)); return t; }
DI float bf2f(bf16_t v) { return __uint_as_float(((u32)v) << 16); }
typedef __bf16 bf16v2 __attribute__((ext_vector_type(2)));
DI bf16_t f2bf(float f) { const __bf16 h = (__bf16)f; return __builtin_bit_cast(bf16_t, h); }
DI u32 pack2(float lo, float hi) { bf16v2 v; v[0] = (__bf16)lo; v[1] = (__bf16)hi; return __builtin_bit_cast(u32, v); }
DI float gelu_tanh(float x) {
    const float y = 0.7978845608028654f * (x + 0.044715f * x * x * x);
    const float e = __expf(2.f * y);
    const float t = 1.f - 2.f / (e + 1.f);
    return 0.5f * x * (1.f + t);
}
DI float wave_sum(float v) {
#pragma unroll
    for (int o = 1; o < 64; o <<= 1) v += __shfl_xor(v, o);
    return v;
}
DI float wave_max(float v) {
#pragma unroll
    for (int o = 1; o < 64; o <<= 1) v = fmaxf(v, __shfl_xor(v, o));
    return v;
}
DI u32 f2ord(float f) { u32 u = __float_as_uint(f); return (u & 0x80000000u) ? ~u : (u | 0x80000000u); }
DI float ord2f(u32 o) { u32 u = (o & 0x80000000u) ? (o & 0x7fffffffu) : ~o; return __uint_as_float(u); }

#define MiB ((size_t)1 << 20)
#define WS_CTL      ((size_t)0)
#define WS_W_ATTIN  (1 * MiB)
#define WS_W_ATTOUT (7 * MiB)
#define WS_W_SGUIN  (9 * MiB)
#define WS_W_SGUOUT (17 * MiB)
#define WS_W_PQ     (21 * MiB)
#define WS_W_SUBK   (29 * MiB)
#define WS_DOWN     (32 * MiB)
#define WS_UP       (64 * MiB)
#define WS_DSC      (96 * MiB)
#define WS_USC      (96 * MiB + 128 * 1024)
#define WS_LSE1     (30 * MiB)
#define WS_XQ       (100 * MiB)
#define WS_XSC      (132 * MiB)
#define WS_XN       (160 * MiB)
#define WS_BIG      (224 * MiB)
#define WS_PROJ     (WS_BIG)
#define WS_MIXED    (WS_BIG + 192 * MiB)
#define WS_Z_U      (WS_BIG)
#define WS_Z_VT     (WS_BIG + 128 * MiB)
#define WS_RIDX     (WS_BIG + 32 * MiB)
#define WS_RG       (WS_BIG + 48 * MiB)
#define WS_QBUF     (WS_BIG + 64 * MiB)
#define WS_SSQ      (WS_BIG + 256 * MiB)
#define WS_NEED     (512 * MiB)

struct Params {
    const float* in[24];
    float* out;
    unsigned char* ws;
};

#include <hip/hip_cooperative_groups.h>
namespace cg = cooperative_groups;

#define GROUP_SMEM (68 * 1024)
#define PG8_EXTRA (128 * 1024)
#define SMEM_BYTES (144 * 1024)
#define SMEM_ALLOC (SMEM_BYTES + 16)
#define NTHREADS 512

#define WSP(T, off) ((T*)(p.ws + (off)))


DI void transpose_tile(const float* __restrict__ W, bf16_t* __restrict__ Wt, int K, int N, int t, unsigned char* smem) {
    float* tile = (float*)smem;
    const int tid = otid();
    const int ntn = N / 64;
    const int n0 = (t % ntn) * 64, k0 = (t / ntn) * 64;
    __syncthreads();
    {
        const int n4 = tid & 15, kr = tid >> 4;
#pragma unroll
        for (int i = 0; i < 4; ++i) {
            const int k = kr + 16 * i;
            const float4 v = *(const float4*)(W + (size_t)(k0 + k) * N + n0 + 4 * n4);
            tile[k * 65 + 4 * n4 + 0] = v.x; tile[k * 65 + 4 * n4 + 1] = v.y; tile[k * 65 + 4 * n4 + 2] = v.z; tile[k * 65 + 4 * n4 + 3] = v.w;
        }
    }
    __syncthreads();
    {
        const int n = tid >> 2, kc = tid & 3;
        float v[16];
#pragma unroll
        for (int j = 0; j < 16; ++j) v[j] = tile[(16 * kc + j) * 65 + n];
        uint4 o0, o1;
        o0.x = pack2(v[0], v[1]); o0.y = pack2(v[2], v[3]); o0.z = pack2(v[4], v[5]); o0.w = pack2(v[6], v[7]);
        o1.x = pack2(v[8], v[9]); o1.y = pack2(v[10], v[11]); o1.z = pack2(v[12], v[13]); o1.w = pack2(v[14], v[15]);
        uint4* dst = (uint4*)(Wt + (size_t)(n0 + n) * K + k0 + 16 * kc);
        dst[0] = o0; dst[1] = o1;
    }
}
DI void cvt_chunk(const float* __restrict__ src, bf16_t* __restrict__ dst, int c) {
    const size_t base = (size_t)c * 2048;
#pragma unroll
    for (int i = 0; i < 8; ++i) {
        const size_t idx = base + i * 256 + otid();
        const float4 v = ((const float4*)src)[idx];
        uint2 o; o.x = pack2(v.x, v.y); o.y = pack2(v.z, v.w);
        ((uint2*)dst)[idx] = o;
    }
}
DI int q8(float v) { int i = __float2int_rn(v); i = i > 127 ? 127 : i; i = i < -127 ? -127 : i; return i & 255; }
template <bool EMIT_Q>
DI void rmsnorm_rows(const float* __restrict__ x, const float* __restrict__ g, bf16_t* __restrict__ o, int vb, signed char* xq = nullptr, float* xsc = nullptr) {
    const int lane = otid() & 63;
    const int row = vb * 4 + (otid() >> 6);
    const float4* xr = (const float4*)(x + (size_t)row * DM);
    float4 v[4]; float ss = 0.f;
#pragma unroll
    for (int j = 0; j < 4; ++j) { v[j] = xr[lane + 64 * j]; ss += v[j].x * v[j].x + v[j].y * v[j].y + v[j].z * v[j].z + v[j].w * v[j].w; }
    ss = wave_sum(ss);
    const float rinv = rsqrtf(ss * (1.f / DM) + EPSN);
    uint2* orow = (uint2*)(o + (size_t)row * DM);
    float am = 0.f;
#pragma unroll
    for (int j = 0; j < 4; ++j) {
        const float4 gg = ((const float4*)g)[lane + 64 * j];
        v[j].x *= rinv * gg.x; v[j].y *= rinv * gg.y; v[j].z *= rinv * gg.z; v[j].w *= rinv * gg.w;
        uint2 w; w.x = pack2(v[j].x, v[j].y); w.y = pack2(v[j].z, v[j].w);
        orow[lane + 64 * j] = w;
        if (EMIT_Q) am = fmaxf(am, fmaxf(fmaxf(fabsf(v[j].x), fabsf(v[j].y)), fmaxf(fabsf(v[j].z), fabsf(v[j].w))));
    }
    if (EMIT_Q) {
        am = wave_max(am);
        const float sc = am > 0.f ? 127.f / am : 0.f;
        u32* qrow = (u32*)(xq + (size_t)row * DM);
#pragma unroll
        for (int j = 0; j < 4; ++j)
            qrow[lane + 64 * j] = (u32)q8(v[j].x * sc) | ((u32)q8(v[j].y * sc) << 8) | ((u32)q8(v[j].z * sc) << 16) | ((u32)q8(v[j].w * sc) << 24);
        if (lane == 0) xsc[row] = am * (1.f / 127.f);
    }
}
#define PREP_T0 (48 * 16)
#define PREP_T1 (PREP_T0 + 16 * 16)
#define PREP_T2 (PREP_T1 + 64 * 16)
#define PREP_T3 (PREP_T2 + 16 * 32)
#define PREP_T4 (PREP_T3 + 2 * 32 * 16)
#define PREP_C0 (PREP_T4 + 64)
#define PREP_C1 (PREP_C0 + 8192)
#define PREP_C2 (PREP_C1 + 8192)
#define PREP_N  (PREP_C2 + 8192)
template <bool INT8>
DI void fp8_rows(const float* __restrict__ src, unsigned char* __restrict__ dst, float* __restrict__ inv_scale, int vb) {
    const int lane = otid() & 63;
    const int row = vb * 4 + (otid() >> 6);
    const float4* sr = (const float4*)(src + (size_t)row * DM) + lane;
    float4 v[4]; float am = 0.f;
#pragma unroll
    for (int j = 0; j < 4; ++j) { v[j] = sr[64 * j]; am = fmaxf(am, fmaxf(fmaxf(fabsf(v[j].x), fabsf(v[j].y)), fmaxf(fabsf(v[j].z), fabsf(v[j].w)))); }
    am = wave_max(am);
    float sc, inv;
    if (INT8) { sc = am > 0.f ? 127.f / am : 0.f; inv = am * (1.f / 127.f); }
    else {
        int e = (int)((__float_as_uint(am) >> 23) & 255u) - 127;
        if (am == 0.f) e = 0;
        e = e < -100 ? -100 : e;
        sc = __uint_as_float((u32)(127 + 7 - e) << 23); inv = __uint_as_float((u32)(127 + e - 7) << 23);
    }
    unsigned char* drow = dst + (size_t)(row >> 14) * NEXP * DM + (size_t)(row & (NEXP - 1)) * 128;
#pragma unroll
    for (int j = 0; j < 4; ++j) {
        const int dim = 4 * (lane + 64 * j);
        u32 w;
        if (INT8) w = (u32)q8(v[j].x * sc) | ((u32)q8(v[j].y * sc) << 8) | ((u32)q8(v[j].z * sc) << 16) | ((u32)q8(v[j].w * sc) << 24);
        else { int t = __builtin_amdgcn_cvt_pk_fp8_f32(v[j].x * sc, v[j].y * sc, 0, false); t = __builtin_amdgcn_cvt_pk_fp8_f32(v[j].z * sc, v[j].w * sc, t, true); w = (u32)t; }
        *(u32*)(drow + (size_t)(dim >> 7) * NEXP * 128 + (dim & 127)) = w;
    }
    if (lane == 0) inv_scale[row] = inv;
}
DI void ph_prep(const Params& p, int vb, unsigned char* smem) {
    if (vb < PREP_T0) transpose_tile(p.in[2], WSP(bf16_t, WS_W_ATTIN), DM, ATT_IN, vb, smem);
    else if (vb < PREP_T1) transpose_tile(p.in[12], WSP(bf16_t, WS_W_ATTOUT), DM, DM, vb - PREP_T0, smem);
    else if (vb < PREP_T2) transpose_tile(p.in[14], WSP(bf16_t, WS_W_SGUIN), DM, 4096, vb - PREP_T1, smem);
    else if (vb < PREP_T3) transpose_tile(p.in[18], WSP(bf16_t, WS_W_SGUOUT), CW, DM, vb - PREP_T2, smem);
    else if (vb < PREP_T4) { const int t = vb - PREP_T3, l = t / 512; transpose_tile(p.in[20] + (size_t)l * DM * 2048, WSP(bf16_t, WS_W_PQ) + (size_t)l * 2048 * DM, DM, 2048, t % 512, smem); }
    else if (vb < PREP_C0) cvt_chunk(p.in[21], WSP(bf16_t, WS_W_SUBK), vb - PREP_T4);
    else if (vb < PREP_C1) fp8_rows<true>(p.in[22], p.ws + WS_DOWN, WSP(float, WS_DSC), vb - PREP_C0);
    else if (vb < PREP_C2) fp8_rows<false>(p.in[23], p.ws + WS_UP, WSP(float, WS_USC), vb - PREP_C1);
    else rmsnorm_rows<false>(p.in[0], p.in[1], WSP(bf16_t, WS_XN), vb - PREP_C2);
}

DI float compute_lam(const Params& p, int lane) {
    const float a = wave_sum(p.in[7][lane] * p.in[8][lane]);
    const float b = wave_sum(p.in[9][lane] * p.in[10][lane]);
    return __expf(a) - __expf(b) + 0.2f;
}
DI void ce_desc(u32& a, u32& b) { const u32 hi = max(a, b), lo = min(a, b); a = hi; b = lo; }
DI void sort16_desc(u32 (&v)[16]) {
#pragma unroll
    for (int k = 2; k <= 16; k <<= 1)
#pragma unroll
        for (int j = k >> 1; j > 0; j >>= 1)
#pragma unroll
            for (int i = 0; i < 16; ++i) {
                const int l = i ^ j;
                if (l > i) { if ((i & k) == 0) ce_desc(v[i], v[l]); else ce_desc(v[l], v[i]); }
            }
}
DI void merge16_desc(u32 (&a)[16], const u32 (&b)[16]) {
#pragma unroll
    for (int i = 0; i < 16; ++i) a[i] = max(a[i], b[15 - i]);
#pragma unroll
    for (int j = 8; j > 0; j >>= 1)
#pragma unroll
        for (int i = 0; i < 16; ++i) { const int l = i ^ j; if (l > i) ce_desc(a[i], a[l]); }
}
DI void top16_insert(u32 (&lst)[16], u32 x) {
#pragma unroll
    for (int j = 0; j < 16; ++j) { const u32 hi = max(lst[j], x); x = min(lst[j], x); lst[j] = hi; }
}
DI void unpack8(const uint4 v, float (&f)[8]) {
    f[0] = __uint_as_float(v.x << 16); f[1] = __uint_as_float(v.x & 0xffff0000u);
    f[2] = __uint_as_float(v.y << 16); f[3] = __uint_as_float(v.y & 0xffff0000u);
    f[4] = __uint_as_float(v.z << 16); f[5] = __uint_as_float(v.z & 0xffff0000u);
    f[6] = __uint_as_float(v.w << 16); f[7] = __uint_as_float(v.w & 0xffff0000u);
}
typedef float f32x2_t __attribute__((ext_vector_type(2)));
DI void unpack16fp8(const uint4 w, float (&f)[16]) {
    f32x2_t t;
    t = __builtin_amdgcn_cvt_pk_f32_fp8((int)w.x, false); f[0] = t[0]; f[1] = t[1];
    t = __builtin_amdgcn_cvt_pk_f32_fp8((int)w.x, true);  f[2] = t[0]; f[3] = t[1];
    t = __builtin_amdgcn_cvt_pk_f32_fp8((int)w.y, false); f[4] = t[0]; f[5] = t[1];
    t = __builtin_amdgcn_cvt_pk_f32_fp8((int)w.y, true);  f[6] = t[0]; f[7] = t[1];
    t = __builtin_amdgcn_cvt_pk_f32_fp8((int)w.z, false); f[8] = t[0]; f[9] = t[1];
    t = __builtin_amdgcn_cvt_pk_f32_fp8((int)w.z, true);  f[10] = t[0]; f[11] = t[1];
    t = __builtin_amdgcn_cvt_pk_f32_fp8((int)w.w, false); f[12] = t[0]; f[13] = t[1];
    t = __builtin_amdgcn_cvt_pk_f32_fp8((int)w.w, true);  f[14] = t[0]; f[15] = t[1];
}
struct PeerPre { int e[16]; uint4 xa, xb; float2 r; };
struct PeerRows { uint4 d[8]; float c[8]; };
template <bool UP>
DI PeerPre peer_prefetch(const Params& p, int tok, int sl, int lane) {
    PeerPre q;
    const int4* rix = (const int4*)(WSP(int, WS_RIDX) + (size_t)tok * 128 + 16 * (lane >> 3));
#pragma unroll
    for (int j = 0; j < 4; ++j) { const int4 t = rix[j]; q.e[4 * j] = t.x; q.e[4 * j + 1] = t.y; q.e[4 * j + 2] = t.z; q.e[4 * j + 3] = t.w; }
    if (UP) {
        q.r = *(const float2*)(p.out + (size_t)tok * DM + sl * 128 + 16 * (lane & 7) + 2 * (lane >> 3));
    } else {
        q.xa = *(const uint4*)(WSP(signed char, WS_XQ) + (size_t)tok * DM + sl * 128 + 16 * (lane & 7));
    }
    return q;
}
template <int HF, bool UP>
DI void peer_issue_rows(const Params& p, const unsigned char* tab, const PeerPre& q, int tok, int lane, PeerRows& R) {
    const unsigned dco = 16u * (unsigned)(lane & 7);
#pragma unroll
    for (int bi = 0; bi < 8; ++bi) R.d[bi] = *(const uint4*)(tab + ((unsigned)q.e[8 * HF + bi] * 128u + dco));
    if (UP) {
        const float4* cf = (const float4*)(WSP(float, WS_RG) + (size_t)tok * 128 + 16 * (lane >> 3) + 8 * HF);
        const float4 c0 = cf[0], c1 = cf[1];
        R.c[0] = c0.x; R.c[1] = c0.y; R.c[2] = c0.z; R.c[3] = c0.w; R.c[4] = c1.x; R.c[5] = c1.y; R.c[6] = c1.z; R.c[7] = c1.w;
    }
}
template <int HF>
DI void peer_down_half(const PeerPre& q, const PeerRows& R, float (&part)[16]) {
#pragma unroll
    for (int bi = 0; bi < 8; ++bi) {
        int a = __builtin_amdgcn_sdot4((int)R.d[bi].x, (int)q.xa.x, 0, false);
        a = __builtin_amdgcn_sdot4((int)R.d[bi].y, (int)q.xa.y, a, false);
        a = __builtin_amdgcn_sdot4((int)R.d[bi].z, (int)q.xa.z, a, false);
        a = __builtin_amdgcn_sdot4((int)R.d[bi].w, (int)q.xa.w, a, false);
        part[8 * HF + bi] = (float)a;
    }
}
DI void peer_down_fin(const Params& p, const float (&part)[16], int tok, int sl, int lane) {
    const bool b2 = lane & 4, b1 = lane & 2, b0 = lane & 1;
    float r8[8], r4[4], r2[2];
#pragma unroll
    for (int i = 0; i < 8; ++i) { const float snd = b2 ? part[i] : part[i + 8]; const float kp = b2 ? part[i + 8] : part[i]; r8[i] = kp + __shfl_xor(snd, 4); }
#pragma unroll
    for (int i = 0; i < 4; ++i) { const float snd = b1 ? r8[i] : r8[i + 4]; const float kp = b1 ? r8[i + 4] : r8[i]; r4[i] = kp + __shfl_xor(snd, 2); }
#pragma unroll
    for (int i = 0; i < 2; ++i) { const float snd = b0 ? r4[i] : r4[i + 2]; const float kp = b0 ? r4[i + 2] : r4[i]; r2[i] = kp + __shfl_xor(snd, 1); }
    float* pd = WSP(float, WS_QBUF) + ((size_t)tok * 8 + sl) * 128;
    *(float2*)(pd + 2 * lane) = make_float2(r2[0], r2[1]);
}
DI void ph_peer_comb(const Params& p, int vb, int l) {
    const int tid = otid(), lane = tid & 63;
    const int tok = vb * 4 + (tid >> 6);
    const float* pd = WSP(float, WS_QBUF) + (size_t)tok * 8 * 128;
    const int* rix = WSP(int, WS_RIDX) + (size_t)tok * 128;
    float* rgp = WSP(float, WS_RG) + (size_t)tok * 128;
    const float* dsc = WSP(float, WS_DSC) + (size_t)l * NEXP;
    const float* usc = WSP(float, WS_USC) + (size_t)l * NEXP;
    const float xs = WSP(float, WS_XSC)[tok];
#pragma unroll
    for (int hh = 0; hh < 2; ++hh) {
        const int k = lane + 64 * hh;
        float t = 0.f;
#pragma unroll
        for (int sl = 0; sl < 8; ++sl) t += pd[sl * 128 + k];
        const int e = rix[k];
        rgp[k] = rgp[k] * gelu_tanh(t * dsc[e] * xs) * usc[e];
    }
}
template <int HF>
DI void peer_up_half(const PeerPre& q, const PeerRows& R, float (&y)[16]) {
#pragma unroll
    for (int bi = 0; bi < 8; ++bi) {
        const float c = R.c[bi];
        float w[16]; unpack16fp8(R.d[bi], w);
#pragma unroll
        for (int i = 0; i < 16; ++i) y[i] += c * w[i];
        asm volatile("" : "+v"(y[0]), "+v"(y[1]), "+v"(y[2]), "+v"(y[3]), "+v"(y[4]), "+v"(y[5]), "+v"(y[6]), "+v"(y[7]), "+v"(y[8]), "+v"(y[9]), "+v"(y[10]), "+v"(y[11]), "+v"(y[12]), "+v"(y[13]), "+v"(y[14]), "+v"(y[15]));
    }
}
DI void peer_up_fin(const Params& p, const PeerPre& q, const float (&y)[16], int tok, int sl, int lane) {
    const int rg = lane >> 3, dc = lane & 7;
    const bool b5 = lane & 32, b4 = lane & 16, b3 = lane & 8;
    float r8[8], r4[4], r2[2];
#pragma unroll
    for (int i = 0; i < 8; ++i) { const float snd = b5 ? y[i] : y[i + 8]; const float kp = b5 ? y[i + 8] : y[i]; r8[i] = kp + __shfl_xor(snd, 32); }
#pragma unroll
    for (int i = 0; i < 4; ++i) { const float snd = b4 ? r8[i] : r8[i + 4]; const float kp = b4 ? r8[i + 4] : r8[i]; r4[i] = kp + __shfl_xor(snd, 16); }
#pragma unroll
    for (int i = 0; i < 2; ++i) { const float snd = b3 ? r4[i] : r4[i + 2]; const float kp = b3 ? r4[i + 2] : r4[i]; r2[i] = kp + __shfl_xor(snd, 8); }
    float2 v = q.r;
    v.x += r2[0]; v.y += r2[1];
    *(float2*)(p.out + (size_t)tok * DM + sl * 128 + 16 * dc + 2 * rg) = v;
}
template <bool UP>
DI void run_peer_sliced(const Params& p, int l, unsigned char* smem) {
    volatile LAS unsigned* st = (volatile LAS unsigned*)(smem + SMEM_BYTES);
    const int nloc = (int)st[0], nx = (int)st[1], rank = (int)st[2], xi = (int)st[3];
    const int tid = otid512(), lane = tid & 63, wave = tid >> 6;
    const int stride = nloc * 8;
#pragma unroll 1
    for (int sl = xi; sl < 8; sl += nx) {
        const unsigned char* tab = p.ws + (UP ? WS_UP : WS_DOWN) + (size_t)l * NEXP * DM + (size_t)sl * NEXP * 128;
        int tok = rank * 8 + wave;
        if (tok >= NTOK) continue;
        PeerPre qc = peer_prefetch<UP>(p, tok, sl, lane);
        PeerRows R;
        peer_issue_rows<0, UP>(p, tab, qc, tok, lane, R);
#pragma unroll 1
        for (; tok < NTOK; tok += stride) {
            const int tn = tok + stride < NTOK ? tok + stride : tok;
            const PeerPre qn = peer_prefetch<UP>(p, tn, sl, lane);
            float acc[16];
#pragma unroll
            for (int i = 0; i < 16; ++i) acc[i] = 0.f;
            PeerRows Rn;
            peer_issue_rows<1, UP>(p, tab, qc, tok, lane, Rn);
            __builtin_amdgcn_sched_barrier(0);
            if (UP) peer_up_half<0>(qc, R, acc); else peer_down_half<0>(qc, R, acc);
            __builtin_amdgcn_sched_barrier(0);
            peer_issue_rows<0, UP>(p, tab, qn, tn, lane, R);
            __builtin_amdgcn_sched_barrier(0);
            if (UP) { peer_up_half<1>(qc, Rn, acc); peer_up_fin(p, qc, acc, tok, sl, lane); }
            else { peer_down_half<1>(qc, Rn, acc); peer_down_fin(p, acc, tok, sl, lane); }
            __builtin_amdgcn_sched_barrier(0);
            qc = qn;
        }
    }
}


typedef short bf16x8 __attribute__((ext_vector_type(8)));
typedef float f32x16 __attribute__((ext_vector_type(16)));
#define MFMA32(a, b, c) __builtin_amdgcn_mfma_f32_32x32x16_bf16((a), (b), (c), 0, 0, 0)
typedef short s16x4 __attribute__((ext_vector_type(4)));
DI bf16x8 pack_p(const f32x16& pt, int s) {
    uint4 o;
    o.x = pack2(pt[8 * s + 0], pt[8 * s + 1]); o.y = pack2(pt[8 * s + 2], pt[8 * s + 3]);
    o.z = pack2(pt[8 * s + 4], pt[8 * s + 5]); o.w = pack2(pt[8 * s + 6], pt[8 * s + 7]);
    return __builtin_bit_cast(bf16x8, o);
}

DI void stage_tile(const bf16_t* __restrict__ g, int ld, int row0, int k0, unsigned char* lt, int wave, int lane) {
#pragma unroll
    for (int i = 0; i < 4; ++i) {
        const int inst = wave * 4 + i;
        const int row = inst * 8 + (lane >> 3);
        const int c = (lane & 7) ^ ((row >> 1) & 7);
        __builtin_amdgcn_global_load_lds((const unsigned*)(g + (size_t)(row0 + row) * ld + k0 + c * 8),
                                         (unsigned*)(lt + inst * 1024 + lane * 16), 16, 0, 0);
    }
}
DI bf16x8 lds_frag(const unsigned char* lt, int row, int c) {
    return *(const bf16x8*)(lt + row * 128 + ((c ^ ((row >> 1) & 7)) << 4));
}
DI int crow(int r, int fh) { return (r & 3) + 8 * (r >> 2) + 4 * fh; }

namespace pg8 {
#define PG8_LAS __attribute__((address_space(3)))
typedef float f32x4 __attribute__((ext_vector_type(4)));
typedef unsigned u32x4 __attribute__((ext_vector_type(4)));
constexpr int BM = 256, BK = 64, HALF = 128, HTB = HALF * BK * 2  , STAGE_BYTES = 8 * HTB;
__host__ __device__ __forceinline__ int lds_byte(int r, int c) { const int st = (r >> 4) * 2 + (c >> 5), rr = r & 15, cc = c & 31, ob = rr * 64 + cc * 2; return st * 1024 + (ob ^ (((ob >> 9) & 1) << 5)); }
__host__ __device__ __forceinline__ void stage_rc(int b, int& R, int& C) { const int st = b / 1024, sb = b % 1024, swz = sb ^ (((sb >> 9) & 1) << 5); R = (st >> 1) * 16 + swz / 64; C = (st & 1) * 32 + (swz % 64) / 2; }
__host__ __device__ __forceinline__ int perm32(int rho) { const int n = rho >> 4, i = rho & 15; return 8 * (i >> 2) + 4 * n + (i & 3); }
struct Unit { int pm, pn; };
struct Gemm { const bf16_t* A; const bf16_t* Bt; int M, N, K; };
struct XcdOrder {
    int ntn, nloc, nx, rank, xi, nown, total;
    __device__ __forceinline__ void init(int nmt, int ntn_, int nloc_, int nx_, int rank_, int xi_) {
        ntn = ntn_; nloc = nloc_; nx = nx_; rank = rank_; xi = xi_; nown = xi < nmt ? (nmt - xi + nx - 1) / nx : 0; total = nown * ntn; }
    __device__ __forceinline__ bool next(int i, Unit& u) const {
        const int t = rank + i * nloc; if (t >= total) return false;
        const int g4 = t / (4 * ntn), r = t - g4 * 4 * ntn;
        const int left = nown - 4 * g4, gs = left < 4 ? left : 4;
        const int nt = r / gs, mi = r - nt * gs;
        u.pm = (4 * g4 + mi) * nx + xi; u.pn = nt; return true;
    }
    __device__ __forceinline__ void a_ready(const Unit&) const {}
    __device__ __forceinline__ void done(const Unit&) const {}
};
template <class Epi, class Sched, bool ALIGN_EPI = false, bool SP2 = false>
__device__ __forceinline__ void gemm_phase(PG8_LAS unsigned char* lds, const Gemm g, const Sched& S, const Epi& E) {
    const int tid = otid512(), wid = __builtin_amdgcn_readfirstlane(tid >> 6), lane = tid & 63, wr = wid >> 2, wc = wid & 3, fr = lane & 15, fq = lane >> 4;
    const int K = g.K, nt = K / BK;
    unsigned voffA[2], voffB[2];
#pragma unroll
    for (int i = 0; i < 2; ++i) { int R, C; stage_rc(tid * 16 + i * 8192, R, C); const int Rb = Epi::PERM ? ((R & ~31) + perm32(R & 31)) : R;
        voffA[i] = (unsigned)(R * K + C) * 2u; voffB[i] = (unsigned)(Rb * K + C) * 2u; }
    const size_t kstep = (size_t)(BK * 2);
    const size_t hstep = (size_t)HALF * K * 2;
    const size_t tstep = 2 * hstep;
    const unsigned ldsw = (unsigned)wid * 1024u;
    const int aoff = lds_byte(wr * 64 + fr, fq * 8), boff = lds_byte(wc * 32 + fr, fq * 8);
#define PG8_SA(b, h) (((b) * 2 + (h)) * HTB)
#define PG8_SB(b, h) ((4 + (b) * 2 + (h)) * HTB)
#define PG8_STAGE(bufoff, gbase, voff) do { _Pragma("unroll") for (int _i = 0; _i < 2; ++_i) \
        __builtin_amdgcn_global_load_lds((const unsigned*)((const char*)(gbase) + (voff)[_i]), (PG8_LAS unsigned*)(lds + (bufoff) + ldsw + _i * 8192), 16, 0, 0); } while (0)
#define PG8_LDA(dst, b, h) do { _Pragma("unroll") for (int m = 0; m < 4; ++m) _Pragma("unroll") for (int k = 0; k < 2; ++k) dst[m][k] = *(const PG8_LAS bf16x8*)(lds + PG8_SA(b, h) + aoff + m * 2048 + k * 1024); } while (0)
#define PG8_LDB(dst, b, h) do { _Pragma("unroll") for (int n = 0; n < 2; ++n) _Pragma("unroll") for (int k = 0; k < 2; ++k) dst[n][k] = *(const PG8_LAS bf16x8*)(lds + PG8_SB(b, h) + boff + n * 2048 + k * 1024); } while (0)
#define PG8_MMA(ai, bj, At, Bt) do { __builtin_amdgcn_s_setprio(1); _Pragma("unroll") for (int m = 0; m < 4; ++m) _Pragma("unroll") for (int n = 0; n < 2; ++n) _Pragma("unroll") for (int k = 0; k < 2; ++k) \
        acc[ai][bj][m][n] = __builtin_amdgcn_mfma_f32_16x16x32_bf16(Bt[n][k], At[m][k], acc[ai][bj][m][n], 0, 0, 0); __builtin_amdgcn_s_setprio(0); } while (0)
#define PG8_WAIT_V(n) asm volatile("s_waitcnt vmcnt(" #n ")" ::: "memory")
#define PG8_WAIT_L(n) asm volatile("s_waitcnt lgkmcnt(" #n ")" ::: "memory")
#define PG8_BAR __builtin_amdgcn_s_barrier()
#define PG8_SCHED __builtin_amdgcn_sched_barrier(0)
    Unit cur, nxt; int ui = 0;
    if (!S.next(0, cur)) return;
    f32x4 acc[2][2][4][2];
#pragma unroll
    for (int a = 0; a < 2; ++a)
#pragma unroll
        for (int b = 0; b < 2; ++b)
#pragma unroll
            for (int m = 0; m < 4; ++m)
#pragma unroll
                for (int n = 0; n < 2; ++n) acc[a][b][m][n] = (f32x4){0.f, 0.f, 0.f, 0.f};
    bf16x8 At[4][2], B0[2][2], B1[2][2];
    const char* cA = (const char*)g.A + (size_t)cur.pm * tstep; const char* cB = (const char*)g.Bt + (size_t)cur.pn * tstep;
    S.a_ready(cur);
    if constexpr (SP2) {
        PG8_STAGE(PG8_SB(0, 0), cB, voffB); PG8_STAGE(PG8_SB(0, 1), cB + hstep, voffB); PG8_STAGE(PG8_SA(0, 0), cA, voffA); PG8_STAGE(PG8_SA(0, 1), cA + hstep, voffA);
        if (wr == 1) PG8_BAR;
        PG8_WAIT_V(2); PG8_BAR;
        PG8_STAGE(PG8_SB(1, 0), cB + kstep, voffB); PG8_STAGE(PG8_SA(1, 0), cA + kstep, voffA); PG8_STAGE(PG8_SB(1, 1), cB + hstep + kstep, voffB);
        PG8_WAIT_V(6); PG8_BAR;
    } else {
        PG8_STAGE(PG8_SB(0, 0), cB, voffB); PG8_STAGE(PG8_SA(0, 0), cA, voffA); PG8_STAGE(PG8_SB(0, 1), cB + hstep, voffB); PG8_STAGE(PG8_SA(0, 1), cA + hstep, voffA);
        if (wr == 1) PG8_BAR;
        PG8_WAIT_V(4); PG8_BAR;
        PG8_STAGE(PG8_SB(1, 0), cB + kstep, voffB); PG8_STAGE(PG8_SA(1, 0), cA + kstep, voffA); PG8_STAGE(PG8_SB(1, 1), cB + hstep + kstep, voffB);
        PG8_WAIT_V(6); PG8_BAR;
    }
    for (;;) {
        const bool has_next = S.next(ui + 1, nxt);
        const char* nA = has_next ? (const char*)g.A + (size_t)nxt.pm * tstep : cA; const char* nB = has_next ? (const char*)g.Bt + (size_t)nxt.pn * tstep : cB;
        for (int t = 0; t < nt; t += 2) {
            const bool last = (t == nt - 2);
            const char* a1 = cA + (size_t)(t + 1) * kstep;
            const char* a2 = last ? nA : cA + (size_t)(t + 2) * kstep; const char* b2 = last ? nB : cB + (size_t)(t + 2) * kstep;
            const char* a3 = a2 + kstep; const char* b3 = b2 + kstep;
            if (last && has_next) S.a_ready(nxt);
            if constexpr (SP2) {
            PG8_LDB(B0, 0, 0); PG8_LDB(B1, 0, 1); PG8_SCHED; PG8_LDA(At, 0, 0); PG8_STAGE(PG8_SA(1, 1), a1 + hstep, voffA);
            PG8_WAIT_V(8); PG8_WAIT_L(0); PG8_BAR; PG8_MMA(0, 0, At, B0); PG8_MMA(0, 1, At, B1); PG8_BAR; PG8_SCHED;
            PG8_LDA(At, 0, 1); PG8_STAGE(PG8_SB(0, 0), b2, voffB); PG8_STAGE(PG8_SB(0, 1), b2 + hstep, voffB); PG8_STAGE(PG8_SA(0, 0), a2, voffA);
            PG8_WAIT_V(8); PG8_WAIT_L(0); PG8_BAR; PG8_MMA(1, 0, At, B0); PG8_MMA(1, 1, At, B1); PG8_BAR; PG8_SCHED;
            PG8_LDB(B0, 1, 0); PG8_LDB(B1, 1, 1); PG8_SCHED; PG8_LDA(At, 1, 0); PG8_STAGE(PG8_SA(0, 1), a2 + hstep, voffA);
            PG8_WAIT_V(8); PG8_WAIT_L(0); PG8_BAR; PG8_MMA(0, 0, At, B0); PG8_MMA(0, 1, At, B1); PG8_BAR; PG8_SCHED;
            PG8_LDA(At, 1, 1); PG8_STAGE(PG8_SB(1, 0), b3, voffB); PG8_STAGE(PG8_SB(1, 1), b3 + hstep, voffB); PG8_STAGE(PG8_SA(1, 0), a3, voffA);
            PG8_WAIT_V(8); PG8_WAIT_L(0); PG8_BAR; PG8_MMA(1, 0, At, B0); PG8_MMA(1, 1, At, B1); PG8_BAR; PG8_SCHED;
            } else {
            PG8_LDB(B0, 0, 0); PG8_SCHED; PG8_LDA(At, 0, 0); PG8_STAGE(PG8_SA(1, 1), a1 + hstep, voffA);
            PG8_WAIT_L(8); PG8_BAR; PG8_WAIT_L(0); PG8_MMA(0, 0, At, B0); PG8_BAR; PG8_SCHED;
            PG8_LDB(B1, 0, 1); PG8_STAGE(PG8_SB(0, 0), b2, voffB);
            PG8_BAR; PG8_WAIT_L(0); PG8_MMA(0, 1, At, B1); PG8_BAR;
            PG8_LDA(At, 0, 1); PG8_STAGE(PG8_SA(0, 0), a2, voffA);
            PG8_BAR; PG8_WAIT_L(0); PG8_MMA(1, 0, At, B0); PG8_BAR; PG8_SCHED;
            PG8_STAGE(PG8_SB(0, 1), b2 + hstep, voffB);
            PG8_WAIT_V(6); PG8_BAR; PG8_MMA(1, 1, At, B1); PG8_BAR;
            PG8_LDB(B0, 1, 0); PG8_SCHED; PG8_LDA(At, 1, 0); PG8_STAGE(PG8_SA(0, 1), a2 + hstep, voffA);
            PG8_WAIT_L(8); PG8_BAR; PG8_WAIT_L(0); PG8_MMA(0, 0, At, B0); PG8_BAR; PG8_SCHED;
            PG8_LDB(B1, 1, 1); PG8_STAGE(PG8_SB(1, 0), b3, voffB);
            PG8_BAR; PG8_WAIT_L(0); PG8_MMA(0, 1, At, B1); PG8_BAR;
            PG8_LDA(At, 1, 1); PG8_STAGE(PG8_SA(1, 0), a3, voffA);
            PG8_BAR; PG8_WAIT_L(0); PG8_MMA(1, 0, At, B0); PG8_BAR; PG8_SCHED;
            PG8_STAGE(PG8_SB(1, 1), b3 + hstep, voffB);
            PG8_WAIT_V(6); PG8_BAR; PG8_MMA(1, 1, At, B1); PG8_BAR;
            }
        }
        if constexpr (ALIGN_EPI) { if (wr == 0) PG8_BAR; }
        if constexpr (!Epi::AFTER_DRAIN) { E(acc, cur, wr, wc, fr, fq); S.done(cur); }
        if (!has_next) break;
#pragma unroll
        for (int a = 0; a < 2; ++a)
#pragma unroll
            for (int b = 0; b < 2; ++b)
#pragma unroll
                for (int m = 0; m < 4; ++m)
#pragma unroll
                    for (int n = 0; n < 2; ++n) acc[a][b][m][n] = (f32x4){0.f, 0.f, 0.f, 0.f};
        cur = nxt; cA = nA; cB = nB; ++ui;
        if constexpr (ALIGN_EPI) { if (wr == 1) PG8_BAR; }
    }
    PG8_WAIT_V(0);
    if constexpr (!ALIGN_EPI) { if (wr == 0) PG8_BAR; }
    PG8_BAR;
    if constexpr (Epi::AFTER_DRAIN) { E.fused(acc, cur, wr, wc, fr, fq, lds, wid, lane); S.done(cur); }
#undef PG8_SA
#undef PG8_SB
#undef PG8_STAGE
#undef PG8_LDA
#undef PG8_LDB
#undef PG8_MMA
#undef PG8_WAIT_V
#undef PG8_WAIT_L
#undef PG8_BAR
#undef PG8_SCHED
}
struct EpiResid {
    static constexpr bool PERM = true, AFTER_DRAIN = false;
    const float* resid; float* out;
    __device__ __forceinline__ void operator()(const f32x4 (&acc)[2][2][4][2], const Unit& u, int wr, int wc, int fr, int fq) const {
        const size_t base = (size_t)(u.pm * BM + wr * 64 + fr) * DM + u.pn * BM + wc * 32 + 8 * fq;
#pragma unroll
        for (int ai = 0; ai < 2; ++ai) {
            f32x4 rv[4][2][2];
#pragma unroll
            for (int m = 0; m < 4; ++m)
#pragma unroll
                for (int bj = 0; bj < 2; ++bj) {
                    const float* rp = resid + base + (size_t)(ai * HALF + m * 16) * DM + bj * HALF;
                    rv[m][bj][0] = *(const f32x4*)rp; rv[m][bj][1] = *(const f32x4*)(rp + 4);
                }
            asm volatile("" ::: "memory");
#pragma unroll
            for (int m = 0; m < 4; ++m)
#pragma unroll
                for (int bj = 0; bj < 2; ++bj) {
                    float* op = out + base + (size_t)(ai * HALF + m * 16) * DM + bj * HALF;
                    *(f32x4*)op = rv[m][bj][0] + acc[ai][bj][m][0]; *(f32x4*)(op + 4) = rv[m][bj][1] + acc[ai][bj][m][1];
                }
            asm volatile("" ::: "memory");
        }
    }
};
struct EpiProj {
    static constexpr bool PERM = true, AFTER_DRAIN = false;
    const float* aq; const float* ak; const float* bq; const float* bk; bf16_t* proj; PG8_LAS float* xs;
    __device__ __forceinline__ void operator()(const f32x4 (&acc)[2][2][4][2], const Unit& u, int wr, int wc, int fr, int fq) const {
        const int wave = wr * 4 + wc;
#pragma unroll
        for (int ai = 0; ai < 2; ++ai)
#pragma unroll
            for (int m = 0; m < 4; ++m)
#pragma unroll
                for (int bj = 0; bj < 2; ++bj) {
                    const f32x4 a = acc[ai][bj][m][0], b = acc[ai][bj][m][1];
                    float t = a[0] * a[0] + a[1] * a[1] + a[2] * a[2] + a[3] * a[3] + b[0] * b[0] + b[1] * b[1] + b[2] * b[2] + b[3] * b[3];
                    t += __shfl_xor(t, 16); t += __shfl_xor(t, 32);
                    if (fq == 0) xs[wave * 256 + ((ai * 4 + m) * 2 + bj) * 16 + fr] = t;
                }
        asm volatile("s_waitcnt lgkmcnt(0)" ::: "memory");
        __builtin_amdgcn_s_barrier();
#pragma unroll
        for (int bj = 0; bj < 2; ++bj) {
            const int gcol = u.pn * BM + bj * HALF + wc * 32 + 8 * fq;
            const float* gain = nullptr; float scale = 1.f;
            if (gcol < 512) { gain = aq + (gcol & 63); scale = 0.125f; }
            else if (gcol < 1024) gain = ak + (gcol & 63);
            else if (gcol < 1536) gain = nullptr;
            else if (gcol < 2048) { gain = bq + (gcol & 127); scale = 0.125f; }
            else if (gcol < 2560) gain = bk + (gcol & 127);
            f32x4 g0 = {1.f, 1.f, 1.f, 1.f}, g1 = {1.f, 1.f, 1.f, 1.f};
            if (gain) { g0 = *(const f32x4*)gain; g1 = *(const f32x4*)(gain + 4); }
#pragma unroll
            for (int ai = 0; ai < 2; ++ai)
#pragma unroll
                for (int m = 0; m < 4; ++m) {
                    float sc = 1.f;
                    if (gain) {
                        const int slot = ((ai * 4 + m) * 2 + bj) * 16 + fr;
                        sc = rsqrtf((xs[wave * 256 + slot] + xs[(wave ^ 1) * 256 + slot]) * (1.f / 64.f) + EPSN) * scale;
                    }
                    const f32x4 v0 = acc[ai][bj][m][0] * g0 * sc, v1 = acc[ai][bj][m][1] * g1 * sc;
                    u32x4 w; w.x = pack2(v0[0], v0[1]); w.y = pack2(v0[2], v0[3]); w.z = pack2(v1[0], v1[1]); w.w = pack2(v1[2], v1[3]);
                    *(u32x4*)(proj + (size_t)(u.pm * BM + ai * HALF + wr * 64 + m * 16 + fr) * ATT_IN + gcol) = w;
                }
        }
    }
};
struct EpiSgu {
    static constexpr bool PERM = true, AFTER_DRAIN = false;
    bf16_t* zu; bf16_t* zvt; float* ssq; PG8_LAS unsigned char* stg;
    __device__ __forceinline__ void operator()(const f32x4 (&acc)[2][2][4][2], const Unit& u, int wr, int wc, int fr, int fq) const {
        const int wave = wr * 4 + wc, lane = fq * 16 + fr;
        PG8_LAS unsigned short* tl = (PG8_LAS unsigned short*)(stg + wave * 2048);
#pragma unroll
        for (int ai = 0; ai < 2; ++ai)
#pragma unroll
            for (int bj = 0; bj < 2; ++bj) {
                const int gcol = u.pn * BM + bj * HALF + wc * 32 + 8 * fq;
                f32x4 g0[4], g1[4];
#pragma unroll
                for (int m = 0; m < 4; ++m) {
                    const f32x4 a = acc[ai][bj][m][0], b = acc[ai][bj][m][1];
                    g0[m] = (f32x4){gelu_tanh(a[0]), gelu_tanh(a[1]), gelu_tanh(a[2]), gelu_tanh(a[3])};
                    g1[m] = (f32x4){gelu_tanh(b[0]), gelu_tanh(b[1]), gelu_tanh(b[2]), gelu_tanh(b[3])};
                }
                if (gcol < CW) {
#pragma unroll
                    for (int m = 0; m < 4; ++m) {
                        u32x4 w; w.x = pack2(g0[m][0], g0[m][1]); w.y = pack2(g0[m][2], g0[m][3]); w.z = pack2(g1[m][0], g1[m][1]); w.w = pack2(g1[m][2], g1[m][3]);
                        *(u32x4*)(zu + (size_t)(u.pm * BM + ai * HALF + wr * 64 + m * 16 + fr) * CW + gcol) = w;
                    }
                } else {
                    const int vcol = gcol - CW;
#pragma unroll
                    for (int m = 0; m < 4; ++m) {
                        float t = g0[m][0] * g0[m][0] + g0[m][1] * g0[m][1] + g0[m][2] * g0[m][2] + g0[m][3] * g0[m][3]
                                + g1[m][0] * g1[m][0] + g1[m][1] * g1[m][1] + g1[m][2] * g1[m][2] + g1[m][3] * g1[m][3];
                        t += __shfl_xor(t, 16); t += __shfl_xor(t, 32);
                        if (fq == 0) ssq[(size_t)(u.pm * BM + ai * HALF + wr * 64 + m * 16 + fr) * 64 + (vcol >> 5)] = t;
                    }
#pragma unroll
                    for (int h = 0; h < 2; ++h) {
#pragma unroll
                        for (int mm = 0; mm < 2; ++mm) {
                            const int m = 2 * h + mm, rl = 16 * mm + fr;
#pragma unroll
                            for (int j = 0; j < 4; ++j) { tl[(8 * fq + j) * 32 + rl] = f2bf(g0[m][j]); tl[(8 * fq + 4 + j) * 32 + rl] = f2bf(g1[m][j]); }
                        }
                        const int c = lane >> 1, hh = lane & 1;
                        const u32x4 w0 = *(const PG8_LAS u32x4*)(tl + c * 32 + hh * 16), w1 = *(const PG8_LAS u32x4*)(tl + c * 32 + hh * 16 + 8);
                        bf16_t* dst = zvt + ((size_t)(2 * u.pm + ai) * CW + (u.pn * BM - CW) + bj * HALF + wc * 32 + c) * 128 + wr * 64 + 32 * h + hh * 16;
                        *(u32x4*)dst = w0; *(u32x4*)(dst + 8) = w1;
                        asm volatile("" ::: "memory");
                    }
                }
            }
    }
};
struct EpiQ {
    static constexpr bool PERM = true, AFTER_DRAIN = false;
    bf16_t* q;
    __device__ __forceinline__ void operator()(const f32x4 (&acc)[2][2][4][2], const Unit& u, int wr, int wc, int fr, int fq) const {
#pragma unroll
        for (int ai = 0; ai < 2; ++ai)
#pragma unroll
            for (int m = 0; m < 4; ++m)
#pragma unroll
                for (int bj = 0; bj < 2; ++bj) {
                    const f32x4 a = acc[ai][bj][m][0], b = acc[ai][bj][m][1];
                    u32x4 w; w.x = pack2(a[0], a[1]); w.y = pack2(a[2], a[3]); w.z = pack2(b[0], b[1]); w.w = pack2(b[2], b[3]);
                    *(u32x4*)(q + (size_t)(u.pm * BM + ai * HALF + wr * 64 + m * 16 + fr) * 2048 + u.pn * BM + bj * HALF + wc * 32 + 8 * fq) = w;
                }
    }
};
}
DI void run_gemmq_pg8(const Params& p, int l, unsigned char* smem) {
    volatile LAS unsigned* st = (volatile LAS unsigned*)(smem + SMEM_BYTES);
    pg8::XcdOrder S; S.init(NTOK / 256, 2048 / 256, (int)st[0], (int)st[1], (int)st[2], (int)st[3]);
    const pg8::Gemm g{WSP(bf16_t, WS_XN), WSP(bf16_t, WS_W_PQ) + (size_t)l * 2048 * DM, NTOK, 2048, DM};
    pg8::EpiQ E; E.q = WSP(bf16_t, WS_QBUF);
    __syncthreads();
    pg8::gemm_phase<pg8::EpiQ, pg8::XcdOrder, true, true>((PG8_LAS unsigned char*)smem, g, S, E);
}
template <int WHICH>
DI void run_gemm_pg8(const Params& p, unsigned char* smem) {
    volatile LAS unsigned* st = (volatile LAS unsigned*)(smem + SMEM_BYTES);
    pg8::XcdOrder S; S.init(NTOK / 256, DM / 256, (int)st[0], (int)st[1], (int)st[2], (int)st[3]);
    pg8::Gemm g;
    pg8::EpiResid E;
    if (WHICH == 0) { g = pg8::Gemm{WSP(bf16_t, WS_MIXED), WSP(bf16_t, WS_W_ATTOUT), NTOK, DM, DM}; E.resid = p.in[0]; E.out = p.out; }
    else { g = pg8::Gemm{WSP(bf16_t, WS_Z_U), WSP(bf16_t, WS_W_SGUOUT), NTOK, DM, CW}; E.resid = p.out; E.out = p.out; }
    __syncthreads();
    pg8::gemm_phase<pg8::EpiResid, pg8::XcdOrder, true, true>((PG8_LAS unsigned char*)smem, g, S, E);
}

DI void run_gemm1_pg8(const Params& p, unsigned char* smem) {
    volatile LAS unsigned* st = (volatile LAS unsigned*)(smem + SMEM_BYTES);
    pg8::XcdOrder S; S.init(NTOK / 256, ATT_IN / 256, (int)st[0], (int)st[1], (int)st[2], (int)st[3]);
    const pg8::Gemm g{WSP(bf16_t, WS_XN), WSP(bf16_t, WS_W_ATTIN), NTOK, ATT_IN, DM};
    pg8::EpiProj E; E.aq = p.in[3]; E.ak = p.in[4]; E.bq = p.in[5]; E.bk = p.in[6]; E.proj = WSP(bf16_t, WS_PROJ); E.xs = (PG8_LAS float*)(smem + PG8_EXTRA);
    __syncthreads();
    pg8::gemm_phase<pg8::EpiProj, pg8::XcdOrder, true, true>((PG8_LAS unsigned char*)smem, g, S, E);
}
DI void run_gemm4_pg8(const Params& p, unsigned char* smem) {
    volatile LAS unsigned* st = (volatile LAS unsigned*)(smem + SMEM_BYTES);
    pg8::XcdOrder S; S.init(NTOK / 256, 4096 / 256, (int)st[0], (int)st[1], (int)st[2], (int)st[3]);
    const pg8::Gemm g{WSP(bf16_t, WS_XN), WSP(bf16_t, WS_W_SGUIN), NTOK, 4096, DM};
    pg8::EpiSgu E; E.zu = WSP(bf16_t, WS_Z_U); E.zvt = WSP(bf16_t, WS_Z_VT); E.ssq = WSP(float, WS_SSQ); E.stg = (PG8_LAS unsigned char*)(smem + PG8_EXTRA);
    __syncthreads();
    pg8::gemm_phase<pg8::EpiSgu, pg8::XcdOrder, true, true>((PG8_LAS unsigned char*)smem, g, S, E);
}

DI u32 cand_key(float s, int ci) { return (f2ord(s) & ~255u) | (u32)(255 - ci); }
template <int P>
DI void score_half(const bf16_t* __restrict__ qrow, const bf16_t* __restrict__ skh, int fr, int fh, u32 (&lst)[16]) {
    bf16x8 qf[8];
#pragma unroll
    for (int ks = 0; ks < 8; ++ks) qf[ks] = *(const bf16x8*)(qrow + P * 128 + 16 * ks);
#pragma unroll
    for (int j = 0; j < 16; ++j) lst[j] = 0u;
#pragma unroll 1
    for (int kt = 0; kt < 4; ++kt) {
        f32x16 st;
#pragma unroll
        for (int r = 0; r < 16; ++r) st[r] = 0.f;
        const bf16_t* skr = skh + ((size_t)P * 128 + kt * 32 + fr) * 128 + 8 * fh;
#pragma unroll
        for (int ks = 0; ks < 8; ++ks) st = MFMA32(*(const bf16x8*)(skr + 16 * ks), qf[ks], st);
        u32 ks_[16];
#pragma unroll
        for (int r = 0; r < 16; ++r) ks_[r] = (f2ord(st[r]) & ~127u) | (u32)(127 - (kt * 32 + crow(r, fh)));
        sort16_desc(ks_);
        merge16_desc(lst, ks_);
    }
    u32 other[16];
#pragma unroll
    for (int j = 0; j < 16; ++j) other[j] = (u32)__shfl_xor((int)lst[j], 32);
    merge16_desc(lst, other);
}
DI void ph_score(const Params& p, int vb, int l, unsigned char* smem) {
    const int tid = otid(), wave = tid >> 6, lane = tid & 63, fr = lane & 31, fh = lane >> 5;
    const int it = vb * 4 + wave, tile = it >> 3, h = it & 7;
    const int tok = tile * 32 + fr;
    const bf16_t* qrow = WSP(bf16_t, WS_QBUF) + (size_t)tok * 2048 + h * 256 + 8 * fh;
    const bf16_t* skh = WSP(bf16_t, WS_W_SUBK) + ((size_t)l * 16 + h * 2) * 128 * 128;
    u32 L0[16], L1[16];
    score_half<0>(qrow, skh, fr, fh, L0);
    score_half<1>(qrow, skh, fr, fh, L1);
    LAS int* slot = (LAS int*)(smem + wave * (64 * 132)) + lane * 33;
    float s1[16], s2[16];
#pragma unroll
    for (int j = 0; j < 16; ++j) {
        s1[j] = ord2f(L0[j] & ~127u); s2[j] = ord2f(L1[j] & ~127u);
        slot[j] = 127 - (int)(L0[j] & 127u); slot[16 + j] = 127 - (int)(L1[j] & 127u);
    }
    u32 lst[16];
#pragma unroll
    for (int j = 0; j < 16; ++j) lst[j] = cand_key(s1[0] + s2[j], j);
#pragma unroll
    for (int i = 1; i < 5; ++i) {
        u32 row[16];
#pragma unroll
        for (int j = 0; j < 16; ++j) row[j] = ((i + 1) * (j + 1) <= 16) ? cand_key(s1[i] + s2[j], i * 16 + j) : 0u;
        merge16_desc(lst, row);
    }
#pragma unroll
    for (int i = 5; i < 16; ++i)
#pragma unroll
        for (int j = 0; j < 2; ++j)
            if ((i + 1) * (j + 1) <= 16) top16_insert(lst, cand_key(s1[i] + s2[j], i * 16 + j));
    float pv[16]; float sum = 0.f;
    const float mx = ord2f(lst[0] & ~255u);
#pragma unroll
    for (int j = 0; j < 16; ++j) { pv[j] = __expf(ord2f(lst[j] & ~255u) - mx); sum += pv[j]; }
    const float inv = 1.f / sum;
    int ev[16];
#pragma unroll
    for (int j = 0; j < 16; ++j) {
        const int ci = 255 - (int)(lst[j] & 255u);
        ev[j] = slot[ci >> 4] * 128 + slot[16 + (ci & 15)];
    }
    if (fh == 0) {
        int4* ro = (int4*)(WSP(int, WS_RIDX) + (size_t)tok * 128 + h * 16);
        float4* go = (float4*)(WSP(float, WS_RG) + (size_t)tok * 128 + h * 16);
#pragma unroll
        for (int q = 0; q < 4; ++q) {
            ro[q] = make_int4(ev[4 * q], ev[4 * q + 1], ev[4 * q + 2], ev[4 * q + 3]);
            go[q] = make_float4(pv[4 * q] * inv, pv[4 * q + 1] * inv, pv[4 * q + 2] * inv, pv[4 * q + 3] * inv);
        }
    }
}


DI void osm_update(f32x16& s, unsigned vm, float& m, float& lh, float& alpha) {
    float mx = -1e30f;
#pragma unroll
    for (int r = 0; r < 16; ++r) mx = ((vm >> r) & 1u) ? fmaxf(mx, s[r]) : mx;
    mx = fmaxf(mx, __shfl_xor(mx, 32));
    const float mn = fmaxf(m, mx);
    alpha = __expf(m - mn);
    float ls = 0.f;
#pragma unroll
    for (int r = 0; r < 16; ++r) { const float pe = ((vm >> r) & 1u) ? __expf(s[r] - mn) : 0.f; s[r] = pe; ls += pe; }
    lh = lh * alpha + ls; m = mn;
}
DI void osm_update_full(f32x16& s, float& m, float& lh, float& alpha) {
    float mx = s[0];
#pragma unroll
    for (int r = 1; r < 16; ++r) mx = fmaxf(mx, s[r]);
    mx = fmaxf(mx, __shfl_xor(mx, 32));
    const float mn = fmaxf(m, mx);
    alpha = __expf(m - mn);
    float ls = 0.f;
#pragma unroll
    for (int r = 0; r < 16; ++r) { const float pe = __expf(s[r] - mn); s[r] = pe; ls += pe; }
    lh = lh * alpha + ls; m = mn;
}
DI void tr_quad(const unsigned (&a)[4], unsigned hi_off, bf16x8 (&f)[4]) {
    s16x4 l0, h0, l1, h1, l2, h2, l3, h3;
    const unsigned b0 = a[0] + hi_off, b1 = a[1] + hi_off, b2 = a[2] + hi_off, b3 = a[3] + hi_off;
    asm volatile("ds_read_b64_tr_b16 %0, %8\n\tds_read_b64_tr_b16 %1, %9\n\tds_read_b64_tr_b16 %2, %10\n\tds_read_b64_tr_b16 %3, %11\n\t"
                 "ds_read_b64_tr_b16 %4, %12\n\tds_read_b64_tr_b16 %5, %13\n\tds_read_b64_tr_b16 %6, %14\n\tds_read_b64_tr_b16 %7, %15\n\ts_waitcnt lgkmcnt(0)"
                 : "=&v"(l0), "=&v"(h0), "=&v"(l1), "=&v"(h1), "=&v"(l2), "=&v"(h2), "=&v"(l3), "=&v"(h3)
                 : "v"(a[0]), "v"(b0), "v"(a[1]), "v"(b1), "v"(a[2]), "v"(b2), "v"(a[3]), "v"(b3) : "memory");
    f[0] = __builtin_shufflevector(l0, h0, 0, 1, 2, 3, 4, 5, 6, 7); f[1] = __builtin_shufflevector(l1, h1, 0, 1, 2, 3, 4, 5, 6, 7);
    f[2] = __builtin_shufflevector(l2, h2, 0, 1, 2, 3, 4, 5, 6, 7); f[3] = __builtin_shufflevector(l3, h3, 0, 1, 2, 3, 4, 5, 6, 7);
}

#define QB_BYTES (128 * 256)
#define KB_BYTES (32 * 256)
template <bool WITH_V>
DI void attnB_stage_kv(const bf16_t* __restrict__ kg  , unsigned char* Kd, unsigned char* Vd, int wave, int lane) {
#pragma unroll
    for (int i = 0; i < 2; ++i) {
        const int idx = wave * 2 + i;
        const int key = 4 * idx + (lane >> 4), cp = lane & 15;
        const bf16_t* g = kg + (size_t)key * ATT_IN;
        __builtin_amdgcn_global_load_lds((const unsigned*)(g + ((cp ^ (key & 15)) << 3)), (unsigned*)(Kd + idx * 1024 + lane * 16), 16, 0, 0);
        if (WITH_V) {
            const int cv = ((((cp >> 2) ^ (key & 3)) << 2) | (cp & 3));
            __builtin_amdgcn_global_load_lds((const unsigned*)(g + 512 + (cv << 3)), (unsigned*)(Vd + idx * 1024 + lane * 16), 16, 0, 0);
        }
    }
}
template <int KOFF, bool FULL>
DI void attnB_map(const unsigned char* Kc, const unsigned char* qlp, int ksw, int qsw, int fh, unsigned vm, unsigned vc, int tq,
                  float& m, float& l, f32x16 (&o)[4]) {
    f32x16 st;
#pragma unroll
    for (int r = 0; r < 16; ++r) st[r] = 0.f;
#pragma unroll
    for (int s = 0; s < 4; ++s) {
        const bf16x8 kf = *(const bf16x8*)(Kc + (((KOFF + 2 * s + fh) ^ ksw) << 4));
        const bf16x8 qf = *(const bf16x8*)(qlp + (((KOFF + 2 * s + fh) ^ qsw) << 4));
        st = MFMA32(kf, qf, st);
    }
    float al;
    if (FULL) osm_update_full(st, m, l, al); else osm_update(st, vm, m, l, al);
#pragma unroll
    for (int d = 0; d < 4; ++d)
#pragma unroll
        for (int r = 0; r < 16; ++r) o[d][r] *= al;
#pragma unroll
    for (int s = 0; s < 2; ++s) {
        const bf16x8 pf = pack_p(st, s);
        unsigned va[4]; bf16x8 vf[4];
#pragma unroll
        for (int d = 0; d < 4; ++d) va[d] = vc + s * 16 * 256 + ((d ^ tq) << 6);
        tr_quad(va, 8 * 256, vf);
#pragma unroll
        for (int d = 0; d < 4; ++d) o[d] = MFMA32(vf[d], pf, o[d]);
    }
}
DI void ph_attnB_fast(const Params& p, int item, unsigned char* smem) {
    const bf16_t* proj = WSP(bf16_t, WS_PROJ);
    const int tid = otid(), wave = tid >> 6, lane = tid & 63, fr = lane & 31, fh = lane >> 5;
    const int qt = 15 - (item >> 6), bh = item & 63, b = bh >> 2, h = bh & 3;
    const int q0 = qt * 128;
    const float lam = compute_lam(p, lane);
    const size_t rowbase = (size_t)b * SEQ;
    const int qrow = wave * 32 + fr, qpos = q0 + qrow;
    unsigned char* Ql = smem;
    unsigned char* Kl = smem + QB_BYTES;
    unsigned char* Vl = Kl + 2 * KB_BYTES;
    const bf16_t* kbase = proj + rowbase * ATT_IN + 2048 + h * 128;
    __syncthreads();
#pragma unroll
    for (int i = 0; i < 8; ++i) {
        const int idx = wave * 8 + i;
        const int row = 4 * idx + (lane >> 4), cp = lane & 15;
        __builtin_amdgcn_global_load_lds((const unsigned*)(proj + (rowbase + q0 + row) * ATT_IN + 1536 + h * 128 + ((cp ^ (row & 15)) << 3)),
                                         (unsigned*)(Ql + idx * 1024 + lane * 16), 16, 0, 0);
    }
    attnB_stage_kv<true>(kbase, Kl, Vl, wave, lane);
    const unsigned char* qlp = Ql + qrow * 256;
    const int qsw = qrow & 15, ksw = fr & 15;
    const int nkt = (q0 + 128) / 32;
    const int wlast = q0 + wave * 32 + 31;
    f32x16 o1[4], o2[4];
#pragma unroll
    for (int d = 0; d < 4; ++d)
#pragma unroll
        for (int r = 0; r < 16; ++r) { o1[d][r] = 0.f; o2[d][r] = 0.f; }
    float m1 = -1e30f, m2 = -1e30f, l1 = 0.f, l2 = 0.f;
    const int tq = (lane & 15) >> 2;
    const unsigned vrow = (unsigned)(uintptr_t)Vl + (4 * fh + tq) * 256 + (16 * ((lane >> 4) & 1) + 4 * (lane & 3)) * 2;
    asm volatile("s_waitcnt vmcnt(0)" ::: "memory");
    __syncthreads();
    for (int kt = 0; kt < nkt; ++kt) {
        const int cur = kt & 1;
        if (kt + 1 < nkt) attnB_stage_kv<true>(kbase + (size_t)(kt + 1) * 32 * ATT_IN, Kl + (cur ^ 1) * KB_BYTES, Vl + (cur ^ 1) * KB_BYTES, wave, lane);
        if (kt * 32 <= wlast) {
            const unsigned char* Kc = Kl + cur * KB_BYTES + fr * 256;
            const unsigned vc = vrow + cur * KB_BYTES;
            if (kt * 32 + 31 <= wlast - 31) {
                attnB_map<0, true>(Kc, qlp, ksw, qsw, fh, 0xffffu, vc, tq, m1, l1, o1);
                __builtin_amdgcn_sched_barrier(0);
                attnB_map<8, true>(Kc, qlp, ksw, qsw, fh, 0xffffu, vc, tq, m2, l2, o2);
            } else {
                unsigned vm = 0;
#pragma unroll
                for (int r = 0; r < 16; ++r) vm |= ((kt * 32 + crow(r, fh)) <= qpos) ? (1u << r) : 0u;
                attnB_map<0, false>(Kc, qlp, ksw, qsw, fh, vm, vc, tq, m1, l1, o1);
                __builtin_amdgcn_sched_barrier(0);
                attnB_map<8, false>(Kc, qlp, ksw, qsw, fh, vm, vc, tq, m2, l2, o2);
            }
        }
        asm volatile("s_waitcnt vmcnt(0)" ::: "memory");
        __syncthreads();
    }
    l1 += __shfl_xor(l1, 32); l2 += __shfl_xor(l2, 32);
    const float i1 = 1.f / l1, i2 = lam / l2;
    float ss = 0.f;
#pragma unroll
    for (int d = 0; d < 4; ++d)
#pragma unroll
        for (int r = 0; r < 16; ++r) { const float v = o1[d][r] * i1 - o2[d][r] * i2; o1[d][r] = v; ss += v * v; }
    ss += __shfl_xor(ss, 32);
    const float rinv = rsqrtf(ss * (1.f / 128.f) + EPSN) * 0.8f;
    const float* subg = p.in[11];
    bf16_t* op = WSP(bf16_t, WS_MIXED) + (rowbase + qpos) * DM + 512 + h * 128;
#pragma unroll
    for (int d = 0; d < 4; ++d)
#pragma unroll
        for (int g = 0; g < 4; ++g) {
            const int dim = 32 * d + 8 * g + 4 * fh;
            const float4 gg = *(const float4*)(subg + dim);
            uint2 w;
            w.x = pack2(o1[d][4 * g + 0] * rinv * gg.x, o1[d][4 * g + 1] * rinv * gg.y);
            w.y = pack2(o1[d][4 * g + 2] * rinv * gg.z, o1[d][4 * g + 3] * rinv * gg.w);
            *(uint2*)(op + dim) = w;
        }
}

#define KA_PITCH 128
#define VA_PITCH 192
#define WA_BYTES (32 * KA_PITCH + 32 * VA_PITCH)
template <int MODE>
DI void ph_attnA_fast(const Params& p, int item, unsigned char* smem) {
    const bf16_t* proj = WSP(bf16_t, WS_PROJ);
    const int tid = otid(), wave = tid >> 6, lane = tid & 63, fr = lane & 31, fh = lane >> 5;
    const int c = item & 15, h = (item >> 4) & 7, b = item >> 7;
    const size_t rowbase = (size_t)b * SEQ;
    const int qpos = MODE == 0 ? 128 * c + 32 * wave + fr : 16 * (32 * wave + fr) + c;
    const int pmin = MODE == 0 ? 128 * c + 32 * wave : 512 * wave + c, pmax = pmin + (MODE == 0 ? 31 : 496);
    bf16x8 qf[4];
    {
        const bf16_t* qp = proj + (rowbase + qpos) * ATT_IN + h * 64 + 8 * fh;
#pragma unroll
        for (int s = 0; s < 4; ++s) qf[s] = *(const bf16x8*)(qp + 16 * s);
    }
    f32x16 o[2];
#pragma unroll
    for (int d = 0; d < 2; ++d)
#pragma unroll
        for (int r = 0; r < 16; ++r) o[d][r] = 0.f;
    float m = -1e30f, l = 0.f;
    unsigned char* Kl = smem + wave * WA_BYTES;
    unsigned char* Vl = Kl + 32 * KA_PITCH;
    const unsigned vaddr = (unsigned)(uintptr_t)Vl + (4 * fh + ((lane & 15) >> 2)) * VA_PITCH + (16 * ((lane >> 4) & 1) + 4 * (lane & 3)) * 2;
    const int skey = lane >> 3, sc = lane & 7;
    __syncthreads();
    int br = 0, d = MODE == 0 ? 1 : 16, W = MODE == 0 ? 128 : 2048, cls = MODE == 0 ? 0 : (c & 15);
    int j0 = MODE == 0 ? (pmin < 128 ? 0 : pmin - 128) : 0, jhi = MODE == 0 ? pmax : ((pmax - cls) >> 4);
    const bf16_t* kvbase = proj + rowbase * ATT_IN + 512 + h * 64 + sc * 8;
    uint4 rk0, rk1, rk2, rk3, rv0, rv1, rv2, rv3;
#define A_LOAD(i, RK, RV) do { int kp_ = cls + d * (j0 + skey + 8 * (i)); kp_ = kp_ > SEQ - 1 ? SEQ - 1 : kp_; kp_ = kp_ < 0 ? 0 : kp_; \
        const bf16_t* g_ = kvbase + (size_t)kp_ * ATT_IN; RK = *(const uint4*)g_; RV = *(const uint4*)(g_ + 512); } while (0)
#define A_WRITE(i, RK, RV) do { const int key_ = skey + 8 * (i); *(uint4*)(Kl + key_ * KA_PITCH + ((sc ^ ((key_ >> 1) & 7)) << 4)) = RK; \
        *(uint4*)(Vl + key_ * VA_PITCH + sc * 16) = RV; } while (0)
    A_LOAD(0, rk0, rv0); A_LOAD(1, rk1, rv1); A_LOAD(2, rk2, rv2); A_LOAD(3, rk3, rv3);
#pragma unroll 1
    for (;;) {
        A_WRITE(0, rk0, rv0); A_WRITE(1, rk1, rv1); A_WRITE(2, rk2, rv2); A_WRITE(3, rk3, rv3);
        const int cd = d, cW = W, ccls = cls, cj0 = j0;
        bool more = true;
        j0 += 32;
        if (j0 > jhi) {
            ++br;
            if (MODE == 0 || br == 2) more = false;
            else {
                d = 4; W = 512; cls = c & 3;
                const int lo = pmin - cls - W;
                j0 = lo < 0 ? 0 : lo >> 2;
                jhi = (pmax - cls) >> 2;
            }
        }
        A_LOAD(0, rk0, rv0); A_LOAD(1, rk1, rv1); A_LOAD(2, rk2, rv2); A_LOAD(3, rk3, rv3);
        f32x16 st;
#pragma unroll
        for (int r = 0; r < 16; ++r) st[r] = 0.f;
#pragma unroll
        for (int s = 0; s < 4; ++s) {
            const bf16x8 kf = *(const bf16x8*)(Kl + fr * KA_PITCH + (((2 * s + fh) ^ ((fr >> 1) & 7)) << 4));
            st = MFMA32(kf, qf[s], st);
        }
        float al;
        const int kfirst = ccls + cd * cj0, klast = kfirst + cd * 31;
        if (klast <= pmin && pmax - kfirst <= cW) osm_update_full(st, m, l, al);
        else {
            unsigned vm = 0;
#pragma unroll
            for (int r = 0; r < 16; ++r) {
                const int dist = qpos - (ccls + cd * (cj0 + crow(r, fh)));
                vm |= (dist >= 0 && dist <= cW) ? (1u << r) : 0u;
            }
            osm_update(st, vm, m, l, al);
        }
#pragma unroll
        for (int dd = 0; dd < 2; ++dd)
#pragma unroll
            for (int r = 0; r < 16; ++r) o[dd][r] *= al;
        {
            unsigned va[4]; bf16x8 vf[4];
            va[0] = vaddr; va[1] = vaddr + 64; va[2] = vaddr + 16 * VA_PITCH; va[3] = vaddr + 16 * VA_PITCH + 64;
            tr_quad(va, 8 * VA_PITCH, vf);
            const bf16x8 p0 = pack_p(st, 0), p1 = pack_p(st, 1);
            o[0] = MFMA32(vf[0], p0, o[0]); o[1] = MFMA32(vf[1], p0, o[1]);
            o[0] = MFMA32(vf[2], p1, o[0]); o[1] = MFMA32(vf[3], p1, o[1]);
        }
        if (!more) break;
    }
    l += __shfl_xor(l, 32);
    bf16_t* op = WSP(bf16_t, WS_MIXED) + (rowbase + qpos) * DM + h * 64;
    float* lsep = WSP(float, WS_LSE1) + (rowbase + qpos) * 8 + h;
    if (MODE == 0) {
        const float il = 1.f / l;
        if (fh == 0) *lsep = m + __logf(l);
#pragma unroll
        for (int dd = 0; dd < 2; ++dd)
#pragma unroll
            for (int g = 0; g < 4; ++g) {
                const int dim = 32 * dd + 8 * g + 4 * fh;
                uint2 w;
                w.x = pack2(o[dd][4 * g + 0] * il, o[dd][4 * g + 1] * il);
                w.y = pack2(o[dd][4 * g + 2] * il, o[dd][4 * g + 3] * il);
                *(uint2*)(op + dim) = w;
            }
    } else {
        const float lse1 = *lsep;
        const float M = fmaxf(m, lse1);
        const float w23 = __expf(m - M), w1 = __expf(lse1 - M);
        const float iden = 1.f / (l * w23 + w1);
        const float a23 = w23 * iden, a1 = w1 * iden;
        uint2 prev[2][4];
#pragma unroll
        for (int dd = 0; dd < 2; ++dd)
#pragma unroll
            for (int g = 0; g < 4; ++g) prev[dd][g] = *(const uint2*)(op + 32 * dd + 8 * g + 4 * fh);
#pragma unroll
        for (int dd = 0; dd < 2; ++dd)
#pragma unroll
            for (int g = 0; g < 4; ++g) {
                const int dim = 32 * dd + 8 * g + 4 * fh;
                const float p0 = __uint_as_float(prev[dd][g].x << 16), p1 = __uint_as_float(prev[dd][g].x & 0xffff0000u);
                const float p2 = __uint_as_float(prev[dd][g].y << 16), p3 = __uint_as_float(prev[dd][g].y & 0xffff0000u);
                uint2 w;
                w.x = pack2(o[dd][4 * g + 0] * a23 + p0 * a1, o[dd][4 * g + 1] * a23 + p1 * a1);
                w.y = pack2(o[dd][4 * g + 2] * a23 + p2 * a1, o[dd][4 * g + 3] * a23 + p3 * a1);
                *(uint2*)(op + dim) = w;
            }
    }
}
#define NITEM_B 1024
#define NITEM_A 2048
DI void ph_attn_fast(const Params& p, int vb, unsigned char* smem) {
    if (vb < NITEM_B) {
        const int item = vb < 512 ? vb : 512 + (1023 - vb);
        ph_attnB_fast(p, item, smem);
    } else ph_attnA_fast<0>(p, vb - NITEM_B, smem);
}


DI void ph_spatial_fast(const Params& p, int item, unsigned char* smem) {
    const int tid = otid(), wave = tid >> 6, lane = tid & 63, fr = lane & 31, fh = lane >> 5;
    const int wm = wave >> 1, wn = wave & 1;
    const int chunk = item >> 3, g = item & 7;
    bf16_t* u = WSP(bf16_t, WS_Z_U);
    const bf16_t* vt = WSP(bf16_t, WS_Z_VT);
    const float* ssq = WSP(float, WS_SSQ);
    const float* wsp = p.in[16] + (size_t)g * 128 * 128;
    float* rinv = (float*)(smem + 66 * 1024);
    unsigned char* Bt = smem + 32768;
    __syncthreads();
    if (tid < 128) {
        const float4* sp = (const float4*)(ssq + (size_t)(chunk * 128 + tid) * 64);
        float sacc = 0.f;
#pragma unroll
        for (int j = 0; j < 16; ++j) { const float4 q = sp[j]; sacc += (q.x + q.y) + (q.z + q.w); }
        rinv[tid] = rsqrtf(sacc * (1.f / CW) + EPSN);
    }
    const size_t vrow0 = (size_t)chunk * CW + g * 256;
    stage_tile(vt, 128, (int)vrow0, 0, Bt, wave, lane);
    stage_tile(vt, 128, (int)vrow0, 64, Bt + 16384, wave, lane);
    __syncthreads();
#pragma unroll
    for (int i = 0; i < 8; ++i) {
        const int id = tid + 256 * i;
        const int t = id >> 4, sc = id & 15;
        const float4 w0 = *(const float4*)(wsp + t * 128 + sc * 8);
        const float4 w1 = *(const float4*)(wsp + t * 128 + sc * 8 + 4);
        const float4 r0 = *(const float4*)(rinv + sc * 8);
        const float4 r1 = *(const float4*)(rinv + sc * 8 + 4);
        const int s0 = sc * 8;
        uint4 o;
        o.x = pack2(s0 + 0 <= t ? w0.x * r0.x : 0.f, s0 + 1 <= t ? w0.y * r0.y : 0.f);
        o.y = pack2(s0 + 2 <= t ? w0.z * r0.z : 0.f, s0 + 3 <= t ? w0.w * r0.w : 0.f);
        o.z = pack2(s0 + 4 <= t ? w1.x * r1.x : 0.f, s0 + 5 <= t ? w1.y * r1.y : 0.f);
        o.w = pack2(s0 + 6 <= t ? w1.z * r1.z : 0.f, s0 + 7 <= t ? w1.w * r1.w : 0.f);
        const int kt = sc >> 3, c = sc & 7;
        *(uint4*)(smem + kt * 16384 + t * 128 + ((c ^ ((t >> 1) & 7)) << 4)) = o;
    }
#pragma unroll 1
    for (int nt = 0; nt < 2; ++nt) {
        asm volatile("s_waitcnt vmcnt(0)" ::: "memory");
        __syncthreads();
        f32x16 acc[2][2];
#pragma unroll
        for (int i = 0; i < 2; ++i)
#pragma unroll
            for (int j = 0; j < 2; ++j)
#pragma unroll
                for (int r = 0; r < 16; ++r) acc[i][j][r] = 0.f;
#pragma unroll
        for (int kt = 0; kt < 2; ++kt)
#pragma unroll
            for (int s = 0; s < 4; ++s) {
                bf16x8 a[2], b[2];
#pragma unroll
                for (int i = 0; i < 2; ++i) {
                    a[i] = lds_frag(smem + kt * 16384, wm * 64 + i * 32 + fr, 2 * s + fh);
                    b[i] = lds_frag(Bt + kt * 16384, wn * 64 + i * 32 + fr, 2 * s + fh);
                }
#pragma unroll
                for (int i = 0; i < 2; ++i)
#pragma unroll
                    for (int j = 0; j < 2; ++j) acc[i][j] = MFMA32(a[i], b[j], acc[i][j]);
            }
        __syncthreads();
        float* st = (float*)(Bt + wave * (32 * 65 * 4));
#pragma unroll
        for (int i = 0; i < 2; ++i) {
#pragma unroll
            for (int j = 0; j < 2; ++j)
#pragma unroll
                for (int r = 0; r < 16; ++r) st[crow(r, fh) * 65 + j * 32 + fr] = acc[i][j][r];
            const int t = wm * 64 + i * 32 + fr;
            const int c0 = g * 256 + nt * 128 + wn * 64 + fh * 32;
            bf16_t* up = u + (size_t)(chunk * 128 + t) * CW + c0;
            const float bias = p.in[17][g * 128 + t];
            const float* gn = p.in[15] + c0;
            uint4 ur[4];
#pragma unroll
            for (int q = 0; q < 4; ++q) ur[q] = ((const uint4*)up)[q];
#pragma unroll
            for (int q = 0; q < 4; ++q) {
                float uf[8]; unpack8(ur[q], uf);
                const float4 g0 = *(const float4*)(gn + 8 * q), g1 = *(const float4*)(gn + 8 * q + 4);
                const float gg[8] = {g0.x, g0.y, g0.z, g0.w, g1.x, g1.y, g1.z, g1.w};
                float ov[8];
#pragma unroll
                for (int e = 0; e < 8; ++e) ov[e] = uf[e] * (st[fr * 65 + fh * 32 + 8 * q + e] * gg[e] + bias);
                uint4 o; o.x = pack2(ov[0], ov[1]); o.y = pack2(ov[2], ov[3]); o.z = pack2(ov[4], ov[5]); o.w = pack2(ov[6], ov[7]);
                ((uint4*)up)[q] = o;
            }
        }
        if (nt == 0) {
            __syncthreads();
            stage_tile(vt, 128, (int)vrow0 + 128, 0, Bt, wave, lane);
            stage_tile(vt, 128, (int)vrow0 + 128, 64, Bt + 16384, wave, lane);
        }
    }
}

#define XB_TMO      128
#define XB_XCNT(j)  (256  + 64 * (j))
#define XB_XSUB(j)  (1280 + 64 * (j))
#define XB_XGEN(j)  (2304 + 64 * (j))
#define XB_TOP      3328
#define XB_TOPGEN   3392
#define XCD_BAR_WORDS 3456
#define XB_SPIN_CAP (1u << 22)
DI unsigned xb_ld(unsigned* p) { return __hip_atomic_load(p, __ATOMIC_RELAXED, __HIP_MEMORY_SCOPE_AGENT); }
DI unsigned xb_add(unsigned* p, unsigned v) { return __hip_atomic_fetch_add(p, v, __ATOMIC_RELAXED, __HIP_MEMORY_SCOPE_AGENT); }
DI unsigned xb_xcc_id() { return (unsigned)__builtin_amdgcn_s_getreg((3 << 11) | 20) & 0xFu; }
#define XB_SPIN(cond, bar) do { unsigned _sp = 0; while (cond) { __builtin_amdgcn_s_sleep(1); \
    if ((++_sp & 255u) == 0u) { if (xb_ld(&(bar)[XB_TMO])) break; if (_sp > XB_SPIN_CAP) { atomicAdd(&(bar)[XB_TMO], 1u); break; } } } } while (0)
struct XcdBarrier { unsigned* bar; unsigned x; volatile LAS unsigned* st; };
DI XcdBarrier xcd_barrier_post(unsigned* bar, volatile LAS unsigned* st) {
    XcdBarrier b; b.bar = bar; b.x = xb_xcc_id(); b.st = st;
    if (threadIdx.x == 0) st[2] = xb_add(&bar[XB_XCNT(b.x)], 1u);
    return b;
}
DI void xcd_barrier_complete(unsigned* bar, unsigned x, unsigned& nloc, unsigned& nx, unsigned& xi) {
    const unsigned G = gridDim.x * gridDim.y * gridDim.z;
    unsigned sum, cnt, mine, below, sp = 0u;
    for (;;) {
        sum = 0u; cnt = 0u; mine = 0u; below = 0u;
#pragma unroll
        for (unsigned j = 0; j < 16; ++j) { const unsigned c = xb_ld(&bar[XB_XCNT(j)]); sum += c; cnt += (c > 0u) ? 1u : 0u; mine = (j == x) ? c : mine; below += (c > 0u && j < x) ? 1u : 0u; }
        if (sum == G) break;
        __builtin_amdgcn_s_sleep(1);
        if ((++sp & 255u) == 0u) { if (xb_ld(&bar[XB_TMO])) break; if (sp > XB_SPIN_CAP) { atomicAdd(&bar[XB_TMO], 1u); break; } }
    }
    nloc = mine > 0u ? mine : 1u; nx = cnt > 0u ? cnt : 1u; xi = below;
}
DI void xcd_barrier(const XcdBarrier& b) {
    asm volatile("s_waitcnt vmcnt(0)" ::: "memory");
    __syncthreads();
    if (threadIdx.x == 0) {
        unsigned* bar = b.bar;
        __builtin_amdgcn_s_waitcnt(0);
        unsigned nloc = b.st[0], nx = b.st[1];
        if (nloc == 0u) { unsigned xi; xcd_barrier_complete(bar, b.x, nloc, nx, xi); b.st[0] = nloc; b.st[1] = nx; b.st[3] = xi; }
        const unsigned old = xb_add(&bar[XB_XSUB(b.x)], 1u);
        const unsigned gen = old / nloc;
        if (old + 1u == (gen + 1u) * nloc) {
            __builtin_amdgcn_fence(__ATOMIC_RELEASE, "agent");
            asm volatile("s_waitcnt vmcnt(0)" ::: "memory");
            const unsigned og = xb_add(&bar[XB_TOP], 1u);
            const unsigned tg = og / nx;
            if (og + 1u == (tg + 1u) * nx) xb_add(&bar[XB_TOPGEN], 1u);
            else XB_SPIN(xb_ld(&bar[XB_TOPGEN]) == tg, bar);
            __builtin_amdgcn_fence(__ATOMIC_ACQUIRE, "agent");
            xb_add(&bar[XB_XGEN(b.x)], 1u);
            asm volatile("s_waitcnt vmcnt(0)" ::: "memory");
        } else {
            XB_SPIN(xb_ld(&bar[XB_XGEN(b.x)]) == gen, bar);
            __builtin_amdgcn_fence(__ATOMIC_ACQUIRE, "agent");
            asm volatile("s_waitcnt vmcnt(0)" ::: "memory");
        }
    }
    __syncthreads();
}

enum { PH_PREP = 0, PH_GEMM1, PH_ATTN, PH_ATTN2, PH_GEMM2,
       PH_NORM_P0, PH_GEMMQ0, PH_SCORE0, PH_PDOWN0, PH_PCOMB0, PH_PUP0, PH_NORM_SGU,
       PH_GEMM4, PH_SPATIAL, PH_GEMM5,
       PH_NORM_P1, PH_GEMMQ1, PH_SCORE1, PH_PDOWN1, PH_PCOMB1, PH_PUP1, PH_COUNT };

__host__ __device__ constexpr int phase_nvb(int ph) {
    switch (ph) {
        case PH_PREP: return PREP_N;
        case PH_GEMM1: return (ATT_IN / 256) * (NTOK / 256);
        case PH_ATTN: return NITEM_B + NITEM_A;
        case PH_ATTN2: return NITEM_A;
        case PH_GEMM2: return (DM / 256) * (NTOK / 256);
        case PH_NORM_P0: case PH_NORM_P1: case PH_NORM_SGU: return NTOK / 4;
        case PH_GEMMQ0: case PH_GEMMQ1: return 16 * (NTOK / 256);
        case PH_SCORE0: case PH_SCORE1: return (NTOK / 32) * 8 / 4;
        case PH_PCOMB0: case PH_PCOMB1: return NTOK / 4;
        case PH_GEMM4: return (4096 / 256) * (NTOK / 256);
        case PH_SPATIAL: return 256 * 8;
        case PH_GEMM5: return (DM / 256) * (NTOK / 256);
    }
    return 0;
}

template <int PH>
DI void run_vb(const Params& p, int vb, unsigned char* smem) {
    if constexpr (PH == PH_PREP) ph_prep(p, vb, smem);
    else if constexpr (PH == PH_ATTN) ph_attn_fast(p, vb, smem);
    else if constexpr (PH == PH_ATTN2) ph_attnA_fast<1>(p, vb, smem);
    else if constexpr (PH == PH_NORM_P0 || PH == PH_NORM_P1) rmsnorm_rows<true>(p.out, p.in[19] + (PH == PH_NORM_P1 ? DM : 0), WSP(bf16_t, WS_XN), vb, WSP(signed char, WS_XQ), WSP(float, WS_XSC));
    else if constexpr (PH == PH_SCORE0 || PH == PH_SCORE1) ph_score(p, vb, PH == PH_SCORE1 ? 1 : 0, smem);
    else if constexpr (PH == PH_PCOMB0 || PH == PH_PCOMB1) ph_peer_comb(p, vb, PH == PH_PCOMB1 ? 1 : 0);
    else if constexpr (PH == PH_NORM_SGU) rmsnorm_rows<false>(p.out, p.in[13], WSP(bf16_t, WS_XN), vb);
    else if constexpr (PH == PH_SPATIAL) ph_spatial_fast(p, vb, smem);
}

template <int PH>
DI void run_phase(const Params& p, unsigned char* smem) {
    if constexpr (PH == PH_PDOWN0 || PH == PH_PDOWN1) run_peer_sliced<false>(p, PH == PH_PDOWN1 ? 1 : 0, smem);
    else if constexpr (PH == PH_PUP0 || PH == PH_PUP1) run_peer_sliced<true>(p, PH == PH_PUP1 ? 1 : 0, smem);
    else if constexpr (PH == PH_GEMMQ0 || PH == PH_GEMMQ1) run_gemmq_pg8(p, PH == PH_GEMMQ1 ? 1 : 0, smem);
    else if constexpr (PH == PH_GEMM1) run_gemm1_pg8(p, smem);
    else if constexpr (PH == PH_GEMM4) run_gemm4_pg8(p, smem);
    else if constexpr (PH == PH_GEMM2) run_gemm_pg8<0>(p, smem);
    else if constexpr (PH == PH_GEMM5) run_gemm_pg8<1>(p, smem);
    else {
        constexpr int nvb = phase_nvb(PH);
        const int g = threadIdx.x >> 8;
        for (int vb = 2 * blockIdx.x; vb < nvb; vb += 2 * gridDim.x)
            if (vb + g < nvb) run_vb<PH>(p, vb + g, smem + g * GROUP_SMEM);
    }
}

template <int PH>
DI void run_from(const Params& p, unsigned char* smem, cg::grid_group& grid, const XcdBarrier& xb) {
    run_phase<PH>(p, smem);
    if constexpr (PH + 1 < PH_COUNT) {
        if constexpr (PH == 1) grid.sync(); else xcd_barrier(xb);
        run_from<PH + 1>(p, smem, grid, xb);
    }
}

__global__ void __launch_bounds__(NTHREADS, 2) k_mega(Params p) {
    extern __shared__ __attribute__((aligned(16))) unsigned char smem[];
    cg::grid_group grid = cg::this_grid();
    volatile LAS unsigned* st = (volatile LAS unsigned*)(smem + SMEM_BYTES);
    if (threadIdx.x == 0) { st[0] = 0u; st[1] = 0u; st[2] = 0u; st[3] = 0u; }
    __syncthreads();
    const XcdBarrier xb = xcd_barrier_post((unsigned*)(p.ws + WS_CTL), st);
    run_from<0>(p, smem, grid, xb);
}


extern "C" void kernel_launch(void* const* d_in, const int* in_sizes, int n_in, void* d_out, int out_size, void* d_ws, size_t ws_size, hipStream_t stream) {
    if (n_in != 24 || ws_size < WS_NEED) { fprintf(stderr, "kernel_launch: unexpected n_in %d or ws_size %zu\n", n_in, ws_size); return; }
    static int grid_blocks = 0;
    if (!grid_blocks) {
        int dev = 0, cus = 0, per_cu = 0;
        (void)hipGetDevice(&dev);
        (void)hipDeviceGetAttribute(&cus, hipDeviceAttributeMultiprocessorCount, dev);
        (void)hipFuncSetAttribute((const void*)k_mega, hipFuncAttributeMaxDynamicSharedMemorySize, SMEM_ALLOC);
        (void)hipOccupancyMaxActiveBlocksPerMultiprocessor(&per_cu, (const void*)k_mega, NTHREADS, SMEM_ALLOC);
        if (per_cu > 1) per_cu = 1;
        if (per_cu < 1) { fprintf(stderr, "kernel_launch: occupancy query returned %d\n", per_cu); per_cu = 1; }
        grid_blocks = cus * per_cu;
    }
    Params p{};
    for (int i = 0; i < 24; ++i) p.in[i] = (const float*)d_in[i];
    p.out = (float*)d_out;
    p.ws = (unsigned char*)d_ws;
    void* args[] = {&p};
    if (hipMemsetAsync((unsigned char*)d_ws + WS_CTL, 0, XCD_BAR_WORDS * 4, stream) != hipSuccess) { fprintf(stderr, "kernel_launch: memset of the barrier words failed\n"); return; }
    hipError_t e = hipLaunchCooperativeKernel((const void*)k_mega, dim3(grid_blocks), dim3(NTHREADS), args, SMEM_ALLOC, stream);
    if (e != hipSuccess) fprintf(stderr, "cooperative launch failed: %s (grid %d)\n", hipGetErrorString(e), grid_blocks);
}
```

```cpp
#include <hip/hip_runtime.h>
#include <stdint.h>
#include <stdio.h>

#define NTOK   32768
#define DM     1024
#define SEQ    2048
#define NB     16
#define ATT_IN 3072
#define CW     2048
#define NEXP   16384
#define EPSN   1e-6f

typedef unsigned short bf16_t;
typedef unsigned int u32;

#define DI __device__ __forceinline__
#define LAS __attribute__((address_space(3)))

DI int otid() { int t = threadIdx.x & 255; asm volatile("" : "+v"(t)); return t; }
DI int otid512() { int t = threadIdx.x; asm volatile("" : "+v"(t)); return t; }
DI float bf2f(bf16_t v) { return __uint_as_float(((u32)v) << 16); }
typedef __bf16 bf16v2 __attribute__((ext_vector_type(2)));
DI bf16_t f2bf(float f) { const __bf16 h = (__bf16)f; return __builtin_bit_cast(bf16_t, h); }
DI u32 pack2(float lo, float hi) { bf16v2 v; v[0] = (__bf16)lo; v[1] = (__bf16)hi; return __builtin_bit_cast(u32, v); }
DI float gelu_tanh(float x) {
    const float y = 0.7978845608028654f * (x + 0.044715f * x * x * x);
    const float e = __expf(2.f * y);
    const float t = 1.f - 2.f / (e + 1.f);
    return 0.5f * x * (1.f + t);
}
DI float wave_sum(float v) {
#pragma unroll
    for (int o = 1; o < 64; o <<= 1) v += __shfl_xor(v, o);
    return v;
}
DI float wave_max(float v) {
#pragma unroll
    for (int o = 1; o < 64; o <<= 1) v = fmaxf(v, __shfl_xor(v, o));
    return v;
}
DI u32 f2ord(float f) { u32 u = __float_as_uint(f); return (u & 0x80000000u) ? ~u : (u | 0x80000000u); }
DI float ord2f(u32 o) { u32 u = (o & 0x80000000u) ? (o & 0x7fffffffu) : ~o; return __uint_as_float(u); }

#define MiB ((size_t)1 << 20)
#define WS_CTL      ((size_t)0)
#define WS_W_ATTIN  (1 * MiB)
#define WS_W_ATTOUT (7 * MiB)
#define WS_W_SGUIN  (9 * MiB)
#define WS_W_SGUOUT (17 * MiB)
#define WS_W_PQ     (21 * MiB)
#define WS_W_SUBK   (29 * MiB)
#define WS_DOWN     (32 * MiB)
#define WS_UP       (64 * MiB)
#define WS_DSC      (96 * MiB)
#define WS_USC      (96 * MiB + 128 * 1024)
#define WS_LSE1     (30 * MiB)
#define WS_XQ       (100 * MiB)
#define WS_XSC      (132 * MiB)
#define WS_XN       (160 * MiB)
#define WS_BIG      (224 * MiB)
#define WS_PROJ     (WS_BIG)
#define WS_MIXED    (WS_BIG + 192 * MiB)
#define WS_Z_U      (WS_BIG)
#define WS_Z_VT     (WS_BIG + 128 * MiB)
#define WS_RIDX     (WS_BIG + 32 * MiB)
#define WS_RG       (WS_BIG + 48 * MiB)
#define WS_QBUF     (WS_BIG + 64 * MiB)
#define WS_SSQ      (WS_BIG + 256 * MiB)
#define WS_NEED     (512 * MiB)

struct Params {
    const float* in[24];
    float* out;
    unsigned char* ws;
};

#include <hip/hip_cooperative_groups.h>
namespace cg = cooperative_groups;

#define GROUP_SMEM (68 * 1024)
#define PG8_EXTRA (128 * 1024)
#define SMEM_BYTES (144 * 1024)
#define SMEM_ALLOC (SMEM_BYTES + 16)
#define NTHREADS 512

#define WSP(T, off) ((T*)(p.ws + (off)))


DI void transpose_tile(const float* __restrict__ W, bf16_t* __restrict__ Wt, int K, int N, int t, unsigned char* smem) {
    float* tile = (float*)smem;
    const int tid = otid();
    const int ntn = N / 64;
    const int n0 = (t % ntn) * 64, k0 = (t / ntn) * 64;
    __syncthreads();
    {
        const int n4 = tid & 15, kr = tid >> 4;
#pragma unroll
        for (int i = 0; i < 4; ++i) {
            const int k = kr + 16 * i;
            const float4 v = *(const float4*)(W + (size_t)(k0 + k) * N + n0 + 4 * n4);
            tile[k * 65 + 4 * n4 + 0] = v.x; tile[k * 65 + 4 * n4 + 1] = v.y; tile[k * 65 + 4 * n4 + 2] = v.z; tile[k * 65 + 4 * n4 + 3] = v.w;
        }
    }
    __syncthreads();
    {
        const int n = tid >> 2, kc = tid & 3;
        float v[16];
#pragma unroll
        for (int j = 0; j < 16; ++j) v[j] = tile[(16 * kc + j) * 65 + n];
        uint4 o0, o1;
        o0.x = pack2(v[0], v[1]); o0.y = pack2(v[2], v[3]); o0.z = pack2(v[4], v[5]); o0.w = pack2(v[6], v[7]);
        o1.x = pack2(v[8], v[9]); o1.y = pack2(v[10], v[11]); o1.z = pack2(v[12], v[13]); o1.w = pack2(v[14], v[15]);
        uint4* dst = (uint4*)(Wt + (size_t)(n0 + n) * K + k0 + 16 * kc);
        dst[0] = o0; dst[1] = o1;
    }
}
DI void cvt_chunk(const float* __restrict__ src, bf16_t* __restrict__ dst, int c) {
    const size_t base = (size_t)c * 2048;
#pragma unroll
    for (int i = 0; i < 8; ++i) {
        const size_t idx = base + i * 256 + otid();
        const float4 v = ((const float4*)src)[idx];
        uint2 o; o.x = pack2(v.x, v.y); o.y = pack2(v.z, v.w);
        ((uint2*)dst)[idx] = o;
    }
}
DI int q8(float v) { int i = __float2int_rn(v); i = i > 127 ? 127 : i; i = i < -127 ? -127 : i; return i & 255; }
template <bool EMIT_Q>
DI void rmsnorm_rows(const float* __restrict__ x, const float* __restrict__ g, bf16_t* __restrict__ o, int vb, signed char* xq = nullptr, float* xsc = nullptr) {
    const int lane = otid() & 63;
    const int row = vb * 4 + (otid() >> 6);
    const float4* xr = (const float4*)(x + (size_t)row * DM);
    float4 v[4]; float ss = 0.f;
#pragma unroll
    for (int j = 0; j < 4; ++j) { v[j] = xr[lane + 64 * j]; ss += v[j].x * v[j].x + v[j].y * v[j].y + v[j].z * v[j].z + v[j].w * v[j].w; }
    ss = wave_sum(ss);
    const float rinv = rsqrtf(ss * (1.f / DM) + EPSN);
    uint2* orow = (uint2*)(o + (size_t)row * DM);
    float am = 0.f;
#pragma unroll
    for (int j = 0; j < 4; ++j) {
        const float4 gg = ((const float4*)g)[lane + 64 * j];
        v[j].x *= rinv * gg.x; v[j].y *= rinv * gg.y; v[j].z *= rinv * gg.z; v[j].w *= rinv * gg.w;
        uint2 w; w.x = pack2(v[j].x, v[j].y); w.y = pack2(v[j].z, v[j].w);
        orow[lane + 64 * j] = w;
        if (EMIT_Q) am = fmaxf(am, fmaxf(fmaxf(fabsf(v[j].x), fabsf(v[j].y)), fmaxf(fabsf(v[j].z), fabsf(v[j].w))));
    }
    if (EMIT_Q) {
        am = wave_max(am);
        const float sc = am > 0.f ? 127.f / am : 0.f;
        u32* qrow = (u32*)(xq + (size_t)row * DM);
#pragma unroll
        for (int j = 0; j < 4; ++j)
            qrow[lane + 64 * j] = (u32)q8(v[j].x * sc) | ((u32)q8(v[j].y * sc) << 8) | ((u32)q8(v[j].z * sc) << 16) | ((u32)q8(v[j].w * sc) << 24);
        if (lane == 0) xsc[row] = am * (1.f / 127.f);
    }
}
#define PREP_T0 (48 * 16)
#define PREP_T1 (PREP_T0 + 16 * 16)
#define PREP_T2 (PREP_T1 + 64 * 16)
#define PREP_T3 (PREP_T2 + 16 * 32)
#define PREP_T4 (PREP_T3 + 2 * 32 * 16)
#define PREP_C0 (PREP_T4 + 64)
#define PREP_C1 (PREP_C0 + 8192)
#define PREP_C2 (PREP_C1 + 8192)
#define PREP_N  (PREP_C2 + 8192)
template <bool INT8>
DI void fp8_rows(const float* __restrict__ src, unsigned char* __restrict__ dst, float* __restrict__ inv_scale, int vb) {
    const int lane = otid() & 63;
    const int row = vb * 4 + (otid() >> 6);
    const float4* sr = (const float4*)(src + (size_t)row * DM) + lane;
    float4 v[4]; float am = 0.f;
#pragma unroll
    for (int j = 0; j < 4; ++j) { v[j] = sr[64 * j]; am = fmaxf(am, fmaxf(fmaxf(fabsf(v[j].x), fabsf(v[j].y)), fmaxf(fabsf(v[j].z), fabsf(v[j].w)))); }
    am = wave_max(am);
    float sc, inv;
    if (INT8) { sc = am > 0.f ? 127.f / am : 0.f; inv = am * (1.f / 127.f); }
    else {
        int e = (int)((__float_as_uint(am) >> 23) & 255u) - 127;
        if (am == 0.f) e = 0;
        e = e < -100 ? -100 : e;
        sc = __uint_as_float((u32)(127 + 7 - e) << 23); inv = __uint_as_float((u32)(127 + e - 7) << 23);
    }
    unsigned char* drow = dst + (size_t)(row >> 14) * NEXP * DM + (size_t)(row & (NEXP - 1)) * 128;
#pragma unroll
    for (int j = 0; j < 4; ++j) {
        const int dim = 4 * (lane + 64 * j);
        u32 w;
        if (INT8) w = (u32)q8(v[j].x * sc) | ((u32)q8(v[j].y * sc) << 8) | ((u32)q8(v[j].z * sc) << 16) | ((u32)q8(v[j].w * sc) << 24);
        else { int t = __builtin_amdgcn_cvt_pk_fp8_f32(v[j].x * sc, v[j].y * sc, 0, false); t = __builtin_amdgcn_cvt_pk_fp8_f32(v[j].z * sc, v[j].w * sc, t, true); w = (u32)t; }
        *(u32*)(drow + (size_t)(dim >> 7) * NEXP * 128 + (dim & 127)) = w;
    }
    if (lane == 0) inv_scale[row] = inv;
}
DI void ph_prep(const Params& p, int vb, unsigned char* smem) {
    if (vb < PREP_T0) transpose_tile(p.in[2], WSP(bf16_t, WS_W_ATTIN), DM, ATT_IN, vb, smem);
    else if (vb < PREP_T1) transpose_tile(p.in[12], WSP(bf16_t, WS_W_ATTOUT), DM, DM, vb - PREP_T0, smem);
    else if (vb < PREP_T2) transpose_tile(p.in[14], WSP(bf16_t, WS_W_SGUIN), DM, 4096, vb - PREP_T1, smem);
    else if (vb < PREP_T3) transpose_tile(p.in[18], WSP(bf16_t, WS_W_SGUOUT), CW, DM, vb - PREP_T2, smem);
    else if (vb < PREP_T4) { const int t = vb - PREP_T3, l = t / 512; transpose_tile(p.in[20] + (size_t)l * DM * 2048, WSP(bf16_t, WS_W_PQ) + (size_t)l * 2048 * DM, DM, 2048, t % 512, smem); }
    else if (vb < PREP_C0) cvt_chunk(p.in[21], WSP(bf16_t, WS_W_SUBK), vb - PREP_T4);
    else if (vb < PREP_C1) fp8_rows<true>(p.in[22], p.ws + WS_DOWN, WSP(float, WS_DSC), vb - PREP_C0);
    else if (vb < PREP_C2) fp8_rows<false>(p.in[23], p.ws + WS_UP, WSP(float, WS_USC), vb - PREP_C1);
    else rmsnorm_rows<false>(p.in[0], p.in[1], WSP(bf16_t, WS_XN), vb - PREP_C2);
}

DI float compute_lam(const Params& p, int lane) {
    const float a = wave_sum(p.in[7][lane] * p.in[8][lane]);
    const float b = wave_sum(p.in[9][lane] * p.in[10][lane]);
    return __expf(a) - __expf(b) + 0.2f;
}
DI void ce_desc(u32& a, u32& b) { const u32 hi = max(a, b), lo = min(a, b); a = hi; b = lo; }
DI void sort16_desc(u32 (&v)[16]) {
#pragma unroll
    for (int k = 2; k <= 16; k <<= 1)
#pragma unroll
        for (int j = k >> 1; j > 0; j >>= 1)
#pragma unroll
            for (int i = 0; i < 16; ++i) {
                const int l = i ^ j;
                if (l > i) { if ((i & k) == 0) ce_desc(v[i], v[l]); else ce_desc(v[l], v[i]); }
            }
}
DI void merge16_desc(u32 (&a)[16], const u32 (&b)[16]) {
#pragma unroll
    for (int i = 0; i < 16; ++i) a[i] = max(a[i], b[15 - i]);
#pragma unroll
    for (int j = 8; j > 0; j >>= 1)
#pragma unroll
        for (int i = 0; i < 16; ++i) { const int l = i ^ j; if (l > i) ce_desc(a[i], a[l]); }
}
DI void top16_insert(u32 (&lst)[16], u32 x) {
#pragma unroll
    for (int j = 0; j < 16; ++j) { const u32 hi = max(lst[j], x); x = min(lst[j], x); lst[j] = hi; }
}
DI void unpack8(const uint4 v, float (&f)[8]) {
    f[0] = __uint_as_float(v.x << 16); f[1] = __uint_as_float(v.x & 0xffff0000u);
    f[2] = __uint_as_float(v.y << 16); f[3] = __uint_as_float(v.y & 0xffff0000u);
    f[4] = __uint_as_float(v.z << 16); f[5] = __uint_as_float(v.z & 0xffff0000u);
    f[6] = __uint_as_float(v.w << 16); f[7] = __uint_as_float(v.w & 0xffff0000u);
}
typedef float f32x2_t __attribute__((ext_vector_type(2)));
DI void unpack16fp8(const uint4 w, float (&f)[16]) {
    f32x2_t t;
    t = __builtin_amdgcn_cvt_pk_f32_fp8((int)w.x, false); f[0] = t[0]; f[1] = t[1];
    t = __builtin_amdgcn_cvt_pk_f32_fp8((int)w.x, true);  f[2] = t[0]; f[3] = t[1];
    t = __builtin_amdgcn_cvt_pk_f32_fp8((int)w.y, false); f[4] = t[0]; f[5] = t[1];
    t = __builtin_amdgcn_cvt_pk_f32_fp8((int)w.y, true);  f[6] = t[0]; f[7] = t[1];
    t = __builtin_amdgcn_cvt_pk_f32_fp8((int)w.z, false); f[8] = t[0]; f[9] = t[1];
    t = __builtin_amdgcn_cvt_pk_f32_fp8((int)w.z, true);  f[10] = t[0]; f[11] = t[1];
    t = __builtin_amdgcn_cvt_pk_f32_fp8((int)w.w, false); f[12] = t[0]; f[13] = t[1];
    t = __builtin_amdgcn_cvt_pk_f32_fp8((int)w.w, true);  f[14] = t[0]; f[15] = t[1];
}
struct PeerPre { int e[16]; uint4 xa, xb; float2 r; };
struct PeerRows { uint4 d[8]; float c[8]; };
template <bool UP>
DI PeerPre peer_prefetch(const Params& p, int tok, int sl, int lane) {
    PeerPre q;
    const int4* rix = (const int4*)(WSP(int, WS_RIDX) + (size_t)tok * 128 + 16 * (lane >> 3));
#pragma unroll
    for (int j = 0; j < 4; ++j) { const int4 t = rix[j]; q.e[4 * j] = t.x; q.e[4 * j + 1] = t.y; q.e[4 * j + 2] = t.z; q.e[4 * j + 3] = t.w; }
    if (UP) {
        q.r = *(const float2*)(p.out + (size_t)tok * DM + sl * 128 + 16 * (lane & 7) + 2 * (lane >> 3));
    } else {
        q.xa = *(const uint4*)(WSP(signed char, WS_XQ) + (size_t)tok * DM + sl * 128 + 16 * (lane & 7));
    }
    return q;
}
template <int HF, bool UP>
DI void peer_issue_rows(const Params& p, const unsigned char* tab, const PeerPre& q, int tok, int lane, PeerRows& R) {
    const unsigned dco = 16u * (unsigned)(lane & 7);
#pragma unroll
    for (int bi = 0; bi < 8; ++bi) R.d[bi] = *(const uint4*)(tab + ((unsigned)q.e[8 * HF + bi] * 128u + dco));
    if (UP) {
        const float4* cf = (const float4*)(WSP(float, WS_RG) + (size_t)tok * 128 + 16 * (lane >> 3) + 8 * HF);
        const float4 c0 = cf[0], c1 = cf[1];
        R.c[0] = c0.x; R.c[1] = c0.y; R.c[2] = c0.z; R.c[3] = c0.w; R.c[4] = c1.x; R.c[5] = c1.y; R.c[6] = c1.z; R.c[7] = c1.w;
    }
}
template <int HF>
DI void peer_down_half(const PeerPre& q, const PeerRows& R, float (&part)[16]) {
#pragma unroll
    for (int bi = 0; bi < 8; ++bi) {
        int a = __builtin_amdgcn_sdot4((int)R.d[bi].x, (int)q.xa.x, 0, false);
        a = __builtin_amdgcn_sdot4((int)R.d[bi].y, (int)q.xa.y, a, false);
        a = __builtin_amdgcn_sdot4((int)R.d[bi].z, (int)q.xa.z, a, false);
        a = __builtin_amdgcn_sdot4((int)R.d[bi].w, (int)q.xa.w, a, false);
        part[8 * HF + bi] = (float)a;
    }
}
DI void peer_down_fin(const Params& p, const float (&part)[16], int tok, int sl, int lane) {
    const bool b2 = lane & 4, b1 = lane & 2, b0 = lane & 1;
    float r8[8], r4[4], r2[2];
#pragma unroll
    for (int i = 0; i < 8; ++i) { const float snd = b2 ? part[i] : part[i + 8]; const float kp = b2 ? part[i + 8] : part[i]; r8[i] = kp + __shfl_xor(snd, 4); }
#pragma unroll
    for (int i = 0; i < 4; ++i) { const float snd = b1 ? r8[i] : r8[i + 4]; const float kp = b1 ? r8[i + 4] : r8[i]; r4[i] = kp + __shfl_xor(snd, 2); }
#pragma unroll
    for (int i = 0; i < 2; ++i) { const float snd = b0 ? r4[i] : r4[i + 2]; const float kp = b0 ? r4[i + 2] : r4[i]; r2[i] = kp + __shfl_xor(snd, 1); }
    float* pd = WSP(float, WS_QBUF) + ((size_t)tok * 8 + sl) * 128;
    *(float2*)(pd + 2 * lane) = make_float2(r2[0], r2[1]);
}
DI void ph_peer_comb(const Params& p, int vb, int l) {
    const int tid = otid(), lane = tid & 63;
    const int tok = vb * 4 + (tid >> 6);
    const float* pd = WSP(float, WS_QBUF) + (size_t)tok * 8 * 128;
    const int* rix = WSP(int, WS_RIDX) + (size_t)tok * 128;
    float* rgp = WSP(float, WS_RG) + (size_t)tok * 128;
    const float* dsc = WSP(float, WS_DSC) + (size_t)l * NEXP;
    const float* usc = WSP(float, WS_USC) + (size_t)l * NEXP;
    const float xs = WSP(float, WS_XSC)[tok];
#pragma unroll
    for (int hh = 0; hh < 2; ++hh) {
        const int k = lane + 64 * hh;
        float t = 0.f;
#pragma unroll
        for (int sl = 0; sl < 8; ++sl) t += pd[sl * 128 + k];
        const int e = rix[k];
        rgp[k] = rgp[k] * gelu_tanh(t * dsc[e] * xs) * usc[e];
    }
}
template <int HF>
DI void peer_up_half(const PeerPre& q, const PeerRows& R, float (&y)[16]) {
#pragma unroll
    for (int bi = 0; bi < 8; ++bi) {
        const float c = R.c[bi];
        float w[16]; unpack16fp8(R.d[bi], w);
#pragma unroll
        for (int i = 0; i < 16; ++i) y[i] += c * w[i];
        asm volatile("" : "+v"(y[0]), "+v"(y[1]), "+v"(y[2]), "+v"(y[3]), "+v"(y[4]), "+v"(y[5]), "+v"(y[6]), "+v"(y[7]), "+v"(y[8]), "+v"(y[9]), "+v"(y[10]), "+v"(y[11]), "+v"(y[12]), "+v"(y[13]), "+v"(y[14]), "+v"(y[15]));
    }
}
DI void peer_up_fin(const Params& p, const PeerPre& q, const float (&y)[16], int tok, int sl, int lane) {
    const int rg = lane >> 3, dc = lane & 7;
    const bool b5 = lane & 32, b4 = lane & 16, b3 = lane & 8;
    float r8[8], r4[4], r2[2];
#pragma unroll
    for (int i = 0; i < 8; ++i) { const float snd = b5 ? y[i] : y[i + 8]; const float kp = b5 ? y[i + 8] : y[i]; r8[i] = kp + __shfl_xor(snd, 32); }
#pragma unroll
    for (int i = 0; i < 4; ++i) { const float snd = b4 ? r8[i] : r8[i + 4]; const float kp = b4 ? r8[i + 4] : r8[i]; r4[i] = kp + __shfl_xor(snd, 16); }
#pragma unroll
    for (int i = 0; i < 2; ++i) { const float snd = b3 ? r4[i] : r4[i + 2]; const float kp = b3 ? r4[i + 2] : r4[i]; r2[i] = kp + __shfl_xor(snd, 8); }
    float2 v = q.r;
    v.x += r2[0]; v.y += r2[1];
    *(float2*)(p.out + (size_t)tok * DM + sl * 128 + 16 * dc + 2 * rg) = v;
}
template <bool UP>
DI void run_peer_sliced(const Params& p, int l, unsigned char* smem) {
    volatile LAS unsigned* st = (volatile LAS unsigned*)(smem + SMEM_BYTES);
    const int nloc = (int)st[0], nx = (int)st[1], rank = (int)st[2], xi = (int)st[3];
    const int tid = otid512(), lane = tid & 63, wave = tid >> 6;
    const int stride = nloc * 8;
#pragma unroll 1
    for (int sl = xi; sl < 8; sl += nx) {
        const unsigned char* tab = p.ws + (UP ? WS_UP : WS_DOWN) + (size_t)l * NEXP * DM + (size_t)sl * NEXP * 128;
        int tok = rank * 8 + wave;
        if (tok >= NTOK) continue;
        PeerPre qc = peer_prefetch<UP>(p, tok, sl, lane);
        PeerRows R;
        peer_issue_rows<0, UP>(p, tab, qc, tok, lane, R);
#pragma unroll 1
        for (; tok < NTOK; tok += stride) {
            const int tn = tok + stride < NTOK ? tok + stride : tok;
            const PeerPre qn = peer_prefetch<UP>(p, tn, sl, lane);
            float acc[16];
#pragma unroll
            for (int i = 0; i < 16; ++i) acc[i] = 0.f;
            PeerRows Rn;
            peer_issue_rows<1, UP>(p, tab, qc, tok, lane, Rn);
            __builtin_amdgcn_sched_barrier(0);
            if (UP) peer_up_half<0>(qc, R, acc); else peer_down_half<0>(qc, R, acc);
            __builtin_amdgcn_sched_barrier(0);
            peer_issue_rows<0, UP>(p, tab, qn, tn, lane, R);
            __builtin_amdgcn_sched_barrier(0);
            if (UP) { peer_up_half<1>(qc, Rn, acc); peer_up_fin(p, qc, acc, tok, sl, lane); }
            else { peer_down_half<1>(qc, Rn, acc); peer_down_fin(p, acc, tok, sl, lane); }
            __builtin_amdgcn_sched_barrier(0);
            qc = qn;
        }
    }
}


typedef short bf16x8 __attribute__((ext_vector_type(8)));
typedef float f32x16 __attribute__((ext_vector_type(16)));
#define MFMA32(a, b, c) __builtin_amdgcn_mfma_f32_32x32x16_bf16((a), (b), (c), 0, 0, 0)
typedef short s16x4 __attribute__((ext_vector_type(4)));
DI bf16x8 pack_p(const f32x16& pt, int s) {
    uint4 o;
    o.x = pack2(pt[8 * s + 0], pt[8 * s + 1]); o.y = pack2(pt[8 * s + 2], pt[8 * s + 3]);
    o.z = pack2(pt[8 * s + 4], pt[8 * s + 5]); o.w = pack2(pt[8 * s + 6], pt[8 * s + 7]);
    return __builtin_bit_cast(bf16x8, o);
}

DI void stage_tile(const bf16_t* __restrict__ g, int ld, int row0, int k0, unsigned char* lt, int wave, int lane) {
#pragma unroll
    for (int i = 0; i < 4; ++i) {
        const int inst = wave * 4 + i;
        const int row = inst * 8 + (lane >> 3);
        const int c = (lane & 7) ^ ((row >> 1) & 7);
        __builtin_amdgcn_global_load_lds((const unsigned*)(g + (size_t)(row0 + row) * ld + k0 + c * 8),
                                         (unsigned*)(lt + inst * 1024 + lane * 16), 16, 0, 0);
    }
}
DI bf16x8 lds_frag(const unsigned char* lt, int row, int c) {
    return *(const bf16x8*)(lt + row * 128 + ((c ^ ((row >> 1) & 7)) << 4));
}
DI int crow(int r, int fh) { return (r & 3) + 8 * (r >> 2) + 4 * fh; }

namespace pg8 {
#define PG8_LAS __attribute__((address_space(3)))
typedef float f32x4 __attribute__((ext_vector_type(4)));
typedef unsigned u32x4 __attribute__((ext_vector_type(4)));
constexpr int BM = 256, BK = 64, HALF = 128, HTB = HALF * BK * 2  , STAGE_BYTES = 8 * HTB;
__host__ __device__ __forceinline__ int lds_byte(int r, int c) { const int st = (r >> 4) * 2 + (c >> 5), rr = r & 15, cc = c & 31, ob = rr * 64 + cc * 2; return st * 1024 + (ob ^ (((ob >> 9) & 1) << 5)); }
__host__ __device__ __forceinline__ void stage_rc(int b, int& R, int& C) { const int st = b / 1024, sb = b % 1024, swz = sb ^ (((sb >> 9) & 1) << 5); R = (st >> 1) * 16 + swz / 64; C = (st & 1) * 32 + (swz % 64) / 2; }
__host__ __device__ __forceinline__ int perm32(int rho) { const int n = rho >> 4, i = rho & 15; return 8 * (i >> 2) + 4 * n + (i & 3); }
struct Unit { int pm, pn; };
struct Gemm { const bf16_t* A; const bf16_t* Bt; int M, N, K; };
struct XcdOrder {
    int ntn, nloc, nx, rank, xi, nown, total;
    __device__ __forceinline__ void init(int nmt, int ntn_, int nloc_, int nx_, int rank_, int xi_) {
        ntn = ntn_; nloc = nloc_; nx = nx_; rank = rank_; xi = xi_; nown = xi < nmt ? (nmt - xi + nx - 1) / nx : 0; total = nown * ntn; }
    __device__ __forceinline__ bool next(int i, Unit& u) const {
        const int t = rank + i * nloc; if (t >= total) return false;
        const int g4 = t / (4 * ntn), r = t - g4 * 4 * ntn;
        const int left = nown - 4 * g4, gs = left < 4 ? left : 4;
        const int nt = r / gs, mi = r - nt * gs;
        u.pm = (4 * g4 + mi) * nx + xi; u.pn = nt; return true;
    }
    __device__ __forceinline__ void a_ready(const Unit&) const {}
    __device__ __forceinline__ void done(const Unit&) const {}
};
template <class Epi, class Sched, bool ALIGN_EPI = false, bool SP2 = false>
__device__ __forceinline__ void gemm_phase(PG8_LAS unsigned char* lds, const Gemm g, const Sched& S, const Epi& E) {
    const int tid = otid512(), wid = __builtin_amdgcn_readfirstlane(tid >> 6), lane = tid & 63, wr = wid >> 2, wc = wid & 3, fr = lane & 15, fq = lane >> 4;
    const int K = g.K, nt = K / BK;
    unsigned voffA[2], voffB[2];
#pragma unroll
    for (int i = 0; i < 2; ++i) { int R, C; stage_rc(tid * 16 + i * 8192, R, C); const int Rb = Epi::PERM ? ((R & ~31) + perm32(R & 31)) : R;
        voffA[i] = (unsigned)(R * K + C) * 2u; voffB[i] = (unsigned)(Rb * K + C) * 2u; }
    const size_t kstep = (size_t)(BK * 2);
    const size_t hstep = (size_t)HALF * K * 2;
    const size_t tstep = 2 * hstep;
    const unsigned ldsw = (unsigned)wid * 1024u;
    const int aoff = lds_byte(wr * 64 + fr, fq * 8), boff = lds_byte(wc * 32 + fr, fq * 8);
#define PG8_SA(b, h) (((b) * 2 + (h)) * HTB)
#define PG8_SB(b, h) ((4 + (b) * 2 + (h)) * HTB)
#define PG8_STAGE(bufoff, gbase, voff) do { _Pragma("unroll") for (int _i = 0; _i < 2; ++_i) \
        __builtin_amdgcn_global_load_lds((const unsigned*)((const char*)(gbase) + (voff)[_i]), (PG8_LAS unsigned*)(lds + (bufoff) + ldsw + _i * 8192), 16, 0, 0); } while (0)
#define PG8_LDA(dst, b, h) do { _Pragma("unroll") for (int m = 0; m < 4; ++m) _Pragma("unroll") for (int k = 0; k < 2; ++k) dst[m][k] = *(const PG8_LAS bf16x8*)(lds + PG8_SA(b, h) + aoff + m * 2048 + k * 1024); } while (0)
#define PG8_LDB(dst, b, h) do { _Pragma("unroll") for (int n = 0; n < 2; ++n) _Pragma("unroll") for (int k = 0; k < 2; ++k) dst[n][k] = *(const PG8_LAS bf16x8*)(lds + PG8_SB(b, h) + boff + n * 2048 + k * 1024); } while (0)
#define PG8_MMA(ai, bj, At, Bt) do { __builtin_amdgcn_s_setprio(1); _Pragma("unroll") for (int m = 0; m < 4; ++m) _Pragma("unroll") for (int n = 0; n < 2; ++n) _Pragma("unroll") for (int k = 0; k < 2; ++k) \
        acc[ai][bj][m][n] = __builtin_amdgcn_mfma_f32_16x16x32_bf16(Bt[n][k], At[m][k], acc[ai][bj][m][n], 0, 0, 0); __builtin_amdgcn_s_setprio(0); } while (0)
#define PG8_WAIT_V(n) asm volatile("s_waitcnt vmcnt(" #n ")" ::: "memory")
#define PG8_WAIT_L(n) asm volatile("s_waitcnt lgkmcnt(" #n ")" ::: "memory")
#define PG8_BAR __builtin_amdgcn_s_barrier()
#define PG8_SCHED __builtin_amdgcn_sched_barrier(0)
    Unit cur, nxt; int ui = 0;
    if (!S.next(0, cur)) return;
    f32x4 acc[2][2][4][2];
#pragma unroll
    for (int a = 0; a < 2; ++a)
#pragma unroll
        for (int b = 0; b < 2; ++b)
#pragma unroll
            for (int m = 0; m < 4; ++m)
#pragma unroll
                for (int n = 0; n < 2; ++n) acc[a][b][m][n] = (f32x4){0.f, 0.f, 0.f, 0.f};
    bf16x8 At[4][2], B0[2][2], B1[2][2];
    const char* cA = (const char*)g.A + (size_t)cur.pm * tstep; const char* cB = (const char*)g.Bt + (size_t)cur.pn * tstep;
    S.a_ready(cur);
    if constexpr (SP2) {
        PG8_STAGE(PG8_SB(0, 0), cB, voffB); PG8_STAGE(PG8_SB(0, 1), cB + hstep, voffB); PG8_STAGE(PG8_SA(0, 0), cA, voffA); PG8_STAGE(PG8_SA(0, 1), cA + hstep, voffA);
        if (wr == 1) PG8_BAR;
        PG8_WAIT_V(2); PG8_BAR;
        PG8_STAGE(PG8_SB(1, 0), cB + kstep, voffB); PG8_STAGE(PG8_SA(1, 0), cA + kstep, voffA); PG8_STAGE(PG8_SB(1, 1), cB + hstep + kstep, voffB);
        PG8_WAIT_V(6); PG8_BAR;
    } else {
        PG8_STAGE(PG8_SB(0, 0), cB, voffB); PG8_STAGE(PG8_SA(0, 0), cA, voffA); PG8_STAGE(PG8_SB(0, 1), cB + hstep, voffB); PG8_STAGE(PG8_SA(0, 1), cA + hstep, voffA);
        if (wr == 1) PG8_BAR;
        PG8_WAIT_V(4); PG8_BAR;
        PG8_STAGE(PG8_SB(1, 0), cB + kstep, voffB); PG8_STAGE(PG8_SA(1, 0), cA + kstep, voffA); PG8_STAGE(PG8_SB(1, 1), cB + hstep + kstep, voffB);
        PG8_WAIT_V(6); PG8_BAR;
    }
    for (;;) {
        const bool has_next = S.next(ui + 1, nxt);
        const char* nA = has_next ? (const char*)g.A + (size_t)nxt.pm * tstep : cA; const char* nB = has_next ? (const char*)g.Bt + (size_t)nxt.pn * tstep : cB;
        for (int t = 0; t < nt; t += 2) {
            const bool last = (t == nt - 2);
            const char* a1 = cA + (size_t)(t + 1) * kstep;
            const char* a2 = last ? nA : cA + (size_t)(t + 2) * kstep; const char* b2 = last ? nB : cB + (size_t)(t + 2) * kstep;
            const char* a3 = a2 + kstep; const char* b3 = b2 + kstep;
            if (last && has_next) S.a_ready(nxt);
            if constexpr (SP2) {
            PG8_LDB(B0, 0, 0); PG8_LDB(B1, 0, 1); PG8_SCHED; PG8_LDA(At, 0, 0); PG8_STAGE(PG8_SA(1, 1), a1 + hstep, voffA);
            PG8_WAIT_V(8); PG8_WAIT_L(0); PG8_BAR; PG8_MMA(0, 0, At, B0); PG8_MMA(0, 1, At, B1); PG8_BAR; PG8_SCHED;
            PG8_LDA(At, 0, 1); PG8_STAGE(PG8_SB(0, 0), b2, voffB); PG8_STAGE(PG8_SB(0, 1), b2 + hstep, voffB); PG8_STAGE(PG8_SA(0, 0), a2, voffA);
            PG8_WAIT_V(8); PG8_WAIT_L(0); PG8_BAR; PG8_MMA(1, 0, At, B0); PG8_MMA(1, 1, At, B1); PG8_BAR; PG8_SCHED;
            PG8_LDB(B0, 1, 0); PG8_LDB(B1, 1, 1); PG8_SCHED; PG8_LDA(At, 1, 0); PG8_STAGE(PG8_SA(0, 1), a2 + hstep, voffA);
            PG8_WAIT_V(8); PG8_WAIT_L(0); PG8_BAR; PG8_MMA(0, 0, At, B0); PG8_MMA(0, 1, At, B1); PG8_BAR; PG8_SCHED;
            PG8_LDA(At, 1, 1); PG8_STAGE(PG8_SB(1, 0), b3, voffB); PG8_STAGE(PG8_SB(1, 1), b3 + hstep, voffB); PG8_STAGE(PG8_SA(1, 0), a3, voffA);
            PG8_WAIT_V(8); PG8_WAIT_L(0); PG8_BAR; PG8_MMA(1, 0, At, B0); PG8_MMA(1, 1, At, B1); PG8_BAR; PG8_SCHED;
            } else {
            PG8_LDB(B0, 0, 0); PG8_SCHED; PG8_LDA(At, 0, 0); PG8_STAGE(PG8_SA(1, 1), a1 + hstep, voffA);
            PG8_WAIT_L(8); PG8_BAR; PG8_WAIT_L(0); PG8_MMA(0, 0, At, B0); PG8_BAR; PG8_SCHED;
            PG8_LDB(B1, 0, 1); PG8_STAGE(PG8_SB(0, 0), b2, voffB);
            PG8_BAR; PG8_WAIT_L(0); PG8_MMA(0, 1, At, B1); PG8_BAR;
            PG8_LDA(At, 0, 1); PG8_STAGE(PG8_SA(0, 0), a2, voffA);
            PG8_BAR; PG8_WAIT_L(0); PG8_MMA(1, 0, At, B0); PG8_BAR; PG8_SCHED;
            PG8_STAGE(PG8_SB(0, 1), b2 + hstep, voffB);
            PG8_WAIT_V(6); PG8_BAR; PG8_MMA(1, 1, At, B1); PG8_BAR;
            PG8_LDB(B0, 1, 0); PG8_SCHED; PG8_LDA(At, 1, 0); PG8_STAGE(PG8_SA(0, 1), a2 + hstep, voffA);
            PG8_WAIT_L(8); PG8_BAR; PG8_WAIT_L(0); PG8_MMA(0, 0, At, B0); PG8_BAR; PG8_SCHED;
            PG8_LDB(B1, 1, 1); PG8_STAGE(PG8_SB(1, 0), b3, voffB);
            PG8_BAR; PG8_WAIT_L(0); PG8_MMA(0, 1, At, B1); PG8_BAR;
            PG8_LDA(At, 1, 1); PG8_STAGE(PG8_SA(1, 0), a3, voffA);
            PG8_BAR; PG8_WAIT_L(0); PG8_MMA(1, 0, At, B0); PG8_BAR; PG8_SCHED;
            PG8_STAGE(PG8_SB(1, 1), b3 + hstep, voffB);
            PG8_WAIT_V(6); PG8_BAR; PG8_MMA(1, 1, At, B1); PG8_BAR;
            }
        }
        if constexpr (ALIGN_EPI) { if (wr == 0) PG8_BAR; }
        if constexpr (!Epi::AFTER_DRAIN) { E(acc, cur, wr, wc, fr, fq); S.done(cur); }
        if (!has_next) break;
#pragma unroll
        for (int a = 0; a < 2; ++a)
#pragma unroll
            for (int b = 0; b < 2; ++b)
#pragma unroll
                for (int m = 0; m < 4; ++m)
#pragma unroll
                    for (int n = 0; n < 2; ++n) acc[a][b][m][n] = (f32x4){0.f, 0.f, 0.f, 0.f};
        cur = nxt; cA = nA; cB = nB; ++ui;
        if constexpr (ALIGN_EPI) { if (wr == 1) PG8_BAR; }
    }
    PG8_WAIT_V(0);
    if constexpr (!ALIGN_EPI) { if (wr == 0) PG8_BAR; }
    PG8_BAR;
    if constexpr (Epi::AFTER_DRAIN) { E.fused(acc, cur, wr, wc, fr, fq, lds, wid, lane); S.done(cur); }
#undef PG8_SA
#undef PG8_SB
#undef PG8_STAGE
#undef PG8_LDA
#undef PG8_LDB
#undef PG8_MMA
#undef PG8_WAIT_V
#undef PG8_WAIT_L
#undef PG8_BAR
#undef PG8_SCHED
}
struct EpiResid {
    static constexpr bool PERM = true, AFTER_DRAIN = false;
    const float* resid; float* out;
    __device__ __forceinline__ void operator()(const f32x4 (&acc)[2][2][4][2], const Unit& u, int wr, int wc, int fr, int fq) const {
        const size_t base = (size_t)(u.pm * BM + wr * 64 + fr) * DM + u.pn * BM + wc * 32 + 8 * fq;
#pragma unroll
        for (int ai = 0; ai < 2; ++ai) {
            f32x4 rv[4][2][2];
#pragma unroll
            for (int m = 0; m < 4; ++m)
#pragma unroll
                for (int bj = 0; bj < 2; ++bj) {
                    const float* rp = resid + base + (size_t)(ai * HALF + m * 16) * DM + bj * HALF;
                    rv[m][bj][0] = *(const f32x4*)rp; rv[m][bj][1] = *(const f32x4*)(rp + 4);
                }
            asm volatile("" ::: "memory");
#pragma unroll
            for (int m = 0; m < 4; ++m)
#pragma unroll
                for (int bj = 0; bj < 2; ++bj) {
                    float* op = out + base + (size_t)(ai * HALF + m * 16) * DM + bj * HALF;
                    *(f32x4*)op = rv[m][bj][0] + acc[ai][bj][m][0]; *(f32x4*)(op + 4) = rv[m][bj][1] + acc[ai][bj][m][1];
                }
            asm volatile("" ::: "memory");
        }
    }
};
struct EpiProj {
    static constexpr bool PERM = true, AFTER_DRAIN = false;
    const float* aq; const float* ak; const float* bq; const float* bk; bf16_t* proj; PG8_LAS float* xs;
    __device__ __forceinline__ void operator()(const f32x4 (&acc)[2][2][4][2], const Unit& u, int wr, int wc, int fr, int fq) const {
        const int wave = wr * 4 + wc;
#pragma unroll
        for (int ai = 0; ai < 2; ++ai)
#pragma unroll
            for (int m = 0; m < 4; ++m)
#pragma unroll
                for (int bj = 0; bj < 2; ++bj) {
                    const f32x4 a = acc[ai][bj][m][0], b = acc[ai][bj][m][1];
                    float t = a[0] * a[0] + a[1] * a[1] + a[2] * a[2] + a[3] * a[3] + b[0] * b[0] + b[1] * b[1] + b[2] * b[2] + b[3] * b[3];
                    t += __shfl_xor(t, 16); t += __shfl_xor(t, 32);
                    if (fq == 0) xs[wave * 256 + ((ai * 4 + m) * 2 + bj) * 16 + fr] = t;
                }
        asm volatile("s_waitcnt lgkmcnt(0)" ::: "memory");
        __builtin_amdgcn_s_barrier();
#pragma unroll
        for (int bj = 0; bj < 2; ++bj) {
            const int gcol = u.pn * BM + bj * HALF + wc * 32 + 8 * fq;
            const float* gain = nullptr; float scale = 1.f;
            if (gcol < 512) { gain = aq + (gcol & 63); scale = 0.125f; }
            else if (gcol < 1024) gain = ak + (gcol & 63);
            else if (gcol < 1536) gain = nullptr;
            else if (gcol < 2048) { gain = bq + (gcol & 127); scale = 0.125f; }
            else if (gcol < 2560) gain = bk + (gcol & 127);
            f32x4 g0 = {1.f, 1.f, 1.f, 1.f}, g1 = {1.f, 1.f, 1.f, 1.f};
            if (gain) { g0 = *(const f32x4*)gain; g1 = *(const f32x4*)(gain + 4); }
#pragma unroll
            for (int ai = 0; ai < 2; ++ai)
#pragma unroll
                for (int m = 0; m < 4; ++m) {
                    float sc = 1.f;
                    if (gain) {
                        const int slot = ((ai * 4 + m) * 2 + bj) * 16 + fr;
                        sc = rsqrtf((xs[wave * 256 + slot] + xs[(wave ^ 1) * 256 + slot]) * (1.f / 64.f) + EPSN) * scale;
                    }
                    const f32x4 v0 = acc[ai][bj][m][0] * g0 * sc, v1 = acc[ai][bj][m][1] * g1 * sc;
                    u32x4 w; w.x = pack2(v0[0], v0[1]); w.y = pack2(v0[2], v0[3]); w.z = pack2(v1[0], v1[1]); w.w = pack2(v1[2], v1[3]);
                    *(u32x4*)(proj + (size_t)(u.pm * BM + ai * HALF + wr * 64 + m * 16 + fr) * ATT_IN + gcol) = w;
                }
        }
    }
};
struct EpiSgu {
    static constexpr bool PERM = true, AFTER_DRAIN = false;
    bf16_t* zu; bf16_t* zvt; float* ssq; PG8_LAS unsigned char* stg;
    __device__ __forceinline__ void operator()(const f32x4 (&acc)[2][2][4][2], const Unit& u, int wr, int wc, int fr, int fq) const {
        const int wave = wr * 4 + wc, lane = fq * 16 + fr;
        PG8_LAS unsigned short* tl = (PG8_LAS unsigned short*)(stg + wave * 2048);
#pragma unroll
        for (int ai = 0; ai < 2; ++ai)
#pragma unroll
            for (int bj = 0; bj < 2; ++bj) {
                const int gcol = u.pn * BM + bj * HALF + wc * 32 + 8 * fq;
                f32x4 g0[4], g1[4];
#pragma unroll
                for (int m = 0; m < 4; ++m) {
                    const f32x4 a = acc[ai][bj][m][0], b = acc[ai][bj][m][1];
                    g0[m] = (f32x4){gelu_tanh(a[0]), gelu_tanh(a[1]), gelu_tanh(a[2]), gelu_tanh(a[3])};
                    g1[m] = (f32x4){gelu_tanh(b[0]), gelu_tanh(b[1]), gelu_tanh(b[2]), gelu_tanh(b[3])};
                }
                if (gcol < CW) {
#pragma unroll
                    for (int m = 0; m < 4; ++m) {
                        u32x4 w; w.x = pack2(g0[m][0], g0[m][1]); w.y = pack2(g0[m][2], g0[m][3]); w.z = pack2(g1[m][0], g1[m][1]); w.w = pack2(g1[m][2], g1[m][3]);
                        *(u32x4*)(zu + (size_t)(u.pm * BM + ai * HALF + wr * 64 + m * 16 + fr) * CW + gcol) = w;
                    }
                } else {
                    const int vcol = gcol - CW;
#pragma unroll
                    for (int m = 0; m < 4; ++m) {
                        float t = g0[m][0] * g0[m][0] + g0[m][1] * g0[m][1] + g0[m][2] * g0[m][2] + g0[m][3] * g0[m][3]
                                + g1[m][0] * g1[m][0] + g1[m][1] * g1[m][1] + g1[m][2] * g1[m][2] + g1[m][3] * g1[m][3];
                        t += __shfl_xor(t, 16); t += __shfl_xor(t, 32);
                        if (fq == 0) ssq[(size_t)(u.pm * BM + ai * HALF + wr * 64 + m * 16 + fr) * 64 + (vcol >> 5)] = t;
                    }
#pragma unroll
                    for (int h = 0; h < 2; ++h) {
#pragma unroll
                        for (int mm = 0; mm < 2; ++mm) {
                            const int m = 2 * h + mm, rl = 16 * mm + fr;
#pragma unroll
                            for (int j = 0; j < 4; ++j) { tl[(8 * fq + j) * 32 + rl] = f2bf(g0[m][j]); tl[(8 * fq + 4 + j) * 32 + rl] = f2bf(g1[m][j]); }
                        }
                        const int c = lane >> 1, hh = lane & 1;
                        const u32x4 w0 = *(const PG8_LAS u32x4*)(tl + c * 32 + hh * 16), w1 = *(const PG8_LAS u32x4*)(tl + c * 32 + hh * 16 + 8);
                        bf16_t* dst = zvt + ((size_t)(2 * u.pm + ai) * CW + (u.pn * BM - CW) + bj * HALF + wc * 32 + c) * 128 + wr * 64 + 32 * h + hh * 16;
                        *(u32x4*)dst = w0; *(u32x4*)(dst + 8) = w1;
                        asm volatile("" ::: "memory");
                    }
                }
            }
    }
};
struct EpiQ {
    static constexpr bool PERM = true, AFTER_DRAIN = false;
    bf16_t* q;
    __device__ __forceinline__ void operator()(const f32x4 (&acc)[2][2][4][2], const Unit& u, int wr, int wc, int fr, int fq) const {
#pragma unroll
        for (int ai = 0; ai < 2; ++ai)
#pragma unroll
            for (int m = 0; m < 4; ++m)
#pragma unroll
                for (int bj = 0; bj < 2; ++bj) {
                    const f32x4 a = acc[ai][bj][m][0], b = acc[ai][bj][m][1];
                    u32x4 w; w.x = pack2(a[0], a[1]); w.y = pack2(a[2], a[3]); w.z = pack2(b[0], b[1]); w.w = pack2(b[2], b[3]);
                    *(u32x4*)(q + (size_t)(u.pm * BM + ai * HALF + wr * 64 + m * 16 + fr) * 2048 + u.pn * BM + bj * HALF + wc * 32 + 8 * fq) = w;
                }
    }
};
}
DI void run_gemmq_pg8(const Params& p, int l, unsigned char* smem) {
    volatile LAS unsigned* st = (volatile LAS unsigned*)(smem + SMEM_BYTES);
    pg8::XcdOrder S; S.init(NTOK / 256, 2048 / 256, (int)st[0], (int)st[1], (int)st[2], (int)st[3]);
    const pg8::Gemm g{WSP(bf16_t, WS_XN), WSP(bf16_t, WS_W_PQ) + (size_t)l * 2048 * DM, NTOK, 2048, DM};
    pg8::EpiQ E; E.q = WSP(bf16_t, WS_QBUF);
    __syncthreads();
    pg8::gemm_phase<pg8::EpiQ, pg8::XcdOrder, true, true>((PG8_LAS unsigned char*)smem, g, S, E);
}
template <int WHICH>
DI void run_gemm_pg8(const Params& p, unsigned char* smem) {
    volatile LAS unsigned* st = (volatile LAS unsigned*)(smem + SMEM_BYTES);
    pg8::XcdOrder S; S.init(NTOK / 256, DM / 256, (int)st[0], (int)st[1], (int)st[2], (int)st[3]);
    pg8::Gemm g;
    pg8::EpiResid E;
    if (WHICH == 0) { g = pg8::Gemm{WSP(bf16_t, WS_MIXED), WSP(bf16_t, WS_W_ATTOUT), NTOK, DM, DM}; E.resid = p.in[0]; E.out = p.out; }
    else { g = pg8::Gemm{WSP(bf16_t, WS_Z_U), WSP(bf16_t, WS_W_SGUOUT), NTOK, DM, CW}; E.resid = p.out; E.out = p.out; }
    __syncthreads();
    pg8::gemm_phase<pg8::EpiResid, pg8::XcdOrder, true, true>((PG8_LAS unsigned char*)smem, g, S, E);
}

DI void run_gemm1_pg8(const Params& p, unsigned char* smem) {
    volatile LAS unsigned* st = (volatile LAS unsigned*)(smem + SMEM_BYTES);
    pg8::XcdOrder S; S.init(NTOK / 256, ATT_IN / 256, (int)st[0], (int)st[1], (int)st[2], (int)st[3]);
    const pg8::Gemm g{WSP(bf16_t, WS_XN), WSP(bf16_t, WS_W_ATTIN), NTOK, ATT_IN, DM};
    pg8::EpiProj E; E.aq = p.in[3]; E.ak = p.in[4]; E.bq = p.in[5]; E.bk = p.in[6]; E.proj = WSP(bf16_t, WS_PROJ); E.xs = (PG8_LAS float*)(smem + PG8_EXTRA);
    __syncthreads();
    pg8::gemm_phase<pg8::EpiProj, pg8::XcdOrder, true, true>((PG8_LAS unsigned char*)smem, g, S, E);
}
DI void run_gemm4_pg8(const Params& p, unsigned char* smem) {
    volatile LAS unsigned* st = (volatile LAS unsigned*)(smem + SMEM_BYTES);
    pg8::XcdOrder S; S.init(NTOK / 256, 4096 / 256, (int)st[0], (int)st[1], (int)st[2], (int)st[3]);
    const pg8::Gemm g{WSP(bf16_t, WS_XN), WSP(bf16_t, WS_W_SGUIN), NTOK, 4096, DM};
    pg8::EpiSgu E; E.zu = WSP(bf16_t, WS_Z_U); E.zvt = WSP(bf16_t, WS_Z_VT); E.ssq = WSP(float, WS_SSQ); E.stg = (PG8_LAS unsigned char*)(smem + PG8_EXTRA);
    __syncthreads();
    pg8::gemm_phase<pg8::EpiSgu, pg8::XcdOrder, true, true>((PG8_LAS unsigned char*)smem, g, S, E);
}

DI u32 cand_key(float s, int ci) { return (f2ord(s) & ~255u) | (u32)(255 - ci); }
template <int P>
DI void score_half(const bf16_t* __restrict__ qrow, const bf16_t* __restrict__ skh, int fr, int fh, u32 (&lst)[16]) {
    bf16x8 qf[8];
#pragma unroll
    for (int ks = 0; ks < 8; ++ks) qf[ks] = *(const bf16x8*)(qrow + P * 128 + 16 * ks);
#pragma unroll
    for (int j = 0; j < 16; ++j) lst[j] = 0u;
#pragma unroll 1
    for (int kt = 0; kt < 4; ++kt) {
        f32x16 st;
#pragma unroll
        for (int r = 0; r < 16; ++r) st[r] = 0.f;
        const bf16_t* skr = skh + ((size_t)P * 128 + kt * 32 + fr) * 128 + 8 * fh;
#pragma unroll
        for (int ks = 0; ks < 8; ++ks) st = MFMA32(*(const bf16x8*)(skr + 16 * ks), qf[ks], st);
        u32 ks_[16];
#pragma unroll
        for (int r = 0; r < 16; ++r) ks_[r] = (f2ord(st[r]) & ~127u) | (u32)(127 - (kt * 32 + crow(r, fh)));
        sort16_desc(ks_);
        merge16_desc(lst, ks_);
    }
    u32 other[16];
#pragma unroll
    for (int j = 0; j < 16; ++j) other[j] = (u32)__shfl_xor((int)lst[j], 32);
    merge16_desc(lst, other);
}
DI void ph_score(const Params& p, int vb, int l, unsigned char* smem) {
    const int tid = otid(), wave = tid >> 6, lane = tid & 63, fr = lane & 31, fh = lane >> 5;
    const int it = vb * 4 + wave, tile = it >> 3, h = it & 7;
    const int tok = tile * 32 + fr;
    const bf16_t* qrow = WSP(bf16_t, WS_QBUF) + (size_t)tok * 2048 + h * 256 + 8 * fh;
    const bf16_t* skh = WSP(bf16_t, WS_W_SUBK) + ((size_t)l * 16 + h * 2) * 128 * 128;
    u32 L0[16], L1[16];
    score_half<0>(qrow, skh, fr, fh, L0);
    score_half<1>(qrow, skh, fr, fh, L1);
    LAS int* slot = (LAS int*)(smem + wave * (64 * 132)) + lane * 33;
    float s1[16], s2[16];
#pragma unroll
    for (int j = 0; j < 16; ++j) {
        s1[j] = ord2f(L0[j] & ~127u); s2[j] = ord2f(L1[j] & ~127u);
        slot[j] = 127 - (int)(L0[j] & 127u); slot[16 + j] = 127 - (int)(L1[j] & 127u);
    }
    u32 lst[16];
#pragma unroll
    for (int j = 0; j < 16; ++j) lst[j] = cand_key(s1[0] + s2[j], j);
#pragma unroll
    for (int i = 1; i < 5; ++i) {
        u32 row[16];
#pragma unroll
        for (int j = 0; j < 16; ++j) row[j] = ((i + 1) * (j + 1) <= 16) ? cand_key(s1[i] + s2[j], i * 16 + j) : 0u;
        merge16_desc(lst, row);
    }
#pragma unroll
    for (int i = 5; i < 16; ++i)
#pragma unroll
        for (int j = 0; j < 2; ++j)
            if ((i + 1) * (j + 1) <= 16) top16_insert(lst, cand_key(s1[i] + s2[j], i * 16 + j));
    float pv[16]; float sum = 0.f;
    const float mx = ord2f(lst[0] & ~255u);
#pragma unroll
    for (int j = 0; j < 16; ++j) { pv[j] = __expf(ord2f(lst[j] & ~255u) - mx); sum += pv[j]; }
    const float inv = 1.f / sum;
    int ev[16];
#pragma unroll
    for (int j = 0; j < 16; ++j) {
        const int ci = 255 - (int)(lst[j] & 255u);
        ev[j] = slot[ci >> 4] * 128 + slot[16 + (ci & 15)];
    }
    if (fh == 0) {
        int4* ro = (int4*)(WSP(int, WS_RIDX) + (size_t)tok * 128 + h * 16);
        float4* go = (float4*)(WSP(float, WS_RG) + (size_t)tok * 128 + h * 16);
#pragma unroll
        for (int q = 0; q < 4; ++q) {
            ro[q] = make_int4(ev[4 * q], ev[4 * q + 1], ev[4 * q + 2], ev[4 * q + 3]);
            go[q] = make_float4(pv[4 * q] * inv, pv[4 * q + 1] * inv, pv[4 * q + 2] * inv, pv[4 * q + 3] * inv);
        }
    }
}


DI void osm_update(f32x16& s, unsigned vm, float& m, float& lh, float& alpha) {
    float mx = -1e30f;
#pragma unroll
    for (int r = 0; r < 16; ++r) mx = ((vm >> r) & 1u) ? fmaxf(mx, s[r]) : mx;
    mx = fmaxf(mx, __shfl_xor(mx, 32));
    const float mn = fmaxf(m, mx);
    alpha = __expf(m - mn);
    float ls = 0.f;
#pragma unroll
    for (int r = 0; r < 16; ++r) { const float pe = ((vm >> r) & 1u) ? __expf(s[r] - mn) : 0.f; s[r] = pe; ls += pe; }
    lh = lh * alpha + ls; m = mn;
}
DI void osm_update_full(f32x16& s, float& m, float& lh, float& alpha) {
    float mx = s[0];
#pragma unroll
    for (int r = 1; r < 16; ++r) mx = fmaxf(mx, s[r]);
    mx = fmaxf(mx, __shfl_xor(mx, 32));
    const float mn = fmaxf(m, mx);
    alpha = __expf(m - mn);
    float ls = 0.f;
#pragma unroll
    for (int r = 0; r < 16; ++r) { const float pe = __expf(s[r] - mn); s[r] = pe; ls += pe; }
    lh = lh * alpha + ls; m = mn;
}
DI void tr_quad(const unsigned (&a)[4], unsigned hi_off, bf16x8 (&f)[4]) {
    s16x4 l0, h0, l1, h1, l2, h2, l3, h3;
    const unsigned b0 = a[0] + hi_off, b1 = a[1] + hi_off, b2 = a[2] + hi_off, b3 = a[3] + hi_off;
    asm volatile("ds_read_b64_tr_b16 %0, %8\n\tds_read_b64_tr_b16 %1, %9\n\tds_read_b64_tr_b16 %2, %10\n\tds_read_b64_tr_b16 %3, %11\n\t"
                 "ds_read_b64_tr_b16 %4, %12\n\tds_read_b64_tr_b16 %5, %13\n\tds_read_b64_tr_b16 %6, %14\n\tds_read_b64_tr_b16 %7, %15\n\ts_waitcnt lgkmcnt(0)"
                 : "=&v"(l0), "=&v"(h0), "=&v"(l1), "=&v"(h1), "=&v"(l2), "=&v"(h2), "=&v"(l3), "=&v"(h3)
                 : "v"(a[0]), "v"(b0), "v"(a[1]), "v"(b1), "v"(a[2]), "v"(b2), "v"(a[3]), "v"(b3) : "memory");
    f[0] = __builtin_shufflevector(l0, h0, 0, 1, 2, 3, 4, 5, 6, 7); f[1] = __builtin_shufflevector(l1, h1, 0, 1, 2, 3, 4, 5, 6, 7);
    f[2] = __builtin_shufflevector(l2, h2, 0, 1, 2, 3, 4, 5, 6, 7); f[3] = __builtin_shufflevector(l3, h3, 0, 1, 2, 3, 4, 5, 6, 7);
}

#define QB_BYTES (128 * 256)
#define KB_BYTES (32 * 256)
template <bool WITH_V>
DI void attnB_stage_kv(const bf16_t* __restrict__ kg  , unsigned char* Kd, unsigned char* Vd, int wave, int lane) {
#pragma unroll
    for (int i = 0; i < 2; ++i) {
        const int idx = wave * 2 + i;
        const int key = 4 * idx + (lane >> 4), cp = lane & 15;
        const bf16_t* g = kg + (size_t)key * ATT_IN;
        __builtin_amdgcn_global_load_lds((const unsigned*)(g + ((cp ^ (key & 15)) << 3)), (unsigned*)(Kd + idx * 1024 + lane * 16), 16, 0, 0);
        if (WITH_V) {
            const int cv = ((((cp >> 2) ^ (key & 3)) << 2) | (cp & 3));
            __builtin_amdgcn_global_load_lds((const unsigned*)(g + 512 + (cv << 3)), (unsigned*)(Vd + idx * 1024 + lane * 16), 16, 0, 0);
        }
    }
}
template <int KOFF, bool FULL>
DI void attnB_map(const unsigned char* Kc, const unsigned char* qlp, int ksw, int qsw, int fh, unsigned vm, unsigned vc, int tq,
                  float& m, float& l, f32x16 (&o)[4]) {
    f32x16 st;
#pragma unroll
    for (int r = 0; r < 16; ++r) st[r] = 0.f;
#pragma unroll
    for (int s = 0; s < 4; ++s) {
        const bf16x8 kf = *(const bf16x8*)(Kc + (((KOFF + 2 * s + fh) ^ ksw) << 4));
        const bf16x8 qf = *(const bf16x8*)(qlp + (((KOFF + 2 * s + fh) ^ qsw) << 4));
        st = MFMA32(kf, qf, st);
    }
    float al;
    if (FULL) osm_update_full(st, m, l, al); else osm_update(st, vm, m, l, al);
    if (!__all(al == 1.f)) {
#pragma unroll
        for (int d = 0; d < 4; ++d)
#pragma unroll
            for (int r = 0; r < 16; ++r) o[d][r] *= al;
    }
#pragma unroll
    for (int s = 0; s < 2; ++s) {
        const bf16x8 pf = pack_p(st, s);
        unsigned va[4]; bf16x8 vf[4];
#pragma unroll
        for (int d = 0; d < 4; ++d) va[d] = vc + s * 16 * 256 + ((d ^ tq) << 6);
        tr_quad(va, 8 * 256, vf);
#pragma unroll
        for (int d = 0; d < 4; ++d) o[d] = MFMA32(vf[d], pf, o[d]);
    }
}
DI void ph_attnB_fast(const Params& p, int item, unsigned char* smem) {
    const bf16_t* proj = WSP(bf16_t, WS_PROJ);
    const int tid = otid(), wave = tid >> 6, lane = tid & 63, fr = lane & 31, fh = lane >> 5;
    const int qt = 15 - (item >> 6), bh = item & 63, b = bh >> 2, h = bh & 3;
    const int q0 = qt * 128;
    const float lam = compute_lam(p, lane);
    const size_t rowbase = (size_t)b * SEQ;
    const int qrow = wave * 32 + fr, qpos = q0 + qrow;
    unsigned char* Ql = smem;
    unsigned char* Kl = smem + QB_BYTES;
    unsigned char* Vl = Kl + 2 * KB_BYTES;
    const bf16_t* kbase = proj + rowbase * ATT_IN + 2048 + h * 128;
    __syncthreads();
#pragma unroll
    for (int i = 0; i < 8; ++i) {
        const int idx = wave * 8 + i;
        const int row = 4 * idx + (lane >> 4), cp = lane & 15;
        __builtin_amdgcn_global_load_lds((const unsigned*)(proj + (rowbase + q0 + row) * ATT_IN + 1536 + h * 128 + ((cp ^ (row & 15)) << 3)),
                                         (unsigned*)(Ql + idx * 1024 + lane * 16), 16, 0, 0);
    }
    attnB_stage_kv<true>(kbase, Kl, Vl, wave, lane);
    const unsigned char* qlp = Ql + qrow * 256;
    const int qsw = qrow & 15, ksw = fr & 15;
    const int nkt = (q0 + 128) / 32;
    const int wlast = q0 + wave * 32 + 31;
    f32x16 o1[4], o2[4];
#pragma unroll
    for (int d = 0; d < 4; ++d)
#pragma unroll
        for (int r = 0; r < 16; ++r) { o1[d][r] = 0.f; o2[d][r] = 0.f; }
    float m1 = -1e30f, m2 = -1e30f, l1 = 0.f, l2 = 0.f;
    const int tq = (lane & 15) >> 2;
    const unsigned vrow = (unsigned)(uintptr_t)Vl + (4 * fh + tq) * 256 + (16 * ((lane >> 4) & 1) + 4 * (lane & 3)) * 2;
    asm volatile("s_waitcnt vmcnt(0)" ::: "memory");
    __syncthreads();
    for (int kt = 0; kt < nkt; ++kt) {
        const int cur = kt & 1;
        if (kt + 1 < nkt) attnB_stage_kv<true>(kbase + (size_t)(kt + 1) * 32 * ATT_IN, Kl + (cur ^ 1) * KB_BYTES, Vl + (cur ^ 1) * KB_BYTES, wave, lane);
        if (kt * 32 <= wlast) {
            const unsigned char* Kc = Kl + cur * KB_BYTES + fr * 256;
            const unsigned vc = vrow + cur * KB_BYTES;
            if (kt * 32 + 31 <= wlast - 31) {
                attnB_map<0, true>(Kc, qlp, ksw, qsw, fh, 0xffffu, vc, tq, m1, l1, o1);
                __builtin_amdgcn_sched_barrier(0);
                attnB_map<8, true>(Kc, qlp, ksw, qsw, fh, 0xffffu, vc, tq, m2, l2, o2);
            } else {
                unsigned vm = 0;
#pragma unroll
                for (int r = 0; r < 16; ++r) vm |= ((kt * 32 + crow(r, fh)) <= qpos) ? (1u << r) : 0u;
                attnB_map<0, false>(Kc, qlp, ksw, qsw, fh, vm, vc, tq, m1, l1, o1);
                __builtin_amdgcn_sched_barrier(0);
                attnB_map<8, false>(Kc, qlp, ksw, qsw, fh, vm, vc, tq, m2, l2, o2);
            }
        }
        asm volatile("s_waitcnt vmcnt(0)" ::: "memory");
        __syncthreads();
    }
    l1 += __shfl_xor(l1, 32); l2 += __shfl_xor(l2, 32);
    const float i1 = 1.f / l1, i2 = lam / l2;
    float ss = 0.f;
#pragma unroll
    for (int d = 0; d < 4; ++d)
#pragma unroll
        for (int r = 0; r < 16; ++r) { const float v = o1[d][r] * i1 - o2[d][r] * i2; o1[d][r] = v; ss += v * v; }
    ss += __shfl_xor(ss, 32);
    const float rinv = rsqrtf(ss * (1.f / 128.f) + EPSN) * 0.8f;
    const float* subg = p.in[11];
    bf16_t* op = WSP(bf16_t, WS_MIXED) + (rowbase + qpos) * DM + 512 + h * 128;
#pragma unroll
    for (int d = 0; d < 4; ++d)
#pragma unroll
        for (int g = 0; g < 4; ++g) {
            const int dim = 32 * d + 8 * g + 4 * fh;
            const float4 gg = *(const float4*)(subg + dim);
            uint2 w;
            w.x = pack2(o1[d][4 * g + 0] * rinv * gg.x, o1[d][4 * g + 1] * rinv * gg.y);
            w.y = pack2(o1[d][4 * g + 2] * rinv * gg.z, o1[d][4 * g + 3] * rinv * gg.w);
            *(uint2*)(op + dim) = w;
        }
}

#define KA_PITCH 128
#define VA_PITCH 192
#define WA_BYTES (32 * KA_PITCH + 32 * VA_PITCH)
template <int MODE>
DI void ph_attnA_fast(const Params& p, int item, unsigned char* smem) {
    const bf16_t* proj = WSP(bf16_t, WS_PROJ);
    const int tid = otid(), wave = tid >> 6, lane = tid & 63, fr = lane & 31, fh = lane >> 5;
    const int c = item & 15, h = (item >> 4) & 7, b = item >> 7;
    const size_t rowbase = (size_t)b * SEQ;
    const int qpos = MODE == 0 ? 128 * c + 32 * wave + fr : 16 * (32 * wave + fr) + c;
    const int pmin = MODE == 0 ? 128 * c + 32 * wave : 512 * wave + c, pmax = pmin + (MODE == 0 ? 31 : 496);
    bf16x8 qf[4];
    {
        const bf16_t* qp = proj + (rowbase + qpos) * ATT_IN + h * 64 + 8 * fh;
#pragma unroll
        for (int s = 0; s < 4; ++s) qf[s] = *(const bf16x8*)(qp + 16 * s);
    }
    f32x16 o[2];
#pragma unroll
    for (int d = 0; d < 2; ++d)
#pragma unroll
        for (int r = 0; r < 16; ++r) o[d][r] = 0.f;
    float m = -1e30f, l = 0.f;
    unsigned char* Kl = smem + wave * WA_BYTES;
    unsigned char* Vl = Kl + 32 * KA_PITCH;
    const unsigned vaddr = (unsigned)(uintptr_t)Vl + (4 * fh + ((lane & 15) >> 2)) * VA_PITCH + (16 * ((lane >> 4) & 1) + 4 * (lane & 3)) * 2;
    const int skey = lane >> 3, sc = lane & 7;
    __syncthreads();
    int br = 0, d = MODE == 0 ? 1 : 16, W = MODE == 0 ? 128 : 2048, cls = MODE == 0 ? 0 : (c & 15);
    int j0 = MODE == 0 ? (pmin < 128 ? 0 : pmin - 128) : 0, jhi = MODE == 0 ? pmax : ((pmax - cls) >> 4);
    const bf16_t* kvbase = proj + rowbase * ATT_IN + 512 + h * 64 + sc * 8;
    uint4 rk0, rk1, rk2, rk3, rv0, rv1, rv2, rv3;
#define A_LOAD(i, RK, RV) do { int kp_ = cls + d * (j0 + skey + 8 * (i)); kp_ = kp_ > SEQ - 1 ? SEQ - 1 : kp_; kp_ = kp_ < 0 ? 0 : kp_; \
        const bf16_t* g_ = kvbase + (size_t)kp_ * ATT_IN; RK = *(const uint4*)g_; RV = *(const uint4*)(g_ + 512); } while (0)
#define A_WRITE(i, RK, RV) do { const int key_ = skey + 8 * (i); *(uint4*)(Kl + key_ * KA_PITCH + ((sc ^ ((key_ >> 1) & 7)) << 4)) = RK; \
        *(uint4*)(Vl + key_ * VA_PITCH + sc * 16) = RV; } while (0)
    A_LOAD(0, rk0, rv0); A_LOAD(1, rk1, rv1); A_LOAD(2, rk2, rv2); A_LOAD(3, rk3, rv3);
#pragma unroll 1
    for (;;) {
        A_WRITE(0, rk0, rv0); A_WRITE(1, rk1, rv1); A_WRITE(2, rk2, rv2); A_WRITE(3, rk3, rv3);
        const int cd = d, cW = W, ccls = cls, cj0 = j0;
        bool more = true;
        j0 += 32;
        if (j0 > jhi) {
            ++br;
            if (MODE == 0 || br == 2) more = false;
            else {
                d = 4; W = 512; cls = c & 3;
                const int lo = pmin - cls - W;
                j0 = lo < 0 ? 0 : lo >> 2;
                jhi = (pmax - cls) >> 2;
            }
        }
        A_LOAD(0, rk0, rv0); A_LOAD(1, rk1, rv1); A_LOAD(2, rk2, rv2); A_LOAD(3, rk3, rv3);
        f32x16 st;
#pragma unroll
        for (int r = 0; r < 16; ++r) st[r] = 0.f;
#pragma unroll
        for (int s = 0; s < 4; ++s) {
            const bf16x8 kf = *(const bf16x8*)(Kl + fr * KA_PITCH + (((2 * s + fh) ^ ((fr >> 1) & 7)) << 4));
            st = MFMA32(kf, qf[s], st);
        }
        float al;
        const int kfirst = ccls + cd * cj0, klast = kfirst + cd * 31;
        if (klast <= pmin && pmax - kfirst <= cW) osm_update_full(st, m, l, al);
        else {
            unsigned vm = 0;
#pragma unroll
            for (int r = 0; r < 16; ++r) {
                const int dist = qpos - (ccls + cd * (cj0 + crow(r, fh)));
                vm |= (dist >= 0 && dist <= cW) ? (1u << r) : 0u;
            }
            osm_update(st, vm, m, l, al);
        }
        if (!__all(al == 1.f)) {
#pragma unroll
            for (int dd = 0; dd < 2; ++dd)
#pragma unroll
                for (int r = 0; r < 16; ++r) o[dd][r] *= al;
        }
        {
            unsigned va[4]; bf16x8 vf[4];
            va[0] = vaddr; va[1] = vaddr + 64; va[2] = vaddr + 16 * VA_PITCH; va[3] = vaddr + 16 * VA_PITCH + 64;
            tr_quad(va, 8 * VA_PITCH, vf);
            const bf16x8 p0 = pack_p(st, 0), p1 = pack_p(st, 1);
            o[0] = MFMA32(vf[0], p0, o[0]); o[1] = MFMA32(vf[1], p0, o[1]);
            o[0] = MFMA32(vf[2], p1, o[0]); o[1] = MFMA32(vf[3], p1, o[1]);
        }
        if (!more) break;
    }
    l += __shfl_xor(l, 32);
    bf16_t* op = WSP(bf16_t, WS_MIXED) + (rowbase + qpos) * DM + h * 64;
    float* lsep = WSP(float, WS_LSE1) + (rowbase + qpos) * 8 + h;
    if (MODE == 0) {
        const float il = 1.f / l;
        if (fh == 0) *lsep = m + __logf(l);
#pragma unroll
        for (int dd = 0; dd < 2; ++dd)
#pragma unroll
            for (int g = 0; g < 4; ++g) {
                const int dim = 32 * dd + 8 * g + 4 * fh;
                uint2 w;
                w.x = pack2(o[dd][4 * g + 0] * il, o[dd][4 * g + 1] * il);
                w.y = pack2(o[dd][4 * g + 2] * il, o[dd][4 * g + 3] * il);
                *(uint2*)(op + dim) = w;
            }
    } else {
        const float lse1 = *lsep;
        const float M = fmaxf(m, lse1);
        const float w23 = __expf(m - M), w1 = __expf(lse1 - M);
        const float iden = 1.f / (l * w23 + w1);
        const float a23 = w23 * iden, a1 = w1 * iden;
        uint2 prev[2][4];
#pragma unroll
        for (int dd = 0; dd < 2; ++dd)
#pragma unroll
            for (int g = 0; g < 4; ++g) prev[dd][g] = *(const uint2*)(op + 32 * dd + 8 * g + 4 * fh);
#pragma unroll
        for (int dd = 0; dd < 2; ++dd)
#pragma unroll
            for (int g = 0; g < 4; ++g) {
                const int dim = 32 * dd + 8 * g + 4 * fh;
                const float p0 = __uint_as_float(prev[dd][g].x << 16), p1 = __uint_as_float(prev[dd][g].x & 0xffff0000u);
                const float p2 = __uint_as_float(prev[dd][g].y << 16), p3 = __uint_as_float(prev[dd][g].y & 0xffff0000u);
                uint2 w;
                w.x = pack2(o[dd][4 * g + 0] * a23 + p0 * a1, o[dd][4 * g + 1] * a23 + p1 * a1);
                w.y = pack2(o[dd][4 * g + 2] * a23 + p2 * a1, o[dd][4 * g + 3] * a23 + p3 * a1);
                *(uint2*)(op + dim) = w;
            }
    }
}
#define NITEM_B 1024
#define NITEM_A 2048
DI void ph_attn_fast(const Params& p, int vb, unsigned char* smem) {
    if (vb < NITEM_B) {
        const int item = vb < 512 ? vb : 512 + (1023 - vb);
        ph_attnB_fast(p, item, smem);
    } else ph_attnA_fast<0>(p, vb - NITEM_B, smem);
}


DI void ph_spatial_fast(const Params& p, int item, unsigned char* smem) {
    const int tid = otid(), wave = tid >> 6, lane = tid & 63, fr = lane & 31, fh = lane >> 5;
    const int wm = wave >> 1, wn = wave & 1;
    const int chunk = item >> 3, g = item & 7;
    bf16_t* u = WSP(bf16_t, WS_Z_U);
    const bf16_t* vt = WSP(bf16_t, WS_Z_VT);
    const float* ssq = WSP(float, WS_SSQ);
    const float* wsp = p.in[16] + (size_t)g * 128 * 128;
    float* rinv = (float*)(smem + 66 * 1024);
    unsigned char* Bt = smem + 32768;
    __syncthreads();
    if (tid < 128) {
        const float4* sp = (const float4*)(ssq + (size_t)(chunk * 128 + tid) * 64);
        float sacc = 0.f;
#pragma unroll
        for (int j = 0; j < 16; ++j) { const float4 q = sp[j]; sacc += (q.x + q.y) + (q.z + q.w); }
        rinv[tid] = rsqrtf(sacc * (1.f / CW) + EPSN);
    }
    const size_t vrow0 = (size_t)chunk * CW + g * 256;
    stage_tile(vt, 128, (int)vrow0, 0, Bt, wave, lane);
    stage_tile(vt, 128, (int)vrow0, 64, Bt + 16384, wave, lane);
    __syncthreads();
#pragma unroll
    for (int i = 0; i < 8; ++i) {
        const int id = tid + 256 * i;
        const int t = id >> 4, sc = id & 15;
        const float4 w0 = *(const float4*)(wsp + t * 128 + sc * 8);
        const float4 w1 = *(const float4*)(wsp + t * 128 + sc * 8 + 4);
        const float4 r0 = *(const float4*)(rinv + sc * 8);
        const float4 r1 = *(const float4*)(rinv + sc * 8 + 4);
        const int s0 = sc * 8;
        uint4 o;
        o.x = pack2(s0 + 0 <= t ? w0.x * r0.x : 0.f, s0 + 1 <= t ? w0.y * r0.y : 0.f);
        o.y = pack2(s0 + 2 <= t ? w0.z * r0.z : 0.f, s0 + 3 <= t ? w0.w * r0.w : 0.f);
        o.z = pack2(s0 + 4 <= t ? w1.x * r1.x : 0.f, s0 + 5 <= t ? w1.y * r1.y : 0.f);
        o.w = pack2(s0 + 6 <= t ? w1.z * r1.z : 0.f, s0 + 7 <= t ? w1.w * r1.w : 0.f);
        const int kt = sc >> 3, c = sc & 7;
        *(uint4*)(smem + kt * 16384 + t * 128 + ((c ^ ((t >> 1) & 7)) << 4)) = o;
    }
#pragma unroll 1
    for (int nt = 0; nt < 2; ++nt) {
        asm volatile("s_waitcnt vmcnt(0)" ::: "memory");
        __syncthreads();
        f32x16 acc[2][2];
#pragma unroll
        for (int i = 0; i < 2; ++i)
#pragma unroll
            for (int j = 0; j < 2; ++j)
#pragma unroll
                for (int r = 0; r < 16; ++r) acc[i][j][r] = 0.f;
#pragma unroll
        for (int kt = 0; kt < 2; ++kt)
#pragma unroll
            for (int s = 0; s < 4; ++s) {
                bf16x8 a[2], b[2];
#pragma unroll
                for (int i = 0; i < 2; ++i) {
                    a[i] = lds_frag(smem + kt * 16384, wm * 64 + i * 32 + fr, 2 * s + fh);
                    b[i] = lds_frag(Bt + kt * 16384, wn * 64 + i * 32 + fr, 2 * s + fh);
                }
#pragma unroll
                for (int i = 0; i < 2; ++i)
#pragma unroll
                    for (int j = 0; j < 2; ++j) acc[i][j] = MFMA32(a[i], b[j], acc[i][j]);
            }
        __syncthreads();
        float* st = (float*)(Bt + wave * (32 * 65 * 4));
#pragma unroll
        for (int i = 0; i < 2; ++i) {
#pragma unroll
            for (int j = 0; j < 2; ++j)
#pragma unroll
                for (int r = 0; r < 16; ++r) st[crow(r, fh) * 65 + j * 32 + fr] = acc[i][j][r];
            const int t = wm * 64 + i * 32 + fr;
            const int c0 = g * 256 + nt * 128 + wn * 64 + fh * 32;
            bf16_t* up = u + (size_t)(chunk * 128 + t) * CW + c0;
            const float bias = p.in[17][g * 128 + t];
            const float* gn = p.in[15] + c0;
            uint4 ur[4];
#pragma unroll
            for (int q = 0; q < 4; ++q) ur[q] = ((const uint4*)up)[q];
#pragma unroll
            for (int q = 0; q < 4; ++q) {
                float uf[8]; unpack8(ur[q], uf);
                const float4 g0 = *(const float4*)(gn + 8 * q), g1 = *(const float4*)(gn + 8 * q + 4);
                const float gg[8] = {g0.x, g0.y, g0.z, g0.w, g1.x, g1.y, g1.z, g1.w};
                float ov[8];
#pragma unroll
                for (int e = 0; e < 8; ++e) ov[e] = uf[e] * (st[fr * 65 + fh * 32 + 8 * q + e] * gg[e] + bias);
                uint4 o; o.x = pack2(ov[0], ov[1]); o.y = pack2(ov[2], ov[3]); o.z = pack2(ov[4], ov[5]); o.w = pack2(ov[6], ov[7]);
                ((uint4*)up)[q] = o;
            }
        }
        if (nt == 0) {
            __syncthreads();
            stage_tile(vt, 128, (int)vrow0 + 128, 0, Bt, wave, lane);
            stage_tile(vt, 128, (int)vrow0 + 128, 64, Bt + 16384, wave, lane);
        }
    }
}

#define XB_TMO      128
#define XB_XCNT(j)  (256  + 64 * (j))
#define XB_XSUB(j)  (1280 + 64 * (j))
#define XB_XGEN(j)  (2304 + 64 * (j))
#define XB_TOP      3328
#define XB_TOPGEN   3392
#define XCD_BAR_WORDS 3456
#define XB_SPIN_CAP (1u << 22)
DI unsigned xb_ld(unsigned* p) { return __hip_atomic_load(p, __ATOMIC_RELAXED, __HIP_MEMORY_SCOPE_AGENT); }
DI unsigned xb_add(unsigned* p, unsigned v) { return __hip_atomic_fetch_add(p, v, __ATOMIC_RELAXED, __HIP_MEMORY_SCOPE_AGENT); }
DI unsigned xb_xcc_id() { return (unsigned)__builtin_amdgcn_s_getreg((3 << 11) | 20) & 0xFu; }
#define XB_SPIN(cond, bar) do { unsigned _sp = 0; while (cond) { __builtin_amdgcn_s_sleep(1); \
    if ((++_sp & 255u) == 0u) { if (xb_ld(&(bar)[XB_TMO])) break; if (_sp > XB_SPIN_CAP) { atomicAdd(&(bar)[XB_TMO], 1u); break; } } } } while (0)
struct XcdBarrier { unsigned* bar; unsigned x; volatile LAS unsigned* st; };
DI XcdBarrier xcd_barrier_post(unsigned* bar, volatile LAS unsigned* st) {
    XcdBarrier b; b.bar = bar; b.x = xb_xcc_id(); b.st = st;
    if (threadIdx.x == 0) st[2] = xb_add(&bar[XB_XCNT(b.x)], 1u);
    return b;
}
DI void xcd_barrier_complete(unsigned* bar, unsigned x, unsigned& nloc, unsigned& nx, unsigned& xi) {
    const unsigned G = gridDim.x * gridDim.y * gridDim.z;
    unsigned sum, cnt, mine, below, sp = 0u;
    for (;;) {
        sum = 0u; cnt = 0u; mine = 0u; below = 0u;
#pragma unroll
        for (unsigned j = 0; j < 16; ++j) { const unsigned c = xb_ld(&bar[XB_XCNT(j)]); sum += c; cnt += (c > 0u) ? 1u : 0u; mine = (j == x) ? c : mine; below += (c > 0u && j < x) ? 1u : 0u; }
        if (sum == G) break;
        __builtin_amdgcn_s_sleep(1);
        if ((++sp & 255u) == 0u) { if (xb_ld(&bar[XB_TMO])) break; if (sp > XB_SPIN_CAP) { atomicAdd(&bar[XB_TMO], 1u); break; } }
    }
    nloc = mine > 0u ? mine : 1u; nx = cnt > 0u ? cnt : 1u; xi = below;
}
DI void xcd_barrier(const XcdBarrier& b) {
    asm volatile("s_waitcnt vmcnt(0)" ::: "memory");
    __syncthreads();
    if (threadIdx.x == 0) {
        unsigned* bar = b.bar;
        __builtin_amdgcn_s_waitcnt(0);
        unsigned nloc = b.st[0], nx = b.st[1];
        if (nloc == 0u) { unsigned xi; xcd_barrier_complete(bar, b.x, nloc, nx, xi); b.st[0] = nloc; b.st[1] = nx; b.st[3] = xi; }
        const unsigned old = xb_add(&bar[XB_XSUB(b.x)], 1u);
        const unsigned gen = old / nloc;
        if (old + 1u == (gen + 1u) * nloc) {
            __builtin_amdgcn_fence(__ATOMIC_RELEASE, "agent");
            asm volatile("s_waitcnt vmcnt(0)" ::: "memory");
            const unsigned og = xb_add(&bar[XB_TOP], 1u);
            const unsigned tg = og / nx;
            if (og + 1u == (tg + 1u) * nx) xb_add(&bar[XB_TOPGEN], 1u);
            else XB_SPIN(xb_ld(&bar[XB_TOPGEN]) == tg, bar);
            __builtin_amdgcn_fence(__ATOMIC_ACQUIRE, "agent");
            xb_add(&bar[XB_XGEN(b.x)], 1u);
            asm volatile("s_waitcnt vmcnt(0)" ::: "memory");
        } else {
            XB_SPIN(xb_ld(&bar[XB_XGEN(b.x)]) == gen, bar);
            __builtin_amdgcn_fence(__ATOMIC_ACQUIRE, "agent");
            asm volatile("s_waitcnt vmcnt(0)" ::: "memory");
        }
    }
    __syncthreads();
}

enum { PH_PREP = 0, PH_GEMM1, PH_ATTN, PH_ATTN2, PH_GEMM2,
       PH_NORM_P0, PH_GEMMQ0, PH_SCORE0, PH_PDOWN0, PH_PCOMB0, PH_PUP0, PH_NORM_SGU,
       PH_GEMM4, PH_SPATIAL, PH_GEMM5,
       PH_NORM_P1, PH_GEMMQ1, PH_SCORE1, PH_PDOWN1, PH_PCOMB1, PH_PUP1, PH_COUNT };

__host__ __device__ constexpr int phase_nvb(int ph) {
    switch (ph) {
        case PH_PREP: return PREP_N;
        case PH_GEMM1: return (ATT_IN / 256) * (NTOK / 256);
        case PH_ATTN: return NITEM_B + NITEM_A;
        case PH_ATTN2: return NITEM_A;
        case PH_GEMM2: return (DM / 256) * (NTOK / 256);
        case PH_NORM_P0: case PH_NORM_P1: case PH_NORM_SGU: return NTOK / 4;
        case PH_GEMMQ0: case PH_GEMMQ1: return 16 * (NTOK / 256);
        case PH_SCORE0: case PH_SCORE1: return (NTOK / 32) * 8 / 4;
        case PH_PCOMB0: case PH_PCOMB1: return NTOK / 4;
        case PH_GEMM4: return (4096 / 256) * (NTOK / 256);
        case PH_SPATIAL: return 256 * 8;
        case PH_GEMM5: return (DM / 256) * (NTOK / 256);
    }
    return 0;
}

template <int PH>
DI void run_vb(const Params& p, int vb, unsigned char* smem) {
    if constexpr (PH == PH_PREP) ph_prep(p, vb, smem);
    else if constexpr (PH == PH_ATTN) ph_attn_fast(p, vb, smem);
    else if constexpr (PH == PH_ATTN2) ph_attnA_fast<1>(p, vb, smem);
    else if constexpr (PH == PH_NORM_P0 || PH == PH_NORM_P1) rmsnorm_rows<true>(p.out, p.in[19] + (PH == PH_NORM_P1 ? DM : 0), WSP(bf16_t, WS_XN), vb, WSP(signed char, WS_XQ), WSP(float, WS_XSC));
    else if constexpr (PH == PH_SCORE0 || PH == PH_SCORE1) ph_score(p, vb, PH == PH_SCORE1 ? 1 : 0, smem);
    else if constexpr (PH == PH_PCOMB0 || PH == PH_PCOMB1) ph_peer_comb(p, vb, PH == PH_PCOMB1 ? 1 : 0);
    else if constexpr (PH == PH_NORM_SGU) rmsnorm_rows<false>(p.out, p.in[13], WSP(bf16_t, WS_XN), vb);
    else if constexpr (PH == PH_SPATIAL) ph_spatial_fast(p, vb, smem);
}

template <int PH>
DI void run_phase(const Params& p, unsigned char* smem) {
    if constexpr (PH == PH_PDOWN0 || PH == PH_PDOWN1) run_peer_sliced<false>(p, PH == PH_PDOWN1 ? 1 : 0, smem);
    else if constexpr (PH == PH_PUP0 || PH == PH_PUP1) run_peer_sliced<true>(p, PH == PH_PUP1 ? 1 : 0, smem);
    else if constexpr (PH == PH_GEMMQ0 || PH == PH_GEMMQ1) run_gemmq_pg8(p, PH == PH_GEMMQ1 ? 1 : 0, smem);
    else if constexpr (PH == PH_GEMM1) run_gemm1_pg8(p, smem);
    else if constexpr (PH == PH_GEMM4) run_gemm4_pg8(p, smem);
    else if constexpr (PH == PH_GEMM2) run_gemm_pg8<0>(p, smem);
    else if constexpr (PH == PH_GEMM5) run_gemm_pg8<1>(p, smem);
    else {
        constexpr int nvb = phase_nvb(PH);
        const int g = threadIdx.x >> 8;
        for (int vb = 2 * blockIdx.x; vb < nvb; vb += 2 * gridDim.x)
            if (vb + g < nvb) run_vb<PH>(p, vb + g, smem + g * GROUP_SMEM);
    }
}

template <int PH>
DI void run_from(const Params& p, unsigned char* smem, cg::grid_group& grid, const XcdBarrier& xb) {
    run_phase<PH>(p, smem);
    if constexpr (PH + 1 < PH_COUNT) {
        if constexpr (PH == 1) grid.sync(); else xcd_barrier(xb);
        run_from<PH + 1>(p, smem, grid, xb);
    }
}

__global__ void __launch_bounds__(NTHREADS, 2) k_mega(Params p) {
    extern __shared__ __attribute__((aligned(16))) unsigned char smem[];
    cg::grid_group grid = cg::this_grid();
    volatile LAS unsigned* st = (volatile LAS unsigned*)(smem + SMEM_BYTES);
    if (threadIdx.x == 0) { st[0] = 0u; st[1] = 0u; st[2] = 0u; st[3] = 0u; }
    __syncthreads();
    const XcdBarrier xb = xcd_barrier_post((unsigned*)(p.ws + WS_CTL), st);
    run_from<0>(p, smem, grid, xb);
}


extern "C" void kernel_launch(void* const* d_in, const int* in_sizes, int n_in, void* d_out, int out_size, void* d_ws, size_t ws_size, hipStream_t stream) {
    if (n_in != 24 || ws_size < WS_NEED) { fprintf(stderr, "kernel_launch: unexpected n_in %d or ws_size %zu\n", n_in, ws_size); return; }
    static int grid_blocks = 0;
    if (!grid_blocks) {
        int dev = 0, cus = 0, per_cu = 0;
        (void)hipGetDevice(&dev);
        (void)hipDeviceGetAttribute(&cus, hipDeviceAttributeMultiprocessorCount, dev);
        (void)hipFuncSetAttribute((const void*)k_mega, hipFuncAttributeMaxDynamicSharedMemorySize, SMEM_ALLOC);
        (void)hipOccupancyMaxActiveBlocksPerMultiprocessor(&per_cu, (const void*)k_mega, NTHREADS, SMEM_ALLOC);
        if (per_cu > 1) per_cu = 1;
        if (per_cu < 1) { fprintf(stderr, "kernel_launch: occupancy query returned %d\n", per_cu); per_cu = 1; }
        grid_blocks = cus * per_cu;
    }
    Params p{};
    for (int i = 0; i < 24; ++i) p.in[i] = (const float*)d_in[i];
    p.out = (float*)d_out;
    p.ws = (unsigned char*)d_ws;
    void* args[] = {&p};
    if (hipMemsetAsync((unsigned char*)d_ws + WS_CTL, 0, XCD_BAR_WORDS * 4, stream) != hipSuccess) { fprintf(stderr, "kernel_launch: memset of the barrier words failed\n"); return; }
    hipError_t e = hipLaunchCooperativeKernel((const void*)k_mega, dim3(grid_blocks), dim3(NTHREADS), args, SMEM_ALLOC, stream);
    if (e != hipSuccess) fprintf(stderr, "cooperative launch failed: %s (grid %d)\n", hipGetErrorString(e), grid_blocks);
}
```

```cpp
#include <hip/hip_runtime.h>
#include <stdint.h>
#include <stdio.h>

#define NTOK   32768
#define DM     1024
#define SEQ    2048
#define NB     16
#define ATT_IN 3072
#define CW     2048
#define NEXP   16384
#define EPSN   1e-6f

typedef unsigned short bf16_t;
typedef unsigned int u32;

#define DI __device__ __forceinline__
#define LAS __attribute__((address_space(3)))

DI int otid() { int t = threadIdx.x & 255; asm volatile("" : "+v"(t)); return t; }
DI int otid512() { int t = threadIdx.x; asm volatile("" : "+v"(t)); return t; }
DI float bf2f(bf16_t v) { return __uint_as_float(((u32)v) << 16); }
typedef __bf16 bf16v2 __attribute__((ext_vector_type(2)));
DI bf16_t f2bf(float f) { const __bf16 h = (__bf16)f; return __builtin_bit_cast(bf16_t, h); }
DI u32 pack2(float lo, float hi) { bf16v2 v; v[0] = (__bf16)lo; v[1] = (__bf16)hi; return __builtin_bit_cast(u32, v); }
DI float gelu_tanh(float x) {
    const float y = 0.7978845608028654f * (x + 0.044715f * x * x * x);
    const float e = __expf(2.f * y);
    const float t = 1.f - 2.f / (e + 1.f);
    return 0.5f * x * (1.f + t);
}
DI float wave_sum(float v) {
#pragma unroll
    for (int o = 1; o < 64; o <<= 1) v += __shfl_xor(v, o);
    return v;
}
DI float wave_max(float v) {
#pragma unroll
    for (int o = 1; o < 64; o <<= 1) v = fmaxf(v, __shfl_xor(v, o));
    return v;
}
DI u32 f2ord(float f) { u32 u = __float_as_uint(f); return (u & 0x80000000u) ? ~u : (u | 0x80000000u); }
DI float ord2f(u32 o) { u32 u = (o & 0x80000000u) ? (o & 0x7fffffffu) : ~o; return __uint_as_float(u); }

#define MiB ((size_t)1 << 20)
#define WS_CTL      ((size_t)0)
#define WS_W_ATTIN  (1 * MiB)
#define WS_W_ATTOUT (7 * MiB)
#define WS_W_SGUIN  (9 * MiB)
#define WS_W_SGUOUT (17 * MiB)
#define WS_W_PQ     (21 * MiB)
#define WS_W_SUBK   (29 * MiB)
#define WS_DOWN     (32 * MiB)
#define WS_UP       (64 * MiB)
#define WS_DSC      (96 * MiB)
#define WS_USC      (96 * MiB + 128 * 1024)
#define WS_LSE1     (30 * MiB)
#define WS_XQ       (100 * MiB)
#define WS_XSC      (132 * MiB)
#define WS_XN       (160 * MiB)
#define WS_BIG      (224 * MiB)
#define WS_PROJ     (WS_BIG)
#define WS_MIXED    (WS_BIG + 192 * MiB)
#define WS_Z_U      (WS_BIG)
#define WS_Z_VT     (WS_BIG + 128 * MiB)
#define WS_RIDX     (WS_BIG + 32 * MiB)
#define WS_RG       (WS_BIG + 48 * MiB)
#define WS_QBUF     (WS_BIG + 64 * MiB)
#define WS_SSQ      (WS_BIG + 256 * MiB)
#define WS_NEED     (512 * MiB)

struct Params {
    const float* in[24];
    float* out;
    unsigned char* ws;
};

#include <hip/hip_cooperative_groups.h>
namespace cg = cooperative_groups;

#define GROUP_SMEM (68 * 1024)
#define PG8_EXTRA (128 * 1024)
#define SMEM_BYTES (144 * 1024)
#define SMEM_ALLOC (SMEM_BYTES + 16)
#define NTHREADS 512

#define WSP(T, off) ((T*)(p.ws + (off)))


DI void transpose_tile(const float* __restrict__ W, bf16_t* __restrict__ Wt, int K, int N, int t, unsigned char* smem) {
    float* tile = (float*)smem;
    const int tid = otid();
    const int ntn = N / 64;
    const int n0 = (t % ntn) * 64, k0 = (t / ntn) * 64;
    __syncthreads();
    {
        const int n4 = tid & 15, kr = tid >> 4;
#pragma unroll
        for (int i = 0; i < 4; ++i) {
            const int k = kr + 16 * i;
            const float4 v = *(const float4*)(W + (size_t)(k0 + k) * N + n0 + 4 * n4);
            tile[k * 65 + 4 * n4 + 0] = v.x; tile[k * 65 + 4 * n4 + 1] = v.y; tile[k * 65 + 4 * n4 + 2] = v.z; tile[k * 65 + 4 * n4 + 3] = v.w;
        }
    }
    __syncthreads();
    {
        const int n = tid >> 2, kc = tid & 3;
        float v[16];
#pragma unroll
        for (int j = 0; j < 16; ++j) v[j] = tile[(16 * kc + j) * 65 + n];
        uint4 o0, o1;
        o0.x = pack2(v[0], v[1]); o0.y = pack2(v[2], v[3]); o0.z = pack2(v[4], v[5]); o0.w = pack2(v[6], v[7]);
        o1.x = pack2(v[8], v[9]); o1.y = pack2(v[10], v[11]); o1.z = pack2(v[12], v[13]); o1.w = pack2(v[14], v[15]);
        uint4* dst = (uint4*)(Wt + (size_t)(n0 + n) * K + k0 + 16 * kc);
        dst[0] = o0; dst[1] = o1;
    }
}
DI void cvt_chunk(const float* __restrict__ src, bf16_t* __restrict__ dst, int c) {
    const size_t base = (size_t)c * 2048;
#pragma unroll
    for (int i = 0; i < 8; ++i) {
        const size_t idx = base + i * 256 + otid();
        const float4 v = ((const float4*)src)[idx];
        uint2 o; o.x = pack2(v.x, v.y); o.y = pack2(v.z, v.w);
        ((uint2*)dst)[idx] = o;
    }
}
DI int q8(float v) { int i = __float2int_rn(v); i = i > 127 ? 127 : i; i = i < -127 ? -127 : i; return i & 255; }
template <bool EMIT_Q>
DI void rmsnorm_rows(const float* __restrict__ x, const float* __restrict__ g, bf16_t* __restrict__ o, int vb, signed char* xq = nullptr, float* xsc = nullptr) {
    const int lane = otid() & 63;
    const int row = vb * 4 + (otid() >> 6);
    const float4* xr = (const float4*)(x + (size_t)row * DM);
    float4 v[4]; float ss = 0.f;
#pragma unroll
    for (int j = 0; j < 4; ++j) { v[j] = xr[lane + 64 * j]; ss += v[j].x * v[j].x + v[j].y * v[j].y + v[j].z * v[j].z + v[j].w * v[j].w; }
    ss = wave_sum(ss);
    const float rinv = rsqrtf(ss * (1.f / DM) + EPSN);
    uint2* orow = (uint2*)(o + (size_t)row * DM);
    float am = 0.f;
#pragma unroll
    for (int j = 0; j < 4; ++j) {
        const float4 gg = ((const float4*)g)[lane + 64 * j];
        v[j].x *= rinv * gg.x; v[j].y *= rinv * gg.y; v[j].z *= rinv * gg.z; v[j].w *= rinv * gg.w;
        uint2 w; w.x = pack2(v[j].x, v[j].y); w.y = pack2(v[j].z, v[j].w);
        orow[lane + 64 * j] = w;
        if (EMIT_Q) am = fmaxf(am, fmaxf(fmaxf(fabsf(v[j].x), fabsf(v[j].y)), fmaxf(fabsf(v[j].z), fabsf(v[j].w))));
    }
    if (EMIT_Q) {
        am = wave_max(am);
        const float sc = am > 0.f ? 127.f / am : 0.f;
        u32* qrow = (u32*)(xq + (size_t)row * DM);
#pragma unroll
        for (int j = 0; j < 4; ++j)
            qrow[lane + 64 * j] = (u32)q8(v[j].x * sc) | ((u32)q8(v[j].y * sc) << 8) | ((u32)q8(v[j].z * sc) << 16) | ((u32)q8(v[j].w * sc) << 24);
        if (lane == 0) xsc[row] = am * (1.f / 127.f);
    }
}
#define PREP_T0 (48 * 16)
#define PREP_T1 (PREP_T0 + 16 * 16)
#define PREP_T2 (PREP_T1 + 64 * 16)
#define PREP_T3 (PREP_T2 + 16 * 32)
#define PREP_T4 (PREP_T3 + 2 * 32 * 16)
#define PREP_C0 (PREP_T4 + 64)
#define PREP_C1 (PREP_C0 + 8192)
#define PREP_C2 (PREP_C1 + 8192)
#define PREP_N  (PREP_C2 + 8192)
template <bool INT8>
DI void fp8_rows(const float* __restrict__ src, unsigned char* __restrict__ dst, float* __restrict__ inv_scale, int vb) {
    const int lane = otid() & 63;
    const int row = vb * 4 + (otid() >> 6);
    const float4* sr = (const float4*)(src + (size_t)row * DM) + lane;
    float4 v[4]; float am = 0.f;
#pragma unroll
    for (int j = 0; j < 4; ++j) { v[j] = sr[64 * j]; am = fmaxf(am, fmaxf(fmaxf(fabsf(v[j].x), fabsf(v[j].y)), fmaxf(fabsf(v[j].z), fabsf(v[j].w)))); }
    am = wave_max(am);
    float sc, inv;
    if (INT8) { sc = am > 0.f ? 127.f / am : 0.f; inv = am * (1.f / 127.f); }
    else {
        int e = (int)((__float_as_uint(am) >> 23) & 255u) - 127;
        if (am == 0.f) e = 0;
        e = e < -100 ? -100 : e;
        sc = __uint_as_float((u32)(127 + 7 - e) << 23); inv = __uint_as_float((u32)(127 + e - 7) << 23);
    }
    unsigned char* drow = dst + (size_t)(row >> 14) * NEXP * DM + (size_t)(row & (NEXP - 1)) * 128;
#pragma unroll
    for (int j = 0; j < 4; ++j) {
        const int dim = 4 * (lane + 64 * j);
        u32 w;
        if (INT8) w = (u32)q8(v[j].x * sc) | ((u32)q8(v[j].y * sc) << 8) | ((u32)q8(v[j].z * sc) << 16) | ((u32)q8(v[j].w * sc) << 24);
        else { int t = __builtin_amdgcn_cvt_pk_fp8_f32(v[j].x * sc, v[j].y * sc, 0, false); t = __builtin_amdgcn_cvt_pk_fp8_f32(v[j].z * sc, v[j].w * sc, t, true); w = (u32)t; }
        *(u32*)(drow + (size_t)(dim >> 7) * NEXP * 128 + (dim & 127)) = w;
    }
    if (lane == 0) inv_scale[row] = inv;
}
DI void ph_prep(const Params& p, int vb, unsigned char* smem) {
    if (vb < PREP_T0) transpose_tile(p.in[2], WSP(bf16_t, WS_W_ATTIN), DM, ATT_IN, vb, smem);
    else if (vb < PREP_T1) transpose_tile(p.in[12], WSP(bf16_t, WS_W_ATTOUT), DM, DM, vb - PREP_T0, smem);
    else if (vb < PREP_T2) transpose_tile(p.in[14], WSP(bf16_t, WS_W_SGUIN), DM, 4096, vb - PREP_T1, smem);
    else if (vb < PREP_T3) transpose_tile(p.in[18], WSP(bf16_t, WS_W_SGUOUT), CW, DM, vb - PREP_T2, smem);
    else if (vb < PREP_T4) { const int t = vb - PREP_T3, l = t / 512; transpose_tile(p.in[20] + (size_t)l * DM * 2048, WSP(bf16_t, WS_W_PQ) + (size_t)l * 2048 * DM, DM, 2048, t % 512, smem); }
    else if (vb < PREP_C0) cvt_chunk(p.in[21], WSP(bf16_t, WS_W_SUBK), vb - PREP_T4);
    else if (vb < PREP_C1) fp8_rows<true>(p.in[22], p.ws + WS_DOWN, WSP(float, WS_DSC), vb - PREP_C0);
    else if (vb < PREP_C2) fp8_rows<false>(p.in[23], p.ws + WS_UP, WSP(float, WS_USC), vb - PREP_C1);
    else rmsnorm_rows<false>(p.in[0], p.in[1], WSP(bf16_t, WS_XN), vb - PREP_C2);
}

DI float compute_lam(const Params& p, int lane) {
    const float a = wave_sum(p.in[7][lane] * p.in[8][lane]);
    const float b = wave_sum(p.in[9][lane] * p.in[10][lane]);
    return __expf(a) - __expf(b) + 0.2f;
}
DI void ce_desc(u32& a, u32& b) { const u32 hi = max(a, b), lo = min(a, b); a = hi; b = lo; }
DI void sort16_desc(u32 (&v)[16]) {
#pragma unroll
    for (int k = 2; k <= 16; k <<= 1)
#pragma unroll
        for (int j = k >> 1; j > 0; j >>= 1)
#pragma unroll
            for (int i = 0; i < 16; ++i) {
                const int l = i ^ j;
                if (l > i) { if ((i & k) == 0) ce_desc(v[i], v[l]); else ce_desc(v[l], v[i]); }
            }
}
DI void merge16_desc(u32 (&a)[16], const u32 (&b)[16]) {
#pragma unroll
    for (int i = 0; i < 16; ++i) a[i] = max(a[i], b[15 - i]);
#pragma unroll
    for (int j = 8; j > 0; j >>= 1)
#pragma unroll
        for (int i = 0; i < 16; ++i) { const int l = i ^ j; if (l > i) ce_desc(a[i], a[l]); }
}
DI void top16_insert(u32 (&lst)[16], u32 x) {
#pragma unroll
    for (int j = 0; j < 16; ++j) { const u32 hi = max(lst[j], x); x = min(lst[j], x); lst[j] = hi; }
}
DI void unpack8(const uint4 v, float (&f)[8]) {
    f[0] = __uint_as_float(v.x << 16); f[1] = __uint_as_float(v.x & 0xffff0000u);
    f[2] = __uint_as_float(v.y << 16); f[3] = __uint_as_float(v.y & 0xffff0000u);
    f[4] = __uint_as_float(v.z << 16); f[5] = __uint_as_float(v.z & 0xffff0000u);
    f[6] = __uint_as_float(v.w << 16); f[7] = __uint_as_float(v.w & 0xffff0000u);
}
typedef float f32x2_t __attribute__((ext_vector_type(2)));
DI void unpack16fp8(const uint4 w, float (&f)[16]) {
    f32x2_t t;
    t = __builtin_amdgcn_cvt_pk_f32_fp8((int)w.x, false); f[0] = t[0]; f[1] = t[1];
    t = __builtin_amdgcn_cvt_pk_f32_fp8((int)w.x, true);  f[2] = t[0]; f[3] = t[1];
    t = __builtin_amdgcn_cvt_pk_f32_fp8((int)w.y, false); f[4] = t[0]; f[5] = t[1];
    t = __builtin_amdgcn_cvt_pk_f32_fp8((int)w.y, true);  f[6] = t[0]; f[7] = t[1];
    t = __builtin_amdgcn_cvt_pk_f32_fp8((int)w.z, false); f[8] = t[0]; f[9] = t[1];
    t = __builtin_amdgcn_cvt_pk_f32_fp8((int)w.z, true);  f[10] = t[0]; f[11] = t[1];
    t = __builtin_amdgcn_cvt_pk_f32_fp8((int)w.w, false); f[12] = t[0]; f[13] = t[1];
    t = __builtin_amdgcn_cvt_pk_f32_fp8((int)w.w, true);  f[14] = t[0]; f[15] = t[1];
}
struct PeerPre { int e[16]; uint4 xa, xb; float2 r; };
struct PeerRows { uint4 d[8]; float c[8]; };
template <bool UP>
DI PeerPre peer_prefetch(const Params& p, int tok, int sl, int lane) {
    PeerPre q;
    const int4* rix = (const int4*)(WSP(int, WS_RIDX) + (size_t)tok * 128 + 16 * (lane >> 3));
#pragma unroll
    for (int j = 0; j < 4; ++j) { const int4 t = rix[j]; q.e[4 * j] = t.x; q.e[4 * j + 1] = t.y; q.e[4 * j + 2] = t.z; q.e[4 * j + 3] = t.w; }
    if (UP) {
        q.r = *(const float2*)(p.out + (size_t)tok * DM + sl * 128 + 16 * (lane & 7) + 2 * (lane >> 3));
    } else {
        q.xa = *(const uint4*)(WSP(signed char, WS_XQ) + (size_t)tok * DM + sl * 128 + 16 * (lane & 7));
    }
    return q;
}
template <int HF, bool UP>
DI void peer_issue_rows(const Params& p, const unsigned char* tab, const PeerPre& q, int tok, int lane, PeerRows& R) {
    const unsigned dco = 16u * (unsigned)(lane & 7);
#pragma unroll
    for (int bi = 0; bi < 8; ++bi) R.d[bi] = *(const uint4*)(tab + ((unsigned)q.e[8 * HF + bi] * 128u + dco));
    if (UP) {
        const float4* cf = (const float4*)(WSP(float, WS_RG) + (size_t)tok * 128 + 16 * (lane >> 3) + 8 * HF);
        const float4 c0 = cf[0], c1 = cf[1];
        R.c[0] = c0.x; R.c[1] = c0.y; R.c[2] = c0.z; R.c[3] = c0.w; R.c[4] = c1.x; R.c[5] = c1.y; R.c[6] = c1.z; R.c[7] = c1.w;
    }
}
template <int HF>
DI void peer_down_half(const PeerPre& q, const PeerRows& R, float (&part)[16]) {
#pragma unroll
    for (int bi = 0; bi < 8; ++bi) {
        int a = __builtin_amdgcn_sdot4((int)R.d[bi].x, (int)q.xa.x, 0, false);
        a = __builtin_amdgcn_sdot4((int)R.d[bi].y, (int)q.xa.y, a, false);
        a = __builtin_amdgcn_sdot4((int)R.d[bi].z, (int)q.xa.z, a, false);
        a = __builtin_amdgcn_sdot4((int)R.d[bi].w, (int)q.xa.w, a, false);
        part[8 * HF + bi] = (float)a;
    }
}
DI void peer_down_fin(const Params& p, const float (&part)[16], int tok, int sl, int lane) {
    const bool b2 = lane & 4, b1 = lane & 2, b0 = lane & 1;
    float r8[8], r4[4], r2[2];
#pragma unroll
    for (int i = 0; i < 8; ++i) { const float snd = b2 ? part[i] : part[i + 8]; const float kp = b2 ? part[i + 8] : part[i]; r8[i] = kp + __shfl_xor(snd, 4); }
#pragma unroll
    for (int i = 0; i < 4; ++i) { const float snd = b1 ? r8[i] : r8[i + 4]; const float kp = b1 ? r8[i + 4] : r8[i]; r4[i] = kp + __shfl_xor(snd, 2); }
#pragma unroll
    for (int i = 0; i < 2; ++i) { const float snd = b0 ? r4[i] : r4[i + 2]; const float kp = b0 ? r4[i + 2] : r4[i]; r2[i] = kp + __shfl_xor(snd, 1); }
    float* pd = WSP(float, WS_QBUF) + ((size_t)tok * 8 + sl) * 128;
    *(float2*)(pd + 2 * lane) = make_float2(r2[0], r2[1]);
}
DI void ph_peer_comb(const Params& p, int vb, int l) {
    const int tid = otid(), lane = tid & 63;
    const int tok = vb * 4 + (tid >> 6);
    const float* pd = WSP(float, WS_QBUF) + (size_t)tok * 8 * 128;
    const int* rix = WSP(int, WS_RIDX) + (size_t)tok * 128;
    float* rgp = WSP(float, WS_RG) + (size_t)tok * 128;
    const float* dsc = WSP(float, WS_DSC) + (size_t)l * NEXP;
    const float* usc = WSP(float, WS_USC) + (size_t)l * NEXP;
    const float xs = WSP(float, WS_XSC)[tok];
#pragma unroll
    for (int hh = 0; hh < 2; ++hh) {
        const int k = lane + 64 * hh;
        float t = 0.f;
#pragma unroll
        for (int sl = 0; sl < 8; ++sl) t += pd[sl * 128 + k];
        const int e = rix[k];
        rgp[k] = rgp[k] * gelu_tanh(t * dsc[e] * xs) * usc[e];
    }
}
template <int HF>
DI void peer_up_half(const PeerPre& q, const PeerRows& R, float (&y)[16]) {
#pragma unroll
    for (int bi = 0; bi < 8; ++bi) {
        const float c = R.c[bi];
        float w[16]; unpack16fp8(R.d[bi], w);
#pragma unroll
        for (int i = 0; i < 16; ++i) y[i] += c * w[i];
        asm volatile("" : "+v"(y[0]), "+v"(y[1]), "+v"(y[2]), "+v"(y[3]), "+v"(y[4]), "+v"(y[5]), "+v"(y[6]), "+v"(y[7]), "+v"(y[8]), "+v"(y[9]), "+v"(y[10]), "+v"(y[11]), "+v"(y[12]), "+v"(y[13]), "+v"(y[14]), "+v"(y[15]));
    }
}
DI void peer_up_fin(const Params& p, const PeerPre& q, const float (&y)[16], int tok, int sl, int lane) {
    const int rg = lane >> 3, dc = lane & 7;
    const bool b5 = lane & 32, b4 = lane & 16, b3 = lane & 8;
    float r8[8], r4[4], r2[2];
#pragma unroll
    for (int i = 0; i < 8; ++i) { const float snd = b5 ? y[i] : y[i + 8]; const float kp = b5 ? y[i + 8] : y[i]; r8[i] = kp + __shfl_xor(snd, 32); }
#pragma unroll
    for (int i = 0; i < 4; ++i) { const float snd = b4 ? r8[i] : r8[i + 4]; const float kp = b4 ? r8[i + 4] : r8[i]; r4[i] = kp + __shfl_xor(snd, 16); }
#pragma unroll
    for (int i = 0; i < 2; ++i) { const float snd = b3 ? r4[i] : r4[i + 2]; const float kp = b3 ? r4[i + 2] : r4[i]; r2[i] = kp + __shfl_xor(snd, 8); }
    float2 v = q.r;
    v.x += r2[0]; v.y += r2[1];
    *(float2*)(p.out + (size_t)tok * DM + sl * 128 + 16 * dc + 2 * rg) = v;
}
template <bool UP>
DI void run_peer_sliced(const Params& p, int l, unsigned char* smem) {
    volatile LAS unsigned* st = (volatile LAS unsigned*)(smem + SMEM_BYTES);
    const int nloc = (int)st[0], nx = (int)st[1], rank = (int)st[2], xi = (int)st[3];
    const int tid = otid512(), lane = tid & 63, wave = tid >> 6;
    const int stride = nloc * 8;
#pragma unroll 1
    for (int sl = xi; sl < 8; sl += nx) {
        const unsigned char* tab = p.ws + (UP ? WS_UP : WS_DOWN) + (size_t)l * NEXP * DM + (size_t)sl * NEXP * 128;
        int tok = rank * 8 + wave;
        if (tok >= NTOK) continue;
        PeerPre qc = peer_prefetch<UP>(p, tok, sl, lane);
        PeerRows R;
        peer_issue_rows<0, UP>(p, tab, qc, tok, lane, R);
#pragma unroll 1
        for (; tok < NTOK; tok += stride) {
            const int tn = tok + stride < NTOK ? tok + stride : tok;
            const PeerPre qn = peer_prefetch<UP>(p, tn, sl, lane);
            float acc[16];
#pragma unroll
            for (int i = 0; i < 16; ++i) acc[i] = 0.f;
            PeerRows Rn;
            peer_issue_rows<1, UP>(p, tab, qc, tok, lane, Rn);
            __builtin_amdgcn_sched_barrier(0);
            if (UP) peer_up_half<0>(qc, R, acc); else peer_down_half<0>(qc, R, acc);
            __builtin_amdgcn_sched_barrier(0);
            peer_issue_rows<0, UP>(p, tab, qn, tn, lane, R);
            __builtin_amdgcn_sched_barrier(0);
            if (UP) { peer_up_half<1>(qc, Rn, acc); peer_up_fin(p, qc, acc, tok, sl, lane); }
            else { peer_down_half<1>(qc, Rn, acc); peer_down_fin(p, acc, tok, sl, lane); }
            __builtin_amdgcn_sched_barrier(0);
            qc = qn;
        }
    }
}


typedef short bf16x8 __attribute__((ext_vector_type(8)));
typedef float f32x16 __attribute__((ext_vector_type(16)));
#define MFMA32(a, b, c) __builtin_amdgcn_mfma_f32_32x32x16_bf16((a), (b), (c), 0, 0, 0)
typedef short s16x4 __attribute__((ext_vector_type(4)));
DI bf16x8 pack_p(const f32x16& pt, int s) {
    uint4 o;
    o.x = pack2(pt[8 * s + 0], pt[8 * s + 1]); o.y = pack2(pt[8 * s + 2], pt[8 * s + 3]);
    o.z = pack2(pt[8 * s + 4], pt[8 * s + 5]); o.w = pack2(pt[8 * s + 6], pt[8 * s + 7]);
    return __builtin_bit_cast(bf16x8, o);
}

DI void stage_tile(const bf16_t* __restrict__ g, int ld, int row0, int k0, unsigned char* lt, int wave, int lane) {
#pragma unroll
    for (int i = 0; i < 4; ++i) {
        const int inst = wave * 4 + i;
        const int row = inst * 8 + (lane >> 3);
        const int c = (lane & 7) ^ ((row >> 1) & 7);
        __builtin_amdgcn_global_load_lds((const unsigned*)(g + (size_t)(row0 + row) * ld + k0 + c * 8),
                                         (unsigned*)(lt + inst * 1024 + lane * 16), 16, 0, 0);
    }
}
DI bf16x8 lds_frag(const unsigned char* lt, int row, int c) {
    return *(const bf16x8*)(lt + row * 128 + ((c ^ ((row >> 1) & 7)) << 4));
}
DI int crow(int r, int fh) { return (r & 3) + 8 * (r >> 2) + 4 * fh; }

namespace pg8 {
#define PG8_LAS __attribute__((address_space(3)))
typedef float f32x4 __attribute__((ext_vector_type(4)));
typedef unsigned u32x4 __attribute__((ext_vector_type(4)));
constexpr int BM = 256, BK = 64, HALF = 128, HTB = HALF * BK * 2  , STAGE_BYTES = 8 * HTB;
__host__ __device__ __forceinline__ int lds_byte(int r, int c) { const int st = (r >> 4) * 2 + (c >> 5), rr = r & 15, cc = c & 31, ob = rr * 64 + cc * 2; return st * 1024 + (ob ^ (((ob >> 9) & 1) << 5)); }
__host__ __device__ __forceinline__ void stage_rc(int b, int& R, int& C) { const int st = b / 1024, sb = b % 1024, swz = sb ^ (((sb >> 9) & 1) << 5); R = (st >> 1) * 16 + swz / 64; C = (st & 1) * 32 + (swz % 64) / 2; }
__host__ __device__ __forceinline__ int perm32(int rho) { const int n = rho >> 4, i = rho & 15; return 8 * (i >> 2) + 4 * n + (i & 3); }
struct Unit { int pm, pn; };
struct Gemm { const bf16_t* A; const bf16_t* Bt; int M, N, K; };
struct XcdOrder {
    int ntn, nloc, nx, rank, xi, nown, total;
    __device__ __forceinline__ void init(int nmt, int ntn_, int nloc_, int nx_, int rank_, int xi_) {
        ntn = ntn_; nloc = nloc_; nx = nx_; rank = rank_; xi = xi_; nown = xi < nmt ? (nmt - xi + nx - 1) / nx : 0; total = nown * ntn; }
    __device__ __forceinline__ bool next(int i, Unit& u) const {
        const int t = rank + i * nloc; if (t >= total) return false;
        const int g4 = t / (4 * ntn), r = t - g4 * 4 * ntn;
        const int left = nown - 4 * g4, gs = left < 4 ? left : 4;
        const int nt = r / gs, mi = r - nt * gs;
        u.pm = (4 * g4 + mi) * nx + xi; u.pn = nt; return true;
    }
    __device__ __forceinline__ void a_ready(const Unit&) const {}
    __device__ __forceinline__ void done(const Unit&) const {}
};
template <class Epi, class Sched, bool ALIGN_EPI = false, bool SP2 = false>
__device__ __forceinline__ void gemm_phase(PG8_LAS unsigned char* lds, const Gemm g, const Sched& S, const Epi& E) {
    const int tid = otid512(), wid = __builtin_amdgcn_readfirstlane(tid >> 6), lane = tid & 63, wr = wid >> 2, wc = wid & 3, fr = lane & 15, fq = lane >> 4;
    const int K = g.K, nt = K / BK;
    unsigned voffA[2], voffB[2];
#pragma unroll
    for (int i = 0; i < 2; ++i) { int R, C; stage_rc(tid * 16 + i * 8192, R, C); const int Rb = Epi::PERM ? ((R & ~31) + perm32(R & 31)) : R;
        voffA[i] = (unsigned)(R * K + C) * 2u; voffB[i] = (unsigned)(Rb * K + C) * 2u; }
    const size_t kstep = (size_t)(BK * 2);
    const size_t hstep = (size_t)HALF * K * 2;
    const size_t tstep = 2 * hstep;
    const unsigned ldsw = (unsigned)wid * 1024u;
    const int aoff = lds_byte(wr * 64 + fr, fq * 8), boff = lds_byte(wc * 32 + fr, fq * 8);
#define PG8_SA(b, h) (((b) * 2 + (h)) * HTB)
#define PG8_SB(b, h) ((4 + (b) * 2 + (h)) * HTB)
#define PG8_STAGE(bufoff, gbase, voff) do { _Pragma("unroll") for (int _i = 0; _i < 2; ++_i) \
        __builtin_amdgcn_global_load_lds((const unsigned*)((const char*)(gbase) + (voff)[_i]), (PG8_LAS unsigned*)(lds + (bufoff) + ldsw + _i * 8192), 16, 0, 0); } while (0)
#define PG8_LDA(dst, b, h) do { _Pragma("unroll") for (int m = 0; m < 4; ++m) _Pragma("unroll") for (int k = 0; k < 2; ++k) dst[m][k] = *(const PG8_LAS bf16x8*)(lds + PG8_SA(b, h) + aoff + m * 2048 + k * 1024); } while (0)
#define PG8_LDB(dst, b, h) do { _Pragma("unroll") for (int n = 0; n < 2; ++n) _Pragma("unroll") for (int k = 0; k < 2; ++k) dst[n][k] = *(const PG8_LAS bf16x8*)(lds + PG8_SB(b, h) + boff + n * 2048 + k * 1024); } while (0)
#define PG8_MMA(ai, bj, At, Bt) do { __builtin_amdgcn_s_setprio(1); _Pragma("unroll") for (int m = 0; m < 4; ++m) _Pragma("unroll") for (int n = 0; n < 2; ++n) _Pragma("unroll") for (int k = 0; k < 2; ++k) \
        acc[ai][bj][m][n] = __builtin_amdgcn_mfma_f32_16x16x32_bf16(Bt[n][k], At[m][k], acc[ai][bj][m][n], 0, 0, 0); __builtin_amdgcn_s_setprio(0); } while (0)
#define PG8_WAIT_V(n) asm volatile("s_waitcnt vmcnt(" #n ")" ::: "memory")
#define PG8_WAIT_L(n) asm volatile("s_waitcnt lgkmcnt(" #n ")" ::: "memory")
#define PG8_BAR __builtin_amdgcn_s_barrier()
#define PG8_SCHED __builtin_amdgcn_sched_barrier(0)
    Unit cur, nxt; int ui = 0;
    if (!S.next(0, cur)) return;
    f32x4 acc[2][2][4][2];
#pragma unroll
    for (int a = 0; a < 2; ++a)
#pragma unroll
        for (int b = 0; b < 2; ++b)
#pragma unroll
            for (int m = 0; m < 4; ++m)
#pragma unroll
                for (int n = 0; n < 2; ++n) acc[a][b][m][n] = (f32x4){0.f, 0.f, 0.f, 0.f};
    bf16x8 At[4][2], B0[2][2], B1[2][2];
    const char* cA = (const char*)g.A + (size_t)cur.pm * tstep; const char* cB = (const char*)g.Bt + (size_t)cur.pn * tstep;
    S.a_ready(cur);
    if constexpr (SP2) {
        PG8_STAGE(PG8_SB(0, 0), cB, voffB); PG8_STAGE(PG8_SB(0, 1), cB + hstep, voffB); PG8_STAGE(PG8_SA(0, 0), cA, voffA); PG8_STAGE(PG8_SA(0, 1), cA + hstep, voffA);
        if (wr == 1) PG8_BAR;
        PG8_WAIT_V(2); PG8_BAR;
        PG8_STAGE(PG8_SB(1, 0), cB + kstep, voffB); PG8_STAGE(PG8_SA(1, 0), cA + kstep, voffA); PG8_STAGE(PG8_SB(1, 1), cB + hstep + kstep, voffB);
        PG8_WAIT_V(6); PG8_BAR;
    } else {
        PG8_STAGE(PG8_SB(0, 0), cB, voffB); PG8_STAGE(PG8_SA(0, 0), cA, voffA); PG8_STAGE(PG8_SB(0, 1), cB + hstep, voffB); PG8_STAGE(PG8_SA(0, 1), cA + hstep, voffA);
        if (wr == 1) PG8_BAR;
        PG8_WAIT_V(4); PG8_BAR;
        PG8_STAGE(PG8_SB(1, 0), cB + kstep, voffB); PG8_STAGE(PG8_SA(1, 0), cA + kstep, voffA); PG8_STAGE(PG8_SB(1, 1), cB + hstep + kstep, voffB);
        PG8_WAIT_V(6); PG8_BAR;
    }
    for (;;) {
        const bool has_next = S.next(ui + 1, nxt);
        const char* nA = has_next ? (const char*)g.A + (size_t)nxt.pm * tstep : cA; const char* nB = has_next ? (const char*)g.Bt + (size_t)nxt.pn * tstep : cB;
        for (int t = 0; t < nt; t += 2) {
            const bool last = (t == nt - 2);
            const char* a1 = cA + (size_t)(t + 1) * kstep;
            const char* a2 = last ? nA : cA + (size_t)(t + 2) * kstep; const char* b2 = last ? nB : cB + (size_t)(t + 2) * kstep;
            const char* a3 = a2 + kstep; const char* b3 = b2 + kstep;
            if (last && has_next) S.a_ready(nxt);
            if constexpr (SP2) {
            PG8_LDB(B0, 0, 0); PG8_LDB(B1, 0, 1); PG8_SCHED; PG8_LDA(At, 0, 0); PG8_STAGE(PG8_SA(1, 1), a1 + hstep, voffA);
            PG8_WAIT_V(8); PG8_WAIT_L(0); PG8_BAR; PG8_MMA(0, 0, At, B0); PG8_MMA(0, 1, At, B1); PG8_BAR; PG8_SCHED;
            PG8_LDA(At, 0, 1); PG8_STAGE(PG8_SB(0, 0), b2, voffB); PG8_STAGE(PG8_SB(0, 1), b2 + hstep, voffB); PG8_STAGE(PG8_SA(0, 0), a2, voffA);
            PG8_WAIT_V(8); PG8_WAIT_L(0); PG8_BAR; PG8_MMA(1, 0, At, B0); PG8_MMA(1, 1, At, B1); PG8_BAR; PG8_SCHED;
            PG8_LDB(B0, 1, 0); PG8_LDB(B1, 1, 1); PG8_SCHED; PG8_LDA(At, 1, 0); PG8_STAGE(PG8_SA(0, 1), a2 + hstep, voffA);
            PG8_WAIT_V(8); PG8_WAIT_L(0); PG8_BAR; PG8_MMA(0, 0, At, B0); PG8_MMA(0, 1, At, B1); PG8_BAR; PG8_SCHED;
            PG8_LDA(At, 1, 1); PG8_STAGE(PG8_SB(1, 0), b3, voffB); PG8_STAGE(PG8_SB(1, 1), b3 + hstep, voffB); PG8_STAGE(PG8_SA(1, 0), a3, voffA);
            PG8_WAIT_V(8); PG8_WAIT_L(0); PG8_BAR; PG8_MMA(1, 0, At, B0); PG8_MMA(1, 1, At, B1); PG8_BAR; PG8_SCHED;
            } else {
            PG8_LDB(B0, 0, 0); PG8_SCHED; PG8_LDA(At, 0, 0); PG8_STAGE(PG8_SA(1, 1), a1 + hstep, voffA);
            PG8_WAIT_L(8); PG8_BAR; PG8_WAIT_L(0); PG8_MMA(0, 0, At, B0); PG8_BAR; PG8_SCHED;
            PG8_LDB(B1, 0, 1); PG8_STAGE(PG8_SB(0, 0), b2, voffB);
            PG8_BAR; PG8_WAIT_L(0); PG8_MMA(0, 1, At, B1); PG8_BAR;
            PG8_LDA(At, 0, 1); PG8_STAGE(PG8_SA(0, 0), a2, voffA);
            PG8_BAR; PG8_WAIT_L(0); PG8_MMA(1, 0, At, B0); PG8_BAR; PG8_SCHED;
            PG8_STAGE(PG8_SB(0, 1), b2 + hstep, voffB);
            PG8_WAIT_V(6); PG8_BAR; PG8_MMA(1, 1, At, B1); PG8_BAR;
            PG8_LDB(B0, 1, 0); PG8_SCHED; PG8_LDA(At, 1, 0); PG8_STAGE(PG8_SA(0, 1), a2 + hstep, voffA);
            PG8_WAIT_L(8); PG8_BAR; PG8_WAIT_L(0); PG8_MMA(0, 0, At, B0); PG8_BAR; PG8_SCHED;
            PG8_LDB(B1, 1, 1); PG8_STAGE(PG8_SB(1, 0), b3, voffB);
            PG8_BAR; PG8_WAIT_L(0); PG8_MMA(0, 1, At, B1); PG8_BAR;
            PG8_LDA(At, 1, 1); PG8_STAGE(PG8_SA(1, 0), a3, voffA);
            PG8_BAR; PG8_WAIT_L(0); PG8_MMA(1, 0, At, B0); PG8_BAR; PG8_SCHED;
            PG8_STAGE(PG8_SB(1, 1), b3 + hstep, voffB);
            PG8_WAIT_V(6); PG8_BAR; PG8_MMA(1, 1, At, B1); PG8_BAR;
            }
        }
        if constexpr (ALIGN_EPI) { if (wr == 0) PG8_BAR; }
        if constexpr (!Epi::AFTER_DRAIN) { E(acc, cur, wr, wc, fr, fq); S.done(cur); }
        if (!has_next) break;
#pragma unroll
        for (int a = 0; a < 2; ++a)
#pragma unroll
            for (int b = 0; b < 2; ++b)
#pragma unroll
                for (int m = 0; m < 4; ++m)
#pragma unroll
                    for (int n = 0; n < 2; ++n) acc[a][b][m][n] = (f32x4){0.f, 0.f, 0.f, 0.f};
        cur = nxt; cA = nA; cB = nB; ++ui;
        if constexpr (ALIGN_EPI) { if (wr == 1) PG8_BAR; }
    }
    PG8_WAIT_V(0);
    if constexpr (!ALIGN_EPI) { if (wr == 0) PG8_BAR; }
    PG8_BAR;
    if constexpr (Epi::AFTER_DRAIN) { E.fused(acc, cur, wr, wc, fr, fq, lds, wid, lane); S.done(cur); }
#undef PG8_SA
#undef PG8_SB
#undef PG8_STAGE
#undef PG8_LDA
#undef PG8_LDB
#undef PG8_MMA
#undef PG8_WAIT_V
#undef PG8_WAIT_L
#undef PG8_BAR
#undef PG8_SCHED
}
struct EpiResid {
    static constexpr bool PERM = true, AFTER_DRAIN = false;
    const float* resid; float* out;
    __device__ __forceinline__ void operator()(const f32x4 (&acc)[2][2][4][2], const Unit& u, int wr, int wc, int fr, int fq) const {
        const size_t base = (size_t)(u.pm * BM + wr * 64 + fr) * DM + u.pn * BM + wc * 32 + 8 * fq;
#pragma unroll
        for (int ai = 0; ai < 2; ++ai) {
            f32x4 rv[4][2][2];
#pragma unroll
            for (int m = 0; m < 4; ++m)
#pragma unroll
                for (int bj = 0; bj < 2; ++bj) {
                    const float* rp = resid + base + (size_t)(ai * HALF + m * 16) * DM + bj * HALF;
                    rv[m][bj][0] = *(const f32x4*)rp; rv[m][bj][1] = *(const f32x4*)(rp + 4);
                }
            asm volatile("" ::: "memory");
#pragma unroll
            for (int m = 0; m < 4; ++m)
#pragma unroll
                for (int bj = 0; bj < 2; ++bj) {
                    float* op = out + base + (size_t)(ai * HALF + m * 16) * DM + bj * HALF;
                    *(f32x4*)op = rv[m][bj][0] + acc[ai][bj][m][0]; *(f32x4*)(op + 4) = rv[m][bj][1] + acc[ai][bj][m][1];
                }
            asm volatile("" ::: "memory");
        }
    }
};
struct EpiProj {
    static constexpr bool PERM = true, AFTER_DRAIN = false;
    const float* aq; const float* ak; const float* bq; const float* bk; bf16_t* proj; PG8_LAS float* xs;
    __device__ __forceinline__ void operator()(const f32x4 (&acc)[2][2][4][2], const Unit& u, int wr, int wc, int fr, int fq) const {
        const int wave = wr * 4 + wc;
#pragma unroll
        for (int ai = 0; ai < 2; ++ai)
#pragma unroll
            for (int m = 0; m < 4; ++m)
#pragma unroll
                for (int bj = 0; bj < 2; ++bj) {
                    const f32x4 a = acc[ai][bj][m][0], b = acc[ai][bj][m][1];
                    float t = a[0] * a[0] + a[1] * a[1] + a[2] * a[2] + a[3] * a[3] + b[0] * b[0] + b[1] * b[1] + b[2] * b[2] + b[3] * b[3];
                    t += __shfl_xor(t, 16); t += __shfl_xor(t, 32);
                    if (fq == 0) xs[wave * 256 + ((ai * 4 + m) * 2 + bj) * 16 + fr] = t;
                }
        asm volatile("s_waitcnt lgkmcnt(0)" ::: "memory");
        __builtin_amdgcn_s_barrier();
#pragma unroll
        for (int bj = 0; bj < 2; ++bj) {
            const int gcol = u.pn * BM + bj * HALF + wc * 32 + 8 * fq;
            const float* gain = nullptr; float scale = 1.f;
            if (gcol < 512) { gain = aq + (gcol & 63); scale = 0.125f; }
            else if (gcol < 1024) gain = ak + (gcol & 63);
            else if (gcol < 1536) gain = nullptr;
            else if (gcol < 2048) { gain = bq + (gcol & 127); scale = 0.125f; }
            else if (gcol < 2560) gain = bk + (gcol & 127);
            f32x4 g0 = {1.f, 1.f, 1.f, 1.f}, g1 = {1.f, 1.f, 1.f, 1.f};
            if (gain) { g0 = *(const f32x4*)gain; g1 = *(const f32x4*)(gain + 4); }
#pragma unroll
            for (int ai = 0; ai < 2; ++ai)
#pragma unroll
                for (int m = 0; m < 4; ++m) {
                    float sc = 1.f;
                    if (gain) {
                        const int slot = ((ai * 4 + m) * 2 + bj) * 16 + fr;
                        sc = rsqrtf((xs[wave * 256 + slot] + xs[(wave ^ 1) * 256 + slot]) * (1.f / 64.f) + EPSN) * scale;
                    }
                    const f32x4 v0 = acc[ai][bj][m][0] * g0 * sc, v1 = acc[ai][bj][m][1] * g1 * sc;
                    u32x4 w; w.x = pack2(v0[0], v0[1]); w.y = pack2(v0[2], v0[3]); w.z = pack2(v1[0], v1[1]); w.w = pack2(v1[2], v1[3]);
                    *(u32x4*)(proj + (size_t)(u.pm * BM + ai * HALF + wr * 64 + m * 16 + fr) * ATT_IN + gcol) = w;
                }
        }
    }
};
struct EpiSgu {
    static constexpr bool PERM = true, AFTER_DRAIN = false;
    bf16_t* zu; bf16_t* zvt; float* ssq; PG8_LAS unsigned char* stg;
    __device__ __forceinline__ void operator()(const f32x4 (&acc)[2][2][4][2], const Unit& u, int wr, int wc, int fr, int fq) const {
        const int wave = wr * 4 + wc, lane = fq * 16 + fr;
        PG8_LAS unsigned short* tl = (PG8_LAS unsigned short*)(stg + wave * 2048);
#pragma unroll
        for (int ai = 0; ai < 2; ++ai)
#pragma unroll
            for (int bj = 0; bj < 2; ++bj) {
                const int gcol = u.pn * BM + bj * HALF + wc * 32 + 8 * fq;
                f32x4 g0[4], g1[4];
#pragma unroll
                for (int m = 0; m < 4; ++m) {
                    const f32x4 a = acc[ai][bj][m][0], b = acc[ai][bj][m][1];
                    g0[m] = (f32x4){gelu_tanh(a[0]), gelu_tanh(a[1]), gelu_tanh(a[2]), gelu_tanh(a[3])};
                    g1[m] = (f32x4){gelu_tanh(b[0]), gelu_tanh(b[1]), gelu_tanh(b[2]), gelu_tanh(b[3])};
                }
                if (gcol < CW) {
#pragma unroll
                    for (int m = 0; m < 4; ++m) {
                        u32x4 w; w.x = pack2(g0[m][0], g0[m][1]); w.y = pack2(g0[m][2], g0[m][3]); w.z = pack2(g1[m][0], g1[m][1]); w.w = pack2(g1[m][2], g1[m][3]);
                        *(u32x4*)(zu + (size_t)(u.pm * BM + ai * HALF + wr * 64 + m * 16 + fr) * CW + gcol) = w;
                    }
                } else {
                    const int vcol = gcol - CW;
#pragma unroll
                    for (int m = 0; m < 4; ++m) {
                        float t = g0[m][0] * g0[m][0] + g0[m][1] * g0[m][1] + g0[m][2] * g0[m][2] + g0[m][3] * g0[m][3]
                                + g1[m][0] * g1[m][0] + g1[m][1] * g1[m][1] + g1[m][2] * g1[m][2] + g1[m][3] * g1[m][3];
                        t += __shfl_xor(t, 16); t += __shfl_xor(t, 32);
                        if (fq == 0) ssq[(size_t)(u.pm * BM + ai * HALF + wr * 64 + m * 16 + fr) * 64 + (vcol >> 5)] = t;
                    }
#pragma unroll
                    for (int h = 0; h < 2; ++h) {
#pragma unroll
                        for (int mm = 0; mm < 2; ++mm) {
                            const int m = 2 * h + mm, rl = 16 * mm + fr;
#pragma unroll
                            for (int j = 0; j < 4; ++j) { tl[(8 * fq + j) * 32 + rl] = f2bf(g0[m][j]); tl[(8 * fq + 4 + j) * 32 + rl] = f2bf(g1[m][j]); }
                        }
                        const int c = lane >> 1, hh = lane & 1;
                        const u32x4 w0 = *(const PG8_LAS u32x4*)(tl + c * 32 + hh * 16), w1 = *(const PG8_LAS u32x4*)(tl + c * 32 + hh * 16 + 8);
                        bf16_t* dst = zvt + ((size_t)(2 * u.pm + ai) * CW + (u.pn * BM - CW) + bj * HALF + wc * 32 + c) * 128 + wr * 64 + 32 * h + hh * 16;
                        *(u32x4*)dst = w0; *(u32x4*)(dst + 8) = w1;
                        asm volatile("" ::: "memory");
                    }
                }
            }
    }
};
struct EpiQ {
    static constexpr bool PERM = true, AFTER_DRAIN = false;
    bf16_t* q;
    __device__ __forceinline__ void operator()(const f32x4 (&acc)[2][2][4][2], const Unit& u, int wr, int wc, int fr, int fq) const {
#pragma unroll
        for (int ai = 0; ai < 2; ++ai)
#pragma unroll
            for (int m = 0; m < 4; ++m)
#pragma unroll
                for (int bj = 0; bj < 2; ++bj) {
                    const f32x4 a = acc[ai][bj][m][0], b = acc[ai][bj][m][1];
                    u32x4 w; w.x = pack2(a[0], a[1]); w.y = pack2(a[2], a[3]); w.z = pack2(b[0], b[1]); w.w = pack2(b[2], b[3]);
                    *(u32x4*)(q + (size_t)(u.pm * BM + ai * HALF + wr * 64 + m * 16 + fr) * 2048 + u.pn * BM + bj * HALF + wc * 32 + 8 * fq) = w;
                }
    }
};
}
DI void run_gemmq_pg8(const Params& p, int l, unsigned char* smem) {
    volatile LAS unsigned* st = (volatile LAS unsigned*)(smem + SMEM_BYTES);
    pg8::XcdOrder S; S.init(NTOK / 256, 2048 / 256, (int)st[0], (int)st[1], (int)st[2], (int)st[3]);
    const pg8::Gemm g{WSP(bf16_t, WS_XN), WSP(bf16_t, WS_W_PQ) + (size_t)l * 2048 * DM, NTOK, 2048, DM};
    pg8::EpiQ E; E.q = WSP(bf16_t, WS_QBUF);
    __syncthreads();
    pg8::gemm_phase<pg8::EpiQ, pg8::XcdOrder, true, true>((PG8_LAS unsigned char*)smem, g, S, E);
}
template <int WHICH>
DI void run_gemm_pg8(const Params& p, unsigned char* smem) {
    volatile LAS unsigned* st = (volatile LAS unsigned*)(smem + SMEM_BYTES);
    pg8::XcdOrder S; S.init(NTOK / 256, DM / 256, (int)st[0], (int)st[1], (int)st[2], (int)st[3]);
    pg8::Gemm g;
    pg8::EpiResid E;
    if (WHICH == 0) { g = pg8::Gemm{WSP(bf16_t, WS_MIXED), WSP(bf16_t, WS_W_ATTOUT), NTOK, DM, DM}; E.resid = p.in[0]; E.out = p.out; }
    else { g = pg8::Gemm{WSP(bf16_t, WS_Z_U), WSP(bf16_t, WS_W_SGUOUT), NTOK, DM, CW}; E.resid = p.out; E.out = p.out; }
    __syncthreads();
    pg8::gemm_phase<pg8::EpiResid, pg8::XcdOrder, true, true>((PG8_LAS unsigned char*)smem, g, S, E);
}

DI void run_gemm1_pg8(const Params& p, unsigned char* smem) {
    volatile LAS unsigned* st = (volatile LAS unsigned*)(smem + SMEM_BYTES);
    pg8::XcdOrder S; S.init(NTOK / 256, ATT_IN / 256, (int)st[0], (int)st[1], (int)st[2], (int)st[3]);
    const pg8::Gemm g{WSP(bf16_t, WS_XN), WSP(bf16_t, WS_W_ATTIN), NTOK, ATT_IN, DM};
    pg8::EpiProj E; E.aq = p.in[3]; E.ak = p.in[4]; E.bq = p.in[5]; E.bk = p.in[6]; E.proj = WSP(bf16_t, WS_PROJ); E.xs = (PG8_LAS float*)(smem + PG8_EXTRA);
    __syncthreads();
    pg8::gemm_phase<pg8::EpiProj, pg8::XcdOrder, true, true>((PG8_LAS unsigned char*)smem, g, S, E);
}
DI void run_gemm4_pg8(const Params& p, unsigned char* smem) {
    volatile LAS unsigned* st = (volatile LAS unsigned*)(smem + SMEM_BYTES);
    pg8::XcdOrder S; S.init(NTOK / 256, 4096 / 256, (int)st[0], (int)st[1], (int)st[2], (int)st[3]);
    const pg8::Gemm g{WSP(bf16_t, WS_XN), WSP(bf16_t, WS_W_SGUIN), NTOK, 4096, DM};
    pg8::EpiSgu E; E.zu = WSP(bf16_t, WS_Z_U); E.zvt = WSP(bf16_t, WS_Z_VT); E.ssq = WSP(float, WS_SSQ); E.stg = (PG8_LAS unsigned char*)(smem + PG8_EXTRA);
    __syncthreads();
    pg8::gemm_phase<pg8::EpiSgu, pg8::XcdOrder, true, true>((PG8_LAS unsigned char*)smem, g, S, E);
}

DI u32 cand_key(float s, int ci) { return (f2ord(s) & ~255u) | (u32)(255 - ci); }
template <int P>
DI void score_half(const bf16_t* __restrict__ qrow, const bf16_t* __restrict__ skh, int fr, int fh, u32 (&lst)[16]) {
    bf16x8 qf[8];
#pragma unroll
    for (int ks = 0; ks < 8; ++ks) qf[ks] = *(const bf16x8*)(qrow + P * 128 + 16 * ks);
#pragma unroll
    for (int j = 0; j < 16; ++j) lst[j] = 0u;
#pragma unroll 1
    for (int kt = 0; kt < 4; ++kt) {
        f32x16 st;
#pragma unroll
        for (int r = 0; r < 16; ++r) st[r] = 0.f;
        const bf16_t* skr = skh + ((size_t)P * 128 + kt * 32 + fr) * 128 + 8 * fh;
#pragma unroll
        for (int ks = 0; ks < 8; ++ks) st = MFMA32(*(const bf16x8*)(skr + 16 * ks), qf[ks], st);
        u32 ks_[16];
#pragma unroll
        for (int r = 0; r < 16; ++r) ks_[r] = (f2ord(st[r]) & ~127u) | (u32)(127 - (kt * 32 + crow(r, fh)));
        sort16_desc(ks_);
        merge16_desc(lst, ks_);
    }
    u32 other[16];
#pragma unroll
    for (int j = 0; j < 16; ++j) other[j] = (u32)__shfl_xor((int)lst[j], 32);
    merge16_desc(lst, other);
}
DI void ph_score(const Params& p, int vb, int l, unsigned char* smem) {
    const int tid = otid(), wave = tid >> 6, lane = tid & 63, fr = lane & 31, fh = lane >> 5;
    const int it = vb * 4 + wave, tile = it >> 3, h = it & 7;
    const int tok = tile * 32 + fr;
    const bf16_t* qrow = WSP(bf16_t, WS_QBUF) + (size_t)tok * 2048 + h * 256 + 8 * fh;
    const bf16_t* skh = WSP(bf16_t, WS_W_SUBK) + ((size_t)l * 16 + h * 2) * 128 * 128;
    u32 L0[16], L1[16];
    score_half<0>(qrow, skh, fr, fh, L0);
    score_half<1>(qrow, skh, fr, fh, L1);
    LAS int* slot = (LAS int*)(smem + wave * (64 * 132)) + lane * 33;
    float s1[16], s2[16];
#pragma unroll
    for (int j = 0; j < 16; ++j) {
        s1[j] = ord2f(L0[j] & ~127u); s2[j] = ord2f(L1[j] & ~127u);
        slot[j] = 127 - (int)(L0[j] & 127u); slot[16 + j] = 127 - (int)(L1[j] & 127u);
    }
    u32 lst[16];
#pragma unroll
    for (int j = 0; j < 16; ++j) lst[j] = cand_key(s1[0] + s2[j], j);
#pragma unroll
    for (int i = 1; i < 5; ++i) {
        u32 row[16];
#pragma unroll
        for (int j = 0; j < 16; ++j) row[j] = ((i + 1) * (j + 1) <= 16) ? cand_key(s1[i] + s2[j], i * 16 + j) : 0u;
        merge16_desc(lst, row);
    }
#pragma unroll
    for (int i = 5; i < 16; ++i)
#pragma unroll
        for (int j = 0; j < 2; ++j)
            if ((i + 1) * (j + 1) <= 16) top16_insert(lst, cand_key(s1[i] + s2[j], i * 16 + j));
    float pv[16]; float sum = 0.f;
    const float mx = ord2f(lst[0] & ~255u);
#pragma unroll
    for (int j = 0; j < 16; ++j) { pv[j] = __expf(ord2f(lst[j] & ~255u) - mx); sum += pv[j]; }
    const float inv = 1.f / sum;
    int ev[16];
#pragma unroll
    for (int j = 0; j < 16; ++j) {
        const int ci = 255 - (int)(lst[j] & 255u);
        ev[j] = slot[ci >> 4] * 128 + slot[16 + (ci & 15)];
    }
    if (fh == 0) {
        int4* ro = (int4*)(WSP(int, WS_RIDX) + (size_t)tok * 128 + h * 16);
        float4* go = (float4*)(WSP(float, WS_RG) + (size_t)tok * 128 + h * 16);
#pragma unroll
        for (int q = 0; q < 4; ++q) {
            ro[q] = make_int4(ev[4 * q], ev[4 * q + 1], ev[4 * q + 2], ev[4 * q + 3]);
            go[q] = make_float4(pv[4 * q] * inv, pv[4 * q + 1] * inv, pv[4 * q + 2] * inv, pv[4 * q + 3] * inv);
        }
    }
}


DI void osm_update(f32x16& s, unsigned vm, float& m, float& lh, float& alpha) {
    float mx = -1e30f;
#pragma unroll
    for (int r = 0; r < 16; ++r) mx = ((vm >> r) & 1u) ? fmaxf(mx, s[r]) : mx;
    mx = fmaxf(mx, __shfl_xor(mx, 32));
    const float mn = fmaxf(m, mx);
    alpha = __expf(m - mn);
    float ls = 0.f;
#pragma unroll
    for (int r = 0; r < 16; ++r) { const float pe = ((vm >> r) & 1u) ? __expf(s[r] - mn) : 0.f; s[r] = pe; ls += pe; }
    lh = lh * alpha + ls; m = mn;
}
DI void osm_update_full(f32x16& s, float& m, float& lh, float& alpha) {
    float mx = s[0];
#pragma unroll
    for (int r = 1; r < 16; ++r) mx = fmaxf(mx, s[r]);
    mx = fmaxf(mx, __shfl_xor(mx, 32));
    const float mn = fmaxf(m, mx);
    alpha = __expf(m - mn);
    float ls = 0.f;
#pragma unroll
    for (int r = 0; r < 16; ++r) { const float pe = __expf(s[r] - mn); s[r] = pe; ls += pe; }
    lh = lh * alpha + ls; m = mn;
}
DI void tr_quad(const unsigned (&a)[4], unsigned hi_off, bf16x8 (&f)[4]) {
    s16x4 l0, h0, l1, h1, l2, h2, l3, h3;
    const unsigned b0 = a[0] + hi_off, b1 = a[1] + hi_off, b2 = a[2] + hi_off, b3 = a[3] + hi_off;
    asm volatile("ds_read_b64_tr_b16 %0, %8\n\tds_read_b64_tr_b16 %1, %9\n\tds_read_b64_tr_b16 %2, %10\n\tds_read_b64_tr_b16 %3, %11\n\t"
                 "ds_read_b64_tr_b16 %4, %12\n\tds_read_b64_tr_b16 %5, %13\n\tds_read_b64_tr_b16 %6, %14\n\tds_read_b64_tr_b16 %7, %15\n\ts_waitcnt lgkmcnt(0)"
                 : "=&v"(l0), "=&v"(h0), "=&v"(l1), "=&v"(h1), "=&v"(l2), "=&v"(h2), "=&v"(l3), "=&v"(h3)
                 : "v"(a[0]), "v"(b0), "v"(a[1]), "v"(b1), "v"(a[2]), "v"(b2), "v"(a[3]), "v"(b3) : "memory");
    f[0] = __builtin_shufflevector(l0, h0, 0, 1, 2, 3, 4, 5, 6, 7); f[1] = __builtin_shufflevector(l1, h1, 0, 1, 2, 3, 4, 5, 6, 7);
    f[2] = __builtin_shufflevector(l2, h2, 0, 1, 2, 3, 4, 5, 6, 7); f[3] = __builtin_shufflevector(l3, h3, 0, 1, 2, 3, 4, 5, 6, 7);
}

#define QB_BYTES (128 * 256)
#define KB_BYTES (32 * 256)
template <bool WITH_V>
DI void attnB_stage_kv(const bf16_t* __restrict__ kg  , unsigned char* Kd, unsigned char* Vd, int wave, int lane) {
#pragma unroll
    for (int i = 0; i < 2; ++i) {
        const int idx = wave * 2 + i;
        const int key = 4 * idx + (lane >> 4), cp = lane & 15;
        const bf16_t* g = kg + (size_t)key * ATT_IN;
        __builtin_amdgcn_global_load_lds((const unsigned*)(g + ((cp ^ (key & 15)) << 3)), (unsigned*)(Kd + idx * 1024 + lane * 16), 16, 0, 0);
        if (WITH_V) {
            const int cv = ((((cp >> 2) ^ (key & 3)) << 2) | (cp & 3));
            __builtin_amdgcn_global_load_lds((const unsigned*)(g + 512 + (cv << 3)), (unsigned*)(Vd + idx * 1024 + lane * 16), 16, 0, 0);
        }
    }
}
template <int KOFF, bool FULL>
DI void attnB_map(const unsigned char* Kc, const unsigned char* qlp, int ksw, int qsw, int fh, unsigned vm, unsigned vc, int tq,
                  float& m, float& l, f32x16 (&o)[4]) {
    f32x16 st;
#pragma unroll
    for (int r = 0; r < 16; ++r) st[r] = 0.f;
#pragma unroll
    for (int s = 0; s < 4; ++s) {
        const bf16x8 kf = *(const bf16x8*)(Kc + (((KOFF + 2 * s + fh) ^ ksw) << 4));
        const bf16x8 qf = *(const bf16x8*)(qlp + (((KOFF + 2 * s + fh) ^ qsw) << 4));
        st = MFMA32(kf, qf, st);
    }
    float al;
    if (FULL) osm_update_full(st, m, l, al); else osm_update(st, vm, m, l, al);
    if (!__all(al == 1.f)) {
#pragma unroll
        for (int d = 0; d < 4; ++d)
#pragma unroll
            for (int r = 0; r < 16; ++r) o[d][r] *= al;
    }
#pragma unroll
    for (int s = 0; s < 2; ++s) {
        const bf16x8 pf = pack_p(st, s);
        unsigned va[4]; bf16x8 vf[4];
#pragma unroll
        for (int d = 0; d < 4; ++d) va[d] = vc + s * 16 * 256 + ((d ^ tq) << 6);
        tr_quad(va, 8 * 256, vf);
#pragma unroll
        for (int d = 0; d < 4; ++d) o[d] = MFMA32(vf[d], pf, o[d]);
    }
}
DI void ph_attnB_fast(const Params& p, int item, unsigned char* smem) {
    const bf16_t* proj = WSP(bf16_t, WS_PROJ);
    const int tid = otid(), wave = tid >> 6, lane = tid & 63, fr = lane & 31, fh = lane >> 5;
    const int qt = 15 - (item >> 6), bh = item & 63, b = bh >> 2, h = bh & 3;
    const int q0 = qt * 128;
    const float lam = compute_lam(p, lane);
    const size_t rowbase = (size_t)b * SEQ;
    const int qrow = wave * 32 + fr, qpos = q0 + qrow;
    unsigned char* Ql = smem;
    unsigned char* Kl = smem + QB_BYTES;
    unsigned char* Vl = Kl + 2 * KB_BYTES;
    const bf16_t* kbase = proj + rowbase * ATT_IN + 2048 + h * 128;
    __syncthreads();
#pragma unroll
    for (int i = 0; i < 8; ++i) {
        const int idx = wave * 8 + i;
        const int row = 4 * idx + (lane >> 4), cp = lane & 15;
        __builtin_amdgcn_global_load_lds((const unsigned*)(proj + (rowbase + q0 + row) * ATT_IN + 1536 + h * 128 + ((cp ^ (row & 15)) << 3)),
                                         (unsigned*)(Ql + idx * 1024 + lane * 16), 16, 0, 0);
    }
    attnB_stage_kv<true>(kbase, Kl, Vl, wave, lane);
    const unsigned char* qlp = Ql + qrow * 256;
    const int qsw = qrow & 15, ksw = fr & 15;
    const int nkt = (q0 + 128) / 32;
    const int wlast = q0 + wave * 32 + 31;
    f32x16 o1[4], o2[4];
#pragma unroll
    for (int d = 0; d < 4; ++d)
#pragma unroll
        for (int r = 0; r < 16; ++r) { o1[d][r] = 0.f; o2[d][r] = 0.f; }
    float m1 = -1e30f, m2 = -1e30f, l1 = 0.f, l2 = 0.f;
    const int tq = (lane & 15) >> 2;
    const unsigned vrow = (unsigned)(uintptr_t)Vl + (4 * fh + tq) * 256 + (16 * ((lane >> 4) & 1) + 4 * (lane & 3)) * 2;
    asm volatile("s_waitcnt vmcnt(0)" ::: "memory");
    __syncthreads();
    for (int kt = 0; kt < nkt; ++kt) {
        const int cur = kt & 1;
        if (kt + 1 < nkt) attnB_stage_kv<true>(kbase + (size_t)(kt + 1) * 32 * ATT_IN, Kl + (cur ^ 1) * KB_BYTES, Vl + (cur ^ 1) * KB_BYTES, wave, lane);
        if (kt * 32 <= wlast) {
            const unsigned char* Kc = Kl + cur * KB_BYTES + fr * 256;
            const unsigned vc = vrow + cur * KB_BYTES;
            if (kt * 32 + 31 <= wlast - 31) {
                attnB_map<0, true>(Kc, qlp, ksw, qsw, fh, 0xffffu, vc, tq, m1, l1, o1);
                __builtin_amdgcn_sched_barrier(0);
                attnB_map<8, true>(Kc, qlp, ksw, qsw, fh, 0xffffu, vc, tq, m2, l2, o2);
            } else {
                unsigned vm = 0;
#pragma unroll
                for (int r = 0; r < 16; ++r) vm |= ((kt * 32 + crow(r, fh)) <= qpos) ? (1u << r) : 0u;
                attnB_map<0, false>(Kc, qlp, ksw, qsw, fh, vm, vc, tq, m1, l1, o1);
                __builtin_amdgcn_sched_barrier(0);
                attnB_map<8, false>(Kc, qlp, ksw, qsw, fh, vm, vc, tq, m2, l2, o2);
            }
        }
        asm volatile("s_waitcnt vmcnt(0)" ::: "memory");
        __syncthreads();
    }
    l1 += __shfl_xor(l1, 32); l2 += __shfl_xor(l2, 32);
    const float i1 = 1.f / l1, i2 = lam / l2;
    float ss = 0.f;
#pragma unroll
    for (int d = 0; d < 4; ++d)
#pragma unroll
        for (int r = 0; r < 16; ++r) { const float v = o1[d][r] * i1 - o2[d][r] * i2; o1[d][r] = v; ss += v * v; }
    ss += __shfl_xor(ss, 32);
    const float rinv = rsqrtf(ss * (1.f / 128.f) + EPSN) * 0.8f;
    const float* subg = p.in[11];
    bf16_t* op = WSP(bf16_t, WS_MIXED) + (rowbase + qpos) * DM + 512 + h * 128;
#pragma unroll
    for (int d = 0; d < 4; ++d)
#pragma unroll
        for (int g = 0; g < 4; ++g) {
            const int dim = 32 * d + 8 * g + 4 * fh;
            const float4 gg = *(const float4*)(subg + dim);
            uint2 w;
            w.x = pack2(o1[d][4 * g + 0] * rinv * gg.x, o1[d][4 * g + 1] * rinv * gg.y);
            w.y = pack2(o1[d][4 * g + 2] * rinv * gg.z, o1[d][4 * g + 3] * rinv * gg.w);
            *(uint2*)(op + dim) = w;
        }
}

#define KA_PITCH 128
#define VA_PITCH 192
#define WA_BYTES (32 * KA_PITCH + 32 * VA_PITCH)
template <int MODE>
DI void ph_attnA_fast(const Params& p, int item, unsigned char* smem) {
    const bf16_t* proj = WSP(bf16_t, WS_PROJ);
    const int tid = otid(), wave = tid >> 6, lane = tid & 63, fr = lane & 31, fh = lane >> 5;
    const int c = item & 15, h = (item >> 4) & 7, b = item >> 7;
    const size_t rowbase = (size_t)b * SEQ;
    const int qpos = MODE == 0 ? 128 * c + 32 * wave + fr : 16 * (32 * wave + fr) + c;
    const int pmin = MODE == 0 ? 128 * c + 32 * wave : 512 * wave + c, pmax = pmin + (MODE == 0 ? 31 : 496);
    bf16x8 qf[4];
    {
        const bf16_t* qp = proj + (rowbase + qpos) * ATT_IN + h * 64 + 8 * fh;
#pragma unroll
        for (int s = 0; s < 4; ++s) qf[s] = *(const bf16x8*)(qp + 16 * s);
    }
    f32x16 o[2];
#pragma unroll
    for (int d = 0; d < 2; ++d)
#pragma unroll
        for (int r = 0; r < 16; ++r) o[d][r] = 0.f;
    float m = -1e30f, l = 0.f;
    unsigned char* Kl = smem + wave * WA_BYTES;
    unsigned char* Vl = Kl + 32 * KA_PITCH;
    const unsigned vaddr = (unsigned)(uintptr_t)Vl + (4 * fh + ((lane & 15) >> 2)) * VA_PITCH + (16 * ((lane >> 4) & 1) + 4 * (lane & 3)) * 2;
    const int skey = lane >> 3, sc = lane & 7;
    __syncthreads();
    int br = 0, d = MODE == 0 ? 1 : 16, W = MODE == 0 ? 128 : 2048, cls = MODE == 0 ? 0 : (c & 15);
    int j0 = MODE == 0 ? (pmin < 128 ? 0 : pmin - 128) : 0, jhi = MODE == 0 ? pmax : ((pmax - cls) >> 4);
    const bf16_t* kvbase = proj + rowbase * ATT_IN + 512 + h * 64 + sc * 8;
    uint4 rk0, rk1, rk2, rk3, rv0, rv1, rv2, rv3;
#define A_LOAD(i, RK, RV) do { int kp_ = cls + d * (j0 + skey + 8 * (i)); kp_ = kp_ > SEQ - 1 ? SEQ - 1 : kp_; kp_ = kp_ < 0 ? 0 : kp_; \
        const bf16_t* g_ = kvbase + (size_t)kp_ * ATT_IN; RK = *(const uint4*)g_; RV = *(const uint4*)(g_ + 512); } while (0)
#define A_WRITE(i, RK, RV) do { const int key_ = skey + 8 * (i); *(uint4*)(Kl + key_ * KA_PITCH + ((sc ^ ((key_ >> 1) & 7)) << 4)) = RK; \
        *(uint4*)(Vl + key_ * VA_PITCH + sc * 16) = RV; } while (0)
    A_LOAD(0, rk0, rv0); A_LOAD(1, rk1, rv1); A_LOAD(2, rk2, rv2); A_LOAD(3, rk3, rv3);
#pragma unroll 1
    for (;;) {
        A_WRITE(0, rk0, rv0); A_WRITE(1, rk1, rv1); A_WRITE(2, rk2, rv2); A_WRITE(3, rk3, rv3);
        const int cd = d, cW = W, ccls = cls, cj0 = j0;
        bool more = true;
        j0 += 32;
        if (j0 > jhi) {
            ++br;
            if (MODE == 0 || br == 2) more = false;
            else {
                d = 4; W = 512; cls = c & 3;
                const int lo = pmin - cls - W;
                j0 = lo < 0 ? 0 : lo >> 2;
                jhi = (pmax - cls) >> 2;
            }
        }
        A_LOAD(0, rk0, rv0); A_LOAD(1, rk1, rv1); A_LOAD(2, rk2, rv2); A_LOAD(3, rk3, rv3);
        f32x16 st;
#pragma unroll
        for (int r = 0; r < 16; ++r) st[r] = 0.f;
#pragma unroll
        for (int s = 0; s < 4; ++s) {
            const bf16x8 kf = *(const bf16x8*)(Kl + fr * KA_PITCH + (((2 * s + fh) ^ ((fr >> 1) & 7)) << 4));
            st = MFMA32(kf, qf[s], st);
        }
        float al;
        const int kfirst = ccls + cd * cj0, klast = kfirst + cd * 31;
        if (klast <= pmin && pmax - kfirst <= cW) osm_update_full(st, m, l, al);
        else {
            unsigned vm = 0;
#pragma unroll
            for (int r = 0; r < 16; ++r) {
                const int dist = qpos - (ccls + cd * (cj0 + crow(r, fh)));
                vm |= (dist >= 0 && dist <= cW) ? (1u << r) : 0u;
            }
            osm_update(st, vm, m, l, al);
        }
        if (!__all(al == 1.f)) {
#pragma unroll
            for (int dd = 0; dd < 2; ++dd)
#pragma unroll
                for (int r = 0; r < 16; ++r) o[dd][r] *= al;
        }
        {
            unsigned va[4]; bf16x8 vf[4];
            va[0] = vaddr; va[1] = vaddr + 64; va[2] = vaddr + 16 * VA_PITCH; va[3] = vaddr + 16 * VA_PITCH + 64;
            tr_quad(va, 8 * VA_PITCH, vf);
            const bf16x8 p0 = pack_p(st, 0), p1 = pack_p(st, 1);
            o[0] = MFMA32(vf[0], p0, o[0]); o[1] = MFMA32(vf[1], p0, o[1]);
            o[0] = MFMA32(vf[2], p1, o[0]); o[1] = MFMA32(vf[3], p1, o[1]);
        }
        if (!more) break;
    }
    l += __shfl_xor(l, 32);
    bf16_t* op = WSP(bf16_t, WS_MIXED) + (rowbase + qpos) * DM + h * 64;
    float* lsep = WSP(float, WS_LSE1) + (rowbase + qpos) * 8 + h;
    if (MODE == 0) {
        const float il = 1.f / l;
        if (fh == 0) *lsep = m + __logf(l);
#pragma unroll
        for (int dd = 0; dd < 2; ++dd)
#pragma unroll
            for (int g = 0; g < 4; ++g) {
                const int dim = 32 * dd + 8 * g + 4 * fh;
                uint2 w;
                w.x = pack2(o[dd][4 * g + 0] * il, o[dd][4 * g + 1] * il);
                w.y = pack2(o[dd][4 * g + 2] * il, o[dd][4 * g + 3] * il);
                *(uint2*)(op + dim) = w;
            }
    } else {
        const float lse1 = *lsep;
        const float M = fmaxf(m, lse1);
        const float w23 = __expf(m - M), w1 = __expf(lse1 - M);
        const float iden = 1.f / (l * w23 + w1);
        const float a23 = w23 * iden, a1 = w1 * iden;
        uint2 prev[2][4];
#pragma unroll
        for (int dd = 0; dd < 2; ++dd)
#pragma unroll
            for (int g = 0; g < 4; ++g) prev[dd][g] = *(const uint2*)(op + 32 * dd + 8 * g + 4 * fh);
#pragma unroll
        for (int dd = 0; dd < 2; ++dd)
#pragma unroll
            for (int g = 0; g < 4; ++g) {
                const int dim = 32 * dd + 8 * g + 4 * fh;
                const float p0 = __uint_as_float(prev[dd][g].x << 16), p1 = __uint_as_float(prev[dd][g].x & 0xffff0000u);
                const float p2 = __uint_as_float(prev[dd][g].y << 16), p3 = __uint_as_float(prev[dd][g].y & 0xffff0000u);
                uint2 w;
                w.x = pack2(o[dd][4 * g + 0] * a23 + p0 * a1, o[dd][4 * g + 1] * a23 + p1 * a1);
                w.y = pack2(o[dd][4 * g + 2] * a23 + p2 * a1, o[dd][4 * g + 3] * a23 + p3 * a1);
                *(uint2*)(op + dim) = w;
            }
    }
}
#define NITEM_B 1024
#define NITEM_A 2048
DI void ph_attn_fast(const Params& p, int vb, unsigned char* smem) {
    if (vb < NITEM_B) {
        const int item = vb < 512 ? vb : 512 + (1023 - vb);
        ph_attnB_fast(p, item, smem);
    } else ph_attnA_fast<0>(p, vb - NITEM_B, smem);
}


DI void ph_spatial_fast(const Params& p, int item, unsigned char* smem) {
    const int tid = otid(), wave = tid >> 6, lane = tid & 63, fr = lane & 31, fh = lane >> 5;
    const int wm = wave >> 1, wn = wave & 1;
    const int chunk = item >> 3, g = item & 7;
    bf16_t* u = WSP(bf16_t, WS_Z_U);
    const bf16_t* vt = WSP(bf16_t, WS_Z_VT);
    const float* ssq = WSP(float, WS_SSQ);
    const float* wsp = p.in[16] + (size_t)g * 128 * 128;
    float* rinv = (float*)(smem + 66 * 1024);
    unsigned char* Bt = smem + 32768;
    __syncthreads();
    if (tid < 128) {
        const float4* sp = (const float4*)(ssq + (size_t)(chunk * 128 + tid) * 64);
        float sacc = 0.f;
#pragma unroll
        for (int j = 0; j < 16; ++j) { const float4 q = sp[j]; sacc += (q.x + q.y) + (q.z + q.w); }
        rinv[tid] = rsqrtf(sacc * (1.f / CW) + EPSN);
    }
    const size_t vrow0 = (size_t)chunk * CW + g * 256;
    stage_tile(vt, 128, (int)vrow0, 0, Bt, wave, lane);
    stage_tile(vt, 128, (int)vrow0, 64, Bt + 16384, wave, lane);
    __syncthreads();
#pragma unroll
    for (int i = 0; i < 8; ++i) {
        const int id = tid + 256 * i;
        const int t = id >> 4, sc = id & 15;
        const float4 w0 = *(const float4*)(wsp + t * 128 + sc * 8);
        const float4 w1 = *(const float4*)(wsp + t * 128 + sc * 8 + 4);
        const float4 r0 = *(const float4*)(rinv + sc * 8);
        const float4 r1 = *(const float4*)(rinv + sc * 8 + 4);
        const int s0 = sc * 8;
        uint4 o;
        o.x = pack2(s0 + 0 <= t ? w0.x * r0.x : 0.f, s0 + 1 <= t ? w0.y * r0.y : 0.f);
        o.y = pack2(s0 + 2 <= t ? w0.z * r0.z : 0.f, s0 + 3 <= t ? w0.w * r0.w : 0.f);
        o.z = pack2(s0 + 4 <= t ? w1.x * r1.x : 0.f, s0 + 5 <= t ? w1.y * r1.y : 0.f);
        o.w = pack2(s0 + 6 <= t ? w1.z * r1.z : 0.f, s0 + 7 <= t ? w1.w * r1.w : 0.f);
        const int kt = sc >> 3, c = sc & 7;
        *(uint4*)(smem + kt * 16384 + t * 128 + ((c ^ ((t >> 1) & 7)) << 4)) = o;
    }
#pragma unroll 1
    for (int nt = 0; nt < 2; ++nt) {
        asm volatile("s_waitcnt vmcnt(0)" ::: "memory");
        __syncthreads();
        f32x16 acc[2][2];
#pragma unroll
        for (int i = 0; i < 2; ++i)
#pragma unroll
            for (int j = 0; j < 2; ++j)
#pragma unroll
                for (int r = 0; r < 16; ++r) acc[i][j][r] = 0.f;
#pragma unroll
        for (int kt = 0; kt < 2; ++kt)
#pragma unroll
            for (int s = 0; s < 4; ++s) {
                bf16x8 a[2], b[2];
#pragma unroll
                for (int i = 0; i < 2; ++i) {
                    a[i] = lds_frag(smem + kt * 16384, wm * 64 + i * 32 + fr, 2 * s + fh);
                    b[i] = lds_frag(Bt + kt * 16384, wn * 64 + i * 32 + fr, 2 * s + fh);
                }
#pragma unroll
                for (int i = 0; i < 2; ++i)
#pragma unroll
                    for (int j = 0; j < 2; ++j) acc[i][j] = MFMA32(a[i], b[j], acc[i][j]);
            }
        __syncthreads();
        float* st = (float*)(Bt + wave * (32 * 65 * 4));
#pragma unroll
        for (int i = 0; i < 2; ++i) {
#pragma unroll
            for (int j = 0; j < 2; ++j)
#pragma unroll
                for (int r = 0; r < 16; ++r) st[crow(r, fh) * 65 + j * 32 + fr] = acc[i][j][r];
            const int t = wm * 64 + i * 32 + fr;
            const int c0 = g * 256 + nt * 128 + wn * 64 + fh * 32;
            bf16_t* up = u + (size_t)(chunk * 128 + t) * CW + c0;
            const float bias = p.in[17][g * 128 + t];
            const float* gn = p.in[15] + c0;
            uint4 ur[4];
#pragma unroll
            for (int q = 0; q < 4; ++q) ur[q] = ((const uint4*)up)[q];
#pragma unroll
            for (int q = 0; q < 4; ++q) {
                float uf[8]; unpack8(ur[q], uf);
                const float4 g0 = *(const float4*)(gn + 8 * q), g1 = *(const float4*)(gn + 8 * q + 4);
                const float gg[8] = {g0.x, g0.y, g0.z, g0.w, g1.x, g1.y, g1.z, g1.w};
                float ov[8];
#pragma unroll
                for (int e = 0; e < 8; ++e) ov[e] = uf[e] * (st[fr * 65 + fh * 32 + 8 * q + e] * gg[e] + bias);
                uint4 o; o.x = pack2(ov[0], ov[1]); o.y = pack2(ov[2], ov[3]); o.z = pack2(ov[4], ov[5]); o.w = pack2(ov[6], ov[7]);
                ((uint4*)up)[q] = o;
            }
        }
        if (nt == 0) {
            __syncthreads();
            stage_tile(vt, 128, (int)vrow0 + 128, 0, Bt, wave, lane);
            stage_tile(vt, 128, (int)vrow0 + 128, 64, Bt + 16384, wave, lane);
        }
    }
}

#define XB_TMO      128
#define XB_XCNT(j)  (256  + 64 * (j))
#define XB_XSUB(j)  (1280 + 64 * (j))
#define XB_XGEN(j)  (2304 + 64 * (j))
#define XB_TOP      3328
#define XB_TOPGEN   3392
#define XCD_BAR_WORDS 3456
#define XB_SPIN_CAP (1u << 22)
DI unsigned xb_ld(unsigned* p) { return __hip_atomic_load(p, __ATOMIC_RELAXED, __HIP_MEMORY_SCOPE_AGENT); }
DI unsigned xb_add(unsigned* p, unsigned v) { return __hip_atomic_fetch_add(p, v, __ATOMIC_RELAXED, __HIP_MEMORY_SCOPE_AGENT); }
DI unsigned xb_xcc_id() { return (unsigned)__builtin_amdgcn_s_getreg((3 << 11) | 20) & 0xFu; }
#define XB_SPIN(cond, bar) do { unsigned _sp = 0; while (cond) { __builtin_amdgcn_s_sleep(1); \
    if ((++_sp & 255u) == 0u) { if (xb_ld(&(bar)[XB_TMO])) break; if (_sp > XB_SPIN_CAP) { atomicAdd(&(bar)[XB_TMO], 1u); break; } } } } while (0)
struct XcdBarrier { unsigned* bar; unsigned x; volatile LAS unsigned* st; };
DI XcdBarrier xcd_barrier_post(unsigned* bar, volatile LAS unsigned* st) {
    XcdBarrier b; b.bar = bar; b.x = xb_xcc_id(); b.st = st;
    if (threadIdx.x == 0) st[2] = xb_add(&bar[XB_XCNT(b.x)], 1u);
    return b;
}
DI void xcd_barrier_complete(unsigned* bar, unsigned x, unsigned& nloc, unsigned& nx, unsigned& xi) {
    const unsigned G = gridDim.x * gridDim.y * gridDim.z;
    unsigned sum, cnt, mine, below, sp = 0u;
    for (;;) {
        sum = 0u; cnt = 0u; mine = 0u; below = 0u;
#pragma unroll
        for (unsigned j = 0; j < 16; ++j) { const unsigned c = xb_ld(&bar[XB_XCNT(j)]); sum += c; cnt += (c > 0u) ? 1u : 0u; mine = (j == x) ? c : mine; below += (c > 0u && j < x) ? 1u : 0u; }
        if (sum == G) break;
        __builtin_amdgcn_s_sleep(1);
        if ((++sp & 255u) == 0u) { if (xb_ld(&bar[XB_TMO])) break; if (sp > XB_SPIN_CAP) { atomicAdd(&bar[XB_TMO], 1u); break; } }
    }
    nloc = mine > 0u ? mine : 1u; nx = cnt > 0u ? cnt : 1u; xi = below;
}
DI void xcd_barrier(const XcdBarrier& b) {
    asm volatile("s_waitcnt vmcnt(0)" ::: "memory");
    __syncthreads();
    if (threadIdx.x == 0) {
        unsigned* bar = b.bar;
        __builtin_amdgcn_s_waitcnt(0);
        unsigned nloc = b.st[0], nx = b.st[1];
        if (nloc == 0u) { unsigned xi; xcd_barrier_complete(bar, b.x, nloc, nx, xi); b.st[0] = nloc; b.st[1] = nx; b.st[3] = xi; }
        const unsigned old = xb_add(&bar[XB_XSUB(b.x)], 1u);
        const unsigned gen = old / nloc;
        if (old + 1u == (gen + 1u) * nloc) {
            __builtin_amdgcn_fence(__ATOMIC_RELEASE, "agent");
            asm volatile("s_waitcnt vmcnt(0)" ::: "memory");
            const unsigned og = xb_add(&bar[XB_TOP], 1u);
            const unsigned tg = og / nx;
            if (og + 1u == (tg + 1u) * nx) xb_add(&bar[XB_TOPGEN], 1u);
            else XB_SPIN(xb_ld(&bar[XB_TOPGEN]) == tg, bar);
            __builtin_amdgcn_fence(__ATOMIC_ACQUIRE, "agent");
            xb_add(&bar[XB_XGEN(b.x)], 1u);
            asm volatile("s_waitcnt vmcnt(0)" ::: "memory");
        } else {
            XB_SPIN(xb_ld(&bar[XB_XGEN(b.x)]) == gen, bar);
            __builtin_amdgcn_fence(__ATOMIC_ACQUIRE, "agent");
            asm volatile("s_waitcnt vmcnt(0)" ::: "memory");
        }
    }
    __syncthreads();
}

enum { PH_PREP = 0, PH_GEMM1, PH_ATTN, PH_ATTN2, PH_GEMM2,
       PH_NORM_P0, PH_GEMMQ0, PH_SCORE0, PH_PDOWN0, PH_PCOMB0, PH_PUP0, PH_NORM_SGU,
       PH_GEMM4, PH_SPATIAL, PH_GEMM5,
       PH_NORM_P1, PH_GEMMQ1, PH_SCORE1, PH_PDOWN1, PH_PCOMB1, PH_PUP1, PH_COUNT };

__host__ __device__ constexpr int phase_nvb(int ph) {
    switch (ph) {
        case PH_PREP: return PREP_N;
        case PH_GEMM1: return (ATT_IN / 256) * (NTOK / 256);
        case PH_ATTN: return NITEM_B + NITEM_A;
        case PH_ATTN2: return NITEM_A;
        case PH_GEMM2: return (DM / 256) * (NTOK / 256);
        case PH_NORM_P0: case PH_NORM_P1: case PH_NORM_SGU: return NTOK / 4;
        case PH_GEMMQ0: case PH_GEMMQ1: return 16 * (NTOK / 256);
        case PH_SCORE0: case PH_SCORE1: return (NTOK / 32) * 8 / 4;
        case PH_PCOMB0: case PH_PCOMB1: return NTOK / 4;
        case PH_GEMM4: return (4096 / 256) * (NTOK / 256);
        case PH_SPATIAL: return 256 * 8;
        case PH_GEMM5: return (DM / 256) * (NTOK / 256);
    }
    return 0;
}

template <int PH>
DI void run_vb(const Params& p, int vb, unsigned char* smem) {
    if constexpr (PH == PH_PREP) ph_prep(p, vb, smem);
    else if constexpr (PH == PH_ATTN) ph_attn_fast(p, vb, smem);
    else if constexpr (PH == PH_ATTN2) ph_attnA_fast<1>(p, vb, smem);
    else if constexpr (PH == PH_NORM_P0 || PH == PH_NORM_P1) rmsnorm_rows<true>(p.out, p.in[19] + (PH == PH_NORM_P1 ? DM : 0), WSP(bf16_t, WS_XN), vb, WSP(signed char, WS_XQ), WSP(float, WS_XSC));
    else if constexpr (PH == PH_SCORE0 || PH == PH_SCORE1) ph_score(p, vb, PH == PH_SCORE1 ? 1 : 0, smem);
    else if constexpr (PH == PH_PCOMB0 || PH == PH_PCOMB1) ph_peer_comb(p, vb, PH == PH_PCOMB1 ? 1 : 0);
    else if constexpr (PH == PH_NORM_SGU) rmsnorm_rows<false>(p.out, p.in[13], WSP(bf16_t, WS_XN), vb);
    else if constexpr (PH == PH_SPATIAL) ph_spatial_fast(p, vb, smem);
}

template <int PH>
DI void run_phase(const Params& p, unsigned char* smem) {
    if constexpr (PH == PH_PDOWN0 || PH == PH_PDOWN1) run_peer_sliced<false>(p, PH == PH_PDOWN1 ? 1 : 0, smem);
    else if constexpr (PH == PH_PUP0 || PH == PH_PUP1) run_peer_sliced<true>(p, PH == PH_PUP1 ? 1 : 0, smem);
    else if constexpr (PH == PH_GEMMQ0 || PH == PH_GEMMQ1) run_gemmq_pg8(p, PH == PH_GEMMQ1 ? 1 : 0, smem);
    else if constexpr (PH == PH_GEMM1) run_gemm1_pg8(p, smem);
    else if constexpr (PH == PH_GEMM4) run_gemm4_pg8(p, smem);
    else if constexpr (PH == PH_GEMM2) run_gemm_pg8<0>(p, smem);
    else if constexpr (PH == PH_GEMM5) run_gemm_pg8<1>(p, smem);
    else {
        constexpr int nvb = phase_nvb(PH);
        const int g = threadIdx.x >> 8;
        for (int vb = 2 * blockIdx.x; vb < nvb; vb += 2 * gridDim.x)
            if (vb + g < nvb) run_vb<PH>(p, vb + g, smem + g * GROUP_SMEM);
    }
}

template <int PH>
DI void run_from(const Params& p, unsigned char* smem, cg::grid_group& grid, const XcdBarrier& xb) {
    run_phase<PH>(p, smem);
    if constexpr (PH + 1 < PH_COUNT) {
        if constexpr (PH == 1) grid.sync(); else xcd_barrier(xb);
        run_from<PH + 1>(p, smem, grid, xb);
    }
}

__global__ void __launch_bounds__(NTHREADS, 2) k_mega(Params p) {
    extern __shared__ __attribute__((aligned(16))) unsigned char smem[];
    cg::grid_group grid = cg::this_grid();
    volatile LAS unsigned* st = (volatile LAS unsigned*)(smem + SMEM_BYTES);
    if (threadIdx.x == 0) { st[0] = 0u; st[1] = 0u; st[2] = 0u; st[3] = 0u; }
    __syncthreads();
    const XcdBarrier xb = xcd_barrier_post((unsigned*)(p.ws + WS_CTL), st);
    run_from<0>(p, smem, grid, xb);
}


extern "C" void kernel_launch(void* const* d_in, const int* in_sizes, int n_in, void* d_out, int out_size, void* d_ws, size_t ws_size, hipStream_t stream) {
    if (n_in != 24 || ws_size < WS_NEED || in_sizes[0] != NTOK * DM || out_size != NTOK * DM || in_sizes[22] != 2 * NEXP * DM) {
        fprintf(stderr, "kernel_launch: built for x[16,2048,1024] with 24 inputs and >= 512 MiB of workspace; got n_in %d, in0 %d, out %d, ws %zu: nothing launched\n", n_in, in_sizes[0], out_size, ws_size); return; }
    static int grid_blocks = 0;
    if (!grid_blocks) {
        int dev = 0, cus = 0, per_cu = 0;
        (void)hipGetDevice(&dev);
        (void)hipDeviceGetAttribute(&cus, hipDeviceAttributeMultiprocessorCount, dev);
        (void)hipFuncSetAttribute((const void*)k_mega, hipFuncAttributeMaxDynamicSharedMemorySize, SMEM_ALLOC);
        (void)hipOccupancyMaxActiveBlocksPerMultiprocessor(&per_cu, (const void*)k_mega, NTHREADS, SMEM_ALLOC);
        if (per_cu > 1) per_cu = 1;
        if (per_cu < 1) { fprintf(stderr, "kernel_launch: occupancy query returned %d\n", per_cu); per_cu = 1; }
        grid_blocks = cus * per_cu;
    }
    Params p{};
    for (int i = 0; i < 24; ++i) p.in[i] = (const float*)d_in[i];
    p.out = (float*)d_out;
    p.ws = (unsigned char*)d_ws;
    void* args[] = {&p};
    if (hipMemsetAsync((unsigned char*)d_ws + WS_CTL, 0, XCD_BAR_WORDS * 4, stream) != hipSuccess) { fprintf(stderr, "kernel_launch: memset of the barrier words failed\n"); return; }
    hipError_t e = hipLaunchCooperativeKernel((const void*)k_mega, dim3(grid_blocks), dim3(NTHREADS), args, SMEM_ALLOC, stream);
    if (e != hipSuccess) fprintf(stderr, "cooperative launch failed: %s (grid %d)\n", hipGetErrorString(e), grid_blocks);
}
```

```cpp
#include <hip/hip_runtime.h>
#include <stdint.h>
#include <stdio.h>

#define NTOK   32768
#define DM     1024
#define SEQ    2048
#define NB     16
#define ATT_IN 3072
#define CW     2048
#define NEXP   16384
#define EPSN   1e-6f

typedef unsigned short bf16_t;
typedef unsigned int u32;

#define DI __device__ __forceinline__
#define LAS __attribute__((address_space(3)))

DI int otid() { int t = threadIdx.x & 255; asm volatile("" : "+v"(t)); return t; }
DI int otid512() { int t = threadIdx.x; asm volatile("" : "+v"(t)); return t; }
DI float bf2f(bf16_t v) { return __uint_as_float(((u32)v) << 16); }
typedef __bf16 bf16v2 __attribute__((ext_vector_type(2)));
DI bf16_t f2bf(float f) { const __bf16 h = (__bf16)f; return __builtin_bit_cast(bf16_t, h); }
DI u32 pack2(float lo, float hi) { bf16v2 v; v[0] = (__bf16)lo; v[1] = (__bf16)hi; return __builtin_bit_cast(u32, v); }
DI float gelu_tanh(float x) {
    const float y = 0.7978845608028654f * (x + 0.044715f * x * x * x);
    const float e = __expf(2.f * y);
    const float t = 1.f - 2.f / (e + 1.f);
    return 0.5f * x * (1.f + t);
}
DI float wave_sum(float v) {
#pragma unroll
    for (int o = 1; o < 64; o <<= 1) v += __shfl_xor(v, o);
    return v;
}
DI float wave_max(float v) {
#pragma unroll
    for (int o = 1; o < 64; o <<= 1) v = fmaxf(v, __shfl_xor(v, o));
    return v;
}
DI u32 f2ord(float f) { u32 u = __float_as_uint(f); return (u & 0x80000000u) ? ~u : (u | 0x80000000u); }
DI float ord2f(u32 o) { u32 u = (o & 0x80000000u) ? (o & 0x7fffffffu) : ~o; return __uint_as_float(u); }

#define MiB ((size_t)1 << 20)
#define WS_CTL      ((size_t)0)
#define WS_W_ATTIN  (1 * MiB)
#define WS_W_ATTOUT (7 * MiB)
#define WS_W_SGUIN  (9 * MiB)
#define WS_W_SGUOUT (17 * MiB)
#define WS_W_PQ     (21 * MiB)
#define WS_W_SUBK   (29 * MiB)
#define WS_DOWN     (32 * MiB)
#define WS_UP       (64 * MiB)
#define WS_DSC      (96 * MiB)
#define WS_USC      (96 * MiB + 128 * 1024)
#define WS_LSE1     (30 * MiB)
#define WS_XQ       (100 * MiB)
#define WS_XSC      (132 * MiB)
#define WS_XN       (160 * MiB)
#define WS_BIG      (224 * MiB)
#define WS_PROJ     (WS_BIG)
#define WS_MIXED    (WS_BIG + 192 * MiB)
#define WS_Z_U      (WS_BIG)
#define WS_Z_VT     (WS_BIG + 128 * MiB)
#define WS_RIDX     (WS_BIG + 32 * MiB)
#define WS_RG       (WS_BIG + 48 * MiB)
#define WS_QBUF     (WS_BIG + 64 * MiB)
#define WS_SSQ      (WS_BIG + 256 * MiB)
#define WS_NEED     (512 * MiB)

struct Params {
    const float* in[24];
    float* out;
    unsigned char* ws;
};

#include <hip/hip_cooperative_groups.h>
namespace cg = cooperative_groups;

#define GROUP_SMEM (68 * 1024)
#define PG8_EXTRA (128 * 1024)
#define SMEM_BYTES (144 * 1024)
#define SMEM_ALLOC (SMEM_BYTES + 16)
#define NTHREADS 512

#define WSP(T, off) ((T*)(p.ws + (off)))


DI void transpose_tile(const float* __restrict__ W, bf16_t* __restrict__ Wt, int K, int N, int t, unsigned char* smem) {
    float* tile = (float*)smem;
    const int tid = otid();
    const int ntn = N / 64;
    const int n0 = (t % ntn) * 64, k0 = (t / ntn) * 64;
    __syncthreads();
    {
        const int n4 = tid & 15, kr = tid >> 4;
#pragma unroll
        for (int i = 0; i < 4; ++i) {
            const int k = kr + 16 * i;
            const float4 v = *(const float4*)(W + (size_t)(k0 + k) * N + n0 + 4 * n4);
            tile[k * 65 + 4 * n4 + 0] = v.x; tile[k * 65 + 4 * n4 + 1] = v.y; tile[k * 65 + 4 * n4 + 2] = v.z; tile[k * 65 + 4 * n4 + 3] = v.w;
        }
    }
    __syncthreads();
    {
        const int n = tid >> 2, kc = tid & 3;
        float v[16];
#pragma unroll
        for (int j = 0; j < 16; ++j) v[j] = tile[(16 * kc + j) * 65 + n];
        uint4 o0, o1;
        o0.x = pack2(v[0], v[1]); o0.y = pack2(v[2], v[3]); o0.z = pack2(v[4], v[5]); o0.w = pack2(v[6], v[7]);
        o1.x = pack2(v[8], v[9]); o1.y = pack2(v[10], v[11]); o1.z = pack2(v[12], v[13]); o1.w = pack2(v[14], v[15]);
        uint4* dst = (uint4*)(Wt + (size_t)(n0 + n) * K + k0 + 16 * kc);
        dst[0] = o0; dst[1] = o1;
    }
}
DI void cvt_chunk(const float* __restrict__ src, bf16_t* __restrict__ dst, int c) {
    const size_t base = (size_t)c * 2048;
#pragma unroll
    for (int i = 0; i < 8; ++i) {
        const size_t idx = base + i * 256 + otid();
        const float4 v = ((const float4*)src)[idx];
        uint2 o; o.x = pack2(v.x, v.y); o.y = pack2(v.z, v.w);
        ((uint2*)dst)[idx] = o;
    }
}
DI int q8(float v) { int i = __float2int_rn(v); i = i > 127 ? 127 : i; i = i < -127 ? -127 : i; return i & 255; }
template <bool EMIT_Q>
DI void rmsnorm_rows(const float* __restrict__ x, const float* __restrict__ g, bf16_t* __restrict__ o, int vb, signed char* xq = nullptr, float* xsc = nullptr) {
    const int lane = otid() & 63;
    const int row = vb * 4 + (otid() >> 6);
    const float4* xr = (const float4*)(x + (size_t)row * DM);
    float4 v[4]; float ss = 0.f;
#pragma unroll
    for (int j = 0; j < 4; ++j) { v[j] = xr[lane + 64 * j]; ss += v[j].x * v[j].x + v[j].y * v[j].y + v[j].z * v[j].z + v[j].w * v[j].w; }
    ss = wave_sum(ss);
    const float rinv = rsqrtf(ss * (1.f / DM) + EPSN);
    uint2* orow = (uint2*)(o + (size_t)row * DM);
    float am = 0.f;
#pragma unroll
    for (int j = 0; j < 4; ++j) {
        const float4 gg = ((const float4*)g)[lane + 64 * j];
        v[j].x *= rinv * gg.x; v[j].y *= rinv * gg.y; v[j].z *= rinv * gg.z; v[j].w *= rinv * gg.w;
        uint2 w; w.x = pack2(v[j].x, v[j].y); w.y = pack2(v[j].z, v[j].w);
        orow[lane + 64 * j] = w;
        if (EMIT_Q) am = fmaxf(am, fmaxf(fmaxf(fabsf(v[j].x), fabsf(v[j].y)), fmaxf(fabsf(v[j].z), fabsf(v[j].w))));
    }
    if (EMIT_Q) {
        am = wave_max(am);
        const float sc = am > 0.f ? 127.f / am : 0.f;
        u32* qrow = (u32*)(xq + (size_t)row * DM);
#pragma unroll
        for (int j = 0; j < 4; ++j)
            qrow[lane + 64 * j] = (u32)q8(v[j].x * sc) | ((u32)q8(v[j].y * sc) << 8) | ((u32)q8(v[j].z * sc) << 16) | ((u32)q8(v[j].w * sc) << 24);
        if (lane == 0) xsc[row] = am * (1.f / 127.f);
    }
}
#define PREP_T0 (48 * 16)
#define PREP_T1 (PREP_T0 + 16 * 16)
#define PREP_T2 (PREP_T1 + 64 * 16)
#define PREP_T3 (PREP_T2 + 16 * 32)
#define PREP_T4 (PREP_T3 + 2 * 32 * 16)
#define PREP_C0 (PREP_T4 + 64)
#define PREP_C1 (PREP_C0 + 8192)
#define PREP_C2 (PREP_C1 + 8192)
#define PREP_N  (PREP_C2 + 8192)
template <bool INT8>
DI void fp8_rows(const float* __restrict__ src, unsigned char* __restrict__ dst, float* __restrict__ inv_scale, int vb) {
    const int lane = otid() & 63;
    const int row = vb * 4 + (otid() >> 6);
    const float4* sr = (const float4*)(src + (size_t)row * DM) + lane;
    float4 v[4]; float am = 0.f;
#pragma unroll
    for (int j = 0; j < 4; ++j) { v[j] = sr[64 * j]; am = fmaxf(am, fmaxf(fmaxf(fabsf(v[j].x), fabsf(v[j].y)), fmaxf(fabsf(v[j].z), fabsf(v[j].w)))); }
    am = wave_max(am);
    float sc, inv;
    if (INT8) { sc = am > 0.f ? 127.f / am : 0.f; inv = am * (1.f / 127.f); }
    else {
        int e = (int)((__float_as_uint(am) >> 23) & 255u) - 127;
        if (am == 0.f) e = 0;
        e = e < -100 ? -100 : e;
        sc = __uint_as_float((u32)(127 + 7 - e) << 23); inv = __uint_as_float((u32)(127 + e - 7) << 23);
    }
    unsigned char* drow = dst + (size_t)(row >> 14) * NEXP * DM + (size_t)(row & (NEXP - 1)) * 128;
#pragma unroll
    for (int j = 0; j < 4; ++j) {
        const int dim = 4 * (lane + 64 * j);
        u32 w;
        if (INT8) w = (u32)q8(v[j].x * sc) | ((u32)q8(v[j].y * sc) << 8) | ((u32)q8(v[j].z * sc) << 16) | ((u32)q8(v[j].w * sc) << 24);
        else { int t = __builtin_amdgcn_cvt_pk_fp8_f32(v[j].x * sc, v[j].y * sc, 0, false); t = __builtin_amdgcn_cvt_pk_fp8_f32(v[j].z * sc, v[j].w * sc, t, true); w = (u32)t; }
        *(u32*)(drow + (size_t)(dim >> 7) * NEXP * 128 + (dim & 127)) = w;
    }
    if (lane == 0) inv_scale[row] = inv;
}
DI void ph_prep(const Params& p, int vb, unsigned char* smem) {
    if (vb < PREP_T0) transpose_tile(p.in[2], WSP(bf16_t, WS_W_ATTIN), DM, ATT_IN, vb, smem);
    else if (vb < PREP_T1) transpose_tile(p.in[12], WSP(bf16_t, WS_W_ATTOUT), DM, DM, vb - PREP_T0, smem);
    else if (vb < PREP_T2) transpose_tile(p.in[14], WSP(bf16_t, WS_W_SGUIN), DM, 4096, vb - PREP_T1, smem);
    else if (vb < PREP_T3) transpose_tile(p.in[18], WSP(bf16_t, WS_W_SGUOUT), CW, DM, vb - PREP_T2, smem);
    else if (vb < PREP_T4) { const int t = vb - PREP_T3, l = t / 512; transpose_tile(p.in[20] + (size_t)l * DM * 2048, WSP(bf16_t, WS_W_PQ) + (size_t)l * 2048 * DM, DM, 2048, t % 512, smem); }
    else if (vb < PREP_C0) cvt_chunk(p.in[21], WSP(bf16_t, WS_W_SUBK), vb - PREP_T4);
    else if (vb < PREP_C1) fp8_rows<true>(p.in[22], p.ws + WS_DOWN, WSP(float, WS_DSC), vb - PREP_C0);
    else if (vb < PREP_C2) fp8_rows<false>(p.in[23], p.ws + WS_UP, WSP(float, WS_USC), vb - PREP_C1);
    else rmsnorm_rows<false>(p.in[0], p.in[1], WSP(bf16_t, WS_XN), vb - PREP_C2);
}

DI float compute_lam(const Params& p, int lane) {
    const float a = wave_sum(p.in[7][lane] * p.in[8][lane]);
    const float b = wave_sum(p.in[9][lane] * p.in[10][lane]);
    return __expf(a) - __expf(b) + 0.2f;
}
DI void ce_desc(u32& a, u32& b) { const u32 hi = max(a, b), lo = min(a, b); a = hi; b = lo; }
DI void sort16_desc(u32 (&v)[16]) {
#pragma unroll
    for (int k = 2; k <= 16; k <<= 1)
#pragma unroll
        for (int j = k >> 1; j > 0; j >>= 1)
#pragma unroll
            for (int i = 0; i < 16; ++i) {
                const int l = i ^ j;
                if (l > i) { if ((i & k) == 0) ce_desc(v[i], v[l]); else ce_desc(v[l], v[i]); }
            }
}
DI void merge16_desc(u32 (&a)[16], const u32 (&b)[16]) {
#pragma unroll
    for (int i = 0; i < 16; ++i) a[i] = max(a[i], b[15 - i]);
#pragma unroll
    for (int j = 8; j > 0; j >>= 1)
#pragma unroll
        for (int i = 0; i < 16; ++i) { const int l = i ^ j; if (l > i) ce_desc(a[i], a[l]); }
}
DI void top16_insert(u32 (&lst)[16], u32 x) {
#pragma unroll
    for (int j = 0; j < 16; ++j) { const u32 hi = max(lst[j], x); x = min(lst[j], x); lst[j] = hi; }
}
DI void unpack8(const uint4 v, float (&f)[8]) {
    f[0] = __uint_as_float(v.x << 16); f[1] = __uint_as_float(v.x & 0xffff0000u);
    f[2] = __uint_as_float(v.y << 16); f[3] = __uint_as_float(v.y & 0xffff0000u);
    f[4] = __uint_as_float(v.z << 16); f[5] = __uint_as_float(v.z & 0xffff0000u);
    f[6] = __uint_as_float(v.w << 16); f[7] = __uint_as_float(v.w & 0xffff0000u);
}
typedef float f32x2_t __attribute__((ext_vector_type(2)));
DI void unpack16fp8(const uint4 w, float (&f)[16]) {
    f32x2_t t;
    t = __builtin_amdgcn_cvt_pk_f32_fp8((int)w.x, false); f[0] = t[0]; f[1] = t[1];
    t = __builtin_amdgcn_cvt_pk_f32_fp8((int)w.x, true);  f[2] = t[0]; f[3] = t[1];
    t = __builtin_amdgcn_cvt_pk_f32_fp8((int)w.y, false); f[4] = t[0]; f[5] = t[1];
    t = __builtin_amdgcn_cvt_pk_f32_fp8((int)w.y, true);  f[6] = t[0]; f[7] = t[1];
    t = __builtin_amdgcn_cvt_pk_f32_fp8((int)w.z, false); f[8] = t[0]; f[9] = t[1];
    t = __builtin_amdgcn_cvt_pk_f32_fp8((int)w.z, true);  f[10] = t[0]; f[11] = t[1];
    t = __builtin_amdgcn_cvt_pk_f32_fp8((int)w.w, false); f[12] = t[0]; f[13] = t[1];
    t = __builtin_amdgcn_cvt_pk_f32_fp8((int)w.w, true);  f[14] = t[0]; f[15] = t[1];
}
struct PeerPre { int e[16]; uint4 xa, xb; float2 r; };
struct PeerRows { uint4 d[8]; float c[8]; };
template <bool UP>
DI PeerPre peer_prefetch(const Params& p, int tok, int sl, int lane) {
    PeerPre q;
    const int4* rix = (const int4*)(WSP(int, WS_RIDX) + (size_t)tok * 128 + 16 * (lane >> 3));
#pragma unroll
    for (int j = 0; j < 4; ++j) { const int4 t = rix[j]; q.e[4 * j] = t.x; q.e[4 * j + 1] = t.y; q.e[4 * j + 2] = t.z; q.e[4 * j + 3] = t.w; }
    if (UP) {
        q.r = *(const float2*)(p.out + (size_t)tok * DM + sl * 128 + 16 * (lane & 7) + 2 * (lane >> 3));
    } else {
        q.xa = *(const uint4*)(WSP(signed char, WS_XQ) + (size_t)tok * DM + sl * 128 + 16 * (lane & 7));
    }
    return q;
}
template <int HF, bool UP>
DI void peer_issue_rows(const Params& p, const unsigned char* tab, const PeerPre& q, int tok, int lane, PeerRows& R) {
    const unsigned dco = 16u * (unsigned)(lane & 7);
#pragma unroll
    for (int bi = 0; bi < 8; ++bi) R.d[bi] = *(const uint4*)(tab + ((unsigned)q.e[8 * HF + bi] * 128u + dco));
    if (UP) {
        const float4* cf = (const float4*)(WSP(float, WS_RG) + (size_t)tok * 128 + 16 * (lane >> 3) + 8 * HF);
        const float4 c0 = cf[0], c1 = cf[1];
        R.c[0] = c0.x; R.c[1] = c0.y; R.c[2] = c0.z; R.c[3] = c0.w; R.c[4] = c1.x; R.c[5] = c1.y; R.c[6] = c1.z; R.c[7] = c1.w;
    }
}
template <int HF>
DI void peer_down_half(const PeerPre& q, const PeerRows& R, float (&part)[16]) {
#pragma unroll
    for (int bi = 0; bi < 8; ++bi) {
        int a = __builtin_amdgcn_sdot4((int)R.d[bi].x, (int)q.xa.x, 0, false);
        a = __builtin_amdgcn_sdot4((int)R.d[bi].y, (int)q.xa.y, a, false);
        a = __builtin_amdgcn_sdot4((int)R.d[bi].z, (int)q.xa.z, a, false);
        a = __builtin_amdgcn_sdot4((int)R.d[bi].w, (int)q.xa.w, a, false);
        part[8 * HF + bi] = (float)a;
    }
}
DI void peer_down_fin(const Params& p, const float (&part)[16], int tok, int sl, int lane) {
    const bool b2 = lane & 4, b1 = lane & 2, b0 = lane & 1;
    float r8[8], r4[4], r2[2];
#pragma unroll
    for (int i = 0; i < 8; ++i) { const float snd = b2 ? part[i] : part[i + 8]; const float kp = b2 ? part[i + 8] : part[i]; r8[i] = kp + __shfl_xor(snd, 4); }
#pragma unroll
    for (int i = 0; i < 4; ++i) { const float snd = b1 ? r8[i] : r8[i + 4]; const float kp = b1 ? r8[i + 4] : r8[i]; r4[i] = kp + __shfl_xor(snd, 2); }
#pragma unroll
    for (int i = 0; i < 2; ++i) { const float snd = b0 ? r4[i] : r4[i + 2]; const float kp = b0 ? r4[i + 2] : r4[i]; r2[i] = kp + __shfl_xor(snd, 1); }
    float* pd = WSP(float, WS_QBUF) + ((size_t)tok * 8 + sl) * 128;
    *(float2*)(pd + 2 * lane) = make_float2(r2[0], r2[1]);
}
DI void ph_peer_comb(const Params& p, int vb, int l) {
    const int tid = otid(), lane = tid & 63;
    const int tok = vb * 4 + (tid >> 6);
    const float* pd = WSP(float, WS_QBUF) + (size_t)tok * 8 * 128;
    const int* rix = WSP(int, WS_RIDX) + (size_t)tok * 128;
    float* rgp = WSP(float, WS_RG) + (size_t)tok * 128;
    const float* dsc = WSP(float, WS_DSC) + (size_t)l * NEXP;
    const float* usc = WSP(float, WS_USC) + (size_t)l * NEXP;
    const float xs = WSP(float, WS_XSC)[tok];
#pragma unroll
    for (int hh = 0; hh < 2; ++hh) {
        const int k = lane + 64 * hh;
        float t = 0.f;
#pragma unroll
        for (int sl = 0; sl < 8; ++sl) t += pd[sl * 128 + k];
        const int e = rix[k];
        rgp[k] = rgp[k] * gelu_tanh(t * dsc[e] * xs) * usc[e];
    }
}
template <int HF>
DI void peer_up_half(const PeerPre& q, const PeerRows& R, float (&y)[16]) {
#pragma unroll
    for (int bi = 0; bi < 8; ++bi) {
        const float c = R.c[bi];
        float w[16]; unpack16fp8(R.d[bi], w);
#pragma unroll
        for (int i = 0; i < 16; ++i) y[i] += c * w[i];
        asm volatile("" : "+v"(y[0]), "+v"(y[1]), "+v"(y[2]), "+v"(y[3]), "+v"(y[4]), "+v"(y[5]), "+v"(y[6]), "+v"(y[7]), "+v"(y[8]), "+v"(y[9]), "+v"(y[10]), "+v"(y[11]), "+v"(y[12]), "+v"(y[13]), "+v"(y[14]), "+v"(y[15]));
    }
}
DI void peer_up_fin(const Params& p, const PeerPre& q, const float (&y)[16], int tok, int sl, int lane) {
    const int rg = lane >> 3, dc = lane & 7;
    const bool b5 = lane & 32, b4 = lane & 16, b3 = lane & 8;
    float r8[8], r4[4], r2[2];
#pragma unroll
    for (int i = 0; i < 8; ++i) { const float snd = b5 ? y[i] : y[i + 8]; const float kp = b5 ? y[i + 8] : y[i]; r8[i] = kp + __shfl_xor(snd, 32); }
#pragma unroll
    for (int i = 0; i < 4; ++i) { const float snd = b4 ? r8[i] : r8[i + 4]; const float kp = b4 ? r8[i + 4] : r8[i]; r4[i] = kp + __shfl_xor(snd, 16); }
#pragma unroll
    for (int i = 0; i < 2; ++i) { const float snd = b3 ? r4[i] : r4[i + 2]; const float kp = b3 ? r4[i + 2] : r4[i]; r2[i] = kp + __shfl_xor(snd, 8); }
    float2 v = q.r;
    v.x += r2[0]; v.y += r2[1];
    *(float2*)(p.out + (size_t)tok * DM + sl * 128 + 16 * dc + 2 * rg) = v;
}
template <bool UP>
DI void run_peer_sliced(const Params& p, int l, unsigned char* smem) {
    volatile LAS unsigned* st = (volatile LAS unsigned*)(smem + SMEM_BYTES);
    const int nloc = (int)st[0], nx = (int)st[1], rank = (int)st[2], xi = (int)st[3];
    const int tid = otid512(), lane = tid & 63, wave = tid >> 6;
    const int stride = nloc * 8;
#pragma unroll 1
    for (int sl = xi; sl < 8; sl += nx) {
        const unsigned char* tab = p.ws + (UP ? WS_UP : WS_DOWN) + (size_t)l * NEXP * DM + (size_t)sl * NEXP * 128;
        int tok = rank * 8 + wave;
        if (tok >= NTOK) continue;
        PeerPre qc = peer_prefetch<UP>(p, tok, sl, lane);
        PeerRows R;
        peer_issue_rows<0, UP>(p, tab, qc, tok, lane, R);
#pragma unroll 1
        for (; tok < NTOK; tok += stride) {
            const int tn = tok + stride < NTOK ? tok + stride : tok;
            const PeerPre qn = peer_prefetch<UP>(p, tn, sl, lane);
            float acc[16];
#pragma unroll
            for (int i = 0; i < 16; ++i) acc[i] = 0.f;
            PeerRows Rn;
            peer_issue_rows<1, UP>(p, tab, qc, tok, lane, Rn);
            __builtin_amdgcn_sched_barrier(0);
            if (UP) peer_up_half<0>(qc, R, acc); else peer_down_half<0>(qc, R, acc);
            __builtin_amdgcn_sched_barrier(0);
            peer_issue_rows<0, UP>(p, tab, qn, tn, lane, R);
            __builtin_amdgcn_sched_barrier(0);
            if (UP) { peer_up_half<1>(qc, Rn, acc); peer_up_fin(p, qc, acc, tok, sl, lane); }
            else { peer_down_half<1>(qc, Rn, acc); peer_down_fin(p, acc, tok, sl, lane); }
            __builtin_amdgcn_sched_barrier(0);
            qc = qn;
        }
    }
}


typedef short bf16x8 __attribute__((ext_vector_type(8)));
typedef float f32x16 __attribute__((ext_vector_type(16)));
#define MFMA32(a, b, c) __builtin_amdgcn_mfma_f32_32x32x16_bf16((a), (b), (c), 0, 0, 0)
typedef short s16x4 __attribute__((ext_vector_type(4)));
DI bf16x8 pack_p(const f32x16& pt, int s) {
    uint4 o;
    o.x = pack2(pt[8 * s + 0], pt[8 * s + 1]); o.y = pack2(pt[8 * s + 2], pt[8 * s + 3]);
    o.z = pack2(pt[8 * s + 4], pt[8 * s + 5]); o.w = pack2(pt[8 * s + 6], pt[8 * s + 7]);
    return __builtin_bit_cast(bf16x8, o);
}

DI void stage_tile(const bf16_t* __restrict__ g, int ld, int row0, int k0, unsigned char* lt, int wave, int lane) {
#pragma unroll
    for (int i = 0; i < 4; ++i) {
        const int inst = wave * 4 + i;
        const int row = inst * 8 + (lane >> 3);
        const int c = (lane & 7) ^ ((row >> 1) & 7);
        __builtin_amdgcn_global_load_lds((const unsigned*)(g + (size_t)(row0 + row) * ld + k0 + c * 8),
                                         (unsigned*)(lt + inst * 1024 + lane * 16), 16, 0, 0);
    }
}
DI bf16x8 lds_frag(const unsigned char* lt, int row, int c) {
    return *(const bf16x8*)(lt + row * 128 + ((c ^ ((row >> 1) & 7)) << 4));
}
DI int crow(int r, int fh) { return (r & 3) + 8 * (r >> 2) + 4 * fh; }

namespace pg8 {
#define PG8_LAS __attribute__((address_space(3)))
typedef float f32x4 __attribute__((ext_vector_type(4)));
typedef unsigned u32x4 __attribute__((ext_vector_type(4)));
constexpr int BM = 256, BK = 64, HALF = 128, HTB = HALF * BK * 2  , STAGE_BYTES = 8 * HTB;
__host__ __device__ __forceinline__ int lds_byte(int r, int c) { const int st = (r >> 4) * 2 + (c >> 5), rr = r & 15, cc = c & 31, ob = rr * 64 + cc * 2; return st * 1024 + (ob ^ (((ob >> 9) & 1) << 5)); }
__host__ __device__ __forceinline__ void stage_rc(int b, int& R, int& C) { const int st = b / 1024, sb = b % 1024, swz = sb ^ (((sb >> 9) & 1) << 5); R = (st >> 1) * 16 + swz / 64; C = (st & 1) * 32 + (swz % 64) / 2; }
__host__ __device__ __forceinline__ int perm32(int rho) { const int n = rho >> 4, i = rho & 15; return 8 * (i >> 2) + 4 * n + (i & 3); }
struct Unit { int pm, pn; };
struct Gemm { const bf16_t* A; const bf16_t* Bt; int M, N, K; };
struct XcdOrder {
    int ntn, nloc, nx, rank, xi, nown, total;
    __device__ __forceinline__ void init(int nmt, int ntn_, int nloc_, int nx_, int rank_, int xi_) {
        ntn = ntn_; nloc = nloc_; nx = nx_; rank = rank_; xi = xi_; nown = xi < nmt ? (nmt - xi + nx - 1) / nx : 0; total = nown * ntn; }
    __device__ __forceinline__ bool next(int i, Unit& u) const {
        const int t = rank + i * nloc; if (t >= total) return false;
        const int g4 = t / (4 * ntn), r = t - g4 * 4 * ntn;
        const int left = nown - 4 * g4, gs = left < 4 ? left : 4;
        const int nt = r / gs, mi = r - nt * gs;
        u.pm = (4 * g4 + mi) * nx + xi; u.pn = nt; return true;
    }
    __device__ __forceinline__ void a_ready(const Unit&) const {}
    __device__ __forceinline__ void done(const Unit&) const {}
};
template <class Epi, class Sched, bool ALIGN_EPI = false, bool SP2 = false>
__device__ __forceinline__ void gemm_phase(PG8_LAS unsigned char* lds, const Gemm g, const Sched& S, const Epi& E) {
    const int tid = otid512(), wid = __builtin_amdgcn_readfirstlane(tid >> 6), lane = tid & 63, wr = wid >> 2, wc = wid & 3, fr = lane & 15, fq = lane >> 4;
    const int K = g.K, nt = K / BK;
    unsigned voffA[2], voffB[2];
#pragma unroll
    for (int i = 0; i < 2; ++i) { int R, C; stage_rc(tid * 16 + i * 8192, R, C); const int Rb = Epi::PERM ? ((R & ~31) + perm32(R & 31)) : R;
        voffA[i] = (unsigned)(R * K + C) * 2u; voffB[i] = (unsigned)(Rb * K + C) * 2u; }
    const size_t kstep = (size_t)(BK * 2);
    const size_t hstep = (size_t)HALF * K * 2;
    const size_t tstep = 2 * hstep;
    const unsigned ldsw = (unsigned)wid * 1024u;
    const int aoff = lds_byte(wr * 64 + fr, fq * 8), boff = lds_byte(wc * 32 + fr, fq * 8);
#define PG8_SA(b, h) (((b) * 2 + (h)) * HTB)
#define PG8_SB(b, h) ((4 + (b) * 2 + (h)) * HTB)
#define PG8_STAGE(bufoff, gbase, voff) do { _Pragma("unroll") for (int _i = 0; _i < 2; ++_i) \
        __builtin_amdgcn_global_load_lds((const unsigned*)((const char*)(gbase) + (voff)[_i]), (PG8_LAS unsigned*)(lds + (bufoff) + ldsw + _i * 8192), 16, 0, 0); } while (0)
#define PG8_LDA(dst, b, h) do { _Pragma("unroll") for (int m = 0; m < 4; ++m) _Pragma("unroll") for (int k = 0; k < 2; ++k) dst[m][k] = *(const PG8_LAS bf16x8*)(lds + PG8_SA(b, h) + aoff + m * 2048 + k * 1024); } while (0)
#define PG8_LDB(dst, b, h) do { _Pragma("unroll") for (int n = 0; n < 2; ++n) _Pragma("unroll") for (int k = 0; k < 2; ++k) dst[n][k] = *(const PG8_LAS bf16x8*)(lds + PG8_SB(b, h) + boff + n * 2048 + k * 1024); } while (0)
#define PG8_MMA(ai, bj, At, Bt) do { __builtin_amdgcn_s_setprio(1); _Pragma("unroll") for (int m = 0; m < 4; ++m) _Pragma("unroll") for (int n = 0; n < 2; ++n) _Pragma("unroll") for (int k = 0; k < 2; ++k) \
        acc[ai][bj][m][n] = __builtin_amdgcn_mfma_f32_16x16x32_bf16(Bt[n][k], At[m][k], acc[ai][bj][m][n], 0, 0, 0); __builtin_amdgcn_s_setprio(0); } while (0)
#define PG8_WAIT_V(n) asm volatile("s_waitcnt vmcnt(" #n ")" ::: "memory")
#define PG8_WAIT_L(n) asm volatile("s_waitcnt lgkmcnt(" #n ")" ::: "memory")
#define PG8_BAR __builtin_amdgcn_s_barrier()
#define PG8_SCHED __builtin_amdgcn_sched_barrier(0)
    Unit cur, nxt; int ui = 0;
    if (!S.next(0, cur)) return;
    f32x4 acc[2][2][4][2];
#pragma unroll
    for (int a = 0; a < 2; ++a)
#pragma unroll
        for (int b = 0; b < 2; ++b)
#pragma unroll
            for (int m = 0; m < 4; ++m)
#pragma unroll
                for (int n = 0; n < 2; ++n) acc[a][b][m][n] = (f32x4){0.f, 0.f, 0.f, 0.f};
    bf16x8 At[4][2], B0[2][2], B1[2][2];
    const char* cA = (const char*)g.A + (size_t)cur.pm * tstep; const char* cB = (const char*)g.Bt + (size_t)cur.pn * tstep;
    S.a_ready(cur);
    if constexpr (SP2) {
        PG8_STAGE(PG8_SB(0, 0), cB, voffB); PG8_STAGE(PG8_SB(0, 1), cB + hstep, voffB); PG8_STAGE(PG8_SA(0, 0), cA, voffA); PG8_STAGE(PG8_SA(0, 1), cA + hstep, voffA);
        if (wr == 1) PG8_BAR;
        PG8_WAIT_V(2); PG8_BAR;
        PG8_STAGE(PG8_SB(1, 0), cB + kstep, voffB); PG8_STAGE(PG8_SA(1, 0), cA + kstep, voffA); PG8_STAGE(PG8_SB(1, 1), cB + hstep + kstep, voffB);
        PG8_WAIT_V(6); PG8_BAR;
    } else {
        PG8_STAGE(PG8_SB(0, 0), cB, voffB); PG8_STAGE(PG8_SA(0, 0), cA, voffA); PG8_STAGE(PG8_SB(0, 1), cB + hstep, voffB); PG8_STAGE(PG8_SA(0, 1), cA + hstep, voffA);
        if (wr == 1) PG8_BAR;
        PG8_WAIT_V(4); PG8_BAR;
        PG8_STAGE(PG8_SB(1, 0), cB + kstep, voffB); PG8_STAGE(PG8_SA(1, 0), cA + kstep, voffA); PG8_STAGE(PG8_SB(1, 1), cB + hstep + kstep, voffB);
        PG8_WAIT_V(6); PG8_BAR;
    }
    for (;;) {
        const bool has_next = S.next(ui + 1, nxt);
        const char* nA = has_next ? (const char*)g.A + (size_t)nxt.pm * tstep : cA; const char* nB = has_next ? (const char*)g.Bt + (size_t)nxt.pn * tstep : cB;
        for (int t = 0; t < nt; t += 2) {
            const bool last = (t == nt - 2);
            const char* a1 = cA + (size_t)(t + 1) * kstep;
            const char* a2 = last ? nA : cA + (size_t)(t + 2) * kstep; const char* b2 = last ? nB : cB + (size_t)(t + 2) * kstep;
            const char* a3 = a2 + kstep; const char* b3 = b2 + kstep;
            if (last && has_next) S.a_ready(nxt);
            if constexpr (SP2) {
            PG8_LDB(B0, 0, 0); PG8_LDB(B1, 0, 1); PG8_SCHED; PG8_LDA(At, 0, 0); PG8_STAGE(PG8_SA(1, 1), a1 + hstep, voffA);
            PG8_WAIT_V(8); PG8_WAIT_L(0); PG8_BAR; PG8_MMA(0, 0, At, B0); PG8_MMA(0, 1, At, B1); PG8_BAR; PG8_SCHED;
            PG8_LDA(At, 0, 1); PG8_STAGE(PG8_SB(0, 0), b2, voffB); PG8_STAGE(PG8_SB(0, 1), b2 + hstep, voffB); PG8_STAGE(PG8_SA(0, 0), a2, voffA);
            PG8_WAIT_V(8); PG8_WAIT_L(0); PG8_BAR; PG8_MMA(1, 0, At, B0); PG8_MMA(1, 1, At, B1); PG8_BAR; PG8_SCHED;
            PG8_LDB(B0, 1, 0); PG8_LDB(B1, 1, 1); PG8_SCHED; PG8_LDA(At, 1, 0); PG8_STAGE(PG8_SA(0, 1), a2 + hstep, voffA);
            PG8_WAIT_V(8); PG8_WAIT_L(0); PG8_BAR; PG8_MMA(0, 0, At, B0); PG8_MMA(0, 1, At, B1); PG8_BAR; PG8_SCHED;
            PG8_LDA(At, 1, 1); PG8_STAGE(PG8_SB(1, 0), b3, voffB); PG8_STAGE(PG8_SB(1, 1), b3 + hstep, voffB); PG8_STAGE(PG8_SA(1, 0), a3, voffA);
            PG8_WAIT_V(8); PG8_WAIT_L(0); PG8_BAR; PG8_MMA(1, 0, At, B0); PG8_MMA(1, 1, At, B1); PG8_BAR; PG8_SCHED;
            } else {
            PG8_LDB(B0, 0, 0); PG8_SCHED; PG8_LDA(At, 0, 0); PG8_STAGE(PG8_SA(1, 1), a1 + hstep, voffA);
            PG8_WAIT_L(8); PG8_BAR; PG8_WAIT_L(0); PG8_MMA(0, 0, At, B0); PG8_BAR; PG8_SCHED;
            PG8_LDB(B1, 0, 1); PG8_STAGE(PG8_SB(0, 0), b2, voffB);
            PG8_BAR; PG8_WAIT_L(0); PG8_MMA(0, 1, At, B1); PG8_BAR;
            PG8_LDA(At, 0, 1); PG8_STAGE(PG8_SA(0, 0), a2, voffA);
            PG8_BAR; PG8_WAIT_L(0); PG8_MMA(1, 0, At, B0); PG8_BAR; PG8_SCHED;
            PG8_STAGE(PG8_SB(0, 1), b2 + hstep, voffB);
            PG8_WAIT_V(6); PG8_BAR; PG8_MMA(1, 1, At, B1); PG8_BAR;
            PG8_LDB(B0, 1, 0); PG8_SCHED; PG8_LDA(At, 1, 0); PG8_STAGE(PG8_SA(0, 1), a2 + hstep, voffA);
            PG8_WAIT_L(8); PG8_BAR; PG8_WAIT_L(0); PG8_MMA(0, 0, At, B0); PG8_BAR; PG8_SCHED;
            PG8_LDB(B1, 1, 1); PG8_STAGE(PG8_SB(1, 0), b3, voffB);
            PG8_BAR; PG8_WAIT_L(0); PG8_MMA(0, 1, At, B1); PG8_BAR;
            PG8_LDA(At, 1, 1); PG8_STAGE(PG8_SA(1, 0), a3, voffA);
            PG8_BAR; PG8_WAIT_L(0); PG8_MMA(1, 0, At, B0); PG8_BAR; PG8_SCHED;
            PG8_STAGE(PG8_SB(1, 1), b3 + hstep, voffB);
            PG8_WAIT_V(6); PG8_BAR; PG8_MMA(1, 1, At, B1); PG8_BAR;
            }
        }
        if constexpr (ALIGN_EPI) { if (wr == 0) PG8_BAR; }
        if constexpr (!Epi::AFTER_DRAIN) { E(acc, cur, wr, wc, fr, fq); S.done(cur); }
        if (!has_next) break;
#pragma unroll
        for (int a = 0; a < 2; ++a)
#pragma unroll
            for (int b = 0; b < 2; ++b)
#pragma unroll
                for (int m = 0; m < 4; ++m)
#pragma unroll
                    for (int n = 0; n < 2; ++n) acc[a][b][m][n] = (f32x4){0.f, 0.f, 0.f, 0.f};
        cur = nxt; cA = nA; cB = nB; ++ui;
        if constexpr (ALIGN_EPI) { if (wr == 1) PG8_BAR; }
    }
    PG8_WAIT_V(0);
    if constexpr (!ALIGN_EPI) { if (wr == 0) PG8_BAR; }
    PG8_BAR;
    if constexpr (Epi::AFTER_DRAIN) { E.fused(acc, cur, wr, wc, fr, fq, lds, wid, lane); S.done(cur); }
#undef PG8_SA
#undef PG8_SB
#undef PG8_STAGE
#undef PG8_LDA
#undef PG8_LDB
#undef PG8_MMA
#undef PG8_WAIT_V
#undef PG8_WAIT_L
#undef PG8_BAR
#undef PG8_SCHED
}
struct EpiResid {
    static constexpr bool PERM = true, AFTER_DRAIN = false;
    const float* resid; float* out;
    __device__ __forceinline__ void operator()(const f32x4 (&acc)[2][2][4][2], const Unit& u, int wr, int wc, int fr, int fq) const {
        const size_t base = (size_t)(u.pm * BM + wr * 64 + fr) * DM + u.pn * BM + wc * 32 + 8 * fq;
#pragma unroll
        for (int ai = 0; ai < 2; ++ai) {
            f32x4 rv[4][2][2];
#pragma unroll
            for (int m = 0; m < 4; ++m)
#pragma unroll
                for (int bj = 0; bj < 2; ++bj) {
                    const float* rp = resid + base + (size_t)(ai * HALF + m * 16) * DM + bj * HALF;
                    rv[m][bj][0] = *(const f32x4*)rp; rv[m][bj][1] = *(const f32x4*)(rp + 4);
                }
            asm volatile("" ::: "memory");
#pragma unroll
            for (int m = 0; m < 4; ++m)
#pragma unroll
                for (int bj = 0; bj < 2; ++bj) {
                    float* op = out + base + (size_t)(ai * HALF + m * 16) * DM + bj * HALF;
                    *(f32x4*)op = rv[m][bj][0] + acc[ai][bj][m][0]; *(f32x4*)(op + 4) = rv[m][bj][1] + acc[ai][bj][m][1];
                }
            asm volatile("" ::: "memory");
        }
    }
};
struct EpiProj {
    static constexpr bool PERM = true, AFTER_DRAIN = false;
    const float* aq; const float* ak; const float* bq; const float* bk; bf16_t* proj; PG8_LAS float* xs;
    __device__ __forceinline__ void operator()(const f32x4 (&acc)[2][2][4][2], const Unit& u, int wr, int wc, int fr, int fq) const {
        const int wave = wr * 4 + wc;
#pragma unroll
        for (int ai = 0; ai < 2; ++ai)
#pragma unroll
            for (int m = 0; m < 4; ++m)
#pragma unroll
                for (int bj = 0; bj < 2; ++bj) {
                    const f32x4 a = acc[ai][bj][m][0], b = acc[ai][bj][m][1];
                    float t = a[0] * a[0] + a[1] * a[1] + a[2] * a[2] + a[3] * a[3] + b[0] * b[0] + b[1] * b[1] + b[2] * b[2] + b[3] * b[3];
                    t += __shfl_xor(t, 16); t += __shfl_xor(t, 32);
                    if (fq == 0) xs[wave * 256 + ((ai * 4 + m) * 2 + bj) * 16 + fr] = t;
                }
        asm volatile("s_waitcnt lgkmcnt(0)" ::: "memory");
        __builtin_amdgcn_s_barrier();
#pragma unroll
        for (int bj = 0; bj < 2; ++bj) {
            const int gcol = u.pn * BM + bj * HALF + wc * 32 + 8 * fq;
            const float* gain = nullptr; float scale = 1.f;
            if (gcol < 512) { gain = aq + (gcol & 63); scale = 0.125f; }
            else if (gcol < 1024) gain = ak + (gcol & 63);
            else if (gcol < 1536) gain = nullptr;
            else if (gcol < 2048) { gain = bq + (gcol & 127); scale = 0.125f; }
            else if (gcol < 2560) gain = bk + (gcol & 127);
            f32x4 g0 = {1.f, 1.f, 1.f, 1.f}, g1 = {1.f, 1.f, 1.f, 1.f};
            if (gain) { g0 = *(const f32x4*)gain; g1 = *(const f32x4*)(gain + 4); }
#pragma unroll
            for (int ai = 0; ai < 2; ++ai)
#pragma unroll
                for (int m = 0; m < 4; ++m) {
                    float sc = 1.f;
                    if (gain) {
                        const int slot = ((ai * 4 + m) * 2 + bj) * 16 + fr;
                        sc = rsqrtf((xs[wave * 256 + slot] + xs[(wave ^ 1) * 256 + slot]) * (1.f / 64.f) + EPSN) * scale;
                    }
                    const f32x4 v0 = acc[ai][bj][m][0] * g0 * sc, v1 = acc[ai][bj][m][1] * g1 * sc;
                    u32x4 w; w.x = pack2(v0[0], v0[1]); w.y = pack2(v0[2], v0[3]); w.z = pack2(v1[0], v1[1]); w.w = pack2(v1[2], v1[3]);
                    *(u32x4*)(proj + (size_t)(u.pm * BM + ai * HALF + wr * 64 + m * 16 + fr) * ATT_IN + gcol) = w;
                }
        }
    }
};
struct EpiSgu {
    static constexpr bool PERM = true, AFTER_DRAIN = false;
    bf16_t* zu; bf16_t* zvt; float* ssq; PG8_LAS unsigned char* stg;
    __device__ __forceinline__ void operator()(const f32x4 (&acc)[2][2][4][2], const Unit& u, int wr, int wc, int fr, int fq) const {
        const int wave = wr * 4 + wc, lane = fq * 16 + fr;
        PG8_LAS unsigned short* tl = (PG8_LAS unsigned short*)(stg + wave * 2048);
#pragma unroll
        for (int ai = 0; ai < 2; ++ai)
#pragma unroll
            for (int bj = 0; bj < 2; ++bj) {
                const int gcol = u.pn * BM + bj * HALF + wc * 32 + 8 * fq;
                f32x4 g0[4], g1[4];
#pragma unroll
                for (int m = 0; m < 4; ++m) {
                    const f32x4 a = acc[ai][bj][m][0], b = acc[ai][bj][m][1];
                    g0[m] = (f32x4){gelu_tanh(a[0]), gelu_tanh(a[1]), gelu_tanh(a[2]), gelu_tanh(a[3])};
                    g1[m] = (f32x4){gelu_tanh(b[0]), gelu_tanh(b[1]), gelu_tanh(b[2]), gelu_tanh(b[3])};
                }
                if (gcol < CW) {
#pragma unroll
                    for (int m = 0; m < 4; ++m) {
                        u32x4 w; w.x = pack2(g0[m][0], g0[m][1]); w.y = pack2(g0[m][2], g0[m][3]); w.z = pack2(g1[m][0], g1[m][1]); w.w = pack2(g1[m][2], g1[m][3]);
                        *(u32x4*)(zu + (size_t)(u.pm * BM + ai * HALF + wr * 64 + m * 16 + fr) * CW + gcol) = w;
                    }
                } else {
                    const int vcol = gcol - CW;
#pragma unroll
                    for (int m = 0; m < 4; ++m) {
                        float t = g0[m][0] * g0[m][0] + g0[m][1] * g0[m][1] + g0[m][2] * g0[m][2] + g0[m][3] * g0[m][3]
                                + g1[m][0] * g1[m][0] + g1[m][1] * g1[m][1] + g1[m][2] * g1[m][2] + g1[m][3] * g1[m][3];
                        t += __shfl_xor(t, 16); t += __shfl_xor(t, 32);
                        if (fq == 0) ssq[(size_t)(u.pm * BM + ai * HALF + wr * 64 + m * 16 + fr) * 64 + (vcol >> 5)] = t;
                    }
#pragma unroll
                    for (int h = 0; h < 2; ++h) {
#pragma unroll
                        for (int mm = 0; mm < 2; ++mm) {
                            const int m = 2 * h + mm, rl = 16 * mm + fr;
#pragma unroll
                            for (int j = 0; j < 4; ++j) { tl[(8 * fq + j) * 32 + rl] = f2bf(g0[m][j]); tl[(8 * fq + 4 + j) * 32 + rl] = f2bf(g1[m][j]); }
                        }
                        const int c = lane >> 1, hh = lane & 1;
                        const u32x4 w0 = *(const PG8_LAS u32x4*)(tl + c * 32 + hh * 16), w1 = *(const PG8_LAS u32x4*)(tl + c * 32 + hh * 16 + 8);
                        bf16_t* dst = zvt + ((size_t)(2 * u.pm + ai) * CW + (u.pn * BM - CW) + bj * HALF + wc * 32 + c) * 128 + wr * 64 + 32 * h + hh * 16;
                        *(u32x4*)dst = w0; *(u32x4*)(dst + 8) = w1;
                        asm volatile("" ::: "memory");
                    }
                }
            }
    }
};
struct EpiQ {
    static constexpr bool PERM = true, AFTER_DRAIN = false;
    bf16_t* q;
    __device__ __forceinline__ void operator()(const f32x4 (&acc)[2][2][4][2], const Unit& u, int wr, int wc, int fr, int fq) const {
#pragma unroll
        for (int ai = 0; ai < 2; ++ai)
#pragma unroll
            for (int m = 0; m < 4; ++m)
#pragma unroll
                for (int bj = 0; bj < 2; ++bj) {
                    const f32x4 a = acc[ai][bj][m][0], b = acc[ai][bj][m][1];
                    u32x4 w; w.x = pack2(a[0], a[1]); w.y = pack2(a[2], a[3]); w.z = pack2(b[0], b[1]); w.w = pack2(b[2], b[3]);
                    *(u32x4*)(q + (size_t)(u.pm * BM + ai * HALF + wr * 64 + m * 16 + fr) * 2048 + u.pn * BM + bj * HALF + wc * 32 + 8 * fq) = w;
                }
    }
};
}
DI void run_gemmq_pg8(const Params& p, int l, unsigned char* smem) {
    volatile LAS unsigned* st = (volatile LAS unsigned*)(smem + SMEM_BYTES);
    pg8::XcdOrder S; S.init(NTOK / 256, 2048 / 256, (int)st[0], (int)st[1], (int)st[2], (int)st[3]);
    const pg8::Gemm g{WSP(bf16_t, WS_XN), WSP(bf16_t, WS_W_PQ) + (size_t)l * 2048 * DM, NTOK, 2048, DM};
    pg8::EpiQ E; E.q = WSP(bf16_t, WS_QBUF);
    __syncthreads();
    pg8::gemm_phase<pg8::EpiQ, pg8::XcdOrder, true, true>((PG8_LAS unsigned char*)smem, g, S, E);
}
template <int WHICH>
DI void run_gemm_pg8(const Params& p, unsigned char* smem) {
    volatile LAS unsigned* st = (volatile LAS unsigned*)(smem + SMEM_BYTES);
    pg8::XcdOrder S; S.init(NTOK / 256, DM / 256, (int)st[0], (int)st[1], (int)st[2], (int)st[3]);
    pg8::Gemm g;
    pg8::EpiResid E;
    if (WHICH == 0) { g = pg8::Gemm{WSP(bf16_t, WS_MIXED), WSP(bf16_t, WS_W_ATTOUT), NTOK, DM, DM}; E.resid = p.in[0]; E.out = p.out; }
    else { g = pg8::Gemm{WSP(bf16_t, WS_Z_U), WSP(bf16_t, WS_W_SGUOUT), NTOK, DM, CW}; E.resid = p.out; E.out = p.out; }
    __syncthreads();
    pg8::gemm_phase<pg8::EpiResid, pg8::XcdOrder, true, true>((PG8_LAS unsigned char*)smem, g, S, E);
}

DI void run_gemm1_pg8(const Params& p, unsigned char* smem) {
    volatile LAS unsigned* st = (volatile LAS unsigned*)(smem + SMEM_BYTES);
    pg8::XcdOrder S; S.init(NTOK / 256, ATT_IN / 256, (int)st[0], (int)st[1], (int)st[2], (int)st[3]);
    const pg8::Gemm g{WSP(bf16_t, WS_XN), WSP(bf16_t, WS_W_ATTIN), NTOK, ATT_IN, DM};
    pg8::EpiProj E; E.aq = p.in[3]; E.ak = p.in[4]; E.bq = p.in[5]; E.bk = p.in[6]; E.proj = WSP(bf16_t, WS_PROJ); E.xs = (PG8_LAS float*)(smem + PG8_EXTRA);
    __syncthreads();
    pg8::gemm_phase<pg8::EpiProj, pg8::XcdOrder, true, true>((PG8_LAS unsigned char*)smem, g, S, E);
}
DI void run_gemm4_pg8(const Params& p, unsigned char* smem) {
    volatile LAS unsigned* st = (volatile LAS unsigned*)(smem + SMEM_BYTES);
    pg8::XcdOrder S; S.init(NTOK / 256, 4096 / 256, (int)st[0], (int)st[1], (int)st[2], (int)st[3]);
    const pg8::Gemm g{WSP(bf16_t, WS_XN), WSP(bf16_t, WS_W_SGUIN), NTOK, 4096, DM};
    pg8::EpiSgu E; E.zu = WSP(bf16_t, WS_Z_U); E.zvt = WSP(bf16_t, WS_Z_VT); E.ssq = WSP(float, WS_SSQ); E.stg = (PG8_LAS unsigned char*)(smem + PG8_EXTRA);
    __syncthreads();
    pg8::gemm_phase<pg8::EpiSgu, pg8::XcdOrder, true, true>((PG8_LAS unsigned char*)smem, g, S, E);
}

DI u32 cand_key(float s, int ci) { return (f2ord(s) & ~255u) | (u32)(255 - ci); }
template <int P>
DI void score_half(const bf16_t* __restrict__ qrow, const bf16_t* __restrict__ skh, int fr, int fh, u32 (&lst)[16]) {
    bf16x8 qf[8];
#pragma unroll
    for (int ks = 0; ks < 8; ++ks) qf[ks] = *(const bf16x8*)(qrow + P * 128 + 16 * ks);
#pragma unroll
    for (int j = 0; j < 16; ++j) lst[j] = 0u;
#pragma unroll 1
    for (int kt = 0; kt < 4; ++kt) {
        f32x16 st;
#pragma unroll
        for (int r = 0; r < 16; ++r) st[r] = 0.f;
        const bf16_t* skr = skh + ((size_t)P * 128 + kt * 32 + fr) * 128 + 8 * fh;
#pragma unroll
        for (int ks = 0; ks < 8; ++ks) st = MFMA32(*(const bf16x8*)(skr + 16 * ks), qf[ks], st);
        u32 ks_[16];
#pragma unroll
        for (int r = 0; r < 16; ++r) ks_[r] = (f2ord(st[r]) & ~127u) | (u32)(127 - (kt * 32 + crow(r, fh)));
        sort16_desc(ks_);
        merge16_desc(lst, ks_);
    }
    u32 other[16];
#pragma unroll
    for (int j = 0; j < 16; ++j) other[j] = (u32)__shfl_xor((int)lst[j], 32);
    merge16_desc(lst, other);
}
DI void ph_score(const Params& p, int vb, int l, unsigned char* smem) {
    const int tid = otid(), wave = tid >> 6, lane = tid & 63, fr = lane & 31, fh = lane >> 5;
    const int it = vb * 4 + wave, tile = it >> 3, h = it & 7;
    const int tok = tile * 32 + fr;
    const bf16_t* qrow = WSP(bf16_t, WS_QBUF) + (size_t)tok * 2048 + h * 256 + 8 * fh;
    const bf16_t* skh = WSP(bf16_t, WS_W_SUBK) + ((size_t)l * 16 + h * 2) * 128 * 128;
    u32 L0[16], L1[16];
    score_half<0>(qrow, skh, fr, fh, L0);
    score_half<1>(qrow, skh, fr, fh, L1);
    LAS int* slot = (LAS int*)(smem + wave * (64 * 132)) + lane * 33;
    float s1[16], s2[16];
#pragma unroll
    for (int j = 0; j < 16; ++j) {
        s1[j] = ord2f(L0[j] & ~127u); s2[j] = ord2f(L1[j] & ~127u);
        slot[j] = 127 - (int)(L0[j] & 127u); slot[16 + j] = 127 - (int)(L1[j] & 127u);
    }
    u32 lst[16];
#pragma unroll
    for (int j = 0; j < 16; ++j) lst[j] = cand_key(s1[0] + s2[j], j);
#pragma unroll
    for (int i = 1; i < 5; ++i) {
        u32 row[16];
#pragma unroll
        for (int j = 0; j < 16; ++j) row[j] = ((i + 1) * (j + 1) <= 16) ? cand_key(s1[i] + s2[j], i * 16 + j) : 0u;
        merge16_desc(lst, row);
    }
#pragma unroll
    for (int i = 5; i < 16; ++i)
#pragma unroll
        for (int j = 0; j < 2; ++j)
            if ((i + 1) * (j + 1) <= 16) top16_insert(lst, cand_key(s1[i] + s2[j], i * 16 + j));
    float pv[16]; float sum = 0.f;
    const float mx = ord2f(lst[0] & ~255u);
#pragma unroll
    for (int j = 0; j < 16; ++j) { pv[j] = __expf(ord2f(lst[j] & ~255u) - mx); sum += pv[j]; }
    const float inv = 1.f / sum;
    int ev[16];
#pragma unroll
    for (int j = 0; j < 16; ++j) {
        const int ci = 255 - (int)(lst[j] & 255u);
        ev[j] = slot[ci >> 4] * 128 + slot[16 + (ci & 15)];
    }
    if (fh == 0) {
        int4* ro = (int4*)(WSP(int, WS_RIDX) + (size_t)tok * 128 + h * 16);
        float4* go = (float4*)(WSP(float, WS_RG) + (size_t)tok * 128 + h * 16);
#pragma unroll
        for (int q = 0; q < 4; ++q) {
            ro[q] = make_int4(ev[4 * q], ev[4 * q + 1], ev[4 * q + 2], ev[4 * q + 3]);
            go[q] = make_float4(pv[4 * q] * inv, pv[4 * q + 1] * inv, pv[4 * q + 2] * inv, pv[4 * q + 3] * inv);
        }
    }
}


#define OSM_THR 8.0f
DI void osm_update(f32x16& s, unsigned vm, float& m, float& lh, float& alpha) {
    float mx = -1e30f;
#pragma unroll
    for (int r = 0; r < 16; ++r) mx = ((vm >> r) & 1u) ? fmaxf(mx, s[r]) : mx;
    mx = fmaxf(mx, __shfl_xor(mx, 32));
    float mn = m; alpha = 1.f;
    if (!__all(mx <= m + OSM_THR)) { mn = fmaxf(m, mx); alpha = __expf(m - mn); }
    float ls = 0.f;
#pragma unroll
    for (int r = 0; r < 16; ++r) { const float pe = ((vm >> r) & 1u) ? __expf(s[r] - mn) : 0.f; s[r] = pe; ls += pe; }
    lh = lh * alpha + ls; m = mn;
}
DI void osm_update_full(f32x16& s, float& m, float& lh, float& alpha) {
    float mx = s[0];
#pragma unroll
    for (int r = 1; r < 16; ++r) mx = fmaxf(mx, s[r]);
    mx = fmaxf(mx, __shfl_xor(mx, 32));
    float mn = m; alpha = 1.f;
    if (!__all(mx <= m + OSM_THR)) { mn = fmaxf(m, mx); alpha = __expf(m - mn); }
    float ls = 0.f;
#pragma unroll
    for (int r = 0; r < 16; ++r) { const float pe = __expf(s[r] - mn); s[r] = pe; ls += pe; }
    lh = lh * alpha + ls; m = mn;
}
DI void tr_quad(const unsigned (&a)[4], unsigned hi_off, bf16x8 (&f)[4]) {
    s16x4 l0, h0, l1, h1, l2, h2, l3, h3;
    const unsigned b0 = a[0] + hi_off, b1 = a[1] + hi_off, b2 = a[2] + hi_off, b3 = a[3] + hi_off;
    asm volatile("ds_read_b64_tr_b16 %0, %8\n\tds_read_b64_tr_b16 %1, %9\n\tds_read_b64_tr_b16 %2, %10\n\tds_read_b64_tr_b16 %3, %11\n\t"
                 "ds_read_b64_tr_b16 %4, %12\n\tds_read_b64_tr_b16 %5, %13\n\tds_read_b64_tr_b16 %6, %14\n\tds_read_b64_tr_b16 %7, %15\n\ts_waitcnt lgkmcnt(0)"
                 : "=&v"(l0), "=&v"(h0), "=&v"(l1), "=&v"(h1), "=&v"(l2), "=&v"(h2), "=&v"(l3), "=&v"(h3)
                 : "v"(a[0]), "v"(b0), "v"(a[1]), "v"(b1), "v"(a[2]), "v"(b2), "v"(a[3]), "v"(b3) : "memory");
    f[0] = __builtin_shufflevector(l0, h0, 0, 1, 2, 3, 4, 5, 6, 7); f[1] = __builtin_shufflevector(l1, h1, 0, 1, 2, 3, 4, 5, 6, 7);
    f[2] = __builtin_shufflevector(l2, h2, 0, 1, 2, 3, 4, 5, 6, 7); f[3] = __builtin_shufflevector(l3, h3, 0, 1, 2, 3, 4, 5, 6, 7);
}

#define QB_BYTES (128 * 256)
#define KB_BYTES (32 * 256)
template <bool WITH_V>
DI void attnB_stage_kv(const bf16_t* __restrict__ kg  , unsigned char* Kd, unsigned char* Vd, int wave, int lane) {
#pragma unroll
    for (int i = 0; i < 2; ++i) {
        const int idx = wave * 2 + i;
        const int key = 4 * idx + (lane >> 4), cp = lane & 15;
        const bf16_t* g = kg + (size_t)key * ATT_IN;
        __builtin_amdgcn_global_load_lds((const unsigned*)(g + ((cp ^ (key & 15)) << 3)), (unsigned*)(Kd + idx * 1024 + lane * 16), 16, 0, 0);
        if (WITH_V) {
            const int cv = ((((cp >> 2) ^ (key & 3)) << 2) | (cp & 3));
            __builtin_amdgcn_global_load_lds((const unsigned*)(g + 512 + (cv << 3)), (unsigned*)(Vd + idx * 1024 + lane * 16), 16, 0, 0);
        }
    }
}
template <int KOFF, bool FULL>
DI void attnB_map(const unsigned char* Kc, const unsigned char* qlp, int ksw, int qsw, int fh, unsigned vm, unsigned vc, int tq,
                  float& m, float& l, f32x16 (&o)[4]) {
    f32x16 st;
#pragma unroll
    for (int r = 0; r < 16; ++r) st[r] = 0.f;
#pragma unroll
    for (int s = 0; s < 4; ++s) {
        const bf16x8 kf = *(const bf16x8*)(Kc + (((KOFF + 2 * s + fh) ^ ksw) << 4));
        const bf16x8 qf = *(const bf16x8*)(qlp + (((KOFF + 2 * s + fh) ^ qsw) << 4));
        st = MFMA32(kf, qf, st);
    }
    float al;
    if (FULL) osm_update_full(st, m, l, al); else osm_update(st, vm, m, l, al);
    if (!__all(al == 1.f)) {
#pragma unroll
        for (int d = 0; d < 4; ++d)
#pragma unroll
            for (int r = 0; r < 16; ++r) o[d][r] *= al;
    }
#pragma unroll
    for (int s = 0; s < 2; ++s) {
        const bf16x8 pf = pack_p(st, s);
        unsigned va[4]; bf16x8 vf[4];
#pragma unroll
        for (int d = 0; d < 4; ++d) va[d] = vc + s * 16 * 256 + ((d ^ tq) << 6);
        tr_quad(va, 8 * 256, vf);
#pragma unroll
        for (int d = 0; d < 4; ++d) o[d] = MFMA32(vf[d], pf, o[d]);
    }
}
DI void ph_attnB_fast(const Params& p, int item, unsigned char* smem) {
    const bf16_t* proj = WSP(bf16_t, WS_PROJ);
    const int tid = otid(), wave = tid >> 6, lane = tid & 63, fr = lane & 31, fh = lane >> 5;
    const int qt = 15 - (item >> 6), bh = item & 63, b = bh >> 2, h = bh & 3;
    const int q0 = qt * 128;
    const float lam = compute_lam(p, lane);
    const size_t rowbase = (size_t)b * SEQ;
    const int qrow = wave * 32 + fr, qpos = q0 + qrow;
    unsigned char* Ql = smem;
    unsigned char* Kl = smem + QB_BYTES;
    unsigned char* Vl = Kl + 2 * KB_BYTES;
    const bf16_t* kbase = proj + rowbase * ATT_IN + 2048 + h * 128;
    __syncthreads();
#pragma unroll
    for (int i = 0; i < 8; ++i) {
        const int idx = wave * 8 + i;
        const int row = 4 * idx + (lane >> 4), cp = lane & 15;
        __builtin_amdgcn_global_load_lds((const unsigned*)(proj + (rowbase + q0 + row) * ATT_IN + 1536 + h * 128 + ((cp ^ (row & 15)) << 3)),
                                         (unsigned*)(Ql + idx * 1024 + lane * 16), 16, 0, 0);
    }
    attnB_stage_kv<true>(kbase, Kl, Vl, wave, lane);
    const unsigned char* qlp = Ql + qrow * 256;
    const int qsw = qrow & 15, ksw = fr & 15;
    const int nkt = (q0 + 128) / 32;
    const int wlast = q0 + wave * 32 + 31;
    f32x16 o1[4], o2[4];
#pragma unroll
    for (int d = 0; d < 4; ++d)
#pragma unroll
        for (int r = 0; r < 16; ++r) { o1[d][r] = 0.f; o2[d][r] = 0.f; }
    float m1 = -1e30f, m2 = -1e30f, l1 = 0.f, l2 = 0.f;
    const int tq = (lane & 15) >> 2;
    const unsigned vrow = (unsigned)(uintptr_t)Vl + (4 * fh + tq) * 256 + (16 * ((lane >> 4) & 1) + 4 * (lane & 3)) * 2;
    asm volatile("s_waitcnt vmcnt(0)" ::: "memory");
    __syncthreads();
    for (int kt = 0; kt < nkt; ++kt) {
        const int cur = kt & 1;
        if (kt + 1 < nkt) attnB_stage_kv<true>(kbase + (size_t)(kt + 1) * 32 * ATT_IN, Kl + (cur ^ 1) * KB_BYTES, Vl + (cur ^ 1) * KB_BYTES, wave, lane);
        if (kt * 32 <= wlast) {
            const unsigned char* Kc = Kl + cur * KB_BYTES + fr * 256;
            const unsigned vc = vrow + cur * KB_BYTES;
            if (kt * 32 + 31 <= wlast - 31) {
                attnB_map<0, true>(Kc, qlp, ksw, qsw, fh, 0xffffu, vc, tq, m1, l1, o1);
                __builtin_amdgcn_sched_barrier(0);
                attnB_map<8, true>(Kc, qlp, ksw, qsw, fh, 0xffffu, vc, tq, m2, l2, o2);
            } else {
                unsigned vm = 0;
#pragma unroll
                for (int r = 0; r < 16; ++r) vm |= ((kt * 32 + crow(r, fh)) <= qpos) ? (1u << r) : 0u;
                attnB_map<0, false>(Kc, qlp, ksw, qsw, fh, vm, vc, tq, m1, l1, o1);
                __builtin_amdgcn_sched_barrier(0);
                attnB_map<8, false>(Kc, qlp, ksw, qsw, fh, vm, vc, tq, m2, l2, o2);
            }
        }
        asm volatile("s_waitcnt vmcnt(0)" ::: "memory");
        __syncthreads();
    }
    l1 += __shfl_xor(l1, 32); l2 += __shfl_xor(l2, 32);
    const float i1 = 1.f / l1, i2 = lam / l2;
    float ss = 0.f;
#pragma unroll
    for (int d = 0; d < 4; ++d)
#pragma unroll
        for (int r = 0; r < 16; ++r) { const float v = o1[d][r] * i1 - o2[d][r] * i2; o1[d][r] = v; ss += v * v; }
    ss += __shfl_xor(ss, 32);
    const float rinv = rsqrtf(ss * (1.f / 128.f) + EPSN) * 0.8f;
    const float* subg = p.in[11];
    bf16_t* op = WSP(bf16_t, WS_MIXED) + (rowbase + qpos) * DM + 512 + h * 128;
#pragma unroll
    for (int d = 0; d < 4; ++d)
#pragma unroll
        for (int g = 0; g < 4; ++g) {
            const int dim = 32 * d + 8 * g + 4 * fh;
            const float4 gg = *(const float4*)(subg + dim);
            uint2 w;
            w.x = pack2(o1[d][4 * g + 0] * rinv * gg.x, o1[d][4 * g + 1] * rinv * gg.y);
            w.y = pack2(o1[d][4 * g + 2] * rinv * gg.z, o1[d][4 * g + 3] * rinv * gg.w);
            *(uint2*)(op + dim) = w;
        }
}

#define KA_PITCH 128
#define VA_PITCH 192
#define WA_BYTES (32 * KA_PITCH + 32 * VA_PITCH)
template <int MODE>
DI void ph_attnA_fast(const Params& p, int item, unsigned char* smem) {
    const bf16_t* proj = WSP(bf16_t, WS_PROJ);
    const int tid = otid(), wave = tid >> 6, lane = tid & 63, fr = lane & 31, fh = lane >> 5;
    const int c = item & 15, h = (item >> 4) & 7, b = item >> 7;
    const size_t rowbase = (size_t)b * SEQ;
    const int qpos = MODE == 0 ? 128 * c + 32 * wave + fr : 16 * (32 * wave + fr) + c;
    const int pmin = MODE == 0 ? 128 * c + 32 * wave : 512 * wave + c, pmax = pmin + (MODE == 0 ? 31 : 496);
    bf16x8 qf[4];
    {
        const bf16_t* qp = proj + (rowbase + qpos) * ATT_IN + h * 64 + 8 * fh;
#pragma unroll
        for (int s = 0; s < 4; ++s) qf[s] = *(const bf16x8*)(qp + 16 * s);
    }
    f32x16 o[2];
#pragma unroll
    for (int d = 0; d < 2; ++d)
#pragma unroll
        for (int r = 0; r < 16; ++r) o[d][r] = 0.f;
    float m = -1e30f, l = 0.f;
    unsigned char* Kl = smem + wave * WA_BYTES;
    unsigned char* Vl = Kl + 32 * KA_PITCH;
    const unsigned vaddr = (unsigned)(uintptr_t)Vl + (4 * fh + ((lane & 15) >> 2)) * VA_PITCH + (16 * ((lane >> 4) & 1) + 4 * (lane & 3)) * 2;
    const int skey = lane >> 3, sc = lane & 7;
    __syncthreads();
    int br = 0, d = MODE == 0 ? 1 : 16, W = MODE == 0 ? 128 : 2048, cls = MODE == 0 ? 0 : (c & 15);
    int j0 = MODE == 0 ? (pmin < 128 ? 0 : pmin - 128) : 0, jhi = MODE == 0 ? pmax : ((pmax - cls) >> 4);
    const bf16_t* kvbase = proj + rowbase * ATT_IN + 512 + h * 64 + sc * 8;
    uint4 rk0, rk1, rk2, rk3, rv0, rv1, rv2, rv3;
#define A_LOAD(i, RK, RV) do { int kp_ = cls + d * (j0 + skey + 8 * (i)); kp_ = kp_ > SEQ - 1 ? SEQ - 1 : kp_; kp_ = kp_ < 0 ? 0 : kp_; \
        const bf16_t* g_ = kvbase + (size_t)kp_ * ATT_IN; RK = *(const uint4*)g_; RV = *(const uint4*)(g_ + 512); } while (0)
#define A_WRITE(i, RK, RV) do { const int key_ = skey + 8 * (i); *(uint4*)(Kl + key_ * KA_PITCH + ((sc ^ ((key_ >> 1) & 7)) << 4)) = RK; \
        *(uint4*)(Vl + key_ * VA_PITCH + sc * 16) = RV; } while (0)
    A_LOAD(0, rk0, rv0); A_LOAD(1, rk1, rv1); A_LOAD(2, rk2, rv2); A_LOAD(3, rk3, rv3);
#pragma unroll 1
    for (;;) {
        A_WRITE(0, rk0, rv0); A_WRITE(1, rk1, rv1); A_WRITE(2, rk2, rv2); A_WRITE(3, rk3, rv3);
        const int cd = d, cW = W, ccls = cls, cj0 = j0;
        bool more = true;
        j0 += 32;
        if (j0 > jhi) {
            ++br;
            if (MODE == 0 || br == 2) more = false;
            else {
                d = 4; W = 512; cls = c & 3;
                const int lo = pmin - cls - W;
                j0 = lo < 0 ? 0 : lo >> 2;
                jhi = (pmax - cls) >> 2;
            }
        }
        A_LOAD(0, rk0, rv0); A_LOAD(1, rk1, rv1); A_LOAD(2, rk2, rv2); A_LOAD(3, rk3, rv3);
        f32x16 st;
#pragma unroll
        for (int r = 0; r < 16; ++r) st[r] = 0.f;
#pragma unroll
        for (int s = 0; s < 4; ++s) {
            const bf16x8 kf = *(const bf16x8*)(Kl + fr * KA_PITCH + (((2 * s + fh) ^ ((fr >> 1) & 7)) << 4));
            st = MFMA32(kf, qf[s], st);
        }
        float al;
        const int kfirst = ccls + cd * cj0, klast = kfirst + cd * 31;
        if (klast <= pmin && pmax - kfirst <= cW) osm_update_full(st, m, l, al);
        else {
            unsigned vm = 0;
#pragma unroll
            for (int r = 0; r < 16; ++r) {
                const int dist = qpos - (ccls + cd * (cj0 + crow(r, fh)));
                vm |= (dist >= 0 && dist <= cW) ? (1u << r) : 0u;
            }
            osm_update(st, vm, m, l, al);
        }
        if (!__all(al == 1.f)) {
#pragma unroll
            for (int dd = 0; dd < 2; ++dd)
#pragma unroll
                for (int r = 0; r < 16; ++r) o[dd][r] *= al;
        }
        {
            unsigned va[4]; bf16x8 vf[4];
            va[0] = vaddr; va[1] = vaddr + 64; va[2] = vaddr + 16 * VA_PITCH; va[3] = vaddr + 16 * VA_PITCH + 64;
            tr_quad(va, 8 * VA_PITCH, vf);
            const bf16x8 p0 = pack_p(st, 0), p1 = pack_p(st, 1);
            o[0] = MFMA32(vf[0], p0, o[0]); o[1] = MFMA32(vf[1], p0, o[1]);
            o[0] = MFMA32(vf[2], p1, o[0]); o[1] = MFMA32(vf[3], p1, o[1]);
        }
        if (!more) break;
    }
    l += __shfl_xor(l, 32);
    bf16_t* op = WSP(bf16_t, WS_MIXED) + (rowbase + qpos) * DM + h * 64;
    float* lsep = WSP(float, WS_LSE1) + (rowbase + qpos) * 8 + h;
    if (MODE == 0) {
        const float il = 1.f / l;
        if (fh == 0) *lsep = m + __logf(l);
#pragma unroll
        for (int dd = 0; dd < 2; ++dd)
#pragma unroll
            for (int g = 0; g < 4; ++g) {
                const int dim = 32 * dd + 8 * g + 4 * fh;
                uint2 w;
                w.x = pack2(o[dd][4 * g + 0] * il, o[dd][4 * g + 1] * il);
                w.y = pack2(o[dd][4 * g + 2] * il, o[dd][4 * g + 3] * il);
                *(uint2*)(op + dim) = w;
            }
    } else {
        const float lse1 = *lsep;
        const float M = fmaxf(m, lse1);
        const float w23 = __expf(m - M), w1 = __expf(lse1 - M);
        const float iden = 1.f / (l * w23 + w1);
        const float a23 = w23 * iden, a1 = w1 * iden;
        uint2 prev[2][4];
#pragma unroll
        for (int dd = 0; dd < 2; ++dd)
#pragma unroll
            for (int g = 0; g < 4; ++g) prev[dd][g] = *(const uint2*)(op + 32 * dd + 8 * g + 4 * fh);
#pragma unroll
        for (int dd = 0; dd < 2; ++dd)
#pragma unroll
            for (int g = 0; g < 4; ++g) {
                const int dim = 32 * dd + 8 * g + 4 * fh;
                const float p0 = __uint_as_float(prev[dd][g].x << 16), p1 = __uint_as_float(prev[dd][g].x & 0xffff0000u);
                const float p2 = __uint_as_float(prev[dd][g].y << 16), p3 = __uint_as_float(prev[dd][g].y & 0xffff0000u);
                uint2 w;
                w.x = pack2(o[dd][4 * g + 0] * a23 + p0 * a1, o[dd][4 * g + 1] * a23 + p1 * a1);
                w.y = pack2(o[dd][4 * g + 2] * a23 + p2 * a1, o[dd][4 * g + 3] * a23 + p3 * a1);
                *(uint2*)(op + dim) = w;
            }
    }
}
#define NITEM_B 1024
#define NITEM_A 2048
DI void ph_attn_fast(const Params& p, int vb, unsigned char* smem) {
    if (vb < NITEM_B) {
        const int item = vb < 512 ? vb : 512 + (1023 - vb);
        ph_attnB_fast(p, item, smem);
    } else ph_attnA_fast<0>(p, vb - NITEM_B, smem);
}


DI void ph_spatial_fast(const Params& p, int item, unsigned char* smem) {
    const int tid = otid(), wave = tid >> 6, lane = tid & 63, fr = lane & 31, fh = lane >> 5;
    const int wm = wave >> 1, wn = wave & 1;
    const int chunk = item >> 3, g = item & 7;
    bf16_t* u = WSP(bf16_t, WS_Z_U);
    const bf16_t* vt = WSP(bf16_t, WS_Z_VT);
    const float* ssq = WSP(float, WS_SSQ);
    const float* wsp = p.in[16] + (size_t)g * 128 * 128;
    float* rinv = (float*)(smem + 66 * 1024);
    unsigned char* Bt = smem + 32768;
    __syncthreads();
    if (tid < 128) {
        const float4* sp = (const float4*)(ssq + (size_t)(chunk * 128 + tid) * 64);
        float sacc = 0.f;
#pragma unroll
        for (int j = 0; j < 16; ++j) { const float4 q = sp[j]; sacc += (q.x + q.y) + (q.z + q.w); }
        rinv[tid] = rsqrtf(sacc * (1.f / CW) + EPSN);
    }
    const size_t vrow0 = (size_t)chunk * CW + g * 256;
    stage_tile(vt, 128, (int)vrow0, 0, Bt, wave, lane);
    stage_tile(vt, 128, (int)vrow0, 64, Bt + 16384, wave, lane);
    __syncthreads();
#pragma unroll
    for (int i = 0; i < 8; ++i) {
        const int id = tid + 256 * i;
        const int t = id >> 4, sc = id & 15;
        const float4 w0 = *(const float4*)(wsp + t * 128 + sc * 8);
        const float4 w1 = *(const float4*)(wsp + t * 128 + sc * 8 + 4);
        const float4 r0 = *(const float4*)(rinv + sc * 8);
        const float4 r1 = *(const float4*)(rinv + sc * 8 + 4);
        const int s0 = sc * 8;
        uint4 o;
        o.x = pack2(s0 + 0 <= t ? w0.x * r0.x : 0.f, s0 + 1 <= t ? w0.y * r0.y : 0.f);
        o.y = pack2(s0 + 2 <= t ? w0.z * r0.z : 0.f, s0 + 3 <= t ? w0.w * r0.w : 0.f);
        o.z = pack2(s0 + 4 <= t ? w1.x * r1.x : 0.f, s0 + 5 <= t ? w1.y * r1.y : 0.f);
        o.w = pack2(s0 + 6 <= t ? w1.z * r1.z : 0.f, s0 + 7 <= t ? w1.w * r1.w : 0.f);
        const int kt = sc >> 3, c = sc & 7;
        *(uint4*)(smem + kt * 16384 + t * 128 + ((c ^ ((t >> 1) & 7)) << 4)) = o;
    }
#pragma unroll 1
    for (int nt = 0; nt < 2; ++nt) {
        asm volatile("s_waitcnt vmcnt(0)" ::: "memory");
        __syncthreads();
        f32x16 acc[2][2];
#pragma unroll
        for (int i = 0; i < 2; ++i)
#pragma unroll
            for (int j = 0; j < 2; ++j)
#pragma unroll
                for (int r = 0; r < 16; ++r) acc[i][j][r] = 0.f;
#pragma unroll
        for (int kt = 0; kt < 2; ++kt)
#pragma unroll
            for (int s = 0; s < 4; ++s) {
                bf16x8 a[2], b[2];
#pragma unroll
                for (int i = 0; i < 2; ++i) {
                    a[i] = lds_frag(smem + kt * 16384, wm * 64 + i * 32 + fr, 2 * s + fh);
                    b[i] = lds_frag(Bt + kt * 16384, wn * 64 + i * 32 + fr, 2 * s + fh);
                }
#pragma unroll
                for (int i = 0; i < 2; ++i)
#pragma unroll
                    for (int j = 0; j < 2; ++j) acc[i][j] = MFMA32(a[i], b[j], acc[i][j]);
            }
        __syncthreads();
        float* st = (float*)(Bt + wave * (32 * 65 * 4));
#pragma unroll
        for (int i = 0; i < 2; ++i) {
#pragma unroll
            for (int j = 0; j < 2; ++j)
#pragma unroll
                for (int r = 0; r < 16; ++r) st[crow(r, fh) * 65 + j * 32 + fr] = acc[i][j][r];
            const int t = wm * 64 + i * 32 + fr;
            const int c0 = g * 256 + nt * 128 + wn * 64 + fh * 32;
            bf16_t* up = u + (size_t)(chunk * 128 + t) * CW + c0;
            const float bias = p.in[17][g * 128 + t];
            const float* gn = p.in[15] + c0;
            uint4 ur[4];
#pragma unroll
            for (int q = 0; q < 4; ++q) ur[q] = ((const uint4*)up)[q];
#pragma unroll
            for (int q = 0; q < 4; ++q) {
                float uf[8]; unpack8(ur[q], uf);
                const float4 g0 = *(const float4*)(gn + 8 * q), g1 = *(const float4*)(gn + 8 * q + 4);
                const float gg[8] = {g0.x, g0.y, g0.z, g0.w, g1.x, g1.y, g1.z, g1.w};
                float ov[8];
#pragma unroll
                for (int e = 0; e < 8; ++e) ov[e] = uf[e] * (st[fr * 65 + fh * 32 + 8 * q + e] * gg[e] + bias);
                uint4 o; o.x = pack2(ov[0], ov[1]); o.y = pack2(ov[2], ov[3]); o.z = pack2(ov[4], ov[5]); o.w = pack2(ov[6], ov[7]);
                ((uint4*)up)[q] = o;
            }
        }
        if (nt == 0) {
            __syncthreads();
            stage_tile(vt, 128, (int)vrow0 + 128, 0, Bt, wave, lane);
            stage_tile(vt, 128, (int)vrow0 + 128, 64, Bt + 16384, wave, lane);
        }
    }
}

#define XB_TMO      128
#define XB_XCNT(j)  (256  + 64 * (j))
#define XB_XSUB(j)  (1280 + 64 * (j))
#define XB_XGEN(j)  (2304 + 64 * (j))
#define XB_TOP      3328
#define XB_TOPGEN   3392
#define XCD_BAR_WORDS 3456
#define XB_SPIN_CAP (1u << 22)
DI unsigned xb_ld(unsigned* p) { return __hip_atomic_load(p, __ATOMIC_RELAXED, __HIP_MEMORY_SCOPE_AGENT); }
DI unsigned xb_add(unsigned* p, unsigned v) { return __hip_atomic_fetch_add(p, v, __ATOMIC_RELAXED, __HIP_MEMORY_SCOPE_AGENT); }
DI unsigned xb_xcc_id() { return (unsigned)__builtin_amdgcn_s_getreg((3 << 11) | 20) & 0xFu; }
#define XB_SPIN(cond, bar) do { unsigned _sp = 0; while (cond) { __builtin_amdgcn_s_sleep(1); \
    if ((++_sp & 255u) == 0u) { if (xb_ld(&(bar)[XB_TMO])) break; if (_sp > XB_SPIN_CAP) { atomicAdd(&(bar)[XB_TMO], 1u); break; } } } } while (0)
struct XcdBarrier { unsigned* bar; unsigned x; volatile LAS unsigned* st; };
DI XcdBarrier xcd_barrier_post(unsigned* bar, volatile LAS unsigned* st) {
    XcdBarrier b; b.bar = bar; b.x = xb_xcc_id(); b.st = st;
    if (threadIdx.x == 0) st[2] = xb_add(&bar[XB_XCNT(b.x)], 1u);
    return b;
}
DI void xcd_barrier_complete(unsigned* bar, unsigned x, unsigned& nloc, unsigned& nx, unsigned& xi) {
    const unsigned G = gridDim.x * gridDim.y * gridDim.z;
    unsigned sum, cnt, mine, below, sp = 0u;
    for (;;) {
        sum = 0u; cnt = 0u; mine = 0u; below = 0u;
#pragma unroll
        for (unsigned j = 0; j < 16; ++j) { const unsigned c = xb_ld(&bar[XB_XCNT(j)]); sum += c; cnt += (c > 0u) ? 1u : 0u; mine = (j == x) ? c : mine; below += (c > 0u && j < x) ? 1u : 0u; }
        if (sum == G) break;
        __builtin_amdgcn_s_sleep(1);
        if ((++sp & 255u) == 0u) { if (xb_ld(&bar[XB_TMO])) break; if (sp > XB_SPIN_CAP) { atomicAdd(&bar[XB_TMO], 1u); break; } }
    }
    nloc = mine > 0u ? mine : 1u; nx = cnt > 0u ? cnt : 1u; xi = below;
}
DI void xcd_barrier(const XcdBarrier& b) {
    asm volatile("s_waitcnt vmcnt(0)" ::: "memory");
    __syncthreads();
    if (threadIdx.x == 0) {
        unsigned* bar = b.bar;
        __builtin_amdgcn_s_waitcnt(0);
        unsigned nloc = b.st[0], nx = b.st[1];
        if (nloc == 0u) { unsigned xi; xcd_barrier_complete(bar, b.x, nloc, nx, xi); b.st[0] = nloc; b.st[1] = nx; b.st[3] = xi; }
        const unsigned old = xb_add(&bar[XB_XSUB(b.x)], 1u);
        const unsigned gen = old / nloc;
        if (old + 1u == (gen + 1u) * nloc) {
            __builtin_amdgcn_fence(__ATOMIC_RELEASE, "agent");
            asm volatile("s_waitcnt vmcnt(0)" ::: "memory");
            const unsigned og = xb_add(&bar[XB_TOP], 1u);
            const unsigned tg = og / nx;
            if (og + 1u == (tg + 1u) * nx) xb_add(&bar[XB_TOPGEN], 1u);
            else XB_SPIN(xb_ld(&bar[XB_TOPGEN]) == tg, bar);
            __builtin_amdgcn_fence(__ATOMIC_ACQUIRE, "agent");
            xb_add(&bar[XB_XGEN(b.x)], 1u);
            asm volatile("s_waitcnt vmcnt(0)" ::: "memory");
        } else {
            XB_SPIN(xb_ld(&bar[XB_XGEN(b.x)]) == gen, bar);
            __builtin_amdgcn_fence(__ATOMIC_ACQUIRE, "agent");
            asm volatile("s_waitcnt vmcnt(0)" ::: "memory");
        }
    }
    __syncthreads();
}

enum { PH_PREP = 0, PH_GEMM1, PH_ATTN, PH_ATTN2, PH_GEMM2,
       PH_NORM_P0, PH_GEMMQ0, PH_SCORE0, PH_PDOWN0, PH_PCOMB0, PH_PUP0, PH_NORM_SGU,
       PH_GEMM4, PH_SPATIAL, PH_GEMM5,
       PH_NORM_P1, PH_GEMMQ1, PH_SCORE1, PH_PDOWN1, PH_PCOMB1, PH_PUP1, PH_COUNT };

__host__ __device__ constexpr int phase_nvb(int ph) {
    switch (ph) {
        case PH_PREP: return PREP_N;
        case PH_GEMM1: return (ATT_IN / 256) * (NTOK / 256);
        case PH_ATTN: return NITEM_B + NITEM_A;
        case PH_ATTN2: return NITEM_A;
        case PH_GEMM2: return (DM / 256) * (NTOK / 256);
        case PH_NORM_P0: case PH_NORM_P1: case PH_NORM_SGU: return NTOK / 4;
        case PH_GEMMQ0: case PH_GEMMQ1: return 16 * (NTOK / 256);
        case PH_SCORE0: case PH_SCORE1: return (NTOK / 32) * 8 / 4;
        case PH_PCOMB0: case PH_PCOMB1: return NTOK / 4;
        case PH_GEMM4: return (4096 / 256) * (NTOK / 256);
        case PH_SPATIAL: return 256 * 8;
        case PH_GEMM5: return (DM / 256) * (NTOK / 256);
    }
    return 0;
}

template <int PH>
DI void run_vb(const Params& p, int vb, unsigned char* smem) {
    if constexpr (PH == PH_PREP) ph_prep(p, vb, smem);
    else if constexpr (PH == PH_ATTN) ph_attn_fast(p, vb, smem);
    else if constexpr (PH == PH_ATTN2) ph_attnA_fast<1>(p, vb, smem);
    else if constexpr (PH == PH_NORM_P0 || PH == PH_NORM_P1) rmsnorm_rows<true>(p.out, p.in[19] + (PH == PH_NORM_P1 ? DM : 0), WSP(bf16_t, WS_XN), vb, WSP(signed char, WS_XQ), WSP(float, WS_XSC));
    else if constexpr (PH == PH_SCORE0 || PH == PH_SCORE1) ph_score(p, vb, PH == PH_SCORE1 ? 1 : 0, smem);
    else if constexpr (PH == PH_PCOMB0 || PH == PH_PCOMB1) ph_peer_comb(p, vb, PH == PH_PCOMB1 ? 1 : 0);
    else if constexpr (PH == PH_NORM_SGU) rmsnorm_rows<false>(p.out, p.in[13], WSP(bf16_t, WS_XN), vb);
    else if constexpr (PH == PH_SPATIAL) ph_spatial_fast(p, vb, smem);
}

template <int PH>
DI void run_phase(const Params& p, unsigned char* smem) {
    if constexpr (PH == PH_PDOWN0 || PH == PH_PDOWN1) run_peer_sliced<false>(p, PH == PH_PDOWN1 ? 1 : 0, smem);
    else if constexpr (PH == PH_PUP0 || PH == PH_PUP1) run_peer_sliced<true>(p, PH == PH_PUP1 ? 1 : 0, smem);
    else if constexpr (PH == PH_GEMMQ0 || PH == PH_GEMMQ1) run_gemmq_pg8(p, PH == PH_GEMMQ1 ? 1 : 0, smem);
    else if constexpr (PH == PH_GEMM1) run_gemm1_pg8(p, smem);
    else if constexpr (PH == PH_GEMM4) run_gemm4_pg8(p, smem);
    else if constexpr (PH == PH_GEMM2) run_gemm_pg8<0>(p, smem);
    else if constexpr (PH == PH_GEMM5) run_gemm_pg8<1>(p, smem);
    else {
        constexpr int nvb = phase_nvb(PH);
        const int g = threadIdx.x >> 8;
        for (int vb = 2 * blockIdx.x; vb < nvb; vb += 2 * gridDim.x)
            if (vb + g < nvb) run_vb<PH>(p, vb + g, smem + g * GROUP_SMEM);
    }
}

template <int PH>
DI void run_from(const Params& p, unsigned char* smem, cg::grid_group& grid, const XcdBarrier& xb) {
    run_phase<PH>(p, smem);
    if constexpr (PH + 1 < PH_COUNT) {
        if constexpr (PH == 1) grid.sync(); else xcd_barrier(xb);
        run_from<PH + 1>(p, smem, grid, xb);
    }
}

__global__ void __launch_bounds__(NTHREADS, 2) k_mega(Params p) {
    extern __shared__ __attribute__((aligned(16))) unsigned char smem[];
    cg::grid_group grid = cg::this_grid();
    volatile LAS unsigned* st = (volatile LAS unsigned*)(smem + SMEM_BYTES);
    if (threadIdx.x == 0) { st[0] = 0u; st[1] = 0u; st[2] = 0u; st[3] = 0u; }
    __syncthreads();
    const XcdBarrier xb = xcd_barrier_post((unsigned*)(p.ws + WS_CTL), st);
    run_from<0>(p, smem, grid, xb);
}


extern "C" void kernel_launch(void* const* d_in, const int* in_sizes, int n_in, void* d_out, int out_size, void* d_ws, size_t ws_size, hipStream_t stream) {
    if (n_in != 24 || ws_size < WS_NEED || in_sizes[0] != NTOK * DM || out_size != NTOK * DM || in_sizes[22] != 2 * NEXP * DM) {
        fprintf(stderr, "kernel_launch: built for x[16,2048,1024] with 24 inputs and >= 512 MiB of workspace; got n_in %d, in0 %d, out %d, ws %zu: nothing launched\n", n_in, in_sizes[0], out_size, ws_size); return; }
    static int grid_blocks = 0;
    if (!grid_blocks) {
        int dev = 0, cus = 0, per_cu = 0;
        (void)hipGetDevice(&dev);
        (void)hipDeviceGetAttribute(&cus, hipDeviceAttributeMultiprocessorCount, dev);
        (void)hipFuncSetAttribute((const void*)k_mega, hipFuncAttributeMaxDynamicSharedMemorySize, SMEM_ALLOC);
        (void)hipOccupancyMaxActiveBlocksPerMultiprocessor(&per_cu, (const void*)k_mega, NTHREADS, SMEM_ALLOC);
        if (per_cu > 1) per_cu = 1;
        if (per_cu < 1) { fprintf(stderr, "kernel_launch: occupancy query returned %d\n", per_cu); per_cu = 1; }
        grid_blocks = cus * per_cu;
    }
    Params p{};
    for (int i = 0; i < 24; ++i) p.in[i] = (const float*)d_in[i];
    p.out = (float*)d_out;
    p.ws = (unsigned char*)d_ws;
    void* args[] = {&p};
    if (hipMemsetAsync((unsigned char*)d_ws + WS_CTL, 0, XCD_BAR_WORDS * 4, stream) != hipSuccess) { fprintf(stderr, "kernel_launch: memset of the barrier words failed\n"); return; }
    hipError_t e = hipLaunchCooperativeKernel((const void*)k_mega, dim3(grid_blocks), dim3(NTHREADS), args, SMEM_ALLOC, stream);
    if (e != hipSuccess) fprintf(stderr, "cooperative launch failed: %s (grid %d)\n", hipGetErrorString(e), grid_blocks);
}
```

```cpp
#include <hip/hip_runtime.h>
#include <stdint.h>
#include <stdio.h>

#define NTOK   32768
#define DM     1024
#define SEQ    2048
#define NB     16
#define ATT_IN 3072
#define CW     2048
#define NEXP   16384
#define EPSN   1e-6f

typedef unsigned short bf16_t;
typedef unsigned int u32;

#define DI __device__ __forceinline__
#define LAS __attribute__((address_space(3)))

DI int otid() { int t = threadIdx.x & 255; asm volatile("" : "+v"(t)); return t; }
DI int otid512() { int t = threadIdx.x; asm volatile("" : "+v"(t)); return t; }
DI float bf2f(bf16_t v) { return __uint_as_float(((u32)v) << 16); }
typedef __bf16 bf16v2 __attribute__((ext_vector_type(2)));
DI bf16_t f2bf(float f) { const __bf16 h = (__bf16)f; return __builtin_bit_cast(bf16_t, h); }
DI u32 pack2(float lo, float hi) { bf16v2 v; v[0] = (__bf16)lo; v[1] = (__bf16)hi; return __builtin_bit_cast(u32, v); }
DI float gelu_tanh(float x) {
    const float y = 0.7978845608028654f * (x + 0.044715f * x * x * x);
    const float e = __expf(2.f * y);
    const float t = 1.f - 2.f / (e + 1.f);
    return 0.5f * x * (1.f + t);
}
DI float wave_sum(float v) {
#pragma unroll
    for (int o = 1; o < 64; o <<= 1) v += __shfl_xor(v, o);
    return v;
}
DI float wave_max(float v) {
#pragma unroll
    for (int o = 1; o < 64; o <<= 1) v = fmaxf(v, __shfl_xor(v, o));
    return v;
}
DI u32 f2ord(float f) { u32 u = __float_as_uint(f); return (u & 0x80000000u) ? ~u : (u | 0x80000000u); }
DI float ord2f(u32 o) { u32 u = (o & 0x80000000u) ? (o & 0x7fffffffu) : ~o; return __uint_as_float(u); }

#define MiB ((size_t)1 << 20)
#define WS_CTL      ((size_t)0)
#define WS_W_ATTIN  (1 * MiB)
#define WS_W_ATTOUT (7 * MiB)
#define WS_W_SGUIN  (9 * MiB)
#define WS_W_SGUOUT (17 * MiB)
#define WS_W_PQ     (21 * MiB)
#define WS_W_SUBK   (29 * MiB)
#define WS_DOWN     (32 * MiB)
#define WS_UP       (64 * MiB)
#define WS_DSC      (96 * MiB)
#define WS_USC      (96 * MiB + 128 * 1024)
#define WS_LSE1     (30 * MiB)
#define WS_XQ       (100 * MiB)
#define WS_XSC      (132 * MiB)
#define WS_XN       (160 * MiB)
#define WS_BIG      (224 * MiB)
#define WS_PROJ     (WS_BIG)
#define WS_MIXED    (WS_BIG + 192 * MiB)
#define WS_Z_U      (WS_BIG)
#define WS_Z_VT     (WS_BIG + 128 * MiB)
#define WS_RIDX     (WS_BIG + 32 * MiB)
#define WS_RG       (WS_BIG + 48 * MiB)
#define WS_QBUF     (WS_BIG + 64 * MiB)
#define WS_SSQ      (WS_BIG + 256 * MiB)
#define WS_NEED     (512 * MiB)

struct Params {
    const float* in[24];
    float* out;
    unsigned char* ws;
};

#include <hip/hip_cooperative_groups.h>
namespace cg = cooperative_groups;

#define GROUP_SMEM (68 * 1024)
#define PG8_EXTRA (128 * 1024)
#define SMEM_BYTES (144 * 1024)
#define SMEM_ALLOC (SMEM_BYTES + 16)
#define NTHREADS 512

#define WSP(T, off) ((T*)(p.ws + (off)))


DI void transpose_tile(const float* __restrict__ W, bf16_t* __restrict__ Wt, int K, int N, int t, unsigned char* smem) {
    float* tile = (float*)smem;
    const int tid = otid();
    const int ntn = N / 64;
    const int n0 = (t % ntn) * 64, k0 = (t / ntn) * 64;
    __syncthreads();
    {
        const int n4 = tid & 15, kr = tid >> 4;
#pragma unroll
        for (int i = 0; i < 4; ++i) {
            const int k = kr + 16 * i;
            const float4 v = *(const float4*)(W + (size_t)(k0 + k) * N + n0 + 4 * n4);
            tile[k * 65 + 4 * n4 + 0] = v.x; tile[k * 65 + 4 * n4 + 1] = v.y; tile[k * 65 + 4 * n4 + 2] = v.z; tile[k * 65 + 4 * n4 + 3] = v.w;
        }
    }
    __syncthreads();
    {
        const int n = tid >> 2, kc = tid & 3;
        float v[16];
#pragma unroll
        for (int j = 0; j < 16; ++j) v[j] = tile[(16 * kc + j) * 65 + n];
        uint4 o0, o1;
        o0.x = pack2(v[0], v[1]); o0.y = pack2(v[2], v[3]); o0.z = pack2(v[4], v[5]); o0.w = pack2(v[6], v[7]);
        o1.x = pack2(v[8], v[9]); o1.y = pack2(v[10], v[11]); o1.z = pack2(v[12], v[13]); o1.w = pack2(v[14], v[15]);
        uint4* dst = (uint4*)(Wt + (size_t)(n0 + n) * K + k0 + 16 * kc);
        dst[0] = o0; dst[1] = o1;
    }
}
DI void cvt_chunk(const float* __restrict__ src, bf16_t* __restrict__ dst, int c) {
    const size_t base = (size_t)c * 2048;
#pragma unroll
    for (int i = 0; i < 8; ++i) {
        const size_t idx = base + i * 256 + otid();
        const float4 v = ((const float4*)src)[idx];
        uint2 o; o.x = pack2(v.x, v.y); o.y = pack2(v.z, v.w);
        ((uint2*)dst)[idx] = o;
    }
}
DI int q8(float v) { int i = __float2int_rn(v); i = i > 127 ? 127 : i; i = i < -127 ? -127 : i; return i & 255; }
template <bool EMIT_Q>
DI void rmsnorm_rows(const float* __restrict__ x, const float* __restrict__ g, bf16_t* __restrict__ o, int vb, signed char* xq = nullptr, float* xsc = nullptr) {
    const int lane = otid() & 63;
    const int row = vb * 4 + (otid() >> 6);
    const float4* xr = (const float4*)(x + (size_t)row * DM);
    float4 v[4]; float ss = 0.f;
#pragma unroll
    for (int j = 0; j < 4; ++j) { v[j] = xr[lane + 64 * j]; ss += v[j].x * v[j].x + v[j].y * v[j].y + v[j].z * v[j].z + v[j].w * v[j].w; }
    ss = wave_sum(ss);
    const float rinv = rsqrtf(ss * (1.f / DM) + EPSN);
    uint2* orow = (uint2*)(o + (size_t)row * DM);
    float am = 0.f;
#pragma unroll
    for (int j = 0; j < 4; ++j) {
        const float4 gg = ((const float4*)g)[lane + 64 * j];
        v[j].x *= rinv * gg.x; v[j].y *= rinv * gg.y; v[j].z *= rinv * gg.z; v[j].w *= rinv * gg.w;
        uint2 w; w.x = pack2(v[j].x, v[j].y); w.y = pack2(v[j].z, v[j].w);
        orow[lane + 64 * j] = w;
        if (EMIT_Q) am = fmaxf(am, fmaxf(fmaxf(fabsf(v[j].x), fabsf(v[j].y)), fmaxf(fabsf(v[j].z), fabsf(v[j].w))));
    }
    if (EMIT_Q) {
        am = wave_max(am);
        const float sc = am > 0.f ? 127.f / am : 0.f;
        u32* qrow = (u32*)(xq + (size_t)row * DM);
#pragma unroll
        for (int j = 0; j < 4; ++j)
            qrow[lane + 64 * j] = (u32)q8(v[j].x * sc) | ((u32)q8(v[j].y * sc) << 8) | ((u32)q8(v[j].z * sc) << 16) | ((u32)q8(v[j].w * sc) << 24);
        if (lane == 0) xsc[row] = am * (1.f / 127.f);
    }
}
#define PREP_T0 (48 * 16)
#define PREP_T1 (PREP_T0 + 16 * 16)
#define PREP_T2 (PREP_T1 + 64 * 16)
#define PREP_T3 (PREP_T2 + 16 * 32)
#define PREP_T4 (PREP_T3 + 2 * 32 * 16)
#define PREP_C0 (PREP_T4 + 64)
#define PREP_C1 (PREP_C0 + 8192)
#define PREP_C2 (PREP_C1 + 8192)
#define PREP_N  (PREP_C2 + 8192)
template <bool INT8>
DI void fp8_rows(const float* __restrict__ src, unsigned char* __restrict__ dst, float* __restrict__ inv_scale, int vb) {
    const int lane = otid() & 63;
    const int row = vb * 4 + (otid() >> 6);
    const float4* sr = (const float4*)(src + (size_t)row * DM) + lane;
    float4 v[4]; float am = 0.f;
#pragma unroll
    for (int j = 0; j < 4; ++j) { v[j] = sr[64 * j]; am = fmaxf(am, fmaxf(fmaxf(fabsf(v[j].x), fabsf(v[j].y)), fmaxf(fabsf(v[j].z), fabsf(v[j].w)))); }
    am = wave_max(am);
    float sc, inv;
    if (INT8) { sc = am > 0.f ? 127.f / am : 0.f; inv = am * (1.f / 127.f); }
    else {
        int e = (int)((__float_as_uint(am) >> 23) & 255u) - 127;
        if (am == 0.f) e = 0;
        e = e < -100 ? -100 : e;
        sc = __uint_as_float((u32)(127 + 7 - e) << 23); inv = __uint_as_float((u32)(127 + e - 7) << 23);
    }
    unsigned char* drow = dst + (size_t)(row >> 14) * NEXP * DM + (size_t)(row & (NEXP - 1)) * 128;
#pragma unroll
    for (int j = 0; j < 4; ++j) {
        const int dim = 4 * (lane + 64 * j);
        u32 w;
        if (INT8) w = (u32)q8(v[j].x * sc) | ((u32)q8(v[j].y * sc) << 8) | ((u32)q8(v[j].z * sc) << 16) | ((u32)q8(v[j].w * sc) << 24);
        else { int t = __builtin_amdgcn_cvt_pk_fp8_f32(v[j].x * sc, v[j].y * sc, 0, false); t = __builtin_amdgcn_cvt_pk_fp8_f32(v[j].z * sc, v[j].w * sc, t, true); w = (u32)t; }
        *(u32*)(drow + (size_t)(dim >> 7) * NEXP * 128 + (dim & 127)) = w;
    }
    if (lane == 0) inv_scale[row] = inv;
}
DI void ph_prep(const Params& p, int vb, unsigned char* smem) {
    if (vb < PREP_T0) transpose_tile(p.in[2], WSP(bf16_t, WS_W_ATTIN), DM, ATT_IN, vb, smem);
    else if (vb < PREP_T1) transpose_tile(p.in[12], WSP(bf16_t, WS_W_ATTOUT), DM, DM, vb - PREP_T0, smem);
    else if (vb < PREP_T2) transpose_tile(p.in[14], WSP(bf16_t, WS_W_SGUIN), DM, 4096, vb - PREP_T1, smem);
    else if (vb < PREP_T3) transpose_tile(p.in[18], WSP(bf16_t, WS_W_SGUOUT), CW, DM, vb - PREP_T2, smem);
    else if (vb < PREP_T4) { const int t = vb - PREP_T3, l = t / 512; transpose_tile(p.in[20] + (size_t)l * DM * 2048, WSP(bf16_t, WS_W_PQ) + (size_t)l * 2048 * DM, DM, 2048, t % 512, smem); }
    else if (vb < PREP_C0) cvt_chunk(p.in[21], WSP(bf16_t, WS_W_SUBK), vb - PREP_T4);
    else if (vb < PREP_C1) fp8_rows<true>(p.in[22], p.ws + WS_DOWN, WSP(float, WS_DSC), vb - PREP_C0);
    else if (vb < PREP_C2) fp8_rows<false>(p.in[23], p.ws + WS_UP, WSP(float, WS_USC), vb - PREP_C1);
    else rmsnorm_rows<false>(p.in[0], p.in[1], WSP(bf16_t, WS_XN), vb - PREP_C2);
}

DI float compute_lam(const Params& p, int lane) {
    const float a = wave_sum(p.in[7][lane] * p.in[8][lane]);
    const float b = wave_sum(p.in[9][lane] * p.in[10][lane]);
    return __expf(a) - __expf(b) + 0.2f;
}
DI void ce_desc(u32& a, u32& b) { const u32 hi = max(a, b), lo = min(a, b); a = hi; b = lo; }
DI void sort16_desc(u32 (&v)[16]) {
#pragma unroll
    for (int k = 2; k <= 16; k <<= 1)
#pragma unroll
        for (int j = k >> 1; j > 0; j >>= 1)
#pragma unroll
            for (int i = 0; i < 16; ++i) {
                const int l = i ^ j;
                if (l > i) { if ((i & k) == 0) ce_desc(v[i], v[l]); else ce_desc(v[l], v[i]); }
            }
}
DI void merge16_desc(u32 (&a)[16], const u32 (&b)[16]) {
#pragma unroll
    for (int i = 0; i < 16; ++i) a[i] = max(a[i], b[15 - i]);
#pragma unroll
    for (int j = 8; j > 0; j >>= 1)
#pragma unroll
        for (int i = 0; i < 16; ++i) { const int l = i ^ j; if (l > i) ce_desc(a[i], a[l]); }
}
DI void top16_insert(u32 (&lst)[16], u32 x) {
#pragma unroll
    for (int j = 0; j < 16; ++j) { const u32 hi = max(lst[j], x); x = min(lst[j], x); lst[j] = hi; }
}
DI void unpack8(const uint4 v, float (&f)[8]) {
    f[0] = __uint_as_float(v.x << 16); f[1] = __uint_as_float(v.x & 0xffff0000u);
    f[2] = __uint_as_float(v.y << 16); f[3] = __uint_as_float(v.y & 0xffff0000u);
    f[4] = __uint_as_float(v.z << 16); f[5] = __uint_as_float(v.z & 0xffff0000u);
    f[6] = __uint_as_float(v.w << 16); f[7] = __uint_as_float(v.w & 0xffff0000u);
}
typedef float f32x2_t __attribute__((ext_vector_type(2)));
DI void unpack16fp8(const uint4 w, float (&f)[16]) {
    f32x2_t t;
    t = __builtin_amdgcn_cvt_pk_f32_fp8((int)w.x, false); f[0] = t[0]; f[1] = t[1];
    t = __builtin_amdgcn_cvt_pk_f32_fp8((int)w.x, true);  f[2] = t[0]; f[3] = t[1];
    t = __builtin_amdgcn_cvt_pk_f32_fp8((int)w.y, false); f[4] = t[0]; f[5] = t[1];
    t = __builtin_amdgcn_cvt_pk_f32_fp8((int)w.y, true);  f[6] = t[0]; f[7] = t[1];
    t = __builtin_amdgcn_cvt_pk_f32_fp8((int)w.z, false); f[8] = t[0]; f[9] = t[1];
    t = __builtin_amdgcn_cvt_pk_f32_fp8((int)w.z, true);  f[10] = t[0]; f[11] = t[1];
    t = __builtin_amdgcn_cvt_pk_f32_fp8((int)w.w, false); f[12] = t[0]; f[13] = t[1];
    t = __builtin_amdgcn_cvt_pk_f32_fp8((int)w.w, true);  f[14] = t[0]; f[15] = t[1];
}
struct PeerPre { int e[16]; uint4 xa, xb; float2 r; };
struct PeerRows { uint4 d[8]; float c[8]; };
template <bool UP>
DI PeerPre peer_prefetch(const Params& p, int tok, int sl, int lane) {
    PeerPre q;
    const int4* rix = (const int4*)(WSP(int, WS_RIDX) + (size_t)tok * 128 + 16 * (lane >> 3));
#pragma unroll
    for (int j = 0; j < 4; ++j) { const int4 t = rix[j]; q.e[4 * j] = t.x; q.e[4 * j + 1] = t.y; q.e[4 * j + 2] = t.z; q.e[4 * j + 3] = t.w; }
    if (UP) {
        q.r = *(const float2*)(p.out + (size_t)tok * DM + sl * 128 + 16 * (lane & 7) + 2 * (lane >> 3));
    } else {
        q.xa = *(const uint4*)(WSP(signed char, WS_XQ) + (size_t)tok * DM + sl * 128 + 16 * (lane & 7));
    }
    return q;
}
template <int HF, bool UP>
DI void peer_issue_rows(const Params& p, const unsigned char* tab, const PeerPre& q, int tok, int lane, PeerRows& R) {
    const unsigned dco = 16u * (unsigned)(lane & 7);
#pragma unroll
    for (int bi = 0; bi < 8; ++bi) R.d[bi] = *(const uint4*)(tab + ((unsigned)q.e[8 * HF + bi] * 128u + dco));
    if (UP) {
        const float4* cf = (const float4*)(WSP(float, WS_RG) + (size_t)tok * 128 + 16 * (lane >> 3) + 8 * HF);
        const float4 c0 = cf[0], c1 = cf[1];
        R.c[0] = c0.x; R.c[1] = c0.y; R.c[2] = c0.z; R.c[3] = c0.w; R.c[4] = c1.x; R.c[5] = c1.y; R.c[6] = c1.z; R.c[7] = c1.w;
    }
}
template <int HF>
DI void peer_down_half(const PeerPre& q, const PeerRows& R, float (&part)[16]) {
#pragma unroll
    for (int bi = 0; bi < 8; ++bi) {
        int a = __builtin_amdgcn_sdot4((int)R.d[bi].x, (int)q.xa.x, 0, false);
        a = __builtin_amdgcn_sdot4((int)R.d[bi].y, (int)q.xa.y, a, false);
        a = __builtin_amdgcn_sdot4((int)R.d[bi].z, (int)q.xa.z, a, false);
        a = __builtin_amdgcn_sdot4((int)R.d[bi].w, (int)q.xa.w, a, false);
        part[8 * HF + bi] = (float)a;
    }
}
DI void peer_down_fin(const Params& p, const float (&part)[16], int tok, int sl, int lane) {
    const bool b2 = lane & 4, b1 = lane & 2, b0 = lane & 1;
    float r8[8], r4[4], r2[2];
#pragma unroll
    for (int i = 0; i < 8; ++i) { const float snd = b2 ? part[i] : part[i + 8]; const float kp = b2 ? part[i + 8] : part[i]; r8[i] = kp + __shfl_xor(snd, 4); }
#pragma unroll
    for (int i = 0; i < 4; ++i) { const float snd = b1 ? r8[i] : r8[i + 4]; const float kp = b1 ? r8[i + 4] : r8[i]; r4[i] = kp + __shfl_xor(snd, 2); }
#pragma unroll
    for (int i = 0; i < 2; ++i) { const float snd = b0 ? r4[i] : r4[i + 2]; const float kp = b0 ? r4[i + 2] : r4[i]; r2[i] = kp + __shfl_xor(snd, 1); }
    float* pd = WSP(float, WS_QBUF) + ((size_t)tok * 8 + sl) * 128;
    *(float2*)(pd + 2 * lane) = make_float2(r2[0], r2[1]);
}
DI void ph_peer_comb(const Params& p, int vb, int l) {
    const int tid = otid(), lane = tid & 63;
    const int tok = vb * 4 + (tid >> 6);
    const float* pd = WSP(float, WS_QBUF) + (size_t)tok * 8 * 128;
    const int* rix = WSP(int, WS_RIDX) + (size_t)tok * 128;
    float* rgp = WSP(float, WS_RG) + (size_t)tok * 128;
    const float* dsc = WSP(float, WS_DSC) + (size_t)l * NEXP;
    const float* usc = WSP(float, WS_USC) + (size_t)l * NEXP;
    const float xs = WSP(float, WS_XSC)[tok];
#pragma unroll
    for (int hh = 0; hh < 2; ++hh) {
        const int k = lane + 64 * hh;
        float t = 0.f;
#pragma unroll
        for (int sl = 0; sl < 8; ++sl) t += pd[sl * 128 + k];
        const int e = rix[k];
        rgp[k] = rgp[k] * gelu_tanh(t * dsc[e] * xs) * usc[e];
    }
}
template <int HF>
DI void peer_up_half(const PeerPre& q, const PeerRows& R, float (&y)[16]) {
#pragma unroll
    for (int bi = 0; bi < 8; ++bi) {
        const float c = R.c[bi];
        float w[16]; unpack16fp8(R.d[bi], w);
#pragma unroll
        for (int i = 0; i < 16; ++i) y[i] += c * w[i];
        asm volatile("" : "+v"(y[0]), "+v"(y[1]), "+v"(y[2]), "+v"(y[3]), "+v"(y[4]), "+v"(y[5]), "+v"(y[6]), "+v"(y[7]), "+v"(y[8]), "+v"(y[9]), "+v"(y[10]), "+v"(y[11]), "+v"(y[12]), "+v"(y[13]), "+v"(y[14]), "+v"(y[15]));
    }
}
DI void peer_up_fin(const Params& p, const PeerPre& q, const float (&y)[16], int tok, int sl, int lane) {
    const int rg = lane >> 3, dc = lane & 7;
    const bool b5 = lane & 32, b4 = lane & 16, b3 = lane & 8;
    float r8[8], r4[4], r2[2];
#pragma unroll
    for (int i = 0; i < 8; ++i) { const float snd = b5 ? y[i] : y[i + 8]; const float kp = b5 ? y[i + 8] : y[i]; r8[i] = kp + __shfl_xor(snd, 32); }
#pragma unroll
    for (int i = 0; i < 4; ++i) { const float snd = b4 ? r8[i] : r8[i + 4]; const float kp = b4 ? r8[i + 4] : r8[i]; r4[i] = kp + __shfl_xor(snd, 16); }
#pragma unroll
    for (int i = 0; i < 2; ++i) { const float snd = b3 ? r4[i] : r4[i + 2]; const float kp = b3 ? r4[i + 2] : r4[i]; r2[i] = kp + __shfl_xor(snd, 8); }
    float2 v = q.r;
    v.x += r2[0]; v.y += r2[1];
    *(float2*)(p.out + (size_t)tok * DM + sl * 128 + 16 * dc + 2 * rg) = v;
}
template <bool UP>
DI void run_peer_sliced(const Params& p, int l, unsigned char* smem) {
    volatile LAS unsigned* st = (volatile LAS unsigned*)(smem + SMEM_BYTES);
    const int nloc = (int)st[0], nx = (int)st[1], rank = (int)st[2], xi = (int)st[3];
    const int tid = otid512(), lane = tid & 63, wave = tid >> 6;
    const int stride = nloc * 8;
#pragma unroll 1
    for (int sl = xi; sl < 8; sl += nx) {
        const unsigned char* tab = p.ws + (UP ? WS_UP : WS_DOWN) + (size_t)l * NEXP * DM + (size_t)sl * NEXP * 128;
        int tok = rank * 8 + wave;
        if (tok >= NTOK) continue;
        PeerPre qc = peer_prefetch<UP>(p, tok, sl, lane);
        PeerRows R;
        peer_issue_rows<0, UP>(p, tab, qc, tok, lane, R);
#pragma unroll 1
        for (; tok < NTOK; tok += stride) {
            const int tn = tok + stride < NTOK ? tok + stride : tok;
            const PeerPre qn = peer_prefetch<UP>(p, tn, sl, lane);
            float acc[16];
#pragma unroll
            for (int i = 0; i < 16; ++i) acc[i] = 0.f;
            PeerRows Rn;
            peer_issue_rows<1, UP>(p, tab, qc, tok, lane, Rn);
            __builtin_amdgcn_sched_barrier(0);
            if (UP) peer_up_half<0>(qc, R, acc); else peer_down_half<0>(qc, R, acc);
            __builtin_amdgcn_sched_barrier(0);
            peer_issue_rows<0, UP>(p, tab, qn, tn, lane, R);
            __builtin_amdgcn_sched_barrier(0);
            if (UP) { peer_up_half<1>(qc, Rn, acc); peer_up_fin(p, qc, acc, tok, sl, lane); }
            else { peer_down_half<1>(qc, Rn, acc); peer_down_fin(p, acc, tok, sl, lane); }
            __builtin_amdgcn_sched_barrier(0);
            qc = qn;
        }
    }
}


typedef short bf16x8 __attribute__((ext_vector_type(8)));
typedef float f32x16 __attribute__((ext_vector_type(16)));
#define MFMA32(a, b, c) __builtin_amdgcn_mfma_f32_32x32x16_bf16((a), (b), (c), 0, 0, 0)
typedef short s16x4 __attribute__((ext_vector_type(4)));
DI bf16x8 pack_p(const f32x16& pt, int s) {
    uint4 o;
    o.x = pack2(pt[8 * s + 0], pt[8 * s + 1]); o.y = pack2(pt[8 * s + 2], pt[8 * s + 3]);
    o.z = pack2(pt[8 * s + 4], pt[8 * s + 5]); o.w = pack2(pt[8 * s + 6], pt[8 * s + 7]);
    return __builtin_bit_cast(bf16x8, o);
}

DI void stage_tile(const bf16_t* __restrict__ g, int ld, int row0, int k0, unsigned char* lt, int wave, int lane) {
#pragma unroll
    for (int i = 0; i < 4; ++i) {
        const int inst = wave * 4 + i;
        const int row = inst * 8 + (lane >> 3);
        const int c = (lane & 7) ^ ((row >> 1) & 7);
        __builtin_amdgcn_global_load_lds((const unsigned*)(g + (size_t)(row0 + row) * ld + k0 + c * 8),
                                         (unsigned*)(lt + inst * 1024 + lane * 16), 16, 0, 0);
    }
}
DI bf16x8 lds_frag(const unsigned char* lt, int row, int c) {
    return *(const bf16x8*)(lt + row * 128 + ((c ^ ((row >> 1) & 7)) << 4));
}
DI int crow(int r, int fh) { return (r & 3) + 8 * (r >> 2) + 4 * fh; }

namespace pg8 {
#define PG8_LAS __attribute__((address_space(3)))
typedef float f32x4 __attribute__((ext_vector_type(4)));
typedef unsigned u32x4 __attribute__((ext_vector_type(4)));
constexpr int BM = 256, BK = 64, HALF = 128, HTB = HALF * BK * 2  , STAGE_BYTES = 8 * HTB;
__host__ __device__ __forceinline__ int lds_byte(int r, int c) { const int st = (r >> 4) * 2 + (c >> 5), rr = r & 15, cc = c & 31, ob = rr * 64 + cc * 2; return st * 1024 + (ob ^ (((ob >> 9) & 1) << 5)); }
__host__ __device__ __forceinline__ void stage_rc(int b, int& R, int& C) { const int st = b / 1024, sb = b % 1024, swz = sb ^ (((sb >> 9) & 1) << 5); R = (st >> 1) * 16 + swz / 64; C = (st & 1) * 32 + (swz % 64) / 2; }
__host__ __device__ __forceinline__ int perm32(int rho) { const int n = rho >> 4, i = rho & 15; return 8 * (i >> 2) + 4 * n + (i & 3); }
struct Unit { int pm, pn; };
struct Gemm { const bf16_t* A; const bf16_t* Bt; int M, N, K; };
struct XcdOrder {
    int ntn, nloc, nx, rank, xi, nown, total;
    __device__ __forceinline__ void init(int nmt, int ntn_, int nloc_, int nx_, int rank_, int xi_) {
        ntn = ntn_; nloc = nloc_; nx = nx_; rank = rank_; xi = xi_; nown = xi < nmt ? (nmt - xi + nx - 1) / nx : 0; total = nown * ntn; }
    __device__ __forceinline__ bool next(int i, Unit& u) const {
        const int t = rank + i * nloc; if (t >= total) return false;
        const int g4 = t / (4 * ntn), r = t - g4 * 4 * ntn;
        const int left = nown - 4 * g4, gs = left < 4 ? left : 4;
        const int nt = r / gs, mi = r - nt * gs;
        u.pm = (4 * g4 + mi) * nx + xi; u.pn = nt; return true;
    }
    __device__ __forceinline__ void a_ready(const Unit&) const {}
    __device__ __forceinline__ void done(const Unit&) const {}
};
template <class Epi, class Sched, bool ALIGN_EPI = false, bool SP2 = false>
__device__ __forceinline__ void gemm_phase(PG8_LAS unsigned char* lds, const Gemm g, const Sched& S, const Epi& E) {
    const int tid = otid512(), wid = __builtin_amdgcn_readfirstlane(tid >> 6), lane = tid & 63, wr = wid >> 2, wc = wid & 3, fr = lane & 15, fq = lane >> 4;
    const int K = g.K, nt = K / BK;
    unsigned voffA[2], voffB[2];
#pragma unroll
    for (int i = 0; i < 2; ++i) { int R, C; stage_rc(tid * 16 + i * 8192, R, C); const int Rb = Epi::PERM ? ((R & ~31) + perm32(R & 31)) : R;
        voffA[i] = (unsigned)(R * K + C) * 2u; voffB[i] = (unsigned)(Rb * K + C) * 2u; }
    const size_t kstep = (size_t)(BK * 2);
    const size_t hstep = (size_t)HALF * K * 2;
    const size_t tstep = 2 * hstep;
    const unsigned ldsw = (unsigned)wid * 1024u;
    const int aoff = lds_byte(wr * 64 + fr, fq * 8), boff = lds_byte(wc * 32 + fr, fq * 8);
#define PG8_SA(b, h) (((b) * 2 + (h)) * HTB)
#define PG8_SB(b, h) ((4 + (b) * 2 + (h)) * HTB)
#define PG8_STAGE(bufoff, gbase, voff) do { _Pragma("unroll") for (int _i = 0; _i < 2; ++_i) \
        __builtin_amdgcn_global_load_lds((const unsigned*)((const char*)(gbase) + (voff)[_i]), (PG8_LAS unsigned*)(lds + (bufoff) + ldsw + _i * 8192), 16, 0, 0); } while (0)
#define PG8_LDA(dst, b, h) do { _Pragma("unroll") for (int m = 0; m < 4; ++m) _Pragma("unroll") for (int k = 0; k < 2; ++k) dst[m][k] = *(const PG8_LAS bf16x8*)(lds + PG8_SA(b, h) + aoff + m * 2048 + k * 1024); } while (0)
#define PG8_LDB(dst, b, h) do { _Pragma("unroll") for (int n = 0; n < 2; ++n) _Pragma("unroll") for (int k = 0; k < 2; ++k) dst[n][k] = *(const PG8_LAS bf16x8*)(lds + PG8_SB(b, h) + boff + n * 2048 + k * 1024); } while (0)
#define PG8_MMA(ai, bj, At, Bt) do { __builtin_amdgcn_s_setprio(1); _Pragma("unroll") for (int m = 0; m < 4; ++m) _Pragma("unroll") for (int n = 0; n < 2; ++n) _Pragma("unroll") for (int k = 0; k < 2; ++k) \
        acc[ai][bj][m][n] = __builtin_amdgcn_mfma_f32_16x16x32_bf16(Bt[n][k], At[m][k], acc[ai][bj][m][n], 0, 0, 0); __builtin_amdgcn_s_setprio(0); } while (0)
#define PG8_WAIT_V(n) asm volatile("s_waitcnt vmcnt(" #n ")" ::: "memory")
#define PG8_WAIT_L(n) asm volatile("s_waitcnt lgkmcnt(" #n ")" ::: "memory")
#define PG8_BAR __builtin_amdgcn_s_barrier()
#define PG8_SCHED __builtin_amdgcn_sched_barrier(0)
    Unit cur, nxt; int ui = 0;
    if (!S.next(0, cur)) return;
    f32x4 acc[2][2][4][2];
#pragma unroll
    for (int a = 0; a < 2; ++a)
#pragma unroll
        for (int b = 0; b < 2; ++b)
#pragma unroll
            for (int m = 0; m < 4; ++m)
#pragma unroll
                for (int n = 0; n < 2; ++n) acc[a][b][m][n] = (f32x4){0.f, 0.f, 0.f, 0.f};
    bf16x8 At[4][2], B0[2][2], B1[2][2];
    const char* cA = (const char*)g.A + (size_t)cur.pm * tstep; const char* cB = (const char*)g.Bt + (size_t)cur.pn * tstep;
    S.a_ready(cur);
    if constexpr (SP2) {
        PG8_STAGE(PG8_SB(0, 0), cB, voffB); PG8_STAGE(PG8_SB(0, 1), cB + hstep, voffB); PG8_STAGE(PG8_SA(0, 0), cA, voffA); PG8_STAGE(PG8_SA(0, 1), cA + hstep, voffA);
        if (wr == 1) PG8_BAR;
        PG8_WAIT_V(2); PG8_BAR;
        PG8_STAGE(PG8_SB(1, 0), cB + kstep, voffB); PG8_STAGE(PG8_SA(1, 0), cA + kstep, voffA); PG8_STAGE(PG8_SB(1, 1), cB + hstep + kstep, voffB);
        PG8_WAIT_V(6); PG8_BAR;
    } else {
        PG8_STAGE(PG8_SB(0, 0), cB, voffB); PG8_STAGE(PG8_SA(0, 0), cA, voffA); PG8_STAGE(PG8_SB(0, 1), cB + hstep, voffB); PG8_STAGE(PG8_SA(0, 1), cA + hstep, voffA);
        if (wr == 1) PG8_BAR;
        PG8_WAIT_V(4); PG8_BAR;
        PG8_STAGE(PG8_SB(1, 0), cB + kstep, voffB); PG8_STAGE(PG8_SA(1, 0), cA + kstep, voffA); PG8_STAGE(PG8_SB(1, 1), cB + hstep + kstep, voffB);
        PG8_WAIT_V(6); PG8_BAR;
    }
    for (;;) {
        const bool has_next = S.next(ui + 1, nxt);
        const char* nA = has_next ? (const char*)g.A + (size_t)nxt.pm * tstep : cA; const char* nB = has_next ? (const char*)g.Bt + (size_t)nxt.pn * tstep : cB;
        for (int t = 0; t < nt; t += 2) {
            const bool last = (t == nt - 2);
            const char* a1 = cA + (size_t)(t + 1) * kstep;
            const char* a2 = last ? nA : cA + (size_t)(t + 2) * kstep; const char* b2 = last ? nB : cB + (size_t)(t + 2) * kstep;
            const char* a3 = a2 + kstep; const char* b3 = b2 + kstep;
            if (last && has_next) S.a_ready(nxt);
            if constexpr (SP2) {
            PG8_LDB(B0, 0, 0); PG8_LDB(B1, 0, 1); PG8_SCHED; PG8_LDA(At, 0, 0); PG8_STAGE(PG8_SA(1, 1), a1 + hstep, voffA);
            PG8_WAIT_V(8); PG8_WAIT_L(0); PG8_BAR; PG8_MMA(0, 0, At, B0); PG8_MMA(0, 1, At, B1); PG8_BAR; PG8_SCHED;
            PG8_LDA(At, 0, 1); PG8_STAGE(PG8_SB(0, 0), b2, voffB); PG8_STAGE(PG8_SB(0, 1), b2 + hstep, voffB); PG8_STAGE(PG8_SA(0, 0), a2, voffA);
            PG8_WAIT_V(8); PG8_WAIT_L(0); PG8_BAR; PG8_MMA(1, 0, At, B0); PG8_MMA(1, 1, At, B1); PG8_BAR; PG8_SCHED;
            PG8_LDB(B0, 1, 0); PG8_LDB(B1, 1, 1); PG8_SCHED; PG8_LDA(At, 1, 0); PG8_STAGE(PG8_SA(0, 1), a2 + hstep, voffA);
            PG8_WAIT_V(8); PG8_WAIT_L(0); PG8_BAR; PG8_MMA(0, 0, At, B0); PG8_MMA(0, 1, At, B1); PG8_BAR; PG8_SCHED;
            PG8_LDA(At, 1, 1); PG8_STAGE(PG8_SB(1, 0), b3, voffB); PG8_STAGE(PG8_SB(1, 1), b3 + hstep, voffB); PG8_STAGE(PG8_SA(1, 0), a3, voffA);
            PG8_WAIT_V(8); PG8_WAIT_L(0); PG8_BAR; PG8_MMA(1, 0, At, B0); PG8_MMA(1, 1, At, B1); PG8_BAR; PG8_SCHED;
            } else {
            PG8_LDB(B0, 0, 0); PG8_SCHED; PG8_LDA(At, 0, 0); PG8_STAGE(PG8_SA(1, 1), a1 + hstep, voffA);
            PG8_WAIT_L(8); PG8_BAR; PG8_WAIT_L(0); PG8_MMA(0, 0, At, B0); PG8_BAR; PG8_SCHED;
            PG8_LDB(B1, 0, 1); PG8_STAGE(PG8_SB(0, 0), b2, voffB);
            PG8_BAR; PG8_WAIT_L(0); PG8_MMA(0, 1, At, B1); PG8_BAR;
            PG8_LDA(At, 0, 1); PG8_STAGE(PG8_SA(0, 0), a2, voffA);
            PG8_BAR; PG8_WAIT_L(0); PG8_MMA(1, 0, At, B0); PG8_BAR; PG8_SCHED;
            PG8_STAGE(PG8_SB(0, 1), b2 + hstep, voffB);
            PG8_WAIT_V(6); PG8_BAR; PG8_MMA(1, 1, At, B1); PG8_BAR;
            PG8_LDB(B0, 1, 0); PG8_SCHED; PG8_LDA(At, 1, 0); PG8_STAGE(PG8_SA(0, 1), a2 + hstep, voffA);
            PG8_WAIT_L(8); PG8_BAR; PG8_WAIT_L(0); PG8_MMA(0, 0, At, B0); PG8_BAR; PG8_SCHED;
            PG8_LDB(B1, 1, 1); PG8_STAGE(PG8_SB(1, 0), b3, voffB);
            PG8_BAR; PG8_WAIT_L(0); PG8_MMA(0, 1, At, B1); PG8_BAR;
            PG8_LDA(At, 1, 1); PG8_STAGE(PG8_SA(1, 0), a3, voffA);
            PG8_BAR; PG8_WAIT_L(0); PG8_MMA(1, 0, At, B0); PG8_BAR; PG8_SCHED;
            PG8_STAGE(PG8_SB(1, 1), b3 + hstep, voffB);
            PG8_WAIT_V(6); PG8_BAR; PG8_MMA(1, 1, At, B1); PG8_BAR;
            }
        }
        if constexpr (ALIGN_EPI) { if (wr == 0) PG8_BAR; }
        if constexpr (!Epi::AFTER_DRAIN) { E(acc, cur, wr, wc, fr, fq); S.done(cur); }
        if (!has_next) break;
#pragma unroll
        for (int a = 0; a < 2; ++a)
#pragma unroll
            for (int b = 0; b < 2; ++b)
#pragma unroll
                for (int m = 0; m < 4; ++m)
#pragma unroll
                    for (int n = 0; n < 2; ++n) acc[a][b][m][n] = (f32x4){0.f, 0.f, 0.f, 0.f};
        cur = nxt; cA = nA; cB = nB; ++ui;
        if constexpr (ALIGN_EPI) { if (wr == 1) PG8_BAR; }
    }
    PG8_WAIT_V(0);
    if constexpr (!ALIGN_EPI) { if (wr == 0) PG8_BAR; }
    PG8_BAR;
    if constexpr (Epi::AFTER_DRAIN) { E.fused(acc, cur, wr, wc, fr, fq, lds, wid, lane); S.done(cur); }
#undef PG8_SA
#undef PG8_SB
#undef PG8_STAGE
#undef PG8_LDA
#undef PG8_LDB
#undef PG8_MMA
#undef PG8_WAIT_V
#undef PG8_WAIT_L
#undef PG8_BAR
#undef PG8_SCHED
}
struct EpiResid {
    static constexpr bool PERM = true, AFTER_DRAIN = false;
    const float* resid; float* out;
    __device__ __forceinline__ void operator()(const f32x4 (&acc)[2][2][4][2], const Unit& u, int wr, int wc, int fr, int fq) const {
        const size_t base = (size_t)(u.pm * BM + wr * 64 + fr) * DM + u.pn * BM + wc * 32 + 8 * fq;
#pragma unroll
        for (int ai = 0; ai < 2; ++ai) {
            f32x4 rv[4][2][2];
#pragma unroll
            for (int m = 0; m < 4; ++m)
#pragma unroll
                for (int bj = 0; bj < 2; ++bj) {
                    const float* rp = resid + base + (size_t)(ai * HALF + m * 16) * DM + bj * HALF;
                    rv[m][bj][0] = *(const f32x4*)rp; rv[m][bj][1] = *(const f32x4*)(rp + 4);
                }
            asm volatile("" ::: "memory");
#pragma unroll
            for (int m = 0; m < 4; ++m)
#pragma unroll
                for (int bj = 0; bj < 2; ++bj) {
                    float* op = out + base + (size_t)(ai * HALF + m * 16) * DM + bj * HALF;
                    *(f32x4*)op = rv[m][bj][0] + acc[ai][bj][m][0]; *(f32x4*)(op + 4) = rv[m][bj][1] + acc[ai][bj][m][1];
                }
            asm volatile("" ::: "memory");
        }
    }
};
struct EpiProj {
    static constexpr bool PERM = true, AFTER_DRAIN = false;
    const float* aq; const float* ak; const float* bq; const float* bk; bf16_t* proj; PG8_LAS float* xs;
    __device__ __forceinline__ void operator()(const f32x4 (&acc)[2][2][4][2], const Unit& u, int wr, int wc, int fr, int fq) const {
        const int wave = wr * 4 + wc;
#pragma unroll
        for (int ai = 0; ai < 2; ++ai)
#pragma unroll
            for (int m = 0; m < 4; ++m)
#pragma unroll
                for (int bj = 0; bj < 2; ++bj) {
                    const f32x4 a = acc[ai][bj][m][0], b = acc[ai][bj][m][1];
                    float t = a[0] * a[0] + a[1] * a[1] + a[2] * a[2] + a[3] * a[3] + b[0] * b[0] + b[1] * b[1] + b[2] * b[2] + b[3] * b[3];
                    t += __shfl_xor(t, 16); t += __shfl_xor(t, 32);
                    if (fq == 0) xs[wave * 256 + ((ai * 4 + m) * 2 + bj) * 16 + fr] = t;
                }
        asm volatile("s_waitcnt lgkmcnt(0)" ::: "memory");
        __builtin_amdgcn_s_barrier();
#pragma unroll
        for (int bj = 0; bj < 2; ++bj) {
            const int gcol = u.pn * BM + bj * HALF + wc * 32 + 8 * fq;
            const float* gain = nullptr; float scale = 1.f;
            if (gcol < 512) { gain = aq + (gcol & 63); scale = 0.125f; }
            else if (gcol < 1024) gain = ak + (gcol & 63);
            else if (gcol < 1536) gain = nullptr;
            else if (gcol < 2048) { gain = bq + (gcol & 127); scale = 0.125f; }
            else if (gcol < 2560) gain = bk + (gcol & 127);
            f32x4 g0 = {1.f, 1.f, 1.f, 1.f}, g1 = {1.f, 1.f, 1.f, 1.f};
            if (gain) { g0 = *(const f32x4*)gain; g1 = *(const f32x4*)(gain + 4); }
#pragma unroll
            for (int ai = 0; ai < 2; ++ai)
#pragma unroll
                for (int m = 0; m < 4; ++m) {
                    float sc = 1.f;
                    if (gain) {
                        const int slot = ((ai * 4 + m) * 2 + bj) * 16 + fr;
                        sc = rsqrtf((xs[wave * 256 + slot] + xs[(wave ^ 1) * 256 + slot]) * (1.f / 64.f) + EPSN) * scale;
                    }
                    const f32x4 v0 = acc[ai][bj][m][0] * g0 * sc, v1 = acc[ai][bj][m][1] * g1 * sc;
                    u32x4 w; w.x = pack2(v0[0], v0[1]); w.y = pack2(v0[2], v0[3]); w.z = pack2(v1[0], v1[1]); w.w = pack2(v1[2], v1[3]);
                    *(u32x4*)(proj + (size_t)(u.pm * BM + ai * HALF + wr * 64 + m * 16 + fr) * ATT_IN + gcol) = w;
                }
        }
    }
};
struct EpiSgu {
    static constexpr bool PERM = true, AFTER_DRAIN = false;
    bf16_t* zu; bf16_t* zvt; float* ssq; PG8_LAS unsigned char* stg;
    __device__ __forceinline__ void operator()(const f32x4 (&acc)[2][2][4][2], const Unit& u, int wr, int wc, int fr, int fq) const {
        const int wave = wr * 4 + wc, lane = fq * 16 + fr;
        PG8_LAS unsigned short* tl = (PG8_LAS unsigned short*)(stg + wave * 2048);
#pragma unroll
        for (int ai = 0; ai < 2; ++ai)
#pragma unroll
            for (int bj = 0; bj < 2; ++bj) {
                const int gcol = u.pn * BM + bj * HALF + wc * 32 + 8 * fq;
                f32x4 g0[4], g1[4];
#pragma unroll
                for (int m = 0; m < 4; ++m) {
                    const f32x4 a = acc[ai][bj][m][0], b = acc[ai][bj][m][1];
                    g0[m] = (f32x4){gelu_tanh(a[0]), gelu_tanh(a[1]), gelu_tanh(a[2]), gelu_tanh(a[3])};
                    g1[m] = (f32x4){gelu_tanh(b[0]), gelu_tanh(b[1]), gelu_tanh(b[2]), gelu_tanh(b[3])};
                }
                if (gcol < CW) {
#pragma unroll
                    for (int m = 0; m < 4; ++m) {
                        u32x4 w; w.x = pack2(g0[m][0], g0[m][1]); w.y = pack2(g0[m][2], g0[m][3]); w.z = pack2(g1[m][0], g1[m][1]); w.w = pack2(g1[m][2], g1[m][3]);
                        *(u32x4*)(zu + (size_t)(u.pm * BM + ai * HALF + wr * 64 + m * 16 + fr) * CW + gcol) = w;
                    }
                } else {
                    const int vcol = gcol - CW;
#pragma unroll
                    for (int m = 0; m < 4; ++m) {
                        float t = g0[m][0] * g0[m][0] + g0[m][1] * g0[m][1] + g0[m][2] * g0[m][2] + g0[m][3] * g0[m][3]
                                + g1[m][0] * g1[m][0] + g1[m][1] * g1[m][1] + g1[m][2] * g1[m][2] + g1[m][3] * g1[m][3];
                        t += __shfl_xor(t, 16); t += __shfl_xor(t, 32);
                        if (fq == 0) ssq[(size_t)(u.pm * BM + ai * HALF + wr * 64 + m * 16 + fr) * 64 + (vcol >> 5)] = t;
                    }
#pragma unroll
                    for (int h = 0; h < 2; ++h) {
#pragma unroll
                        for (int mm = 0; mm < 2; ++mm) {
                            const int m = 2 * h + mm, rl = 16 * mm + fr;
#pragma unroll
                            for (int j = 0; j < 4; ++j) { tl[(8 * fq + j) * 32 + rl] = f2bf(g0[m][j]); tl[(8 * fq + 4 + j) * 32 + rl] = f2bf(g1[m][j]); }
                        }
                        const int c = lane >> 1, hh = lane & 1;
                        const u32x4 w0 = *(const PG8_LAS u32x4*)(tl + c * 32 + hh * 16), w1 = *(const PG8_LAS u32x4*)(tl + c * 32 + hh * 16 + 8);
                        bf16_t* dst = zvt + ((size_t)(2 * u.pm + ai) * CW + (u.pn * BM - CW) + bj * HALF + wc * 32 + c) * 128 + wr * 64 + 32 * h + hh * 16;
                        *(u32x4*)dst = w0; *(u32x4*)(dst + 8) = w1;
                        asm volatile("" ::: "memory");
                    }
                }
            }
    }
};
struct EpiQ {
    static constexpr bool PERM = true, AFTER_DRAIN = false;
    bf16_t* q;
    __device__ __forceinline__ void operator()(const f32x4 (&acc)[2][2][4][2], const Unit& u, int wr, int wc, int fr, int fq) const {
#pragma unroll
        for (int ai = 0; ai < 2; ++ai)
#pragma unroll
            for (int m = 0; m < 4; ++m)
#pragma unroll
                for (int bj = 0; bj < 2; ++bj) {
                    const f32x4 a = acc[ai][bj][m][0], b = acc[ai][bj][m][1];
                    u32x4 w; w.x = pack2(a[0], a[1]); w.y = pack2(a[2], a[3]); w.z = pack2(b[0], b[1]); w.w = pack2(b[2], b[3]);
                    *(u32x4*)(q + (size_t)(u.pm * BM + ai * HALF + wr * 64 + m * 16 + fr) * 2048 + u.pn * BM + bj * HALF + wc * 32 + 8 * fq) = w;
                }
    }
};
}
DI void run_gemmq_pg8(const Params& p, int l, unsigned char* smem) {
    volatile LAS unsigned* st = (volatile LAS unsigned*)(smem + SMEM_BYTES);
    pg8::XcdOrder S; S.init(NTOK / 256, 2048 / 256, (int)st[0], (int)st[1], (int)st[2], (int)st[3]);
    const pg8::Gemm g{WSP(bf16_t, WS_XN), WSP(bf16_t, WS_W_PQ) + (size_t)l * 2048 * DM, NTOK, 2048, DM};
    pg8::EpiQ E; E.q = WSP(bf16_t, WS_QBUF);
    __syncthreads();
    pg8::gemm_phase<pg8::EpiQ, pg8::XcdOrder, true, true>((PG8_LAS unsigned char*)smem, g, S, E);
}
template <int WHICH>
DI void run_gemm_pg8(const Params& p, unsigned char* smem) {
    volatile LAS unsigned* st = (volatile LAS unsigned*)(smem + SMEM_BYTES);
    pg8::XcdOrder S; S.init(NTOK / 256, DM / 256, (int)st[0], (int)st[1], (int)st[2], (int)st[3]);
    pg8::Gemm g;
    pg8::EpiResid E;
    if (WHICH == 0) { g = pg8::Gemm{WSP(bf16_t, WS_MIXED), WSP(bf16_t, WS_W_ATTOUT), NTOK, DM, DM}; E.resid = p.in[0]; E.out = p.out; }
    else { g = pg8::Gemm{WSP(bf16_t, WS_Z_U), WSP(bf16_t, WS_W_SGUOUT), NTOK, DM, CW}; E.resid = p.out; E.out = p.out; }
    __syncthreads();
    pg8::gemm_phase<pg8::EpiResid, pg8::XcdOrder, true, true>((PG8_LAS unsigned char*)smem, g, S, E);
}

DI void run_gemm1_pg8(const Params& p, unsigned char* smem) {
    volatile LAS unsigned* st = (volatile LAS unsigned*)(smem + SMEM_BYTES);
    pg8::XcdOrder S; S.init(NTOK / 256, ATT_IN / 256, (int)st[0], (int)st[1], (int)st[2], (int)st[3]);
    const pg8::Gemm g{WSP(bf16_t, WS_XN), WSP(bf16_t, WS_W_ATTIN), NTOK, ATT_IN, DM};
    pg8::EpiProj E; E.aq = p.in[3]; E.ak = p.in[4]; E.bq = p.in[5]; E.bk = p.in[6]; E.proj = WSP(bf16_t, WS_PROJ); E.xs = (PG8_LAS float*)(smem + PG8_EXTRA);
    __syncthreads();
    pg8::gemm_phase<pg8::EpiProj, pg8::XcdOrder, true, true>((PG8_LAS unsigned char*)smem, g, S, E);
}
DI void run_gemm4_pg8(const Params& p, unsigned char* smem) {
    volatile LAS unsigned* st = (volatile LAS unsigned*)(smem + SMEM_BYTES);
    pg8::XcdOrder S; S.init(NTOK / 256, 4096 / 256, (int)st[0], (int)st[1], (int)st[2], (int)st[3]);
    const pg8::Gemm g{WSP(bf16_t, WS_XN), WSP(bf16_t, WS_W_SGUIN), NTOK, 4096, DM};
    pg8::EpiSgu E; E.zu = WSP(bf16_t, WS_Z_U); E.zvt = WSP(bf16_t, WS_Z_VT); E.ssq = WSP(float, WS_SSQ); E.stg = (PG8_LAS unsigned char*)(smem + PG8_EXTRA);
    __syncthreads();
    pg8::gemm_phase<pg8::EpiSgu, pg8::XcdOrder, true, true>((PG8_LAS unsigned char*)smem, g, S, E);
}

DI u32 cand_key(float s, int ci) { return (f2ord(s) & ~255u) | (u32)(255 - ci); }
template <int P>
DI void score_half(const bf16x8 (&qf)[8], const unsigned char* skl, int fr, int fh, u32 (&lst)[16]) {
#pragma unroll
    for (int j = 0; j < 16; ++j) lst[j] = 0u;
#pragma unroll 1
    for (int kt = 0; kt < 4; ++kt) {
        f32x16 st;
#pragma unroll
        for (int r = 0; r < 16; ++r) st[r] = 0.f;
        const int row = P * 128 + kt * 32 + fr;
        const unsigned char* skr = skl + row * 256;
#pragma unroll
        for (int ks = 0; ks < 8; ++ks) st = MFMA32(*(const bf16x8*)(skr + (((2 * ks + fh) ^ (row & 15)) << 4)), qf[ks], st);
        u32 ks_[16];
#pragma unroll
        for (int r = 0; r < 16; ++r) ks_[r] = (f2ord(st[r]) & ~127u) | (u32)(127 - (kt * 32 + crow(r, fh)));
        sort16_desc(ks_);
        merge16_desc(lst, ks_);
    }
    u32 other[16];
#pragma unroll
    for (int j = 0; j < 16; ++j) other[j] = (u32)__shfl_xor((int)lst[j], 32);
    merge16_desc(lst, other);
}
DI void run_score(const Params& p, int l, unsigned char* smem) {
    const int tid = otid512(), wave = tid >> 6, lane = tid & 63, fr = lane & 31, fh = lane >> 5;
    int cur_h = -1;
    bf16x8 qa[8], qb[8];
    if ((int)blockIdx.x < 8 * (NTOK / 256)) {
        const int it0 = blockIdx.x;
        const bf16_t* q0 = WSP(bf16_t, WS_QBUF) + (size_t)((it0 >> 3) * 256 + wave * 32 + fr) * 2048 + (it0 & 7) * 256 + 8 * fh;
#pragma unroll
        for (int ks = 0; ks < 8; ++ks) { qa[ks] = *(const bf16x8*)(q0 + 16 * ks); qb[ks] = *(const bf16x8*)(q0 + 128 + 16 * ks); }
    }
#pragma unroll 1
    for (int it = blockIdx.x; it < 8 * (NTOK / 256); it += gridDim.x) {
    const int h = it & 7, oct = it >> 3;
    if (h != cur_h) {
        __syncthreads();
        const bf16_t* skg = WSP(bf16_t, WS_W_SUBK) + ((size_t)l * 16 + h * 2) * 128 * 128;
#pragma unroll
        for (int i = 0; i < 8; ++i) {
            const int idx = wave * 8 + i;
            const int row = 4 * idx + (lane >> 4), cp = lane & 15;
            __builtin_amdgcn_global_load_lds((const unsigned*)(skg + (size_t)row * 128 + ((cp ^ (row & 15)) << 3)), (unsigned*)(smem + idx * 1024 + lane * 16), 16, 0, 0);
        }
        asm volatile("s_waitcnt vmcnt(0)" ::: "memory");
        __syncthreads();
        cur_h = h;
    }
    const int tok = oct * 256 + wave * 32 + fr;
    const unsigned char* skh = smem;
    u32 L0[16], L1[16];
    score_half<0>(qa, skh, fr, fh, L0);
    score_half<1>(qb, skh, fr, fh, L1);
    {
        const int itn = it + gridDim.x < 8 * (NTOK / 256) ? it + gridDim.x : it;
        const bf16_t* qn = WSP(bf16_t, WS_QBUF) + (size_t)((itn >> 3) * 256 + wave * 32 + fr) * 2048 + (itn & 7) * 256 + 8 * fh;
#pragma unroll
        for (int ks = 0; ks < 8; ++ks) { qa[ks] = *(const bf16x8*)(qn + 16 * ks); qb[ks] = *(const bf16x8*)(qn + 128 + 16 * ks); }
    }
    LAS int* slot = (LAS int*)(smem + 65536 + wave * (64 * 132)) + lane * 33;
    float s1[16], s2[16];
#pragma unroll
    for (int j = 0; j < 16; ++j) {
        s1[j] = ord2f(L0[j] & ~127u); s2[j] = ord2f(L1[j] & ~127u);
        slot[j] = 127 - (int)(L0[j] & 127u); slot[16 + j] = 127 - (int)(L1[j] & 127u);
    }
    u32 lst[16];
#pragma unroll
    for (int j = 0; j < 16; ++j) lst[j] = cand_key(s1[0] + s2[j], j);
#pragma unroll
    for (int i = 1; i < 5; ++i) {
        u32 row[16];
#pragma unroll
        for (int j = 0; j < 16; ++j) row[j] = ((i + 1) * (j + 1) <= 16) ? cand_key(s1[i] + s2[j], i * 16 + j) : 0u;
        merge16_desc(lst, row);
    }
#pragma unroll
    for (int i = 5; i < 16; ++i)
#pragma unroll
        for (int j = 0; j < 2; ++j)
            if ((i + 1) * (j + 1) <= 16) top16_insert(lst, cand_key(s1[i] + s2[j], i * 16 + j));
    float pv[16]; float sum = 0.f;
    const float mx = ord2f(lst[0] & ~255u);
#pragma unroll
    for (int j = 0; j < 16; ++j) { pv[j] = __expf(ord2f(lst[j] & ~255u) - mx); sum += pv[j]; }
    const float inv = 1.f / sum;
    int ev[16];
#pragma unroll
    for (int j = 0; j < 16; ++j) {
        const int ci = 255 - (int)(lst[j] & 255u);
        ev[j] = slot[ci >> 4] * 128 + slot[16 + (ci & 15)];
    }
    if (fh == 0) {
        int4* ro = (int4*)(WSP(int, WS_RIDX) + (size_t)tok * 128 + h * 16);
        float4* go = (float4*)(WSP(float, WS_RG) + (size_t)tok * 128 + h * 16);
#pragma unroll
        for (int q = 0; q < 4; ++q) {
            ro[q] = make_int4(ev[4 * q], ev[4 * q + 1], ev[4 * q + 2], ev[4 * q + 3]);
            go[q] = make_float4(pv[4 * q] * inv, pv[4 * q + 1] * inv, pv[4 * q + 2] * inv, pv[4 * q + 3] * inv);
        }
    }
    }
}


#define OSM_THR 8.0f
DI void osm_update(f32x16& s, unsigned vm, float& m, float& lh, float& alpha) {
    float mx = -1e30f;
#pragma unroll
    for (int r = 0; r < 16; ++r) mx = ((vm >> r) & 1u) ? fmaxf(mx, s[r]) : mx;
    mx = fmaxf(mx, __shfl_xor(mx, 32));
    float mn = m; alpha = 1.f;
    if (!__all(mx <= m + OSM_THR)) { mn = fmaxf(m, mx); alpha = __expf(m - mn); }
    float ls = 0.f;
#pragma unroll
    for (int r = 0; r < 16; ++r) { const float pe = ((vm >> r) & 1u) ? __expf(s[r] - mn) : 0.f; s[r] = pe; ls += pe; }
    lh = lh * alpha + ls; m = mn;
}
DI void osm_update_full(f32x16& s, float& m, float& lh, float& alpha) {
    float mx = s[0];
#pragma unroll
    for (int r = 1; r < 16; ++r) mx = fmaxf(mx, s[r]);
    mx = fmaxf(mx, __shfl_xor(mx, 32));
    float mn = m; alpha = 1.f;
    if (!__all(mx <= m + OSM_THR)) { mn = fmaxf(m, mx); alpha = __expf(m - mn); }
    float ls = 0.f;
#pragma unroll
    for (int r = 0; r < 16; ++r) { const float pe = __expf(s[r] - mn); s[r] = pe; ls += pe; }
    lh = lh * alpha + ls; m = mn;
}
DI void tr_quad(const unsigned (&a)[4], unsigned hi_off, bf16x8 (&f)[4]) {
    s16x4 l0, h0, l1, h1, l2, h2, l3, h3;
    const unsigned b0 = a[0] + hi_off, b1 = a[1] + hi_off, b2 = a[2] + hi_off, b3 = a[3] + hi_off;
    asm volatile("ds_read_b64_tr_b16 %0, %8\n\tds_read_b64_tr_b16 %1, %9\n\tds_read_b64_tr_b16 %2, %10\n\tds_read_b64_tr_b16 %3, %11\n\t"
                 "ds_read_b64_tr_b16 %4, %12\n\tds_read_b64_tr_b16 %5, %13\n\tds_read_b64_tr_b16 %6, %14\n\tds_read_b64_tr_b16 %7, %15\n\ts_waitcnt lgkmcnt(0)"
                 : "=&v"(l0), "=&v"(h0), "=&v"(l1), "=&v"(h1), "=&v"(l2), "=&v"(h2), "=&v"(l3), "=&v"(h3)
                 : "v"(a[0]), "v"(b0), "v"(a[1]), "v"(b1), "v"(a[2]), "v"(b2), "v"(a[3]), "v"(b3) : "memory");
    f[0] = __builtin_shufflevector(l0, h0, 0, 1, 2, 3, 4, 5, 6, 7); f[1] = __builtin_shufflevector(l1, h1, 0, 1, 2, 3, 4, 5, 6, 7);
    f[2] = __builtin_shufflevector(l2, h2, 0, 1, 2, 3, 4, 5, 6, 7); f[3] = __builtin_shufflevector(l3, h3, 0, 1, 2, 3, 4, 5, 6, 7);
}

#define QB_BYTES (128 * 256)
#define KB_BYTES (32 * 256)
template <bool WITH_V>
DI void attnB_stage_kv(const bf16_t* __restrict__ kg  , unsigned char* Kd, unsigned char* Vd, int wave, int lane) {
#pragma unroll
    for (int i = 0; i < 2; ++i) {
        const int idx = wave * 2 + i;
        const int key = 4 * idx + (lane >> 4), cp = lane & 15;
        const bf16_t* g = kg + (size_t)key * ATT_IN;
        __builtin_amdgcn_global_load_lds((const unsigned*)(g + ((cp ^ (key & 15)) << 3)), (unsigned*)(Kd + idx * 1024 + lane * 16), 16, 0, 0);
        if (WITH_V) {
            const int cv = ((((cp >> 2) ^ (key & 3)) << 2) | (cp & 3));
            __builtin_amdgcn_global_load_lds((const unsigned*)(g + 512 + (cv << 3)), (unsigned*)(Vd + idx * 1024 + lane * 16), 16, 0, 0);
        }
    }
}
template <int KOFF, bool FULL>
DI void attnB_map(const unsigned char* Kc, const unsigned char* qlp, int ksw, int qsw, int fh, unsigned vm, unsigned vc, int tq,
                  float& m, float& l, f32x16 (&o)[4]) {
    f32x16 st;
#pragma unroll
    for (int r = 0; r < 16; ++r) st[r] = 0.f;
#pragma unroll
    for (int s = 0; s < 4; ++s) {
        const bf16x8 kf = *(const bf16x8*)(Kc + (((KOFF + 2 * s + fh) ^ ksw) << 4));
        const bf16x8 qf = *(const bf16x8*)(qlp + (((KOFF + 2 * s + fh) ^ qsw) << 4));
        st = MFMA32(kf, qf, st);
    }
    float al;
    if (FULL) osm_update_full(st, m, l, al); else osm_update(st, vm, m, l, al);
    if (!__all(al == 1.f)) {
#pragma unroll
        for (int d = 0; d < 4; ++d)
#pragma unroll
            for (int r = 0; r < 16; ++r) o[d][r] *= al;
    }
#pragma unroll
    for (int s = 0; s < 2; ++s) {
        const bf16x8 pf = pack_p(st, s);
        unsigned va[4]; bf16x8 vf[4];
#pragma unroll
        for (int d = 0; d < 4; ++d) va[d] = vc + s * 16 * 256 + ((d ^ tq) << 6);
        tr_quad(va, 8 * 256, vf);
#pragma unroll
        for (int d = 0; d < 4; ++d) o[d] = MFMA32(vf[d], pf, o[d]);
    }
}
DI void ph_attnB_fast(const Params& p, int item, unsigned char* smem) {
    const bf16_t* proj = WSP(bf16_t, WS_PROJ);
    const int tid = otid(), wave = tid >> 6, lane = tid & 63, fr = lane & 31, fh = lane >> 5;
    const int qt = 15 - (item >> 6), bh = item & 63, b = bh >> 2, h = bh & 3;
    const int q0 = qt * 128;
    const float lam = compute_lam(p, lane);
    const size_t rowbase = (size_t)b * SEQ;
    const int qrow = wave * 32 + fr, qpos = q0 + qrow;
    unsigned char* Ql = smem;
    unsigned char* Kl = smem + QB_BYTES;
    unsigned char* Vl = Kl + 2 * KB_BYTES;
    const bf16_t* kbase = proj + rowbase * ATT_IN + 2048 + h * 128;
    __syncthreads();
#pragma unroll
    for (int i = 0; i < 8; ++i) {
        const int idx = wave * 8 + i;
        const int row = 4 * idx + (lane >> 4), cp = lane & 15;
        __builtin_amdgcn_global_load_lds((const unsigned*)(proj + (rowbase + q0 + row) * ATT_IN + 1536 + h * 128 + ((cp ^ (row & 15)) << 3)),
                                         (unsigned*)(Ql + idx * 1024 + lane * 16), 16, 0, 0);
    }
    attnB_stage_kv<true>(kbase, Kl, Vl, wave, lane);
    const unsigned char* qlp = Ql + qrow * 256;
    const int qsw = qrow & 15, ksw = fr & 15;
    const int nkt = (q0 + 128) / 32;
    const int wlast = q0 + wave * 32 + 31;
    f32x16 o1[4], o2[4];
#pragma unroll
    for (int d = 0; d < 4; ++d)
#pragma unroll
        for (int r = 0; r < 16; ++r) { o1[d][r] = 0.f; o2[d][r] = 0.f; }
    float m1 = -1e30f, m2 = -1e30f, l1 = 0.f, l2 = 0.f;
    const int tq = (lane & 15) >> 2;
    const unsigned vrow = (unsigned)(uintptr_t)Vl + (4 * fh + tq) * 256 + (16 * ((lane >> 4) & 1) + 4 * (lane & 3)) * 2;
    asm volatile("s_waitcnt vmcnt(0)" ::: "memory");
    __syncthreads();
    for (int kt = 0; kt < nkt; ++kt) {
        const int cur = kt & 1;
        if (kt + 1 < nkt) attnB_stage_kv<true>(kbase + (size_t)(kt + 1) * 32 * ATT_IN, Kl + (cur ^ 1) * KB_BYTES, Vl + (cur ^ 1) * KB_BYTES, wave, lane);
        if (kt * 32 <= wlast) {
            const unsigned char* Kc = Kl + cur * KB_BYTES + fr * 256;
            const unsigned vc = vrow + cur * KB_BYTES;
            if (kt * 32 + 31 <= wlast - 31) {
                attnB_map<0, true>(Kc, qlp, ksw, qsw, fh, 0xffffu, vc, tq, m1, l1, o1);
                __builtin_amdgcn_sched_barrier(0);
                attnB_map<8, true>(Kc, qlp, ksw, qsw, fh, 0xffffu, vc, tq, m2, l2, o2);
            } else {
                unsigned vm = 0;
#pragma unroll
                for (int r = 0; r < 16; ++r) vm |= ((kt * 32 + crow(r, fh)) <= qpos) ? (1u << r) : 0u;
                attnB_map<0, false>(Kc, qlp, ksw, qsw, fh, vm, vc, tq, m1, l1, o1);
                __builtin_amdgcn_sched_barrier(0);
                attnB_map<8, false>(Kc, qlp, ksw, qsw, fh, vm, vc, tq, m2, l2, o2);
            }
        }
        asm volatile("s_waitcnt vmcnt(0)" ::: "memory");
        __syncthreads();
    }
    l1 += __shfl_xor(l1, 32); l2 += __shfl_xor(l2, 32);
    const float i1 = 1.f / l1, i2 = lam / l2;
    float ss = 0.f;
#pragma unroll
    for (int d = 0; d < 4; ++d)
#pragma unroll
        for (int r = 0; r < 16; ++r) { const float v = o1[d][r] * i1 - o2[d][r] * i2; o1[d][r] = v; ss += v * v; }
    ss += __shfl_xor(ss, 32);
    const float rinv = rsqrtf(ss * (1.f / 128.f) + EPSN) * 0.8f;
    const float* subg = p.in[11];
    bf16_t* op = WSP(bf16_t, WS_MIXED) + (rowbase + qpos) * DM + 512 + h * 128;
#pragma unroll
    for (int d = 0; d < 4; ++d)
#pragma unroll
        for (int g = 0; g < 4; ++g) {
            const int dim = 32 * d + 8 * g + 4 * fh;
            const float4 gg = *(const float4*)(subg + dim);
            uint2 w;
            w.x = pack2(o1[d][4 * g + 0] * rinv * gg.x, o1[d][4 * g + 1] * rinv * gg.y);
            w.y = pack2(o1[d][4 * g + 2] * rinv * gg.z, o1[d][4 * g + 3] * rinv * gg.w);
            *(uint2*)(op + dim) = w;
        }
}

#define KA_PITCH 128
#define VA_PITCH 192
#define WA_BYTES (32 * KA_PITCH + 32 * VA_PITCH)
template <int MODE>
DI void ph_attnA_fast(const Params& p, int item, unsigned char* smem) {
    const bf16_t* proj = WSP(bf16_t, WS_PROJ);
    const int tid = otid(), wave = tid >> 6, lane = tid & 63, fr = lane & 31, fh = lane >> 5;
    const int c = item & 15, h = (item >> 4) & 7, b = item >> 7;
    const size_t rowbase = (size_t)b * SEQ;
    const int qpos = MODE == 0 ? 128 * c + 32 * wave + fr : 16 * (32 * wave + fr) + c;
    const int pmin = MODE == 0 ? 128 * c + 32 * wave : 512 * wave + c, pmax = pmin + (MODE == 0 ? 31 : 496);
    bf16x8 qf[4];
    {
        const bf16_t* qp = proj + (rowbase + qpos) * ATT_IN + h * 64 + 8 * fh;
#pragma unroll
        for (int s = 0; s < 4; ++s) qf[s] = *(const bf16x8*)(qp + 16 * s);
    }
    f32x16 o[2];
#pragma unroll
    for (int d = 0; d < 2; ++d)
#pragma unroll
        for (int r = 0; r < 16; ++r) o[d][r] = 0.f;
    float m = -1e30f, l = 0.f;
    unsigned char* Kl = smem + wave * WA_BYTES;
    unsigned char* Vl = Kl + 32 * KA_PITCH;
    const unsigned vaddr = (unsigned)(uintptr_t)Vl + (4 * fh + ((lane & 15) >> 2)) * VA_PITCH + (16 * ((lane >> 4) & 1) + 4 * (lane & 3)) * 2;
    const int skey = lane >> 3, sc = lane & 7;
    int br = 0, d = MODE == 0 ? 1 : 16, W = MODE == 0 ? 128 : 2048, cls = MODE == 0 ? 0 : (c & 15);
    int j0 = MODE == 0 ? (pmin < 128 ? 0 : pmin - 128) : 0, jhi = MODE == 0 ? pmax : ((pmax - cls) >> 4);
    const bf16_t* kvbase = proj + rowbase * ATT_IN + 512 + h * 64 + sc * 8;
    uint4 rk0, rk1, rk2, rk3, rv0, rv1, rv2, rv3;
#define A_LOAD(i, RK, RV) do { int kp_ = cls + d * (j0 + skey + 8 * (i)); kp_ = kp_ > SEQ - 1 ? SEQ - 1 : kp_; kp_ = kp_ < 0 ? 0 : kp_; \
        const bf16_t* g_ = kvbase + (size_t)kp_ * ATT_IN; RK = *(const uint4*)g_; RV = *(const uint4*)(g_ + 512); } while (0)
#define A_WRITE(i, RK, RV) do { const int key_ = skey + 8 * (i); *(uint4*)(Kl + key_ * KA_PITCH + ((sc ^ ((key_ >> 1) & 7)) << 4)) = RK; \
        *(uint4*)(Vl + key_ * VA_PITCH + sc * 16) = RV; } while (0)
    A_LOAD(0, rk0, rv0); A_LOAD(1, rk1, rv1); A_LOAD(2, rk2, rv2); A_LOAD(3, rk3, rv3);
#pragma unroll 1
    for (;;) {
        A_WRITE(0, rk0, rv0); A_WRITE(1, rk1, rv1); A_WRITE(2, rk2, rv2); A_WRITE(3, rk3, rv3);
        const int cd = d, cW = W, ccls = cls, cj0 = j0;
        bool more = true;
        j0 += 32;
        if (j0 > jhi) {
            ++br;
            if (MODE == 0 || br == 2) more = false;
            else {
                d = 4; W = 512; cls = c & 3;
                const int lo = pmin - cls - W;
                j0 = lo < 0 ? 0 : lo >> 2;
                jhi = (pmax - cls) >> 2;
            }
        }
        A_LOAD(0, rk0, rv0); A_LOAD(1, rk1, rv1); A_LOAD(2, rk2, rv2); A_LOAD(3, rk3, rv3);
        f32x16 st;
#pragma unroll
        for (int r = 0; r < 16; ++r) st[r] = 0.f;
#pragma unroll
        for (int s = 0; s < 4; ++s) {
            const bf16x8 kf = *(const bf16x8*)(Kl + fr * KA_PITCH + (((2 * s + fh) ^ ((fr >> 1) & 7)) << 4));
            st = MFMA32(kf, qf[s], st);
        }
        float al;
        const int kfirst = ccls + cd * cj0, klast = kfirst + cd * 31;
        if (klast <= pmin && pmax - kfirst <= cW) osm_update_full(st, m, l, al);
        else {
            unsigned vm = 0;
#pragma unroll
            for (int r = 0; r < 16; ++r) {
                const int dist = qpos - (ccls + cd * (cj0 + crow(r, fh)));
                vm |= (dist >= 0 && dist <= cW) ? (1u << r) : 0u;
            }
            osm_update(st, vm, m, l, al);
        }
        if (!__all(al == 1.f)) {
#pragma unroll
            for (int dd = 0; dd < 2; ++dd)
#pragma unroll
                for (int r = 0; r < 16; ++r) o[dd][r] *= al;
        }
        {
            unsigned va[4]; bf16x8 vf[4];
            va[0] = vaddr; va[1] = vaddr + 64; va[2] = vaddr + 16 * VA_PITCH; va[3] = vaddr + 16 * VA_PITCH + 64;
            tr_quad(va, 8 * VA_PITCH, vf);
            const bf16x8 p0 = pack_p(st, 0), p1 = pack_p(st, 1);
            o[0] = MFMA32(vf[0], p0, o[0]); o[1] = MFMA32(vf[1], p0, o[1]);
            o[0] = MFMA32(vf[2], p1, o[0]); o[1] = MFMA32(vf[3], p1, o[1]);
        }
        if (!more) break;
    }
    l += __shfl_xor(l, 32);
    bf16_t* op = WSP(bf16_t, WS_MIXED) + (rowbase + qpos) * DM + h * 64;
    float* lsep = WSP(float, WS_LSE1) + (rowbase + qpos) * 8 + h;
    if (MODE == 0) {
        const float il = 1.f / l;
        if (fh == 0) *lsep = m + __logf(l);
#pragma unroll
        for (int dd = 0; dd < 2; ++dd)
#pragma unroll
            for (int g = 0; g < 4; ++g) {
                const int dim = 32 * dd + 8 * g + 4 * fh;
                uint2 w;
                w.x = pack2(o[dd][4 * g + 0] * il, o[dd][4 * g + 1] * il);
                w.y = pack2(o[dd][4 * g + 2] * il, o[dd][4 * g + 3] * il);
                *(uint2*)(op + dim) = w;
            }
    } else {
        const float lse1 = *lsep;
        const float M = fmaxf(m, lse1);
        const float w23 = __expf(m - M), w1 = __expf(lse1 - M);
        const float iden = 1.f / (l * w23 + w1);
        const float a23 = w23 * iden, a1 = w1 * iden;
        uint2 prev[2][4];
#pragma unroll
        for (int dd = 0; dd < 2; ++dd)
#pragma unroll
            for (int g = 0; g < 4; ++g) prev[dd][g] = *(const uint2*)(op + 32 * dd + 8 * g + 4 * fh);
#pragma unroll
        for (int dd = 0; dd < 2; ++dd)
#pragma unroll
            for (int g = 0; g < 4; ++g) {
                const int dim = 32 * dd + 8 * g + 4 * fh;
                const float p0 = __uint_as_float(prev[dd][g].x << 16), p1 = __uint_as_float(prev[dd][g].x & 0xffff0000u);
                const float p2 = __uint_as_float(prev[dd][g].y << 16), p3 = __uint_as_float(prev[dd][g].y & 0xffff0000u);
                uint2 w;
                w.x = pack2(o[dd][4 * g + 0] * a23 + p0 * a1, o[dd][4 * g + 1] * a23 + p1 * a1);
                w.y = pack2(o[dd][4 * g + 2] * a23 + p2 * a1, o[dd][4 * g + 3] * a23 + p3 * a1);
                *(uint2*)(op + dim) = w;
            }
    }
}
#define NITEM_B 1024
#define NITEM_A 2048
DI void ph_attn_fast(const Params& p, int vb, unsigned char* smem) {
    if (vb < NITEM_B) {
        const int item = vb < 512 ? vb : 512 + (1023 - vb);
        ph_attnB_fast(p, item, smem);
    } else ph_attnA_fast<0>(p, vb - NITEM_B, smem);
}


DI void ph_spatial_fast(const Params& p, int item, unsigned char* smem) {
    const int tid = otid(), wave = tid >> 6, lane = tid & 63, fr = lane & 31, fh = lane >> 5;
    const int wm = wave >> 1, wn = wave & 1;
    const int chunk = item >> 3, g = item & 7;
    bf16_t* u = WSP(bf16_t, WS_Z_U);
    const bf16_t* vt = WSP(bf16_t, WS_Z_VT);
    const float* ssq = WSP(float, WS_SSQ);
    const float* wsp = p.in[16] + (size_t)g * 128 * 128;
    float* rinv = (float*)(smem + 66 * 1024);
    unsigned char* Bt = smem + 32768;
    __syncthreads();
    if (tid < 128) {
        const float4* sp = (const float4*)(ssq + (size_t)(chunk * 128 + tid) * 64);
        float sacc = 0.f;
#pragma unroll
        for (int j = 0; j < 16; ++j) { const float4 q = sp[j]; sacc += (q.x + q.y) + (q.z + q.w); }
        rinv[tid] = rsqrtf(sacc * (1.f / CW) + EPSN);
    }
    const size_t vrow0 = (size_t)chunk * CW + g * 256;
    stage_tile(vt, 128, (int)vrow0, 0, Bt, wave, lane);
    stage_tile(vt, 128, (int)vrow0, 64, Bt + 16384, wave, lane);
    __syncthreads();
#pragma unroll
    for (int i = 0; i < 8; ++i) {
        const int id = tid + 256 * i;
        const int t = id >> 4, sc = id & 15;
        const float4 w0 = *(const float4*)(wsp + t * 128 + sc * 8);
        const float4 w1 = *(const float4*)(wsp + t * 128 + sc * 8 + 4);
        const float4 r0 = *(const float4*)(rinv + sc * 8);
        const float4 r1 = *(const float4*)(rinv + sc * 8 + 4);
        const int s0 = sc * 8;
        uint4 o;
        o.x = pack2(s0 + 0 <= t ? w0.x * r0.x : 0.f, s0 + 1 <= t ? w0.y * r0.y : 0.f);
        o.y = pack2(s0 + 2 <= t ? w0.z * r0.z : 0.f, s0 + 3 <= t ? w0.w * r0.w : 0.f);
        o.z = pack2(s0 + 4 <= t ? w1.x * r1.x : 0.f, s0 + 5 <= t ? w1.y * r1.y : 0.f);
        o.w = pack2(s0 + 6 <= t ? w1.z * r1.z : 0.f, s0 + 7 <= t ? w1.w * r1.w : 0.f);
        const int kt = sc >> 3, c = sc & 7;
        *(uint4*)(smem + kt * 16384 + t * 128 + ((c ^ ((t >> 1) & 7)) << 4)) = o;
    }
#pragma unroll 1
    for (int nt = 0; nt < 2; ++nt) {
        asm volatile("s_waitcnt vmcnt(0)" ::: "memory");
        __syncthreads();
        f32x16 acc[2][2];
#pragma unroll
        for (int i = 0; i < 2; ++i)
#pragma unroll
            for (int j = 0; j < 2; ++j)
#pragma unroll
                for (int r = 0; r < 16; ++r) acc[i][j][r] = 0.f;
#pragma unroll
        for (int kt = 0; kt < 2; ++kt)
#pragma unroll
            for (int s = 0; s < 4; ++s) {
                bf16x8 a[2], b[2];
#pragma unroll
                for (int i = 0; i < 2; ++i) {
                    a[i] = lds_frag(smem + kt * 16384, wm * 64 + i * 32 + fr, 2 * s + fh);
                    b[i] = lds_frag(Bt + kt * 16384, wn * 64 + i * 32 + fr, 2 * s + fh);
                }
#pragma unroll
                for (int i = 0; i < 2; ++i)
#pragma unroll
                    for (int j = 0; j < 2; ++j) acc[i][j] = MFMA32(a[i], b[j], acc[i][j]);
            }
        __syncthreads();
        float* st = (float*)(Bt + wave * (32 * 65 * 4));
#pragma unroll
        for (int i = 0; i < 2; ++i) {
#pragma unroll
            for (int j = 0; j < 2; ++j)
#pragma unroll
                for (int r = 0; r < 16; ++r) st[crow(r, fh) * 65 + j * 32 + fr] = acc[i][j][r];
            const int t = wm * 64 + i * 32 + fr;
            const int c0 = g * 256 + nt * 128 + wn * 64 + fh * 32;
            bf16_t* up = u + (size_t)(chunk * 128 + t) * CW + c0;
            const float bias = p.in[17][g * 128 + t];
            const float* gn = p.in[15] + c0;
            uint4 ur[4];
#pragma unroll
            for (int q = 0; q < 4; ++q) ur[q] = ((const uint4*)up)[q];
#pragma unroll
            for (int q = 0; q < 4; ++q) {
                float uf[8]; unpack8(ur[q], uf);
                const float4 g0 = *(const float4*)(gn + 8 * q), g1 = *(const float4*)(gn + 8 * q + 4);
                const float gg[8] = {g0.x, g0.y, g0.z, g0.w, g1.x, g1.y, g1.z, g1.w};
                float ov[8];
#pragma unroll
                for (int e = 0; e < 8; ++e) ov[e] = uf[e] * (st[fr * 65 + fh * 32 + 8 * q + e] * gg[e] + bias);
                uint4 o; o.x = pack2(ov[0], ov[1]); o.y = pack2(ov[2], ov[3]); o.z = pack2(ov[4], ov[5]); o.w = pack2(ov[6], ov[7]);
                ((uint4*)up)[q] = o;
            }
        }
        if (nt == 0) {
            __syncthreads();
            stage_tile(vt, 128, (int)vrow0 + 128, 0, Bt, wave, lane);
            stage_tile(vt, 128, (int)vrow0 + 128, 64, Bt + 16384, wave, lane);
        }
    }
}

#define XB_TMO      128
#define XB_XCNT(j)  (256  + 64 * (j))
#define XB_XSUB(j)  (1280 + 64 * (j))
#define XB_XGEN(j)  (2304 + 64 * (j))
#define XB_TOP      3328
#define XB_TOPGEN   3392
#define XCD_BAR_WORDS 3456
#define XB_SPIN_CAP (1u << 22)
DI unsigned xb_ld(unsigned* p) { return __hip_atomic_load(p, __ATOMIC_RELAXED, __HIP_MEMORY_SCOPE_AGENT); }
DI unsigned xb_add(unsigned* p, unsigned v) { return __hip_atomic_fetch_add(p, v, __ATOMIC_RELAXED, __HIP_MEMORY_SCOPE_AGENT); }
DI unsigned xb_xcc_id() { return (unsigned)__builtin_amdgcn_s_getreg((3 << 11) | 20) & 0xFu; }
#define XB_SPIN(cond, bar) do { unsigned _sp = 0; while (cond) { __builtin_amdgcn_s_sleep(1); \
    if ((++_sp & 255u) == 0u) { if (xb_ld(&(bar)[XB_TMO])) break; if (_sp > XB_SPIN_CAP) { atomicAdd(&(bar)[XB_TMO], 1u); break; } } } } while (0)
struct XcdBarrier { unsigned* bar; unsigned x; volatile LAS unsigned* st; };
DI XcdBarrier xcd_barrier_post(unsigned* bar, volatile LAS unsigned* st) {
    XcdBarrier b; b.bar = bar; b.x = xb_xcc_id(); b.st = st;
    if (threadIdx.x == 0) st[2] = xb_add(&bar[XB_XCNT(b.x)], 1u);
    return b;
}
DI void xcd_barrier_complete(unsigned* bar, unsigned x, unsigned& nloc, unsigned& nx, unsigned& xi) {
    const unsigned G = gridDim.x * gridDim.y * gridDim.z;
    unsigned sum, cnt, mine, below, sp = 0u;
    for (;;) {
        sum = 0u; cnt = 0u; mine = 0u; below = 0u;
#pragma unroll
        for (unsigned j = 0; j < 16; ++j) { const unsigned c = xb_ld(&bar[XB_XCNT(j)]); sum += c; cnt += (c > 0u) ? 1u : 0u; mine = (j == x) ? c : mine; below += (c > 0u && j < x) ? 1u : 0u; }
        if (sum == G) break;
        __builtin_amdgcn_s_sleep(1);
        if ((++sp & 255u) == 0u) { if (xb_ld(&bar[XB_TMO])) break; if (sp > XB_SPIN_CAP) { atomicAdd(&bar[XB_TMO], 1u); break; } }
    }
    nloc = mine > 0u ? mine : 1u; nx = cnt > 0u ? cnt : 1u; xi = below;
}
DI void xcd_barrier(const XcdBarrier& b) {
    asm volatile("s_waitcnt vmcnt(0)" ::: "memory");
    __syncthreads();
    if (threadIdx.x == 0) {
        unsigned* bar = b.bar;
        __builtin_amdgcn_s_waitcnt(0);
        unsigned nloc = b.st[0], nx = b.st[1];
        if (nloc == 0u) { unsigned xi; xcd_barrier_complete(bar, b.x, nloc, nx, xi); b.st[0] = nloc; b.st[1] = nx; b.st[3] = xi; }
        const unsigned old = xb_add(&bar[XB_XSUB(b.x)], 1u);
        const unsigned gen = old / nloc;
        if (old + 1u == (gen + 1u) * nloc) {
            __builtin_amdgcn_fence(__ATOMIC_RELEASE, "agent");
            asm volatile("s_waitcnt vmcnt(0)" ::: "memory");
            const unsigned og = xb_add(&bar[XB_TOP], 1u);
            const unsigned tg = og / nx;
            if (og + 1u == (tg + 1u) * nx) xb_add(&bar[XB_TOPGEN], 1u);
            else XB_SPIN(xb_ld(&bar[XB_TOPGEN]) == tg, bar);
            __builtin_amdgcn_fence(__ATOMIC_ACQUIRE, "agent");
            xb_add(&bar[XB_XGEN(b.x)], 1u);
            asm volatile("s_waitcnt vmcnt(0)" ::: "memory");
        } else {
            XB_SPIN(xb_ld(&bar[XB_XGEN(b.x)]) == gen, bar);
            __builtin_amdgcn_fence(__ATOMIC_ACQUIRE, "agent");
            asm volatile("s_waitcnt vmcnt(0)" ::: "memory");
        }
    }
    __syncthreads();
}

enum { PH_PREP = 0, PH_GEMM1, PH_ATTN, PH_ATTN2, PH_GEMM2,
       PH_NORM_P0, PH_GEMMQ0, PH_SCORE0, PH_PDOWN0, PH_PCOMB0, PH_PUP0, PH_NORM_SGU,
       PH_GEMM4, PH_SPATIAL, PH_GEMM5,
       PH_NORM_P1, PH_GEMMQ1, PH_SCORE1, PH_PDOWN1, PH_PCOMB1, PH_PUP1, PH_COUNT };

__host__ __device__ constexpr int phase_nvb(int ph) {
    switch (ph) {
        case PH_PREP: return PREP_N;
        case PH_GEMM1: return (ATT_IN / 256) * (NTOK / 256);
        case PH_ATTN: return NITEM_B + NITEM_A;
        case PH_ATTN2: return NITEM_A;
        case PH_GEMM2: return (DM / 256) * (NTOK / 256);
        case PH_NORM_P0: case PH_NORM_P1: case PH_NORM_SGU: return NTOK / 4;
        case PH_GEMMQ0: case PH_GEMMQ1: return 16 * (NTOK / 256);
        case PH_SCORE0: case PH_SCORE1: return (NTOK / 32) * 8 / 4;
        case PH_PCOMB0: case PH_PCOMB1: return NTOK / 4;
        case PH_GEMM4: return (4096 / 256) * (NTOK / 256);
        case PH_SPATIAL: return 256 * 8;
        case PH_GEMM5: return (DM / 256) * (NTOK / 256);
    }
    return 0;
}

template <int PH>
DI void run_vb(const Params& p, int vb, unsigned char* smem) {
    if constexpr (PH == PH_PREP) ph_prep(p, vb, smem);
    else if constexpr (PH == PH_ATTN) ph_attn_fast(p, vb, smem);
    else if constexpr (PH == PH_ATTN2) ph_attnA_fast<1>(p, vb, smem);
    else if constexpr (PH == PH_NORM_P0 || PH == PH_NORM_P1) rmsnorm_rows<true>(p.out, p.in[19] + (PH == PH_NORM_P1 ? DM : 0), WSP(bf16_t, WS_XN), vb, WSP(signed char, WS_XQ), WSP(float, WS_XSC));
    else if constexpr (PH == PH_PCOMB0 || PH == PH_PCOMB1) ph_peer_comb(p, vb, PH == PH_PCOMB1 ? 1 : 0);
    else if constexpr (PH == PH_NORM_SGU) rmsnorm_rows<false>(p.out, p.in[13], WSP(bf16_t, WS_XN), vb);
    else if constexpr (PH == PH_SPATIAL) ph_spatial_fast(p, vb, smem);
}

template <int PH>
DI void run_phase(const Params& p, unsigned char* smem) {
    if constexpr (PH == PH_PDOWN0 || PH == PH_PDOWN1) run_peer_sliced<false>(p, PH == PH_PDOWN1 ? 1 : 0, smem);
    else if constexpr (PH == PH_PUP0 || PH == PH_PUP1) run_peer_sliced<true>(p, PH == PH_PUP1 ? 1 : 0, smem);
    else if constexpr (PH == PH_SCORE0 || PH == PH_SCORE1) run_score(p, PH == PH_SCORE1 ? 1 : 0, smem);
    else if constexpr (PH == PH_GEMMQ0 || PH == PH_GEMMQ1) run_gemmq_pg8(p, PH == PH_GEMMQ1 ? 1 : 0, smem);
    else if constexpr (PH == PH_GEMM1) run_gemm1_pg8(p, smem);
    else if constexpr (PH == PH_GEMM4) run_gemm4_pg8(p, smem);
    else if constexpr (PH == PH_GEMM2) run_gemm_pg8<0>(p, smem);
    else if constexpr (PH == PH_GEMM5) run_gemm_pg8<1>(p, smem);
    else {
        constexpr int nvb = phase_nvb(PH);
        const int g = threadIdx.x >> 8;
        for (int vb = 2 * blockIdx.x; vb < nvb; vb += 2 * gridDim.x)
            if (vb + g < nvb) run_vb<PH>(p, vb + g, smem + g * GROUP_SMEM);
    }
}

template <int PH>
DI void run_from(const Params& p, unsigned char* smem, cg::grid_group& grid, const XcdBarrier& xb) {
    run_phase<PH>(p, smem);
    if constexpr (PH + 1 < PH_COUNT) {
        if constexpr (PH == 1) grid.sync(); else xcd_barrier(xb);
        run_from<PH + 1>(p, smem, grid, xb);
    }
}

__global__ void __launch_bounds__(NTHREADS, 2) k_mega(Params p) {
    extern __shared__ __attribute__((aligned(16))) unsigned char smem[];
    cg::grid_group grid = cg::this_grid();
    volatile LAS unsigned* st = (volatile LAS unsigned*)(smem + SMEM_BYTES);
    if (threadIdx.x == 0) { st[0] = 0u; st[1] = 0u; st[2] = 0u; st[3] = 0u; }
    __syncthreads();
    const XcdBarrier xb = xcd_barrier_post((unsigned*)(p.ws + WS_CTL), st);
    run_from<0>(p, smem, grid, xb);
}


extern "C" void kernel_launch(void* const* d_in, const int* in_sizes, int n_in, void* d_out, int out_size, void* d_ws, size_t ws_size, hipStream_t stream) {
    if (n_in != 24 || ws_size < WS_NEED || in_sizes[0] != NTOK * DM || out_size != NTOK * DM || in_sizes[22] != 2 * NEXP * DM) {
        fprintf(stderr, "kernel_launch: built for x[16,2048,1024] with 24 inputs and >= 512 MiB of workspace; got n_in %d, in0 %d, out %d, ws %zu: nothing launched\n", n_in, in_sizes[0], out_size, ws_size); return; }
    static int grid_blocks = 0;
    if (!grid_blocks) {
        int dev = 0, cus = 0, per_cu = 0;
        (void)hipGetDevice(&dev);
        (void)hipDeviceGetAttribute(&cus, hipDeviceAttributeMultiprocessorCount, dev);
        (void)hipFuncSetAttribute((const void*)k_mega, hipFuncAttributeMaxDynamicSharedMemorySize, SMEM_ALLOC);
        (void)hipOccupancyMaxActiveBlocksPerMultiprocessor(&per_cu, (const void*)k_mega, NTHREADS, SMEM_ALLOC);
        if (per_cu > 1) per_cu = 1;
        if (per_cu < 1) { fprintf(stderr, "kernel_launch: occupancy query returned %d\n", per_cu); per_cu = 1; }
        grid_blocks = cus * per_cu;
    }
    Params p{};
    for (int i = 0; i < 24; ++i) p.in[i] = (const float*)d_in[i];
    p.out = (float*)d_out;
    p.ws = (unsigned char*)d_ws;
    void* args[] = {&p};
    if (hipMemsetAsync((unsigned char*)d_ws + WS_CTL, 0, XCD_BAR_WORDS * 4, stream) != hipSuccess) { fprintf(stderr, "kernel_launch: memset of the barrier words failed\n"); return; }
    hipError_t e = hipLaunchCooperativeKernel((const void*)k_mega, dim3(grid_blocks), dim3(NTHREADS), args, SMEM_ALLOC, stream);
    if (e != hipSuccess) fprintf(stderr, "cooperative launch failed: %s (grid %d)\n", hipGetErrorString(e), grid_blocks);
}
```

```cpp
#include <hip/hip_runtime.h>
#include <stdint.h>
#include <stdio.h>

#define NTOK   32768
#define DM     1024
#define SEQ    2048
#define NB     16
#define ATT_IN 3072
#define CW     2048
#define NEXP   16384
#define EPSN   1e-6f

typedef unsigned short bf16_t;
typedef unsigned int u32;

#define DI __device__ __forceinline__
#define LAS __attribute__((address_space(3)))

DI int otid() { int t = threadIdx.x & 255; asm volatile("" : "+v"(t)); return t; }
DI int otid512() { int t = threadIdx.x; asm volatile("" : "+v"(t)); return t; }
DI float bf2f(bf16_t v) { return __uint_as_float(((u32)v) << 16); }
typedef __bf16 bf16v2 __attribute__((ext_vector_type(2)));
DI bf16_t f2bf(float f) { const __bf16 h = (__bf16)f; return __builtin_bit_cast(bf16_t, h); }
DI u32 pack2(float lo, float hi) { bf16v2 v; v[0] = (__bf16)lo; v[1] = (__bf16)hi; return __builtin_bit_cast(u32, v); }
DI float gelu_tanh(float x) {
    const float y = 0.7978845608028654f * (x + 0.044715f * x * x * x);
    const float e = __expf(2.f * y);
    const float t = 1.f - 2.f / (e + 1.f);
    return 0.5f * x * (1.f + t);
}
DI float wave_sum(float v) {
#pragma unroll
    for (int o = 1; o < 64; o <<= 1) v += __shfl_xor(v, o);
    return v;
}
DI float wave_max(float v) {
#pragma unroll
    for (int o = 1; o < 64; o <<= 1) v = fmaxf(v, __shfl_xor(v, o));
    return v;
}
DI u32 f2ord(float f) { u32 u = __float_as_uint(f); return (u & 0x80000000u) ? ~u : (u | 0x80000000u); }
DI float ord2f(u32 o) { u32 u = (o & 0x80000000u) ? (o & 0x7fffffffu) : ~o; return __uint_as_float(u); }

#define MiB ((size_t)1 << 20)
#define WS_CTL      ((size_t)0)
#define WS_W_ATTIN  (1 * MiB)
#define WS_W_ATTOUT (7 * MiB)
#define WS_W_SGUIN  (9 * MiB)
#define WS_W_SGUOUT (17 * MiB)
#define WS_W_PQ     (21 * MiB)
#define WS_W_SUBK   (29 * MiB)
#define WS_DOWN     (32 * MiB)
#define WS_UP       (64 * MiB)
#define WS_DSC      (96 * MiB)
#define WS_USC      (96 * MiB + 128 * 1024)
#define WS_LSE1     (30 * MiB)
#define WS_XQ       (100 * MiB)
#define WS_XSC      (132 * MiB)
#define WS_XN       (160 * MiB)
#define WS_BIG      (224 * MiB)
#define WS_PROJ     (WS_BIG)
#define WS_MIXED    (WS_BIG + 192 * MiB)
#define WS_Z_U      (WS_BIG)
#define WS_Z_VT     (WS_BIG + 128 * MiB)
#define WS_RIDX     (WS_BIG + 32 * MiB)
#define WS_RG       (WS_BIG + 48 * MiB)
#define WS_QBUF     (WS_BIG + 64 * MiB)
#define WS_SSQ      (WS_BIG + 256 * MiB)
#define WS_NEED     (512 * MiB)

struct Params {
    const float* in[24];
    float* out;
    unsigned char* ws;
};

#include <hip/hip_cooperative_groups.h>
namespace cg = cooperative_groups;

#define GROUP_SMEM (68 * 1024)
#define PG8_EXTRA (128 * 1024)
#define SMEM_BYTES (144 * 1024)
#define SMEM_ALLOC (SMEM_BYTES + 16)
#define NTHREADS 512

#define WSP(T, off) ((T*)(p.ws + (off)))


DI void transpose_tile(const float* __restrict__ W, bf16_t* __restrict__ Wt, int K, int N, int t, unsigned char* smem) {
    float* tile = (float*)smem;
    const int tid = otid();
    const int ntn = N / 64;
    const int n0 = (t % ntn) * 64, k0 = (t / ntn) * 64;
    __syncthreads();
    {
        const int n4 = tid & 15, kr = tid >> 4;
#pragma unroll
        for (int i = 0; i < 4; ++i) {
            const int k = kr + 16 * i;
            const float4 v = *(const float4*)(W + (size_t)(k0 + k) * N + n0 + 4 * n4);
            tile[k * 65 + 4 * n4 + 0] = v.x; tile[k * 65 + 4 * n4 + 1] = v.y; tile[k * 65 + 4 * n4 + 2] = v.z; tile[k * 65 + 4 * n4 + 3] = v.w;
        }
    }
    __syncthreads();
    {
        const int n = tid >> 2, kc = tid & 3;
        float v[16];
#pragma unroll
        for (int j = 0; j < 16; ++j) v[j] = tile[(16 * kc + j) * 65 + n];
        uint4 o0, o1;
        o0.x = pack2(v[0], v[1]); o0.y = pack2(v[2], v[3]); o0.z = pack2(v[4], v[5]); o0.w = pack2(v[6], v[7]);
        o1.x = pack2(v[8], v[9]); o1.y = pack2(v[10], v[11]); o1.z = pack2(v[12], v[13]); o1.w = pack2(v[14], v[15]);
        uint4* dst = (uint4*)(Wt + (size_t)(n0 + n) * K + k0 + 16 * kc);
        dst[0] = o0; dst[1] = o1;
    }
}
DI void cvt_chunk(const float* __restrict__ src, bf16_t* __restrict__ dst, int c) {
    const size_t base = (size_t)c * 2048;
#pragma unroll
    for (int i = 0; i < 8; ++i) {
        const size_t idx = base + i * 256 + otid();
        const float4 v = ((const float4*)src)[idx];
        uint2 o; o.x = pack2(v.x, v.y); o.y = pack2(v.z, v.w);
        ((uint2*)dst)[idx] = o;
    }
}
DI int q8(float v) { int i = __float2int_rn(v); i = i > 127 ? 127 : i; i = i < -127 ? -127 : i; return i & 255; }
template <bool EMIT_Q>
DI void rmsnorm_rows(const float* __restrict__ x, const float* __restrict__ g, bf16_t* __restrict__ o, int vb, signed char* xq = nullptr, float* xsc = nullptr) {
    const int lane = otid() & 63;
    const int row = vb * 4 + (otid() >> 6);
    const float4* xr = (const float4*)(x + (size_t)row * DM);
    float4 v[4]; float ss = 0.f;
#pragma unroll
    for (int j = 0; j < 4; ++j) { v[j] = xr[lane + 64 * j]; ss += v[j].x * v[j].x + v[j].y * v[j].y + v[j].z * v[j].z + v[j].w * v[j].w; }
    ss = wave_sum(ss);
    const float rinv = rsqrtf(ss * (1.f / DM) + EPSN);
    uint2* orow = (uint2*)(o + (size_t)row * DM);
    float am = 0.f;
#pragma unroll
    for (int j = 0; j < 4; ++j) {
        const float4 gg = ((const float4*)g)[lane + 64 * j];
        v[j].x *= rinv * gg.x; v[j].y *= rinv * gg.y; v[j].z *= rinv * gg.z; v[j].w *= rinv * gg.w;
        uint2 w; w.x = pack2(v[j].x, v[j].y); w.y = pack2(v[j].z, v[j].w);
        orow[lane + 64 * j] = w;
        if (EMIT_Q) am = fmaxf(am, fmaxf(fmaxf(fabsf(v[j].x), fabsf(v[j].y)), fmaxf(fabsf(v[j].z), fabsf(v[j].w))));
    }
    if (EMIT_Q) {
        am = wave_max(am);
        const float sc = am > 0.f ? 127.f / am : 0.f;
        u32* qrow = (u32*)(xq + (size_t)row * DM);
#pragma unroll
        for (int j = 0; j < 4; ++j)
            qrow[lane + 64 * j] = (u32)q8(v[j].x * sc) | ((u32)q8(v[j].y * sc) << 8) | ((u32)q8(v[j].z * sc) << 16) | ((u32)q8(v[j].w * sc) << 24);
        if (lane == 0) xsc[row] = am * (1.f / 127.f);
    }
}
#define PREP_T0 (48 * 16)
#define PREP_T1 (PREP_T0 + 16 * 16)
#define PREP_T2 (PREP_T1 + 64 * 16)
#define PREP_T3 (PREP_T2 + 16 * 32)
#define PREP_T4 (PREP_T3 + 2 * 32 * 16)
#define PREP_C0 (PREP_T4 + 64)
#define PREP_C1 (PREP_C0 + 8192)
#define PREP_C2 (PREP_C1 + 8192)
#define PREP_N  (PREP_C2 + 8192)
template <bool INT8>
DI void fp8_rows(const float* __restrict__ src, unsigned char* __restrict__ dst, float* __restrict__ inv_scale, int vb) {
    const int lane = otid() & 63;
    const int row = vb * 4 + (otid() >> 6);
    const float4* sr = (const float4*)(src + (size_t)row * DM) + lane;
    float4 v[4]; float am = 0.f;
#pragma unroll
    for (int j = 0; j < 4; ++j) { v[j] = sr[64 * j]; am = fmaxf(am, fmaxf(fmaxf(fabsf(v[j].x), fabsf(v[j].y)), fmaxf(fabsf(v[j].z), fabsf(v[j].w)))); }
    am = wave_max(am);
    float sc, inv;
    if (INT8) { sc = am > 0.f ? 127.f / am : 0.f; inv = am * (1.f / 127.f); }
    else {
        int e = (int)((__float_as_uint(am) >> 23) & 255u) - 127;
        if (am == 0.f) e = 0;
        e = e < -100 ? -100 : e;
        sc = __uint_as_float((u32)(127 + 7 - e) << 23); inv = __uint_as_float((u32)(127 + e - 7) << 23);
    }
    unsigned char* drow = dst + (size_t)(row >> 14) * NEXP * DM + (size_t)(row & (NEXP - 1)) * 128;
#pragma unroll
    for (int j = 0; j < 4; ++j) {
        const int dim = 4 * (lane + 64 * j);
        u32 w;
        if (INT8) w = (u32)q8(v[j].x * sc) | ((u32)q8(v[j].y * sc) << 8) | ((u32)q8(v[j].z * sc) << 16) | ((u32)q8(v[j].w * sc) << 24);
        else { int t = __builtin_amdgcn_cvt_pk_fp8_f32(v[j].x * sc, v[j].y * sc, 0, false); t = __builtin_amdgcn_cvt_pk_fp8_f32(v[j].z * sc, v[j].w * sc, t, true); w = (u32)t; }
        *(u32*)(drow + (size_t)(dim >> 7) * NEXP * 128 + (dim & 127)) = w;
    }
    if (lane == 0) inv_scale[row] = inv;
}
DI void ph_prep(const Params& p, int vb, unsigned char* smem) {
    if (vb < PREP_T0) transpose_tile(p.in[2], WSP(bf16_t, WS_W_ATTIN), DM, ATT_IN, vb, smem);
    else if (vb < PREP_T1) transpose_tile(p.in[12], WSP(bf16_t, WS_W_ATTOUT), DM, DM, vb - PREP_T0, smem);
    else if (vb < PREP_T2) transpose_tile(p.in[14], WSP(bf16_t, WS_W_SGUIN), DM, 4096, vb - PREP_T1, smem);
    else if (vb < PREP_T3) transpose_tile(p.in[18], WSP(bf16_t, WS_W_SGUOUT), CW, DM, vb - PREP_T2, smem);
    else if (vb < PREP_T4) { const int t = vb - PREP_T3, l = t / 512; transpose_tile(p.in[20] + (size_t)l * DM * 2048, WSP(bf16_t, WS_W_PQ) + (size_t)l * 2048 * DM, DM, 2048, t % 512, smem); }
    else if (vb < PREP_C0) cvt_chunk(p.in[21], WSP(bf16_t, WS_W_SUBK), vb - PREP_T4);
    else if (vb < PREP_C1) fp8_rows<true>(p.in[22], p.ws + WS_DOWN, WSP(float, WS_DSC), vb - PREP_C0);
    else if (vb < PREP_C2) fp8_rows<false>(p.in[23], p.ws + WS_UP, WSP(float, WS_USC), vb - PREP_C1);
    else rmsnorm_rows<false>(p.in[0], p.in[1], WSP(bf16_t, WS_XN), vb - PREP_C2);
}

DI float compute_lam(const Params& p, int lane) {
    const float a = wave_sum(p.in[7][lane] * p.in[8][lane]);
    const float b = wave_sum(p.in[9][lane] * p.in[10][lane]);
    return __expf(a) - __expf(b) + 0.2f;
}
DI void ce_desc(u32& a, u32& b) { const u32 hi = max(a, b), lo = min(a, b); a = hi; b = lo; }
DI void sort16_desc(u32 (&v)[16]) {
#pragma unroll
    for (int k = 2; k <= 16; k <<= 1)
#pragma unroll
        for (int j = k >> 1; j > 0; j >>= 1)
#pragma unroll
            for (int i = 0; i < 16; ++i) {
                const int l = i ^ j;
                if (l > i) { if ((i & k) == 0) ce_desc(v[i], v[l]); else ce_desc(v[l], v[i]); }
            }
}
DI void merge16_desc(u32 (&a)[16], const u32 (&b)[16]) {
#pragma unroll
    for (int i = 0; i < 16; ++i) a[i] = max(a[i], b[15 - i]);
#pragma unroll
    for (int j = 8; j > 0; j >>= 1)
#pragma unroll
        for (int i = 0; i < 16; ++i) { const int l = i ^ j; if (l > i) ce_desc(a[i], a[l]); }
}
DI void top16_insert(u32 (&lst)[16], u32 x) {
#pragma unroll
    for (int j = 0; j < 16; ++j) { const u32 hi = max(lst[j], x); x = min(lst[j], x); lst[j] = hi; }
}
DI void unpack8(const uint4 v, float (&f)[8]) {
    f[0] = __uint_as_float(v.x << 16); f[1] = __uint_as_float(v.x & 0xffff0000u);
    f[2] = __uint_as_float(v.y << 16); f[3] = __uint_as_float(v.y & 0xffff0000u);
    f[4] = __uint_as_float(v.z << 16); f[5] = __uint_as_float(v.z & 0xffff0000u);
    f[6] = __uint_as_float(v.w << 16); f[7] = __uint_as_float(v.w & 0xffff0000u);
}
typedef float f32x2_t __attribute__((ext_vector_type(2)));
DI void unpack16fp8(const uint4 w, float (&f)[16]) {
    f32x2_t t;
    t = __builtin_amdgcn_cvt_pk_f32_fp8((int)w.x, false); f[0] = t[0]; f[1] = t[1];
    t = __builtin_amdgcn_cvt_pk_f32_fp8((int)w.x, true);  f[2] = t[0]; f[3] = t[1];
    t = __builtin_amdgcn_cvt_pk_f32_fp8((int)w.y, false); f[4] = t[0]; f[5] = t[1];
    t = __builtin_amdgcn_cvt_pk_f32_fp8((int)w.y, true);  f[6] = t[0]; f[7] = t[1];
    t = __builtin_amdgcn_cvt_pk_f32_fp8((int)w.z, false); f[8] = t[0]; f[9] = t[1];
    t = __builtin_amdgcn_cvt_pk_f32_fp8((int)w.z, true);  f[10] = t[0]; f[11] = t[1];
    t = __builtin_amdgcn_cvt_pk_f32_fp8((int)w.w, false); f[12] = t[0]; f[13] = t[1];
    t = __builtin_amdgcn_cvt_pk_f32_fp8((int)w.w, true);  f[14] = t[0]; f[15] = t[1];
}
struct PeerPre { int e[16]; uint4 xa, xb; float2 r; };
struct PeerRows { uint4 d[8]; float c[8]; };
template <bool UP>
DI PeerPre peer_prefetch(const Params& p, int tok, int sl, int lane) {
    PeerPre q;
    const int4* rix = (const int4*)(WSP(int, WS_RIDX) + (size_t)tok * 128 + 16 * (lane >> 3));
#pragma unroll
    for (int j = 0; j < 4; ++j) { const int4 t = rix[j]; q.e[4 * j] = t.x; q.e[4 * j + 1] = t.y; q.e[4 * j + 2] = t.z; q.e[4 * j + 3] = t.w; }
    if (UP) {
        q.r = *(const float2*)(p.out + (size_t)tok * DM + sl * 128 + 16 * (lane & 7) + 2 * (lane >> 3));
    } else {
        q.xa = *(const uint4*)(WSP(signed char, WS_XQ) + (size_t)tok * DM + sl * 128 + 16 * (lane & 7));
    }
    return q;
}
template <int HF, bool UP>
DI void peer_issue_rows(const Params& p, const unsigned char* tab, const PeerPre& q, int tok, int lane, PeerRows& R) {
    const unsigned dco = 16u * (unsigned)(lane & 7);
#pragma unroll
    for (int bi = 0; bi < 8; ++bi) R.d[bi] = *(const uint4*)(tab + ((unsigned)q.e[8 * HF + bi] * 128u + dco));
    if (UP) {
        const float4* cf = (const float4*)(WSP(float, WS_RG) + (size_t)tok * 128 + 16 * (lane >> 3) + 8 * HF);
        const float4 c0 = cf[0], c1 = cf[1];
        R.c[0] = c0.x; R.c[1] = c0.y; R.c[2] = c0.z; R.c[3] = c0.w; R.c[4] = c1.x; R.c[5] = c1.y; R.c[6] = c1.z; R.c[7] = c1.w;
    }
}
template <int HF>
DI void peer_down_half(const PeerPre& q, const PeerRows& R, float (&part)[16]) {
#pragma unroll
    for (int bi = 0; bi < 8; ++bi) {
        int a = __builtin_amdgcn_sdot4((int)R.d[bi].x, (int)q.xa.x, 0, false);
        a = __builtin_amdgcn_sdot4((int)R.d[bi].y, (int)q.xa.y, a, false);
        a = __builtin_amdgcn_sdot4((int)R.d[bi].z, (int)q.xa.z, a, false);
        a = __builtin_amdgcn_sdot4((int)R.d[bi].w, (int)q.xa.w, a, false);
        part[8 * HF + bi] = (float)a;
    }
}
DI void peer_down_fin(const Params& p, const float (&part)[16], int tok, int sl, int lane) {
    const bool b2 = lane & 4, b1 = lane & 2, b0 = lane & 1;
    float r8[8], r4[4], r2[2];
#pragma unroll
    for (int i = 0; i < 8; ++i) { const float snd = b2 ? part[i] : part[i + 8]; const float kp = b2 ? part[i + 8] : part[i]; r8[i] = kp + __shfl_xor(snd, 4); }
#pragma unroll
    for (int i = 0; i < 4; ++i) { const float snd = b1 ? r8[i] : r8[i + 4]; const float kp = b1 ? r8[i + 4] : r8[i]; r4[i] = kp + __shfl_xor(snd, 2); }
#pragma unroll
    for (int i = 0; i < 2; ++i) { const float snd = b0 ? r4[i] : r4[i + 2]; const float kp = b0 ? r4[i + 2] : r4[i]; r2[i] = kp + __shfl_xor(snd, 1); }
    u32* pd = WSP(u32, WS_QBUF) + ((size_t)tok * 8 + sl) * 64;
    pd[lane] = pack2(r2[0], r2[1]);
}
DI void ph_peer_comb(const Params& p, int vb, int l) {
    const int tid = otid(), lane = tid & 63;
    const int tok = vb * 4 + (tid >> 6);
    const u32* pd = WSP(u32, WS_QBUF) + (size_t)tok * 8 * 64;
    const int* rix = WSP(int, WS_RIDX) + (size_t)tok * 128;
    float* rgp = WSP(float, WS_RG) + (size_t)tok * 128;
    const float* dsc = WSP(float, WS_DSC) + (size_t)l * NEXP;
    const float* usc = WSP(float, WS_USC) + (size_t)l * NEXP;
    const float xs = WSP(float, WS_XSC)[tok];
    float t0 = 0.f, t1 = 0.f;
#pragma unroll
    for (int sl = 0; sl < 8; ++sl) { const u32 w = pd[sl * 64 + lane]; t0 += __uint_as_float(w << 16); t1 += __uint_as_float(w & 0xffff0000u); }
    const int2 e = *(const int2*)(rix + 2 * lane);
    float2 g = *(const float2*)(rgp + 2 * lane);
    g.x = g.x * gelu_tanh(t0 * dsc[e.x] * xs) * usc[e.x];
    g.y = g.y * gelu_tanh(t1 * dsc[e.y] * xs) * usc[e.y];
    *(float2*)(rgp + 2 * lane) = g;
}
template <int HF>
DI void peer_up_half(const PeerPre& q, const PeerRows& R, float (&y)[16]) {
#pragma unroll
    for (int bi = 0; bi < 8; ++bi) {
        const float c = R.c[bi];
        float w[16]; unpack16fp8(R.d[bi], w);
#pragma unroll
        for (int i = 0; i < 16; ++i) y[i] += c * w[i];
        asm volatile("" : "+v"(y[0]), "+v"(y[1]), "+v"(y[2]), "+v"(y[3]), "+v"(y[4]), "+v"(y[5]), "+v"(y[6]), "+v"(y[7]), "+v"(y[8]), "+v"(y[9]), "+v"(y[10]), "+v"(y[11]), "+v"(y[12]), "+v"(y[13]), "+v"(y[14]), "+v"(y[15]));
    }
}
DI void peer_up_fin(const Params& p, const PeerPre& q, const float (&y)[16], int tok, int sl, int lane) {
    const int rg = lane >> 3, dc = lane & 7;
    const bool b5 = lane & 32, b4 = lane & 16, b3 = lane & 8;
    float r8[8], r4[4], r2[2];
#pragma unroll
    for (int i = 0; i < 8; ++i) { const float snd = b5 ? y[i] : y[i + 8]; const float kp = b5 ? y[i + 8] : y[i]; r8[i] = kp + __shfl_xor(snd, 32); }
#pragma unroll
    for (int i = 0; i < 4; ++i) { const float snd = b4 ? r8[i] : r8[i + 4]; const float kp = b4 ? r8[i + 4] : r8[i]; r4[i] = kp + __shfl_xor(snd, 16); }
#pragma unroll
    for (int i = 0; i < 2; ++i) { const float snd = b3 ? r4[i] : r4[i + 2]; const float kp = b3 ? r4[i + 2] : r4[i]; r2[i] = kp + __shfl_xor(snd, 8); }
    float2 v = q.r;
    v.x += r2[0]; v.y += r2[1];
    *(float2*)(p.out + (size_t)tok * DM + sl * 128 + 16 * dc + 2 * rg) = v;
}
template <bool UP>
DI void run_peer_sliced(const Params& p, int l, unsigned char* smem) {
    volatile LAS unsigned* st = (volatile LAS unsigned*)(smem + SMEM_BYTES);
    const int nloc = (int)st[0], nx = (int)st[1], rank = (int)st[2], xi = (int)st[3];
    const int tid = otid512(), lane = tid & 63, wave = tid >> 6;
    const int stride = nloc * 8;
#pragma unroll 1
    for (int sl = xi; sl < 8; sl += nx) {
        const unsigned char* tab = p.ws + (UP ? WS_UP : WS_DOWN) + (size_t)l * NEXP * DM + (size_t)sl * NEXP * 128;
        int tok = rank * 8 + wave;
        if (tok >= NTOK) continue;
        PeerPre qc = peer_prefetch<UP>(p, tok, sl, lane);
        PeerRows R;
        peer_issue_rows<0, UP>(p, tab, qc, tok, lane, R);
#pragma unroll 1
        for (; tok < NTOK; tok += stride) {
            const int tn = tok + stride < NTOK ? tok + stride : tok;
            const PeerPre qn = peer_prefetch<UP>(p, tn, sl, lane);
            float acc[16];
#pragma unroll
            for (int i = 0; i < 16; ++i) acc[i] = 0.f;
            PeerRows Rn;
            peer_issue_rows<1, UP>(p, tab, qc, tok, lane, Rn);
            __builtin_amdgcn_sched_barrier(0);
            if (UP) peer_up_half<0>(qc, R, acc); else peer_down_half<0>(qc, R, acc);
            __builtin_amdgcn_sched_barrier(0);
            peer_issue_rows<0, UP>(p, tab, qn, tn, lane, R);
            __builtin_amdgcn_sched_barrier(0);
            if (UP) { peer_up_half<1>(qc, Rn, acc); peer_up_fin(p, qc, acc, tok, sl, lane); }
            else { peer_down_half<1>(qc, Rn, acc); peer_down_fin(p, acc, tok, sl, lane); }
            __builtin_amdgcn_sched_barrier(0);
            qc = qn;
        }
    }
}


typedef short bf16x8 __attribute__((ext_vector_type(8)));
typedef float f32x16 __attribute__((ext_vector_type(16)));
#define MFMA32(a, b, c) __builtin_amdgcn_mfma_f32_32x32x16_bf16((a), (b), (c), 0, 0, 0)
typedef short s16x4 __attribute__((ext_vector_type(4)));
DI bf16x8 pack_p(const f32x16& pt, int s) {
    uint4 o;
    o.x = pack2(pt[8 * s + 0], pt[8 * s + 1]); o.y = pack2(pt[8 * s + 2], pt[8 * s + 3]);
    o.z = pack2(pt[8 * s + 4], pt[8 * s + 5]); o.w = pack2(pt[8 * s + 6], pt[8 * s + 7]);
    return __builtin_bit_cast(bf16x8, o);
}

DI void stage_tile(const bf16_t* __restrict__ g, int ld, int row0, int k0, unsigned char* lt, int wave, int lane) {
#pragma unroll
    for (int i = 0; i < 4; ++i) {
        const int inst = wave * 4 + i;
        const int row = inst * 8 + (lane >> 3);
        const int c = (lane & 7) ^ ((row >> 1) & 7);
        __builtin_amdgcn_global_load_lds((const unsigned*)(g + (size_t)(row0 + row) * ld + k0 + c * 8),
                                         (unsigned*)(lt + inst * 1024 + lane * 16), 16, 0, 0);
    }
}
DI bf16x8 lds_frag(const unsigned char* lt, int row, int c) {
    return *(const bf16x8*)(lt + row * 128 + ((c ^ ((row >> 1) & 7)) << 4));
}
DI int crow(int r, int fh) { return (r & 3) + 8 * (r >> 2) + 4 * fh; }

namespace pg8 {
#define PG8_LAS __attribute__((address_space(3)))
typedef float f32x4 __attribute__((ext_vector_type(4)));
typedef unsigned u32x4 __attribute__((ext_vector_type(4)));
constexpr int BM = 256, BK = 64, HALF = 128, HTB = HALF * BK * 2  , STAGE_BYTES = 8 * HTB;
__host__ __device__ __forceinline__ int lds_byte(int r, int c) { const int st = (r >> 4) * 2 + (c >> 5), rr = r & 15, cc = c & 31, ob = rr * 64 + cc * 2; return st * 1024 + (ob ^ (((ob >> 9) & 1) << 5)); }
__host__ __device__ __forceinline__ void stage_rc(int b, int& R, int& C) { const int st = b / 1024, sb = b % 1024, swz = sb ^ (((sb >> 9) & 1) << 5); R = (st >> 1) * 16 + swz / 64; C = (st & 1) * 32 + (swz % 64) / 2; }
__host__ __device__ __forceinline__ int perm32(int rho) { const int n = rho >> 4, i = rho & 15; return 8 * (i >> 2) + 4 * n + (i & 3); }
struct Unit { int pm, pn; };
struct Gemm { const bf16_t* A; const bf16_t* Bt; int M, N, K; };
struct XcdOrder {
    int ntn, nloc, nx, rank, xi, nown, total;
    __device__ __forceinline__ void init(int nmt, int ntn_, int nloc_, int nx_, int rank_, int xi_) {
        ntn = ntn_; nloc = nloc_; nx = nx_; rank = rank_; xi = xi_; nown = xi < nmt ? (nmt - xi + nx - 1) / nx : 0; total = nown * ntn; }
    __device__ __forceinline__ bool next(int i, Unit& u) const {
        const int t = rank + i * nloc; if (t >= total) return false;
        const int g4 = t / (4 * ntn), r = t - g4 * 4 * ntn;
        const int left = nown - 4 * g4, gs = left < 4 ? left : 4;
        const int nt = r / gs, mi = r - nt * gs;
        u.pm = (4 * g4 + mi) * nx + xi; u.pn = nt; return true;
    }
    __device__ __forceinline__ void a_ready(const Unit&) const {}
    __device__ __forceinline__ void done(const Unit&) const {}
};
template <class Epi, class Sched, bool ALIGN_EPI = false, bool SP2 = false>
__device__ __forceinline__ void gemm_phase(PG8_LAS unsigned char* lds, const Gemm g, const Sched& S, const Epi& E) {
    const int tid = otid512(), wid = __builtin_amdgcn_readfirstlane(tid >> 6), lane = tid & 63, wr = wid >> 2, wc = wid & 3, fr = lane & 15, fq = lane >> 4;
    const int K = g.K, nt = K / BK;
    unsigned voffA[2], voffB[2];
#pragma unroll
    for (int i = 0; i < 2; ++i) { int R, C; stage_rc(tid * 16 + i * 8192, R, C); const int Rb = Epi::PERM ? ((R & ~31) + perm32(R & 31)) : R;
        voffA[i] = (unsigned)(R * K + C) * 2u; voffB[i] = (unsigned)(Rb * K + C) * 2u; }
    const size_t kstep = (size_t)(BK * 2);
    const size_t hstep = (size_t)HALF * K * 2;
    const size_t tstep = 2 * hstep;
    const unsigned ldsw = (unsigned)wid * 1024u;
    const int aoff = lds_byte(wr * 64 + fr, fq * 8), boff = lds_byte(wc * 32 + fr, fq * 8);
#define PG8_SA(b, h) (((b) * 2 + (h)) * HTB)
#define PG8_SB(b, h) ((4 + (b) * 2 + (h)) * HTB)
#define PG8_STAGE(bufoff, gbase, voff) do { _Pragma("unroll") for (int _i = 0; _i < 2; ++_i) \
        __builtin_amdgcn_global_load_lds((const unsigned*)((const char*)(gbase) + (voff)[_i]), (PG8_LAS unsigned*)(lds + (bufoff) + ldsw + _i * 8192), 16, 0, 0); } while (0)
#define PG8_LDA(dst, b, h) do { _Pragma("unroll") for (int m = 0; m < 4; ++m) _Pragma("unroll") for (int k = 0; k < 2; ++k) dst[m][k] = *(const PG8_LAS bf16x8*)(lds + PG8_SA(b, h) + aoff + m * 2048 + k * 1024); } while (0)
#define PG8_LDB(dst, b, h) do { _Pragma("unroll") for (int n = 0; n < 2; ++n) _Pragma("unroll") for (int k = 0; k < 2; ++k) dst[n][k] = *(const PG8_LAS bf16x8*)(lds + PG8_SB(b, h) + boff + n * 2048 + k * 1024); } while (0)
#define PG8_MMA(ai, bj, At, Bt) do { __builtin_amdgcn_s_setprio(1); _Pragma("unroll") for (int m = 0; m < 4; ++m) _Pragma("unroll") for (int n = 0; n < 2; ++n) _Pragma("unroll") for (int k = 0; k < 2; ++k) \
        acc[ai][bj][m][n] = __builtin_amdgcn_mfma_f32_16x16x32_bf16(Bt[n][k], At[m][k], acc[ai][bj][m][n], 0, 0, 0); __builtin_amdgcn_s_setprio(0); } while (0)
#define PG8_WAIT_V(n) asm volatile("s_waitcnt vmcnt(" #n ")" ::: "memory")
#define PG8_WAIT_L(n) asm volatile("s_waitcnt lgkmcnt(" #n ")" ::: "memory")
#define PG8_BAR __builtin_amdgcn_s_barrier()
#define PG8_SCHED __builtin_amdgcn_sched_barrier(0)
    Unit cur, nxt; int ui = 0;
    if (!S.next(0, cur)) return;
    f32x4 acc[2][2][4][2];
#pragma unroll
    for (int a = 0; a < 2; ++a)
#pragma unroll
        for (int b = 0; b < 2; ++b)
#pragma unroll
            for (int m = 0; m < 4; ++m)
#pragma unroll
                for (int n = 0; n < 2; ++n) acc[a][b][m][n] = (f32x4){0.f, 0.f, 0.f, 0.f};
    bf16x8 At[4][2], B0[2][2], B1[2][2];
    const char* cA = (const char*)g.A + (size_t)cur.pm * tstep; const char* cB = (const char*)g.Bt + (size_t)cur.pn * tstep;
    S.a_ready(cur);
    if constexpr (SP2) {
        PG8_STAGE(PG8_SB(0, 0), cB, voffB); PG8_STAGE(PG8_SB(0, 1), cB + hstep, voffB); PG8_STAGE(PG8_SA(0, 0), cA, voffA); PG8_STAGE(PG8_SA(0, 1), cA + hstep, voffA);
        if (wr == 1) PG8_BAR;
        PG8_WAIT_V(2); PG8_BAR;
        PG8_STAGE(PG8_SB(1, 0), cB + kstep, voffB); PG8_STAGE(PG8_SA(1, 0), cA + kstep, voffA); PG8_STAGE(PG8_SB(1, 1), cB + hstep + kstep, voffB);
        PG8_WAIT_V(6); PG8_BAR;
    } else {
        PG8_STAGE(PG8_SB(0, 0), cB, voffB); PG8_STAGE(PG8_SA(0, 0), cA, voffA); PG8_STAGE(PG8_SB(0, 1), cB + hstep, voffB); PG8_STAGE(PG8_SA(0, 1), cA + hstep, voffA);
        if (wr == 1) PG8_BAR;
        PG8_WAIT_V(4); PG8_BAR;
        PG8_STAGE(PG8_SB(1, 0), cB + kstep, voffB); PG8_STAGE(PG8_SA(1, 0), cA + kstep, voffA); PG8_STAGE(PG8_SB(1, 1), cB + hstep + kstep, voffB);
        PG8_WAIT_V(6); PG8_BAR;
    }
    for (;;) {
        const bool has_next = S.next(ui + 1, nxt);
        const char* nA = has_next ? (const char*)g.A + (size_t)nxt.pm * tstep : cA; const char* nB = has_next ? (const char*)g.Bt + (size_t)nxt.pn * tstep : cB;
        for (int t = 0; t < nt; t += 2) {
            const bool last = (t == nt - 2);
            const char* a1 = cA + (size_t)(t + 1) * kstep;
            const char* a2 = last ? nA : cA + (size_t)(t + 2) * kstep; const char* b2 = last ? nB : cB + (size_t)(t + 2) * kstep;
            const char* a3 = a2 + kstep; const char* b3 = b2 + kstep;
            if (last && has_next) S.a_ready(nxt);
            if constexpr (SP2) {
            PG8_LDB(B0, 0, 0); PG8_LDB(B1, 0, 1); PG8_SCHED; PG8_LDA(At, 0, 0); PG8_STAGE(PG8_SA(1, 1), a1 + hstep, voffA);
            PG8_WAIT_V(8); PG8_WAIT_L(0); PG8_BAR; PG8_MMA(0, 0, At, B0); PG8_MMA(0, 1, At, B1); PG8_BAR; PG8_SCHED;
            PG8_LDA(At, 0, 1); PG8_STAGE(PG8_SB(0, 0), b2, voffB); PG8_STAGE(PG8_SB(0, 1), b2 + hstep, voffB); PG8_STAGE(PG8_SA(0, 0), a2, voffA);
            PG8_WAIT_V(8); PG8_WAIT_L(0); PG8_BAR; PG8_MMA(1, 0, At, B0); PG8_MMA(1, 1, At, B1); PG8_BAR; PG8_SCHED;
            PG8_LDB(B0, 1, 0); PG8_LDB(B1, 1, 1); PG8_SCHED; PG8_LDA(At, 1, 0); PG8_STAGE(PG8_SA(0, 1), a2 + hstep, voffA);
            PG8_WAIT_V(8); PG8_WAIT_L(0); PG8_BAR; PG8_MMA(0, 0, At, B0); PG8_MMA(0, 1, At, B1); PG8_BAR; PG8_SCHED;
            PG8_LDA(At, 1, 1); PG8_STAGE(PG8_SB(1, 0), b3, voffB); PG8_STAGE(PG8_SB(1, 1), b3 + hstep, voffB); PG8_STAGE(PG8_SA(1, 0), a3, voffA);
            PG8_WAIT_V(8); PG8_WAIT_L(0); PG8_BAR; PG8_MMA(1, 0, At, B0); PG8_MMA(1, 1, At, B1); PG8_BAR; PG8_SCHED;
            } else {
            PG8_LDB(B0, 0, 0); PG8_SCHED; PG8_LDA(At, 0, 0); PG8_STAGE(PG8_SA(1, 1), a1 + hstep, voffA);
            PG8_WAIT_L(8); PG8_BAR; PG8_WAIT_L(0); PG8_MMA(0, 0, At, B0); PG8_BAR; PG8_SCHED;
            PG8_LDB(B1, 0, 1); PG8_STAGE(PG8_SB(0, 0), b2, voffB);
            PG8_BAR; PG8_WAIT_L(0); PG8_MMA(0, 1, At, B1); PG8_BAR;
            PG8_LDA(At, 0, 1); PG8_STAGE(PG8_SA(0, 0), a2, voffA);
            PG8_BAR; PG8_WAIT_L(0); PG8_MMA(1, 0, At, B0); PG8_BAR; PG8_SCHED;
            PG8_STAGE(PG8_SB(0, 1), b2 + hstep, voffB);
            PG8_WAIT_V(6); PG8_BAR; PG8_MMA(1, 1, At, B1); PG8_BAR;
            PG8_LDB(B0, 1, 0); PG8_SCHED; PG8_LDA(At, 1, 0); PG8_STAGE(PG8_SA(0, 1), a2 + hstep, voffA);
            PG8_WAIT_L(8); PG8_BAR; PG8_WAIT_L(0); PG8_MMA(0, 0, At, B0); PG8_BAR; PG8_SCHED;
            PG8_LDB(B1, 1, 1); PG8_STAGE(PG8_SB(1, 0), b3, voffB);
            PG8_BAR; PG8_WAIT_L(0); PG8_MMA(0, 1, At, B1); PG8_BAR;
            PG8_LDA(At, 1, 1); PG8_STAGE(PG8_SA(1, 0), a3, voffA);
            PG8_BAR; PG8_WAIT_L(0); PG8_MMA(1, 0, At, B0); PG8_BAR; PG8_SCHED;
            PG8_STAGE(PG8_SB(1, 1), b3 + hstep, voffB);
            PG8_WAIT_V(6); PG8_BAR; PG8_MMA(1, 1, At, B1); PG8_BAR;
            }
        }
        if constexpr (ALIGN_EPI) { if (wr == 0) PG8_BAR; }
        if constexpr (!Epi::AFTER_DRAIN) { E(acc, cur, wr, wc, fr, fq); S.done(cur); }
        if (!has_next) break;
#pragma unroll
        for (int a = 0; a < 2; ++a)
#pragma unroll
            for (int b = 0; b < 2; ++b)
#pragma unroll
                for (int m = 0; m < 4; ++m)
#pragma unroll
                    for (int n = 0; n < 2; ++n) acc[a][b][m][n] = (f32x4){0.f, 0.f, 0.f, 0.f};
        cur = nxt; cA = nA; cB = nB; ++ui;
        if constexpr (ALIGN_EPI) { if (wr == 1) PG8_BAR; }
    }
    PG8_WAIT_V(0);
    if constexpr (!ALIGN_EPI) { if (wr == 0) PG8_BAR; }
    PG8_BAR;
    if constexpr (Epi::AFTER_DRAIN) { E.fused(acc, cur, wr, wc, fr, fq, lds, wid, lane); S.done(cur); }
#undef PG8_SA
#undef PG8_SB
#undef PG8_STAGE
#undef PG8_LDA
#undef PG8_LDB
#undef PG8_MMA
#undef PG8_WAIT_V
#undef PG8_WAIT_L
#undef PG8_BAR
#undef PG8_SCHED
}
struct EpiResid {
    static constexpr bool PERM = true, AFTER_DRAIN = false;
    const float* resid; float* out;
    __device__ __forceinline__ void operator()(const f32x4 (&acc)[2][2][4][2], const Unit& u, int wr, int wc, int fr, int fq) const {
        const size_t base = (size_t)(u.pm * BM + wr * 64 + fr) * DM + u.pn * BM + wc * 32 + 8 * fq;
#pragma unroll
        for (int ai = 0; ai < 2; ++ai) {
            f32x4 rv[4][2][2];
#pragma unroll
            for (int m = 0; m < 4; ++m)
#pragma unroll
                for (int bj = 0; bj < 2; ++bj) {
                    const float* rp = resid + base + (size_t)(ai * HALF + m * 16) * DM + bj * HALF;
                    rv[m][bj][0] = *(const f32x4*)rp; rv[m][bj][1] = *(const f32x4*)(rp + 4);
                }
            asm volatile("" ::: "memory");
#pragma unroll
            for (int m = 0; m < 4; ++m)
#pragma unroll
                for (int bj = 0; bj < 2; ++bj) {
                    float* op = out + base + (size_t)(ai * HALF + m * 16) * DM + bj * HALF;
                    *(f32x4*)op = rv[m][bj][0] + acc[ai][bj][m][0]; *(f32x4*)(op + 4) = rv[m][bj][1] + acc[ai][bj][m][1];
                }
            asm volatile("" ::: "memory");
        }
    }
};
struct EpiProj {
    static constexpr bool PERM = true, AFTER_DRAIN = false;
    const float* aq; const float* ak; const float* bq; const float* bk; bf16_t* proj; PG8_LAS float* xs;
    __device__ __forceinline__ void operator()(const f32x4 (&acc)[2][2][4][2], const Unit& u, int wr, int wc, int fr, int fq) const {
        const int wave = wr * 4 + wc;
#pragma unroll
        for (int ai = 0; ai < 2; ++ai)
#pragma unroll
            for (int m = 0; m < 4; ++m)
#pragma unroll
                for (int bj = 0; bj < 2; ++bj) {
                    const f32x4 a = acc[ai][bj][m][0], b = acc[ai][bj][m][1];
                    float t = a[0] * a[0] + a[1] * a[1] + a[2] * a[2] + a[3] * a[3] + b[0] * b[0] + b[1] * b[1] + b[2] * b[2] + b[3] * b[3];
                    t += __shfl_xor(t, 16); t += __shfl_xor(t, 32);
                    if (fq == 0) xs[wave * 256 + ((ai * 4 + m) * 2 + bj) * 16 + fr] = t;
                }
        asm volatile("s_waitcnt lgkmcnt(0)" ::: "memory");
        __builtin_amdgcn_s_barrier();
#pragma unroll
        for (int bj = 0; bj < 2; ++bj) {
            const int gcol = u.pn * BM + bj * HALF + wc * 32 + 8 * fq;
            const float* gain = nullptr; float scale = 1.f;
            if (gcol < 512) { gain = aq + (gcol & 63); scale = 0.125f; }
            else if (gcol < 1024) gain = ak + (gcol & 63);
            else if (gcol < 1536) gain = nullptr;
            else if (gcol < 2048) { gain = bq + (gcol & 127); scale = 0.125f; }
            else if (gcol < 2560) gain = bk + (gcol & 127);
            f32x4 g0 = {1.f, 1.f, 1.f, 1.f}, g1 = {1.f, 1.f, 1.f, 1.f};
            if (gain) { g0 = *(const f32x4*)gain; g1 = *(const f32x4*)(gain + 4); }
#pragma unroll
            for (int ai = 0; ai < 2; ++ai)
#pragma unroll
                for (int m = 0; m < 4; ++m) {
                    float sc = 1.f;
                    if (gain) {
                        const int slot = ((ai * 4 + m) * 2 + bj) * 16 + fr;
                        sc = rsqrtf((xs[wave * 256 + slot] + xs[(wave ^ 1) * 256 + slot]) * (1.f / 64.f) + EPSN) * scale;
                    }
                    const f32x4 v0 = acc[ai][bj][m][0] * g0 * sc, v1 = acc[ai][bj][m][1] * g1 * sc;
                    u32x4 w; w.x = pack2(v0[0], v0[1]); w.y = pack2(v0[2], v0[3]); w.z = pack2(v1[0], v1[1]); w.w = pack2(v1[2], v1[3]);
                    *(u32x4*)(proj + (size_t)(u.pm * BM + ai * HALF + wr * 64 + m * 16 + fr) * ATT_IN + gcol) = w;
                }
        }
    }
};
struct EpiSgu {
    static constexpr bool PERM = true, AFTER_DRAIN = false;
    bf16_t* zu; bf16_t* zvt; float* ssq; PG8_LAS unsigned char* stg;
    __device__ __forceinline__ void operator()(const f32x4 (&acc)[2][2][4][2], const Unit& u, int wr, int wc, int fr, int fq) const {
        const int wave = wr * 4 + wc, lane = fq * 16 + fr;
        PG8_LAS unsigned short* tl = (PG8_LAS unsigned short*)(stg + wave * 2048);
#pragma unroll
        for (int ai = 0; ai < 2; ++ai)
#pragma unroll
            for (int bj = 0; bj < 2; ++bj) {
                const int gcol = u.pn * BM + bj * HALF + wc * 32 + 8 * fq;
                f32x4 g0[4], g1[4];
#pragma unroll
                for (int m = 0; m < 4; ++m) {
                    const f32x4 a = acc[ai][bj][m][0], b = acc[ai][bj][m][1];
                    g0[m] = (f32x4){gelu_tanh(a[0]), gelu_tanh(a[1]), gelu_tanh(a[2]), gelu_tanh(a[3])};
                    g1[m] = (f32x4){gelu_tanh(b[0]), gelu_tanh(b[1]), gelu_tanh(b[2]), gelu_tanh(b[3])};
                }
                if (gcol < CW) {
#pragma unroll
                    for (int m = 0; m < 4; ++m) {
                        u32x4 w; w.x = pack2(g0[m][0], g0[m][1]); w.y = pack2(g0[m][2], g0[m][3]); w.z = pack2(g1[m][0], g1[m][1]); w.w = pack2(g1[m][2], g1[m][3]);
                        *(u32x4*)(zu + (size_t)(u.pm * BM + ai * HALF + wr * 64 + m * 16 + fr) * CW + gcol) = w;
                    }
                } else {
                    const int vcol = gcol - CW;
#pragma unroll
                    for (int m = 0; m < 4; ++m) {
                        float t = g0[m][0] * g0[m][0] + g0[m][1] * g0[m][1] + g0[m][2] * g0[m][2] + g0[m][3] * g0[m][3]
                                + g1[m][0] * g1[m][0] + g1[m][1] * g1[m][1] + g1[m][2] * g1[m][2] + g1[m][3] * g1[m][3];
                        t += __shfl_xor(t, 16); t += __shfl_xor(t, 32);
                        if (fq == 0) ssq[(size_t)(u.pm * BM + ai * HALF + wr * 64 + m * 16 + fr) * 64 + (vcol >> 5)] = t;
                    }
#pragma unroll
                    for (int h = 0; h < 2; ++h) {
#pragma unroll
                        for (int mm = 0; mm < 2; ++mm) {
                            const int m = 2 * h + mm, rl = 16 * mm + fr;
#pragma unroll
                            for (int j = 0; j < 4; ++j) { tl[(8 * fq + j) * 32 + rl] = f2bf(g0[m][j]); tl[(8 * fq + 4 + j) * 32 + rl] = f2bf(g1[m][j]); }
                        }
                        const int c = lane >> 1, hh = lane & 1;
                        const u32x4 w0 = *(const PG8_LAS u32x4*)(tl + c * 32 + hh * 16), w1 = *(const PG8_LAS u32x4*)(tl + c * 32 + hh * 16 + 8);
                        bf16_t* dst = zvt + ((size_t)(2 * u.pm + ai) * CW + (u.pn * BM - CW) + bj * HALF + wc * 32 + c) * 128 + wr * 64 + 32 * h + hh * 16;
                        *(u32x4*)dst = w0; *(u32x4*)(dst + 8) = w1;
                        asm volatile("" ::: "memory");
                    }
                }
            }
    }
};
struct EpiQ {
    static constexpr bool PERM = true, AFTER_DRAIN = false;
    bf16_t* q;
    __device__ __forceinline__ void operator()(const f32x4 (&acc)[2][2][4][2], const Unit& u, int wr, int wc, int fr, int fq) const {
#pragma unroll
        for (int ai = 0; ai < 2; ++ai)
#pragma unroll
            for (int m = 0; m < 4; ++m)
#pragma unroll
                for (int bj = 0; bj < 2; ++bj) {
                    const f32x4 a = acc[ai][bj][m][0], b = acc[ai][bj][m][1];
                    u32x4 w; w.x = pack2(a[0], a[1]); w.y = pack2(a[2], a[3]); w.z = pack2(b[0], b[1]); w.w = pack2(b[2], b[3]);
                    *(u32x4*)(q + (size_t)(u.pm * BM + ai * HALF + wr * 64 + m * 16 + fr) * 2048 + u.pn * BM + bj * HALF + wc * 32 + 8 * fq) = w;
                }
    }
};
}
DI void run_gemmq_pg8(const Params& p, int l, unsigned char* smem) {
    volatile LAS unsigned* st = (volatile LAS unsigned*)(smem + SMEM_BYTES);
    pg8::XcdOrder S; S.init(NTOK / 256, 2048 / 256, (int)st[0], (int)st[1], (int)st[2], (int)st[3]);
    const pg8::Gemm g{WSP(bf16_t, WS_XN), WSP(bf16_t, WS_W_PQ) + (size_t)l * 2048 * DM, NTOK, 2048, DM};
    pg8::EpiQ E; E.q = WSP(bf16_t, WS_QBUF);
    __syncthreads();
    pg8::gemm_phase<pg8::EpiQ, pg8::XcdOrder, true, true>((PG8_LAS unsigned char*)smem, g, S, E);
}
template <int WHICH>
DI void run_gemm_pg8(const Params& p, unsigned char* smem) {
    volatile LAS unsigned* st = (volatile LAS unsigned*)(smem + SMEM_BYTES);
    pg8::XcdOrder S; S.init(NTOK / 256, DM / 256, (int)st[0], (int)st[1], (int)st[2], (int)st[3]);
    pg8::Gemm g;
    pg8::EpiResid E;
    if (WHICH == 0) { g = pg8::Gemm{WSP(bf16_t, WS_MIXED), WSP(bf16_t, WS_W_ATTOUT), NTOK, DM, DM}; E.resid = p.in[0]; E.out = p.out; }
    else { g = pg8::Gemm{WSP(bf16_t, WS_Z_U), WSP(bf16_t, WS_W_SGUOUT), NTOK, DM, CW}; E.resid = p.out; E.out = p.out; }
    __syncthreads();
    pg8::gemm_phase<pg8::EpiResid, pg8::XcdOrder, true, true>((PG8_LAS unsigned char*)smem, g, S, E);
}

DI void run_gemm1_pg8(const Params& p, unsigned char* smem) {
    volatile LAS unsigned* st = (volatile LAS unsigned*)(smem + SMEM_BYTES);
    pg8::XcdOrder S; S.init(NTOK / 256, ATT_IN / 256, (int)st[0], (int)st[1], (int)st[2], (int)st[3]);
    const pg8::Gemm g{WSP(bf16_t, WS_XN), WSP(bf16_t, WS_W_ATTIN), NTOK, ATT_IN, DM};
    pg8::EpiProj E; E.aq = p.in[3]; E.ak = p.in[4]; E.bq = p.in[5]; E.bk = p.in[6]; E.proj = WSP(bf16_t, WS_PROJ); E.xs = (PG8_LAS float*)(smem + PG8_EXTRA);
    __syncthreads();
    pg8::gemm_phase<pg8::EpiProj, pg8::XcdOrder, true, true>((PG8_LAS unsigned char*)smem, g, S, E);
}
DI void run_gemm4_pg8(const Params& p, unsigned char* smem) {
    volatile LAS unsigned* st = (volatile LAS unsigned*)(smem + SMEM_BYTES);
    pg8::XcdOrder S; S.init(NTOK / 256, 4096 / 256, (int)st[0], (int)st[1], (int)st[2], (int)st[3]);
    const pg8::Gemm g{WSP(bf16_t, WS_XN), WSP(bf16_t, WS_W_SGUIN), NTOK, 4096, DM};
    pg8::EpiSgu E; E.zu = WSP(bf16_t, WS_Z_U); E.zvt = WSP(bf16_t, WS_Z_VT); E.ssq = WSP(float, WS_SSQ); E.stg = (PG8_LAS unsigned char*)(smem + PG8_EXTRA);
    __syncthreads();
    pg8::gemm_phase<pg8::EpiSgu, pg8::XcdOrder, true, true>((PG8_LAS unsigned char*)smem, g, S, E);
}

DI u32 cand_key(float s, int ci) { return (f2ord(s) & ~255u) | (u32)(255 - ci); }
template <int P>
DI void score_half(const bf16x8 (&qf)[8], const unsigned char* skl, int fr, int fh, u32 (&lst)[16]) {
#pragma unroll
    for (int j = 0; j < 16; ++j) lst[j] = 0u;
#pragma unroll 1
    for (int kt = 0; kt < 4; ++kt) {
        f32x16 st;
#pragma unroll
        for (int r = 0; r < 16; ++r) st[r] = 0.f;
        const int row = P * 128 + kt * 32 + fr;
        const unsigned char* skr = skl + row * 256;
#pragma unroll
        for (int ks = 0; ks < 8; ++ks) st = MFMA32(*(const bf16x8*)(skr + (((2 * ks + fh) ^ (row & 15)) << 4)), qf[ks], st);
        u32 ks_[16];
#pragma unroll
        for (int r = 0; r < 16; ++r) ks_[r] = (f2ord(st[r]) & ~127u) | (u32)(127 - (kt * 32 + crow(r, fh)));
        sort16_desc(ks_);
        merge16_desc(lst, ks_);
    }
    u32 other[16];
#pragma unroll
    for (int j = 0; j < 16; ++j) other[j] = (u32)__shfl_xor((int)lst[j], 32);
    merge16_desc(lst, other);
}
DI void run_score(const Params& p, int l, unsigned char* smem) {
    const int tid = otid512(), wave = tid >> 6, lane = tid & 63, fr = lane & 31, fh = lane >> 5;
    int cur_h = -1;
    bf16x8 qa[8], qb[8];
    if ((int)blockIdx.x < 8 * (NTOK / 256)) {
        const int it0 = blockIdx.x;
        const bf16_t* q0 = WSP(bf16_t, WS_QBUF) + (size_t)((it0 >> 3) * 256 + wave * 32 + fr) * 2048 + (it0 & 7) * 256 + 8 * fh;
#pragma unroll
        for (int ks = 0; ks < 8; ++ks) { qa[ks] = *(const bf16x8*)(q0 + 16 * ks); qb[ks] = *(const bf16x8*)(q0 + 128 + 16 * ks); }
    }
#pragma unroll 1
    for (int it = blockIdx.x; it < 8 * (NTOK / 256); it += gridDim.x) {
    const int h = it & 7, oct = it >> 3;
    if (h != cur_h) {
        __syncthreads();
        const bf16_t* skg = WSP(bf16_t, WS_W_SUBK) + ((size_t)l * 16 + h * 2) * 128 * 128;
#pragma unroll
        for (int i = 0; i < 8; ++i) {
            const int idx = wave * 8 + i;
            const int row = 4 * idx + (lane >> 4), cp = lane & 15;
            __builtin_amdgcn_global_load_lds((const unsigned*)(skg + (size_t)row * 128 + ((cp ^ (row & 15)) << 3)), (unsigned*)(smem + idx * 1024 + lane * 16), 16, 0, 0);
        }
        asm volatile("s_waitcnt vmcnt(0)" ::: "memory");
        __syncthreads();
        cur_h = h;
    }
    const int tok = oct * 256 + wave * 32 + fr;
    const unsigned char* skh = smem;
    u32 L0[16], L1[16];
    score_half<0>(qa, skh, fr, fh, L0);
    score_half<1>(qb, skh, fr, fh, L1);
    {
        const int itn = it + gridDim.x < 8 * (NTOK / 256) ? it + gridDim.x : it;
        const bf16_t* qn = WSP(bf16_t, WS_QBUF) + (size_t)((itn >> 3) * 256 + wave * 32 + fr) * 2048 + (itn & 7) * 256 + 8 * fh;
#pragma unroll
        for (int ks = 0; ks < 8; ++ks) { qa[ks] = *(const bf16x8*)(qn + 16 * ks); qb[ks] = *(const bf16x8*)(qn + 128 + 16 * ks); }
    }
    LAS int* slot = (LAS int*)(smem + 65536 + wave * (64 * 132)) + lane * 33;
    float s1[16], s2[16];
#pragma unroll
    for (int j = 0; j < 16; ++j) {
        s1[j] = ord2f(L0[j] & ~127u); s2[j] = ord2f(L1[j] & ~127u);
        slot[j] = 127 - (int)(L0[j] & 127u); slot[16 + j] = 127 - (int)(L1[j] & 127u);
    }
    u32 lst[16];
#pragma unroll
    for (int j = 0; j < 16; ++j) lst[j] = cand_key(s1[0] + s2[j], j);
#pragma unroll
    for (int i = 1; i < 5; ++i) {
        u32 row[16];
#pragma unroll
        for (int j = 0; j < 16; ++j) row[j] = ((i + 1) * (j + 1) <= 16) ? cand_key(s1[i] + s2[j], i * 16 + j) : 0u;
        merge16_desc(lst, row);
    }
#pragma unroll
    for (int i = 5; i < 16; ++i)
#pragma unroll
        for (int j = 0; j < 2; ++j)
            if ((i + 1) * (j + 1) <= 16) top16_insert(lst, cand_key(s1[i] + s2[j], i * 16 + j));
    float pv[16]; float sum = 0.f;
    const float mx = ord2f(lst[0] & ~255u);
#pragma unroll
    for (int j = 0; j < 16; ++j) { pv[j] = __expf(ord2f(lst[j] & ~255u) - mx); sum += pv[j]; }
    const float inv = 1.f / sum;
    int ev[16];
#pragma unroll
    for (int j = 0; j < 16; ++j) {
        const int ci = 255 - (int)(lst[j] & 255u);
        ev[j] = slot[ci >> 4] * 128 + slot[16 + (ci & 15)];
    }
    if (fh == 0) {
        int4* ro = (int4*)(WSP(int, WS_RIDX) + (size_t)tok * 128 + h * 16);
        float4* go = (float4*)(WSP(float, WS_RG) + (size_t)tok * 128 + h * 16);
#pragma unroll
        for (int q = 0; q < 4; ++q) {
            ro[q] = make_int4(ev[4 * q], ev[4 * q + 1], ev[4 * q + 2], ev[4 * q + 3]);
            go[q] = make_float4(pv[4 * q] * inv, pv[4 * q + 1] * inv, pv[4 * q + 2] * inv, pv[4 * q + 3] * inv);
        }
    }
    }
}


#define OSM_THR 8.0f
DI void osm_update(f32x16& s, unsigned vm, float& m, float& lh, float& alpha) {
    float mx = -1e30f;
#pragma unroll
    for (int r = 0; r < 16; ++r) mx = ((vm >> r) & 1u) ? fmaxf(mx, s[r]) : mx;
    mx = fmaxf(mx, __shfl_xor(mx, 32));
    float mn = m; alpha = 1.f;
    if (!__all(mx <= m + OSM_THR)) { mn = fmaxf(m, mx); alpha = __expf(m - mn); }
    float ls = 0.f;
#pragma unroll
    for (int r = 0; r < 16; ++r) { const float pe = ((vm >> r) & 1u) ? __expf(s[r] - mn) : 0.f; s[r] = pe; ls += pe; }
    lh = lh * alpha + ls; m = mn;
}
DI void osm_update_full(f32x16& s, float& m, float& lh, float& alpha) {
    float mx = s[0];
#pragma unroll
    for (int r = 1; r < 16; ++r) mx = fmaxf(mx, s[r]);
    mx = fmaxf(mx, __shfl_xor(mx, 32));
    float mn = m; alpha = 1.f;
    if (!__all(mx <= m + OSM_THR)) { mn = fmaxf(m, mx); alpha = __expf(m - mn); }
    float ls = 0.f;
#pragma unroll
    for (int r = 0; r < 16; ++r) { const float pe = __expf(s[r] - mn); s[r] = pe; ls += pe; }
    lh = lh * alpha + ls; m = mn;
}
DI void tr_quad(const unsigned (&a)[4], unsigned hi_off, bf16x8 (&f)[4]) {
    s16x4 l0, h0, l1, h1, l2, h2, l3, h3;
    const unsigned b0 = a[0] + hi_off, b1 = a[1] + hi_off, b2 = a[2] + hi_off, b3 = a[3] + hi_off;
    asm volatile("ds_read_b64_tr_b16 %0, %8\n\tds_read_b64_tr_b16 %1, %9\n\tds_read_b64_tr_b16 %2, %10\n\tds_read_b64_tr_b16 %3, %11\n\t"
                 "ds_read_b64_tr_b16 %4, %12\n\tds_read_b64_tr_b16 %5, %13\n\tds_read_b64_tr_b16 %6, %14\n\tds_read_b64_tr_b16 %7, %15\n\ts_waitcnt lgkmcnt(0)"
                 : "=&v"(l0), "=&v"(h0), "=&v"(l1), "=&v"(h1), "=&v"(l2), "=&v"(h2), "=&v"(l3), "=&v"(h3)
                 : "v"(a[0]), "v"(b0), "v"(a[1]), "v"(b1), "v"(a[2]), "v"(b2), "v"(a[3]), "v"(b3) : "memory");
    f[0] = __builtin_shufflevector(l0, h0, 0, 1, 2, 3, 4, 5, 6, 7); f[1] = __builtin_shufflevector(l1, h1, 0, 1, 2, 3, 4, 5, 6, 7);
    f[2] = __builtin_shufflevector(l2, h2, 0, 1, 2, 3, 4, 5, 6, 7); f[3] = __builtin_shufflevector(l3, h3, 0, 1, 2, 3, 4, 5, 6, 7);
}

#define QB_BYTES (128 * 256)
#define KB_BYTES (32 * 256)
template <bool WITH_V>
DI void attnB_stage_kv(const bf16_t* __restrict__ kg  , unsigned char* Kd, unsigned char* Vd, int wave, int lane) {
#pragma unroll
    for (int i = 0; i < 2; ++i) {
        const int idx = wave * 2 + i;
        const int key = 4 * idx + (lane >> 4), cp = lane & 15;
        const bf16_t* g = kg + (size_t)key * ATT_IN;
        __builtin_amdgcn_global_load_lds((const unsigned*)(g + ((cp ^ (key & 15)) << 3)), (unsigned*)(Kd + idx * 1024 + lane * 16), 16, 0, 0);
        if (WITH_V) {
            const int cv = ((((cp >> 2) ^ (key & 3)) << 2) | (cp & 3));
            __builtin_amdgcn_global_load_lds((const unsigned*)(g + 512 + (cv << 3)), (unsigned*)(Vd + idx * 1024 + lane * 16), 16, 0, 0);
        }
    }
}
template <int KOFF, bool FULL>
DI void attnB_map(const unsigned char* Kc, const unsigned char* qlp, int ksw, int qsw, int fh, unsigned vm, unsigned vc, int tq,
                  float& m, float& l, f32x16 (&o)[4]) {
    f32x16 st;
#pragma unroll
    for (int r = 0; r < 16; ++r) st[r] = 0.f;
#pragma unroll
    for (int s = 0; s < 4; ++s) {
        const bf16x8 kf = *(const bf16x8*)(Kc + (((KOFF + 2 * s + fh) ^ ksw) << 4));
        const bf16x8 qf = *(const bf16x8*)(qlp + (((KOFF + 2 * s + fh) ^ qsw) << 4));
        st = MFMA32(kf, qf, st);
    }
    float al;
    if (FULL) osm_update_full(st, m, l, al); else osm_update(st, vm, m, l, al);
    if (!__all(al == 1.f)) {
#pragma unroll
        for (int d = 0; d < 4; ++d)
#pragma unroll
            for (int r = 0; r < 16; ++r) o[d][r] *= al;
    }
#pragma unroll
    for (int s = 0; s < 2; ++s) {
        const bf16x8 pf = pack_p(st, s);
        unsigned va[4]; bf16x8 vf[4];
#pragma unroll
        for (int d = 0; d < 4; ++d) va[d] = vc + s * 16 * 256 + ((d ^ tq) << 6);
        tr_quad(va, 8 * 256, vf);
#pragma unroll
        for (int d = 0; d < 4; ++d) o[d] = MFMA32(vf[d], pf, o[d]);
    }
}
DI void ph_attnB_fast(const Params& p, int item, unsigned char* smem) {
    const bf16_t* proj = WSP(bf16_t, WS_PROJ);
    const int tid = otid(), wave = tid >> 6, lane = tid & 63, fr = lane & 31, fh = lane >> 5;
    const int qt = 15 - (item >> 6), bh = item & 63, b = bh >> 2, h = bh & 3;
    const int q0 = qt * 128;
    const float lam = compute_lam(p, lane);
    const size_t rowbase = (size_t)b * SEQ;
    const int qrow = wave * 32 + fr, qpos = q0 + qrow;
    unsigned char* Ql = smem;
    unsigned char* Kl = smem + QB_BYTES;
    unsigned char* Vl = Kl + 2 * KB_BYTES;
    const bf16_t* kbase = proj + rowbase * ATT_IN + 2048 + h * 128;
    __syncthreads();
#pragma unroll
    for (int i = 0; i < 8; ++i) {
        const int idx = wave * 8 + i;
        const int row = 4 * idx + (lane >> 4), cp = lane & 15;
        __builtin_amdgcn_global_load_lds((const unsigned*)(proj + (rowbase + q0 + row) * ATT_IN + 1536 + h * 128 + ((cp ^ (row & 15)) << 3)),
                                         (unsigned*)(Ql + idx * 1024 + lane * 16), 16, 0, 0);
    }
    attnB_stage_kv<true>(kbase, Kl, Vl, wave, lane);
    const unsigned char* qlp = Ql + qrow * 256;
    const int qsw = qrow & 15, ksw = fr & 15;
    const int nkt = (q0 + 128) / 32;
    const int wlast = q0 + wave * 32 + 31;
    f32x16 o1[4], o2[4];
#pragma unroll
    for (int d = 0; d < 4; ++d)
#pragma unroll
        for (int r = 0; r < 16; ++r) { o1[d][r] = 0.f; o2[d][r] = 0.f; }
    float m1 = -1e30f, m2 = -1e30f, l1 = 0.f, l2 = 0.f;
    const int tq = (lane & 15) >> 2;
    const unsigned vrow = (unsigned)(uintptr_t)Vl + (4 * fh + tq) * 256 + (16 * ((lane >> 4) & 1) + 4 * (lane & 3)) * 2;
    asm volatile("s_waitcnt vmcnt(0)" ::: "memory");
    __syncthreads();
    for (int kt = 0; kt < nkt; ++kt) {
        const int cur = kt & 1;
        if (kt + 1 < nkt) attnB_stage_kv<true>(kbase + (size_t)(kt + 1) * 32 * ATT_IN, Kl + (cur ^ 1) * KB_BYTES, Vl + (cur ^ 1) * KB_BYTES, wave, lane);
        if (kt * 32 <= wlast) {
            const unsigned char* Kc = Kl + cur * KB_BYTES + fr * 256;
            const unsigned vc = vrow + cur * KB_BYTES;
            if (kt * 32 + 31 <= wlast - 31) {
                attnB_map<0, true>(Kc, qlp, ksw, qsw, fh, 0xffffu, vc, tq, m1, l1, o1);
                __builtin_amdgcn_sched_barrier(0);
                attnB_map<8, true>(Kc, qlp, ksw, qsw, fh, 0xffffu, vc, tq, m2, l2, o2);
            } else {
                unsigned vm = 0;
#pragma unroll
                for (int r = 0; r < 16; ++r) vm |= ((kt * 32 + crow(r, fh)) <= qpos) ? (1u << r) : 0u;
                attnB_map<0, false>(Kc, qlp, ksw, qsw, fh, vm, vc, tq, m1, l1, o1);
                __builtin_amdgcn_sched_barrier(0);
                attnB_map<8, false>(Kc, qlp, ksw, qsw, fh, vm, vc, tq, m2, l2, o2);
            }
        }
        asm volatile("s_waitcnt vmcnt(0)" ::: "memory");
        __syncthreads();
    }
    l1 += __shfl_xor(l1, 32); l2 += __shfl_xor(l2, 32);
    const float i1 = 1.f / l1, i2 = lam / l2;
    float ss = 0.f;
#pragma unroll
    for (int d = 0; d < 4; ++d)
#pragma unroll
        for (int r = 0; r < 16; ++r) { const float v = o1[d][r] * i1 - o2[d][r] * i2; o1[d][r] = v; ss += v * v; }
    ss += __shfl_xor(ss, 32);
    const float rinv = rsqrtf(ss * (1.f / 128.f) + EPSN) * 0.8f;
    const float* subg = p.in[11];
    bf16_t* op = WSP(bf16_t, WS_MIXED) + (rowbase + qpos) * DM + 512 + h * 128;
#pragma unroll
    for (int d = 0; d < 4; ++d)
#pragma unroll
        for (int g = 0; g < 4; ++g) {
            const int dim = 32 * d + 8 * g + 4 * fh;
            const float4 gg = *(const float4*)(subg + dim);
            uint2 w;
            w.x = pack2(o1[d][4 * g + 0] * rinv * gg.x, o1[d][4 * g + 1] * rinv * gg.y);
            w.y = pack2(o1[d][4 * g + 2] * rinv * gg.z, o1[d][4 * g + 3] * rinv * gg.w);
            *(uint2*)(op + dim) = w;
        }
}

#define KA_PITCH 128
#define VA_PITCH 192
#define WA_BYTES (32 * KA_PITCH + 32 * VA_PITCH)
template <int MODE>
DI void ph_attnA_fast(const Params& p, int item, unsigned char* smem) {
    const bf16_t* proj = WSP(bf16_t, WS_PROJ);
    const int tid = otid(), wave = tid >> 6, lane = tid & 63, fr = lane & 31, fh = lane >> 5;
    const int c = item & 15, h = (item >> 4) & 7, b = item >> 7;
    const size_t rowbase = (size_t)b * SEQ;
    const int qpos = MODE == 0 ? 128 * c + 32 * wave + fr : 16 * (32 * wave + fr) + c;
    const int pmin = MODE == 0 ? 128 * c + 32 * wave : 512 * wave + c, pmax = pmin + (MODE == 0 ? 31 : 496);
    bf16x8 qf[4];
    {
        const bf16_t* qp = proj + (rowbase + qpos) * ATT_IN + h * 64 + 8 * fh;
#pragma unroll
        for (int s = 0; s < 4; ++s) qf[s] = *(const bf16x8*)(qp + 16 * s);
    }
    f32x16 o[2];
#pragma unroll
    for (int d = 0; d < 2; ++d)
#pragma unroll
        for (int r = 0; r < 16; ++r) o[d][r] = 0.f;
    float m = -1e30f, l = 0.f;
    unsigned char* Kl = smem + wave * WA_BYTES;
    unsigned char* Vl = Kl + 32 * KA_PITCH;
    const unsigned vaddr = (unsigned)(uintptr_t)Vl + (4 * fh + ((lane & 15) >> 2)) * VA_PITCH + (16 * ((lane >> 4) & 1) + 4 * (lane & 3)) * 2;
    const int skey = lane >> 3, sc = lane & 7;
    int br = 0, d = MODE == 0 ? 1 : 16, W = MODE == 0 ? 128 : 2048, cls = MODE == 0 ? 0 : (c & 15);
    int j0 = MODE == 0 ? (pmin < 128 ? 0 : pmin - 128) : 0, jhi = MODE == 0 ? pmax : ((pmax - cls) >> 4);
    const bf16_t* kvbase = proj + rowbase * ATT_IN + 512 + h * 64 + sc * 8;
    uint4 rk0, rk1, rk2, rk3, rv0, rv1, rv2, rv3;
#define A_LOAD(i, RK, RV) do { int kp_ = cls + d * (j0 + skey + 8 * (i)); kp_ = kp_ > SEQ - 1 ? SEQ - 1 : kp_; kp_ = kp_ < 0 ? 0 : kp_; \
        const bf16_t* g_ = kvbase + (size_t)kp_ * ATT_IN; RK = *(const uint4*)g_; RV = *(const uint4*)(g_ + 512); } while (0)
#define A_WRITE(i, RK, RV) do { const int key_ = skey + 8 * (i); *(uint4*)(Kl + key_ * KA_PITCH + ((sc ^ ((key_ >> 1) & 7)) << 4)) = RK; \
        *(uint4*)(Vl + key_ * VA_PITCH + sc * 16) = RV; } while (0)
    A_LOAD(0, rk0, rv0); A_LOAD(1, rk1, rv1); A_LOAD(2, rk2, rv2); A_LOAD(3, rk3, rv3);
#pragma unroll 1
    for (;;) {
        A_WRITE(0, rk0, rv0); A_WRITE(1, rk1, rv1); A_WRITE(2, rk2, rv2); A_WRITE(3, rk3, rv3);
        const int cd = d, cW = W, ccls = cls, cj0 = j0;
        bool more = true;
        j0 += 32;
        if (j0 > jhi) {
            ++br;
            if (MODE == 0 || br == 2) more = false;
            else {
                d = 4; W = 512; cls = c & 3;
                const int lo = pmin - cls - W;
                j0 = lo < 0 ? 0 : lo >> 2;
                jhi = (pmax - cls) >> 2;
            }
        }
        A_LOAD(0, rk0, rv0); A_LOAD(1, rk1, rv1); A_LOAD(2, rk2, rv2); A_LOAD(3, rk3, rv3);
        f32x16 st;
#pragma unroll
        for (int r = 0; r < 16; ++r) st[r] = 0.f;
#pragma unroll
        for (int s = 0; s < 4; ++s) {
            const bf16x8 kf = *(const bf16x8*)(Kl + fr * KA_PITCH + (((2 * s + fh) ^ ((fr >> 1) & 7)) << 4));
            st = MFMA32(kf, qf[s], st);
        }
        float al;
        const int kfirst = ccls + cd * cj0, klast = kfirst + cd * 31;
        if (klast <= pmin && pmax - kfirst <= cW) osm_update_full(st, m, l, al);
        else {
            unsigned vm = 0;
#pragma unroll
            for (int r = 0; r < 16; ++r) {
                const int dist = qpos - (ccls + cd * (cj0 + crow(r, fh)));
                vm |= (dist >= 0 && dist <= cW) ? (1u << r) : 0u;
            }
            osm_update(st, vm, m, l, al);
        }
        if (!__all(al == 1.f)) {
#pragma unroll
            for (int dd = 0; dd < 2; ++dd)
#pragma unroll
                for (int r = 0; r < 16; ++r) o[dd][r] *= al;
        }
        {
            unsigned va[4]; bf16x8 vf[4];
            va[0] = vaddr; va[1] = vaddr + 64; va[2] = vaddr + 16 * VA_PITCH; va[3] = vaddr + 16 * VA_PITCH + 64;
            tr_quad(va, 8 * VA_PITCH, vf);
            const bf16x8 p0 = pack_p(st, 0), p1 = pack_p(st, 1);
            o[0] = MFMA32(vf[0], p0, o[0]); o[1] = MFMA32(vf[1], p0, o[1]);
            o[0] = MFMA32(vf[2], p1, o[0]); o[1] = MFMA32(vf[3], p1, o[1]);
        }
        if (!more) break;
    }
    l += __shfl_xor(l, 32);
    bf16_t* op = WSP(bf16_t, WS_MIXED) + (rowbase + qpos) * DM + h * 64;
    float* lsep = WSP(float, WS_LSE1) + (rowbase + qpos) * 8 + h;
    if (MODE == 0) {
        const float il = 1.f / l;
        if (fh == 0) *lsep = m + __logf(l);
#pragma unroll
        for (int dd = 0; dd < 2; ++dd)
#pragma unroll
            for (int g = 0; g < 4; ++g) {
                const int dim = 32 * dd + 8 * g + 4 * fh;
                uint2 w;
                w.x = pack2(o[dd][4 * g + 0] * il, o[dd][4 * g + 1] * il);
                w.y = pack2(o[dd][4 * g + 2] * il, o[dd][4 * g + 3] * il);
                *(uint2*)(op + dim) = w;
            }
    } else {
        const float lse1 = *lsep;
        const float M = fmaxf(m, lse1);
        const float w23 = __expf(m - M), w1 = __expf(lse1 - M);
        const float iden = 1.f / (l * w23 + w1);
        const float a23 = w23 * iden, a1 = w1 * iden;
        uint2 prev[2][4];
#pragma unroll
        for (int dd = 0; dd < 2; ++dd)
#pragma unroll
            for (int g = 0; g < 4; ++g) prev[dd][g] = *(const uint2*)(op + 32 * dd + 8 * g + 4 * fh);
#pragma unroll
        for (int dd = 0; dd < 2; ++dd)
#pragma unroll
            for (int g = 0; g < 4; ++g) {
                const int dim = 32 * dd + 8 * g + 4 * fh;
                const float p0 = __uint_as_float(prev[dd][g].x << 16), p1 = __uint_as_float(prev[dd][g].x & 0xffff0000u);
                const float p2 = __uint_as_float(prev[dd][g].y << 16), p3 = __uint_as_float(prev[dd][g].y & 0xffff0000u);
                uint2 w;
                w.x = pack2(o[dd][4 * g + 0] * a23 + p0 * a1, o[dd][4 * g + 1] * a23 + p1 * a1);
                w.y = pack2(o[dd][4 * g + 2] * a23 + p2 * a1, o[dd][4 * g + 3] * a23 + p3 * a1);
                *(uint2*)(op + dim) = w;
            }
    }
}
#define NITEM_B 1024
#define NITEM_A 2048
DI void ph_attn_fast(const Params& p, int vb, unsigned char* smem) {
    if (vb < NITEM_B) {
        const int item = vb < 512 ? vb : 512 + (1023 - vb);
        ph_attnB_fast(p, item, smem);
    } else ph_attnA_fast<0>(p, vb - NITEM_B, smem);
}


DI void ph_spatial_fast(const Params& p, int item, unsigned char* smem) {
    const int tid = otid(), wave = tid >> 6, lane = tid & 63, fr = lane & 31, fh = lane >> 5;
    const int wm = wave >> 1, wn = wave & 1;
    const int chunk = item >> 3, g = item & 7;
    bf16_t* u = WSP(bf16_t, WS_Z_U);
    const bf16_t* vt = WSP(bf16_t, WS_Z_VT);
    const float* ssq = WSP(float, WS_SSQ);
    const float* wsp = p.in[16] + (size_t)g * 128 * 128;
    float* rinv = (float*)(smem + 66 * 1024);
    unsigned char* Bt = smem + 32768;
    __syncthreads();
    if (tid < 128) {
        const float4* sp = (const float4*)(ssq + (size_t)(chunk * 128 + tid) * 64);
        float sacc = 0.f;
#pragma unroll
        for (int j = 0; j < 16; ++j) { const float4 q = sp[j]; sacc += (q.x + q.y) + (q.z + q.w); }
        rinv[tid] = rsqrtf(sacc * (1.f / CW) + EPSN);
    }
    const size_t vrow0 = (size_t)chunk * CW + g * 256;
    stage_tile(vt, 128, (int)vrow0, 0, Bt, wave, lane);
    stage_tile(vt, 128, (int)vrow0, 64, Bt + 16384, wave, lane);
    __syncthreads();
#pragma unroll
    for (int i = 0; i < 8; ++i) {
        const int id = tid + 256 * i;
        const int t = id >> 4, sc = id & 15;
        const float4 w0 = *(const float4*)(wsp + t * 128 + sc * 8);
        const float4 w1 = *(const float4*)(wsp + t * 128 + sc * 8 + 4);
        const float4 r0 = *(const float4*)(rinv + sc * 8);
        const float4 r1 = *(const float4*)(rinv + sc * 8 + 4);
        const int s0 = sc * 8;
        uint4 o;
        o.x = pack2(s0 + 0 <= t ? w0.x * r0.x : 0.f, s0 + 1 <= t ? w0.y * r0.y : 0.f);
        o.y = pack2(s0 + 2 <= t ? w0.z * r0.z : 0.f, s0 + 3 <= t ? w0.w * r0.w : 0.f);
        o.z = pack2(s0 + 4 <= t ? w1.x * r1.x : 0.f, s0 + 5 <= t ? w1.y * r1.y : 0.f);
        o.w = pack2(s0 + 6 <= t ? w1.z * r1.z : 0.f, s0 + 7 <= t ? w1.w * r1.w : 0.f);
        const int kt = sc >> 3, c = sc & 7;
        *(uint4*)(smem + kt * 16384 + t * 128 + ((c ^ ((t >> 1) & 7)) << 4)) = o;
    }
#pragma unroll 1
    for (int nt = 0; nt < 2; ++nt) {
        asm volatile("s_waitcnt vmcnt(0)" ::: "memory");
        __syncthreads();
        f32x16 acc[2][2];
#pragma unroll
        for (int i = 0; i < 2; ++i)
#pragma unroll
            for (int j = 0; j < 2; ++j)
#pragma unroll
                for (int r = 0; r < 16; ++r) acc[i][j][r] = 0.f;
#pragma unroll
        for (int kt = 0; kt < 2; ++kt)
#pragma unroll
            for (int s = 0; s < 4; ++s) {
                bf16x8 a[2], b[2];
#pragma unroll
                for (int i = 0; i < 2; ++i) {
                    a[i] = lds_frag(smem + kt * 16384, wm * 64 + i * 32 + fr, 2 * s + fh);
                    b[i] = lds_frag(Bt + kt * 16384, wn * 64 + i * 32 + fr, 2 * s + fh);
                }
#pragma unroll
                for (int i = 0; i < 2; ++i)
#pragma unroll
                    for (int j = 0; j < 2; ++j) acc[i][j] = MFMA32(a[i], b[j], acc[i][j]);
            }
        __syncthreads();
        float* st = (float*)(Bt + wave * (32 * 65 * 4));
#pragma unroll
        for (int i = 0; i < 2; ++i) {
#pragma unroll
            for (int j = 0; j < 2; ++j)
#pragma unroll
                for (int r = 0; r < 16; ++r) st[crow(r, fh) * 65 + j * 32 + fr] = acc[i][j][r];
            const int t = wm * 64 + i * 32 + fr;
            const int c0 = g * 256 + nt * 128 + wn * 64 + fh * 32;
            bf16_t* up = u + (size_t)(chunk * 128 + t) * CW + c0;
            const float bias = p.in[17][g * 128 + t];
            const float* gn = p.in[15] + c0;
            uint4 ur[4];
#pragma unroll
            for (int q = 0; q < 4; ++q) ur[q] = ((const uint4*)up)[q];
#pragma unroll
            for (int q = 0; q < 4; ++q) {
                float uf[8]; unpack8(ur[q], uf);
                const float4 g0 = *(const float4*)(gn + 8 * q), g1 = *(const float4*)(gn + 8 * q + 4);
                const float gg[8] = {g0.x, g0.y, g0.z, g0.w, g1.x, g1.y, g1.z, g1.w};
                float ov[8];
#pragma unroll
                for (int e = 0; e < 8; ++e) ov[e] = uf[e] * (st[fr * 65 + fh * 32 + 8 * q + e] * gg[e] + bias);
                uint4 o; o.x = pack2(ov[0], ov[1]); o.y = pack2(ov[2], ov[3]); o.z = pack2(ov[4], ov[5]); o.w = pack2(ov[6], ov[7]);
                ((uint4*)up)[q] = o;
            }
        }
        if (nt == 0) {
            __syncthreads();
            stage_tile(vt, 128, (int)vrow0 + 128, 0, Bt, wave, lane);
            stage_tile(vt, 128, (int)vrow0 + 128, 64, Bt + 16384, wave, lane);
        }
    }
}

#define XB_TMO      128
#define XB_XCNT(j)  (256  + 64 * (j))
#define XB_XSUB(j)  (1280 + 64 * (j))
#define XB_XGEN(j)  (2304 + 64 * (j))
#define XB_TOP      3328
#define XB_TOPGEN   3392
#define XCD_BAR_WORDS 3456
#define XB_SPIN_CAP (1u << 22)
DI unsigned xb_ld(unsigned* p) { return __hip_atomic_load(p, __ATOMIC_RELAXED, __HIP_MEMORY_SCOPE_AGENT); }
DI unsigned xb_add(unsigned* p, unsigned v) { return __hip_atomic_fetch_add(p, v, __ATOMIC_RELAXED, __HIP_MEMORY_SCOPE_AGENT); }
DI unsigned xb_xcc_id() { return (unsigned)__builtin_amdgcn_s_getreg((3 << 11) | 20) & 0xFu; }
#define XB_SPIN(cond, bar) do { unsigned _sp = 0; while (cond) { __builtin_amdgcn_s_sleep(1); \
    if ((++_sp & 255u) == 0u) { if (xb_ld(&(bar)[XB_TMO])) break; if (_sp > XB_SPIN_CAP) { atomicAdd(&(bar)[XB_TMO], 1u); break; } } } } while (0)
struct XcdBarrier { unsigned* bar; unsigned x; volatile LAS unsigned* st; };
DI XcdBarrier xcd_barrier_post(unsigned* bar, volatile LAS unsigned* st) {
    XcdBarrier b; b.bar = bar; b.x = xb_xcc_id(); b.st = st;
    if (threadIdx.x == 0) st[2] = xb_add(&bar[XB_XCNT(b.x)], 1u);
    return b;
}
DI void xcd_barrier_complete(unsigned* bar, unsigned x, unsigned& nloc, unsigned& nx, unsigned& xi) {
    const unsigned G = gridDim.x * gridDim.y * gridDim.z;
    unsigned sum, cnt, mine, below, sp = 0u;
    for (;;) {
        sum = 0u; cnt = 0u; mine = 0u; below = 0u;
#pragma unroll
        for (unsigned j = 0; j < 16; ++j) { const unsigned c = xb_ld(&bar[XB_XCNT(j)]); sum += c; cnt += (c > 0u) ? 1u : 0u; mine = (j == x) ? c : mine; below += (c > 0u && j < x) ? 1u : 0u; }
        if (sum == G) break;
        __builtin_amdgcn_s_sleep(1);
        if ((++sp & 255u) == 0u) { if (xb_ld(&bar[XB_TMO])) break; if (sp > XB_SPIN_CAP) { atomicAdd(&bar[XB_TMO], 1u); break; } }
    }
    nloc = mine > 0u ? mine : 1u; nx = cnt > 0u ? cnt : 1u; xi = below;
}
DI void xcd_barrier(const XcdBarrier& b) {
    asm volatile("s_waitcnt vmcnt(0)" ::: "memory");
    __syncthreads();
    if (threadIdx.x == 0) {
        unsigned* bar = b.bar;
        __builtin_amdgcn_s_waitcnt(0);
        unsigned nloc = b.st[0], nx = b.st[1];
        if (nloc == 0u) { unsigned xi; xcd_barrier_complete(bar, b.x, nloc, nx, xi); b.st[0] = nloc; b.st[1] = nx; b.st[3] = xi; }
        const unsigned old = xb_add(&bar[XB_XSUB(b.x)], 1u);
        const unsigned gen = old / nloc;
        if (old + 1u == (gen + 1u) * nloc) {
            __builtin_amdgcn_fence(__ATOMIC_RELEASE, "agent");
            asm volatile("s_waitcnt vmcnt(0)" ::: "memory");
            const unsigned og = xb_add(&bar[XB_TOP], 1u);
            const unsigned tg = og / nx;
            if (og + 1u == (tg + 1u) * nx) xb_add(&bar[XB_TOPGEN], 1u);
            else XB_SPIN(xb_ld(&bar[XB_TOPGEN]) == tg, bar);
            __builtin_amdgcn_fence(__ATOMIC_ACQUIRE, "agent");
            xb_add(&bar[XB_XGEN(b.x)], 1u);
            asm volatile("s_waitcnt vmcnt(0)" ::: "memory");
        } else {
            XB_SPIN(xb_ld(&bar[XB_XGEN(b.x)]) == gen, bar);
            __builtin_amdgcn_fence(__ATOMIC_ACQUIRE, "agent");
            asm volatile("s_waitcnt vmcnt(0)" ::: "memory");
        }
    }
    __syncthreads();
}

enum { PH_PREP = 0, PH_GEMM1, PH_ATTN, PH_ATTN2, PH_GEMM2,
       PH_NORM_P0, PH_GEMMQ0, PH_SCORE0, PH_PDOWN0, PH_PCOMB0, PH_PUP0, PH_NORM_SGU,
       PH_GEMM4, PH_SPATIAL, PH_GEMM5,
       PH_NORM_P1, PH_GEMMQ1, PH_SCORE1, PH_PDOWN1, PH_PCOMB1, PH_PUP1, PH_COUNT };

__host__ __device__ constexpr int phase_nvb(int ph) {
    switch (ph) {
        case PH_PREP: return PREP_N;
        case PH_GEMM1: return (ATT_IN / 256) * (NTOK / 256);
        case PH_ATTN: return NITEM_B + NITEM_A;
        case PH_ATTN2: return NITEM_A;
        case PH_GEMM2: return (DM / 256) * (NTOK / 256);
        case PH_NORM_P0: case PH_NORM_P1: case PH_NORM_SGU: return NTOK / 4;
        case PH_GEMMQ0: case PH_GEMMQ1: return 16 * (NTOK / 256);
        case PH_SCORE0: case PH_SCORE1: return (NTOK / 32) * 8 / 4;
        case PH_PCOMB0: case PH_PCOMB1: return NTOK / 4;
        case PH_GEMM4: return (4096 / 256) * (NTOK / 256);
        case PH_SPATIAL: return 256 * 8;
        case PH_GEMM5: return (DM / 256) * (NTOK / 256);
    }
    return 0;
}

template <int PH>
DI void run_vb(const Params& p, int vb, unsigned char* smem) {
    if constexpr (PH == PH_PREP) ph_prep(p, vb, smem);
    else if constexpr (PH == PH_ATTN) ph_attn_fast(p, vb, smem);
    else if constexpr (PH == PH_ATTN2) ph_attnA_fast<1>(p, vb, smem);
    else if constexpr (PH == PH_NORM_P0 || PH == PH_NORM_P1) rmsnorm_rows<true>(p.out, p.in[19] + (PH == PH_NORM_P1 ? DM : 0), WSP(bf16_t, WS_XN), vb, WSP(signed char, WS_XQ), WSP(float, WS_XSC));
    else if constexpr (PH == PH_PCOMB0 || PH == PH_PCOMB1) ph_peer_comb(p, vb, PH == PH_PCOMB1 ? 1 : 0);
    else if constexpr (PH == PH_NORM_SGU) rmsnorm_rows<false>(p.out, p.in[13], WSP(bf16_t, WS_XN), vb);
    else if constexpr (PH == PH_SPATIAL) ph_spatial_fast(p, vb, smem);
}

template <int PH>
DI void run_phase(const Params& p, unsigned char* smem) {
    if constexpr (PH == PH_PDOWN0 || PH == PH_PDOWN1) run_peer_sliced<false>(p, PH == PH_PDOWN1 ? 1 : 0, smem);
    else if constexpr (PH == PH_PUP0 || PH == PH_PUP1) run_peer_sliced<true>(p, PH == PH_PUP1 ? 1 : 0, smem);
    else if constexpr (PH == PH_SCORE0 || PH == PH_SCORE1) run_score(p, PH == PH_SCORE1 ? 1 : 0, smem);
    else if constexpr (PH == PH_GEMMQ0 || PH == PH_GEMMQ1) run_gemmq_pg8(p, PH == PH_GEMMQ1 ? 1 : 0, smem);
    else if constexpr (PH == PH_GEMM1) run_gemm1_pg8(p, smem);
    else if constexpr (PH == PH_GEMM4) run_gemm4_pg8(p, smem);
    else if constexpr (PH == PH_GEMM2) run_gemm_pg8<0>(p, smem);
    else if constexpr (PH == PH_GEMM5) run_gemm_pg8<1>(p, smem);
    else {
        constexpr int nvb = phase_nvb(PH);
        const int g = threadIdx.x >> 8;
        for (int vb = 2 * blockIdx.x; vb < nvb; vb += 2 * gridDim.x)
            if (vb + g < nvb) run_vb<PH>(p, vb + g, smem + g * GROUP_SMEM);
    }
}

template <int PH>
DI void run_from(const Params& p, unsigned char* smem, cg::grid_group& grid, const XcdBarrier& xb) {
    run_phase<PH>(p, smem);
    if constexpr (PH + 1 < PH_COUNT) {
        if constexpr (PH == 1) grid.sync(); else xcd_barrier(xb);
        run_from<PH + 1>(p, smem, grid, xb);
    }
}

__global__ void __launch_bounds__(NTHREADS, 2) k_mega(Params p) {
    extern __shared__ __attribute__((aligned(16))) unsigned char smem[];
    cg::grid_group grid = cg::this_grid();
    volatile LAS unsigned* st = (volatile LAS unsigned*)(smem + SMEM_BYTES);
    if (threadIdx.x == 0) { st[0] = 0u; st[1] = 0u; st[2] = 0u; st[3] = 0u; }
    __syncthreads();
    const XcdBarrier xb = xcd_barrier_post((unsigned*)(p.ws + WS_CTL), st);
    run_from<0>(p, smem, grid, xb);
}


extern "C" void kernel_launch(void* const* d_in, const int* in_sizes, int n_in, void* d_out, int out_size, void* d_ws, size_t ws_size, hipStream_t stream) {
    if (n_in != 24 || ws_size < WS_NEED || in_sizes[0] != NTOK * DM || out_size != NTOK * DM || in_sizes[22] != 2 * NEXP * DM) {
        fprintf(stderr, "kernel_launch: built for x[16,2048,1024] with 24 inputs and >= 512 MiB of workspace; got n_in %d, in0 %d, out %d, ws %zu: nothing launched\n", n_in, in_sizes[0], out_size, ws_size); return; }
    static int grid_blocks = 0;
    if (!grid_blocks) {
        int dev = 0, cus = 0, per_cu = 0;
        (void)hipGetDevice(&dev);
        (void)hipDeviceGetAttribute(&cus, hipDeviceAttributeMultiprocessorCount, dev);
        (void)hipFuncSetAttribute((const void*)k_mega, hipFuncAttributeMaxDynamicSharedMemorySize, SMEM_ALLOC);
        (void)hipOccupancyMaxActiveBlocksPerMultiprocessor(&per_cu, (const void*)k_mega, NTHREADS, SMEM_ALLOC);
        if (per_cu > 1) per_cu = 1;
        if (per_cu < 1) { fprintf(stderr, "kernel_launch: occupancy query returned %d\n", per_cu); per_cu = 1; }
        grid_blocks = cus * per_cu;
    }
    Params p{};
    for (int i = 0; i < 24; ++i) p.in[i] = (const float*)d_in[i];
    p.out = (float*)d_out;
    p.ws = (unsigned char*)d_ws;
    void* args[] = {&p};
    if (hipMemsetAsync((unsigned char*)d_ws + WS_CTL, 0, XCD_BAR_WORDS * 4, stream) != hipSuccess) { fprintf(stderr, "kernel_launch: memset of the barrier words failed\n"); return; }
    hipError_t e = hipLaunchCooperativeKernel((const void*)k_mega, dim3(grid_blocks), dim3(NTHREADS), args, SMEM_ALLOC, stream);
    if (e != hipSuccess) fprintf(stderr, "cooperative launch failed: %s (grid %d)\n", hipGetErrorString(e), grid_blocks);
}
```

```cpp
#include <hip/hip_runtime.h>
#include <stdint.h>
#include <stdio.h>

#define NTOK   32768
#define DM     1024
#define SEQ    2048
#define NB     16
#define ATT_IN 3072
#define CW     2048
#define NEXP   16384
#define EPSN   1e-6f

typedef unsigned short bf16_t;
typedef unsigned int u32;

#define DI __device__ __forceinline__
#define LAS __attribute__((address_space(3)))

DI int otid() { int t = threadIdx.x & 255; asm volatile("" : "+v"(t)); return t; }
DI int otid512() { int t = threadIdx.x; asm volatile("" : "+v"(t)); return t; }
DI float bf2f(bf16_t v) { return __uint_as_float(((u32)v) << 16); }
typedef __bf16 bf16v2 __attribute__((ext_vector_type(2)));
DI bf16_t f2bf(float f) { const __bf16 h = (__bf16)f; return __builtin_bit_cast(bf16_t, h); }
DI u32 pack2(float lo, float hi) { bf16v2 v; v[0] = (__bf16)lo; v[1] = (__bf16)hi; return __builtin_bit_cast(u32, v); }
DI float gelu_tanh(float x) {
    const float y = 0.7978845608028654f * (x + 0.044715f * x * x * x);
    const float e = __expf(2.f * y);
    const float t = 1.f - 2.f / (e + 1.f);
    return 0.5f * x * (1.f + t);
}
DI float wave_sum(float v) {
#pragma unroll
    for (int o = 1; o < 64; o <<= 1) v += __shfl_xor(v, o);
    return v;
}
DI float wave_max(float v) {
#pragma unroll
    for (int o = 1; o < 64; o <<= 1) v = fmaxf(v, __shfl_xor(v, o));
    return v;
}
DI u32 f2ord(float f) { u32 u = __float_as_uint(f); return (u & 0x80000000u) ? ~u : (u | 0x80000000u); }
DI float ord2f(u32 o) { u32 u = (o & 0x80000000u) ? (o & 0x7fffffffu) : ~o; return __uint_as_float(u); }

#define MiB ((size_t)1 << 20)
#define WS_CTL      ((size_t)0)
#define WS_W_ATTIN  (1 * MiB)
#define WS_W_ATTOUT (7 * MiB)
#define WS_W_SGUIN  (9 * MiB)
#define WS_W_SGUOUT (17 * MiB)
#define WS_W_PQ     (21 * MiB)
#define WS_WQS      (25 * MiB)
#define WS_W_SUBK   (29 * MiB)
#define WS_DOWN     (32 * MiB)
#define WS_UP       (64 * MiB)
#define WS_DSC      (96 * MiB)
#define WS_USC      (96 * MiB + 128 * 1024)
#define WS_LSE1     (30 * MiB)
#define WS_XQ       (100 * MiB)
#define WS_XSC      (132 * MiB)
#define WS_XN       (160 * MiB)
#define WS_BIG      (224 * MiB)
#define WS_PROJ     (WS_BIG)
#define WS_MIXED    (WS_BIG + 192 * MiB)
#define WS_Z_U      (WS_BIG)
#define WS_Z_VT     (WS_BIG + 128 * MiB)
#define WS_RIDX     (WS_BIG + 32 * MiB)
#define WS_RG       (WS_BIG + 48 * MiB)
#define WS_QBUF     (WS_BIG + 64 * MiB)
#define WS_SSQ      (WS_BIG + 256 * MiB)
#define WS_NEED     (512 * MiB)

struct Params {
    const float* in[24];
    float* out;
    unsigned char* ws;
};

#include <hip/hip_cooperative_groups.h>
namespace cg = cooperative_groups;

#define GROUP_SMEM (68 * 1024)
#define PG8_EXTRA (128 * 1024)
#define SMEM_BYTES (144 * 1024)
#define SMEM_ALLOC (SMEM_BYTES + 16)
#define NTHREADS 512

#define WSP(T, off) ((T*)(p.ws + (off)))


DI void transpose_tile(const float* __restrict__ W, bf16_t* __restrict__ Wt, int K, int N, int t, unsigned char* smem) {
    float* tile = (float*)smem;
    const int tid = otid();
    const int ntn = N / 64;
    const int n0 = (t % ntn) * 64, k0 = (t / ntn) * 64;
    __syncthreads();
    {
        const int n4 = tid & 15, kr = tid >> 4;
#pragma unroll
        for (int i = 0; i < 4; ++i) {
            const int k = kr + 16 * i;
            const float4 v = *(const float4*)(W + (size_t)(k0 + k) * N + n0 + 4 * n4);
            tile[k * 65 + 4 * n4 + 0] = v.x; tile[k * 65 + 4 * n4 + 1] = v.y; tile[k * 65 + 4 * n4 + 2] = v.z; tile[k * 65 + 4 * n4 + 3] = v.w;
        }
    }
    __syncthreads();
    {
        const int n = tid >> 2, kc = tid & 3;
        float v[16];
#pragma unroll
        for (int j = 0; j < 16; ++j) v[j] = tile[(16 * kc + j) * 65 + n];
        uint4 o0, o1;
        o0.x = pack2(v[0], v[1]); o0.y = pack2(v[2], v[3]); o0.z = pack2(v[4], v[5]); o0.w = pack2(v[6], v[7]);
        o1.x = pack2(v[8], v[9]); o1.y = pack2(v[10], v[11]); o1.z = pack2(v[12], v[13]); o1.w = pack2(v[14], v[15]);
        uint4* dst = (uint4*)(Wt + (size_t)(n0 + n) * K + k0 + 16 * kc);
        dst[0] = o0; dst[1] = o1;
    }
}
DI void cvt_chunk(const float* __restrict__ src, bf16_t* __restrict__ dst, int c) {
    const size_t base = (size_t)c * 2048;
#pragma unroll
    for (int i = 0; i < 8; ++i) {
        const size_t idx = base + i * 256 + otid();
        const float4 v = ((const float4*)src)[idx];
        uint2 o; o.x = pack2(v.x, v.y); o.y = pack2(v.z, v.w);
        ((uint2*)dst)[idx] = o;
    }
}
DI int q8(float v) { int i = __float2int_rn(v); i = i > 127 ? 127 : i; i = i < -127 ? -127 : i; return i & 255; }
template <bool EMIT_Q>
DI void rmsnorm_rows(const float* __restrict__ x, const float* __restrict__ g, bf16_t* __restrict__ o, int vb, signed char* xq = nullptr, float* xsc = nullptr) {
    const int lane = otid() & 63;
    const int row = vb * 4 + (otid() >> 6);
    const float4* xr = (const float4*)(x + (size_t)row * DM);
    float4 v[4]; float ss = 0.f;
#pragma unroll
    for (int j = 0; j < 4; ++j) { v[j] = xr[lane + 64 * j]; ss += v[j].x * v[j].x + v[j].y * v[j].y + v[j].z * v[j].z + v[j].w * v[j].w; }
    ss = wave_sum(ss);
    const float rinv = rsqrtf(ss * (1.f / DM) + EPSN);
    uint2* orow = (uint2*)(o + (size_t)row * DM);
    float am = 0.f;
#pragma unroll
    for (int j = 0; j < 4; ++j) {
        const float4 gg = ((const float4*)g)[lane + 64 * j];
        v[j].x *= rinv * gg.x; v[j].y *= rinv * gg.y; v[j].z *= rinv * gg.z; v[j].w *= rinv * gg.w;
        uint2 w; w.x = pack2(v[j].x, v[j].y); w.y = pack2(v[j].z, v[j].w);
        orow[lane + 64 * j] = w;
        if (EMIT_Q) am = fmaxf(am, fmaxf(fmaxf(fabsf(v[j].x), fabsf(v[j].y)), fmaxf(fabsf(v[j].z), fabsf(v[j].w))));
    }
    if (EMIT_Q) {
        am = wave_max(am);
        const float sc = am > 0.f ? 127.f / am : 0.f;
        u32* qrow = (u32*)(xq + (size_t)row * DM);
#pragma unroll
        for (int j = 0; j < 4; ++j)
            qrow[lane + 64 * j] = (u32)q8(v[j].x * sc) | ((u32)q8(v[j].y * sc) << 8) | ((u32)q8(v[j].z * sc) << 16) | ((u32)q8(v[j].w * sc) << 24);
        if (lane == 0) xsc[row] = am * (1.f / 127.f);
    }
}
#define PREP_T0 (48 * 16)
#define PREP_T1 (PREP_T0 + 16 * 16)
#define PREP_T2 (PREP_T1 + 64 * 16)
#define PREP_T3 (PREP_T2 + 16 * 32)
#define PREP_T4 (PREP_T3 + 2 * 32)
#define PREP_C0 (PREP_T4 + 64)
#define PREP_C1 (PREP_C0 + 8192)
#define PREP_C2 (PREP_C1 + 8192)
#define PREP_N  (PREP_C2 + 8192)
template <bool INT8>
DI void fp8_rows(const float* __restrict__ src, unsigned char* __restrict__ dst, float* __restrict__ inv_scale, int vb) {
    const int lane = otid() & 63;
    const int row = vb * 4 + (otid() >> 6);
    const float4* sr = (const float4*)(src + (size_t)row * DM) + lane;
    float4 v[4]; float am = 0.f;
#pragma unroll
    for (int j = 0; j < 4; ++j) { v[j] = sr[64 * j]; am = fmaxf(am, fmaxf(fmaxf(fabsf(v[j].x), fabsf(v[j].y)), fmaxf(fabsf(v[j].z), fabsf(v[j].w)))); }
    am = wave_max(am);
    float sc, inv;
    if (INT8) { sc = am > 0.f ? 127.f / am : 0.f; inv = am * (1.f / 127.f); }
    else {
        int e = (int)((__float_as_uint(am) >> 23) & 255u) - 127;
        if (am == 0.f) e = 0;
        e = e < -100 ? -100 : e;
        sc = __uint_as_float((u32)(127 + 7 - e) << 23); inv = __uint_as_float((u32)(127 + e - 7) << 23);
    }
    unsigned char* drow = dst + (size_t)(row >> 14) * NEXP * DM + (size_t)(row & (NEXP - 1)) * 128;
#pragma unroll
    for (int j = 0; j < 4; ++j) {
        const int dim = 4 * (lane + 64 * j);
        u32 w;
        if (INT8) w = (u32)q8(v[j].x * sc) | ((u32)q8(v[j].y * sc) << 8) | ((u32)q8(v[j].z * sc) << 16) | ((u32)q8(v[j].w * sc) << 24);
        else { int t = __builtin_amdgcn_cvt_pk_fp8_f32(v[j].x * sc, v[j].y * sc, 0, false); t = __builtin_amdgcn_cvt_pk_fp8_f32(v[j].z * sc, v[j].w * sc, t, true); w = (u32)t; }
        *(u32*)(drow + (size_t)(dim >> 7) * NEXP * 128 + (dim & 127)) = w;
    }
    if (lane == 0) inv_scale[row] = inv;
}
DI void wq8_item(const float* __restrict__ W, signed char* __restrict__ Wt, float* __restrict__ wsc, int t, unsigned char* smem) {
    float* red = (float*)smem;
    const int tid = otid(), n = tid & 63, kq = tid >> 6;
    const float* col = W + t * 64 + n;
    float am = 0.f;
#pragma unroll 16
    for (int k = 0; k < 256; ++k) am = fmaxf(am, fabsf(col[(size_t)(kq * 256 + k) * 2048]));
    __syncthreads();
    red[kq * 64 + n] = am;
    __syncthreads();
    am = fmaxf(fmaxf(red[n], red[64 + n]), fmaxf(red[128 + n], red[192 + n]));
    const float sc = am > 0.f ? 127.f / am : 0.f;
    if (kq == 0) wsc[t * 64 + n] = am * (1.f / 127.f);
    signed char* drow = Wt + (size_t)(t * 64 + n) * 1024;
#pragma unroll 1
    for (int kb = 0; kb < 16; ++kb) {
        const int k0 = kb * 64 + kq * 16;
        u32 w[4];
#pragma unroll
        for (int j = 0; j < 4; ++j) {
            const float* c4 = col + (size_t)(k0 + 4 * j) * 2048;
            w[j] = (u32)q8(c4[0] * sc) | ((u32)q8(c4[2048] * sc) << 8) | ((u32)q8(c4[4096] * sc) << 16) | ((u32)q8(c4[6144] * sc) << 24);
        }
        *(uint4*)(drow + k0) = make_uint4(w[0], w[1], w[2], w[3]);
    }
}
DI void ph_prep(const Params& p, int vb, unsigned char* smem) {
    if (vb < PREP_T0) transpose_tile(p.in[2], WSP(bf16_t, WS_W_ATTIN), DM, ATT_IN, vb, smem);
    else if (vb < PREP_T1) transpose_tile(p.in[12], WSP(bf16_t, WS_W_ATTOUT), DM, DM, vb - PREP_T0, smem);
    else if (vb < PREP_T2) transpose_tile(p.in[14], WSP(bf16_t, WS_W_SGUIN), DM, 4096, vb - PREP_T1, smem);
    else if (vb < PREP_T3) transpose_tile(p.in[18], WSP(bf16_t, WS_W_SGUOUT), CW, DM, vb - PREP_T2, smem);
    else if (vb < PREP_T4) { const int t = vb - PREP_T3, l = t / 32; wq8_item(p.in[20] + (size_t)l * DM * 2048, WSP(signed char, WS_W_PQ) + (size_t)l * 2048 * DM, WSP(float, WS_WQS) + l * 2048, t % 32, smem); }
    else if (vb < PREP_C0) cvt_chunk(p.in[21], WSP(bf16_t, WS_W_SUBK), vb - PREP_T4);
    else if (vb < PREP_C1) fp8_rows<true>(p.in[22], p.ws + WS_DOWN, WSP(float, WS_DSC), vb - PREP_C0);
    else if (vb < PREP_C2) fp8_rows<false>(p.in[23], p.ws + WS_UP, WSP(float, WS_USC), vb - PREP_C1);
    else rmsnorm_rows<false>(p.in[0], p.in[1], WSP(bf16_t, WS_XN), vb - PREP_C2);
}

DI float compute_lam(const Params& p, int lane) {
    const float a = wave_sum(p.in[7][lane] * p.in[8][lane]);
    const float b = wave_sum(p.in[9][lane] * p.in[10][lane]);
    return __expf(a) - __expf(b) + 0.2f;
}
DI void ce_desc(u32& a, u32& b) { const u32 hi = max(a, b), lo = min(a, b); a = hi; b = lo; }
DI void sort16_desc(u32 (&v)[16]) {
#pragma unroll
    for (int k = 2; k <= 16; k <<= 1)
#pragma unroll
        for (int j = k >> 1; j > 0; j >>= 1)
#pragma unroll
            for (int i = 0; i < 16; ++i) {
                const int l = i ^ j;
                if (l > i) { if ((i & k) == 0) ce_desc(v[i], v[l]); else ce_desc(v[l], v[i]); }
            }
}
DI void merge16_desc(u32 (&a)[16], const u32 (&b)[16]) {
#pragma unroll
    for (int i = 0; i < 16; ++i) a[i] = max(a[i], b[15 - i]);
#pragma unroll
    for (int j = 8; j > 0; j >>= 1)
#pragma unroll
        for (int i = 0; i < 16; ++i) { const int l = i ^ j; if (l > i) ce_desc(a[i], a[l]); }
}
DI void top16_insert(u32 (&lst)[16], u32 x) {
#pragma unroll
    for (int j = 0; j < 16; ++j) { const u32 hi = max(lst[j], x); x = min(lst[j], x); lst[j] = hi; }
}
DI void unpack8(const uint4 v, float (&f)[8]) {
    f[0] = __uint_as_float(v.x << 16); f[1] = __uint_as_float(v.x & 0xffff0000u);
    f[2] = __uint_as_float(v.y << 16); f[3] = __uint_as_float(v.y & 0xffff0000u);
    f[4] = __uint_as_float(v.z << 16); f[5] = __uint_as_float(v.z & 0xffff0000u);
    f[6] = __uint_as_float(v.w << 16); f[7] = __uint_as_float(v.w & 0xffff0000u);
}
typedef float f32x2_t __attribute__((ext_vector_type(2)));
DI void unpack16fp8(const uint4 w, float (&f)[16]) {
    f32x2_t t;
    t = __builtin_amdgcn_cvt_pk_f32_fp8((int)w.x, false); f[0] = t[0]; f[1] = t[1];
    t = __builtin_amdgcn_cvt_pk_f32_fp8((int)w.x, true);  f[2] = t[0]; f[3] = t[1];
    t = __builtin_amdgcn_cvt_pk_f32_fp8((int)w.y, false); f[4] = t[0]; f[5] = t[1];
    t = __builtin_amdgcn_cvt_pk_f32_fp8((int)w.y, true);  f[6] = t[0]; f[7] = t[1];
    t = __builtin_amdgcn_cvt_pk_f32_fp8((int)w.z, false); f[8] = t[0]; f[9] = t[1];
    t = __builtin_amdgcn_cvt_pk_f32_fp8((int)w.z, true);  f[10] = t[0]; f[11] = t[1];
    t = __builtin_amdgcn_cvt_pk_f32_fp8((int)w.w, false); f[12] = t[0]; f[13] = t[1];
    t = __builtin_amdgcn_cvt_pk_f32_fp8((int)w.w, true);  f[14] = t[0]; f[15] = t[1];
}
struct PeerPre { int e[16]; uint4 xa, xb; float2 r; };
struct PeerRows { uint4 d[8]; float c[8]; };
template <bool UP>
DI PeerPre peer_prefetch(const Params& p, int tok, int sl, int lane) {
    PeerPre q;
    const int4* rix = (const int4*)(WSP(int, WS_RIDX) + (size_t)tok * 128 + 16 * (lane >> 3));
#pragma unroll
    for (int j = 0; j < 4; ++j) { const int4 t = rix[j]; q.e[4 * j] = t.x; q.e[4 * j + 1] = t.y; q.e[4 * j + 2] = t.z; q.e[4 * j + 3] = t.w; }
    if (UP) {
        q.r = *(const float2*)(p.out + (size_t)tok * DM + sl * 128 + 16 * (lane & 7) + 2 * (lane >> 3));
    } else {
        q.xa = *(const uint4*)(WSP(signed char, WS_XQ) + (size_t)tok * DM + sl * 128 + 16 * (lane & 7));
    }
    return q;
}
template <int HF, bool UP>
DI void peer_issue_rows(const Params& p, const unsigned char* tab, const PeerPre& q, int tok, int lane, PeerRows& R) {
    const unsigned dco = 16u * (unsigned)(lane & 7);
#pragma unroll
    for (int bi = 0; bi < 8; ++bi) R.d[bi] = *(const uint4*)(tab + ((unsigned)q.e[8 * HF + bi] * 128u + dco));
    if (UP) {
        const float4* cf = (const float4*)(WSP(float, WS_RG) + (size_t)tok * 128 + 16 * (lane >> 3) + 8 * HF);
        const float4 c0 = cf[0], c1 = cf[1];
        R.c[0] = c0.x; R.c[1] = c0.y; R.c[2] = c0.z; R.c[3] = c0.w; R.c[4] = c1.x; R.c[5] = c1.y; R.c[6] = c1.z; R.c[7] = c1.w;
    }
}
template <int HF>
DI void peer_down_half(const PeerPre& q, const PeerRows& R, float (&part)[16]) {
#pragma unroll
    for (int bi = 0; bi < 8; ++bi) {
        int a = __builtin_amdgcn_sdot4((int)R.d[bi].x, (int)q.xa.x, 0, false);
        a = __builtin_amdgcn_sdot4((int)R.d[bi].y, (int)q.xa.y, a, false);
        a = __builtin_amdgcn_sdot4((int)R.d[bi].z, (int)q.xa.z, a, false);
        a = __builtin_amdgcn_sdot4((int)R.d[bi].w, (int)q.xa.w, a, false);
        part[8 * HF + bi] = (float)a;
    }
}
DI void peer_down_fin(const Params& p, const float (&part)[16], int tok, int sl, int lane) {
    const bool b2 = lane & 4, b1 = lane & 2, b0 = lane & 1;
    float r8[8], r4[4], r2[2];
#pragma unroll
    for (int i = 0; i < 8; ++i) { const float snd = b2 ? part[i] : part[i + 8]; const float kp = b2 ? part[i + 8] : part[i]; r8[i] = kp + __shfl_xor(snd, 4); }
#pragma unroll
    for (int i = 0; i < 4; ++i) { const float snd = b1 ? r8[i] : r8[i + 4]; const float kp = b1 ? r8[i + 4] : r8[i]; r4[i] = kp + __shfl_xor(snd, 2); }
#pragma unroll
    for (int i = 0; i < 2; ++i) { const float snd = b0 ? r4[i] : r4[i + 2]; const float kp = b0 ? r4[i + 2] : r4[i]; r2[i] = kp + __shfl_xor(snd, 1); }
    u32* pd = WSP(u32, WS_QBUF) + ((size_t)tok * 8 + sl) * 64;
    pd[lane] = pack2(r2[0], r2[1]);
}
DI void ph_peer_comb(const Params& p, int vb, int l) {
    const int tid = otid(), lane = tid & 63;
    const int tok = vb * 4 + (tid >> 6);
    const u32* pd = WSP(u32, WS_QBUF) + (size_t)tok * 8 * 64;
    const int* rix = WSP(int, WS_RIDX) + (size_t)tok * 128;
    float* rgp = WSP(float, WS_RG) + (size_t)tok * 128;
    const float* dsc = WSP(float, WS_DSC) + (size_t)l * NEXP;
    const float* usc = WSP(float, WS_USC) + (size_t)l * NEXP;
    const float xs = WSP(float, WS_XSC)[tok];
    float t0 = 0.f, t1 = 0.f;
#pragma unroll
    for (int sl = 0; sl < 8; ++sl) { const u32 w = pd[sl * 64 + lane]; t0 += __uint_as_float(w << 16); t1 += __uint_as_float(w & 0xffff0000u); }
    const int2 e = *(const int2*)(rix + 2 * lane);
    float2 g = *(const float2*)(rgp + 2 * lane);
    g.x = g.x * gelu_tanh(t0 * dsc[e.x] * xs) * usc[e.x];
    g.y = g.y * gelu_tanh(t1 * dsc[e.y] * xs) * usc[e.y];
    *(float2*)(rgp + 2 * lane) = g;
}
template <int HF>
DI void peer_up_half(const PeerPre& q, const PeerRows& R, float (&y)[16]) {
#pragma unroll
    for (int bi = 0; bi < 8; ++bi) {
        const float c = R.c[bi];
        float w[16]; unpack16fp8(R.d[bi], w);
#pragma unroll
        for (int i = 0; i < 16; ++i) y[i] += c * w[i];
        asm volatile("" : "+v"(y[0]), "+v"(y[1]), "+v"(y[2]), "+v"(y[3]), "+v"(y[4]), "+v"(y[5]), "+v"(y[6]), "+v"(y[7]), "+v"(y[8]), "+v"(y[9]), "+v"(y[10]), "+v"(y[11]), "+v"(y[12]), "+v"(y[13]), "+v"(y[14]), "+v"(y[15]));
    }
}
DI void peer_up_fin(const Params& p, const PeerPre& q, const float (&y)[16], int tok, int sl, int lane) {
    const int rg = lane >> 3, dc = lane & 7;
    const bool b5 = lane & 32, b4 = lane & 16, b3 = lane & 8;
    float r8[8], r4[4], r2[2];
#pragma unroll
    for (int i = 0; i < 8; ++i) { const float snd = b5 ? y[i] : y[i + 8]; const float kp = b5 ? y[i + 8] : y[i]; r8[i] = kp + __shfl_xor(snd, 32); }
#pragma unroll
    for (int i = 0; i < 4; ++i) { const float snd = b4 ? r8[i] : r8[i + 4]; const float kp = b4 ? r8[i + 4] : r8[i]; r4[i] = kp + __shfl_xor(snd, 16); }
#pragma unroll
    for (int i = 0; i < 2; ++i) { const float snd = b3 ? r4[i] : r4[i + 2]; const float kp = b3 ? r4[i + 2] : r4[i]; r2[i] = kp + __shfl_xor(snd, 8); }
    float2 v = q.r;
    v.x += r2[0]; v.y += r2[1];
    *(float2*)(p.out + (size_t)tok * DM + sl * 128 + 16 * dc + 2 * rg) = v;
}
template <bool UP>
DI void run_peer_sliced(const Params& p, int l, unsigned char* smem) {
    volatile LAS unsigned* st = (volatile LAS unsigned*)(smem + SMEM_BYTES);
    const int nloc = (int)st[0], nx = (int)st[1], rank = (int)st[2], xi = (int)st[3];
    const int tid = otid512(), lane = tid & 63, wave = tid >> 6;
    const int stride = nloc * 8;
#pragma unroll 1
    for (int sl = xi; sl < 8; sl += nx) {
        const unsigned char* tab = p.ws + (UP ? WS_UP : WS_DOWN) + (size_t)l * NEXP * DM + (size_t)sl * NEXP * 128;
        int tok = rank * 8 + wave;
        if (tok >= NTOK) continue;
        PeerPre qc = peer_prefetch<UP>(p, tok, sl, lane);
        PeerRows R;
        peer_issue_rows<0, UP>(p, tab, qc, tok, lane, R);
#pragma unroll 1
        for (; tok < NTOK; tok += stride) {
            const int tn = tok + stride < NTOK ? tok + stride : tok;
            const PeerPre qn = peer_prefetch<UP>(p, tn, sl, lane);
            float acc[16];
#pragma unroll
            for (int i = 0; i < 16; ++i) acc[i] = 0.f;
            PeerRows Rn;
            peer_issue_rows<1, UP>(p, tab, qc, tok, lane, Rn);
            __builtin_amdgcn_sched_barrier(0);
            if (UP) peer_up_half<0>(qc, R, acc); else peer_down_half<0>(qc, R, acc);
            __builtin_amdgcn_sched_barrier(0);
            peer_issue_rows<0, UP>(p, tab, qn, tn, lane, R);
            __builtin_amdgcn_sched_barrier(0);
            if (UP) { peer_up_half<1>(qc, Rn, acc); peer_up_fin(p, qc, acc, tok, sl, lane); }
            else { peer_down_half<1>(qc, Rn, acc); peer_down_fin(p, acc, tok, sl, lane); }
            __builtin_amdgcn_sched_barrier(0);
            qc = qn;
        }
    }
}


typedef short bf16x8 __attribute__((ext_vector_type(8)));
typedef float f32x16 __attribute__((ext_vector_type(16)));
#define MFMA32(a, b, c) __builtin_amdgcn_mfma_f32_32x32x16_bf16((a), (b), (c), 0, 0, 0)
typedef short s16x4 __attribute__((ext_vector_type(4)));
DI bf16x8 pack_p(const f32x16& pt, int s) {
    uint4 o;
    o.x = pack2(pt[8 * s + 0], pt[8 * s + 1]); o.y = pack2(pt[8 * s + 2], pt[8 * s + 3]);
    o.z = pack2(pt[8 * s + 4], pt[8 * s + 5]); o.w = pack2(pt[8 * s + 6], pt[8 * s + 7]);
    return __builtin_bit_cast(bf16x8, o);
}

DI void stage_tile(const bf16_t* __restrict__ g, int ld, int row0, int k0, unsigned char* lt, int wave, int lane) {
#pragma unroll
    for (int i = 0; i < 4; ++i) {
        const int inst = wave * 4 + i;
        const int row = inst * 8 + (lane >> 3);
        const int c = (lane & 7) ^ ((row >> 1) & 7);
        __builtin_amdgcn_global_load_lds((const unsigned*)(g + (size_t)(row0 + row) * ld + k0 + c * 8),
                                         (unsigned*)(lt + inst * 1024 + lane * 16), 16, 0, 0);
    }
}
DI bf16x8 lds_frag(const unsigned char* lt, int row, int c) {
    return *(const bf16x8*)(lt + row * 128 + ((c ^ ((row >> 1) & 7)) << 4));
}
DI int crow(int r, int fh) { return (r & 3) + 8 * (r >> 2) + 4 * fh; }

namespace pg8 {
#define PG8_LAS __attribute__((address_space(3)))
typedef float f32x4 __attribute__((ext_vector_type(4)));
typedef unsigned u32x4 __attribute__((ext_vector_type(4)));
constexpr int BM = 256, BK = 64, HALF = 128, HTB = HALF * BK * 2  , STAGE_BYTES = 8 * HTB;
__host__ __device__ __forceinline__ int lds_byte(int r, int c) { const int st = (r >> 4) * 2 + (c >> 5), rr = r & 15, cc = c & 31, ob = rr * 64 + cc * 2; return st * 1024 + (ob ^ (((ob >> 9) & 1) << 5)); }
__host__ __device__ __forceinline__ void stage_rc(int b, int& R, int& C) { const int st = b / 1024, sb = b % 1024, swz = sb ^ (((sb >> 9) & 1) << 5); R = (st >> 1) * 16 + swz / 64; C = (st & 1) * 32 + (swz % 64) / 2; }
__host__ __device__ __forceinline__ int perm32(int rho) { const int n = rho >> 4, i = rho & 15; return 8 * (i >> 2) + 4 * n + (i & 3); }
struct Unit { int pm, pn; };
struct Gemm { const bf16_t* A; const bf16_t* Bt; int M, N, K; };
struct XcdOrder {
    int ntn, nloc, nx, rank, xi, nown, total;
    __device__ __forceinline__ void init(int nmt, int ntn_, int nloc_, int nx_, int rank_, int xi_) {
        ntn = ntn_; nloc = nloc_; nx = nx_; rank = rank_; xi = xi_; nown = xi < nmt ? (nmt - xi + nx - 1) / nx : 0; total = nown * ntn; }
    __device__ __forceinline__ bool next(int i, Unit& u) const {
        const int t = rank + i * nloc; if (t >= total) return false;
        const int g4 = t / (4 * ntn), r = t - g4 * 4 * ntn;
        const int left = nown - 4 * g4, gs = left < 4 ? left : 4;
        const int nt = r / gs, mi = r - nt * gs;
        u.pm = (4 * g4 + mi) * nx + xi; u.pn = nt; return true;
    }
    __device__ __forceinline__ void a_ready(const Unit&) const {}
    __device__ __forceinline__ void done(const Unit&) const {}
};
typedef int i32x4 __attribute__((ext_vector_type(4)));
template <class Epi, class Sched, bool ALIGN_EPI = false, bool SP2 = false, bool I8 = false>
__device__ __forceinline__ void gemm_phase(PG8_LAS unsigned char* lds, const Gemm g, const Sched& S, const Epi& E) {
    const int tid = otid512(), wid = __builtin_amdgcn_readfirstlane(tid >> 6), lane = tid & 63, wr = wid >> 2, wc = wid & 3, fr = lane & 15, fq = lane >> 4;
    const int K = g.K, KB = I8 ? K : 2 * K  , nt = KB / (BK * 2);
    unsigned voffA[2], voffB[2];
#pragma unroll
    for (int i = 0; i < 2; ++i) { int R, C; stage_rc(tid * 16 + i * 8192, R, C); const int Rb = Epi::PERM ? ((R & ~31) + perm32(R & 31)) : R;
        voffA[i] = (unsigned)(R * KB + C * 2); voffB[i] = (unsigned)(Rb * KB + C * 2); }
    const size_t kstep = (size_t)(BK * 2);
    const size_t hstep = (size_t)HALF * KB;
    const size_t tstep = 2 * hstep;
    const unsigned ldsw = (unsigned)wid * 1024u;
    const int aoff = lds_byte(wr * 64 + fr, fq * 8), boff = lds_byte(wc * 32 + fr, fq * 8);
#define PG8_SA(b, h) (((b) * 2 + (h)) * HTB)
#define PG8_SB(b, h) ((4 + (b) * 2 + (h)) * HTB)
#define PG8_STAGE(bufoff, gbase, voff) do { _Pragma("unroll") for (int _i = 0; _i < 2; ++_i) \
        __builtin_amdgcn_global_load_lds((const unsigned*)((const char*)(gbase) + (voff)[_i]), (PG8_LAS unsigned*)(lds + (bufoff) + ldsw + _i * 8192), 16, 0, 0); } while (0)
#define PG8_LDA(dst, b, h) do { _Pragma("unroll") for (int m = 0; m < 4; ++m) _Pragma("unroll") for (int k = 0; k < 2; ++k) dst[m][k] = *(const PG8_LAS bf16x8*)(lds + PG8_SA(b, h) + aoff + m * 2048 + k * 1024); } while (0)
#define PG8_LDB(dst, b, h) do { _Pragma("unroll") for (int n = 0; n < 2; ++n) _Pragma("unroll") for (int k = 0; k < 2; ++k) dst[n][k] = *(const PG8_LAS bf16x8*)(lds + PG8_SB(b, h) + boff + n * 2048 + k * 1024); } while (0)
#define PG8_MMA(ai, bj, At, Bt) do { __builtin_amdgcn_s_setprio(1); _Pragma("unroll") for (int m = 0; m < 4; ++m) _Pragma("unroll") for (int n = 0; n < 2; ++n) _Pragma("unroll") for (int k = 0; k < 2; ++k) \
        { if constexpr (I8) acc[ai][bj][m][n] = __builtin_bit_cast(f32x4, __builtin_amdgcn_mfma_i32_16x16x64_i8(__builtin_bit_cast(i32x4, Bt[n][k]), __builtin_bit_cast(i32x4, At[m][k]), __builtin_bit_cast(i32x4, acc[ai][bj][m][n]), 0, 0, 0)); \
          else acc[ai][bj][m][n] = __builtin_amdgcn_mfma_f32_16x16x32_bf16(Bt[n][k], At[m][k], acc[ai][bj][m][n], 0, 0, 0); } __builtin_amdgcn_s_setprio(0); } while (0)
#define PG8_WAIT_V(n) asm volatile("s_waitcnt vmcnt(" #n ")" ::: "memory")
#define PG8_WAIT_L(n) asm volatile("s_waitcnt lgkmcnt(" #n ")" ::: "memory")
#define PG8_BAR __builtin_amdgcn_s_barrier()
#define PG8_SCHED __builtin_amdgcn_sched_barrier(0)
    Unit cur, nxt; int ui = 0;
    if (!S.next(0, cur)) return;
    f32x4 acc[2][2][4][2];
#pragma unroll
    for (int a = 0; a < 2; ++a)
#pragma unroll
        for (int b = 0; b < 2; ++b)
#pragma unroll
            for (int m = 0; m < 4; ++m)
#pragma unroll
                for (int n = 0; n < 2; ++n) acc[a][b][m][n] = (f32x4){0.f, 0.f, 0.f, 0.f};
    bf16x8 At[4][2], B0[2][2], B1[2][2];
    const char* cA = (const char*)g.A + (size_t)cur.pm * tstep; const char* cB = (const char*)g.Bt + (size_t)cur.pn * tstep;
    S.a_ready(cur);
    if constexpr (SP2) {
        PG8_STAGE(PG8_SB(0, 0), cB, voffB); PG8_STAGE(PG8_SB(0, 1), cB + hstep, voffB); PG8_STAGE(PG8_SA(0, 0), cA, voffA); PG8_STAGE(PG8_SA(0, 1), cA + hstep, voffA);
        if (wr == 1) PG8_BAR;
        PG8_WAIT_V(2); PG8_BAR;
        PG8_STAGE(PG8_SB(1, 0), cB + kstep, voffB); PG8_STAGE(PG8_SA(1, 0), cA + kstep, voffA); PG8_STAGE(PG8_SB(1, 1), cB + hstep + kstep, voffB);
        PG8_WAIT_V(6); PG8_BAR;
    } else {
        PG8_STAGE(PG8_SB(0, 0), cB, voffB); PG8_STAGE(PG8_SA(0, 0), cA, voffA); PG8_STAGE(PG8_SB(0, 1), cB + hstep, voffB); PG8_STAGE(PG8_SA(0, 1), cA + hstep, voffA);
        if (wr == 1) PG8_BAR;
        PG8_WAIT_V(4); PG8_BAR;
        PG8_STAGE(PG8_SB(1, 0), cB + kstep, voffB); PG8_STAGE(PG8_SA(1, 0), cA + kstep, voffA); PG8_STAGE(PG8_SB(1, 1), cB + hstep + kstep, voffB);
        PG8_WAIT_V(6); PG8_BAR;
    }
    for (;;) {
        const bool has_next = S.next(ui + 1, nxt);
        const char* nA = has_next ? (const char*)g.A + (size_t)nxt.pm * tstep : cA; const char* nB = has_next ? (const char*)g.Bt + (size_t)nxt.pn * tstep : cB;
        for (int t = 0; t < nt; t += 2) {
            const bool last = (t == nt - 2);
            const char* a1 = cA + (size_t)(t + 1) * kstep;
            const char* a2 = last ? nA : cA + (size_t)(t + 2) * kstep; const char* b2 = last ? nB : cB + (size_t)(t + 2) * kstep;
            const char* a3 = a2 + kstep; const char* b3 = b2 + kstep;
            if (last && has_next) S.a_ready(nxt);
            if constexpr (SP2) {
            PG8_LDB(B0, 0, 0); PG8_LDB(B1, 0, 1); PG8_SCHED; PG8_LDA(At, 0, 0); PG8_STAGE(PG8_SA(1, 1), a1 + hstep, voffA);
            PG8_WAIT_V(8); PG8_WAIT_L(0); PG8_BAR; PG8_MMA(0, 0, At, B0); PG8_MMA(0, 1, At, B1); PG8_BAR; PG8_SCHED;
            PG8_LDA(At, 0, 1); PG8_STAGE(PG8_SB(0, 0), b2, voffB); PG8_STAGE(PG8_SB(0, 1), b2 + hstep, voffB); PG8_STAGE(PG8_SA(0, 0), a2, voffA);
            PG8_WAIT_V(8); PG8_WAIT_L(0); PG8_BAR; PG8_MMA(1, 0, At, B0); PG8_MMA(1, 1, At, B1); PG8_BAR; PG8_SCHED;
            PG8_LDB(B0, 1, 0); PG8_LDB(B1, 1, 1); PG8_SCHED; PG8_LDA(At, 1, 0); PG8_STAGE(PG8_SA(0, 1), a2 + hstep, voffA);
            PG8_WAIT_V(8); PG8_WAIT_L(0); PG8_BAR; PG8_MMA(0, 0, At, B0); PG8_MMA(0, 1, At, B1); PG8_BAR; PG8_SCHED;
            PG8_LDA(At, 1, 1); PG8_STAGE(PG8_SB(1, 0), b3, voffB); PG8_STAGE(PG8_SB(1, 1), b3 + hstep, voffB); PG8_STAGE(PG8_SA(1, 0), a3, voffA);
            PG8_WAIT_V(8); PG8_WAIT_L(0); PG8_BAR; PG8_MMA(1, 0, At, B0); PG8_MMA(1, 1, At, B1); PG8_BAR; PG8_SCHED;
            } else {
            PG8_LDB(B0, 0, 0); PG8_SCHED; PG8_LDA(At, 0, 0); PG8_STAGE(PG8_SA(1, 1), a1 + hstep, voffA);
            PG8_WAIT_L(8); PG8_BAR; PG8_WAIT_L(0); PG8_MMA(0, 0, At, B0); PG8_BAR; PG8_SCHED;
            PG8_LDB(B1, 0, 1); PG8_STAGE(PG8_SB(0, 0), b2, voffB);
            PG8_BAR; PG8_WAIT_L(0); PG8_MMA(0, 1, At, B1); PG8_BAR;
            PG8_LDA(At, 0, 1); PG8_STAGE(PG8_SA(0, 0), a2, voffA);
            PG8_BAR; PG8_WAIT_L(0); PG8_MMA(1, 0, At, B0); PG8_BAR; PG8_SCHED;
            PG8_STAGE(PG8_SB(0, 1), b2 + hstep, voffB);
            PG8_WAIT_V(6); PG8_BAR; PG8_MMA(1, 1, At, B1); PG8_BAR;
            PG8_LDB(B0, 1, 0); PG8_SCHED; PG8_LDA(At, 1, 0); PG8_STAGE(PG8_SA(0, 1), a2 + hstep, voffA);
            PG8_WAIT_L(8); PG8_BAR; PG8_WAIT_L(0); PG8_MMA(0, 0, At, B0); PG8_BAR; PG8_SCHED;
            PG8_LDB(B1, 1, 1); PG8_STAGE(PG8_SB(1, 0), b3, voffB);
            PG8_BAR; PG8_WAIT_L(0); PG8_MMA(0, 1, At, B1); PG8_BAR;
            PG8_LDA(At, 1, 1); PG8_STAGE(PG8_SA(1, 0), a3, voffA);
            PG8_BAR; PG8_WAIT_L(0); PG8_MMA(1, 0, At, B0); PG8_BAR; PG8_SCHED;
            PG8_STAGE(PG8_SB(1, 1), b3 + hstep, voffB);
            PG8_WAIT_V(6); PG8_BAR; PG8_MMA(1, 1, At, B1); PG8_BAR;
            }
        }
        if constexpr (ALIGN_EPI) { if (wr == 0) PG8_BAR; }
        if constexpr (I8) {
#pragma unroll
            for (int a = 0; a < 2; ++a)
#pragma unroll
                for (int b = 0; b < 2; ++b)
#pragma unroll
                    for (int m = 0; m < 4; ++m)
#pragma unroll
                        for (int n = 0; n < 2; ++n) acc[a][b][m][n] = __builtin_convertvector(__builtin_bit_cast(i32x4, acc[a][b][m][n]), f32x4);
        }
        if constexpr (!Epi::AFTER_DRAIN) { E(acc, cur, wr, wc, fr, fq); S.done(cur); }
        if (!has_next) break;
#pragma unroll
        for (int a = 0; a < 2; ++a)
#pragma unroll
            for (int b = 0; b < 2; ++b)
#pragma unroll
                for (int m = 0; m < 4; ++m)
#pragma unroll
                    for (int n = 0; n < 2; ++n) acc[a][b][m][n] = (f32x4){0.f, 0.f, 0.f, 0.f};
        cur = nxt; cA = nA; cB = nB; ++ui;
        if constexpr (ALIGN_EPI) { if (wr == 1) PG8_BAR; }
    }
    PG8_WAIT_V(0);
    if constexpr (!ALIGN_EPI) { if (wr == 0) PG8_BAR; }
    PG8_BAR;
    if constexpr (Epi::AFTER_DRAIN) { E.fused(acc, cur, wr, wc, fr, fq, lds, wid, lane); S.done(cur); }
#undef PG8_SA
#undef PG8_SB
#undef PG8_STAGE
#undef PG8_LDA
#undef PG8_LDB
#undef PG8_MMA
#undef PG8_WAIT_V
#undef PG8_WAIT_L
#undef PG8_BAR
#undef PG8_SCHED
}
struct EpiResid {
    static constexpr bool PERM = true, AFTER_DRAIN = false;
    const float* resid; float* out;
    __device__ __forceinline__ void operator()(const f32x4 (&acc)[2][2][4][2], const Unit& u, int wr, int wc, int fr, int fq) const {
        const size_t base = (size_t)(u.pm * BM + wr * 64 + fr) * DM + u.pn * BM + wc * 32 + 8 * fq;
#pragma unroll
        for (int ai = 0; ai < 2; ++ai) {
            f32x4 rv[4][2][2];
#pragma unroll
            for (int m = 0; m < 4; ++m)
#pragma unroll
                for (int bj = 0; bj < 2; ++bj) {
                    const float* rp = resid + base + (size_t)(ai * HALF + m * 16) * DM + bj * HALF;
                    rv[m][bj][0] = *(const f32x4*)rp; rv[m][bj][1] = *(const f32x4*)(rp + 4);
                }
            asm volatile("" ::: "memory");
#pragma unroll
            for (int m = 0; m < 4; ++m)
#pragma unroll
                for (int bj = 0; bj < 2; ++bj) {
                    float* op = out + base + (size_t)(ai * HALF + m * 16) * DM + bj * HALF;
                    *(f32x4*)op = rv[m][bj][0] + acc[ai][bj][m][0]; *(f32x4*)(op + 4) = rv[m][bj][1] + acc[ai][bj][m][1];
                }
            asm volatile("" ::: "memory");
        }
    }
};
struct EpiProj {
    static constexpr bool PERM = true, AFTER_DRAIN = false;
    const float* aq; const float* ak; const float* bq; const float* bk; bf16_t* proj; PG8_LAS float* xs;
    __device__ __forceinline__ void operator()(const f32x4 (&acc)[2][2][4][2], const Unit& u, int wr, int wc, int fr, int fq) const {
        const int wave = wr * 4 + wc;
#pragma unroll
        for (int ai = 0; ai < 2; ++ai)
#pragma unroll
            for (int m = 0; m < 4; ++m)
#pragma unroll
                for (int bj = 0; bj < 2; ++bj) {
                    const f32x4 a = acc[ai][bj][m][0], b = acc[ai][bj][m][1];
                    float t = a[0] * a[0] + a[1] * a[1] + a[2] * a[2] + a[3] * a[3] + b[0] * b[0] + b[1] * b[1] + b[2] * b[2] + b[3] * b[3];
                    t += __shfl_xor(t, 16); t += __shfl_xor(t, 32);
                    if (fq == 0) xs[wave * 256 + ((ai * 4 + m) * 2 + bj) * 16 + fr] = t;
                }
        asm volatile("s_waitcnt lgkmcnt(0)" ::: "memory");
        __builtin_amdgcn_s_barrier();
#pragma unroll
        for (int bj = 0; bj < 2; ++bj) {
            const int gcol = u.pn * BM + bj * HALF + wc * 32 + 8 * fq;
            const float* gain = nullptr; float scale = 1.f;
            if (gcol < 512) { gain = aq + (gcol & 63); scale = 0.125f; }
            else if (gcol < 1024) gain = ak + (gcol & 63);
            else if (gcol < 1536) gain = nullptr;
            else if (gcol < 2048) { gain = bq + (gcol & 127); scale = 0.125f; }
            else if (gcol < 2560) gain = bk + (gcol & 127);
            f32x4 g0 = {1.f, 1.f, 1.f, 1.f}, g1 = {1.f, 1.f, 1.f, 1.f};
            if (gain) { g0 = *(const f32x4*)gain; g1 = *(const f32x4*)(gain + 4); }
#pragma unroll
            for (int ai = 0; ai < 2; ++ai)
#pragma unroll
                for (int m = 0; m < 4; ++m) {
                    float sc = 1.f;
                    if (gain) {
                        const int slot = ((ai * 4 + m) * 2 + bj) * 16 + fr;
                        sc = rsqrtf((xs[wave * 256 + slot] + xs[(wave ^ 1) * 256 + slot]) * (1.f / 64.f) + EPSN) * scale;
                    }
                    const f32x4 v0 = acc[ai][bj][m][0] * g0 * sc, v1 = acc[ai][bj][m][1] * g1 * sc;
                    u32x4 w; w.x = pack2(v0[0], v0[1]); w.y = pack2(v0[2], v0[3]); w.z = pack2(v1[0], v1[1]); w.w = pack2(v1[2], v1[3]);
                    *(u32x4*)(proj + (size_t)(u.pm * BM + ai * HALF + wr * 64 + m * 16 + fr) * ATT_IN + gcol) = w;
                }
        }
    }
};
struct EpiSgu {
    static constexpr bool PERM = true, AFTER_DRAIN = false;
    bf16_t* zu; bf16_t* zvt; float* ssq; PG8_LAS unsigned char* stg;
    __device__ __forceinline__ void operator()(const f32x4 (&acc)[2][2][4][2], const Unit& u, int wr, int wc, int fr, int fq) const {
        const int wave = wr * 4 + wc, lane = fq * 16 + fr;
        PG8_LAS unsigned short* tl = (PG8_LAS unsigned short*)(stg + wave * 2048);
#pragma unroll
        for (int ai = 0; ai < 2; ++ai)
#pragma unroll
            for (int bj = 0; bj < 2; ++bj) {
                const int gcol = u.pn * BM + bj * HALF + wc * 32 + 8 * fq;
                f32x4 g0[4], g1[4];
#pragma unroll
                for (int m = 0; m < 4; ++m) {
                    const f32x4 a = acc[ai][bj][m][0], b = acc[ai][bj][m][1];
                    g0[m] = (f32x4){gelu_tanh(a[0]), gelu_tanh(a[1]), gelu_tanh(a[2]), gelu_tanh(a[3])};
                    g1[m] = (f32x4){gelu_tanh(b[0]), gelu_tanh(b[1]), gelu_tanh(b[2]), gelu_tanh(b[3])};
                }
                if (gcol < CW) {
#pragma unroll
                    for (int m = 0; m < 4; ++m) {
                        u32x4 w; w.x = pack2(g0[m][0], g0[m][1]); w.y = pack2(g0[m][2], g0[m][3]); w.z = pack2(g1[m][0], g1[m][1]); w.w = pack2(g1[m][2], g1[m][3]);
                        *(u32x4*)(zu + (size_t)(u.pm * BM + ai * HALF + wr * 64 + m * 16 + fr) * CW + gcol) = w;
                    }
                } else {
                    const int vcol = gcol - CW;
#pragma unroll
                    for (int m = 0; m < 4; ++m) {
                        float t = g0[m][0] * g0[m][0] + g0[m][1] * g0[m][1] + g0[m][2] * g0[m][2] + g0[m][3] * g0[m][3]
                                + g1[m][0] * g1[m][0] + g1[m][1] * g1[m][1] + g1[m][2] * g1[m][2] + g1[m][3] * g1[m][3];
                        t += __shfl_xor(t, 16); t += __shfl_xor(t, 32);
                        if (fq == 0) ssq[(size_t)(u.pm * BM + ai * HALF + wr * 64 + m * 16 + fr) * 64 + (vcol >> 5)] = t;
                    }
#pragma unroll
                    for (int h = 0; h < 2; ++h) {
#pragma unroll
                        for (int mm = 0; mm < 2; ++mm) {
                            const int m = 2 * h + mm, rl = 16 * mm + fr;
#pragma unroll
                            for (int j = 0; j < 4; ++j) { tl[(8 * fq + j) * 32 + rl] = f2bf(g0[m][j]); tl[(8 * fq + 4 + j) * 32 + rl] = f2bf(g1[m][j]); }
                        }
                        const int c = lane >> 1, hh = lane & 1;
                        const u32x4 w0 = *(const PG8_LAS u32x4*)(tl + c * 32 + hh * 16), w1 = *(const PG8_LAS u32x4*)(tl + c * 32 + hh * 16 + 8);
                        bf16_t* dst = zvt + ((size_t)(2 * u.pm + ai) * CW + (u.pn * BM - CW) + bj * HALF + wc * 32 + c) * 128 + wr * 64 + 32 * h + hh * 16;
                        *(u32x4*)dst = w0; *(u32x4*)(dst + 8) = w1;
                        asm volatile("" ::: "memory");
                    }
                }
            }
    }
};
struct EpiQ {
    static constexpr bool PERM = true, AFTER_DRAIN = false;
    bf16_t* q;
    __device__ __forceinline__ void operator()(const f32x4 (&acc)[2][2][4][2], const Unit& u, int wr, int wc, int fr, int fq) const {
#pragma unroll
        for (int ai = 0; ai < 2; ++ai)
#pragma unroll
            for (int m = 0; m < 4; ++m)
#pragma unroll
                for (int bj = 0; bj < 2; ++bj) {
                    const f32x4 a = acc[ai][bj][m][0], b = acc[ai][bj][m][1];
                    u32x4 w; w.x = pack2(a[0], a[1]); w.y = pack2(a[2], a[3]); w.z = pack2(b[0], b[1]); w.w = pack2(b[2], b[3]);
                    *(u32x4*)(q + (size_t)(u.pm * BM + ai * HALF + wr * 64 + m * 16 + fr) * 2048 + u.pn * BM + bj * HALF + wc * 32 + 8 * fq) = w;
                }
    }
};
struct EpiQ8 {
    static constexpr bool PERM = true, AFTER_DRAIN = false;
    bf16_t* q; const float* xsc; const float* wsc;
    __device__ __forceinline__ void operator()(const f32x4 (&acc)[2][2][4][2], const Unit& u, int wr, int wc, int fr, int fq) const {
#pragma unroll
        for (int bj = 0; bj < 2; ++bj) {
            const int gcol = u.pn * BM + bj * HALF + wc * 32 + 8 * fq;
            const f32x4 s0 = *(const f32x4*)(wsc + gcol), s1 = *(const f32x4*)(wsc + gcol + 4);
#pragma unroll
            for (int ai = 0; ai < 2; ++ai)
#pragma unroll
                for (int m = 0; m < 4; ++m) {
                    const int row = u.pm * BM + ai * HALF + wr * 64 + m * 16 + fr;
                    const float xs = xsc[row];
                    const f32x4 a = acc[ai][bj][m][0] * s0 * xs, b = acc[ai][bj][m][1] * s1 * xs;
                    u32x4 w; w.x = pack2(a[0], a[1]); w.y = pack2(a[2], a[3]); w.z = pack2(b[0], b[1]); w.w = pack2(b[2], b[3]);
                    *(u32x4*)(q + (size_t)row * 2048 + gcol) = w;
                }
        }
    }
};
}
DI void run_gemmq_pg8(const Params& p, int l, unsigned char* smem) {
    volatile LAS unsigned* st = (volatile LAS unsigned*)(smem + SMEM_BYTES);
    pg8::XcdOrder S; S.init(NTOK / 256, 2048 / 256, (int)st[0], (int)st[1], (int)st[2], (int)st[3]);
    const pg8::Gemm g{(const bf16_t*)WSP(signed char, WS_XQ), (const bf16_t*)(WSP(signed char, WS_W_PQ) + (size_t)l * 2048 * DM), NTOK, 2048, DM};
    pg8::EpiQ8 E; E.q = WSP(bf16_t, WS_QBUF); E.xsc = WSP(float, WS_XSC); E.wsc = WSP(float, WS_WQS) + l * 2048;
    __syncthreads();
    pg8::gemm_phase<pg8::EpiQ8, pg8::XcdOrder, true, true, true>((PG8_LAS unsigned char*)smem, g, S, E);
}
template <int WHICH>
DI void run_gemm_pg8(const Params& p, unsigned char* smem) {
    volatile LAS unsigned* st = (volatile LAS unsigned*)(smem + SMEM_BYTES);
    pg8::XcdOrder S; S.init(NTOK / 256, DM / 256, (int)st[0], (int)st[1], (int)st[2], (int)st[3]);
    pg8::Gemm g;
    pg8::EpiResid E;
    if (WHICH == 0) { g = pg8::Gemm{WSP(bf16_t, WS_MIXED), WSP(bf16_t, WS_W_ATTOUT), NTOK, DM, DM}; E.resid = p.in[0]; E.out = p.out; }
    else { g = pg8::Gemm{WSP(bf16_t, WS_Z_U), WSP(bf16_t, WS_W_SGUOUT), NTOK, DM, CW}; E.resid = p.out; E.out = p.out; }
    __syncthreads();
    pg8::gemm_phase<pg8::EpiResid, pg8::XcdOrder, true, true>((PG8_LAS unsigned char*)smem, g, S, E);
}

DI void run_gemm1_pg8(const Params& p, unsigned char* smem) {
    volatile LAS unsigned* st = (volatile LAS unsigned*)(smem + SMEM_BYTES);
    pg8::XcdOrder S; S.init(NTOK / 256, ATT_IN / 256, (int)st[0], (int)st[1], (int)st[2], (int)st[3]);
    const pg8::Gemm g{WSP(bf16_t, WS_XN), WSP(bf16_t, WS_W_ATTIN), NTOK, ATT_IN, DM};
    pg8::EpiProj E; E.aq = p.in[3]; E.ak = p.in[4]; E.bq = p.in[5]; E.bk = p.in[6]; E.proj = WSP(bf16_t, WS_PROJ); E.xs = (PG8_LAS float*)(smem + PG8_EXTRA);
    __syncthreads();
    pg8::gemm_phase<pg8::EpiProj, pg8::XcdOrder, true, true>((PG8_LAS unsigned char*)smem, g, S, E);
}
DI void run_gemm4_pg8(const Params& p, unsigned char* smem) {
    volatile LAS unsigned* st = (volatile LAS unsigned*)(smem + SMEM_BYTES);
    pg8::XcdOrder S; S.init(NTOK / 256, 4096 / 256, (int)st[0], (int)st[1], (int)st[2], (int)st[3]);
    const pg8::Gemm g{WSP(bf16_t, WS_XN), WSP(bf16_t, WS_W_SGUIN), NTOK, 4096, DM};
    pg8::EpiSgu E; E.zu = WSP(bf16_t, WS_Z_U); E.zvt = WSP(bf16_t, WS_Z_VT); E.ssq = WSP(float, WS_SSQ); E.stg = (PG8_LAS unsigned char*)(smem + PG8_EXTRA);
    __syncthreads();
    pg8::gemm_phase<pg8::EpiSgu, pg8::XcdOrder, true, true>((PG8_LAS unsigned char*)smem, g, S, E);
}

DI u32 cand_key(float s, int ci) { return (f2ord(s) & ~255u) | (u32)(255 - ci); }
template <int P>
DI void score_half(const bf16x8 (&qf)[8], const unsigned char* skl, int fr, int fh, u32 (&lst)[16]) {
#pragma unroll
    for (int j = 0; j < 16; ++j) lst[j] = 0u;
#pragma unroll 1
    for (int kt = 0; kt < 4; ++kt) {
        f32x16 st;
#pragma unroll
        for (int r = 0; r < 16; ++r) st[r] = 0.f;
        const int row = P * 128 + kt * 32 + fr;
        const unsigned char* skr = skl + row * 256;
#pragma unroll
        for (int ks = 0; ks < 8; ++ks) st = MFMA32(*(const bf16x8*)(skr + (((2 * ks + fh) ^ (row & 15)) << 4)), qf[ks], st);
        u32 ks_[16];
#pragma unroll
        for (int r = 0; r < 16; ++r) ks_[r] = (f2ord(st[r]) & ~127u) | (u32)(127 - (kt * 32 + crow(r, fh)));
        sort16_desc(ks_);
        merge16_desc(lst, ks_);
    }
    u32 other[16];
#pragma unroll
    for (int j = 0; j < 16; ++j) other[j] = (u32)__shfl_xor((int)lst[j], 32);
    merge16_desc(lst, other);
}
DI void run_score(const Params& p, int l, unsigned char* smem) {
    const int tid = otid512(), wave = tid >> 6, lane = tid & 63, fr = lane & 31, fh = lane >> 5;
    int cur_h = -1;
    bf16x8 qa[8], qb[8];
    if ((int)blockIdx.x < 8 * (NTOK / 256)) {
        const int it0 = blockIdx.x;
        const bf16_t* q0 = WSP(bf16_t, WS_QBUF) + (size_t)((it0 >> 3) * 256 + wave * 32 + fr) * 2048 + (it0 & 7) * 256 + 8 * fh;
#pragma unroll
        for (int ks = 0; ks < 8; ++ks) { qa[ks] = *(const bf16x8*)(q0 + 16 * ks); qb[ks] = *(const bf16x8*)(q0 + 128 + 16 * ks); }
    }
#pragma unroll 1
    for (int it = blockIdx.x; it < 8 * (NTOK / 256); it += gridDim.x) {
    const int h = it & 7, oct = it >> 3;
    if (h != cur_h) {
        __syncthreads();
        const bf16_t* skg = WSP(bf16_t, WS_W_SUBK) + ((size_t)l * 16 + h * 2) * 128 * 128;
#pragma unroll
        for (int i = 0; i < 8; ++i) {
            const int idx = wave * 8 + i;
            const int row = 4 * idx + (lane >> 4), cp = lane & 15;
            __builtin_amdgcn_global_load_lds((const unsigned*)(skg + (size_t)row * 128 + ((cp ^ (row & 15)) << 3)), (unsigned*)(smem + idx * 1024 + lane * 16), 16, 0, 0);
        }
        asm volatile("s_waitcnt vmcnt(0)" ::: "memory");
        __syncthreads();
        cur_h = h;
    }
    const int tok = oct * 256 + wave * 32 + fr;
    const unsigned char* skh = smem;
    u32 L0[16], L1[16];
    score_half<0>(qa, skh, fr, fh, L0);
    score_half<1>(qb, skh, fr, fh, L1);
    {
        const int itn = it + gridDim.x < 8 * (NTOK / 256) ? it + gridDim.x : it;
        const bf16_t* qn = WSP(bf16_t, WS_QBUF) + (size_t)((itn >> 3) * 256 + wave * 32 + fr) * 2048 + (itn & 7) * 256 + 8 * fh;
#pragma unroll
        for (int ks = 0; ks < 8; ++ks) { qa[ks] = *(const bf16x8*)(qn + 16 * ks); qb[ks] = *(const bf16x8*)(qn + 128 + 16 * ks); }
    }
    LAS int* slot = (LAS int*)(smem + 65536 + wave * (64 * 132)) + lane * 33;
    float s1[16], s2[16];
#pragma unroll
    for (int j = 0; j < 16; ++j) {
        s1[j] = ord2f(L0[j] & ~127u); s2[j] = ord2f(L1[j] & ~127u);
        slot[j] = 127 - (int)(L0[j] & 127u); slot[16 + j] = 127 - (int)(L1[j] & 127u);
    }
    u32 lst[16];
#pragma unroll
    for (int j = 0; j < 16; ++j) lst[j] = cand_key(s1[0] + s2[j], j);
#pragma unroll
    for (int i = 1; i < 5; ++i) {
        u32 row[16];
#pragma unroll
        for (int j = 0; j < 16; ++j) row[j] = ((i + 1) * (j + 1) <= 16) ? cand_key(s1[i] + s2[j], i * 16 + j) : 0u;
        merge16_desc(lst, row);
    }
#pragma unroll
    for (int i = 5; i < 16; ++i)
#pragma unroll
        for (int j = 0; j < 2; ++j)
            if ((i + 1) * (j + 1) <= 16) top16_insert(lst, cand_key(s1[i] + s2[j], i * 16 + j));
    float pv[16]; float sum = 0.f;
    const float mx = ord2f(lst[0] & ~255u);
#pragma unroll
    for (int j = 0; j < 16; ++j) { pv[j] = __expf(ord2f(lst[j] & ~255u) - mx); sum += pv[j]; }
    const float inv = 1.f / sum;
    int ev[16];
#pragma unroll
    for (int j = 0; j < 16; ++j) {
        const int ci = 255 - (int)(lst[j] & 255u);
        ev[j] = slot[ci >> 4] * 128 + slot[16 + (ci & 15)];
    }
    if (fh == 0) {
        int4* ro = (int4*)(WSP(int, WS_RIDX) + (size_t)tok * 128 + h * 16);
        float4* go = (float4*)(WSP(float, WS_RG) + (size_t)tok * 128 + h * 16);
#pragma unroll
        for (int q = 0; q < 4; ++q) {
            ro[q] = make_int4(ev[4 * q], ev[4 * q + 1], ev[4 * q + 2], ev[4 * q + 3]);
            go[q] = make_float4(pv[4 * q] * inv, pv[4 * q + 1] * inv, pv[4 * q + 2] * inv, pv[4 * q + 3] * inv);
        }
    }
    }
}


#define OSM_THR 8.0f
DI void osm_update(f32x16& s, unsigned vm, float& m, float& lh, float& alpha) {
    float mx = -1e30f;
#pragma unroll
    for (int r = 0; r < 16; ++r) mx = ((vm >> r) & 1u) ? fmaxf(mx, s[r]) : mx;
    mx = fmaxf(mx, __shfl_xor(mx, 32));
    float mn = m; alpha = 1.f;
    if (!__all(mx <= m + OSM_THR)) { mn = fmaxf(m, mx); alpha = __expf(m - mn); }
    float ls = 0.f;
#pragma unroll
    for (int r = 0; r < 16; ++r) { const float pe = ((vm >> r) & 1u) ? __expf(s[r] - mn) : 0.f; s[r] = pe; ls += pe; }
    lh = lh * alpha + ls; m = mn;
}
DI void osm_update_full(f32x16& s, float& m, float& lh, float& alpha) {
    float mx = s[0];
#pragma unroll
    for (int r = 1; r < 16; ++r) mx = fmaxf(mx, s[r]);
    mx = fmaxf(mx, __shfl_xor(mx, 32));
    float mn = m; alpha = 1.f;
    if (!__all(mx <= m + OSM_THR)) { mn = fmaxf(m, mx); alpha = __expf(m - mn); }
    float ls = 0.f;
#pragma unroll
    for (int r = 0; r < 16; ++r) { const float pe = __expf(s[r] - mn); s[r] = pe; ls += pe; }
    lh = lh * alpha + ls; m = mn;
}
DI void tr_quad(const unsigned (&a)[4], unsigned hi_off, bf16x8 (&f)[4]) {
    s16x4 l0, h0, l1, h1, l2, h2, l3, h3;
    const unsigned b0 = a[0] + hi_off, b1 = a[1] + hi_off, b2 = a[2] + hi_off, b3 = a[3] + hi_off;
    asm volatile("ds_read_b64_tr_b16 %0, %8\n\tds_read_b64_tr_b16 %1, %9\n\tds_read_b64_tr_b16 %2, %10\n\tds_read_b64_tr_b16 %3, %11\n\t"
                 "ds_read_b64_tr_b16 %4, %12\n\tds_read_b64_tr_b16 %5, %13\n\tds_read_b64_tr_b16 %6, %14\n\tds_read_b64_tr_b16 %7, %15\n\ts_waitcnt lgkmcnt(0)"
                 : "=&v"(l0), "=&v"(h0), "=&v"(l1), "=&v"(h1), "=&v"(l2), "=&v"(h2), "=&v"(l3), "=&v"(h3)
                 : "v"(a[0]), "v"(b0), "v"(a[1]), "v"(b1), "v"(a[2]), "v"(b2), "v"(a[3]), "v"(b3) : "memory");
    f[0] = __builtin_shufflevector(l0, h0, 0, 1, 2, 3, 4, 5, 6, 7); f[1] = __builtin_shufflevector(l1, h1, 0, 1, 2, 3, 4, 5, 6, 7);
    f[2] = __builtin_shufflevector(l2, h2, 0, 1, 2, 3, 4, 5, 6, 7); f[3] = __builtin_shufflevector(l3, h3, 0, 1, 2, 3, 4, 5, 6, 7);
}

#define QB_BYTES (128 * 256)
#define KB_BYTES (32 * 256)
template <bool WITH_V>
DI void attnB_stage_kv(const bf16_t* __restrict__ kg  , unsigned char* Kd, unsigned char* Vd, int wave, int lane) {
#pragma unroll
    for (int i = 0; i < 2; ++i) {
        const int idx = wave * 2 + i;
        const int key = 4 * idx + (lane >> 4), cp = lane & 15;
        const bf16_t* g = kg + (size_t)key * ATT_IN;
        __builtin_amdgcn_global_load_lds((const unsigned*)(g + ((cp ^ (key & 15)) << 3)), (unsigned*)(Kd + idx * 1024 + lane * 16), 16, 0, 0);
        if (WITH_V) {
            const int cv = ((((cp >> 2) ^ (key & 3)) << 2) | (cp & 3));
            __builtin_amdgcn_global_load_lds((const unsigned*)(g + 512 + (cv << 3)), (unsigned*)(Vd + idx * 1024 + lane * 16), 16, 0, 0);
        }
    }
}
template <int KOFF, bool FULL>
DI void attnB_map(const unsigned char* Kc, const unsigned char* qlp, int ksw, int qsw, int fh, unsigned vm, unsigned vc, int tq,
                  float& m, float& l, f32x16 (&o)[4]) {
    f32x16 st;
#pragma unroll
    for (int r = 0; r < 16; ++r) st[r] = 0.f;
#pragma unroll
    for (int s = 0; s < 4; ++s) {
        const bf16x8 kf = *(const bf16x8*)(Kc + (((KOFF + 2 * s + fh) ^ ksw) << 4));
        const bf16x8 qf = *(const bf16x8*)(qlp + (((KOFF + 2 * s + fh) ^ qsw) << 4));
        st = MFMA32(kf, qf, st);
    }
    float al;
    if (FULL) osm_update_full(st, m, l, al); else osm_update(st, vm, m, l, al);
    if (!__all(al == 1.f)) {
#pragma unroll
        for (int d = 0; d < 4; ++d)
#pragma unroll
            for (int r = 0; r < 16; ++r) o[d][r] *= al;
    }
#pragma unroll
    for (int s = 0; s < 2; ++s) {
        const bf16x8 pf = pack_p(st, s);
        unsigned va[4]; bf16x8 vf[4];
#pragma unroll
        for (int d = 0; d < 4; ++d) va[d] = vc + s * 16 * 256 + ((d ^ tq) << 6);
        tr_quad(va, 8 * 256, vf);
#pragma unroll
        for (int d = 0; d < 4; ++d) o[d] = MFMA32(vf[d], pf, o[d]);
    }
}
DI void ph_attnB_fast(const Params& p, int item, unsigned char* smem) {
    const bf16_t* proj = WSP(bf16_t, WS_PROJ);
    const int tid = otid(), wave = tid >> 6, lane = tid & 63, fr = lane & 31, fh = lane >> 5;
    const int qt = 15 - (item >> 6), bh = item & 63, b = bh >> 2, h = bh & 3;
    const int q0 = qt * 128;
    const float lam = compute_lam(p, lane);
    const size_t rowbase = (size_t)b * SEQ;
    const int qrow = wave * 32 + fr, qpos = q0 + qrow;
    unsigned char* Ql = smem;
    unsigned char* Kl = smem + QB_BYTES;
    unsigned char* Vl = Kl + 2 * KB_BYTES;
    const bf16_t* kbase = proj + rowbase * ATT_IN + 2048 + h * 128;
    __syncthreads();
#pragma unroll
    for (int i = 0; i < 8; ++i) {
        const int idx = wave * 8 + i;
        const int row = 4 * idx + (lane >> 4), cp = lane & 15;
        __builtin_amdgcn_global_load_lds((const unsigned*)(proj + (rowbase + q0 + row) * ATT_IN + 1536 + h * 128 + ((cp ^ (row & 15)) << 3)),
                                         (unsigned*)(Ql + idx * 1024 + lane * 16), 16, 0, 0);
    }
    attnB_stage_kv<true>(kbase, Kl, Vl, wave, lane);
    const unsigned char* qlp = Ql + qrow * 256;
    const int qsw = qrow & 15, ksw = fr & 15;
    const int nkt = (q0 + 128) / 32;
    const int wlast = q0 + wave * 32 + 31;
    f32x16 o1[4], o2[4];
#pragma unroll
    for (int d = 0; d < 4; ++d)
#pragma unroll
        for (int r = 0; r < 16; ++r) { o1[d][r] = 0.f; o2[d][r] = 0.f; }
    float m1 = -1e30f, m2 = -1e30f, l1 = 0.f, l2 = 0.f;
    const int tq = (lane & 15) >> 2;
    const unsigned vrow = (unsigned)(uintptr_t)Vl + (4 * fh + tq) * 256 + (16 * ((lane >> 4) & 1) + 4 * (lane & 3)) * 2;
    asm volatile("s_waitcnt vmcnt(0)" ::: "memory");
    __syncthreads();
    for (int kt = 0; kt < nkt; ++kt) {
        const int cur = kt & 1;
        if (kt + 1 < nkt) attnB_stage_kv<true>(kbase + (size_t)(kt + 1) * 32 * ATT_IN, Kl + (cur ^ 1) * KB_BYTES, Vl + (cur ^ 1) * KB_BYTES, wave, lane);
        if (kt * 32 <= wlast) {
            const unsigned char* Kc = Kl + cur * KB_BYTES + fr * 256;
            const unsigned vc = vrow + cur * KB_BYTES;
            if (kt * 32 + 31 <= wlast - 31) {
                attnB_map<0, true>(Kc, qlp, ksw, qsw, fh, 0xffffu, vc, tq, m1, l1, o1);
                __builtin_amdgcn_sched_barrier(0);
                attnB_map<8, true>(Kc, qlp, ksw, qsw, fh, 0xffffu, vc, tq, m2, l2, o2);
            } else {
                unsigned vm = 0;
#pragma unroll
                for (int r = 0; r < 16; ++r) vm |= ((kt * 32 + crow(r, fh)) <= qpos) ? (1u << r) : 0u;
                attnB_map<0, false>(Kc, qlp, ksw, qsw, fh, vm, vc, tq, m1, l1, o1);
                __builtin_amdgcn_sched_barrier(0);
                attnB_map<8, false>(Kc, qlp, ksw, qsw, fh, vm, vc, tq, m2, l2, o2);
            }
        }
        asm volatile("s_waitcnt vmcnt(0)" ::: "memory");
        __syncthreads();
    }
    l1 += __shfl_xor(l1, 32); l2 += __shfl_xor(l2, 32);
    const float i1 = 1.f / l1, i2 = lam / l2;
    float ss = 0.f;
#pragma unroll
    for (int d = 0; d < 4; ++d)
#pragma unroll
        for (int r = 0; r < 16; ++r) { const float v = o1[d][r] * i1 - o2[d][r] * i2; o1[d][r] = v; ss += v * v; }
    ss += __shfl_xor(ss, 32);
    const float rinv = rsqrtf(ss * (1.f / 128.f) + EPSN) * 0.8f;
    const float* subg = p.in[11];
    bf16_t* op = WSP(bf16_t, WS_MIXED) + (rowbase + qpos) * DM + 512 + h * 128;
#pragma unroll
    for (int d = 0; d < 4; ++d)
#pragma unroll
        for (int g = 0; g < 4; ++g) {
            const int dim = 32 * d + 8 * g + 4 * fh;
            const float4 gg = *(const float4*)(subg + dim);
            uint2 w;
            w.x = pack2(o1[d][4 * g + 0] * rinv * gg.x, o1[d][4 * g + 1] * rinv * gg.y);
            w.y = pack2(o1[d][4 * g + 2] * rinv * gg.z, o1[d][4 * g + 3] * rinv * gg.w);
            *(uint2*)(op + dim) = w;
        }
}

#define KA_PITCH 128
#define VA_PITCH 192
#define WA_BYTES (32 * KA_PITCH + 32 * VA_PITCH)
template <int MODE>
DI void ph_attnA_fast(const Params& p, int item, unsigned char* smem) {
    const bf16_t* proj = WSP(bf16_t, WS_PROJ);
    const int tid = otid(), wave = tid >> 6, lane = tid & 63, fr = lane & 31, fh = lane >> 5;
    const int c = item & 15, h = (item >> 4) & 7, b = item >> 7;
    const size_t rowbase = (size_t)b * SEQ;
    const int qpos = MODE == 0 ? 128 * c + 32 * wave + fr : 16 * (32 * wave + fr) + c;
    const int pmin = MODE == 0 ? 128 * c + 32 * wave : 512 * wave + c, pmax = pmin + (MODE == 0 ? 31 : 496);
    bf16x8 qf[4];
    {
        const bf16_t* qp = proj + (rowbase + qpos) * ATT_IN + h * 64 + 8 * fh;
#pragma unroll
        for (int s = 0; s < 4; ++s) qf[s] = *(const bf16x8*)(qp + 16 * s);
    }
    f32x16 o[2];
#pragma unroll
    for (int d = 0; d < 2; ++d)
#pragma unroll
        for (int r = 0; r < 16; ++r) o[d][r] = 0.f;
    float m = -1e30f, l = 0.f;
    unsigned char* Kl = smem + wave * WA_BYTES;
    unsigned char* Vl = Kl + 32 * KA_PITCH;
    const unsigned vaddr = (unsigned)(uintptr_t)Vl + (4 * fh + ((lane & 15) >> 2)) * VA_PITCH + (16 * ((lane >> 4) & 1) + 4 * (lane & 3)) * 2;
    const int skey = lane >> 3, sc = lane & 7;
    int br = 0, d = MODE == 0 ? 1 : 16, W = MODE == 0 ? 128 : 2048, cls = MODE == 0 ? 0 : (c & 15);
    int j0 = MODE == 0 ? (pmin < 128 ? 0 : pmin - 128) : 0, jhi = MODE == 0 ? pmax : ((pmax - cls) >> 4);
    const bf16_t* kvbase = proj + rowbase * ATT_IN + 512 + h * 64 + sc * 8;
    uint4 rk0, rk1, rk2, rk3, rv0, rv1, rv2, rv3;
#define A_LOAD(i, RK, RV) do { int kp_ = cls + d * (j0 + skey + 8 * (i)); kp_ = kp_ > SEQ - 1 ? SEQ - 1 : kp_; kp_ = kp_ < 0 ? 0 : kp_; \
        const bf16_t* g_ = kvbase + (size_t)kp_ * ATT_IN; RK = *(const uint4*)g_; RV = *(const uint4*)(g_ + 512); } while (0)
#define A_WRITE(i, RK, RV) do { const int key_ = skey + 8 * (i); *(uint4*)(Kl + key_ * KA_PITCH + ((sc ^ ((key_ >> 1) & 7)) << 4)) = RK; \
        *(uint4*)(Vl + key_ * VA_PITCH + sc * 16) = RV; } while (0)
    A_LOAD(0, rk0, rv0); A_LOAD(1, rk1, rv1); A_LOAD(2, rk2, rv2); A_LOAD(3, rk3, rv3);
#pragma unroll 1
    for (;;) {
        A_WRITE(0, rk0, rv0); A_WRITE(1, rk1, rv1); A_WRITE(2, rk2, rv2); A_WRITE(3, rk3, rv3);
        const int cd = d, cW = W, ccls = cls, cj0 = j0;
        bool more = true;
        j0 += 32;
        if (j0 > jhi) {
            ++br;
            if (MODE == 0 || br == 2) more = false;
            else {
                d = 4; W = 512; cls = c & 3;
                const int lo = pmin - cls - W;
                j0 = lo < 0 ? 0 : lo >> 2;
                jhi = (pmax - cls) >> 2;
            }
        }
        A_LOAD(0, rk0, rv0); A_LOAD(1, rk1, rv1); A_LOAD(2, rk2, rv2); A_LOAD(3, rk3, rv3);
        f32x16 st;
#pragma unroll
        for (int r = 0; r < 16; ++r) st[r] = 0.f;
#pragma unroll
        for (int s = 0; s < 4; ++s) {
            const bf16x8 kf = *(const bf16x8*)(Kl + fr * KA_PITCH + (((2 * s + fh) ^ ((fr >> 1) & 7)) << 4));
            st = MFMA32(kf, qf[s], st);
        }
        float al;
        const int kfirst = ccls + cd * cj0, klast = kfirst + cd * 31;
        if (klast <= pmin && pmax - kfirst <= cW) osm_update_full(st, m, l, al);
        else {
            unsigned vm = 0;
#pragma unroll
            for (int r = 0; r < 16; ++r) {
                const int dist = qpos - (ccls + cd * (cj0 + crow(r, fh)));
                vm |= (dist >= 0 && dist <= cW) ? (1u << r) : 0u;
            }
            osm_update(st, vm, m, l, al);
        }
        if (!__all(al == 1.f)) {
#pragma unroll
            for (int dd = 0; dd < 2; ++dd)
#pragma unroll
                for (int r = 0; r < 16; ++r) o[dd][r] *= al;
        }
        {
            unsigned va[4]; bf16x8 vf[4];
            va[0] = vaddr; va[1] = vaddr + 64; va[2] = vaddr + 16 * VA_PITCH; va[3] = vaddr + 16 * VA_PITCH + 64;
            tr_quad(va, 8 * VA_PITCH, vf);
            const bf16x8 p0 = pack_p(st, 0), p1 = pack_p(st, 1);
            o[0] = MFMA32(vf[0], p0, o[0]); o[1] = MFMA32(vf[1], p0, o[1]);
            o[0] = MFMA32(vf[2], p1, o[0]); o[1] = MFMA32(vf[3], p1, o[1]);
        }
        if (!more) break;
    }
    l += __shfl_xor(l, 32);
    bf16_t* op = WSP(bf16_t, WS_MIXED) + (rowbase + qpos) * DM + h * 64;
    float* lsep = WSP(float, WS_LSE1) + (rowbase + qpos) * 8 + h;
    if (MODE == 0) {
        const float il = 1.f / l;
        if (fh == 0) *lsep = m + __logf(l);
#pragma unroll
        for (int dd = 0; dd < 2; ++dd)
#pragma unroll
            for (int g = 0; g < 4; ++g) {
                const int dim = 32 * dd + 8 * g + 4 * fh;
                uint2 w;
                w.x = pack2(o[dd][4 * g + 0] * il, o[dd][4 * g + 1] * il);
                w.y = pack2(o[dd][4 * g + 2] * il, o[dd][4 * g + 3] * il);
                *(uint2*)(op + dim) = w;
            }
    } else {
        const float lse1 = *lsep;
        const float M = fmaxf(m, lse1);
        const float w23 = __expf(m - M), w1 = __expf(lse1 - M);
        const float iden = 1.f / (l * w23 + w1);
        const float a23 = w23 * iden, a1 = w1 * iden;
        uint2 prev[2][4];
#pragma unroll
        for (int dd = 0; dd < 2; ++dd)
#pragma unroll
            for (int g = 0; g < 4; ++g) prev[dd][g] = *(const uint2*)(op + 32 * dd + 8 * g + 4 * fh);
#pragma unroll
        for (int dd = 0; dd < 2; ++dd)
#pragma unroll
            for (int g = 0; g < 4; ++g) {
                const int dim = 32 * dd + 8 * g + 4 * fh;
                const float p0 = __uint_as_float(prev[dd][g].x << 16), p1 = __uint_as_float(prev[dd][g].x & 0xffff0000u);
                const float p2 = __uint_as_float(prev[dd][g].y << 16), p3 = __uint_as_float(prev[dd][g].y & 0xffff0000u);
                uint2 w;
                w.x = pack2(o[dd][4 * g + 0] * a23 + p0 * a1, o[dd][4 * g + 1] * a23 + p1 * a1);
                w.y = pack2(o[dd][4 * g + 2] * a23 + p2 * a1, o[dd][4 * g + 3] * a23 + p3 * a1);
                *(uint2*)(op + dim) = w;
            }
    }
}
#define NITEM_B 1024
#define NITEM_A 2048
DI void ph_attn_fast(const Params& p, int vb, unsigned char* smem) {
    if (vb < NITEM_B) {
        const int item = vb < 512 ? vb : 512 + (1023 - vb);
        ph_attnB_fast(p, item, smem);
    } else ph_attnA_fast<0>(p, vb - NITEM_B, smem);
}


DI void ph_spatial_fast(const Params& p, int item, unsigned char* smem) {
    const int tid = otid(), wave = tid >> 6, lane = tid & 63, fr = lane & 31, fh = lane >> 5;
    const int wm = wave >> 1, wn = wave & 1;
    const int chunk = item >> 3, g = item & 7;
    bf16_t* u = WSP(bf16_t, WS_Z_U);
    const bf16_t* vt = WSP(bf16_t, WS_Z_VT);
    const float* ssq = WSP(float, WS_SSQ);
    const float* wsp = p.in[16] + (size_t)g * 128 * 128;
    float* rinv = (float*)(smem + 66 * 1024);
    unsigned char* Bt = smem + 32768;
    __syncthreads();
    if (tid < 128) {
        const float4* sp = (const float4*)(ssq + (size_t)(chunk * 128 + tid) * 64);
        float sacc = 0.f;
#pragma unroll
        for (int j = 0; j < 16; ++j) { const float4 q = sp[j]; sacc += (q.x + q.y) + (q.z + q.w); }
        rinv[tid] = rsqrtf(sacc * (1.f / CW) + EPSN);
    }
    const size_t vrow0 = (size_t)chunk * CW + g * 256;
    stage_tile(vt, 128, (int)vrow0, 0, Bt, wave, lane);
    stage_tile(vt, 128, (int)vrow0, 64, Bt + 16384, wave, lane);
    __syncthreads();
#pragma unroll
    for (int i = 0; i < 8; ++i) {
        const int id = tid + 256 * i;
        const int t = id >> 4, sc = id & 15;
        const float4 w0 = *(const float4*)(wsp + t * 128 + sc * 8);
        const float4 w1 = *(const float4*)(wsp + t * 128 + sc * 8 + 4);
        const float4 r0 = *(const float4*)(rinv + sc * 8);
        const float4 r1 = *(const float4*)(rinv + sc * 8 + 4);
        const int s0 = sc * 8;
        uint4 o;
        o.x = pack2(s0 + 0 <= t ? w0.x * r0.x : 0.f, s0 + 1 <= t ? w0.y * r0.y : 0.f);
        o.y = pack2(s0 + 2 <= t ? w0.z * r0.z : 0.f, s0 + 3 <= t ? w0.w * r0.w : 0.f);
        o.z = pack2(s0 + 4 <= t ? w1.x * r1.x : 0.f, s0 + 5 <= t ? w1.y * r1.y : 0.f);
        o.w = pack2(s0 + 6 <= t ? w1.z * r1.z : 0.f, s0 + 7 <= t ? w1.w * r1.w : 0.f);
        const int kt = sc >> 3, c = sc & 7;
        *(uint4*)(smem + kt * 16384 + t * 128 + ((c ^ ((t >> 1) & 7)) << 4)) = o;
    }
#pragma unroll 1
    for (int nt = 0; nt < 2; ++nt) {
        asm volatile("s_waitcnt vmcnt(0)" ::: "memory");
        __syncthreads();
        f32x16 acc[2][2];
#pragma unroll
        for (int i = 0; i < 2; ++i)
#pragma unroll
            for (int j = 0; j < 2; ++j)
#pragma unroll
                for (int r = 0; r < 16; ++r) acc[i][j][r] = 0.f;
#pragma unroll
        for (int kt = 0; kt < 2; ++kt)
#pragma unroll
            for (int s = 0; s < 4; ++s) {
                bf16x8 a[2], b[2];
#pragma unroll
                for (int i = 0; i < 2; ++i) {
                    a[i] = lds_frag(smem + kt * 16384, wm * 64 + i * 32 + fr, 2 * s + fh);
                    b[i] = lds_frag(Bt + kt * 16384, wn * 64 + i * 32 + fr, 2 * s + fh);
                }
#pragma unroll
                for (int i = 0; i < 2; ++i)
#pragma unroll
                    for (int j = 0; j < 2; ++j) acc[i][j] = MFMA32(a[i], b[j], acc[i][j]);
            }
        __syncthreads();
        float* st = (float*)(Bt + wave * (32 * 65 * 4));
#pragma unroll
        for (int i = 0; i < 2; ++i) {
#pragma unroll
            for (int j = 0; j < 2; ++j)
#pragma unroll
                for (int r = 0; r < 16; ++r) st[crow(r, fh) * 65 + j * 32 + fr] = acc[i][j][r];
            const int t = wm * 64 + i * 32 + fr;
            const int c0 = g * 256 + nt * 128 + wn * 64 + fh * 32;
            bf16_t* up = u + (size_t)(chunk * 128 + t) * CW + c0;
            const float bias = p.in[17][g * 128 + t];
            const float* gn = p.in[15] + c0;
            uint4 ur[4];
#pragma unroll
            for (int q = 0; q < 4; ++q) ur[q] = ((const uint4*)up)[q];
#pragma unroll
            for (int q = 0; q < 4; ++q) {
                float uf[8]; unpack8(ur[q], uf);
                const float4 g0 = *(const float4*)(gn + 8 * q), g1 = *(const float4*)(gn + 8 * q + 4);
                const float gg[8] = {g0.x, g0.y, g0.z, g0.w, g1.x, g1.y, g1.z, g1.w};
                float ov[8];
#pragma unroll
                for (int e = 0; e < 8; ++e) ov[e] = uf[e] * (st[fr * 65 + fh * 32 + 8 * q + e] * gg[e] + bias);
                uint4 o; o.x = pack2(ov[0], ov[1]); o.y = pack2(ov[2], ov[3]); o.z = pack2(ov[4], ov[5]); o.w = pack2(ov[6], ov[7]);
                ((uint4*)up)[q] = o;
            }
        }
        if (nt == 0) {
            __syncthreads();
            stage_tile(vt, 128, (int)vrow0 + 128, 0, Bt, wave, lane);
            stage_tile(vt, 128, (int)vrow0 + 128, 64, Bt + 16384, wave, lane);
        }
    }
}

#define XB_TMO      128
#define XB_XCNT(j)  (256  + 64 * (j))
#define XB_XSUB(j)  (1280 + 64 * (j))
#define XB_XGEN(j)  (2304 + 64 * (j))
#define XB_TOP      3328
#define XB_TOPGEN   3392
#define XCD_BAR_WORDS 3456
#define XB_SPIN_CAP (1u << 22)
DI unsigned xb_ld(unsigned* p) { return __hip_atomic_load(p, __ATOMIC_RELAXED, __HIP_MEMORY_SCOPE_AGENT); }
DI unsigned xb_add(unsigned* p, unsigned v) { return __hip_atomic_fetch_add(p, v, __ATOMIC_RELAXED, __HIP_MEMORY_SCOPE_AGENT); }
DI unsigned xb_xcc_id() { return (unsigned)__builtin_amdgcn_s_getreg((3 << 11) | 20) & 0xFu; }
#define XB_SPIN(cond, bar) do { unsigned _sp = 0; while (cond) { __builtin_amdgcn_s_sleep(1); \
    if ((++_sp & 255u) == 0u) { if (xb_ld(&(bar)[XB_TMO])) break; if (_sp > XB_SPIN_CAP) { atomicAdd(&(bar)[XB_TMO], 1u); break; } } } } while (0)
struct XcdBarrier { unsigned* bar; unsigned x; volatile LAS unsigned* st; };
DI XcdBarrier xcd_barrier_post(unsigned* bar, volatile LAS unsigned* st) {
    XcdBarrier b; b.bar = bar; b.x = xb_xcc_id(); b.st = st;
    if (threadIdx.x == 0) st[2] = xb_add(&bar[XB_XCNT(b.x)], 1u);
    return b;
}
DI void xcd_barrier_complete(unsigned* bar, unsigned x, unsigned& nloc, unsigned& nx, unsigned& xi) {
    const unsigned G = gridDim.x * gridDim.y * gridDim.z;
    unsigned sum, cnt, mine, below, sp = 0u;
    for (;;) {
        sum = 0u; cnt = 0u; mine = 0u; below = 0u;
#pragma unroll
        for (unsigned j = 0; j < 16; ++j) { const unsigned c = xb_ld(&bar[XB_XCNT(j)]); sum += c; cnt += (c > 0u) ? 1u : 0u; mine = (j == x) ? c : mine; below += (c > 0u && j < x) ? 1u : 0u; }
        if (sum == G) break;
        __builtin_amdgcn_s_sleep(1);
        if ((++sp & 255u) == 0u) { if (xb_ld(&bar[XB_TMO])) break; if (sp > XB_SPIN_CAP) { atomicAdd(&bar[XB_TMO], 1u); break; } }
    }
    nloc = mine > 0u ? mine : 1u; nx = cnt > 0u ? cnt : 1u; xi = below;
}
DI void xcd_barrier(const XcdBarrier& b) {
    asm volatile("s_waitcnt vmcnt(0)" ::: "memory");
    __syncthreads();
    if (threadIdx.x == 0) {
        unsigned* bar = b.bar;
        __builtin_amdgcn_s_waitcnt(0);
        unsigned nloc = b.st[0], nx = b.st[1];
        if (nloc == 0u) { unsigned xi; xcd_barrier_complete(bar, b.x, nloc, nx, xi); b.st[0] = nloc; b.st[1] = nx; b.st[3] = xi; }
        const unsigned old = xb_add(&bar[XB_XSUB(b.x)], 1u);
        const unsigned gen = old / nloc;
        if (old + 1u == (gen + 1u) * nloc) {
            __builtin_amdgcn_fence(__ATOMIC_RELEASE, "agent");
            asm volatile("s_waitcnt vmcnt(0)" ::: "memory");
            const unsigned og = xb_add(&bar[XB_TOP], 1u);
            const unsigned tg = og / nx;
            if (og + 1u == (tg + 1u) * nx) xb_add(&bar[XB_TOPGEN], 1u);
            else XB_SPIN(xb_ld(&bar[XB_TOPGEN]) == tg, bar);
            __builtin_amdgcn_fence(__ATOMIC_ACQUIRE, "agent");
            xb_add(&bar[XB_XGEN(b.x)], 1u);
            asm volatile("s_waitcnt vmcnt(0)" ::: "memory");
        } else {
            XB_SPIN(xb_ld(&bar[XB_XGEN(b.x)]) == gen, bar);
            __builtin_amdgcn_fence(__ATOMIC_ACQUIRE, "agent");
            asm volatile("s_waitcnt vmcnt(0)" ::: "memory");
        }
    }
    __syncthreads();
}

enum { PH_PREP = 0, PH_GEMM1, PH_ATTN, PH_ATTN2, PH_GEMM2,
       PH_NORM_P0, PH_GEMMQ0, PH_SCORE0, PH_PDOWN0, PH_PCOMB0, PH_PUP0, PH_NORM_SGU,
       PH_GEMM4, PH_SPATIAL, PH_GEMM5,
       PH_NORM_P1, PH_GEMMQ1, PH_SCORE1, PH_PDOWN1, PH_PCOMB1, PH_PUP1, PH_COUNT };

__host__ __device__ constexpr int phase_nvb(int ph) {
    switch (ph) {
        case PH_PREP: return PREP_N;
        case PH_GEMM1: return (ATT_IN / 256) * (NTOK / 256);
        case PH_ATTN: return NITEM_B + NITEM_A;
        case PH_ATTN2: return NITEM_A;
        case PH_GEMM2: return (DM / 256) * (NTOK / 256);
        case PH_NORM_P0: case PH_NORM_P1: case PH_NORM_SGU: return NTOK / 4;
        case PH_GEMMQ0: case PH_GEMMQ1: return 16 * (NTOK / 256);
        case PH_SCORE0: case PH_SCORE1: return (NTOK / 32) * 8 / 4;
        case PH_PCOMB0: case PH_PCOMB1: return NTOK / 4;
        case PH_GEMM4: return (4096 / 256) * (NTOK / 256);
        case PH_SPATIAL: return 256 * 8;
        case PH_GEMM5: return (DM / 256) * (NTOK / 256);
    }
    return 0;
}

template <int PH>
DI void run_vb(const Params& p, int vb, unsigned char* smem) {
    if constexpr (PH == PH_PREP) ph_prep(p, vb, smem);
    else if constexpr (PH == PH_ATTN) ph_attn_fast(p, vb, smem);
    else if constexpr (PH == PH_ATTN2) ph_attnA_fast<1>(p, vb, smem);
    else if constexpr (PH == PH_NORM_P0 || PH == PH_NORM_P1) rmsnorm_rows<true>(p.out, p.in[19] + (PH == PH_NORM_P1 ? DM : 0), WSP(bf16_t, WS_XN), vb, WSP(signed char, WS_XQ), WSP(float, WS_XSC));
    else if constexpr (PH == PH_PCOMB0 || PH == PH_PCOMB1) ph_peer_comb(p, vb, PH == PH_PCOMB1 ? 1 : 0);
    else if constexpr (PH == PH_NORM_SGU) rmsnorm_rows<false>(p.out, p.in[13], WSP(bf16_t, WS_XN), vb);
    else if constexpr (PH == PH_SPATIAL) ph_spatial_fast(p, vb, smem);
}

template <int PH>
DI void run_phase(const Params& p, unsigned char* smem) {
    if constexpr (PH == PH_PDOWN0 || PH == PH_PDOWN1) run_peer_sliced<false>(p, PH == PH_PDOWN1 ? 1 : 0, smem);
    else if constexpr (PH == PH_PUP0 || PH == PH_PUP1) run_peer_sliced<true>(p, PH == PH_PUP1 ? 1 : 0, smem);
    else if constexpr (PH == PH_SCORE0 || PH == PH_SCORE1) run_score(p, PH == PH_SCORE1 ? 1 : 0, smem);
    else if constexpr (PH == PH_GEMMQ0 || PH == PH_GEMMQ1) run_gemmq_pg8(p, PH == PH_GEMMQ1 ? 1 : 0, smem);
    else if constexpr (PH == PH_GEMM1) run_gemm1_pg8(p, smem);
    else if constexpr (PH == PH_GEMM4) run_gemm4_pg8(p, smem);
    else if constexpr (PH == PH_GEMM2) run_gemm_pg8<0>(p, smem);
    else if constexpr (PH == PH_GEMM5) run_gemm_pg8<1>(p, smem);
    else {
        constexpr int nvb = phase_nvb(PH);
        const int g = threadIdx.x >> 8;
        for (int vb = 2 * blockIdx.x; vb < nvb; vb += 2 * gridDim.x)
            if (vb + g < nvb) run_vb<PH>(p, vb + g, smem + g * GROUP_SMEM);
    }
}

template <int PH>
DI void run_from(const Params& p, unsigned char* smem, cg::grid_group& grid, const XcdBarrier& xb) {
    run_phase<PH>(p, smem);
    if constexpr (PH + 1 < PH_COUNT) {
        if constexpr (PH == 1) grid.sync(); else xcd_barrier(xb);
        run_from<PH + 1>(p, smem, grid, xb);
    }
}

__global__ void __launch_bounds__(NTHREADS, 2) k_mega(Params p) {
    extern __shared__ __attribute__((aligned(16))) unsigned char smem[];
    cg::grid_group grid = cg::this_grid();
    volatile LAS unsigned* st = (volatile LAS unsigned*)(smem + SMEM_BYTES);
    if (threadIdx.x == 0) { st[0] = 0u; st[1] = 0u; st[2] = 0u; st[3] = 0u; }
    __syncthreads();
    const XcdBarrier xb = xcd_barrier_post((unsigned*)(p.ws + WS_CTL), st);
    run_from<0>(p, smem, grid, xb);
}


extern "C" void kernel_launch(void* const* d_in, const int* in_sizes, int n_in, void* d_out, int out_size, void* d_ws, size_t ws_size, hipStream_t stream) {
    if (n_in != 24 || ws_size < WS_NEED || in_sizes[0] != NTOK * DM || out_size != NTOK * DM || in_sizes[22] != 2 * NEXP * DM) {
        fprintf(stderr, "kernel_launch: built for x[16,2048,1024] with 24 inputs and >= 512 MiB of workspace; got n_in %d, in0 %d, out %d, ws %zu: nothing launched\n", n_in, in_sizes[0], out_size, ws_size); return; }
    static int grid_blocks = 0;
    if (!grid_blocks) {
        int dev = 0, cus = 0, per_cu = 0;
        (void)hipGetDevice(&dev);
        (void)hipDeviceGetAttribute(&cus, hipDeviceAttributeMultiprocessorCount, dev);
        (void)hipFuncSetAttribute((const void*)k_mega, hipFuncAttributeMaxDynamicSharedMemorySize, SMEM_ALLOC);
        (void)hipOccupancyMaxActiveBlocksPerMultiprocessor(&per_cu, (const void*)k_mega, NTHREADS, SMEM_ALLOC);
        if (per_cu > 1) per_cu = 1;
        if (per_cu < 1) { fprintf(stderr, "kernel_launch: occupancy query returned %d\n", per_cu); per_cu = 1; }
        grid_blocks = cus * per_cu;
    }
    Params p{};
    for (int i = 0; i < 24; ++i) p.in[i] = (const float*)d_in[i];
    p.out = (float*)d_out;
    p.ws = (unsigned char*)d_ws;
    void* args[] = {&p};
    if (hipMemsetAsync((unsigned char*)d_ws + WS_CTL, 0, XCD_BAR_WORDS * 4, stream) != hipSuccess) { fprintf(stderr, "kernel_launch: memset of the barrier words failed\n"); return; }
    hipError_t e = hipLaunchCooperativeKernel((const void*)k_mega, dim3(grid_blocks), dim3(NTHREADS), args, SMEM_ALLOC, stream);
    if (e != hipSuccess) fprintf(stderr, "cooperative launch failed: %s (grid %d)\n", hipGetErrorString(e), grid_blocks);
}
```

```cpp
#include <hip/hip_runtime.h>
#include <stdint.h>
#include <stdio.h>

#define NTOK   32768
#define DM     1024
#define SEQ    2048
#define NB     16
#define ATT_IN 3072
#define CW     2048
#define NEXP   16384
#define EPSN   1e-6f

typedef unsigned short bf16_t;
typedef unsigned int u32;

#define DI __device__ __forceinline__
#define LAS __attribute__((address_space(3)))

DI int otid() { int t = threadIdx.x & 255; asm volatile("" : "+v"(t)); return t; }
DI int otid512() { int t = threadIdx.x; asm volatile("" : "+v"(t)); return t; }
DI float bf2f(bf16_t v) { return __uint_as_float(((u32)v) << 16); }
typedef __bf16 bf16v2 __attribute__((ext_vector_type(2)));
DI bf16_t f2bf(float f) { const __bf16 h = (__bf16)f; return __builtin_bit_cast(bf16_t, h); }
DI u32 pack2(float lo, float hi) { bf16v2 v; v[0] = (__bf16)lo; v[1] = (__bf16)hi; return __builtin_bit_cast(u32, v); }
DI float gelu_tanh(float x) {
    const float y = 0.7978845608028654f * (x + 0.044715f * x * x * x);
    const float e = __expf(2.f * y);
    const float t = 1.f - 2.f / (e + 1.f);
    return 0.5f * x * (1.f + t);
}
DI float wave_sum(float v) {
#pragma unroll
    for (int o = 1; o < 64; o <<= 1) v += __shfl_xor(v, o);
    return v;
}
DI float wave_max(float v) {
#pragma unroll
    for (int o = 1; o < 64; o <<= 1) v = fmaxf(v, __shfl_xor(v, o));
    return v;
}
DI u32 f2ord(float f) { u32 u = __float_as_uint(f); return (u & 0x80000000u) ? ~u : (u | 0x80000000u); }
DI float ord2f(u32 o) { u32 u = (o & 0x80000000u) ? (o & 0x7fffffffu) : ~o; return __uint_as_float(u); }

#define MiB ((size_t)1 << 20)
#define WS_CTL      ((size_t)0)
#define WS_W_ATTIN  (1 * MiB)
#define WS_W_ATTOUT (7 * MiB)
#define WS_W_SGUIN  (9 * MiB)
#define WS_W_SGUOUT (17 * MiB)
#define WS_W_PQ     (21 * MiB)
#define WS_WQS      (25 * MiB)
#define WS_WAS      (25 * MiB + 64 * 1024)
#define WS_WSS      (25 * MiB + 128 * 1024)
#define WS_W_SUBK   (29 * MiB)
#define WS_DOWN     (32 * MiB)
#define WS_UP       (64 * MiB)
#define WS_DSC      (96 * MiB)
#define WS_USC      (96 * MiB + 128 * 1024)
#define WS_LSE1     (30 * MiB)
#define WS_XQ       (100 * MiB)
#define WS_XSC      (132 * MiB)
#define WS_BIG      (224 * MiB)
#define WS_PROJ     (WS_BIG)
#define WS_MIXED    (WS_BIG + 192 * MiB)
#define WS_Z_U      (WS_BIG)
#define WS_Z_VT     (WS_BIG + 128 * MiB)
#define WS_RIDX     (WS_BIG + 32 * MiB)
#define WS_RG       (WS_BIG + 48 * MiB)
#define WS_QBUF     (WS_BIG + 64 * MiB)
#define WS_SSQ      (WS_BIG + 256 * MiB)
#define WS_NEED     (512 * MiB)

struct Params {
    const float* in[24];
    float* out;
    unsigned char* ws;
};

#include <hip/hip_cooperative_groups.h>
namespace cg = cooperative_groups;

#define GROUP_SMEM (68 * 1024)
#define PG8_EXTRA (128 * 1024)
#define SMEM_BYTES (144 * 1024)
#define SMEM_ALLOC (SMEM_BYTES + 16)
#define NTHREADS 512

#define WSP(T, off) ((T*)(p.ws + (off)))


DI void transpose_tile(const float* __restrict__ W, bf16_t* __restrict__ Wt, int K, int N, int t, unsigned char* smem) {
    float* tile = (float*)smem;
    const int tid = otid();
    const int ntn = N / 64;
    const int n0 = (t % ntn) * 64, k0 = (t / ntn) * 64;
    __syncthreads();
    {
        const int n4 = tid & 15, kr = tid >> 4;
#pragma unroll
        for (int i = 0; i < 4; ++i) {
            const int k = kr + 16 * i;
            const float4 v = *(const float4*)(W + (size_t)(k0 + k) * N + n0 + 4 * n4);
            tile[k * 65 + 4 * n4 + 0] = v.x; tile[k * 65 + 4 * n4 + 1] = v.y; tile[k * 65 + 4 * n4 + 2] = v.z; tile[k * 65 + 4 * n4 + 3] = v.w;
        }
    }
    __syncthreads();
    {
        const int n = tid >> 2, kc = tid & 3;
        float v[16];
#pragma unroll
        for (int j = 0; j < 16; ++j) v[j] = tile[(16 * kc + j) * 65 + n];
        uint4 o0, o1;
        o0.x = pack2(v[0], v[1]); o0.y = pack2(v[2], v[3]); o0.z = pack2(v[4], v[5]); o0.w = pack2(v[6], v[7]);
        o1.x = pack2(v[8], v[9]); o1.y = pack2(v[10], v[11]); o1.z = pack2(v[12], v[13]); o1.w = pack2(v[14], v[15]);
        uint4* dst = (uint4*)(Wt + (size_t)(n0 + n) * K + k0 + 16 * kc);
        dst[0] = o0; dst[1] = o1;
    }
}
DI void cvt_chunk(const float* __restrict__ src, bf16_t* __restrict__ dst, int c) {
    const size_t base = (size_t)c * 2048;
#pragma unroll
    for (int i = 0; i < 8; ++i) {
        const size_t idx = base + i * 256 + otid();
        const float4 v = ((const float4*)src)[idx];
        uint2 o; o.x = pack2(v.x, v.y); o.y = pack2(v.z, v.w);
        ((uint2*)dst)[idx] = o;
    }
}
DI int q8(float v) { int i = __float2int_rn(v); i = i > 127 ? 127 : i; i = i < -127 ? -127 : i; return i & 255; }
DI void rmsnorm_rows(const float* __restrict__ x, const float* __restrict__ g, int vb, signed char* xq, float* xsc) {
    const int lane = otid() & 63;
    const int row = vb * 4 + (otid() >> 6);
    const float4* xr = (const float4*)(x + (size_t)row * DM);
    float4 v[4]; float ss = 0.f;
#pragma unroll
    for (int j = 0; j < 4; ++j) { v[j] = xr[lane + 64 * j]; ss += v[j].x * v[j].x + v[j].y * v[j].y + v[j].z * v[j].z + v[j].w * v[j].w; }
    ss = wave_sum(ss);
    const float rinv = rsqrtf(ss * (1.f / DM) + EPSN);
    float am = 0.f;
#pragma unroll
    for (int j = 0; j < 4; ++j) {
        const float4 gg = ((const float4*)g)[lane + 64 * j];
        v[j].x *= rinv * gg.x; v[j].y *= rinv * gg.y; v[j].z *= rinv * gg.z; v[j].w *= rinv * gg.w;
        am = fmaxf(am, fmaxf(fmaxf(fabsf(v[j].x), fabsf(v[j].y)), fmaxf(fabsf(v[j].z), fabsf(v[j].w))));
    }
    am = wave_max(am);
    const float sc = am > 0.f ? 127.f / am : 0.f;
    u32* qrow = (u32*)(xq + (size_t)row * DM);
#pragma unroll
    for (int j = 0; j < 4; ++j)
        qrow[lane + 64 * j] = (u32)q8(v[j].x * sc) | ((u32)q8(v[j].y * sc) << 8) | ((u32)q8(v[j].z * sc) << 16) | ((u32)q8(v[j].w * sc) << 24);
    if (lane == 0) xsc[row] = am * (1.f / 127.f);
}
#define PREP_T0 48
#define PREP_T1 (PREP_T0 + 16 * 16)
#define PREP_T2 (PREP_T1 + 64)
#define PREP_T3 (PREP_T2 + 16 * 32)
#define PREP_T4 (PREP_T3 + 2 * 32)
#define PREP_C0 (PREP_T4 + 64)
#define PREP_C1 (PREP_C0 + 8192)
#define PREP_C2 (PREP_C1 + 8192)
#define PREP_N  (PREP_C2 + 8192)
template <bool INT8>
DI void fp8_rows(const float* __restrict__ src, unsigned char* __restrict__ dst, float* __restrict__ inv_scale, int vb) {
    const int lane = otid() & 63;
    const int row = vb * 4 + (otid() >> 6);
    const float4* sr = (const float4*)(src + (size_t)row * DM) + lane;
    float4 v[4]; float am = 0.f;
#pragma unroll
    for (int j = 0; j < 4; ++j) { v[j] = sr[64 * j]; am = fmaxf(am, fmaxf(fmaxf(fabsf(v[j].x), fabsf(v[j].y)), fmaxf(fabsf(v[j].z), fabsf(v[j].w)))); }
    am = wave_max(am);
    float sc, inv;
    if (INT8) { sc = am > 0.f ? 127.f / am : 0.f; inv = am * (1.f / 127.f); }
    else {
        int e = (int)((__float_as_uint(am) >> 23) & 255u) - 127;
        if (am == 0.f) e = 0;
        e = e < -100 ? -100 : e;
        sc = __uint_as_float((u32)(127 + 7 - e) << 23); inv = __uint_as_float((u32)(127 + e - 7) << 23);
    }
    unsigned char* drow = dst + (size_t)(row >> 14) * NEXP * DM + (size_t)(row & (NEXP - 1)) * 128;
#pragma unroll
    for (int j = 0; j < 4; ++j) {
        const int dim = 4 * (lane + 64 * j);
        u32 w;
        if (INT8) w = (u32)q8(v[j].x * sc) | ((u32)q8(v[j].y * sc) << 8) | ((u32)q8(v[j].z * sc) << 16) | ((u32)q8(v[j].w * sc) << 24);
        else { int t = __builtin_amdgcn_cvt_pk_fp8_f32(v[j].x * sc, v[j].y * sc, 0, false); t = __builtin_amdgcn_cvt_pk_fp8_f32(v[j].z * sc, v[j].w * sc, t, true); w = (u32)t; }
        *(u32*)(drow + (size_t)(dim >> 7) * NEXP * 128 + (dim & 127)) = w;
    }
    if (lane == 0) inv_scale[row] = inv;
}
DI void wq8_item(const float* __restrict__ W, signed char* __restrict__ Wt, float* __restrict__ wsc, int t, unsigned char* smem, int N) {
    float* red = (float*)smem;
    const int tid = otid(), n = tid & 63, kq = tid >> 6;
    const float* col = W + t * 64 + n;
    float am = 0.f;
#pragma unroll 16
    for (int k = 0; k < 256; ++k) am = fmaxf(am, fabsf(col[(size_t)(kq * 256 + k) * N]));
    __syncthreads();
    red[kq * 64 + n] = am;
    __syncthreads();
    am = fmaxf(fmaxf(red[n], red[64 + n]), fmaxf(red[128 + n], red[192 + n]));
    const float sc = am > 0.f ? 127.f / am : 0.f;
    if (kq == 0) wsc[t * 64 + n] = am * (1.f / 127.f);
    signed char* drow = Wt + (size_t)(t * 64 + n) * 1024;
#pragma unroll 1
    for (int kb = 0; kb < 16; ++kb) {
        const int k0 = kb * 64 + kq * 16;
        u32 w[4];
#pragma unroll
        for (int j = 0; j < 4; ++j) {
            const float* c4 = col + (size_t)(k0 + 4 * j) * N;
            w[j] = (u32)q8(c4[0] * sc) | ((u32)q8(c4[N] * sc) << 8) | ((u32)q8(c4[2 * N] * sc) << 16) | ((u32)q8(c4[3 * N] * sc) << 24);
        }
        *(uint4*)(drow + k0) = make_uint4(w[0], w[1], w[2], w[3]);
    }
}
DI void ph_prep(const Params& p, int vb, unsigned char* smem) {
    if (vb < PREP_T0) wq8_item(p.in[2], WSP(signed char, WS_W_ATTIN), WSP(float, WS_WAS), vb, smem, ATT_IN);
    else if (vb < PREP_T1) transpose_tile(p.in[12], WSP(bf16_t, WS_W_ATTOUT), DM, DM, vb - PREP_T0, smem);
    else if (vb < PREP_T2) wq8_item(p.in[14], WSP(signed char, WS_W_SGUIN), WSP(float, WS_WSS), vb - PREP_T1, smem, 4096);
    else if (vb < PREP_T3) transpose_tile(p.in[18], WSP(bf16_t, WS_W_SGUOUT), CW, DM, vb - PREP_T2, smem);
    else if (vb < PREP_T4) { const int t = vb - PREP_T3, l = t / 32; wq8_item(p.in[20] + (size_t)l * DM * 2048, WSP(signed char, WS_W_PQ) + (size_t)l * 2048 * DM, WSP(float, WS_WQS) + l * 2048, t % 32, smem, 2048); }
    else if (vb < PREP_C0) cvt_chunk(p.in[21], WSP(bf16_t, WS_W_SUBK), vb - PREP_T4);
    else if (vb < PREP_C1) fp8_rows<true>(p.in[22], p.ws + WS_DOWN, WSP(float, WS_DSC), vb - PREP_C0);
    else if (vb < PREP_C2) fp8_rows<false>(p.in[23], p.ws + WS_UP, WSP(float, WS_USC), vb - PREP_C1);
    else rmsnorm_rows(p.in[0], p.in[1], vb - PREP_C2, WSP(signed char, WS_XQ), WSP(float, WS_XSC));
}

DI float compute_lam(const Params& p, int lane) {
    const float a = wave_sum(p.in[7][lane] * p.in[8][lane]);
    const float b = wave_sum(p.in[9][lane] * p.in[10][lane]);
    return __expf(a) - __expf(b) + 0.2f;
}
DI void ce_desc(u32& a, u32& b) { const u32 hi = max(a, b), lo = min(a, b); a = hi; b = lo; }
DI void sort16_desc(u32 (&v)[16]) {
#pragma unroll
    for (int k = 2; k <= 16; k <<= 1)
#pragma unroll
        for (int j = k >> 1; j > 0; j >>= 1)
#pragma unroll
            for (int i = 0; i < 16; ++i) {
                const int l = i ^ j;
                if (l > i) { if ((i & k) == 0) ce_desc(v[i], v[l]); else ce_desc(v[l], v[i]); }
            }
}
DI void merge16_desc(u32 (&a)[16], const u32 (&b)[16]) {
#pragma unroll
    for (int i = 0; i < 16; ++i) a[i] = max(a[i], b[15 - i]);
#pragma unroll
    for (int j = 8; j > 0; j >>= 1)
#pragma unroll
        for (int i = 0; i < 16; ++i) { const int l = i ^ j; if (l > i) ce_desc(a[i], a[l]); }
}
DI void top16_insert(u32 (&lst)[16], u32 x) {
#pragma unroll
    for (int j = 0; j < 16; ++j) { const u32 hi = max(lst[j], x); x = min(lst[j], x); lst[j] = hi; }
}
DI void unpack8(const uint4 v, float (&f)[8]) {
    f[0] = __uint_as_float(v.x << 16); f[1] = __uint_as_float(v.x & 0xffff0000u);
    f[2] = __uint_as_float(v.y << 16); f[3] = __uint_as_float(v.y & 0xffff0000u);
    f[4] = __uint_as_float(v.z << 16); f[5] = __uint_as_float(v.z & 0xffff0000u);
    f[6] = __uint_as_float(v.w << 16); f[7] = __uint_as_float(v.w & 0xffff0000u);
}
typedef float f32x2_t __attribute__((ext_vector_type(2)));
DI void unpack16fp8(const uint4 w, float (&f)[16]) {
    f32x2_t t;
    t = __builtin_amdgcn_cvt_pk_f32_fp8((int)w.x, false); f[0] = t[0]; f[1] = t[1];
    t = __builtin_amdgcn_cvt_pk_f32_fp8((int)w.x, true);  f[2] = t[0]; f[3] = t[1];
    t = __builtin_amdgcn_cvt_pk_f32_fp8((int)w.y, false); f[4] = t[0]; f[5] = t[1];
    t = __builtin_amdgcn_cvt_pk_f32_fp8((int)w.y, true);  f[6] = t[0]; f[7] = t[1];
    t = __builtin_amdgcn_cvt_pk_f32_fp8((int)w.z, false); f[8] = t[0]; f[9] = t[1];
    t = __builtin_amdgcn_cvt_pk_f32_fp8((int)w.z, true);  f[10] = t[0]; f[11] = t[1];
    t = __builtin_amdgcn_cvt_pk_f32_fp8((int)w.w, false); f[12] = t[0]; f[13] = t[1];
    t = __builtin_amdgcn_cvt_pk_f32_fp8((int)w.w, true);  f[14] = t[0]; f[15] = t[1];
}
struct PeerPre { int e[16]; uint4 xa, xb; float2 r; };
struct PeerRows { uint4 d[8]; float c[8]; };
template <bool UP>
DI PeerPre peer_prefetch(const Params& p, int tok, int sl, int lane) {
    PeerPre q;
    const int4* rix = (const int4*)(WSP(int, WS_RIDX) + (size_t)tok * 128 + 16 * (lane >> 3));
#pragma unroll
    for (int j = 0; j < 4; ++j) { const int4 t = rix[j]; q.e[4 * j] = t.x; q.e[4 * j + 1] = t.y; q.e[4 * j + 2] = t.z; q.e[4 * j + 3] = t.w; }
    if (UP) {
        q.r = *(const float2*)(p.out + (size_t)tok * DM + sl * 128 + 16 * (lane & 7) + 2 * (lane >> 3));
    } else {
        q.xa = *(const uint4*)(WSP(signed char, WS_XQ) + (size_t)tok * DM + sl * 128 + 16 * (lane & 7));
    }
    return q;
}
template <int HF, bool UP>
DI void peer_issue_rows(const Params& p, const unsigned char* tab, const PeerPre& q, int tok, int lane, PeerRows& R) {
    const unsigned dco = 16u * (unsigned)(lane & 7);
#pragma unroll
    for (int bi = 0; bi < 8; ++bi) R.d[bi] = *(const uint4*)(tab + ((unsigned)q.e[8 * HF + bi] * 128u + dco));
    if (UP) {
        const float4* cf = (const float4*)(WSP(float, WS_RG) + (size_t)tok * 128 + 16 * (lane >> 3) + 8 * HF);
        const float4 c0 = cf[0], c1 = cf[1];
        R.c[0] = c0.x; R.c[1] = c0.y; R.c[2] = c0.z; R.c[3] = c0.w; R.c[4] = c1.x; R.c[5] = c1.y; R.c[6] = c1.z; R.c[7] = c1.w;
    }
}
template <int HF>
DI void peer_down_half(const PeerPre& q, const PeerRows& R, float (&part)[16]) {
#pragma unroll
    for (int bi = 0; bi < 8; ++bi) {
        int a = __builtin_amdgcn_sdot4((int)R.d[bi].x, (int)q.xa.x, 0, false);
        a = __builtin_amdgcn_sdot4((int)R.d[bi].y, (int)q.xa.y, a, false);
        a = __builtin_amdgcn_sdot4((int)R.d[bi].z, (int)q.xa.z, a, false);
        a = __builtin_amdgcn_sdot4((int)R.d[bi].w, (int)q.xa.w, a, false);
        part[8 * HF + bi] = (float)a;
    }
}
DI void peer_down_fin(const Params& p, const float (&part)[16], int tok, int sl, int lane) {
    const bool b2 = lane & 4, b1 = lane & 2, b0 = lane & 1;
    float r8[8], r4[4], r2[2];
#pragma unroll
    for (int i = 0; i < 8; ++i) { const float snd = b2 ? part[i] : part[i + 8]; const float kp = b2 ? part[i + 8] : part[i]; r8[i] = kp + __shfl_xor(snd, 4); }
#pragma unroll
    for (int i = 0; i < 4; ++i) { const float snd = b1 ? r8[i] : r8[i + 4]; const float kp = b1 ? r8[i + 4] : r8[i]; r4[i] = kp + __shfl_xor(snd, 2); }
#pragma unroll
    for (int i = 0; i < 2; ++i) { const float snd = b0 ? r4[i] : r4[i + 2]; const float kp = b0 ? r4[i + 2] : r4[i]; r2[i] = kp + __shfl_xor(snd, 1); }
    u32* pd = WSP(u32, WS_QBUF) + ((size_t)tok * 8 + sl) * 64;
    pd[lane] = pack2(r2[0], r2[1]);
}
DI void ph_peer_comb(const Params& p, int vb, int l) {
    const int tid = otid(), lane = tid & 63;
    const int tok = vb * 4 + (tid >> 6);
    const u32* pd = WSP(u32, WS_QBUF) + (size_t)tok * 8 * 64;
    const int* rix = WSP(int, WS_RIDX) + (size_t)tok * 128;
    float* rgp = WSP(float, WS_RG) + (size_t)tok * 128;
    const float* dsc = WSP(float, WS_DSC) + (size_t)l * NEXP;
    const float* usc = WSP(float, WS_USC) + (size_t)l * NEXP;
    const float xs = WSP(float, WS_XSC)[tok];
    float t0 = 0.f, t1 = 0.f;
#pragma unroll
    for (int sl = 0; sl < 8; ++sl) { const u32 w = pd[sl * 64 + lane]; t0 += __uint_as_float(w << 16); t1 += __uint_as_float(w & 0xffff0000u); }
    const int2 e = *(const int2*)(rix + 2 * lane);
    float2 g = *(const float2*)(rgp + 2 * lane);
    g.x = g.x * gelu_tanh(t0 * dsc[e.x] * xs) * usc[e.x];
    g.y = g.y * gelu_tanh(t1 * dsc[e.y] * xs) * usc[e.y];
    *(float2*)(rgp + 2 * lane) = g;
}
template <int HF>
DI void peer_up_half(const PeerPre& q, const PeerRows& R, float (&y)[16]) {
#pragma unroll
    for (int bi = 0; bi < 8; ++bi) {
        const float c = R.c[bi];
        float w[16]; unpack16fp8(R.d[bi], w);
#pragma unroll
        for (int i = 0; i < 16; ++i) y[i] += c * w[i];
        asm volatile("" : "+v"(y[0]), "+v"(y[1]), "+v"(y[2]), "+v"(y[3]), "+v"(y[4]), "+v"(y[5]), "+v"(y[6]), "+v"(y[7]), "+v"(y[8]), "+v"(y[9]), "+v"(y[10]), "+v"(y[11]), "+v"(y[12]), "+v"(y[13]), "+v"(y[14]), "+v"(y[15]));
    }
}
DI void peer_up_fin(const Params& p, const PeerPre& q, const float (&y)[16], int tok, int sl, int lane) {
    const int rg = lane >> 3, dc = lane & 7;
    const bool b5 = lane & 32, b4 = lane & 16, b3 = lane & 8;
    float r8[8], r4[4], r2[2];
#pragma unroll
    for (int i = 0; i < 8; ++i) { const float snd = b5 ? y[i] : y[i + 8]; const float kp = b5 ? y[i + 8] : y[i]; r8[i] = kp + __shfl_xor(snd, 32); }
#pragma unroll
    for (int i = 0; i < 4; ++i) { const float snd = b4 ? r8[i] : r8[i + 4]; const float kp = b4 ? r8[i + 4] : r8[i]; r4[i] = kp + __shfl_xor(snd, 16); }
#pragma unroll
    for (int i = 0; i < 2; ++i) { const float snd = b3 ? r4[i] : r4[i + 2]; const float kp = b3 ? r4[i + 2] : r4[i]; r2[i] = kp + __shfl_xor(snd, 8); }
    float2 v = q.r;
    v.x += r2[0]; v.y += r2[1];
    *(float2*)(p.out + (size_t)tok * DM + sl * 128 + 16 * dc + 2 * rg) = v;
}
template <bool UP>
DI void run_peer_sliced(const Params& p, int l, unsigned char* smem) {
    volatile LAS unsigned* st = (volatile LAS unsigned*)(smem + SMEM_BYTES);
    const int nloc = (int)st[0], nx = (int)st[1], rank = (int)st[2], xi = (int)st[3];
    const int tid = otid512(), lane = tid & 63, wave = tid >> 6;
    const int stride = nloc * 8;
#pragma unroll 1
    for (int sl = xi; sl < 8; sl += nx) {
        const unsigned char* tab = p.ws + (UP ? WS_UP : WS_DOWN) + (size_t)l * NEXP * DM + (size_t)sl * NEXP * 128;
        int tok = rank * 8 + wave;
        if (tok >= NTOK) continue;
        PeerPre qc = peer_prefetch<UP>(p, tok, sl, lane);
        PeerRows R;
        peer_issue_rows<0, UP>(p, tab, qc, tok, lane, R);
#pragma unroll 1
        for (; tok < NTOK; tok += stride) {
            const int tn = tok + stride < NTOK ? tok + stride : tok;
            const PeerPre qn = peer_prefetch<UP>(p, tn, sl, lane);
            float acc[16];
#pragma unroll
            for (int i = 0; i < 16; ++i) acc[i] = 0.f;
            PeerRows Rn;
            peer_issue_rows<1, UP>(p, tab, qc, tok, lane, Rn);
            __builtin_amdgcn_sched_barrier(0);
            if (UP) peer_up_half<0>(qc, R, acc); else peer_down_half<0>(qc, R, acc);
            __builtin_amdgcn_sched_barrier(0);
            peer_issue_rows<0, UP>(p, tab, qn, tn, lane, R);
            __builtin_amdgcn_sched_barrier(0);
            if (UP) { peer_up_half<1>(qc, Rn, acc); peer_up_fin(p, qc, acc, tok, sl, lane); }
            else { peer_down_half<1>(qc, Rn, acc); peer_down_fin(p, acc, tok, sl, lane); }
            __builtin_amdgcn_sched_barrier(0);
            qc = qn;
        }
    }
}


typedef short bf16x8 __attribute__((ext_vector_type(8)));
typedef float f32x16 __attribute__((ext_vector_type(16)));
#define MFMA32(a, b, c) __builtin_amdgcn_mfma_f32_32x32x16_bf16((a), (b), (c), 0, 0, 0)
typedef short s16x4 __attribute__((ext_vector_type(4)));
DI bf16x8 pack_p(const f32x16& pt, int s) {
    uint4 o;
    o.x = pack2(pt[8 * s + 0], pt[8 * s + 1]); o.y = pack2(pt[8 * s + 2], pt[8 * s + 3]);
    o.z = pack2(pt[8 * s + 4], pt[8 * s + 5]); o.w = pack2(pt[8 * s + 6], pt[8 * s + 7]);
    return __builtin_bit_cast(bf16x8, o);
}

DI void stage_tile(const bf16_t* __restrict__ g, int ld, int row0, int k0, unsigned char* lt, int wave, int lane) {
#pragma unroll
    for (int i = 0; i < 4; ++i) {
        const int inst = wave * 4 + i;
        const int row = inst * 8 + (lane >> 3);
        const int c = (lane & 7) ^ ((row >> 1) & 7);
        __builtin_amdgcn_global_load_lds((const unsigned*)(g + (size_t)(row0 + row) * ld + k0 + c * 8),
                                         (unsigned*)(lt + inst * 1024 + lane * 16), 16, 0, 0);
    }
}
DI bf16x8 lds_frag(const unsigned char* lt, int row, int c) {
    return *(const bf16x8*)(lt + row * 128 + ((c ^ ((row >> 1) & 7)) << 4));
}
DI int crow(int r, int fh) { return (r & 3) + 8 * (r >> 2) + 4 * fh; }

namespace pg8 {
#define PG8_LAS __attribute__((address_space(3)))
typedef float f32x4 __attribute__((ext_vector_type(4)));
typedef unsigned u32x4 __attribute__((ext_vector_type(4)));
constexpr int BM = 256, BK = 64, HALF = 128, HTB = HALF * BK * 2  , STAGE_BYTES = 8 * HTB;
__host__ __device__ __forceinline__ int lds_byte(int r, int c) { const int st = (r >> 4) * 2 + (c >> 5), rr = r & 15, cc = c & 31, ob = rr * 64 + cc * 2; return st * 1024 + (ob ^ (((ob >> 9) & 1) << 5)); }
__host__ __device__ __forceinline__ void stage_rc(int b, int& R, int& C) { const int st = b / 1024, sb = b % 1024, swz = sb ^ (((sb >> 9) & 1) << 5); R = (st >> 1) * 16 + swz / 64; C = (st & 1) * 32 + (swz % 64) / 2; }
__host__ __device__ __forceinline__ int perm32(int rho) { const int n = rho >> 4, i = rho & 15; return 8 * (i >> 2) + 4 * n + (i & 3); }
struct Unit { int pm, pn; };
struct Gemm { const void* A; const void* Bt; int M, N, K; const float* rsc; const float* csc; };
struct XcdOrder {
    int ntn, nloc, nx, rank, xi, nown, total;
    __device__ __forceinline__ void init(int nmt, int ntn_, int nloc_, int nx_, int rank_, int xi_) {
        ntn = ntn_; nloc = nloc_; nx = nx_; rank = rank_; xi = xi_; nown = xi < nmt ? (nmt - xi + nx - 1) / nx : 0; total = nown * ntn; }
    __device__ __forceinline__ bool next(int i, Unit& u) const {
        const int t = rank + i * nloc; if (t >= total) return false;
        const int g4 = t / (4 * ntn), r = t - g4 * 4 * ntn;
        const int left = nown - 4 * g4, gs = left < 4 ? left : 4;
        const int nt = r / gs, mi = r - nt * gs;
        u.pm = (4 * g4 + mi) * nx + xi; u.pn = nt; return true;
    }
    __device__ __forceinline__ void a_ready(const Unit&) const {}
    __device__ __forceinline__ void done(const Unit&) const {}
};
typedef int i32x4 __attribute__((ext_vector_type(4)));
template <class Epi, class Sched, bool ALIGN_EPI = false, bool SP2 = false, bool I8 = false>
__device__ __forceinline__ void gemm_phase(PG8_LAS unsigned char* lds, const Gemm g, const Sched& S, const Epi& E) {
    const int tid = otid512(), wid = __builtin_amdgcn_readfirstlane(tid >> 6), lane = tid & 63, wr = wid >> 2, wc = wid & 3, fr = lane & 15, fq = lane >> 4;
    const int K = g.K, KB = I8 ? K : 2 * K  , nt = KB / (BK * 2);
    unsigned voffA[2], voffB[2];
#pragma unroll
    for (int i = 0; i < 2; ++i) { int R, C; stage_rc(tid * 16 + i * 8192, R, C); const int Rb = Epi::PERM ? ((R & ~31) + perm32(R & 31)) : R;
        voffA[i] = (unsigned)(R * KB + C * 2); voffB[i] = (unsigned)(Rb * KB + C * 2); }
    const size_t kstep = (size_t)(BK * 2);
    const size_t hstep = (size_t)HALF * KB;
    const size_t tstep = 2 * hstep;
    const unsigned ldsw = (unsigned)wid * 1024u;
    const int aoff = lds_byte(wr * 64 + fr, fq * 8), boff = lds_byte(wc * 32 + fr, fq * 8);
#define PG8_SA(b, h) (((b) * 2 + (h)) * HTB)
#define PG8_SB(b, h) ((4 + (b) * 2 + (h)) * HTB)
#define PG8_STAGE(bufoff, gbase, voff) do { _Pragma("unroll") for (int _i = 0; _i < 2; ++_i) \
        __builtin_amdgcn_global_load_lds((const unsigned*)((const char*)(gbase) + (voff)[_i]), (PG8_LAS unsigned*)(lds + (bufoff) + ldsw + _i * 8192), 16, 0, 0); } while (0)
#define PG8_LDA(dst, b, h) do { _Pragma("unroll") for (int m = 0; m < 4; ++m) _Pragma("unroll") for (int k = 0; k < 2; ++k) dst[m][k] = *(const PG8_LAS bf16x8*)(lds + PG8_SA(b, h) + aoff + m * 2048 + k * 1024); } while (0)
#define PG8_LDB(dst, b, h) do { _Pragma("unroll") for (int n = 0; n < 2; ++n) _Pragma("unroll") for (int k = 0; k < 2; ++k) dst[n][k] = *(const PG8_LAS bf16x8*)(lds + PG8_SB(b, h) + boff + n * 2048 + k * 1024); } while (0)
#define PG8_MMA(ai, bj, At, Bt) do { __builtin_amdgcn_s_setprio(1); _Pragma("unroll") for (int m = 0; m < 4; ++m) _Pragma("unroll") for (int n = 0; n < 2; ++n) _Pragma("unroll") for (int k = 0; k < 2; ++k) \
        { if constexpr (I8) acc[ai][bj][m][n] = __builtin_bit_cast(f32x4, __builtin_amdgcn_mfma_i32_16x16x64_i8(__builtin_bit_cast(i32x4, Bt[n][k]), __builtin_bit_cast(i32x4, At[m][k]), __builtin_bit_cast(i32x4, acc[ai][bj][m][n]), 0, 0, 0)); \
          else acc[ai][bj][m][n] = __builtin_amdgcn_mfma_f32_16x16x32_bf16(Bt[n][k], At[m][k], acc[ai][bj][m][n], 0, 0, 0); } __builtin_amdgcn_s_setprio(0); } while (0)
#define PG8_WAIT_V(n) asm volatile("s_waitcnt vmcnt(" #n ")" ::: "memory")
#define PG8_WAIT_L(n) asm volatile("s_waitcnt lgkmcnt(" #n ")" ::: "memory")
#define PG8_BAR __builtin_amdgcn_s_barrier()
#define PG8_SCHED __builtin_amdgcn_sched_barrier(0)
    Unit cur, nxt; int ui = 0;
    if (!S.next(0, cur)) return;
    f32x4 acc[2][2][4][2];
#pragma unroll
    for (int a = 0; a < 2; ++a)
#pragma unroll
        for (int b = 0; b < 2; ++b)
#pragma unroll
            for (int m = 0; m < 4; ++m)
#pragma unroll
                for (int n = 0; n < 2; ++n) acc[a][b][m][n] = (f32x4){0.f, 0.f, 0.f, 0.f};
    bf16x8 At[4][2], B0[2][2], B1[2][2];
    const char* cA = (const char*)g.A + (size_t)cur.pm * tstep; const char* cB = (const char*)g.Bt + (size_t)cur.pn * tstep;
    S.a_ready(cur);
    if constexpr (SP2) {
        PG8_STAGE(PG8_SB(0, 0), cB, voffB); PG8_STAGE(PG8_SB(0, 1), cB + hstep, voffB); PG8_STAGE(PG8_SA(0, 0), cA, voffA); PG8_STAGE(PG8_SA(0, 1), cA + hstep, voffA);
        if (wr == 1) PG8_BAR;
        PG8_WAIT_V(2); PG8_BAR;
        PG8_STAGE(PG8_SB(1, 0), cB + kstep, voffB); PG8_STAGE(PG8_SA(1, 0), cA + kstep, voffA); PG8_STAGE(PG8_SB(1, 1), cB + hstep + kstep, voffB);
        PG8_WAIT_V(6); PG8_BAR;
    } else {
        PG8_STAGE(PG8_SB(0, 0), cB, voffB); PG8_STAGE(PG8_SA(0, 0), cA, voffA); PG8_STAGE(PG8_SB(0, 1), cB + hstep, voffB); PG8_STAGE(PG8_SA(0, 1), cA + hstep, voffA);
        if (wr == 1) PG8_BAR;
        PG8_WAIT_V(4); PG8_BAR;
        PG8_STAGE(PG8_SB(1, 0), cB + kstep, voffB); PG8_STAGE(PG8_SA(1, 0), cA + kstep, voffA); PG8_STAGE(PG8_SB(1, 1), cB + hstep + kstep, voffB);
        PG8_WAIT_V(6); PG8_BAR;
    }
    for (;;) {
        const bool has_next = S.next(ui + 1, nxt);
        const char* nA = has_next ? (const char*)g.A + (size_t)nxt.pm * tstep : cA; const char* nB = has_next ? (const char*)g.Bt + (size_t)nxt.pn * tstep : cB;
        for (int t = 0; t < nt; t += 2) {
            const bool last = (t == nt - 2);
            const char* a1 = cA + (size_t)(t + 1) * kstep;
            const char* a2 = last ? nA : cA + (size_t)(t + 2) * kstep; const char* b2 = last ? nB : cB + (size_t)(t + 2) * kstep;
            const char* a3 = a2 + kstep; const char* b3 = b2 + kstep;
            if (last && has_next) S.a_ready(nxt);
            if constexpr (SP2) {
            PG8_LDB(B0, 0, 0); PG8_LDB(B1, 0, 1); PG8_SCHED; PG8_LDA(At, 0, 0); PG8_STAGE(PG8_SA(1, 1), a1 + hstep, voffA);
            PG8_WAIT_V(8); PG8_WAIT_L(0); PG8_BAR; PG8_MMA(0, 0, At, B0); PG8_MMA(0, 1, At, B1); PG8_BAR; PG8_SCHED;
            PG8_LDA(At, 0, 1); PG8_STAGE(PG8_SB(0, 0), b2, voffB); PG8_STAGE(PG8_SB(0, 1), b2 + hstep, voffB); PG8_STAGE(PG8_SA(0, 0), a2, voffA);
            PG8_WAIT_V(8); PG8_WAIT_L(0); PG8_BAR; PG8_MMA(1, 0, At, B0); PG8_MMA(1, 1, At, B1); PG8_BAR; PG8_SCHED;
            PG8_LDB(B0, 1, 0); PG8_LDB(B1, 1, 1); PG8_SCHED; PG8_LDA(At, 1, 0); PG8_STAGE(PG8_SA(0, 1), a2 + hstep, voffA);
            PG8_WAIT_V(8); PG8_WAIT_L(0); PG8_BAR; PG8_MMA(0, 0, At, B0); PG8_MMA(0, 1, At, B1); PG8_BAR; PG8_SCHED;
            PG8_LDA(At, 1, 1); PG8_STAGE(PG8_SB(1, 0), b3, voffB); PG8_STAGE(PG8_SB(1, 1), b3 + hstep, voffB); PG8_STAGE(PG8_SA(1, 0), a3, voffA);
            PG8_WAIT_V(8); PG8_WAIT_L(0); PG8_BAR; PG8_MMA(1, 0, At, B0); PG8_MMA(1, 1, At, B1); PG8_BAR; PG8_SCHED;
            } else {
            PG8_LDB(B0, 0, 0); PG8_SCHED; PG8_LDA(At, 0, 0); PG8_STAGE(PG8_SA(1, 1), a1 + hstep, voffA);
            PG8_WAIT_L(8); PG8_BAR; PG8_WAIT_L(0); PG8_MMA(0, 0, At, B0); PG8_BAR; PG8_SCHED;
            PG8_LDB(B1, 0, 1); PG8_STAGE(PG8_SB(0, 0), b2, voffB);
            PG8_BAR; PG8_WAIT_L(0); PG8_MMA(0, 1, At, B1); PG8_BAR;
            PG8_LDA(At, 0, 1); PG8_STAGE(PG8_SA(0, 0), a2, voffA);
            PG8_BAR; PG8_WAIT_L(0); PG8_MMA(1, 0, At, B0); PG8_BAR; PG8_SCHED;
            PG8_STAGE(PG8_SB(0, 1), b2 + hstep, voffB);
            PG8_WAIT_V(6); PG8_BAR; PG8_MMA(1, 1, At, B1); PG8_BAR;
            PG8_LDB(B0, 1, 0); PG8_SCHED; PG8_LDA(At, 1, 0); PG8_STAGE(PG8_SA(0, 1), a2 + hstep, voffA);
            PG8_WAIT_L(8); PG8_BAR; PG8_WAIT_L(0); PG8_MMA(0, 0, At, B0); PG8_BAR; PG8_SCHED;
            PG8_LDB(B1, 1, 1); PG8_STAGE(PG8_SB(1, 0), b3, voffB);
            PG8_BAR; PG8_WAIT_L(0); PG8_MMA(0, 1, At, B1); PG8_BAR;
            PG8_LDA(At, 1, 1); PG8_STAGE(PG8_SA(1, 0), a3, voffA);
            PG8_BAR; PG8_WAIT_L(0); PG8_MMA(1, 0, At, B0); PG8_BAR; PG8_SCHED;
            PG8_STAGE(PG8_SB(1, 1), b3 + hstep, voffB);
            PG8_WAIT_V(6); PG8_BAR; PG8_MMA(1, 1, At, B1); PG8_BAR;
            }
        }
        if constexpr (ALIGN_EPI) { if (wr == 0) PG8_BAR; }
        if constexpr (I8) {
#pragma unroll
            for (int b = 0; b < 2; ++b) {
                const float* cp = g.csc + cur.pn * BM + b * HALF + wc * 32 + 8 * fq;
                const f32x4 c0 = *(const f32x4*)cp, c1 = *(const f32x4*)(cp + 4);
#pragma unroll
                for (int a = 0; a < 2; ++a)
#pragma unroll
                    for (int m = 0; m < 4; ++m) {
                        const float xs = g.rsc[cur.pm * BM + a * HALF + wr * 64 + m * 16 + fr];
                        acc[a][b][m][0] = __builtin_convertvector(__builtin_bit_cast(i32x4, acc[a][b][m][0]), f32x4) * c0 * xs;
                        acc[a][b][m][1] = __builtin_convertvector(__builtin_bit_cast(i32x4, acc[a][b][m][1]), f32x4) * c1 * xs;
                    }
            }
        }
        if constexpr (!Epi::AFTER_DRAIN) { E(acc, cur, wr, wc, fr, fq); S.done(cur); }
        if (!has_next) break;
#pragma unroll
        for (int a = 0; a < 2; ++a)
#pragma unroll
            for (int b = 0; b < 2; ++b)
#pragma unroll
                for (int m = 0; m < 4; ++m)
#pragma unroll
                    for (int n = 0; n < 2; ++n) acc[a][b][m][n] = (f32x4){0.f, 0.f, 0.f, 0.f};
        cur = nxt; cA = nA; cB = nB; ++ui;
        if constexpr (ALIGN_EPI) { if (wr == 1) PG8_BAR; }
    }
    PG8_WAIT_V(0);
    if constexpr (!ALIGN_EPI) { if (wr == 0) PG8_BAR; }
    PG8_BAR;
    if constexpr (Epi::AFTER_DRAIN) { E.fused(acc, cur, wr, wc, fr, fq, lds, wid, lane); S.done(cur); }
#undef PG8_SA
#undef PG8_SB
#undef PG8_STAGE
#undef PG8_LDA
#undef PG8_LDB
#undef PG8_MMA
#undef PG8_WAIT_V
#undef PG8_WAIT_L
#undef PG8_BAR
#undef PG8_SCHED
}
struct EpiResid {
    static constexpr bool PERM = true, AFTER_DRAIN = false;
    const float* resid; float* out;
    __device__ __forceinline__ void operator()(const f32x4 (&acc)[2][2][4][2], const Unit& u, int wr, int wc, int fr, int fq) const {
        const size_t base = (size_t)(u.pm * BM + wr * 64 + fr) * DM + u.pn * BM + wc * 32 + 8 * fq;
#pragma unroll
        for (int ai = 0; ai < 2; ++ai) {
            f32x4 rv[4][2][2];
#pragma unroll
            for (int m = 0; m < 4; ++m)
#pragma unroll
                for (int bj = 0; bj < 2; ++bj) {
                    const float* rp = resid + base + (size_t)(ai * HALF + m * 16) * DM + bj * HALF;
                    rv[m][bj][0] = *(const f32x4*)rp; rv[m][bj][1] = *(const f32x4*)(rp + 4);
                }
            asm volatile("" ::: "memory");
#pragma unroll
            for (int m = 0; m < 4; ++m)
#pragma unroll
                for (int bj = 0; bj < 2; ++bj) {
                    float* op = out + base + (size_t)(ai * HALF + m * 16) * DM + bj * HALF;
                    *(f32x4*)op = rv[m][bj][0] + acc[ai][bj][m][0]; *(f32x4*)(op + 4) = rv[m][bj][1] + acc[ai][bj][m][1];
                }
            asm volatile("" ::: "memory");
        }
    }
};
struct EpiProj {
    static constexpr bool PERM = true, AFTER_DRAIN = false;
    const float* aq; const float* ak; const float* bq; const float* bk; bf16_t* proj; PG8_LAS float* xs;
    __device__ __forceinline__ void operator()(const f32x4 (&acc)[2][2][4][2], const Unit& u, int wr, int wc, int fr, int fq) const {
        const int wave = wr * 4 + wc;
#pragma unroll
        for (int ai = 0; ai < 2; ++ai)
#pragma unroll
            for (int m = 0; m < 4; ++m)
#pragma unroll
                for (int bj = 0; bj < 2; ++bj) {
                    const f32x4 a = acc[ai][bj][m][0], b = acc[ai][bj][m][1];
                    float t = a[0] * a[0] + a[1] * a[1] + a[2] * a[2] + a[3] * a[3] + b[0] * b[0] + b[1] * b[1] + b[2] * b[2] + b[3] * b[3];
                    t += __shfl_xor(t, 16); t += __shfl_xor(t, 32);
                    if (fq == 0) xs[wave * 256 + ((ai * 4 + m) * 2 + bj) * 16 + fr] = t;
                }
        asm volatile("s_waitcnt lgkmcnt(0)" ::: "memory");
        __builtin_amdgcn_s_barrier();
#pragma unroll
        for (int bj = 0; bj < 2; ++bj) {
            const int gcol = u.pn * BM + bj * HALF + wc * 32 + 8 * fq;
            const float* gain = nullptr; float scale = 1.f;
            if (gcol < 512) { gain = aq + (gcol & 63); scale = 0.125f; }
            else if (gcol < 1024) gain = ak + (gcol & 63);
            else if (gcol < 1536) gain = nullptr;
            else if (gcol < 2048) { gain = bq + (gcol & 127); scale = 0.125f; }
            else if (gcol < 2560) gain = bk + (gcol & 127);
            f32x4 g0 = {1.f, 1.f, 1.f, 1.f}, g1 = {1.f, 1.f, 1.f, 1.f};
            if (gain) { g0 = *(const f32x4*)gain; g1 = *(const f32x4*)(gain + 4); }
#pragma unroll
            for (int ai = 0; ai < 2; ++ai)
#pragma unroll
                for (int m = 0; m < 4; ++m) {
                    float sc = 1.f;
                    if (gain) {
                        const int slot = ((ai * 4 + m) * 2 + bj) * 16 + fr;
                        sc = rsqrtf((xs[wave * 256 + slot] + xs[(wave ^ 1) * 256 + slot]) * (1.f / 64.f) + EPSN) * scale;
                    }
                    const f32x4 v0 = acc[ai][bj][m][0] * g0 * sc, v1 = acc[ai][bj][m][1] * g1 * sc;
                    u32x4 w; w.x = pack2(v0[0], v0[1]); w.y = pack2(v0[2], v0[3]); w.z = pack2(v1[0], v1[1]); w.w = pack2(v1[2], v1[3]);
                    *(u32x4*)(proj + (size_t)(u.pm * BM + ai * HALF + wr * 64 + m * 16 + fr) * ATT_IN + gcol) = w;
                }
        }
    }
};
struct EpiSgu {
    static constexpr bool PERM = true, AFTER_DRAIN = false;
    bf16_t* zu; bf16_t* zvt; float* ssq; PG8_LAS unsigned char* stg;
    __device__ __forceinline__ void operator()(const f32x4 (&acc)[2][2][4][2], const Unit& u, int wr, int wc, int fr, int fq) const {
        const int wave = wr * 4 + wc, lane = fq * 16 + fr;
        PG8_LAS unsigned short* tl = (PG8_LAS unsigned short*)(stg + wave * 2048);
#pragma unroll
        for (int ai = 0; ai < 2; ++ai)
#pragma unroll
            for (int bj = 0; bj < 2; ++bj) {
                const int gcol = u.pn * BM + bj * HALF + wc * 32 + 8 * fq;
                f32x4 g0[4], g1[4];
#pragma unroll
                for (int m = 0; m < 4; ++m) {
                    const f32x4 a = acc[ai][bj][m][0], b = acc[ai][bj][m][1];
                    g0[m] = (f32x4){gelu_tanh(a[0]), gelu_tanh(a[1]), gelu_tanh(a[2]), gelu_tanh(a[3])};
                    g1[m] = (f32x4){gelu_tanh(b[0]), gelu_tanh(b[1]), gelu_tanh(b[2]), gelu_tanh(b[3])};
                }
                if (gcol < CW) {
#pragma unroll
                    for (int m = 0; m < 4; ++m) {
                        u32x4 w; w.x = pack2(g0[m][0], g0[m][1]); w.y = pack2(g0[m][2], g0[m][3]); w.z = pack2(g1[m][0], g1[m][1]); w.w = pack2(g1[m][2], g1[m][3]);
                        *(u32x4*)(zu + (size_t)(u.pm * BM + ai * HALF + wr * 64 + m * 16 + fr) * CW + gcol) = w;
                    }
                } else {
                    const int vcol = gcol - CW;
#pragma unroll
                    for (int m = 0; m < 4; ++m) {
                        float t = g0[m][0] * g0[m][0] + g0[m][1] * g0[m][1] + g0[m][2] * g0[m][2] + g0[m][3] * g0[m][3]
                                + g1[m][0] * g1[m][0] + g1[m][1] * g1[m][1] + g1[m][2] * g1[m][2] + g1[m][3] * g1[m][3];
                        t += __shfl_xor(t, 16); t += __shfl_xor(t, 32);
                        if (fq == 0) ssq[(size_t)(u.pm * BM + ai * HALF + wr * 64 + m * 16 + fr) * 64 + (vcol >> 5)] = t;
                    }
#pragma unroll
                    for (int h = 0; h < 2; ++h) {
#pragma unroll
                        for (int mm = 0; mm < 2; ++mm) {
                            const int m = 2 * h + mm, rl = 16 * mm + fr;
#pragma unroll
                            for (int j = 0; j < 4; ++j) { tl[(8 * fq + j) * 32 + rl] = f2bf(g0[m][j]); tl[(8 * fq + 4 + j) * 32 + rl] = f2bf(g1[m][j]); }
                        }
                        const int c = lane >> 1, hh = lane & 1;
                        const u32x4 w0 = *(const PG8_LAS u32x4*)(tl + c * 32 + hh * 16), w1 = *(const PG8_LAS u32x4*)(tl + c * 32 + hh * 16 + 8);
                        bf16_t* dst = zvt + ((size_t)(2 * u.pm + ai) * CW + (u.pn * BM - CW) + bj * HALF + wc * 32 + c) * 128 + wr * 64 + 32 * h + hh * 16;
                        *(u32x4*)dst = w0; *(u32x4*)(dst + 8) = w1;
                        asm volatile("" ::: "memory");
                    }
                }
            }
    }
};
struct EpiQ {
    static constexpr bool PERM = true, AFTER_DRAIN = false;
    bf16_t* q;
    __device__ __forceinline__ void operator()(const f32x4 (&acc)[2][2][4][2], const Unit& u, int wr, int wc, int fr, int fq) const {
#pragma unroll
        for (int ai = 0; ai < 2; ++ai)
#pragma unroll
            for (int m = 0; m < 4; ++m)
#pragma unroll
                for (int bj = 0; bj < 2; ++bj) {
                    const f32x4 a = acc[ai][bj][m][0], b = acc[ai][bj][m][1];
                    u32x4 w; w.x = pack2(a[0], a[1]); w.y = pack2(a[2], a[3]); w.z = pack2(b[0], b[1]); w.w = pack2(b[2], b[3]);
                    *(u32x4*)(q + (size_t)(u.pm * BM + ai * HALF + wr * 64 + m * 16 + fr) * 2048 + u.pn * BM + bj * HALF + wc * 32 + 8 * fq) = w;
                }
    }
};
}
DI void run_gemmq_pg8(const Params& p, int l, unsigned char* smem) {
    volatile LAS unsigned* st = (volatile LAS unsigned*)(smem + SMEM_BYTES);
    pg8::XcdOrder S; S.init(NTOK / 256, 2048 / 256, (int)st[0], (int)st[1], (int)st[2], (int)st[3]);
    const pg8::Gemm g{WSP(signed char, WS_XQ), WSP(signed char, WS_W_PQ) + (size_t)l * 2048 * DM, NTOK, 2048, DM, WSP(float, WS_XSC), WSP(float, WS_WQS) + l * 2048};
    pg8::EpiQ E; E.q = WSP(bf16_t, WS_QBUF);
    __syncthreads();
    pg8::gemm_phase<pg8::EpiQ, pg8::XcdOrder, true, true, true>((PG8_LAS unsigned char*)smem, g, S, E);
}
template <int WHICH>
DI void run_gemm_pg8(const Params& p, unsigned char* smem) {
    volatile LAS unsigned* st = (volatile LAS unsigned*)(smem + SMEM_BYTES);
    pg8::XcdOrder S; S.init(NTOK / 256, DM / 256, (int)st[0], (int)st[1], (int)st[2], (int)st[3]);
    pg8::Gemm g;
    pg8::EpiResid E;
    if (WHICH == 0) { g = pg8::Gemm{WSP(bf16_t, WS_MIXED), WSP(bf16_t, WS_W_ATTOUT), NTOK, DM, DM, nullptr, nullptr}; E.resid = p.in[0]; E.out = p.out; }
    else { g = pg8::Gemm{WSP(bf16_t, WS_Z_U), WSP(bf16_t, WS_W_SGUOUT), NTOK, DM, CW, nullptr, nullptr}; E.resid = p.out; E.out = p.out; }
    __syncthreads();
    pg8::gemm_phase<pg8::EpiResid, pg8::XcdOrder, true, true>((PG8_LAS unsigned char*)smem, g, S, E);
}

DI void run_gemm1_pg8(const Params& p, unsigned char* smem) {
    volatile LAS unsigned* st = (volatile LAS unsigned*)(smem + SMEM_BYTES);
    pg8::XcdOrder S; S.init(NTOK / 256, ATT_IN / 256, (int)st[0], (int)st[1], (int)st[2], (int)st[3]);
    const pg8::Gemm g{WSP(signed char, WS_XQ), WSP(signed char, WS_W_ATTIN), NTOK, ATT_IN, DM, WSP(float, WS_XSC), WSP(float, WS_WAS)};
    pg8::EpiProj E; E.aq = p.in[3]; E.ak = p.in[4]; E.bq = p.in[5]; E.bk = p.in[6]; E.proj = WSP(bf16_t, WS_PROJ); E.xs = (PG8_LAS float*)(smem + PG8_EXTRA);
    __syncthreads();
    pg8::gemm_phase<pg8::EpiProj, pg8::XcdOrder, true, true, true>((PG8_LAS unsigned char*)smem, g, S, E);
}
DI void run_gemm4_pg8(const Params& p, unsigned char* smem) {
    volatile LAS unsigned* st = (volatile LAS unsigned*)(smem + SMEM_BYTES);
    pg8::XcdOrder S; S.init(NTOK / 256, 4096 / 256, (int)st[0], (int)st[1], (int)st[2], (int)st[3]);
    const pg8::Gemm g{WSP(signed char, WS_XQ), WSP(signed char, WS_W_SGUIN), NTOK, 4096, DM, WSP(float, WS_XSC), WSP(float, WS_WSS)};
    pg8::EpiSgu E; E.zu = WSP(bf16_t, WS_Z_U); E.zvt = WSP(bf16_t, WS_Z_VT); E.ssq = WSP(float, WS_SSQ); E.stg = (PG8_LAS unsigned char*)(smem + PG8_EXTRA);
    __syncthreads();
    pg8::gemm_phase<pg8::EpiSgu, pg8::XcdOrder, true, true, true>((PG8_LAS unsigned char*)smem, g, S, E);
}

DI u32 cand_key(float s, int ci) { return (f2ord(s) & ~255u) | (u32)(255 - ci); }
template <int P>
DI void score_half(const bf16x8 (&qf)[8], const unsigned char* skl, int fr, int fh, u32 (&lst)[16]) {
#pragma unroll
    for (int j = 0; j < 16; ++j) lst[j] = 0u;
#pragma unroll 1
    for (int kt = 0; kt < 4; ++kt) {
        f32x16 st;
#pragma unroll
        for (int r = 0; r < 16; ++r) st[r] = 0.f;
        const int row = P * 128 + kt * 32 + fr;
        const unsigned char* skr = skl + row * 256;
#pragma unroll
        for (int ks = 0; ks < 8; ++ks) st = MFMA32(*(const bf16x8*)(skr + (((2 * ks + fh) ^ (row & 15)) << 4)), qf[ks], st);
        u32 ks_[16];
#pragma unroll
        for (int r = 0; r < 16; ++r) ks_[r] = (f2ord(st[r]) & ~127u) | (u32)(127 - (kt * 32 + crow(r, fh)));
        sort16_desc(ks_);
        merge16_desc(lst, ks_);
    }
    u32 other[16];
#pragma unroll
    for (int j = 0; j < 16; ++j) other[j] = (u32)__shfl_xor((int)lst[j], 32);
    merge16_desc(lst, other);
}
DI void run_score(const Params& p, int l, unsigned char* smem) {
    const int tid = otid512(), wave = tid >> 6, lane = tid & 63, fr = lane & 31, fh = lane >> 5;
    int cur_h = -1;
    bf16x8 qa[8], qb[8];
    if ((int)blockIdx.x < 8 * (NTOK / 256)) {
        const int it0 = blockIdx.x;
        const bf16_t* q0 = WSP(bf16_t, WS_QBUF) + (size_t)((it0 >> 3) * 256 + wave * 32 + fr) * 2048 + (it0 & 7) * 256 + 8 * fh;
#pragma unroll
        for (int ks = 0; ks < 8; ++ks) { qa[ks] = *(const bf16x8*)(q0 + 16 * ks); qb[ks] = *(const bf16x8*)(q0 + 128 + 16 * ks); }
    }
#pragma unroll 1
    for (int it = blockIdx.x; it < 8 * (NTOK / 256); it += gridDim.x) {
    const int h = it & 7, oct = it >> 3;
    if (h != cur_h) {
        __syncthreads();
        const bf16_t* skg = WSP(bf16_t, WS_W_SUBK) + ((size_t)l * 16 + h * 2) * 128 * 128;
#pragma unroll
        for (int i = 0; i < 8; ++i) {
            const int idx = wave * 8 + i;
            const int row = 4 * idx + (lane >> 4), cp = lane & 15;
            __builtin_amdgcn_global_load_lds((const unsigned*)(skg + (size_t)row * 128 + ((cp ^ (row & 15)) << 3)), (unsigned*)(smem + idx * 1024 + lane * 16), 16, 0, 0);
        }
        asm volatile("s_waitcnt vmcnt(0)" ::: "memory");
        __syncthreads();
        cur_h = h;
    }
    const int tok = oct * 256 + wave * 32 + fr;
    const unsigned char* skh = smem;
    u32 L0[16], L1[16];
    score_half<0>(qa, skh, fr, fh, L0);
    score_half<1>(qb, skh, fr, fh, L1);
    {
        const int itn = it + gridDim.x < 8 * (NTOK / 256) ? it + gridDim.x : it;
        const bf16_t* qn = WSP(bf16_t, WS_QBUF) + (size_t)((itn >> 3) * 256 + wave * 32 + fr) * 2048 + (itn & 7) * 256 + 8 * fh;
#pragma unroll
        for (int ks = 0; ks < 8; ++ks) { qa[ks] = *(const bf16x8*)(qn + 16 * ks); qb[ks] = *(const bf16x8*)(qn + 128 + 16 * ks); }
    }
    LAS int* slot = (LAS int*)(smem + 65536 + wave * (64 * 132)) + lane * 33;
    float s1[16], s2[16];
#pragma unroll
    for (int j = 0; j < 16; ++j) {
        s1[j] = ord2f(L0[j] & ~127u); s2[j] = ord2f(L1[j] & ~127u);
        slot[j] = 127 - (int)(L0[j] & 127u); slot[16 + j] = 127 - (int)(L1[j] & 127u);
    }
    u32 lst[16];
#pragma unroll
    for (int j = 0; j < 16; ++j) lst[j] = cand_key(s1[0] + s2[j], j);
#pragma unroll
    for (int i = 1; i < 5; ++i) {
        u32 row[16];
#pragma unroll
        for (int j = 0; j < 16; ++j) row[j] = ((i + 1) * (j + 1) <= 16) ? cand_key(s1[i] + s2[j], i * 16 + j) : 0u;
        merge16_desc(lst, row);
    }
#pragma unroll
    for (int i = 5; i < 16; ++i)
#pragma unroll
        for (int j = 0; j < 2; ++j)
            if ((i + 1) * (j + 1) <= 16) top16_insert(lst, cand_key(s1[i] + s2[j], i * 16 + j));
    float pv[16]; float sum = 0.f;
    const float mx = ord2f(lst[0] & ~255u);
#pragma unroll
    for (int j = 0; j < 16; ++j) { pv[j] = __expf(ord2f(lst[j] & ~255u) - mx); sum += pv[j]; }
    const float inv = 1.f / sum;
    int ev[16];
#pragma unroll
    for (int j = 0; j < 16; ++j) {
        const int ci = 255 - (int)(lst[j] & 255u);
        ev[j] = slot[ci >> 4] * 128 + slot[16 + (ci & 15)];
    }
    if (fh == 0) {
        int4* ro = (int4*)(WSP(int, WS_RIDX) + (size_t)tok * 128 + h * 16);
        float4* go = (float4*)(WSP(float, WS_RG) + (size_t)tok * 128 + h * 16);
#pragma unroll
        for (int q = 0; q < 4; ++q) {
            ro[q] = make_int4(ev[4 * q], ev[4 * q + 1], ev[4 * q + 2], ev[4 * q + 3]);
            go[q] = make_float4(pv[4 * q] * inv, pv[4 * q + 1] * inv, pv[4 * q + 2] * inv, pv[4 * q + 3] * inv);
        }
    }
    }
}


#define OSM_THR 8.0f
DI void osm_update(f32x16& s, unsigned vm, float& m, float& lh, float& alpha) {
    float mx = -1e30f;
#pragma unroll
    for (int r = 0; r < 16; ++r) mx = ((vm >> r) & 1u) ? fmaxf(mx, s[r]) : mx;
    mx = fmaxf(mx, __shfl_xor(mx, 32));
    float mn = m; alpha = 1.f;
    if (!__all(mx <= m + OSM_THR)) { mn = fmaxf(m, mx); alpha = __expf(m - mn); }
    float ls = 0.f;
#pragma unroll
    for (int r = 0; r < 16; ++r) { const float pe = ((vm >> r) & 1u) ? __expf(s[r] - mn) : 0.f; s[r] = pe; ls += pe; }
    lh = lh * alpha + ls; m = mn;
}
DI void osm_update_full(f32x16& s, float& m, float& lh, float& alpha) {
    float mx = s[0];
#pragma unroll
    for (int r = 1; r < 16; ++r) mx = fmaxf(mx, s[r]);
    mx = fmaxf(mx, __shfl_xor(mx, 32));
    float mn = m; alpha = 1.f;
    if (!__all(mx <= m + OSM_THR)) { mn = fmaxf(m, mx); alpha = __expf(m - mn); }
    float ls = 0.f;
#pragma unroll
    for (int r = 0; r < 16; ++r) { const float pe = __expf(s[r] - mn); s[r] = pe; ls += pe; }
    lh = lh * alpha + ls; m = mn;
}
DI void tr_quad(const unsigned (&a)[4], unsigned hi_off, bf16x8 (&f)[4]) {
    s16x4 l0, h0, l1, h1, l2, h2, l3, h3;
    const unsigned b0 = a[0] + hi_off, b1 = a[1] + hi_off, b2 = a[2] + hi_off, b3 = a[3] + hi_off;
    asm volatile("ds_read_b64_tr_b16 %0, %8\n\tds_read_b64_tr_b16 %1, %9\n\tds_read_b64_tr_b16 %2, %10\n\tds_read_b64_tr_b16 %3, %11\n\t"
                 "ds_read_b64_tr_b16 %4, %12\n\tds_read_b64_tr_b16 %5, %13\n\tds_read_b64_tr_b16 %6, %14\n\tds_read_b64_tr_b16 %7, %15\n\ts_waitcnt lgkmcnt(0)"
                 : "=&v"(l0), "=&v"(h0), "=&v"(l1), "=&v"(h1), "=&v"(l2), "=&v"(h2), "=&v"(l3), "=&v"(h3)
                 : "v"(a[0]), "v"(b0), "v"(a[1]), "v"(b1), "v"(a[2]), "v"(b2), "v"(a[3]), "v"(b3) : "memory");
    f[0] = __builtin_shufflevector(l0, h0, 0, 1, 2, 3, 4, 5, 6, 7); f[1] = __builtin_shufflevector(l1, h1, 0, 1, 2, 3, 4, 5, 6, 7);
    f[2] = __builtin_shufflevector(l2, h2, 0, 1, 2, 3, 4, 5, 6, 7); f[3] = __builtin_shufflevector(l3, h3, 0, 1, 2, 3, 4, 5, 6, 7);
}

#define QB_BYTES (128 * 256)
#define KB_BYTES (32 * 256)
template <bool WITH_V>
DI void attnB_stage_kv(const bf16_t* __restrict__ kg  , unsigned char* Kd, unsigned char* Vd, int wave, int lane) {
#pragma unroll
    for (int i = 0; i < 2; ++i) {
        const int idx = wave * 2 + i;
        const int key = 4 * idx + (lane >> 4), cp = lane & 15;
        const bf16_t* g = kg + (size_t)key * ATT_IN;
        __builtin_amdgcn_global_load_lds((const unsigned*)(g + ((cp ^ (key & 15)) << 3)), (unsigned*)(Kd + idx * 1024 + lane * 16), 16, 0, 0);
        if (WITH_V) {
            const int cv = ((((cp >> 2) ^ (key & 3)) << 2) | (cp & 3));
            __builtin_amdgcn_global_load_lds((const unsigned*)(g + 512 + (cv << 3)), (unsigned*)(Vd + idx * 1024 + lane * 16), 16, 0, 0);
        }
    }
}
template <int KOFF, bool FULL>
DI void attnB_map(const unsigned char* Kc, const unsigned char* qlp, int ksw, int qsw, int fh, unsigned vm, unsigned vc, int tq,
                  float& m, float& l, f32x16 (&o)[4]) {
    f32x16 st;
#pragma unroll
    for (int r = 0; r < 16; ++r) st[r] = 0.f;
#pragma unroll
    for (int s = 0; s < 4; ++s) {
        const bf16x8 kf = *(const bf16x8*)(Kc + (((KOFF + 2 * s + fh) ^ ksw) << 4));
        const bf16x8 qf = *(const bf16x8*)(qlp + (((KOFF + 2 * s + fh) ^ qsw) << 4));
        st = MFMA32(kf, qf, st);
    }
    float al;
    if (FULL) osm_update_full(st, m, l, al); else osm_update(st, vm, m, l, al);
    if (!__all(al == 1.f)) {
#pragma unroll
        for (int d = 0; d < 4; ++d)
#pragma unroll
            for (int r = 0; r < 16; ++r) o[d][r] *= al;
    }
#pragma unroll
    for (int s = 0; s < 2; ++s) {
        const bf16x8 pf = pack_p(st, s);
        unsigned va[4]; bf16x8 vf[4];
#pragma unroll
        for (int d = 0; d < 4; ++d) va[d] = vc + s * 16 * 256 + ((d ^ tq) << 6);
        tr_quad(va, 8 * 256, vf);
#pragma unroll
        for (int d = 0; d < 4; ++d) o[d] = MFMA32(vf[d], pf, o[d]);
    }
}
DI void ph_attnB_fast(const Params& p, int item, unsigned char* smem) {
    const bf16_t* proj = WSP(bf16_t, WS_PROJ);
    const int tid = otid(), wave = tid >> 6, lane = tid & 63, fr = lane & 31, fh = lane >> 5;
    const int qt = 15 - (item >> 6), bh = item & 63, b = bh >> 2, h = bh & 3;
    const int q0 = qt * 128;
    const float lam = compute_lam(p, lane);
    const size_t rowbase = (size_t)b * SEQ;
    const int qrow = wave * 32 + fr, qpos = q0 + qrow;
    unsigned char* Ql = smem;
    unsigned char* Kl = smem + QB_BYTES;
    unsigned char* Vl = Kl + 2 * KB_BYTES;
    const bf16_t* kbase = proj + rowbase * ATT_IN + 2048 + h * 128;
    __syncthreads();
#pragma unroll
    for (int i = 0; i < 8; ++i) {
        const int idx = wave * 8 + i;
        const int row = 4 * idx + (lane >> 4), cp = lane & 15;
        __builtin_amdgcn_global_load_lds((const unsigned*)(proj + (rowbase + q0 + row) * ATT_IN + 1536 + h * 128 + ((cp ^ (row & 15)) << 3)),
                                         (unsigned*)(Ql + idx * 1024 + lane * 16), 16, 0, 0);
    }
    attnB_stage_kv<true>(kbase, Kl, Vl, wave, lane);
    const unsigned char* qlp = Ql + qrow * 256;
    const int qsw = qrow & 15, ksw = fr & 15;
    const int nkt = (q0 + 128) / 32;
    const int wlast = q0 + wave * 32 + 31;
    f32x16 o1[4], o2[4];
#pragma unroll
    for (int d = 0; d < 4; ++d)
#pragma unroll
        for (int r = 0; r < 16; ++r) { o1[d][r] = 0.f; o2[d][r] = 0.f; }
    float m1 = -1e30f, m2 = -1e30f, l1 = 0.f, l2 = 0.f;
    const int tq = (lane & 15) >> 2;
    const unsigned vrow = (unsigned)(uintptr_t)Vl + (4 * fh + tq) * 256 + (16 * ((lane >> 4) & 1) + 4 * (lane & 3)) * 2;
    asm volatile("s_waitcnt vmcnt(0)" ::: "memory");
    __syncthreads();
    for (int kt = 0; kt < nkt; ++kt) {
        const int cur = kt & 1;
        if (kt + 1 < nkt) attnB_stage_kv<true>(kbase + (size_t)(kt + 1) * 32 * ATT_IN, Kl + (cur ^ 1) * KB_BYTES, Vl + (cur ^ 1) * KB_BYTES, wave, lane);
        if (kt * 32 <= wlast) {
            const unsigned char* Kc = Kl + cur * KB_BYTES + fr * 256;
            const unsigned vc = vrow + cur * KB_BYTES;
            if (kt * 32 + 31 <= wlast - 31) {
                attnB_map<0, true>(Kc, qlp, ksw, qsw, fh, 0xffffu, vc, tq, m1, l1, o1);
                __builtin_amdgcn_sched_barrier(0);
                attnB_map<8, true>(Kc, qlp, ksw, qsw, fh, 0xffffu, vc, tq, m2, l2, o2);
            } else {
                unsigned vm = 0;
#pragma unroll
                for (int r = 0; r < 16; ++r) vm |= ((kt * 32 + crow(r, fh)) <= qpos) ? (1u << r) : 0u;
                attnB_map<0, false>(Kc, qlp, ksw, qsw, fh, vm, vc, tq, m1, l1, o1);
                __builtin_amdgcn_sched_barrier(0);
                attnB_map<8, false>(Kc, qlp, ksw, qsw, fh, vm, vc, tq, m2, l2, o2);
            }
        }
        asm volatile("s_waitcnt vmcnt(0)" ::: "memory");
        __syncthreads();
    }
    l1 += __shfl_xor(l1, 32); l2 += __shfl_xor(l2, 32);
    const float i1 = 1.f / l1, i2 = lam / l2;
    float ss = 0.f;
#pragma unroll
    for (int d = 0; d < 4; ++d)
#pragma unroll
        for (int r = 0; r < 16; ++r) { const float v = o1[d][r] * i1 - o2[d][r] * i2; o1[d][r] = v; ss += v * v; }
    ss += __shfl_xor(ss, 32);
    const float rinv = rsqrtf(ss * (1.f / 128.f) + EPSN) * 0.8f;
    const float* subg = p.in[11];
    bf16_t* op = WSP(bf16_t, WS_MIXED) + (rowbase + qpos) * DM + 512 + h * 128;
#pragma unroll
    for (int d = 0; d < 4; ++d)
#pragma unroll
        for (int g = 0; g < 4; ++g) {
            const int dim = 32 * d + 8 * g + 4 * fh;
            const float4 gg = *(const float4*)(subg + dim);
            uint2 w;
            w.x = pack2(o1[d][4 * g + 0] * rinv * gg.x, o1[d][4 * g + 1] * rinv * gg.y);
            w.y = pack2(o1[d][4 * g + 2] * rinv * gg.z, o1[d][4 * g + 3] * rinv * gg.w);
            *(uint2*)(op + dim) = w;
        }
}

#define KA_PITCH 128
#define VA_PITCH 192
#define WA_BYTES (32 * KA_PITCH + 32 * VA_PITCH)
template <int MODE>
DI void ph_attnA_fast(const Params& p, int item, unsigned char* smem) {
    const bf16_t* proj = WSP(bf16_t, WS_PROJ);
    const int tid = otid(), wave = tid >> 6, lane = tid & 63, fr = lane & 31, fh = lane >> 5;
    const int c = item & 15, h = (item >> 4) & 7, b = item >> 7;
    const size_t rowbase = (size_t)b * SEQ;
    const int qpos = MODE == 0 ? 128 * c + 32 * wave + fr : 16 * (32 * wave + fr) + c;
    const int pmin = MODE == 0 ? 128 * c + 32 * wave : 512 * wave + c, pmax = pmin + (MODE == 0 ? 31 : 496);
    bf16x8 qf[4];
    {
        const bf16_t* qp = proj + (rowbase + qpos) * ATT_IN + h * 64 + 8 * fh;
#pragma unroll
        for (int s = 0; s < 4; ++s) qf[s] = *(const bf16x8*)(qp + 16 * s);
    }
    f32x16 o[2];
#pragma unroll
    for (int d = 0; d < 2; ++d)
#pragma unroll
        for (int r = 0; r < 16; ++r) o[d][r] = 0.f;
    float m = -1e30f, l = 0.f;
    unsigned char* Kl = smem + wave * WA_BYTES;
    unsigned char* Vl = Kl + 32 * KA_PITCH;
    const unsigned vaddr = (unsigned)(uintptr_t)Vl + (4 * fh + ((lane & 15) >> 2)) * VA_PITCH + (16 * ((lane >> 4) & 1) + 4 * (lane & 3)) * 2;
    const int skey = lane >> 3, sc = lane & 7;
    int br = 0, d = MODE == 0 ? 1 : 16, W = MODE == 0 ? 128 : 2048, cls = MODE == 0 ? 0 : (c & 15);
    int j0 = MODE == 0 ? (pmin < 128 ? 0 : pmin - 128) : 0, jhi = MODE == 0 ? pmax : ((pmax - cls) >> 4);
    const bf16_t* kvbase = proj + rowbase * ATT_IN + 512 + h * 64 + sc * 8;
    uint4 rk0, rk1, rk2, rk3, rv0, rv1, rv2, rv3;
#define A_LOAD(i, RK, RV) do { int kp_ = cls + d * (j0 + skey + 8 * (i)); kp_ = kp_ > SEQ - 1 ? SEQ - 1 : kp_; kp_ = kp_ < 0 ? 0 : kp_; \
        const bf16_t* g_ = kvbase + (size_t)kp_ * ATT_IN; RK = *(const uint4*)g_; RV = *(const uint4*)(g_ + 512); } while (0)
#define A_WRITE(i, RK, RV) do { const int key_ = skey + 8 * (i); *(uint4*)(Kl + key_ * KA_PITCH + ((sc ^ ((key_ >> 1) & 7)) << 4)) = RK; \
        *(uint4*)(Vl + key_ * VA_PITCH + sc * 16) = RV; } while (0)
    A_LOAD(0, rk0, rv0); A_LOAD(1, rk1, rv1); A_LOAD(2, rk2, rv2); A_LOAD(3, rk3, rv3);
#pragma unroll 1
    for (;;) {
        A_WRITE(0, rk0, rv0); A_WRITE(1, rk1, rv1); A_WRITE(2, rk2, rv2); A_WRITE(3, rk3, rv3);
        const int cd = d, cW = W, ccls = cls, cj0 = j0;
        bool more = true;
        j0 += 32;
        if (j0 > jhi) {
            ++br;
            if (MODE == 0 || br == 2) more = false;
            else {
                d = 4; W = 512; cls = c & 3;
                const int lo = pmin - cls - W;
                j0 = lo < 0 ? 0 : lo >> 2;
                jhi = (pmax - cls) >> 2;
            }
        }
        A_LOAD(0, rk0, rv0); A_LOAD(1, rk1, rv1); A_LOAD(2, rk2, rv2); A_LOAD(3, rk3, rv3);
        f32x16 st;
#pragma unroll
        for (int r = 0; r < 16; ++r) st[r] = 0.f;
#pragma unroll
        for (int s = 0; s < 4; ++s) {
            const bf16x8 kf = *(const bf16x8*)(Kl + fr * KA_PITCH + (((2 * s + fh) ^ ((fr >> 1) & 7)) << 4));
            st = MFMA32(kf, qf[s], st);
        }
        float al;
        const int kfirst = ccls + cd * cj0, klast = kfirst + cd * 31;
        if (klast <= pmin && pmax - kfirst <= cW) osm_update_full(st, m, l, al);
        else {
            unsigned vm = 0;
#pragma unroll
            for (int r = 0; r < 16; ++r) {
                const int dist = qpos - (ccls + cd * (cj0 + crow(r, fh)));
                vm |= (dist >= 0 && dist <= cW) ? (1u << r) : 0u;
            }
            osm_update(st, vm, m, l, al);
        }
        if (!__all(al == 1.f)) {
#pragma unroll
            for (int dd = 0; dd < 2; ++dd)
#pragma unroll
                for (int r = 0; r < 16; ++r) o[dd][r] *= al;
        }
        {
            unsigned va[4]; bf16x8 vf[4];
            va[0] = vaddr; va[1] = vaddr + 64; va[2] = vaddr + 16 * VA_PITCH; va[3] = vaddr + 16 * VA_PITCH + 64;
            tr_quad(va, 8 * VA_PITCH, vf);
            const bf16x8 p0 = pack_p(st, 0), p1 = pack_p(st, 1);
            o[0] = MFMA32(vf[0], p0, o[0]); o[1] = MFMA32(vf[1], p0, o[1]);
            o[0] = MFMA32(vf[2], p1, o[0]); o[1] = MFMA32(vf[3], p1, o[1]);
        }
        if (!more) break;
    }
    l += __shfl_xor(l, 32);
    bf16_t* op = WSP(bf16_t, WS_MIXED) + (rowbase + qpos) * DM + h * 64;
    float* lsep = WSP(float, WS_LSE1) + (rowbase + qpos) * 8 + h;
    if (MODE == 0) {
        const float il = 1.f / l;
        if (fh == 0) *lsep = m + __logf(l);
#pragma unroll
        for (int dd = 0; dd < 2; ++dd)
#pragma unroll
            for (int g = 0; g < 4; ++g) {
                const int dim = 32 * dd + 8 * g + 4 * fh;
                uint2 w;
                w.x = pack2(o[dd][4 * g + 0] * il, o[dd][4 * g + 1] * il);
                w.y = pack2(o[dd][4 * g + 2] * il, o[dd][4 * g + 3] * il);
                *(uint2*)(op + dim) = w;
            }
    } else {
        const float lse1 = *lsep;
        const float M = fmaxf(m, lse1);
        const float w23 = __expf(m - M), w1 = __expf(lse1 - M);
        const float iden = 1.f / (l * w23 + w1);
        const float a23 = w23 * iden, a1 = w1 * iden;
        uint2 prev[2][4];
#pragma unroll
        for (int dd = 0; dd < 2; ++dd)
#pragma unroll
            for (int g = 0; g < 4; ++g) prev[dd][g] = *(const uint2*)(op + 32 * dd + 8 * g + 4 * fh);
#pragma unroll
        for (int dd = 0; dd < 2; ++dd)
#pragma unroll
            for (int g = 0; g < 4; ++g) {
                const int dim = 32 * dd + 8 * g + 4 * fh;
                const float p0 = __uint_as_float(prev[dd][g].x << 16), p1 = __uint_as_float(prev[dd][g].x & 0xffff0000u);
                const float p2 = __uint_as_float(prev[dd][g].y << 16), p3 = __uint_as_float(prev[dd][g].y & 0xffff0000u);
                uint2 w;
                w.x = pack2(o[dd][4 * g + 0] * a23 + p0 * a1, o[dd][4 * g + 1] * a23 + p1 * a1);
                w.y = pack2(o[dd][4 * g + 2] * a23 + p2 * a1, o[dd][4 * g + 3] * a23 + p3 * a1);
                *(uint2*)(op + dim) = w;
            }
    }
}
#define NITEM_B 1024
#define NITEM_A 2048
DI void ph_attn_fast(const Params& p, int vb, unsigned char* smem) {
    if (vb < NITEM_B) {
        const int item = vb < 512 ? vb : 512 + (1023 - vb);
        ph_attnB_fast(p, item, smem);
    } else ph_attnA_fast<0>(p, vb - NITEM_B, smem);
}


DI void ph_spatial_fast(const Params& p, int item, unsigned char* smem) {
    const int tid = otid(), wave = tid >> 6, lane = tid & 63, fr = lane & 31, fh = lane >> 5;
    const int wm = wave >> 1, wn = wave & 1;
    const int chunk = item >> 3, g = item & 7;
    bf16_t* u = WSP(bf16_t, WS_Z_U);
    const bf16_t* vt = WSP(bf16_t, WS_Z_VT);
    const float* ssq = WSP(float, WS_SSQ);
    const float* wsp = p.in[16] + (size_t)g * 128 * 128;
    float* rinv = (float*)(smem + 66 * 1024);
    unsigned char* Bt = smem + 32768;
    __syncthreads();
    if (tid < 128) {
        const float4* sp = (const float4*)(ssq + (size_t)(chunk * 128 + tid) * 64);
        float sacc = 0.f;
#pragma unroll
        for (int j = 0; j < 16; ++j) { const float4 q = sp[j]; sacc += (q.x + q.y) + (q.z + q.w); }
        rinv[tid] = rsqrtf(sacc * (1.f / CW) + EPSN);
    }
    const size_t vrow0 = (size_t)chunk * CW + g * 256;
    stage_tile(vt, 128, (int)vrow0, 0, Bt, wave, lane);
    stage_tile(vt, 128, (int)vrow0, 64, Bt + 16384, wave, lane);
    __syncthreads();
#pragma unroll
    for (int i = 0; i < 8; ++i) {
        const int id = tid + 256 * i;
        const int t = id >> 4, sc = id & 15;
        const float4 w0 = *(const float4*)(wsp + t * 128 + sc * 8);
        const float4 w1 = *(const float4*)(wsp + t * 128 + sc * 8 + 4);
        const float4 r0 = *(const float4*)(rinv + sc * 8);
        const float4 r1 = *(const float4*)(rinv + sc * 8 + 4);
        const int s0 = sc * 8;
        uint4 o;
        o.x = pack2(s0 + 0 <= t ? w0.x * r0.x : 0.f, s0 + 1 <= t ? w0.y * r0.y : 0.f);
        o.y = pack2(s0 + 2 <= t ? w0.z * r0.z : 0.f, s0 + 3 <= t ? w0.w * r0.w : 0.f);
        o.z = pack2(s0 + 4 <= t ? w1.x * r1.x : 0.f, s0 + 5 <= t ? w1.y * r1.y : 0.f);
        o.w = pack2(s0 + 6 <= t ? w1.z * r1.z : 0.f, s0 + 7 <= t ? w1.w * r1.w : 0.f);
        const int kt = sc >> 3, c = sc & 7;
        *(uint4*)(smem + kt * 16384 + t * 128 + ((c ^ ((t >> 1) & 7)) << 4)) = o;
    }
#pragma unroll 1
    for (int nt = 0; nt < 2; ++nt) {
        asm volatile("s_waitcnt vmcnt(0)" ::: "memory");
        __syncthreads();
        f32x16 acc[2][2];
#pragma unroll
        for (int i = 0; i < 2; ++i)
#pragma unroll
            for (int j = 0; j < 2; ++j)
#pragma unroll
                for (int r = 0; r < 16; ++r) acc[i][j][r] = 0.f;
#pragma unroll
        for (int kt = 0; kt < 2; ++kt)
#pragma unroll
            for (int s = 0; s < 4; ++s) {
                bf16x8 a[2], b[2];
#pragma unroll
                for (int i = 0; i < 2; ++i) {
                    a[i] = lds_frag(smem + kt * 16384, wm * 64 + i * 32 + fr, 2 * s + fh);
                    b[i] = lds_frag(Bt + kt * 16384, wn * 64 + i * 32 + fr, 2 * s + fh);
                }
#pragma unroll
                for (int i = 0; i < 2; ++i)
#pragma unroll
                    for (int j = 0; j < 2; ++j) acc[i][j] = MFMA32(a[i], b[j], acc[i][j]);
            }
        __syncthreads();
        float* st = (float*)(Bt + wave * (32 * 65 * 4));
#pragma unroll
        for (int i = 0; i < 2; ++i) {
#pragma unroll
            for (int j = 0; j < 2; ++j)
#pragma unroll
                for (int r = 0; r < 16; ++r) st[crow(r, fh) * 65 + j * 32 + fr] = acc[i][j][r];
            const int t = wm * 64 + i * 32 + fr;
            const int c0 = g * 256 + nt * 128 + wn * 64 + fh * 32;
            bf16_t* up = u + (size_t)(chunk * 128 + t) * CW + c0;
            const float bias = p.in[17][g * 128 + t];
            const float* gn = p.in[15] + c0;
            uint4 ur[4];
#pragma unroll
            for (int q = 0; q < 4; ++q) ur[q] = ((const uint4*)up)[q];
#pragma unroll
            for (int q = 0; q < 4; ++q) {
                float uf[8]; unpack8(ur[q], uf);
                const float4 g0 = *(const float4*)(gn + 8 * q), g1 = *(const float4*)(gn + 8 * q + 4);
                const float gg[8] = {g0.x, g0.y, g0.z, g0.w, g1.x, g1.y, g1.z, g1.w};
                float ov[8];
#pragma unroll
                for (int e = 0; e < 8; ++e) ov[e] = uf[e] * (st[fr * 65 + fh * 32 + 8 * q + e] * gg[e] + bias);
                uint4 o; o.x = pack2(ov[0], ov[1]); o.y = pack2(ov[2], ov[3]); o.z = pack2(ov[4], ov[5]); o.w = pack2(ov[6], ov[7]);
                ((uint4*)up)[q] = o;
            }
        }
        if (nt == 0) {
            __syncthreads();
            stage_tile(vt, 128, (int)vrow0 + 128, 0, Bt, wave, lane);
            stage_tile(vt, 128, (int)vrow0 + 128, 64, Bt + 16384, wave, lane);
        }
    }
}

#define XB_TMO      128
#define XB_XCNT(j)  (256  + 64 * (j))
#define XB_XSUB(j)  (1280 + 64 * (j))
#define XB_XGEN(j)  (2304 + 64 * (j))
#define XB_TOP      3328
#define XB_TOPGEN   3392
#define XCD_BAR_WORDS 3456
#define XB_SPIN_CAP (1u << 22)
DI unsigned xb_ld(unsigned* p) { return __hip_atomic_load(p, __ATOMIC_RELAXED, __HIP_MEMORY_SCOPE_AGENT); }
DI unsigned xb_add(unsigned* p, unsigned v) { return __hip_atomic_fetch_add(p, v, __ATOMIC_RELAXED, __HIP_MEMORY_SCOPE_AGENT); }
DI unsigned xb_xcc_id() { return (unsigned)__builtin_amdgcn_s_getreg((3 << 11) | 20) & 0xFu; }
#define XB_SPIN(cond, bar) do { unsigned _sp = 0; while (cond) { __builtin_amdgcn_s_sleep(1); \
    if ((++_sp & 255u) == 0u) { if (xb_ld(&(bar)[XB_TMO])) break; if (_sp > XB_SPIN_CAP) { atomicAdd(&(bar)[XB_TMO], 1u); break; } } } } while (0)
struct XcdBarrier { unsigned* bar; unsigned x; volatile LAS unsigned* st; };
DI XcdBarrier xcd_barrier_post(unsigned* bar, volatile LAS unsigned* st) {
    XcdBarrier b; b.bar = bar; b.x = xb_xcc_id(); b.st = st;
    if (threadIdx.x == 0) st[2] = xb_add(&bar[XB_XCNT(b.x)], 1u);
    return b;
}
DI void xcd_barrier_complete(unsigned* bar, unsigned x, unsigned& nloc, unsigned& nx, unsigned& xi) {
    const unsigned G = gridDim.x * gridDim.y * gridDim.z;
    unsigned sum, cnt, mine, below, sp = 0u;
    for (;;) {
        sum = 0u; cnt = 0u; mine = 0u; below = 0u;
#pragma unroll
        for (unsigned j = 0; j < 16; ++j) { const unsigned c = xb_ld(&bar[XB_XCNT(j)]); sum += c; cnt += (c > 0u) ? 1u : 0u; mine = (j == x) ? c : mine; below += (c > 0u && j < x) ? 1u : 0u; }
        if (sum == G) break;
        __builtin_amdgcn_s_sleep(1);
        if ((++sp & 255u) == 0u) { if (xb_ld(&bar[XB_TMO])) break; if (sp > XB_SPIN_CAP) { atomicAdd(&bar[XB_TMO], 1u); break; } }
    }
    nloc = mine > 0u ? mine : 1u; nx = cnt > 0u ? cnt : 1u; xi = below;
}
DI void xcd_barrier(const XcdBarrier& b) {
    asm volatile("s_waitcnt vmcnt(0)" ::: "memory");
    __syncthreads();
    if (threadIdx.x == 0) {
        unsigned* bar = b.bar;
        __builtin_amdgcn_s_waitcnt(0);
        unsigned nloc = b.st[0], nx = b.st[1];
        if (nloc == 0u) { unsigned xi; xcd_barrier_complete(bar, b.x, nloc, nx, xi); b.st[0] = nloc; b.st[1] = nx; b.st[3] = xi; }
        const unsigned old = xb_add(&bar[XB_XSUB(b.x)], 1u);
        const unsigned gen = old / nloc;
        if (old + 1u == (gen + 1u) * nloc) {
            __builtin_amdgcn_fence(__ATOMIC_RELEASE, "agent");
            asm volatile("s_waitcnt vmcnt(0)" ::: "memory");
            const unsigned og = xb_add(&bar[XB_TOP], 1u);
            const unsigned tg = og / nx;
            if (og + 1u == (tg + 1u) * nx) xb_add(&bar[XB_TOPGEN], 1u);
            else XB_SPIN(xb_ld(&bar[XB_TOPGEN]) == tg, bar);
            __builtin_amdgcn_fence(__ATOMIC_ACQUIRE, "agent");
            xb_add(&bar[XB_XGEN(b.x)], 1u);
            asm volatile("s_waitcnt vmcnt(0)" ::: "memory");
        } else {
            XB_SPIN(xb_ld(&bar[XB_XGEN(b.x)]) == gen, bar);
            __builtin_amdgcn_fence(__ATOMIC_ACQUIRE, "agent");
            asm volatile("s_waitcnt vmcnt(0)" ::: "memory");
        }
    }
    __syncthreads();
}

enum { PH_PREP = 0, PH_GEMM1, PH_ATTN, PH_ATTN2, PH_GEMM2,
       PH_NORM_P0, PH_GEMMQ0, PH_SCORE0, PH_PDOWN0, PH_PCOMB0, PH_PUP0, PH_NORM_SGU,
       PH_GEMM4, PH_SPATIAL, PH_GEMM5,
       PH_NORM_P1, PH_GEMMQ1, PH_SCORE1, PH_PDOWN1, PH_PCOMB1, PH_PUP1, PH_COUNT };

__host__ __device__ constexpr int phase_nvb(int ph) {
    switch (ph) {
        case PH_PREP: return PREP_N;
        case PH_GEMM1: return (ATT_IN / 256) * (NTOK / 256);
        case PH_ATTN: return NITEM_B + NITEM_A;
        case PH_ATTN2: return NITEM_A;
        case PH_GEMM2: return (DM / 256) * (NTOK / 256);
        case PH_NORM_P0: case PH_NORM_P1: case PH_NORM_SGU: return NTOK / 4;
        case PH_GEMMQ0: case PH_GEMMQ1: return 16 * (NTOK / 256);
        case PH_SCORE0: case PH_SCORE1: return (NTOK / 32) * 8 / 4;
        case PH_PCOMB0: case PH_PCOMB1: return NTOK / 4;
        case PH_GEMM4: return (4096 / 256) * (NTOK / 256);
        case PH_SPATIAL: return 256 * 8;
        case PH_GEMM5: return (DM / 256) * (NTOK / 256);
    }
    return 0;
}

template <int PH>
DI void run_vb(const Params& p, int vb, unsigned char* smem) {
    if constexpr (PH == PH_PREP) ph_prep(p, vb, smem);
    else if constexpr (PH == PH_ATTN) ph_attn_fast(p, vb, smem);
    else if constexpr (PH == PH_ATTN2) ph_attnA_fast<1>(p, vb, smem);
    else if constexpr (PH == PH_NORM_P0 || PH == PH_NORM_P1) rmsnorm_rows(p.out, p.in[19] + (PH == PH_NORM_P1 ? DM : 0), vb, WSP(signed char, WS_XQ), WSP(float, WS_XSC));
    else if constexpr (PH == PH_PCOMB0 || PH == PH_PCOMB1) ph_peer_comb(p, vb, PH == PH_PCOMB1 ? 1 : 0);
    else if constexpr (PH == PH_NORM_SGU) rmsnorm_rows(p.out, p.in[13], vb, WSP(signed char, WS_XQ), WSP(float, WS_XSC));
    else if constexpr (PH == PH_SPATIAL) ph_spatial_fast(p, vb, smem);
}

template <int PH>
DI void run_phase(const Params& p, unsigned char* smem) {
    if constexpr (PH == PH_PDOWN0 || PH == PH_PDOWN1) run_peer_sliced<false>(p, PH == PH_PDOWN1 ? 1 : 0, smem);
    else if constexpr (PH == PH_PUP0 || PH == PH_PUP1) run_peer_sliced<true>(p, PH == PH_PUP1 ? 1 : 0, smem);
    else if constexpr (PH == PH_SCORE0 || PH == PH_SCORE1) run_score(p, PH == PH_SCORE1 ? 1 : 0, smem);
    else if constexpr (PH == PH_GEMMQ0 || PH == PH_GEMMQ1) run_gemmq_pg8(p, PH == PH_GEMMQ1 ? 1 : 0, smem);
    else if constexpr (PH == PH_GEMM1) run_gemm1_pg8(p, smem);
    else if constexpr (PH == PH_GEMM4) run_gemm4_pg8(p, smem);
    else if constexpr (PH == PH_GEMM2) run_gemm_pg8<0>(p, smem);
    else if constexpr (PH == PH_GEMM5) run_gemm_pg8<1>(p, smem);
    else {
        constexpr int nvb = phase_nvb(PH);
        const int g = threadIdx.x >> 8;
        for (int vb = 2 * blockIdx.x; vb < nvb; vb += 2 * gridDim.x)
            if (vb + g < nvb) run_vb<PH>(p, vb + g, smem + g * GROUP_SMEM);
    }
}

template <int PH>
DI void run_from(const Params& p, unsigned char* smem, cg::grid_group& grid, const XcdBarrier& xb) {
    run_phase<PH>(p, smem);
    if constexpr (PH + 1 < PH_COUNT) {
        if constexpr (PH == 1) grid.sync(); else xcd_barrier(xb);
        run_from<PH + 1>(p, smem, grid, xb);
    }
}

__global__ void __launch_bounds__(NTHREADS, 2) k_mega(Params p) {
    extern __shared__ __attribute__((aligned(16))) unsigned char smem[];
    cg::grid_group grid = cg::this_grid();
    volatile LAS unsigned* st = (volatile LAS unsigned*)(smem + SMEM_BYTES);
    if (threadIdx.x == 0) { st[0] = 0u; st[1] = 0u; st[2] = 0u; st[3] = 0u; }
    __syncthreads();
    const XcdBarrier xb = xcd_barrier_post((unsigned*)(p.ws + WS_CTL), st);
    run_from<0>(p, smem, grid, xb);
}


extern "C" void kernel_launch(void* const* d_in, const int* in_sizes, int n_in, void* d_out, int out_size, void* d_ws, size_t ws_size, hipStream_t stream) {
    if (n_in != 24 || ws_size < WS_NEED || in_sizes[0] != NTOK * DM || out_size != NTOK * DM || in_sizes[22] != 2 * NEXP * DM) {
        fprintf(stderr, "kernel_launch: built for x[16,2048,1024] with 24 inputs and >= 512 MiB of workspace; got n_in %d, in0 %d, out %d, ws %zu: nothing launched\n", n_in, in_sizes[0], out_size, ws_size); return; }
    static int grid_blocks = 0;
    if (!grid_blocks) {
        int dev = 0, cus = 0, per_cu = 0;
        (void)hipGetDevice(&dev);
        (void)hipDeviceGetAttribute(&cus, hipDeviceAttributeMultiprocessorCount, dev);
        (void)hipFuncSetAttribute((const void*)k_mega, hipFuncAttributeMaxDynamicSharedMemorySize, SMEM_ALLOC);
        (void)hipOccupancyMaxActiveBlocksPerMultiprocessor(&per_cu, (const void*)k_mega, NTHREADS, SMEM_ALLOC);
        if (per_cu > 1) per_cu = 1;
        if (per_cu < 1) { fprintf(stderr, "kernel_launch: occupancy query returned %d\n", per_cu); per_cu = 1; }
        grid_blocks = cus * per_cu;
    }
    Params p{};
    for (int i = 0; i < 24; ++i) p.in[i] = (const float*)d_in[i];
    p.out = (float*)d_out;
    p.ws = (unsigned char*)d_ws;
    void* args[] = {&p};
    if (hipMemsetAsync((unsigned char*)d_ws + WS_CTL, 0, XCD_BAR_WORDS * 4, stream) != hipSuccess) { fprintf(stderr, "kernel_launch: memset of the barrier words failed\n"); return; }
    hipError_t e = hipLaunchCooperativeKernel((const void*)k_mega, dim3(grid_blocks), dim3(NTHREADS), args, SMEM_ALLOC, stream);
    if (e != hipSuccess) fprintf(stderr, "cooperative launch failed: %s (grid %d)\n", hipGetErrorString(e), grid_blocks);
}
```

```cpp
#include <hip/hip_runtime.h>
#include <stdint.h>
#include <stdio.h>

#define NTOK   32768
#define DM     1024
#define SEQ    2048
#define NB     16
#define ATT_IN 3072
#define CW     2048
#define NEXP   16384
#define EPSN   1e-6f

typedef unsigned short bf16_t;
typedef unsigned int u32;

#define DI __device__ __forceinline__
#define LAS __attribute__((address_space(3)))

DI int otid() { int t = threadIdx.x & 255; asm volatile("" : "+v"(t)); return t; }
DI int otid512() { int t = threadIdx.x; asm volatile("" : "+v"(t)); return t; }
DI float bf2f(bf16_t v) { return __uint_as_float(((u32)v) << 16); }
typedef __bf16 bf16v2 __attribute__((ext_vector_type(2)));
DI bf16_t f2bf(float f) { const __bf16 h = (__bf16)f; return __builtin_bit_cast(bf16_t, h); }
DI u32 pack2(float lo, float hi) { bf16v2 v; v[0] = (__bf16)lo; v[1] = (__bf16)hi; return __builtin_bit_cast(u32, v); }
DI float gelu_tanh(float x) {
    const float y = 0.7978845608028654f * (x + 0.044715f * x * x * x);
    const float e = __expf(2.f * y);
    const float t = 1.f - 2.f / (e + 1.f);
    return 0.5f * x * (1.f + t);
}
DI float wave_sum(float v) {
#pragma unroll
    for (int o = 1; o < 64; o <<= 1) v += __shfl_xor(v, o);
    return v;
}
DI float wave_max(float v) {
#pragma unroll
    for (int o = 1; o < 64; o <<= 1) v = fmaxf(v, __shfl_xor(v, o));
    return v;
}
DI u32 f2ord(float f) { u32 u = __float_as_uint(f); return (u & 0x80000000u) ? ~u : (u | 0x80000000u); }
DI float ord2f(u32 o) { u32 u = (o & 0x80000000u) ? (o & 0x7fffffffu) : ~o; return __uint_as_float(u); }

#define MiB ((size_t)1 << 20)
#define WS_CTL      ((size_t)0)
#define WS_W_ATTIN  (1 * MiB)
#define WS_W_ATTOUT (7 * MiB)
#define WS_W_SGUIN  (9 * MiB)
#define WS_W_SGUOUT (17 * MiB)
#define WS_W_PQ     (21 * MiB)
#define WS_WQS      (25 * MiB)
#define WS_WAS      (25 * MiB + 64 * 1024)
#define WS_WSS      (25 * MiB + 128 * 1024)
#define WS_W_SUBK   (29 * MiB)
#define WS_DOWN     (32 * MiB)
#define WS_UP       (64 * MiB)
#define WS_DSC      (96 * MiB)
#define WS_USC      (96 * MiB + 128 * 1024)
#define WS_LSE1     (30 * MiB)
#define WS_XQ       (100 * MiB)
#define WS_XSC      (132 * MiB)
#define WS_RES      (160 * MiB)
#define WS_BIG      (224 * MiB)
#define WS_PROJ     (WS_BIG)
#define WS_MIXED    (WS_BIG + 192 * MiB)
#define WS_Z_U      (WS_BIG)
#define WS_Z_VT     (WS_BIG + 128 * MiB)
#define WS_RIDX     (WS_BIG + 32 * MiB)
#define WS_RG       (WS_BIG + 48 * MiB)
#define WS_QBUF     (WS_BIG + 64 * MiB)
#define WS_SSQ      (WS_BIG + 256 * MiB)
#define WS_NEED     (512 * MiB)

struct Params {
    const float* in[24];
    float* out;
    unsigned char* ws;
};

#include <hip/hip_cooperative_groups.h>
namespace cg = cooperative_groups;

#define GROUP_SMEM (68 * 1024)
#define PG8_EXTRA (128 * 1024)
#define SMEM_BYTES (144 * 1024)
#define SMEM_ALLOC (SMEM_BYTES + 16)
#define NTHREADS 512

#define WSP(T, off) ((T*)(p.ws + (off)))


DI void transpose_tile(const float* __restrict__ W, bf16_t* __restrict__ Wt, int K, int N, int t, unsigned char* smem) {
    float* tile = (float*)smem;
    const int tid = otid();
    const int ntn = N / 64;
    const int n0 = (t % ntn) * 64, k0 = (t / ntn) * 64;
    __syncthreads();
    {
        const int n4 = tid & 15, kr = tid >> 4;
#pragma unroll
        for (int i = 0; i < 4; ++i) {
            const int k = kr + 16 * i;
            const float4 v = *(const float4*)(W + (size_t)(k0 + k) * N + n0 + 4 * n4);
            tile[k * 65 + 4 * n4 + 0] = v.x; tile[k * 65 + 4 * n4 + 1] = v.y; tile[k * 65 + 4 * n4 + 2] = v.z; tile[k * 65 + 4 * n4 + 3] = v.w;
        }
    }
    __syncthreads();
    {
        const int n = tid >> 2, kc = tid & 3;
        float v[16];
#pragma unroll
        for (int j = 0; j < 16; ++j) v[j] = tile[(16 * kc + j) * 65 + n];
        uint4 o0, o1;
        o0.x = pack2(v[0], v[1]); o0.y = pack2(v[2], v[3]); o0.z = pack2(v[4], v[5]); o0.w = pack2(v[6], v[7]);
        o1.x = pack2(v[8], v[9]); o1.y = pack2(v[10], v[11]); o1.z = pack2(v[12], v[13]); o1.w = pack2(v[14], v[15]);
        uint4* dst = (uint4*)(Wt + (size_t)(n0 + n) * K + k0 + 16 * kc);
        dst[0] = o0; dst[1] = o1;
    }
}
DI void cvt_chunk(const float* __restrict__ src, bf16_t* __restrict__ dst, int c) {
    const size_t base = (size_t)c * 2048;
#pragma unroll
    for (int i = 0; i < 8; ++i) {
        const size_t idx = base + i * 256 + otid();
        const float4 v = ((const float4*)src)[idx];
        uint2 o; o.x = pack2(v.x, v.y); o.y = pack2(v.z, v.w);
        ((uint2*)dst)[idx] = o;
    }
}
DI int q8(float v) { int i = __float2int_rn(v); i = i > 127 ? 127 : i; i = i < -127 ? -127 : i; return i & 255; }
template <bool IN_BF16>
DI void rmsnorm_rows(const void* __restrict__ x, const float* __restrict__ g, int vb, signed char* xq, float* xsc) {
    const int lane = otid() & 63;
    const int row = vb * 4 + (otid() >> 6);
    float4 v[4]; float ss = 0.f;
#pragma unroll
    for (int j = 0; j < 4; ++j) {
        if (IN_BF16) { const uint2 w = ((const uint2*)((const bf16_t*)x + (size_t)row * DM))[lane + 64 * j];
            v[j] = make_float4(__uint_as_float(w.x << 16), __uint_as_float(w.x & 0xffff0000u), __uint_as_float(w.y << 16), __uint_as_float(w.y & 0xffff0000u)); }
        else v[j] = ((const float4*)((const float*)x + (size_t)row * DM))[lane + 64 * j];
        ss += v[j].x * v[j].x + v[j].y * v[j].y + v[j].z * v[j].z + v[j].w * v[j].w;
    }
    ss = wave_sum(ss);
    const float rinv = rsqrtf(ss * (1.f / DM) + EPSN);
    float am = 0.f;
#pragma unroll
    for (int j = 0; j < 4; ++j) {
        const float4 gg = ((const float4*)g)[lane + 64 * j];
        v[j].x *= rinv * gg.x; v[j].y *= rinv * gg.y; v[j].z *= rinv * gg.z; v[j].w *= rinv * gg.w;
        am = fmaxf(am, fmaxf(fmaxf(fabsf(v[j].x), fabsf(v[j].y)), fmaxf(fabsf(v[j].z), fabsf(v[j].w))));
    }
    am = wave_max(am);
    const float sc = am > 0.f ? 127.f / am : 0.f;
    u32* qrow = (u32*)(xq + (size_t)row * DM);
#pragma unroll
    for (int j = 0; j < 4; ++j)
        qrow[lane + 64 * j] = (u32)q8(v[j].x * sc) | ((u32)q8(v[j].y * sc) << 8) | ((u32)q8(v[j].z * sc) << 16) | ((u32)q8(v[j].w * sc) << 24);
    if (lane == 0) xsc[row] = am * (1.f / 127.f);
}
#define PREP_T0 48
#define PREP_T1 (PREP_T0 + 16 * 16)
#define PREP_T2 (PREP_T1 + 64)
#define PREP_T3 (PREP_T2 + 16 * 32)
#define PREP_T4 (PREP_T3 + 2 * 32)
#define PREP_C0 (PREP_T4 + 64)
#define PREP_C1 (PREP_C0 + 8192)
#define PREP_C2 (PREP_C1 + 8192)
#define PREP_N  (PREP_C2 + 8192)
template <bool INT8>
DI void fp8_rows(const float* __restrict__ src, unsigned char* __restrict__ dst, float* __restrict__ inv_scale, int vb) {
    const int lane = otid() & 63;
    const int row = vb * 4 + (otid() >> 6);
    const float4* sr = (const float4*)(src + (size_t)row * DM) + lane;
    float4 v[4]; float am = 0.f;
#pragma unroll
    for (int j = 0; j < 4; ++j) { v[j] = sr[64 * j]; am = fmaxf(am, fmaxf(fmaxf(fabsf(v[j].x), fabsf(v[j].y)), fmaxf(fabsf(v[j].z), fabsf(v[j].w)))); }
    am = wave_max(am);
    float sc, inv;
    if (INT8) { sc = am > 0.f ? 127.f / am : 0.f; inv = am * (1.f / 127.f); }
    else {
        int e = (int)((__float_as_uint(am) >> 23) & 255u) - 127;
        if (am == 0.f) e = 0;
        e = e < -100 ? -100 : e;
        sc = __uint_as_float((u32)(127 + 7 - e) << 23); inv = __uint_as_float((u32)(127 + e - 7) << 23);
    }
    unsigned char* drow = dst + (size_t)(row >> 14) * NEXP * DM + (size_t)(row & (NEXP - 1)) * 128;
#pragma unroll
    for (int j = 0; j < 4; ++j) {
        const int dim = 4 * (lane + 64 * j);
        u32 w;
        if (INT8) w = (u32)q8(v[j].x * sc) | ((u32)q8(v[j].y * sc) << 8) | ((u32)q8(v[j].z * sc) << 16) | ((u32)q8(v[j].w * sc) << 24);
        else { int t = __builtin_amdgcn_cvt_pk_fp8_f32(v[j].x * sc, v[j].y * sc, 0, false); t = __builtin_amdgcn_cvt_pk_fp8_f32(v[j].z * sc, v[j].w * sc, t, true); w = (u32)t; }
        *(u32*)(drow + (size_t)(dim >> 7) * NEXP * 128 + (dim & 127)) = w;
    }
    if (lane == 0) inv_scale[row] = inv;
}
DI void wq8_item(const float* __restrict__ W, signed char* __restrict__ Wt, float* __restrict__ wsc, int t, unsigned char* smem, int N) {
    float* red = (float*)smem;
    const int tid = otid(), n = tid & 63, kq = tid >> 6;
    const float* col = W + t * 64 + n;
    float am = 0.f;
#pragma unroll 16
    for (int k = 0; k < 256; ++k) am = fmaxf(am, fabsf(col[(size_t)(kq * 256 + k) * N]));
    __syncthreads();
    red[kq * 64 + n] = am;
    __syncthreads();
    am = fmaxf(fmaxf(red[n], red[64 + n]), fmaxf(red[128 + n], red[192 + n]));
    const float sc = am > 0.f ? 127.f / am : 0.f;
    if (kq == 0) wsc[t * 64 + n] = am * (1.f / 127.f);
    signed char* drow = Wt + (size_t)(t * 64 + n) * 1024;
#pragma unroll 1
    for (int kb = 0; kb < 16; ++kb) {
        const int k0 = kb * 64 + kq * 16;
        u32 w[4];
#pragma unroll
        for (int j = 0; j < 4; ++j) {
            const float* c4 = col + (size_t)(k0 + 4 * j) * N;
            w[j] = (u32)q8(c4[0] * sc) | ((u32)q8(c4[N] * sc) << 8) | ((u32)q8(c4[2 * N] * sc) << 16) | ((u32)q8(c4[3 * N] * sc) << 24);
        }
        *(uint4*)(drow + k0) = make_uint4(w[0], w[1], w[2], w[3]);
    }
}
DI void ph_prep(const Params& p, int vb, unsigned char* smem) {
    if (vb < PREP_T0) wq8_item(p.in[2], WSP(signed char, WS_W_ATTIN), WSP(float, WS_WAS), vb, smem, ATT_IN);
    else if (vb < PREP_T1) transpose_tile(p.in[12], WSP(bf16_t, WS_W_ATTOUT), DM, DM, vb - PREP_T0, smem);
    else if (vb < PREP_T2) wq8_item(p.in[14], WSP(signed char, WS_W_SGUIN), WSP(float, WS_WSS), vb - PREP_T1, smem, 4096);
    else if (vb < PREP_T3) transpose_tile(p.in[18], WSP(bf16_t, WS_W_SGUOUT), CW, DM, vb - PREP_T2, smem);
    else if (vb < PREP_T4) { const int t = vb - PREP_T3, l = t / 32; wq8_item(p.in[20] + (size_t)l * DM * 2048, WSP(signed char, WS_W_PQ) + (size_t)l * 2048 * DM, WSP(float, WS_WQS) + l * 2048, t % 32, smem, 2048); }
    else if (vb < PREP_C0) cvt_chunk(p.in[21], WSP(bf16_t, WS_W_SUBK), vb - PREP_T4);
    else if (vb < PREP_C1) fp8_rows<true>(p.in[22], p.ws + WS_DOWN, WSP(float, WS_DSC), vb - PREP_C0);
    else if (vb < PREP_C2) fp8_rows<false>(p.in[23], p.ws + WS_UP, WSP(float, WS_USC), vb - PREP_C1);
    else rmsnorm_rows<false>(p.in[0], p.in[1], vb - PREP_C2, WSP(signed char, WS_XQ), WSP(float, WS_XSC));
}

DI float compute_lam(const Params& p, int lane) {
    const float a = wave_sum(p.in[7][lane] * p.in[8][lane]);
    const float b = wave_sum(p.in[9][lane] * p.in[10][lane]);
    return __expf(a) - __expf(b) + 0.2f;
}
DI void ce_desc(u32& a, u32& b) { const u32 hi = max(a, b), lo = min(a, b); a = hi; b = lo; }
DI void sort16_desc(u32 (&v)[16]) {
#pragma unroll
    for (int k = 2; k <= 16; k <<= 1)
#pragma unroll
        for (int j = k >> 1; j > 0; j >>= 1)
#pragma unroll
            for (int i = 0; i < 16; ++i) {
                const int l = i ^ j;
                if (l > i) { if ((i & k) == 0) ce_desc(v[i], v[l]); else ce_desc(v[l], v[i]); }
            }
}
DI void merge16_desc(u32 (&a)[16], const u32 (&b)[16]) {
#pragma unroll
    for (int i = 0; i < 16; ++i) a[i] = max(a[i], b[15 - i]);
#pragma unroll
    for (int j = 8; j > 0; j >>= 1)
#pragma unroll
        for (int i = 0; i < 16; ++i) { const int l = i ^ j; if (l > i) ce_desc(a[i], a[l]); }
}
DI void top16_insert(u32 (&lst)[16], u32 x) {
#pragma unroll
    for (int j = 0; j < 16; ++j) { const u32 hi = max(lst[j], x); x = min(lst[j], x); lst[j] = hi; }
}
DI void unpack8(const uint4 v, float (&f)[8]) {
    f[0] = __uint_as_float(v.x << 16); f[1] = __uint_as_float(v.x & 0xffff0000u);
    f[2] = __uint_as_float(v.y << 16); f[3] = __uint_as_float(v.y & 0xffff0000u);
    f[4] = __uint_as_float(v.z << 16); f[5] = __uint_as_float(v.z & 0xffff0000u);
    f[6] = __uint_as_float(v.w << 16); f[7] = __uint_as_float(v.w & 0xffff0000u);
}
typedef float f32x2_t __attribute__((ext_vector_type(2)));
DI void unpack16fp8(const uint4 w, float (&f)[16]) {
    f32x2_t t;
    t = __builtin_amdgcn_cvt_pk_f32_fp8((int)w.x, false); f[0] = t[0]; f[1] = t[1];
    t = __builtin_amdgcn_cvt_pk_f32_fp8((int)w.x, true);  f[2] = t[0]; f[3] = t[1];
    t = __builtin_amdgcn_cvt_pk_f32_fp8((int)w.y, false); f[4] = t[0]; f[5] = t[1];
    t = __builtin_amdgcn_cvt_pk_f32_fp8((int)w.y, true);  f[6] = t[0]; f[7] = t[1];
    t = __builtin_amdgcn_cvt_pk_f32_fp8((int)w.z, false); f[8] = t[0]; f[9] = t[1];
    t = __builtin_amdgcn_cvt_pk_f32_fp8((int)w.z, true);  f[10] = t[0]; f[11] = t[1];
    t = __builtin_amdgcn_cvt_pk_f32_fp8((int)w.w, false); f[12] = t[0]; f[13] = t[1];
    t = __builtin_amdgcn_cvt_pk_f32_fp8((int)w.w, true);  f[14] = t[0]; f[15] = t[1];
}
struct PeerPre { int e[16]; uint4 xa, xb; float2 r; };
struct PeerRows { uint4 d[8]; float c[8]; };
template <bool UP>
DI PeerPre peer_prefetch(const Params& p, int tok, int sl, int lane) {
    PeerPre q;
    const int4* rix = (const int4*)(WSP(int, WS_RIDX) + (size_t)tok * 128 + 16 * (lane >> 3));
#pragma unroll
    for (int j = 0; j < 4; ++j) { const int4 t = rix[j]; q.e[4 * j] = t.x; q.e[4 * j + 1] = t.y; q.e[4 * j + 2] = t.z; q.e[4 * j + 3] = t.w; }
    if (UP) {
        const u32 w = *(const u32*)(WSP(bf16_t, WS_RES) + (size_t)tok * DM + sl * 128 + 16 * (lane & 7) + 2 * (lane >> 3));
        q.r = make_float2(__uint_as_float(w << 16), __uint_as_float(w & 0xffff0000u));
    } else {
        q.xa = *(const uint4*)(WSP(signed char, WS_XQ) + (size_t)tok * DM + sl * 128 + 16 * (lane & 7));
    }
    return q;
}
template <int HF, bool UP>
DI void peer_issue_rows(const Params& p, const unsigned char* tab, const PeerPre& q, int tok, int lane, PeerRows& R) {
    const unsigned dco = 16u * (unsigned)(lane & 7);
#pragma unroll
    for (int bi = 0; bi < 8; ++bi) R.d[bi] = *(const uint4*)(tab + ((unsigned)q.e[8 * HF + bi] * 128u + dco));
    if (UP) {
        const float4* cf = (const float4*)(WSP(float, WS_RG) + (size_t)tok * 128 + 16 * (lane >> 3) + 8 * HF);
        const float4 c0 = cf[0], c1 = cf[1];
        R.c[0] = c0.x; R.c[1] = c0.y; R.c[2] = c0.z; R.c[3] = c0.w; R.c[4] = c1.x; R.c[5] = c1.y; R.c[6] = c1.z; R.c[7] = c1.w;
    }
}
template <int HF>
DI void peer_down_half(const PeerPre& q, const PeerRows& R, float (&part)[16]) {
#pragma unroll
    for (int bi = 0; bi < 8; ++bi) {
        int a = __builtin_amdgcn_sdot4((int)R.d[bi].x, (int)q.xa.x, 0, false);
        a = __builtin_amdgcn_sdot4((int)R.d[bi].y, (int)q.xa.y, a, false);
        a = __builtin_amdgcn_sdot4((int)R.d[bi].z, (int)q.xa.z, a, false);
        a = __builtin_amdgcn_sdot4((int)R.d[bi].w, (int)q.xa.w, a, false);
        part[8 * HF + bi] = (float)a;
    }
}
DI void peer_down_fin(const Params& p, const float (&part)[16], int tok, int sl, int lane) {
    const bool b2 = lane & 4, b1 = lane & 2, b0 = lane & 1;
    float r8[8], r4[4], r2[2];
#pragma unroll
    for (int i = 0; i < 8; ++i) { const float snd = b2 ? part[i] : part[i + 8]; const float kp = b2 ? part[i + 8] : part[i]; r8[i] = kp + __shfl_xor(snd, 4); }
#pragma unroll
    for (int i = 0; i < 4; ++i) { const float snd = b1 ? r8[i] : r8[i + 4]; const float kp = b1 ? r8[i + 4] : r8[i]; r4[i] = kp + __shfl_xor(snd, 2); }
#pragma unroll
    for (int i = 0; i < 2; ++i) { const float snd = b0 ? r4[i] : r4[i + 2]; const float kp = b0 ? r4[i + 2] : r4[i]; r2[i] = kp + __shfl_xor(snd, 1); }
    u32* pd = WSP(u32, WS_QBUF) + ((size_t)tok * 8 + sl) * 64;
    pd[lane] = pack2(r2[0], r2[1]);
}
DI void ph_peer_comb(const Params& p, int vb, int l) {
    const int tid = otid(), lane = tid & 63;
    const int tok = vb * 4 + (tid >> 6);
    const u32* pd = WSP(u32, WS_QBUF) + (size_t)tok * 8 * 64;
    const int* rix = WSP(int, WS_RIDX) + (size_t)tok * 128;
    float* rgp = WSP(float, WS_RG) + (size_t)tok * 128;
    const float* dsc = WSP(float, WS_DSC) + (size_t)l * NEXP;
    const float* usc = WSP(float, WS_USC) + (size_t)l * NEXP;
    const float xs = WSP(float, WS_XSC)[tok];
    float t0 = 0.f, t1 = 0.f;
#pragma unroll
    for (int sl = 0; sl < 8; ++sl) { const u32 w = pd[sl * 64 + lane]; t0 += __uint_as_float(w << 16); t1 += __uint_as_float(w & 0xffff0000u); }
    const int2 e = *(const int2*)(rix + 2 * lane);
    float2 g = *(const float2*)(rgp + 2 * lane);
    g.x = g.x * gelu_tanh(t0 * dsc[e.x] * xs) * usc[e.x];
    g.y = g.y * gelu_tanh(t1 * dsc[e.y] * xs) * usc[e.y];
    *(float2*)(rgp + 2 * lane) = g;
}
template <int HF>
DI void peer_up_half(const PeerPre& q, const PeerRows& R, float (&y)[16]) {
#pragma unroll
    for (int bi = 0; bi < 8; ++bi) {
        const float c = R.c[bi];
        float w[16]; unpack16fp8(R.d[bi], w);
#pragma unroll
        for (int i = 0; i < 16; ++i) y[i] += c * w[i];
        asm volatile("" : "+v"(y[0]), "+v"(y[1]), "+v"(y[2]), "+v"(y[3]), "+v"(y[4]), "+v"(y[5]), "+v"(y[6]), "+v"(y[7]), "+v"(y[8]), "+v"(y[9]), "+v"(y[10]), "+v"(y[11]), "+v"(y[12]), "+v"(y[13]), "+v"(y[14]), "+v"(y[15]));
    }
}
DI void peer_up_fin(const Params& p, const PeerPre& q, const float (&y)[16], int tok, int sl, int lane, bool final_layer) {
    const int rg = lane >> 3, dc = lane & 7;
    const bool b5 = lane & 32, b4 = lane & 16, b3 = lane & 8;
    float r8[8], r4[4], r2[2];
#pragma unroll
    for (int i = 0; i < 8; ++i) { const float snd = b5 ? y[i] : y[i + 8]; const float kp = b5 ? y[i + 8] : y[i]; r8[i] = kp + __shfl_xor(snd, 32); }
#pragma unroll
    for (int i = 0; i < 4; ++i) { const float snd = b4 ? r8[i] : r8[i + 4]; const float kp = b4 ? r8[i + 4] : r8[i]; r4[i] = kp + __shfl_xor(snd, 16); }
#pragma unroll
    for (int i = 0; i < 2; ++i) { const float snd = b3 ? r4[i] : r4[i + 2]; const float kp = b3 ? r4[i + 2] : r4[i]; r2[i] = kp + __shfl_xor(snd, 8); }
    float2 v = q.r;
    v.x += r2[0]; v.y += r2[1];
    if (final_layer) *(float2*)(p.out + (size_t)tok * DM + sl * 128 + 16 * dc + 2 * rg) = v;
    else *(u32*)(WSP(bf16_t, WS_RES) + (size_t)tok * DM + sl * 128 + 16 * dc + 2 * rg) = pack2(v.x, v.y);
}
template <bool UP>
DI void run_peer_sliced(const Params& p, int l, unsigned char* smem) {
    volatile LAS unsigned* st = (volatile LAS unsigned*)(smem + SMEM_BYTES);
    const int nloc = (int)st[0], nx = (int)st[1], rank = (int)st[2], xi = (int)st[3];
    const int tid = otid512(), lane = tid & 63, wave = tid >> 6;
    const int stride = nloc * 8;
#pragma unroll 1
    for (int sl = xi; sl < 8; sl += nx) {
        const unsigned char* tab = p.ws + (UP ? WS_UP : WS_DOWN) + (size_t)l * NEXP * DM + (size_t)sl * NEXP * 128;
        int tok = rank * 8 + wave;
        if (tok >= NTOK) continue;
        PeerPre qc = peer_prefetch<UP>(p, tok, sl, lane);
        PeerRows R;
        peer_issue_rows<0, UP>(p, tab, qc, tok, lane, R);
#pragma unroll 1
        for (; tok < NTOK; tok += stride) {
            const int tn = tok + stride < NTOK ? tok + stride : tok;
            const PeerPre qn = peer_prefetch<UP>(p, tn, sl, lane);
            float acc[16];
#pragma unroll
            for (int i = 0; i < 16; ++i) acc[i] = 0.f;
            PeerRows Rn;
            peer_issue_rows<1, UP>(p, tab, qc, tok, lane, Rn);
            __builtin_amdgcn_sched_barrier(0);
            if (UP) peer_up_half<0>(qc, R, acc); else peer_down_half<0>(qc, R, acc);
            __builtin_amdgcn_sched_barrier(0);
            peer_issue_rows<0, UP>(p, tab, qn, tn, lane, R);
            __builtin_amdgcn_sched_barrier(0);
            if (UP) { peer_up_half<1>(qc, Rn, acc); peer_up_fin(p, qc, acc, tok, sl, lane, l == 1); }
            else { peer_down_half<1>(qc, Rn, acc); peer_down_fin(p, acc, tok, sl, lane); }
            __builtin_amdgcn_sched_barrier(0);
            qc = qn;
        }
    }
}


typedef short bf16x8 __attribute__((ext_vector_type(8)));
typedef float f32x16 __attribute__((ext_vector_type(16)));
#define MFMA32(a, b, c) __builtin_amdgcn_mfma_f32_32x32x16_bf16((a), (b), (c), 0, 0, 0)
typedef short s16x4 __attribute__((ext_vector_type(4)));
DI bf16x8 pack_p(const f32x16& pt, int s) {
    uint4 o;
    o.x = pack2(pt[8 * s + 0], pt[8 * s + 1]); o.y = pack2(pt[8 * s + 2], pt[8 * s + 3]);
    o.z = pack2(pt[8 * s + 4], pt[8 * s + 5]); o.w = pack2(pt[8 * s + 6], pt[8 * s + 7]);
    return __builtin_bit_cast(bf16x8, o);
}

DI void stage_tile(const bf16_t* __restrict__ g, int ld, int row0, int k0, unsigned char* lt, int wave, int lane) {
#pragma unroll
    for (int i = 0; i < 4; ++i) {
        const int inst = wave * 4 + i;
        const int row = inst * 8 + (lane >> 3);
        const int c = (lane & 7) ^ ((row >> 1) & 7);
        __builtin_amdgcn_global_load_lds((const unsigned*)(g + (size_t)(row0 + row) * ld + k0 + c * 8),
                                         (unsigned*)(lt + inst * 1024 + lane * 16), 16, 0, 0);
    }
}
DI bf16x8 lds_frag(const unsigned char* lt, int row, int c) {
    return *(const bf16x8*)(lt + row * 128 + ((c ^ ((row >> 1) & 7)) << 4));
}
DI int crow(int r, int fh) { return (r & 3) + 8 * (r >> 2) + 4 * fh; }

namespace pg8 {
#define PG8_LAS __attribute__((address_space(3)))
typedef float f32x4 __attribute__((ext_vector_type(4)));
typedef unsigned u32x4 __attribute__((ext_vector_type(4)));
constexpr int BM = 256, BK = 64, HALF = 128, HTB = HALF * BK * 2  , STAGE_BYTES = 8 * HTB;
__host__ __device__ __forceinline__ int lds_byte(int r, int c) { const int st = (r >> 4) * 2 + (c >> 5), rr = r & 15, cc = c & 31, ob = rr * 64 + cc * 2; return st * 1024 + (ob ^ (((ob >> 9) & 1) << 5)); }
__host__ __device__ __forceinline__ void stage_rc(int b, int& R, int& C) { const int st = b / 1024, sb = b % 1024, swz = sb ^ (((sb >> 9) & 1) << 5); R = (st >> 1) * 16 + swz / 64; C = (st & 1) * 32 + (swz % 64) / 2; }
__host__ __device__ __forceinline__ int perm32(int rho) { const int n = rho >> 4, i = rho & 15; return 8 * (i >> 2) + 4 * n + (i & 3); }
struct Unit { int pm, pn; };
struct Gemm { const void* A; const void* Bt; int M, N, K; const float* rsc; const float* csc; };
struct XcdOrder {
    int ntn, nloc, nx, rank, xi, nown, total;
    __device__ __forceinline__ void init(int nmt, int ntn_, int nloc_, int nx_, int rank_, int xi_) {
        ntn = ntn_; nloc = nloc_; nx = nx_; rank = rank_; xi = xi_; nown = xi < nmt ? (nmt - xi + nx - 1) / nx : 0; total = nown * ntn; }
    __device__ __forceinline__ bool next(int i, Unit& u) const {
        const int t = rank + i * nloc; if (t >= total) return false;
        const int g4 = t / (4 * ntn), r = t - g4 * 4 * ntn;
        const int left = nown - 4 * g4, gs = left < 4 ? left : 4;
        const int nt = r / gs, mi = r - nt * gs;
        u.pm = (4 * g4 + mi) * nx + xi; u.pn = nt; return true;
    }
    __device__ __forceinline__ void a_ready(const Unit&) const {}
    __device__ __forceinline__ void done(const Unit&) const {}
};
typedef int i32x4 __attribute__((ext_vector_type(4)));
template <class Epi, class Sched, bool ALIGN_EPI = false, bool SP2 = false, bool I8 = false>
__device__ __forceinline__ void gemm_phase(PG8_LAS unsigned char* lds, const Gemm g, const Sched& S, const Epi& E) {
    const int tid = otid512(), wid = __builtin_amdgcn_readfirstlane(tid >> 6), lane = tid & 63, wr = wid >> 2, wc = wid & 3, fr = lane & 15, fq = lane >> 4;
    const int K = g.K, KB = I8 ? K : 2 * K  , nt = KB / (BK * 2);
    unsigned voffA[2], voffB[2];
#pragma unroll
    for (int i = 0; i < 2; ++i) { int R, C; stage_rc(tid * 16 + i * 8192, R, C); const int Rb = Epi::PERM ? ((R & ~31) + perm32(R & 31)) : R;
        voffA[i] = (unsigned)(R * KB + C * 2); voffB[i] = (unsigned)(Rb * KB + C * 2); }
    const size_t kstep = (size_t)(BK * 2);
    const size_t hstep = (size_t)HALF * KB;
    const size_t tstep = 2 * hstep;
    const unsigned ldsw = (unsigned)wid * 1024u;
    const int aoff = lds_byte(wr * 64 + fr, fq * 8), boff = lds_byte(wc * 32 + fr, fq * 8);
#define PG8_SA(b, h) (((b) * 2 + (h)) * HTB)
#define PG8_SB(b, h) ((4 + (b) * 2 + (h)) * HTB)
#define PG8_STAGE(bufoff, gbase, voff) do { _Pragma("unroll") for (int _i = 0; _i < 2; ++_i) \
        __builtin_amdgcn_global_load_lds((const unsigned*)((const char*)(gbase) + (voff)[_i]), (PG8_LAS unsigned*)(lds + (bufoff) + ldsw + _i * 8192), 16, 0, 0); } while (0)
#define PG8_LDA(dst, b, h) do { _Pragma("unroll") for (int m = 0; m < 4; ++m) _Pragma("unroll") for (int k = 0; k < 2; ++k) dst[m][k] = *(const PG8_LAS bf16x8*)(lds + PG8_SA(b, h) + aoff + m * 2048 + k * 1024); } while (0)
#define PG8_LDB(dst, b, h) do { _Pragma("unroll") for (int n = 0; n < 2; ++n) _Pragma("unroll") for (int k = 0; k < 2; ++k) dst[n][k] = *(const PG8_LAS bf16x8*)(lds + PG8_SB(b, h) + boff + n * 2048 + k * 1024); } while (0)
#define PG8_MMA(ai, bj, At, Bt) do { __builtin_amdgcn_s_setprio(1); _Pragma("unroll") for (int m = 0; m < 4; ++m) _Pragma("unroll") for (int n = 0; n < 2; ++n) _Pragma("unroll") for (int k = 0; k < 2; ++k) \
        { if constexpr (I8) acc[ai][bj][m][n] = __builtin_bit_cast(f32x4, __builtin_amdgcn_mfma_i32_16x16x64_i8(__builtin_bit_cast(i32x4, Bt[n][k]), __builtin_bit_cast(i32x4, At[m][k]), __builtin_bit_cast(i32x4, acc[ai][bj][m][n]), 0, 0, 0)); \
          else acc[ai][bj][m][n] = __builtin_amdgcn_mfma_f32_16x16x32_bf16(Bt[n][k], At[m][k], acc[ai][bj][m][n], 0, 0, 0); } __builtin_amdgcn_s_setprio(0); } while (0)
#define PG8_WAIT_V(n) asm volatile("s_waitcnt vmcnt(" #n ")" ::: "memory")
#define PG8_WAIT_L(n) asm volatile("s_waitcnt lgkmcnt(" #n ")" ::: "memory")
#define PG8_BAR __builtin_amdgcn_s_barrier()
#define PG8_SCHED __builtin_amdgcn_sched_barrier(0)
    Unit cur, nxt; int ui = 0;
    if (!S.next(0, cur)) return;
    f32x4 acc[2][2][4][2];
#pragma unroll
    for (int a = 0; a < 2; ++a)
#pragma unroll
        for (int b = 0; b < 2; ++b)
#pragma unroll
            for (int m = 0; m < 4; ++m)
#pragma unroll
                for (int n = 0; n < 2; ++n) acc[a][b][m][n] = (f32x4){0.f, 0.f, 0.f, 0.f};
    bf16x8 At[4][2], B0[2][2], B1[2][2];
    const char* cA = (const char*)g.A + (size_t)cur.pm * tstep; const char* cB = (const char*)g.Bt + (size_t)cur.pn * tstep;
    S.a_ready(cur);
    if constexpr (SP2) {
        PG8_STAGE(PG8_SB(0, 0), cB, voffB); PG8_STAGE(PG8_SB(0, 1), cB + hstep, voffB); PG8_STAGE(PG8_SA(0, 0), cA, voffA); PG8_STAGE(PG8_SA(0, 1), cA + hstep, voffA);
        if (wr == 1) PG8_BAR;
        PG8_WAIT_V(2); PG8_BAR;
        PG8_STAGE(PG8_SB(1, 0), cB + kstep, voffB); PG8_STAGE(PG8_SA(1, 0), cA + kstep, voffA); PG8_STAGE(PG8_SB(1, 1), cB + hstep + kstep, voffB);
        PG8_WAIT_V(6); PG8_BAR;
    } else {
        PG8_STAGE(PG8_SB(0, 0), cB, voffB); PG8_STAGE(PG8_SA(0, 0), cA, voffA); PG8_STAGE(PG8_SB(0, 1), cB + hstep, voffB); PG8_STAGE(PG8_SA(0, 1), cA + hstep, voffA);
        if (wr == 1) PG8_BAR;
        PG8_WAIT_V(4); PG8_BAR;
        PG8_STAGE(PG8_SB(1, 0), cB + kstep, voffB); PG8_STAGE(PG8_SA(1, 0), cA + kstep, voffA); PG8_STAGE(PG8_SB(1, 1), cB + hstep + kstep, voffB);
        PG8_WAIT_V(6); PG8_BAR;
    }
    for (;;) {
        const bool has_next = S.next(ui + 1, nxt);
        const char* nA = has_next ? (const char*)g.A + (size_t)nxt.pm * tstep : cA; const char* nB = has_next ? (const char*)g.Bt + (size_t)nxt.pn * tstep : cB;
        for (int t = 0; t < nt; t += 2) {
            const bool last = (t == nt - 2);
            const char* a1 = cA + (size_t)(t + 1) * kstep;
            const char* a2 = last ? nA : cA + (size_t)(t + 2) * kstep; const char* b2 = last ? nB : cB + (size_t)(t + 2) * kstep;
            const char* a3 = a2 + kstep; const char* b3 = b2 + kstep;
            if (last && has_next) S.a_ready(nxt);
            if constexpr (SP2) {
            PG8_LDB(B0, 0, 0); PG8_LDB(B1, 0, 1); PG8_SCHED; PG8_LDA(At, 0, 0); PG8_STAGE(PG8_SA(1, 1), a1 + hstep, voffA);
            PG8_WAIT_V(8); PG8_WAIT_L(0); PG8_BAR; PG8_MMA(0, 0, At, B0); PG8_MMA(0, 1, At, B1); PG8_BAR; PG8_SCHED;
            PG8_LDA(At, 0, 1); PG8_STAGE(PG8_SB(0, 0), b2, voffB); PG8_STAGE(PG8_SB(0, 1), b2 + hstep, voffB); PG8_STAGE(PG8_SA(0, 0), a2, voffA);
            PG8_WAIT_V(8); PG8_WAIT_L(0); PG8_BAR; PG8_MMA(1, 0, At, B0); PG8_MMA(1, 1, At, B1); PG8_BAR; PG8_SCHED;
            PG8_LDB(B0, 1, 0); PG8_LDB(B1, 1, 1); PG8_SCHED; PG8_LDA(At, 1, 0); PG8_STAGE(PG8_SA(0, 1), a2 + hstep, voffA);
            PG8_WAIT_V(8); PG8_WAIT_L(0); PG8_BAR; PG8_MMA(0, 0, At, B0); PG8_MMA(0, 1, At, B1); PG8_BAR; PG8_SCHED;
            PG8_LDA(At, 1, 1); PG8_STAGE(PG8_SB(1, 0), b3, voffB); PG8_STAGE(PG8_SB(1, 1), b3 + hstep, voffB); PG8_STAGE(PG8_SA(1, 0), a3, voffA);
            PG8_WAIT_V(8); PG8_WAIT_L(0); PG8_BAR; PG8_MMA(1, 0, At, B0); PG8_MMA(1, 1, At, B1); PG8_BAR; PG8_SCHED;
            } else {
            PG8_LDB(B0, 0, 0); PG8_SCHED; PG8_LDA(At, 0, 0); PG8_STAGE(PG8_SA(1, 1), a1 + hstep, voffA);
            PG8_WAIT_L(8); PG8_BAR; PG8_WAIT_L(0); PG8_MMA(0, 0, At, B0); PG8_BAR; PG8_SCHED;
            PG8_LDB(B1, 0, 1); PG8_STAGE(PG8_SB(0, 0), b2, voffB);
            PG8_BAR; PG8_WAIT_L(0); PG8_MMA(0, 1, At, B1); PG8_BAR;
            PG8_LDA(At, 0, 1); PG8_STAGE(PG8_SA(0, 0), a2, voffA);
            PG8_BAR; PG8_WAIT_L(0); PG8_MMA(1, 0, At, B0); PG8_BAR; PG8_SCHED;
            PG8_STAGE(PG8_SB(0, 1), b2 + hstep, voffB);
            PG8_WAIT_V(6); PG8_BAR; PG8_MMA(1, 1, At, B1); PG8_BAR;
            PG8_LDB(B0, 1, 0); PG8_SCHED; PG8_LDA(At, 1, 0); PG8_STAGE(PG8_SA(0, 1), a2 + hstep, voffA);
            PG8_WAIT_L(8); PG8_BAR; PG8_WAIT_L(0); PG8_MMA(0, 0, At, B0); PG8_BAR; PG8_SCHED;
            PG8_LDB(B1, 1, 1); PG8_STAGE(PG8_SB(1, 0), b3, voffB);
            PG8_BAR; PG8_WAIT_L(0); PG8_MMA(0, 1, At, B1); PG8_BAR;
            PG8_LDA(At, 1, 1); PG8_STAGE(PG8_SA(1, 0), a3, voffA);
            PG8_BAR; PG8_WAIT_L(0); PG8_MMA(1, 0, At, B0); PG8_BAR; PG8_SCHED;
            PG8_STAGE(PG8_SB(1, 1), b3 + hstep, voffB);
            PG8_WAIT_V(6); PG8_BAR; PG8_MMA(1, 1, At, B1); PG8_BAR;
            }
        }
        if constexpr (ALIGN_EPI) { if (wr == 0) PG8_BAR; }
        if constexpr (I8) {
#pragma unroll
            for (int b = 0; b < 2; ++b) {
                const float* cp = g.csc + cur.pn * BM + b * HALF + wc * 32 + 8 * fq;
                const f32x4 c0 = *(const f32x4*)cp, c1 = *(const f32x4*)(cp + 4);
#pragma unroll
                for (int a = 0; a < 2; ++a)
#pragma unroll
                    for (int m = 0; m < 4; ++m) {
                        const float xs = g.rsc[cur.pm * BM + a * HALF + wr * 64 + m * 16 + fr];
                        acc[a][b][m][0] = __builtin_convertvector(__builtin_bit_cast(i32x4, acc[a][b][m][0]), f32x4) * c0 * xs;
                        acc[a][b][m][1] = __builtin_convertvector(__builtin_bit_cast(i32x4, acc[a][b][m][1]), f32x4) * c1 * xs;
                    }
            }
        }
        if constexpr (!Epi::AFTER_DRAIN) { E(acc, cur, wr, wc, fr, fq); S.done(cur); }
        if (!has_next) break;
#pragma unroll
        for (int a = 0; a < 2; ++a)
#pragma unroll
            for (int b = 0; b < 2; ++b)
#pragma unroll
                for (int m = 0; m < 4; ++m)
#pragma unroll
                    for (int n = 0; n < 2; ++n) acc[a][b][m][n] = (f32x4){0.f, 0.f, 0.f, 0.f};
        cur = nxt; cA = nA; cB = nB; ++ui;
        if constexpr (ALIGN_EPI) { if (wr == 1) PG8_BAR; }
    }
    PG8_WAIT_V(0);
    if constexpr (!ALIGN_EPI) { if (wr == 0) PG8_BAR; }
    PG8_BAR;
    if constexpr (Epi::AFTER_DRAIN) { E.fused(acc, cur, wr, wc, fr, fq, lds, wid, lane); S.done(cur); }
#undef PG8_SA
#undef PG8_SB
#undef PG8_STAGE
#undef PG8_LDA
#undef PG8_LDB
#undef PG8_MMA
#undef PG8_WAIT_V
#undef PG8_WAIT_L
#undef PG8_BAR
#undef PG8_SCHED
}
template <bool RES_BF16>
struct EpiResid {
    static constexpr bool PERM = true, AFTER_DRAIN = false;
    const void* resid; bf16_t* out;
    __device__ __forceinline__ void operator()(const f32x4 (&acc)[2][2][4][2], const Unit& u, int wr, int wc, int fr, int fq) const {
        const size_t base = (size_t)(u.pm * BM + wr * 64 + fr) * DM + u.pn * BM + wc * 32 + 8 * fq;
#pragma unroll
        for (int ai = 0; ai < 2; ++ai) {
            f32x4 rv[4][2][2];
#pragma unroll
            for (int m = 0; m < 4; ++m)
#pragma unroll
                for (int bj = 0; bj < 2; ++bj) {
                    const size_t o = base + (size_t)(ai * HALF + m * 16) * DM + bj * HALF;
                    if constexpr (RES_BF16) {
                        const u32x4 w = *(const u32x4*)((const bf16_t*)resid + o);
                        rv[m][bj][0] = (f32x4){__uint_as_float(w.x << 16), __uint_as_float(w.x & 0xffff0000u), __uint_as_float(w.y << 16), __uint_as_float(w.y & 0xffff0000u)};
                        rv[m][bj][1] = (f32x4){__uint_as_float(w.z << 16), __uint_as_float(w.z & 0xffff0000u), __uint_as_float(w.w << 16), __uint_as_float(w.w & 0xffff0000u)};
                    } else { const float* rp = (const float*)resid + o; rv[m][bj][0] = *(const f32x4*)rp; rv[m][bj][1] = *(const f32x4*)(rp + 4); }
                }
            asm volatile("" ::: "memory");
#pragma unroll
            for (int m = 0; m < 4; ++m)
#pragma unroll
                for (int bj = 0; bj < 2; ++bj) {
                    const f32x4 a = rv[m][bj][0] + acc[ai][bj][m][0], b = rv[m][bj][1] + acc[ai][bj][m][1];
                    u32x4 w; w.x = pack2(a[0], a[1]); w.y = pack2(a[2], a[3]); w.z = pack2(b[0], b[1]); w.w = pack2(b[2], b[3]);
                    *(u32x4*)(out + base + (size_t)(ai * HALF + m * 16) * DM + bj * HALF) = w;
                }
            asm volatile("" ::: "memory");
        }
    }
};
struct EpiProj {
    static constexpr bool PERM = true, AFTER_DRAIN = false;
    const float* aq; const float* ak; const float* bq; const float* bk; bf16_t* proj; PG8_LAS float* xs;
    __device__ __forceinline__ void operator()(const f32x4 (&acc)[2][2][4][2], const Unit& u, int wr, int wc, int fr, int fq) const {
        const int wave = wr * 4 + wc;
#pragma unroll
        for (int ai = 0; ai < 2; ++ai)
#pragma unroll
            for (int m = 0; m < 4; ++m)
#pragma unroll
                for (int bj = 0; bj < 2; ++bj) {
                    const f32x4 a = acc[ai][bj][m][0], b = acc[ai][bj][m][1];
                    float t = a[0] * a[0] + a[1] * a[1] + a[2] * a[2] + a[3] * a[3] + b[0] * b[0] + b[1] * b[1] + b[2] * b[2] + b[3] * b[3];
                    t += __shfl_xor(t, 16); t += __shfl_xor(t, 32);
                    if (fq == 0) xs[wave * 256 + ((ai * 4 + m) * 2 + bj) * 16 + fr] = t;
                }
        asm volatile("s_waitcnt lgkmcnt(0)" ::: "memory");
        __builtin_amdgcn_s_barrier();
#pragma unroll
        for (int bj = 0; bj < 2; ++bj) {
            const int gcol = u.pn * BM + bj * HALF + wc * 32 + 8 * fq;
            const float* gain = nullptr; float scale = 1.f;
            if (gcol < 512) { gain = aq + (gcol & 63); scale = 0.125f; }
            else if (gcol < 1024) gain = ak + (gcol & 63);
            else if (gcol < 1536) gain = nullptr;
            else if (gcol < 2048) { gain = bq + (gcol & 127); scale = 0.125f; }
            else if (gcol < 2560) gain = bk + (gcol & 127);
            f32x4 g0 = {1.f, 1.f, 1.f, 1.f}, g1 = {1.f, 1.f, 1.f, 1.f};
            if (gain) { g0 = *(const f32x4*)gain; g1 = *(const f32x4*)(gain + 4); }
#pragma unroll
            for (int ai = 0; ai < 2; ++ai)
#pragma unroll
                for (int m = 0; m < 4; ++m) {
                    float sc = 1.f;
                    if (gain) {
                        const int slot = ((ai * 4 + m) * 2 + bj) * 16 + fr;
                        sc = rsqrtf((xs[wave * 256 + slot] + xs[(wave ^ 1) * 256 + slot]) * (1.f / 64.f) + EPSN) * scale;
                    }
                    const f32x4 v0 = acc[ai][bj][m][0] * g0 * sc, v1 = acc[ai][bj][m][1] * g1 * sc;
                    u32x4 w; w.x = pack2(v0[0], v0[1]); w.y = pack2(v0[2], v0[3]); w.z = pack2(v1[0], v1[1]); w.w = pack2(v1[2], v1[3]);
                    *(u32x4*)(proj + (size_t)(u.pm * BM + ai * HALF + wr * 64 + m * 16 + fr) * ATT_IN + gcol) = w;
                }
        }
    }
};
struct EpiSgu {
    static constexpr bool PERM = true, AFTER_DRAIN = false;
    bf16_t* zu; bf16_t* zvt; float* ssq; PG8_LAS unsigned char* stg;
    __device__ __forceinline__ void operator()(const f32x4 (&acc)[2][2][4][2], const Unit& u, int wr, int wc, int fr, int fq) const {
        const int wave = wr * 4 + wc, lane = fq * 16 + fr;
        PG8_LAS unsigned short* tl = (PG8_LAS unsigned short*)(stg + wave * 2048);
#pragma unroll
        for (int ai = 0; ai < 2; ++ai)
#pragma unroll
            for (int bj = 0; bj < 2; ++bj) {
                const int gcol = u.pn * BM + bj * HALF + wc * 32 + 8 * fq;
                f32x4 g0[4], g1[4];
#pragma unroll
                for (int m = 0; m < 4; ++m) {
                    const f32x4 a = acc[ai][bj][m][0], b = acc[ai][bj][m][1];
                    g0[m] = (f32x4){gelu_tanh(a[0]), gelu_tanh(a[1]), gelu_tanh(a[2]), gelu_tanh(a[3])};
                    g1[m] = (f32x4){gelu_tanh(b[0]), gelu_tanh(b[1]), gelu_tanh(b[2]), gelu_tanh(b[3])};
                }
                if (gcol < CW) {
#pragma unroll
                    for (int m = 0; m < 4; ++m) {
                        u32x4 w; w.x = pack2(g0[m][0], g0[m][1]); w.y = pack2(g0[m][2], g0[m][3]); w.z = pack2(g1[m][0], g1[m][1]); w.w = pack2(g1[m][2], g1[m][3]);
                        *(u32x4*)(zu + (size_t)(u.pm * BM + ai * HALF + wr * 64 + m * 16 + fr) * CW + gcol) = w;
                    }
                } else {
                    const int vcol = gcol - CW;
#pragma unroll
                    for (int m = 0; m < 4; ++m) {
                        float t = g0[m][0] * g0[m][0] + g0[m][1] * g0[m][1] + g0[m][2] * g0[m][2] + g0[m][3] * g0[m][3]
                                + g1[m][0] * g1[m][0] + g1[m][1] * g1[m][1] + g1[m][2] * g1[m][2] + g1[m][3] * g1[m][3];
                        t += __shfl_xor(t, 16); t += __shfl_xor(t, 32);
                        if (fq == 0) ssq[(size_t)(u.pm * BM + ai * HALF + wr * 64 + m * 16 + fr) * 64 + (vcol >> 5)] = t;
                    }
#pragma unroll
                    for (int h = 0; h < 2; ++h) {
#pragma unroll
                        for (int mm = 0; mm < 2; ++mm) {
                            const int m = 2 * h + mm, rl = 16 * mm + fr;
#pragma unroll
                            for (int j = 0; j < 4; ++j) { tl[(8 * fq + j) * 32 + rl] = f2bf(g0[m][j]); tl[(8 * fq + 4 + j) * 32 + rl] = f2bf(g1[m][j]); }
                        }
                        const int c = lane >> 1, hh = lane & 1;
                        const u32x4 w0 = *(const PG8_LAS u32x4*)(tl + c * 32 + hh * 16), w1 = *(const PG8_LAS u32x4*)(tl + c * 32 + hh * 16 + 8);
                        bf16_t* dst = zvt + ((size_t)(2 * u.pm + ai) * CW + (u.pn * BM - CW) + bj * HALF + wc * 32 + c) * 128 + wr * 64 + 32 * h + hh * 16;
                        *(u32x4*)dst = w0; *(u32x4*)(dst + 8) = w1;
                        asm volatile("" ::: "memory");
                    }
                }
            }
    }
};
struct EpiQ {
    static constexpr bool PERM = true, AFTER_DRAIN = false;
    bf16_t* q;
    __device__ __forceinline__ void operator()(const f32x4 (&acc)[2][2][4][2], const Unit& u, int wr, int wc, int fr, int fq) const {
#pragma unroll
        for (int ai = 0; ai < 2; ++ai)
#pragma unroll
            for (int m = 0; m < 4; ++m)
#pragma unroll
                for (int bj = 0; bj < 2; ++bj) {
                    const f32x4 a = acc[ai][bj][m][0], b = acc[ai][bj][m][1];
                    u32x4 w; w.x = pack2(a[0], a[1]); w.y = pack2(a[2], a[3]); w.z = pack2(b[0], b[1]); w.w = pack2(b[2], b[3]);
                    *(u32x4*)(q + (size_t)(u.pm * BM + ai * HALF + wr * 64 + m * 16 + fr) * 2048 + u.pn * BM + bj * HALF + wc * 32 + 8 * fq) = w;
                }
    }
};
}
DI void run_gemmq_pg8(const Params& p, int l, unsigned char* smem) {
    volatile LAS unsigned* st = (volatile LAS unsigned*)(smem + SMEM_BYTES);
    pg8::XcdOrder S; S.init(NTOK / 256, 2048 / 256, (int)st[0], (int)st[1], (int)st[2], (int)st[3]);
    const pg8::Gemm g{WSP(signed char, WS_XQ), WSP(signed char, WS_W_PQ) + (size_t)l * 2048 * DM, NTOK, 2048, DM, WSP(float, WS_XSC), WSP(float, WS_WQS) + l * 2048};
    pg8::EpiQ E; E.q = WSP(bf16_t, WS_QBUF);
    __syncthreads();
    pg8::gemm_phase<pg8::EpiQ, pg8::XcdOrder, true, true, true>((PG8_LAS unsigned char*)smem, g, S, E);
}
template <int WHICH>
DI void run_gemm_pg8(const Params& p, unsigned char* smem) {
    volatile LAS unsigned* st = (volatile LAS unsigned*)(smem + SMEM_BYTES);
    pg8::XcdOrder S; S.init(NTOK / 256, DM / 256, (int)st[0], (int)st[1], (int)st[2], (int)st[3]);
    pg8::Gemm g;
    pg8::EpiResid<WHICH == 1> E; E.out = WSP(bf16_t, WS_RES);
    if (WHICH == 0) { g = pg8::Gemm{WSP(bf16_t, WS_MIXED), WSP(bf16_t, WS_W_ATTOUT), NTOK, DM, DM, nullptr, nullptr}; E.resid = p.in[0]; }
    else { g = pg8::Gemm{WSP(bf16_t, WS_Z_U), WSP(bf16_t, WS_W_SGUOUT), NTOK, DM, CW, nullptr, nullptr}; E.resid = WSP(bf16_t, WS_RES); }
    __syncthreads();
    pg8::gemm_phase<pg8::EpiResid<WHICH == 1>, pg8::XcdOrder, true, true>((PG8_LAS unsigned char*)smem, g, S, E);
}

DI void run_gemm1_pg8(const Params& p, unsigned char* smem) {
    volatile LAS unsigned* st = (volatile LAS unsigned*)(smem + SMEM_BYTES);
    pg8::XcdOrder S; S.init(NTOK / 256, ATT_IN / 256, (int)st[0], (int)st[1], (int)st[2], (int)st[3]);
    const pg8::Gemm g{WSP(signed char, WS_XQ), WSP(signed char, WS_W_ATTIN), NTOK, ATT_IN, DM, WSP(float, WS_XSC), WSP(float, WS_WAS)};
    pg8::EpiProj E; E.aq = p.in[3]; E.ak = p.in[4]; E.bq = p.in[5]; E.bk = p.in[6]; E.proj = WSP(bf16_t, WS_PROJ); E.xs = (PG8_LAS float*)(smem + PG8_EXTRA);
    __syncthreads();
    pg8::gemm_phase<pg8::EpiProj, pg8::XcdOrder, true, true, true>((PG8_LAS unsigned char*)smem, g, S, E);
}
DI void run_gemm4_pg8(const Params& p, unsigned char* smem) {
    volatile LAS unsigned* st = (volatile LAS unsigned*)(smem + SMEM_BYTES);
    pg8::XcdOrder S; S.init(NTOK / 256, 4096 / 256, (int)st[0], (int)st[1], (int)st[2], (int)st[3]);
    const pg8::Gemm g{WSP(signed char, WS_XQ), WSP(signed char, WS_W_SGUIN), NTOK, 4096, DM, WSP(float, WS_XSC), WSP(float, WS_WSS)};
    pg8::EpiSgu E; E.zu = WSP(bf16_t, WS_Z_U); E.zvt = WSP(bf16_t, WS_Z_VT); E.ssq = WSP(float, WS_SSQ); E.stg = (PG8_LAS unsigned char*)(smem + PG8_EXTRA);
    __syncthreads();
    pg8::gemm_phase<pg8::EpiSgu, pg8::XcdOrder, true, true, true>((PG8_LAS unsigned char*)smem, g, S, E);
}

DI u32 cand_key(float s, int ci) { return (f2ord(s) & ~255u) | (u32)(255 - ci); }
template <int P>
DI void score_half(const bf16x8 (&qf)[8], const unsigned char* skl, int fr, int fh, u32 (&lst)[16]) {
#pragma unroll
    for (int j = 0; j < 16; ++j) lst[j] = 0u;
#pragma unroll 1
    for (int kt = 0; kt < 4; ++kt) {
        f32x16 st;
#pragma unroll
        for (int r = 0; r < 16; ++r) st[r] = 0.f;
        const int row = P * 128 + kt * 32 + fr;
        const unsigned char* skr = skl + row * 256;
#pragma unroll
        for (int ks = 0; ks < 8; ++ks) st = MFMA32(*(const bf16x8*)(skr + (((2 * ks + fh) ^ (row & 15)) << 4)), qf[ks], st);
        u32 ks_[16];
#pragma unroll
        for (int r = 0; r < 16; ++r) ks_[r] = (f2ord(st[r]) & ~127u) | (u32)(127 - (kt * 32 + crow(r, fh)));
        sort16_desc(ks_);
        merge16_desc(lst, ks_);
    }
    u32 other[16];
#pragma unroll
    for (int j = 0; j < 16; ++j) other[j] = (u32)__shfl_xor((int)lst[j], 32);
    merge16_desc(lst, other);
}
DI void run_score(const Params& p, int l, unsigned char* smem) {
    const int tid = otid512(), wave = tid >> 6, lane = tid & 63, fr = lane & 31, fh = lane >> 5;
    int cur_h = -1;
    bf16x8 qa[8], qb[8];
    if ((int)blockIdx.x < 8 * (NTOK / 256)) {
        const int it0 = blockIdx.x;
        const bf16_t* q0 = WSP(bf16_t, WS_QBUF) + (size_t)((it0 >> 3) * 256 + wave * 32 + fr) * 2048 + (it0 & 7) * 256 + 8 * fh;
#pragma unroll
        for (int ks = 0; ks < 8; ++ks) { qa[ks] = *(const bf16x8*)(q0 + 16 * ks); qb[ks] = *(const bf16x8*)(q0 + 128 + 16 * ks); }
    }
#pragma unroll 1
    for (int it = blockIdx.x; it < 8 * (NTOK / 256); it += gridDim.x) {
    const int h = it & 7, oct = it >> 3;
    if (h != cur_h) {
        __syncthreads();
        const bf16_t* skg = WSP(bf16_t, WS_W_SUBK) + ((size_t)l * 16 + h * 2) * 128 * 128;
#pragma unroll
        for (int i = 0; i < 8; ++i) {
            const int idx = wave * 8 + i;
            const int row = 4 * idx + (lane >> 4), cp = lane & 15;
            __builtin_amdgcn_global_load_lds((const unsigned*)(skg + (size_t)row * 128 + ((cp ^ (row & 15)) << 3)), (unsigned*)(smem + idx * 1024 + lane * 16), 16, 0, 0);
        }
        asm volatile("s_waitcnt vmcnt(0)" ::: "memory");
        __syncthreads();
        cur_h = h;
    }
    const int tok = oct * 256 + wave * 32 + fr;
    const unsigned char* skh = smem;
    u32 L0[16], L1[16];
    score_half<0>(qa, skh, fr, fh, L0);
    score_half<1>(qb, skh, fr, fh, L1);
    {
        const int itn = it + gridDim.x < 8 * (NTOK / 256) ? it + gridDim.x : it;
        const bf16_t* qn = WSP(bf16_t, WS_QBUF) + (size_t)((itn >> 3) * 256 + wave * 32 + fr) * 2048 + (itn & 7) * 256 + 8 * fh;
#pragma unroll
        for (int ks = 0; ks < 8; ++ks) { qa[ks] = *(const bf16x8*)(qn + 16 * ks); qb[ks] = *(const bf16x8*)(qn + 128 + 16 * ks); }
    }
    LAS int* slot = (LAS int*)(smem + 65536 + wave * (64 * 132)) + lane * 33;
    float s1[16], s2[16];
#pragma unroll
    for (int j = 0; j < 16; ++j) {
        s1[j] = ord2f(L0[j] & ~127u); s2[j] = ord2f(L1[j] & ~127u);
        slot[j] = 127 - (int)(L0[j] & 127u); slot[16 + j] = 127 - (int)(L1[j] & 127u);
    }
    u32 lst[16];
#pragma unroll
    for (int j = 0; j < 16; ++j) lst[j] = cand_key(s1[0] + s2[j], j);
#pragma unroll
    for (int i = 1; i < 5; ++i) {
        u32 row[16];
#pragma unroll
        for (int j = 0; j < 16; ++j) row[j] = ((i + 1) * (j + 1) <= 16) ? cand_key(s1[i] + s2[j], i * 16 + j) : 0u;
        merge16_desc(lst, row);
    }
#pragma unroll
    for (int i = 5; i < 16; ++i)
#pragma unroll
        for (int j = 0; j < 2; ++j)
            if ((i + 1) * (j + 1) <= 16) top16_insert(lst, cand_key(s1[i] + s2[j], i * 16 + j));
    float pv[16]; float sum = 0.f;
    const float mx = ord2f(lst[0] & ~255u);
#pragma unroll
    for (int j = 0; j < 16; ++j) { pv[j] = __expf(ord2f(lst[j] & ~255u) - mx); sum += pv[j]; }
    const float inv = 1.f / sum;
    int ev[16];
#pragma unroll
    for (int j = 0; j < 16; ++j) {
        const int ci = 255 - (int)(lst[j] & 255u);
        ev[j] = slot[ci >> 4] * 128 + slot[16 + (ci & 15)];
    }
    if (fh == 0) {
        int4* ro = (int4*)(WSP(int, WS_RIDX) + (size_t)tok * 128 + h * 16);
        float4* go = (float4*)(WSP(float, WS_RG) + (size_t)tok * 128 + h * 16);
#pragma unroll
        for (int q = 0; q < 4; ++q) {
            ro[q] = make_int4(ev[4 * q], ev[4 * q + 1], ev[4 * q + 2], ev[4 * q + 3]);
            go[q] = make_float4(pv[4 * q] * inv, pv[4 * q + 1] * inv, pv[4 * q + 2] * inv, pv[4 * q + 3] * inv);
        }
    }
    }
}


#define OSM_THR 8.0f
DI void osm_update(f32x16& s, unsigned vm, float& m, float& lh, float& alpha) {
    float mx = -1e30f;
#pragma unroll
    for (int r = 0; r < 16; ++r) mx = ((vm >> r) & 1u) ? fmaxf(mx, s[r]) : mx;
    mx = fmaxf(mx, __shfl_xor(mx, 32));
    float mn = m; alpha = 1.f;
    if (!__all(mx <= m + OSM_THR)) { mn = fmaxf(m, mx); alpha = __expf(m - mn); }
    float ls = 0.f;
#pragma unroll
    for (int r = 0; r < 16; ++r) { const float pe = ((vm >> r) & 1u) ? __expf(s[r] - mn) : 0.f; s[r] = pe; ls += pe; }
    lh = lh * alpha + ls; m = mn;
}
DI void osm_update_full(f32x16& s, float& m, float& lh, float& alpha) {
    float mx = s[0];
#pragma unroll
    for (int r = 1; r < 16; ++r) mx = fmaxf(mx, s[r]);
    mx = fmaxf(mx, __shfl_xor(mx, 32));
    float mn = m; alpha = 1.f;
    if (!__all(mx <= m + OSM_THR)) { mn = fmaxf(m, mx); alpha = __expf(m - mn); }
    float ls = 0.f;
#pragma unroll
    for (int r = 0; r < 16; ++r) { const float pe = __expf(s[r] - mn); s[r] = pe; ls += pe; }
    lh = lh * alpha + ls; m = mn;
}
DI void tr_quad(const unsigned (&a)[4], unsigned hi_off, bf16x8 (&f)[4]) {
    s16x4 l0, h0, l1, h1, l2, h2, l3, h3;
    const unsigned b0 = a[0] + hi_off, b1 = a[1] + hi_off, b2 = a[2] + hi_off, b3 = a[3] + hi_off;
    asm volatile("ds_read_b64_tr_b16 %0, %8\n\tds_read_b64_tr_b16 %1, %9\n\tds_read_b64_tr_b16 %2, %10\n\tds_read_b64_tr_b16 %3, %11\n\t"
                 "ds_read_b64_tr_b16 %4, %12\n\tds_read_b64_tr_b16 %5, %13\n\tds_read_b64_tr_b16 %6, %14\n\tds_read_b64_tr_b16 %7, %15\n\ts_waitcnt lgkmcnt(0)"
                 : "=&v"(l0), "=&v"(h0), "=&v"(l1), "=&v"(h1), "=&v"(l2), "=&v"(h2), "=&v"(l3), "=&v"(h3)
                 : "v"(a[0]), "v"(b0), "v"(a[1]), "v"(b1), "v"(a[2]), "v"(b2), "v"(a[3]), "v"(b3) : "memory");
    f[0] = __builtin_shufflevector(l0, h0, 0, 1, 2, 3, 4, 5, 6, 7); f[1] = __builtin_shufflevector(l1, h1, 0, 1, 2, 3, 4, 5, 6, 7);
    f[2] = __builtin_shufflevector(l2, h2, 0, 1, 2, 3, 4, 5, 6, 7); f[3] = __builtin_shufflevector(l3, h3, 0, 1, 2, 3, 4, 5, 6, 7);
}

#define QB_BYTES (128 * 256)
#define KB_BYTES (32 * 256)
template <bool WITH_V>
DI void attnB_stage_kv(const bf16_t* __restrict__ kg  , unsigned char* Kd, unsigned char* Vd, int wave, int lane) {
#pragma unroll
    for (int i = 0; i < 2; ++i) {
        const int idx = wave * 2 + i;
        const int key = 4 * idx + (lane >> 4), cp = lane & 15;
        const bf16_t* g = kg + (size_t)key * ATT_IN;
        __builtin_amdgcn_global_load_lds((const unsigned*)(g + ((cp ^ (key & 15)) << 3)), (unsigned*)(Kd + idx * 1024 + lane * 16), 16, 0, 0);
        if (WITH_V) {
            const int cv = ((((cp >> 2) ^ (key & 3)) << 2) | (cp & 3));
            __builtin_amdgcn_global_load_lds((const unsigned*)(g + 512 + (cv << 3)), (unsigned*)(Vd + idx * 1024 + lane * 16), 16, 0, 0);
        }
    }
}
template <int KOFF, bool FULL>
DI void attnB_map(const unsigned char* Kc, const unsigned char* qlp, int ksw, int qsw, int fh, unsigned vm, unsigned vc, int tq,
                  float& m, float& l, f32x16 (&o)[4]) {
    f32x16 st;
#pragma unroll
    for (int r = 0; r < 16; ++r) st[r] = 0.f;
#pragma unroll
    for (int s = 0; s < 4; ++s) {
        const bf16x8 kf = *(const bf16x8*)(Kc + (((KOFF + 2 * s + fh) ^ ksw) << 4));
        const bf16x8 qf = *(const bf16x8*)(qlp + (((KOFF + 2 * s + fh) ^ qsw) << 4));
        st = MFMA32(kf, qf, st);
    }
    float al;
    if (FULL) osm_update_full(st, m, l, al); else osm_update(st, vm, m, l, al);
    if (!__all(al == 1.f)) {
#pragma unroll
        for (int d = 0; d < 4; ++d)
#pragma unroll
            for (int r = 0; r < 16; ++r) o[d][r] *= al;
    }
#pragma unroll
    for (int s = 0; s < 2; ++s) {
        const bf16x8 pf = pack_p(st, s);
        unsigned va[4]; bf16x8 vf[4];
#pragma unroll
        for (int d = 0; d < 4; ++d) va[d] = vc + s * 16 * 256 + ((d ^ tq) << 6);
        tr_quad(va, 8 * 256, vf);
#pragma unroll
        for (int d = 0; d < 4; ++d) o[d] = MFMA32(vf[d], pf, o[d]);
    }
}
DI void ph_attnB_fast(const Params& p, int item, unsigned char* smem) {
    const bf16_t* proj = WSP(bf16_t, WS_PROJ);
    const int tid = otid(), wave = tid >> 6, lane = tid & 63, fr = lane & 31, fh = lane >> 5;
    const int qt = 15 - (item >> 6), bh = item & 63, b = bh >> 2, h = bh & 3;
    const int q0 = qt * 128;
    const float lam = compute_lam(p, lane);
    const size_t rowbase = (size_t)b * SEQ;
    const int qrow = wave * 32 + fr, qpos = q0 + qrow;
    unsigned char* Ql = smem;
    unsigned char* Kl = smem + QB_BYTES;
    unsigned char* Vl = Kl + 2 * KB_BYTES;
    const bf16_t* kbase = proj + rowbase * ATT_IN + 2048 + h * 128;
    __syncthreads();
#pragma unroll
    for (int i = 0; i < 8; ++i) {
        const int idx = wave * 8 + i;
        const int row = 4 * idx + (lane >> 4), cp = lane & 15;
        __builtin_amdgcn_global_load_lds((const unsigned*)(proj + (rowbase + q0 + row) * ATT_IN + 1536 + h * 128 + ((cp ^ (row & 15)) << 3)),
                                         (unsigned*)(Ql + idx * 1024 + lane * 16), 16, 0, 0);
    }
    attnB_stage_kv<true>(kbase, Kl, Vl, wave, lane);
    const unsigned char* qlp = Ql + qrow * 256;
    const int qsw = qrow & 15, ksw = fr & 15;
    const int nkt = (q0 + 128) / 32;
    const int wlast = q0 + wave * 32 + 31;
    f32x16 o1[4], o2[4];
#pragma unroll
    for (int d = 0; d < 4; ++d)
#pragma unroll
        for (int r = 0; r < 16; ++r) { o1[d][r] = 0.f; o2[d][r] = 0.f; }
    float m1 = -1e30f, m2 = -1e30f, l1 = 0.f, l2 = 0.f;
    const int tq = (lane & 15) >> 2;
    const unsigned vrow = (unsigned)(uintptr_t)Vl + (4 * fh + tq) * 256 + (16 * ((lane >> 4) & 1) + 4 * (lane & 3)) * 2;
    asm volatile("s_waitcnt vmcnt(0)" ::: "memory");
    __syncthreads();
    for (int kt = 0; kt < nkt; ++kt) {
        const int cur = kt & 1;
        if (kt + 1 < nkt) attnB_stage_kv<true>(kbase + (size_t)(kt + 1) * 32 * ATT_IN, Kl + (cur ^ 1) * KB_BYTES, Vl + (cur ^ 1) * KB_BYTES, wave, lane);
        if (kt * 32 <= wlast) {
            const unsigned char* Kc = Kl + cur * KB_BYTES + fr * 256;
            const unsigned vc = vrow + cur * KB_BYTES;
            if (kt * 32 + 31 <= wlast - 31) {
                attnB_map<0, true>(Kc, qlp, ksw, qsw, fh, 0xffffu, vc, tq, m1, l1, o1);
                __builtin_amdgcn_sched_barrier(0);
                attnB_map<8, true>(Kc, qlp, ksw, qsw, fh, 0xffffu, vc, tq, m2, l2, o2);
            } else {
                unsigned vm = 0;
#pragma unroll
                for (int r = 0; r < 16; ++r) vm |= ((kt * 32 + crow(r, fh)) <= qpos) ? (1u << r) : 0u;
                attnB_map<0, false>(Kc, qlp, ksw, qsw, fh, vm, vc, tq, m1, l1, o1);
                __builtin_amdgcn_sched_barrier(0);
                attnB_map<8, false>(Kc, qlp, ksw, qsw, fh, vm, vc, tq, m2, l2, o2);
            }
        }
        asm volatile("s_waitcnt vmcnt(0)" ::: "memory");
        __syncthreads();
    }
    l1 += __shfl_xor(l1, 32); l2 += __shfl_xor(l2, 32);
    const float i1 = 1.f / l1, i2 = lam / l2;
    float ss = 0.f;
#pragma unroll
    for (int d = 0; d < 4; ++d)
#pragma unroll
        for (int r = 0; r < 16; ++r) { const float v = o1[d][r] * i1 - o2[d][r] * i2; o1[d][r] = v; ss += v * v; }
    ss += __shfl_xor(ss, 32);
    const float rinv = rsqrtf(ss * (1.f / 128.f) + EPSN) * 0.8f;
    const float* subg = p.in[11];
    bf16_t* op = WSP(bf16_t, WS_MIXED) + (rowbase + qpos) * DM + 512 + h * 128;
#pragma unroll
    for (int d = 0; d < 4; ++d)
#pragma unroll
        for (int g = 0; g < 4; ++g) {
            const int dim = 32 * d + 8 * g + 4 * fh;
            const float4 gg = *(const float4*)(subg + dim);
            uint2 w;
            w.x = pack2(o1[d][4 * g + 0] * rinv * gg.x, o1[d][4 * g + 1] * rinv * gg.y);
            w.y = pack2(o1[d][4 * g + 2] * rinv * gg.z, o1[d][4 * g + 3] * rinv * gg.w);
            *(uint2*)(op + dim) = w;
        }
}

#define KA_PITCH 128
#define VA_PITCH 192
#define WA_BYTES (32 * KA_PITCH + 32 * VA_PITCH)
template <int MODE>
DI void ph_attnA_fast(const Params& p, int item, unsigned char* smem) {
    const bf16_t* proj = WSP(bf16_t, WS_PROJ);
    const int tid = otid(), wave = tid >> 6, lane = tid & 63, fr = lane & 31, fh = lane >> 5;
    const int c = item & 15, h = (item >> 4) & 7, b = item >> 7;
    const size_t rowbase = (size_t)b * SEQ;
    const int qpos = MODE == 0 ? 128 * c + 32 * wave + fr : 16 * (32 * wave + fr) + c;
    const int pmin = MODE == 0 ? 128 * c + 32 * wave : 512 * wave + c, pmax = pmin + (MODE == 0 ? 31 : 496);
    bf16x8 qf[4];
    {
        const bf16_t* qp = proj + (rowbase + qpos) * ATT_IN + h * 64 + 8 * fh;
#pragma unroll
        for (int s = 0; s < 4; ++s) qf[s] = *(const bf16x8*)(qp + 16 * s);
    }
    f32x16 o[2];
#pragma unroll
    for (int d = 0; d < 2; ++d)
#pragma unroll
        for (int r = 0; r < 16; ++r) o[d][r] = 0.f;
    float m = -1e30f, l = 0.f;
    unsigned char* Kl = smem + wave * WA_BYTES;
    unsigned char* Vl = Kl + 32 * KA_PITCH;
    const unsigned vaddr = (unsigned)(uintptr_t)Vl + (4 * fh + ((lane & 15) >> 2)) * VA_PITCH + (16 * ((lane >> 4) & 1) + 4 * (lane & 3)) * 2;
    const int skey = lane >> 3, sc = lane & 7;
    int br = 0, d = MODE == 0 ? 1 : 16, W = MODE == 0 ? 128 : 2048, cls = MODE == 0 ? 0 : (c & 15);
    int j0 = MODE == 0 ? (pmin < 128 ? 0 : pmin - 128) : 0, jhi = MODE == 0 ? pmax : ((pmax - cls) >> 4);
    const bf16_t* kvbase = proj + rowbase * ATT_IN + 512 + h * 64 + sc * 8;
    uint4 rk0, rk1, rk2, rk3, rv0, rv1, rv2, rv3;
#define A_LOAD(i, RK, RV) do { int kp_ = cls + d * (j0 + skey + 8 * (i)); kp_ = kp_ > SEQ - 1 ? SEQ - 1 : kp_; kp_ = kp_ < 0 ? 0 : kp_; \
        const bf16_t* g_ = kvbase + (size_t)kp_ * ATT_IN; RK = *(const uint4*)g_; RV = *(const uint4*)(g_ + 512); } while (0)
#define A_WRITE(i, RK, RV) do { const int key_ = skey + 8 * (i); *(uint4*)(Kl + key_ * KA_PITCH + ((sc ^ ((key_ >> 1) & 7)) << 4)) = RK; \
        *(uint4*)(Vl + key_ * VA_PITCH + sc * 16) = RV; } while (0)
    A_LOAD(0, rk0, rv0); A_LOAD(1, rk1, rv1); A_LOAD(2, rk2, rv2); A_LOAD(3, rk3, rv3);
#pragma unroll 1
    for (;;) {
        A_WRITE(0, rk0, rv0); A_WRITE(1, rk1, rv1); A_WRITE(2, rk2, rv2); A_WRITE(3, rk3, rv3);
        const int cd = d, cW = W, ccls = cls, cj0 = j0;
        bool more = true;
        j0 += 32;
        if (j0 > jhi) {
            ++br;
            if (MODE == 0 || br == 2) more = false;
            else {
                d = 4; W = 512; cls = c & 3;
                const int lo = pmin - cls - W;
                j0 = lo < 0 ? 0 : lo >> 2;
                jhi = (pmax - cls) >> 2;
            }
        }
        A_LOAD(0, rk0, rv0); A_LOAD(1, rk1, rv1); A_LOAD(2, rk2, rv2); A_LOAD(3, rk3, rv3);
        f32x16 st;
#pragma unroll
        for (int r = 0; r < 16; ++r) st[r] = 0.f;
#pragma unroll
        for (int s = 0; s < 4; ++s) {
            const bf16x8 kf = *(const bf16x8*)(Kl + fr * KA_PITCH + (((2 * s + fh) ^ ((fr >> 1) & 7)) << 4));
            st = MFMA32(kf, qf[s], st);
        }
        float al;
        const int kfirst = ccls + cd * cj0, klast = kfirst + cd * 31;
        if (klast <= pmin && pmax - kfirst <= cW) osm_update_full(st, m, l, al);
        else {
            unsigned vm = 0;
#pragma unroll
            for (int r = 0; r < 16; ++r) {
                const int dist = qpos - (ccls + cd * (cj0 + crow(r, fh)));
                vm |= (dist >= 0 && dist <= cW) ? (1u << r) : 0u;
            }
            osm_update(st, vm, m, l, al);
        }
        if (!__all(al == 1.f)) {
#pragma unroll
            for (int dd = 0; dd < 2; ++dd)
#pragma unroll
                for (int r = 0; r < 16; ++r) o[dd][r] *= al;
        }
        {
            unsigned va[4]; bf16x8 vf[4];
            va[0] = vaddr; va[1] = vaddr + 64; va[2] = vaddr + 16 * VA_PITCH; va[3] = vaddr + 16 * VA_PITCH + 64;
            tr_quad(va, 8 * VA_PITCH, vf);
            const bf16x8 p0 = pack_p(st, 0), p1 = pack_p(st, 1);
            o[0] = MFMA32(vf[0], p0, o[0]); o[1] = MFMA32(vf[1], p0, o[1]);
            o[0] = MFMA32(vf[2], p1, o[0]); o[1] = MFMA32(vf[3], p1, o[1]);
        }
        if (!more) break;
    }
    l += __shfl_xor(l, 32);
    bf16_t* op = WSP(bf16_t, WS_MIXED) + (rowbase + qpos) * DM + h * 64;
    float* lsep = WSP(float, WS_LSE1) + (rowbase + qpos) * 8 + h;
    if (MODE == 0) {
        const float il = 1.f / l;
        if (fh == 0) *lsep = m + __logf(l);
#pragma unroll
        for (int dd = 0; dd < 2; ++dd)
#pragma unroll
            for (int g = 0; g < 4; ++g) {
                const int dim = 32 * dd + 8 * g + 4 * fh;
                uint2 w;
                w.x = pack2(o[dd][4 * g + 0] * il, o[dd][4 * g + 1] * il);
                w.y = pack2(o[dd][4 * g + 2] * il, o[dd][4 * g + 3] * il);
                *(uint2*)(op + dim) = w;
            }
    } else {
        const float lse1 = *lsep;
        const float M = fmaxf(m, lse1);
        const float w23 = __expf(m - M), w1 = __expf(lse1 - M);
        const float iden = 1.f / (l * w23 + w1);
        const float a23 = w23 * iden, a1 = w1 * iden;
        uint2 prev[2][4];
#pragma unroll
        for (int dd = 0; dd < 2; ++dd)
#pragma unroll
            for (int g = 0; g < 4; ++g) prev[dd][g] = *(const uint2*)(op + 32 * dd + 8 * g + 4 * fh);
#pragma unroll
        for (int dd = 0; dd < 2; ++dd)
#pragma unroll
            for (int g = 0; g < 4; ++g) {
                const int dim = 32 * dd + 8 * g + 4 * fh;
                const float p0 = __uint_as_float(prev[dd][g].x << 16), p1 = __uint_as_float(prev[dd][g].x & 0xffff0000u);
                const float p2 = __uint_as_float(prev[dd][g].y << 16), p3 = __uint_as_float(prev[dd][g].y & 0xffff0000u);
                uint2 w;
                w.x = pack2(o[dd][4 * g + 0] * a23 + p0 * a1, o[dd][4 * g + 1] * a23 + p1 * a1);
                w.y = pack2(o[dd][4 * g + 2] * a23 + p2 * a1, o[dd][4 * g + 3] * a23 + p3 * a1);
                *(uint2*)(op + dim) = w;
            }
    }
}
#define NITEM_B 1024
#define NITEM_A 2048
DI void ph_attn_fast(const Params& p, int vb, unsigned char* smem) {
    if (vb < NITEM_B) {
        const int item = vb < 512 ? vb : 512 + (1023 - vb);
        ph_attnB_fast(p, item, smem);
    } else ph_attnA_fast<0>(p, vb - NITEM_B, smem);
}


DI void ph_spatial_fast(const Params& p, int item, unsigned char* smem) {
    const int tid = otid(), wave = tid >> 6, lane = tid & 63, fr = lane & 31, fh = lane >> 5;
    const int wm = wave >> 1, wn = wave & 1;
    const int chunk = item >> 3, g = item & 7;
    bf16_t* u = WSP(bf16_t, WS_Z_U);
    const bf16_t* vt = WSP(bf16_t, WS_Z_VT);
    const float* ssq = WSP(float, WS_SSQ);
    const float* wsp = p.in[16] + (size_t)g * 128 * 128;
    float* rinv = (float*)(smem + 66 * 1024);
    unsigned char* Bt = smem + 32768;
    __syncthreads();
    if (tid < 128) {
        const float4* sp = (const float4*)(ssq + (size_t)(chunk * 128 + tid) * 64);
        float sacc = 0.f;
#pragma unroll
        for (int j = 0; j < 16; ++j) { const float4 q = sp[j]; sacc += (q.x + q.y) + (q.z + q.w); }
        rinv[tid] = rsqrtf(sacc * (1.f / CW) + EPSN);
    }
    const size_t vrow0 = (size_t)chunk * CW + g * 256;
    stage_tile(vt, 128, (int)vrow0, 0, Bt, wave, lane);
    stage_tile(vt, 128, (int)vrow0, 64, Bt + 16384, wave, lane);
    __syncthreads();
#pragma unroll
    for (int i = 0; i < 8; ++i) {
        const int id = tid + 256 * i;
        const int t = id >> 4, sc = id & 15;
        const float4 w0 = *(const float4*)(wsp + t * 128 + sc * 8);
        const float4 w1 = *(const float4*)(wsp + t * 128 + sc * 8 + 4);
        const float4 r0 = *(const float4*)(rinv + sc * 8);
        const float4 r1 = *(const float4*)(rinv + sc * 8 + 4);
        const int s0 = sc * 8;
        uint4 o;
        o.x = pack2(s0 + 0 <= t ? w0.x * r0.x : 0.f, s0 + 1 <= t ? w0.y * r0.y : 0.f);
        o.y = pack2(s0 + 2 <= t ? w0.z * r0.z : 0.f, s0 + 3 <= t ? w0.w * r0.w : 0.f);
        o.z = pack2(s0 + 4 <= t ? w1.x * r1.x : 0.f, s0 + 5 <= t ? w1.y * r1.y : 0.f);
        o.w = pack2(s0 + 6 <= t ? w1.z * r1.z : 0.f, s0 + 7 <= t ? w1.w * r1.w : 0.f);
        const int kt = sc >> 3, c = sc & 7;
        *(uint4*)(smem + kt * 16384 + t * 128 + ((c ^ ((t >> 1) & 7)) << 4)) = o;
    }
#pragma unroll 1
    for (int nt = 0; nt < 2; ++nt) {
        asm volatile("s_waitcnt vmcnt(0)" ::: "memory");
        __syncthreads();
        f32x16 acc[2][2];
#pragma unroll
        for (int i = 0; i < 2; ++i)
#pragma unroll
            for (int j = 0; j < 2; ++j)
#pragma unroll
                for (int r = 0; r < 16; ++r) acc[i][j][r] = 0.f;
#pragma unroll
        for (int kt = 0; kt < 2; ++kt)
#pragma unroll
            for (int s = 0; s < 4; ++s) {
                bf16x8 a[2], b[2];
#pragma unroll
                for (int i = 0; i < 2; ++i) {
                    a[i] = lds_frag(smem + kt * 16384, wm * 64 + i * 32 + fr, 2 * s + fh);
                    b[i] = lds_frag(Bt + kt * 16384, wn * 64 + i * 32 + fr, 2 * s + fh);
                }
#pragma unroll
                for (int i = 0; i < 2; ++i)
#pragma unroll
                    for (int j = 0; j < 2; ++j) acc[i][j] = MFMA32(a[i], b[j], acc[i][j]);
            }
        __syncthreads();
        float* st = (float*)(Bt + wave * (32 * 65 * 4));
#pragma unroll
        for (int i = 0; i < 2; ++i) {
#pragma unroll
            for (int j = 0; j < 2; ++j)
#pragma unroll
                for (int r = 0; r < 16; ++r) st[crow(r, fh) * 65 + j * 32 + fr] = acc[i][j][r];
            const int t = wm * 64 + i * 32 + fr;
            const int c0 = g * 256 + nt * 128 + wn * 64 + fh * 32;
            bf16_t* up = u + (size_t)(chunk * 128 + t) * CW + c0;
            const float bias = p.in[17][g * 128 + t];
            const float* gn = p.in[15] + c0;
            uint4 ur[4];
#pragma unroll
            for (int q = 0; q < 4; ++q) ur[q] = ((const uint4*)up)[q];
#pragma unroll
            for (int q = 0; q < 4; ++q) {
                float uf[8]; unpack8(ur[q], uf);
                const float4 g0 = *(const float4*)(gn + 8 * q), g1 = *(const float4*)(gn + 8 * q + 4);
                const float gg[8] = {g0.x, g0.y, g0.z, g0.w, g1.x, g1.y, g1.z, g1.w};
                float ov[8];
#pragma unroll
                for (int e = 0; e < 8; ++e) ov[e] = uf[e] * (st[fr * 65 + fh * 32 + 8 * q + e] * gg[e] + bias);
                uint4 o; o.x = pack2(ov[0], ov[1]); o.y = pack2(ov[2], ov[3]); o.z = pack2(ov[4], ov[5]); o.w = pack2(ov[6], ov[7]);
                ((uint4*)up)[q] = o;
            }
        }
        if (nt == 0) {
            __syncthreads();
            stage_tile(vt, 128, (int)vrow0 + 128, 0, Bt, wave, lane);
            stage_tile(vt, 128, (int)vrow0 + 128, 64, Bt + 16384, wave, lane);
        }
    }
}

#define XB_TMO      128
#define XB_XCNT(j)  (256  + 64 * (j))
#define XB_XSUB(j)  (1280 + 64 * (j))
#define XB_XGEN(j)  (2304 + 64 * (j))
#define XB_TOP      3328
#define XB_TOPGEN   3392
#define XCD_BAR_WORDS 3456
#define XB_SPIN_CAP (1u << 22)
DI unsigned xb_ld(unsigned* p) { return __hip_atomic_load(p, __ATOMIC_RELAXED, __HIP_MEMORY_SCOPE_AGENT); }
DI unsigned xb_add(unsigned* p, unsigned v) { return __hip_atomic_fetch_add(p, v, __ATOMIC_RELAXED, __HIP_MEMORY_SCOPE_AGENT); }
DI unsigned xb_xcc_id() { return (unsigned)__builtin_amdgcn_s_getreg((3 << 11) | 20) & 0xFu; }
#define XB_SPIN(cond, bar) do { unsigned _sp = 0; while (cond) { __builtin_amdgcn_s_sleep(1); \
    if ((++_sp & 255u) == 0u) { if (xb_ld(&(bar)[XB_TMO])) break; if (_sp > XB_SPIN_CAP) { atomicAdd(&(bar)[XB_TMO], 1u); break; } } } } while (0)
struct XcdBarrier { unsigned* bar; unsigned x; volatile LAS unsigned* st; };
DI XcdBarrier xcd_barrier_post(unsigned* bar, volatile LAS unsigned* st) {
    XcdBarrier b; b.bar = bar; b.x = xb_xcc_id(); b.st = st;
    if (threadIdx.x == 0) st[2] = xb_add(&bar[XB_XCNT(b.x)], 1u);
    return b;
}
DI void xcd_barrier_complete(unsigned* bar, unsigned x, unsigned& nloc, unsigned& nx, unsigned& xi) {
    const unsigned G = gridDim.x * gridDim.y * gridDim.z;
    unsigned sum, cnt, mine, below, sp = 0u;
    for (;;) {
        sum = 0u; cnt = 0u; mine = 0u; below = 0u;
#pragma unroll
        for (unsigned j = 0; j < 16; ++j) { const unsigned c = xb_ld(&bar[XB_XCNT(j)]); sum += c; cnt += (c > 0u) ? 1u : 0u; mine = (j == x) ? c : mine; below += (c > 0u && j < x) ? 1u : 0u; }
        if (sum == G) break;
        __builtin_amdgcn_s_sleep(1);
        if ((++sp & 255u) == 0u) { if (xb_ld(&bar[XB_TMO])) break; if (sp > XB_SPIN_CAP) { atomicAdd(&bar[XB_TMO], 1u); break; } }
    }
    nloc = mine > 0u ? mine : 1u; nx = cnt > 0u ? cnt : 1u; xi = below;
}
DI void xcd_barrier(const XcdBarrier& b) {
    asm volatile("s_waitcnt vmcnt(0)" ::: "memory");
    __syncthreads();
    if (threadIdx.x == 0) {
        unsigned* bar = b.bar;
        __builtin_amdgcn_s_waitcnt(0);
        unsigned nloc = b.st[0], nx = b.st[1];
        if (nloc == 0u) { unsigned xi; xcd_barrier_complete(bar, b.x, nloc, nx, xi); b.st[0] = nloc; b.st[1] = nx; b.st[3] = xi; }
        const unsigned old = xb_add(&bar[XB_XSUB(b.x)], 1u);
        const unsigned gen = old / nloc;
        if (old + 1u == (gen + 1u) * nloc) {
            __builtin_amdgcn_fence(__ATOMIC_RELEASE, "agent");
            asm volatile("s_waitcnt vmcnt(0)" ::: "memory");
            const unsigned og = xb_add(&bar[XB_TOP], 1u);
            const unsigned tg = og / nx;
            if (og + 1u == (tg + 1u) * nx) xb_add(&bar[XB_TOPGEN], 1u);
            else XB_SPIN(xb_ld(&bar[XB_TOPGEN]) == tg, bar);
            __builtin_amdgcn_fence(__ATOMIC_ACQUIRE, "agent");
            xb_add(&bar[XB_XGEN(b.x)], 1u);
            asm volatile("s_waitcnt vmcnt(0)" ::: "memory");
        } else {
            XB_SPIN(xb_ld(&bar[XB_XGEN(b.x)]) == gen, bar);
            __builtin_amdgcn_fence(__ATOMIC_ACQUIRE, "agent");
            asm volatile("s_waitcnt vmcnt(0)" ::: "memory");
        }
    }
    __syncthreads();
}

enum { PH_PREP = 0, PH_GEMM1, PH_ATTN, PH_ATTN2, PH_GEMM2,
       PH_NORM_P0, PH_GEMMQ0, PH_SCORE0, PH_PDOWN0, PH_PCOMB0, PH_PUP0, PH_NORM_SGU,
       PH_GEMM4, PH_SPATIAL, PH_GEMM5,
       PH_NORM_P1, PH_GEMMQ1, PH_SCORE1, PH_PDOWN1, PH_PCOMB1, PH_PUP1, PH_COUNT };

__host__ __device__ constexpr int phase_nvb(int ph) {
    switch (ph) {
        case PH_PREP: return PREP_N;
        case PH_GEMM1: return (ATT_IN / 256) * (NTOK / 256);
        case PH_ATTN: return NITEM_B + NITEM_A;
        case PH_ATTN2: return NITEM_A;
        case PH_GEMM2: return (DM / 256) * (NTOK / 256);
        case PH_NORM_P0: case PH_NORM_P1: case PH_NORM_SGU: return NTOK / 4;
        case PH_GEMMQ0: case PH_GEMMQ1: return 16 * (NTOK / 256);
        case PH_SCORE0: case PH_SCORE1: return (NTOK / 32) * 8 / 4;
        case PH_PCOMB0: case PH_PCOMB1: return NTOK / 4;
        case PH_GEMM4: return (4096 / 256) * (NTOK / 256);
        case PH_SPATIAL: return 256 * 8;
        case PH_GEMM5: return (DM / 256) * (NTOK / 256);
    }
    return 0;
}

template <int PH>
DI void run_vb(const Params& p, int vb, unsigned char* smem) {
    if constexpr (PH == PH_PREP) ph_prep(p, vb, smem);
    else if constexpr (PH == PH_ATTN) ph_attn_fast(p, vb, smem);
    else if constexpr (PH == PH_ATTN2) ph_attnA_fast<1>(p, vb, smem);
    else if constexpr (PH == PH_NORM_P0 || PH == PH_NORM_P1) rmsnorm_rows<true>(WSP(bf16_t, WS_RES), p.in[19] + (PH == PH_NORM_P1 ? DM : 0), vb, WSP(signed char, WS_XQ), WSP(float, WS_XSC));
    else if constexpr (PH == PH_PCOMB0 || PH == PH_PCOMB1) ph_peer_comb(p, vb, PH == PH_PCOMB1 ? 1 : 0);
    else if constexpr (PH == PH_NORM_SGU) rmsnorm_rows<true>(WSP(bf16_t, WS_RES), p.in[13], vb, WSP(signed char, WS_XQ), WSP(float, WS_XSC));
    else if constexpr (PH == PH_SPATIAL) ph_spatial_fast(p, vb, smem);
}

template <int PH>
DI void run_phase(const Params& p, unsigned char* smem) {
    if constexpr (PH == PH_PDOWN0 || PH == PH_PDOWN1) run_peer_sliced<false>(p, PH == PH_PDOWN1 ? 1 : 0, smem);
    else if constexpr (PH == PH_PUP0 || PH == PH_PUP1) run_peer_sliced<true>(p, PH == PH_PUP1 ? 1 : 0, smem);
    else if constexpr (PH == PH_SCORE0 || PH == PH_SCORE1) run_score(p, PH == PH_SCORE1 ? 1 : 0, smem);
    else if constexpr (PH == PH_GEMMQ0 || PH == PH_GEMMQ1) run_gemmq_pg8(p, PH == PH_GEMMQ1 ? 1 : 0, smem);
    else if constexpr (PH == PH_GEMM1) run_gemm1_pg8(p, smem);
    else if constexpr (PH == PH_GEMM4) run_gemm4_pg8(p, smem);
    else if constexpr (PH == PH_GEMM2) run_gemm_pg8<0>(p, smem);
    else if constexpr (PH == PH_GEMM5) run_gemm_pg8<1>(p, smem);
    else {
        constexpr int nvb = phase_nvb(PH);
        const int g = threadIdx.x >> 8;
        for (int vb = 2 * blockIdx.x; vb < nvb; vb += 2 * gridDim.x)
            if (vb + g < nvb) run_vb<PH>(p, vb + g, smem + g * GROUP_SMEM);
    }
}

template <int PH>
DI void run_from(const Params& p, unsigned char* smem, cg::grid_group& grid, const XcdBarrier& xb) {
    run_phase<PH>(p, smem);
    if constexpr (PH + 1 < PH_COUNT) {
        if constexpr (PH == 1) grid.sync(); else xcd_barrier(xb);
        run_from<PH + 1>(p, smem, grid, xb);
    }
}

__global__ void __launch_bounds__(NTHREADS, 2) k_mega(Params p) {
    extern __shared__ __attribute__((aligned(16))) unsigned char smem[];
    cg::grid_group grid = cg::this_grid();
    volatile LAS unsigned* st = (volatile LAS unsigned*)(smem + SMEM_BYTES);
    if (threadIdx.x == 0) { st[0] = 0u; st[1] = 0u; st[2] = 0u; st[3] = 0u; }
    __syncthreads();
    const XcdBarrier xb = xcd_barrier_post((unsigned*)(p.ws + WS_CTL), st);
    run_from<0>(p, smem, grid, xb);
}


extern "C" void kernel_launch(void* const* d_in, const int* in_sizes, int n_in, void* d_out, int out_size, void* d_ws, size_t ws_size, hipStream_t stream) {
    if (n_in != 24 || ws_size < WS_NEED || in_sizes[0] != NTOK * DM || out_size != NTOK * DM || in_sizes[22] != 2 * NEXP * DM) {
        fprintf(stderr, "kernel_launch: built for x[16,2048,1024] with 24 inputs and >= 512 MiB of workspace; got n_in %d, in0 %d, out %d, ws %zu: nothing launched\n", n_in, in_sizes[0], out_size, ws_size); return; }
    static int grid_blocks = 0;
    if (!grid_blocks) {
        int dev = 0, cus = 0, per_cu = 0;
        (void)hipGetDevice(&dev);
        (void)hipDeviceGetAttribute(&cus, hipDeviceAttributeMultiprocessorCount, dev);
        (void)hipFuncSetAttribute((const void*)k_mega, hipFuncAttributeMaxDynamicSharedMemorySize, SMEM_ALLOC);
        (void)hipOccupancyMaxActiveBlocksPerMultiprocessor(&per_cu, (const void*)k_mega, NTHREADS, SMEM_ALLOC);
        if (per_cu > 1) per_cu = 1;
        if (per_cu < 1) { fprintf(stderr, "kernel_launch: occupancy query returned %d\n", per_cu); per_cu = 1; }
        grid_blocks = cus * per_cu;
    }
    Params p{};
    for (int i = 0; i < 24; ++i) p.in[i] = (const float*)d_in[i];
    p.out = (float*)d_out;
    p.ws = (unsigned char*)d_ws;
    void* args[] = {&p};
    if (hipMemsetAsync((unsigned char*)d_ws + WS_CTL, 0, XCD_BAR_WORDS * 4, stream) != hipSuccess) { fprintf(stderr, "kernel_launch: memset of the barrier words failed\n"); return; }
    hipError_t e = hipLaunchCooperativeKernel((const void*)k_mega, dim3(grid_blocks), dim3(NTHREADS), args, SMEM_ALLOC, stream);
    if (e != hipSuccess) fprintf(stderr, "cooperative launch failed: %s (grid %d)\n", hipGetErrorString(e), grid_blocks);
}
```

```cpp
#include <hip/hip_runtime.h>
#include <stdint.h>
#include <stdio.h>

#define NTOK   32768
#define DM     1024
#define SEQ    2048
#define NB     16
#define ATT_IN 3072
#define CW     2048
#define NEXP   16384
#define EPSN   1e-6f

typedef unsigned short bf16_t;
typedef unsigned int u32;

#define DI __device__ __forceinline__
#define LAS __attribute__((address_space(3)))

DI int otid() { int t = threadIdx.x & 255; asm volatile("" : "+v"(t)); return t; }
DI int otid512() { int t = threadIdx.x; asm volatile("" : "+v"(t)); return t; }
DI float bf2f(bf16_t v) { return __uint_as_float(((u32)v) << 16); }
typedef __bf16 bf16v2 __attribute__((ext_vector_type(2)));
DI bf16_t f2bf(float f) { const __bf16 h = (__bf16)f; return __builtin_bit_cast(bf16_t, h); }
DI u32 pack2(float lo, float hi) { bf16v2 v; v[0] = (__bf16)lo; v[1] = (__bf16)hi; return __builtin_bit_cast(u32, v); }
DI float gelu_tanh(float x) {
    const float y = 0.7978845608028654f * (x + 0.044715f * x * x * x);
    const float e = __expf(2.f * y);
    const float t = 1.f - 2.f / (e + 1.f);
    return 0.5f * x * (1.f + t);
}
DI float wave_sum(float v) {
#pragma unroll
    for (int o = 1; o < 64; o <<= 1) v += __shfl_xor(v, o);
    return v;
}
DI float wave_max(float v) {
#pragma unroll
    for (int o = 1; o < 64; o <<= 1) v = fmaxf(v, __shfl_xor(v, o));
    return v;
}
DI u32 f2ord(float f) { u32 u = __float_as_uint(f); return (u & 0x80000000u) ? ~u : (u | 0x80000000u); }
DI float ord2f(u32 o) { u32 u = (o & 0x80000000u) ? (o & 0x7fffffffu) : ~o; return __uint_as_float(u); }

#define MiB ((size_t)1 << 20)
#define WS_CTL      ((size_t)0)
#define WS_W_ATTIN  (1 * MiB)
#define WS_W_ATTOUT (7 * MiB)
#define WS_W_SGUIN  (9 * MiB)
#define WS_W_SGUOUT (17 * MiB)
#define WS_W_PQ     (21 * MiB)
#define WS_WQS      (25 * MiB)
#define WS_WAS      (25 * MiB + 64 * 1024)
#define WS_WSS      (25 * MiB + 128 * 1024)
#define WS_W_SUBK   (29 * MiB)
#define WS_DOWN     (32 * MiB)
#define WS_UP       (64 * MiB)
#define WS_DSC      (96 * MiB)
#define WS_USC      (96 * MiB + 128 * 1024)
#define WS_LSE1     (30 * MiB)
#define WS_XQ       (100 * MiB)
#define WS_XSC      (132 * MiB)
#define WS_RES      (160 * MiB)
#define WS_BIG      (224 * MiB)
#define WS_PROJ     (WS_BIG)
#define WS_MIXED    (WS_BIG + 192 * MiB)
#define WS_Z_U      (WS_BIG)
#define WS_Z_VT     (WS_BIG + 128 * MiB)
#define WS_RIDX     (WS_BIG + 32 * MiB)
#define WS_RG       (WS_BIG + 48 * MiB)
#define WS_QBUF     (WS_BIG + 64 * MiB)
#define WS_SSQ      (WS_BIG + 256 * MiB)
#define WS_NEED     (512 * MiB)

struct Params {
    const float* in[24];
    float* out;
    unsigned char* ws;
};

#include <hip/hip_cooperative_groups.h>
namespace cg = cooperative_groups;

#define GROUP_SMEM (68 * 1024)
#define PG8_EXTRA (128 * 1024)
#define SMEM_BYTES (144 * 1024)
#define SMEM_ALLOC (SMEM_BYTES + 16)
#define NTHREADS 512

#define WSP(T, off) ((T*)(p.ws + (off)))


DI void transpose_tile(const float* __restrict__ W, bf16_t* __restrict__ Wt, int K, int N, int t, unsigned char* smem) {
    float* tile = (float*)smem;
    const int tid = otid();
    const int ntn = N / 64;
    const int n0 = (t % ntn) * 64, k0 = (t / ntn) * 64;
    __syncthreads();
    {
        const int n4 = tid & 15, kr = tid >> 4;
#pragma unroll
        for (int i = 0; i < 4; ++i) {
            const int k = kr + 16 * i;
            const float4 v = *(const float4*)(W + (size_t)(k0 + k) * N + n0 + 4 * n4);
            tile[k * 65 + 4 * n4 + 0] = v.x; tile[k * 65 + 4 * n4 + 1] = v.y; tile[k * 65 + 4 * n4 + 2] = v.z; tile[k * 65 + 4 * n4 + 3] = v.w;
        }
    }
    __syncthreads();
    {
        const int n = tid >> 2, kc = tid & 3;
        float v[16];
#pragma unroll
        for (int j = 0; j < 16; ++j) v[j] = tile[(16 * kc + j) * 65 + n];
        uint4 o0, o1;
        o0.x = pack2(v[0], v[1]); o0.y = pack2(v[2], v[3]); o0.z = pack2(v[4], v[5]); o0.w = pack2(v[6], v[7]);
        o1.x = pack2(v[8], v[9]); o1.y = pack2(v[10], v[11]); o1.z = pack2(v[12], v[13]); o1.w = pack2(v[14], v[15]);
        uint4* dst = (uint4*)(Wt + (size_t)(n0 + n) * K + k0 + 16 * kc);
        dst[0] = o0; dst[1] = o1;
    }
}
DI void cvt_chunk(const float* __restrict__ src, bf16_t* __restrict__ dst, int c) {
    const size_t base = (size_t)c * 2048;
#pragma unroll
    for (int i = 0; i < 8; ++i) {
        const size_t idx = base + i * 256 + otid();
        const float4 v = ((const float4*)src)[idx];
        uint2 o; o.x = pack2(v.x, v.y); o.y = pack2(v.z, v.w);
        ((uint2*)dst)[idx] = o;
    }
}
DI int q8(float v) { int i = __float2int_rn(v); i = i > 127 ? 127 : i; i = i < -127 ? -127 : i; return i & 255; }
template <bool IN_BF16, int ROWS>
DI void rmsnorm_rows(const void* __restrict__ x, const float* __restrict__ g, int vb, signed char* xq, float* xsc) {
    const int lane = otid() & 63;
    const int row0 = (vb * 4 + (otid() >> 6)) * ROWS;
    float4 v[ROWS][4];
#pragma unroll
    for (int r = 0; r < ROWS; ++r)
#pragma unroll
        for (int j = 0; j < 4; ++j) {
            if (IN_BF16) { const uint2 w = ((const uint2*)((const bf16_t*)x + (size_t)(row0 + r) * DM))[lane + 64 * j];
                v[r][j] = make_float4(__uint_as_float(w.x << 16), __uint_as_float(w.x & 0xffff0000u), __uint_as_float(w.y << 16), __uint_as_float(w.y & 0xffff0000u)); }
            else v[r][j] = ((const float4*)((const float*)x + (size_t)(row0 + r) * DM))[lane + 64 * j];
        }
    float4 gg[4];
#pragma unroll
    for (int j = 0; j < 4; ++j) gg[j] = ((const float4*)g)[lane + 64 * j];
#pragma unroll
    for (int r = 0; r < ROWS; ++r) {
        float ss = 0.f;
#pragma unroll
        for (int j = 0; j < 4; ++j) ss += v[r][j].x * v[r][j].x + v[r][j].y * v[r][j].y + v[r][j].z * v[r][j].z + v[r][j].w * v[r][j].w;
        ss = wave_sum(ss);
        const float rinv = rsqrtf(ss * (1.f / DM) + EPSN);
        float am = 0.f;
#pragma unroll
        for (int j = 0; j < 4; ++j) {
            v[r][j].x *= rinv * gg[j].x; v[r][j].y *= rinv * gg[j].y; v[r][j].z *= rinv * gg[j].z; v[r][j].w *= rinv * gg[j].w;
            am = fmaxf(am, fmaxf(fmaxf(fabsf(v[r][j].x), fabsf(v[r][j].y)), fmaxf(fabsf(v[r][j].z), fabsf(v[r][j].w))));
        }
        am = wave_max(am);
        const float sc = am > 0.f ? 127.f / am : 0.f;
        u32* qrow = (u32*)(xq + (size_t)(row0 + r) * DM);
#pragma unroll
        for (int j = 0; j < 4; ++j)
            qrow[lane + 64 * j] = (u32)q8(v[r][j].x * sc) | ((u32)q8(v[r][j].y * sc) << 8) | ((u32)q8(v[r][j].z * sc) << 16) | ((u32)q8(v[r][j].w * sc) << 24);
        if (lane == 0) xsc[row0 + r] = am * (1.f / 127.f);
    }
}
#define PREP_T0 48
#define PREP_T1 (PREP_T0 + 16 * 16)
#define PREP_T2 (PREP_T1 + 64)
#define PREP_T3 (PREP_T2 + 16 * 32)
#define PREP_T4 (PREP_T3 + 2 * 32)
#define PREP_C0 (PREP_T4 + 64)
#define PREP_C1 (PREP_C0 + 4096)
#define PREP_C2 (PREP_C1 + 4096)
#define PREP_N  (PREP_C2 + 4096)
template <bool INT8>
DI void fp8_rows(const float* __restrict__ src, unsigned char* __restrict__ dst, float* __restrict__ inv_scale, int vb) {
    const int lane = otid() & 63;
    const int row0 = (vb * 4 + (otid() >> 6)) * 2;
    float4 v[2][4];
#pragma unroll
    for (int r = 0; r < 2; ++r)
#pragma unroll
        for (int j = 0; j < 4; ++j) v[r][j] = ((const float4*)(src + (size_t)(row0 + r) * DM) + lane)[64 * j];
#pragma unroll
    for (int r = 0; r < 2; ++r) {
        const int row = row0 + r;
        float am = 0.f;
#pragma unroll
        for (int j = 0; j < 4; ++j) am = fmaxf(am, fmaxf(fmaxf(fabsf(v[r][j].x), fabsf(v[r][j].y)), fmaxf(fabsf(v[r][j].z), fabsf(v[r][j].w))));
        am = wave_max(am);
        float sc, inv;
        if (INT8) { sc = am > 0.f ? 127.f / am : 0.f; inv = am * (1.f / 127.f); }
        else {
            int e = (int)((__float_as_uint(am) >> 23) & 255u) - 127;
            if (am == 0.f) e = 0;
            e = e < -100 ? -100 : e;
            sc = __uint_as_float((u32)(127 + 7 - e) << 23); inv = __uint_as_float((u32)(127 + e - 7) << 23);
        }
        unsigned char* drow = dst + (size_t)(row >> 14) * NEXP * DM + (size_t)(row & (NEXP - 1)) * 128;
#pragma unroll
        for (int j = 0; j < 4; ++j) {
            const int dim = 4 * (lane + 64 * j);
            u32 w;
            if (INT8) w = (u32)q8(v[r][j].x * sc) | ((u32)q8(v[r][j].y * sc) << 8) | ((u32)q8(v[r][j].z * sc) << 16) | ((u32)q8(v[r][j].w * sc) << 24);
            else { int t = __builtin_amdgcn_cvt_pk_fp8_f32(v[r][j].x * sc, v[r][j].y * sc, 0, false); t = __builtin_amdgcn_cvt_pk_fp8_f32(v[r][j].z * sc, v[r][j].w * sc, t, true); w = (u32)t; }
            *(u32*)(drow + (size_t)(dim >> 7) * NEXP * 128 + (dim & 127)) = w;
        }
        if (lane == 0) inv_scale[row] = inv;
    }
}
DI void wq8_item(const float* __restrict__ W, signed char* __restrict__ Wt, float* __restrict__ wsc, int t, unsigned char* smem, int N) {
    float* red = (float*)smem;
    const int tid = otid(), n = tid & 63, kq = tid >> 6;
    const float* col = W + t * 64 + n;
    float am = 0.f;
#pragma unroll 16
    for (int k = 0; k < 256; ++k) am = fmaxf(am, fabsf(col[(size_t)(kq * 256 + k) * N]));
    __syncthreads();
    red[kq * 64 + n] = am;
    __syncthreads();
    am = fmaxf(fmaxf(red[n], red[64 + n]), fmaxf(red[128 + n], red[192 + n]));
    const float sc = am > 0.f ? 127.f / am : 0.f;
    if (kq == 0) wsc[t * 64 + n] = am * (1.f / 127.f);
    signed char* drow = Wt + (size_t)(t * 64 + n) * 1024;
#pragma unroll 1
    for (int kb = 0; kb < 16; ++kb) {
        const int k0 = kb * 64 + kq * 16;
        u32 w[4];
#pragma unroll
        for (int j = 0; j < 4; ++j) {
            const float* c4 = col + (size_t)(k0 + 4 * j) * N;
            w[j] = (u32)q8(c4[0] * sc) | ((u32)q8(c4[N] * sc) << 8) | ((u32)q8(c4[2 * N] * sc) << 16) | ((u32)q8(c4[3 * N] * sc) << 24);
        }
        *(uint4*)(drow + k0) = make_uint4(w[0], w[1], w[2], w[3]);
    }
}
DI void ph_prep(const Params& p, int vb, unsigned char* smem) {
    if (vb < PREP_T0) wq8_item(p.in[2], WSP(signed char, WS_W_ATTIN), WSP(float, WS_WAS), vb, smem, ATT_IN);
    else if (vb < PREP_T1) transpose_tile(p.in[12], WSP(bf16_t, WS_W_ATTOUT), DM, DM, vb - PREP_T0, smem);
    else if (vb < PREP_T2) wq8_item(p.in[14], WSP(signed char, WS_W_SGUIN), WSP(float, WS_WSS), vb - PREP_T1, smem, 4096);
    else if (vb < PREP_T3) transpose_tile(p.in[18], WSP(bf16_t, WS_W_SGUOUT), CW, DM, vb - PREP_T2, smem);
    else if (vb < PREP_T4) { const int t = vb - PREP_T3, l = t / 32; wq8_item(p.in[20] + (size_t)l * DM * 2048, WSP(signed char, WS_W_PQ) + (size_t)l * 2048 * DM, WSP(float, WS_WQS) + l * 2048, t % 32, smem, 2048); }
    else if (vb < PREP_C0) cvt_chunk(p.in[21], WSP(bf16_t, WS_W_SUBK), vb - PREP_T4);
    else if (vb < PREP_C1) fp8_rows<true>(p.in[22], p.ws + WS_DOWN, WSP(float, WS_DSC), vb - PREP_C0);
    else if (vb < PREP_C2) fp8_rows<false>(p.in[23], p.ws + WS_UP, WSP(float, WS_USC), vb - PREP_C1);
    else rmsnorm_rows<false, 2>(p.in[0], p.in[1], vb - PREP_C2, WSP(signed char, WS_XQ), WSP(float, WS_XSC));
}

DI float compute_lam(const Params& p, int lane) {
    const float a = wave_sum(p.in[7][lane] * p.in[8][lane]);
    const float b = wave_sum(p.in[9][lane] * p.in[10][lane]);
    return __expf(a) - __expf(b) + 0.2f;
}
DI void ce_desc(u32& a, u32& b) { const u32 hi = max(a, b), lo = min(a, b); a = hi; b = lo; }
DI void sort16_desc(u32 (&v)[16]) {
#pragma unroll
    for (int k = 2; k <= 16; k <<= 1)
#pragma unroll
        for (int j = k >> 1; j > 0; j >>= 1)
#pragma unroll
            for (int i = 0; i < 16; ++i) {
                const int l = i ^ j;
                if (l > i) { if ((i & k) == 0) ce_desc(v[i], v[l]); else ce_desc(v[l], v[i]); }
            }
}
DI void merge16_desc(u32 (&a)[16], const u32 (&b)[16]) {
#pragma unroll
    for (int i = 0; i < 16; ++i) a[i] = max(a[i], b[15 - i]);
#pragma unroll
    for (int j = 8; j > 0; j >>= 1)
#pragma unroll
        for (int i = 0; i < 16; ++i) { const int l = i ^ j; if (l > i) ce_desc(a[i], a[l]); }
}
DI void top16_insert(u32 (&lst)[16], u32 x) {
#pragma unroll
    for (int j = 0; j < 16; ++j) { const u32 hi = max(lst[j], x); x = min(lst[j], x); lst[j] = hi; }
}
DI void unpack8(const uint4 v, float (&f)[8]) {
    f[0] = __uint_as_float(v.x << 16); f[1] = __uint_as_float(v.x & 0xffff0000u);
    f[2] = __uint_as_float(v.y << 16); f[3] = __uint_as_float(v.y & 0xffff0000u);
    f[4] = __uint_as_float(v.z << 16); f[5] = __uint_as_float(v.z & 0xffff0000u);
    f[6] = __uint_as_float(v.w << 16); f[7] = __uint_as_float(v.w & 0xffff0000u);
}
typedef float f32x2_t __attribute__((ext_vector_type(2)));
DI void unpack16fp8(const uint4 w, float (&f)[16]) {
    f32x2_t t;
    t = __builtin_amdgcn_cvt_pk_f32_fp8((int)w.x, false); f[0] = t[0]; f[1] = t[1];
    t = __builtin_amdgcn_cvt_pk_f32_fp8((int)w.x, true);  f[2] = t[0]; f[3] = t[1];
    t = __builtin_amdgcn_cvt_pk_f32_fp8((int)w.y, false); f[4] = t[0]; f[5] = t[1];
    t = __builtin_amdgcn_cvt_pk_f32_fp8((int)w.y, true);  f[6] = t[0]; f[7] = t[1];
    t = __builtin_amdgcn_cvt_pk_f32_fp8((int)w.z, false); f[8] = t[0]; f[9] = t[1];
    t = __builtin_amdgcn_cvt_pk_f32_fp8((int)w.z, true);  f[10] = t[0]; f[11] = t[1];
    t = __builtin_amdgcn_cvt_pk_f32_fp8((int)w.w, false); f[12] = t[0]; f[13] = t[1];
    t = __builtin_amdgcn_cvt_pk_f32_fp8((int)w.w, true);  f[14] = t[0]; f[15] = t[1];
}
struct PeerPre { int e[16]; uint4 xa, xb; float2 r; };
struct PeerRows { uint4 d[8]; float c[8]; };
template <bool UP>
DI PeerPre peer_prefetch(const Params& p, int tok, int sl, int lane) {
    PeerPre q;
    const int4* rix = (const int4*)(WSP(int, WS_RIDX) + (size_t)tok * 128 + 16 * (lane >> 3));
#pragma unroll
    for (int j = 0; j < 4; ++j) { const int4 t = rix[j]; q.e[4 * j] = t.x; q.e[4 * j + 1] = t.y; q.e[4 * j + 2] = t.z; q.e[4 * j + 3] = t.w; }
    if (UP) {
        const u32 w = *(const u32*)(WSP(bf16_t, WS_RES) + (size_t)tok * DM + sl * 128 + 16 * (lane & 7) + 2 * (lane >> 3));
        q.r = make_float2(__uint_as_float(w << 16), __uint_as_float(w & 0xffff0000u));
    } else {
        q.xa = *(const uint4*)(WSP(signed char, WS_XQ) + (size_t)tok * DM + sl * 128 + 16 * (lane & 7));
    }
    return q;
}
template <int HF, bool UP>
DI void peer_issue_rows(const Params& p, const unsigned char* tab, const PeerPre& q, int tok, int lane, PeerRows& R) {
    const unsigned dco = 16u * (unsigned)(lane & 7);
#pragma unroll
    for (int bi = 0; bi < 8; ++bi) R.d[bi] = *(const uint4*)(tab + ((unsigned)q.e[8 * HF + bi] * 128u + dco));
    if (UP) {
        const float4* cf = (const float4*)(WSP(float, WS_RG) + (size_t)tok * 128 + 16 * (lane >> 3) + 8 * HF);
        const float4 c0 = cf[0], c1 = cf[1];
        R.c[0] = c0.x; R.c[1] = c0.y; R.c[2] = c0.z; R.c[3] = c0.w; R.c[4] = c1.x; R.c[5] = c1.y; R.c[6] = c1.z; R.c[7] = c1.w;
    }
}
template <int HF>
DI void peer_down_half(const PeerPre& q, const PeerRows& R, float (&part)[16]) {
#pragma unroll
    for (int bi = 0; bi < 8; ++bi) {
        int a = __builtin_amdgcn_sdot4((int)R.d[bi].x, (int)q.xa.x, 0, false);
        a = __builtin_amdgcn_sdot4((int)R.d[bi].y, (int)q.xa.y, a, false);
        a = __builtin_amdgcn_sdot4((int)R.d[bi].z, (int)q.xa.z, a, false);
        a = __builtin_amdgcn_sdot4((int)R.d[bi].w, (int)q.xa.w, a, false);
        part[8 * HF + bi] = (float)a;
    }
}
DI void peer_down_fin(const Params& p, const float (&part)[16], int tok, int sl, int lane) {
    const bool b2 = lane & 4, b1 = lane & 2, b0 = lane & 1;
    float r8[8], r4[4], r2[2];
#pragma unroll
    for (int i = 0; i < 8; ++i) { const float snd = b2 ? part[i] : part[i + 8]; const float kp = b2 ? part[i + 8] : part[i]; r8[i] = kp + __shfl_xor(snd, 4); }
#pragma unroll
    for (int i = 0; i < 4; ++i) { const float snd = b1 ? r8[i] : r8[i + 4]; const float kp = b1 ? r8[i + 4] : r8[i]; r4[i] = kp + __shfl_xor(snd, 2); }
#pragma unroll
    for (int i = 0; i < 2; ++i) { const float snd = b0 ? r4[i] : r4[i + 2]; const float kp = b0 ? r4[i + 2] : r4[i]; r2[i] = kp + __shfl_xor(snd, 1); }
    u32* pd = WSP(u32, WS_QBUF) + ((size_t)tok * 8 + sl) * 64;
    pd[lane] = pack2(r2[0], r2[1]);
}
DI void ph_peer_comb(const Params& p, int vb, int l) {
    const int tid = otid(), lane = tid & 63;
    const int tok0 = (vb * 4 + (tid >> 6)) * 2;
    const float* dsc = WSP(float, WS_DSC) + (size_t)l * NEXP;
    const float* usc = WSP(float, WS_USC) + (size_t)l * NEXP;
    u32 w[2][8]; int2 e[2]; float2 g[2]; float xs[2];
#pragma unroll
    for (int r = 0; r < 2; ++r) {
        const int tok = tok0 + r;
        const u32* pd = WSP(u32, WS_QBUF) + (size_t)tok * 8 * 64;
#pragma unroll
        for (int sl = 0; sl < 8; ++sl) w[r][sl] = pd[sl * 64 + lane];
        e[r] = *(const int2*)(WSP(int, WS_RIDX) + (size_t)tok * 128 + 2 * lane);
        g[r] = *(const float2*)(WSP(float, WS_RG) + (size_t)tok * 128 + 2 * lane);
        xs[r] = WSP(float, WS_XSC)[tok];
    }
#pragma unroll
    for (int r = 0; r < 2; ++r) {
        float t0 = 0.f, t1 = 0.f;
#pragma unroll
        for (int sl = 0; sl < 8; ++sl) { t0 += __uint_as_float(w[r][sl] << 16); t1 += __uint_as_float(w[r][sl] & 0xffff0000u); }
        float2 o;
        o.x = g[r].x * gelu_tanh(t0 * dsc[e[r].x] * xs[r]) * usc[e[r].x];
        o.y = g[r].y * gelu_tanh(t1 * dsc[e[r].y] * xs[r]) * usc[e[r].y];
        *(float2*)(WSP(float, WS_RG) + (size_t)(tok0 + r) * 128 + 2 * lane) = o;
    }
}
template <int HF>
DI void peer_up_half(const PeerPre& q, const PeerRows& R, float (&y)[16]) {
#pragma unroll
    for (int bi = 0; bi < 8; ++bi) {
        const float c = R.c[bi];
        float w[16]; unpack16fp8(R.d[bi], w);
#pragma unroll
        for (int i = 0; i < 16; ++i) y[i] += c * w[i];
        asm volatile("" : "+v"(y[0]), "+v"(y[1]), "+v"(y[2]), "+v"(y[3]), "+v"(y[4]), "+v"(y[5]), "+v"(y[6]), "+v"(y[7]), "+v"(y[8]), "+v"(y[9]), "+v"(y[10]), "+v"(y[11]), "+v"(y[12]), "+v"(y[13]), "+v"(y[14]), "+v"(y[15]));
    }
}
DI void peer_up_fin(const Params& p, const PeerPre& q, const float (&y)[16], int tok, int sl, int lane, bool final_layer) {
    const int rg = lane >> 3, dc = lane & 7;
    const bool b5 = lane & 32, b4 = lane & 16, b3 = lane & 8;
    float r8[8], r4[4], r2[2];
#pragma unroll
    for (int i = 0; i < 8; ++i) { const float snd = b5 ? y[i] : y[i + 8]; const float kp = b5 ? y[i + 8] : y[i]; r8[i] = kp + __shfl_xor(snd, 32); }
#pragma unroll
    for (int i = 0; i < 4; ++i) { const float snd = b4 ? r8[i] : r8[i + 4]; const float kp = b4 ? r8[i + 4] : r8[i]; r4[i] = kp + __shfl_xor(snd, 16); }
#pragma unroll
    for (int i = 0; i < 2; ++i) { const float snd = b3 ? r4[i] : r4[i + 2]; const float kp = b3 ? r4[i + 2] : r4[i]; r2[i] = kp + __shfl_xor(snd, 8); }
    float2 v = q.r;
    v.x += r2[0]; v.y += r2[1];
    if (final_layer) *(float2*)(p.out + (size_t)tok * DM + sl * 128 + 16 * dc + 2 * rg) = v;
    else *(u32*)(WSP(bf16_t, WS_RES) + (size_t)tok * DM + sl * 128 + 16 * dc + 2 * rg) = pack2(v.x, v.y);
}
template <bool UP>
DI void run_peer_sliced(const Params& p, int l, unsigned char* smem) {
    volatile LAS unsigned* st = (volatile LAS unsigned*)(smem + SMEM_BYTES);
    const int nloc = (int)st[0], nx = (int)st[1], rank = (int)st[2], xi = (int)st[3];
    const int tid = otid512(), lane = tid & 63, wave = tid >> 6;
    const int stride = nloc * 8;
#pragma unroll 1
    for (int sl = xi; sl < 8; sl += nx) {
        const unsigned char* tab = p.ws + (UP ? WS_UP : WS_DOWN) + (size_t)l * NEXP * DM + (size_t)sl * NEXP * 128;
        int tok = rank * 8 + wave;
        if (tok >= NTOK) continue;
        PeerPre qc = peer_prefetch<UP>(p, tok, sl, lane);
        PeerRows R;
        peer_issue_rows<0, UP>(p, tab, qc, tok, lane, R);
#pragma unroll 1
        for (; tok < NTOK; tok += stride) {
            const int tn = tok + stride < NTOK ? tok + stride : tok;
            const PeerPre qn = peer_prefetch<UP>(p, tn, sl, lane);
            float acc[16];
#pragma unroll
            for (int i = 0; i < 16; ++i) acc[i] = 0.f;
            PeerRows Rn;
            peer_issue_rows<1, UP>(p, tab, qc, tok, lane, Rn);
            __builtin_amdgcn_sched_barrier(0);
            if (UP) peer_up_half<0>(qc, R, acc); else peer_down_half<0>(qc, R, acc);
            __builtin_amdgcn_sched_barrier(0);
            peer_issue_rows<0, UP>(p, tab, qn, tn, lane, R);
            __builtin_amdgcn_sched_barrier(0);
            if (UP) { peer_up_half<1>(qc, Rn, acc); peer_up_fin(p, qc, acc, tok, sl, lane, l == 1); }
            else { peer_down_half<1>(qc, Rn, acc); peer_down_fin(p, acc, tok, sl, lane); }
            __builtin_amdgcn_sched_barrier(0);
            qc = qn;
        }
    }
}


typedef short bf16x8 __attribute__((ext_vector_type(8)));
typedef float f32x16 __attribute__((ext_vector_type(16)));
#define MFMA32(a, b, c) __builtin_amdgcn_mfma_f32_32x32x16_bf16((a), (b), (c), 0, 0, 0)
typedef short s16x4 __attribute__((ext_vector_type(4)));
DI bf16x8 pack_p(const f32x16& pt, int s) {
    uint4 o;
    o.x = pack2(pt[8 * s + 0], pt[8 * s + 1]); o.y = pack2(pt[8 * s + 2], pt[8 * s + 3]);
    o.z = pack2(pt[8 * s + 4], pt[8 * s + 5]); o.w = pack2(pt[8 * s + 6], pt[8 * s + 7]);
    return __builtin_bit_cast(bf16x8, o);
}

DI void stage_tile(const bf16_t* __restrict__ g, int ld, int row0, int k0, unsigned char* lt, int wave, int lane) {
#pragma unroll
    for (int i = 0; i < 4; ++i) {
        const int inst = wave * 4 + i;
        const int row = inst * 8 + (lane >> 3);
        const int c = (lane & 7) ^ ((row >> 1) & 7);
        __builtin_amdgcn_global_load_lds((const unsigned*)(g + (size_t)(row0 + row) * ld + k0 + c * 8),
                                         (unsigned*)(lt + inst * 1024 + lane * 16), 16, 0, 0);
    }
}
DI bf16x8 lds_frag(const unsigned char* lt, int row, int c) {
    return *(const bf16x8*)(lt + row * 128 + ((c ^ ((row >> 1) & 7)) << 4));
}
DI int crow(int r, int fh) { return (r & 3) + 8 * (r >> 2) + 4 * fh; }

namespace pg8 {
#define PG8_LAS __attribute__((address_space(3)))
typedef float f32x4 __attribute__((ext_vector_type(4)));
typedef unsigned u32x4 __attribute__((ext_vector_type(4)));
constexpr int BM = 256, BK = 64, HALF = 128, HTB = HALF * BK * 2  , STAGE_BYTES = 8 * HTB;
__host__ __device__ __forceinline__ int lds_byte(int r, int c) { const int st = (r >> 4) * 2 + (c >> 5), rr = r & 15, cc = c & 31, ob = rr * 64 + cc * 2; return st * 1024 + (ob ^ (((ob >> 9) & 1) << 5)); }
__host__ __device__ __forceinline__ void stage_rc(int b, int& R, int& C) { const int st = b / 1024, sb = b % 1024, swz = sb ^ (((sb >> 9) & 1) << 5); R = (st >> 1) * 16 + swz / 64; C = (st & 1) * 32 + (swz % 64) / 2; }
__host__ __device__ __forceinline__ int perm32(int rho) { const int n = rho >> 4, i = rho & 15; return 8 * (i >> 2) + 4 * n + (i & 3); }
struct Unit { int pm, pn; };
struct Gemm { const void* A; const void* Bt; int M, N, K; const float* rsc; const float* csc; };
struct XcdOrder {
    int ntn, nloc, nx, rank, xi, nown, total;
    __device__ __forceinline__ void init(int nmt, int ntn_, int nloc_, int nx_, int rank_, int xi_) {
        ntn = ntn_; nloc = nloc_; nx = nx_; rank = rank_; xi = xi_; nown = xi < nmt ? (nmt - xi + nx - 1) / nx : 0; total = nown * ntn; }
    __device__ __forceinline__ bool next(int i, Unit& u) const {
        const int t = rank + i * nloc; if (t >= total) return false;
        const int g4 = t / (4 * ntn), r = t - g4 * 4 * ntn;
        const int left = nown - 4 * g4, gs = left < 4 ? left : 4;
        const int nt = r / gs, mi = r - nt * gs;
        u.pm = (4 * g4 + mi) * nx + xi; u.pn = nt; return true;
    }
    __device__ __forceinline__ void a_ready(const Unit&) const {}
    __device__ __forceinline__ void done(const Unit&) const {}
};
typedef int i32x4 __attribute__((ext_vector_type(4)));
template <class Epi, class Sched, bool ALIGN_EPI = false, bool SP2 = false, bool I8 = false>
__device__ __forceinline__ void gemm_phase(PG8_LAS unsigned char* lds, const Gemm g, const Sched& S, const Epi& E) {
    const int tid = otid512(), wid = __builtin_amdgcn_readfirstlane(tid >> 6), lane = tid & 63, wr = wid >> 2, wc = wid & 3, fr = lane & 15, fq = lane >> 4;
    const int K = g.K, KB = I8 ? K : 2 * K  , nt = KB / (BK * 2);
    unsigned voffA[2], voffB[2];
#pragma unroll
    for (int i = 0; i < 2; ++i) { int R, C; stage_rc(tid * 16 + i * 8192, R, C); const int Rb = Epi::PERM ? ((R & ~31) + perm32(R & 31)) : R;
        voffA[i] = (unsigned)(R * KB + C * 2); voffB[i] = (unsigned)(Rb * KB + C * 2); }
    const size_t kstep = (size_t)(BK * 2);
    const size_t hstep = (size_t)HALF * KB;
    const size_t tstep = 2 * hstep;
    const unsigned ldsw = (unsigned)wid * 1024u;
    const int aoff = lds_byte(wr * 64 + fr, fq * 8), boff = lds_byte(wc * 32 + fr, fq * 8);
#define PG8_SA(b, h) (((b) * 2 + (h)) * HTB)
#define PG8_SB(b, h) ((4 + (b) * 2 + (h)) * HTB)
#define PG8_STAGE(bufoff, gbase, voff) do { _Pragma("unroll") for (int _i = 0; _i < 2; ++_i) \
        __builtin_amdgcn_global_load_lds((const unsigned*)((const char*)(gbase) + (voff)[_i]), (PG8_LAS unsigned*)(lds + (bufoff) + ldsw + _i * 8192), 16, 0, 0); } while (0)
#define PG8_LDA(dst, b, h) do { _Pragma("unroll") for (int m = 0; m < 4; ++m) _Pragma("unroll") for (int k = 0; k < 2; ++k) dst[m][k] = *(const PG8_LAS bf16x8*)(lds + PG8_SA(b, h) + aoff + m * 2048 + k * 1024); } while (0)
#define PG8_LDB(dst, b, h) do { _Pragma("unroll") for (int n = 0; n < 2; ++n) _Pragma("unroll") for (int k = 0; k < 2; ++k) dst[n][k] = *(const PG8_LAS bf16x8*)(lds + PG8_SB(b, h) + boff + n * 2048 + k * 1024); } while (0)
#define PG8_MMA(ai, bj, At, Bt) do { __builtin_amdgcn_s_setprio(1); _Pragma("unroll") for (int m = 0; m < 4; ++m) _Pragma("unroll") for (int n = 0; n < 2; ++n) _Pragma("unroll") for (int k = 0; k < 2; ++k) \
        { if constexpr (I8) acc[ai][bj][m][n] = __builtin_bit_cast(f32x4, __builtin_amdgcn_mfma_i32_16x16x64_i8(__builtin_bit_cast(i32x4, Bt[n][k]), __builtin_bit_cast(i32x4, At[m][k]), __builtin_bit_cast(i32x4, acc[ai][bj][m][n]), 0, 0, 0)); \
          else acc[ai][bj][m][n] = __builtin_amdgcn_mfma_f32_16x16x32_bf16(Bt[n][k], At[m][k], acc[ai][bj][m][n], 0, 0, 0); } __builtin_amdgcn_s_setprio(0); } while (0)
#define PG8_WAIT_V(n) asm volatile("s_waitcnt vmcnt(" #n ")" ::: "memory")
#define PG8_WAIT_L(n) asm volatile("s_waitcnt lgkmcnt(" #n ")" ::: "memory")
#define PG8_BAR __builtin_amdgcn_s_barrier()
#define PG8_SCHED __builtin_amdgcn_sched_barrier(0)
    Unit cur, nxt; int ui = 0;
    if (!S.next(0, cur)) return;
    f32x4 acc[2][2][4][2];
#pragma unroll
    for (int a = 0; a < 2; ++a)
#pragma unroll
        for (int b = 0; b < 2; ++b)
#pragma unroll
            for (int m = 0; m < 4; ++m)
#pragma unroll
                for (int n = 0; n < 2; ++n) acc[a][b][m][n] = (f32x4){0.f, 0.f, 0.f, 0.f};
    bf16x8 At[4][2], B0[2][2], B1[2][2];
    const char* cA = (const char*)g.A + (size_t)cur.pm * tstep; const char* cB = (const char*)g.Bt + (size_t)cur.pn * tstep;
    S.a_ready(cur);
    if constexpr (SP2) {
        PG8_STAGE(PG8_SB(0, 0), cB, voffB); PG8_STAGE(PG8_SB(0, 1), cB + hstep, voffB); PG8_STAGE(PG8_SA(0, 0), cA, voffA); PG8_STAGE(PG8_SA(0, 1), cA + hstep, voffA);
        if (wr == 1) PG8_BAR;
        PG8_WAIT_V(2); PG8_BAR;
        PG8_STAGE(PG8_SB(1, 0), cB + kstep, voffB); PG8_STAGE(PG8_SA(1, 0), cA + kstep, voffA); PG8_STAGE(PG8_SB(1, 1), cB + hstep + kstep, voffB);
        PG8_WAIT_V(6); PG8_BAR;
    } else {
        PG8_STAGE(PG8_SB(0, 0), cB, voffB); PG8_STAGE(PG8_SA(0, 0), cA, voffA); PG8_STAGE(PG8_SB(0, 1), cB + hstep, voffB); PG8_STAGE(PG8_SA(0, 1), cA + hstep, voffA);
        if (wr == 1) PG8_BAR;
        PG8_WAIT_V(4); PG8_BAR;
        PG8_STAGE(PG8_SB(1, 0), cB + kstep, voffB); PG8_STAGE(PG8_SA(1, 0), cA + kstep, voffA); PG8_STAGE(PG8_SB(1, 1), cB + hstep + kstep, voffB);
        PG8_WAIT_V(6); PG8_BAR;
    }
    for (;;) {
        const bool has_next = S.next(ui + 1, nxt);
        const char* nA = has_next ? (const char*)g.A + (size_t)nxt.pm * tstep : cA; const char* nB = has_next ? (const char*)g.Bt + (size_t)nxt.pn * tstep : cB;
        for (int t = 0; t < nt; t += 2) {
            const bool last = (t == nt - 2);
            const char* a1 = cA + (size_t)(t + 1) * kstep;
            const char* a2 = last ? nA : cA + (size_t)(t + 2) * kstep; const char* b2 = last ? nB : cB + (size_t)(t + 2) * kstep;
            const char* a3 = a2 + kstep; const char* b3 = b2 + kstep;
            if (last && has_next) S.a_ready(nxt);
            if constexpr (SP2) {
            PG8_LDB(B0, 0, 0); PG8_LDB(B1, 0, 1); PG8_SCHED; PG8_LDA(At, 0, 0); PG8_STAGE(PG8_SA(1, 1), a1 + hstep, voffA);
            PG8_WAIT_V(8); PG8_WAIT_L(0); PG8_BAR; PG8_MMA(0, 0, At, B0); PG8_MMA(0, 1, At, B1); PG8_BAR; PG8_SCHED;
            PG8_LDA(At, 0, 1); PG8_STAGE(PG8_SB(0, 0), b2, voffB); PG8_STAGE(PG8_SB(0, 1), b2 + hstep, voffB); PG8_STAGE(PG8_SA(0, 0), a2, voffA);
            PG8_WAIT_V(8); PG8_WAIT_L(0); PG8_BAR; PG8_MMA(1, 0, At, B0); PG8_MMA(1, 1, At, B1); PG8_BAR; PG8_SCHED;
            PG8_LDB(B0, 1, 0); PG8_LDB(B1, 1, 1); PG8_SCHED; PG8_LDA(At, 1, 0); PG8_STAGE(PG8_SA(0, 1), a2 + hstep, voffA);
            PG8_WAIT_V(8); PG8_WAIT_L(0); PG8_BAR; PG8_MMA(0, 0, At, B0); PG8_MMA(0, 1, At, B1); PG8_BAR; PG8_SCHED;
            PG8_LDA(At, 1, 1); PG8_STAGE(PG8_SB(1, 0), b3, voffB); PG8_STAGE(PG8_SB(1, 1), b3 + hstep, voffB); PG8_STAGE(PG8_SA(1, 0), a3, voffA);
            PG8_WAIT_V(8); PG8_WAIT_L(0); PG8_BAR; PG8_MMA(1, 0, At, B0); PG8_MMA(1, 1, At, B1); PG8_BAR; PG8_SCHED;
            } else {
            PG8_LDB(B0, 0, 0); PG8_SCHED; PG8_LDA(At, 0, 0); PG8_STAGE(PG8_SA(1, 1), a1 + hstep, voffA);
            PG8_WAIT_L(8); PG8_BAR; PG8_WAIT_L(0); PG8_MMA(0, 0, At, B0); PG8_BAR; PG8_SCHED;
            PG8_LDB(B1, 0, 1); PG8_STAGE(PG8_SB(0, 0), b2, voffB);
            PG8_BAR; PG8_WAIT_L(0); PG8_MMA(0, 1, At, B1); PG8_BAR;
            PG8_LDA(At, 0, 1); PG8_STAGE(PG8_SA(0, 0), a2, voffA);
            PG8_BAR; PG8_WAIT_L(0); PG8_MMA(1, 0, At, B0); PG8_BAR; PG8_SCHED;
            PG8_STAGE(PG8_SB(0, 1), b2 + hstep, voffB);
            PG8_WAIT_V(6); PG8_BAR; PG8_MMA(1, 1, At, B1); PG8_BAR;
            PG8_LDB(B0, 1, 0); PG8_SCHED; PG8_LDA(At, 1, 0); PG8_STAGE(PG8_SA(0, 1), a2 + hstep, voffA);
            PG8_WAIT_L(8); PG8_BAR; PG8_WAIT_L(0); PG8_MMA(0, 0, At, B0); PG8_BAR; PG8_SCHED;
            PG8_LDB(B1, 1, 1); PG8_STAGE(PG8_SB(1, 0), b3, voffB);
            PG8_BAR; PG8_WAIT_L(0); PG8_MMA(0, 1, At, B1); PG8_BAR;
            PG8_LDA(At, 1, 1); PG8_STAGE(PG8_SA(1, 0), a3, voffA);
            PG8_BAR; PG8_WAIT_L(0); PG8_MMA(1, 0, At, B0); PG8_BAR; PG8_SCHED;
            PG8_STAGE(PG8_SB(1, 1), b3 + hstep, voffB);
            PG8_WAIT_V(6); PG8_BAR; PG8_MMA(1, 1, At, B1); PG8_BAR;
            }
        }
        if constexpr (ALIGN_EPI) { if (wr == 0) PG8_BAR; }
        if constexpr (I8) {
#pragma unroll
            for (int b = 0; b < 2; ++b) {
                const float* cp = g.csc + cur.pn * BM + b * HALF + wc * 32 + 8 * fq;
                const f32x4 c0 = *(const f32x4*)cp, c1 = *(const f32x4*)(cp + 4);
#pragma unroll
                for (int a = 0; a < 2; ++a)
#pragma unroll
                    for (int m = 0; m < 4; ++m) {
                        const float xs = g.rsc[cur.pm * BM + a * HALF + wr * 64 + m * 16 + fr];
                        acc[a][b][m][0] = __builtin_convertvector(__builtin_bit_cast(i32x4, acc[a][b][m][0]), f32x4) * c0 * xs;
                        acc[a][b][m][1] = __builtin_convertvector(__builtin_bit_cast(i32x4, acc[a][b][m][1]), f32x4) * c1 * xs;
                    }
            }
        }
        if constexpr (!Epi::AFTER_DRAIN) { E(acc, cur, wr, wc, fr, fq); S.done(cur); }
        if (!has_next) break;
#pragma unroll
        for (int a = 0; a < 2; ++a)
#pragma unroll
            for (int b = 0; b < 2; ++b)
#pragma unroll
                for (int m = 0; m < 4; ++m)
#pragma unroll
                    for (int n = 0; n < 2; ++n) acc[a][b][m][n] = (f32x4){0.f, 0.f, 0.f, 0.f};
        cur = nxt; cA = nA; cB = nB; ++ui;
        if constexpr (ALIGN_EPI) { if (wr == 1) PG8_BAR; }
    }
    PG8_WAIT_V(0);
    if constexpr (!ALIGN_EPI) { if (wr == 0) PG8_BAR; }
    PG8_BAR;
    if constexpr (Epi::AFTER_DRAIN) { E.fused(acc, cur, wr, wc, fr, fq, lds, wid, lane); S.done(cur); }
#undef PG8_SA
#undef PG8_SB
#undef PG8_STAGE
#undef PG8_LDA
#undef PG8_LDB
#undef PG8_MMA
#undef PG8_WAIT_V
#undef PG8_WAIT_L
#undef PG8_BAR
#undef PG8_SCHED
}
template <bool RES_BF16>
struct EpiResid {
    static constexpr bool PERM = true, AFTER_DRAIN = false;
    const void* resid; bf16_t* out;
    __device__ __forceinline__ void operator()(const f32x4 (&acc)[2][2][4][2], const Unit& u, int wr, int wc, int fr, int fq) const {
        const size_t base = (size_t)(u.pm * BM + wr * 64 + fr) * DM + u.pn * BM + wc * 32 + 8 * fq;
#pragma unroll
        for (int ai = 0; ai < 2; ++ai) {
            f32x4 rv[4][2][2];
#pragma unroll
            for (int m = 0; m < 4; ++m)
#pragma unroll
                for (int bj = 0; bj < 2; ++bj) {
                    const size_t o = base + (size_t)(ai * HALF + m * 16) * DM + bj * HALF;
                    if constexpr (RES_BF16) {
                        const u32x4 w = *(const u32x4*)((const bf16_t*)resid + o);
                        rv[m][bj][0] = (f32x4){__uint_as_float(w.x << 16), __uint_as_float(w.x & 0xffff0000u), __uint_as_float(w.y << 16), __uint_as_float(w.y & 0xffff0000u)};
                        rv[m][bj][1] = (f32x4){__uint_as_float(w.z << 16), __uint_as_float(w.z & 0xffff0000u), __uint_as_float(w.w << 16), __uint_as_float(w.w & 0xffff0000u)};
                    } else { const float* rp = (const float*)resid + o; rv[m][bj][0] = *(const f32x4*)rp; rv[m][bj][1] = *(const f32x4*)(rp + 4); }
                }
            asm volatile("" ::: "memory");
#pragma unroll
            for (int m = 0; m < 4; ++m)
#pragma unroll
                for (int bj = 0; bj < 2; ++bj) {
                    const f32x4 a = rv[m][bj][0] + acc[ai][bj][m][0], b = rv[m][bj][1] + acc[ai][bj][m][1];
                    u32x4 w; w.x = pack2(a[0], a[1]); w.y = pack2(a[2], a[3]); w.z = pack2(b[0], b[1]); w.w = pack2(b[2], b[3]);
                    *(u32x4*)(out + base + (size_t)(ai * HALF + m * 16) * DM + bj * HALF) = w;
                }
            asm volatile("" ::: "memory");
        }
    }
};
struct EpiProj {
    static constexpr bool PERM = true, AFTER_DRAIN = false;
    const float* aq; const float* ak; const float* bq; const float* bk; bf16_t* proj; PG8_LAS float* xs;
    __device__ __forceinline__ void operator()(const f32x4 (&acc)[2][2][4][2], const Unit& u, int wr, int wc, int fr, int fq) const {
        const int wave = wr * 4 + wc;
#pragma unroll
        for (int ai = 0; ai < 2; ++ai)
#pragma unroll
            for (int m = 0; m < 4; ++m)
#pragma unroll
                for (int bj = 0; bj < 2; ++bj) {
                    const f32x4 a = acc[ai][bj][m][0], b = acc[ai][bj][m][1];
                    float t = a[0] * a[0] + a[1] * a[1] + a[2] * a[2] + a[3] * a[3] + b[0] * b[0] + b[1] * b[1] + b[2] * b[2] + b[3] * b[3];
                    t += __shfl_xor(t, 16); t += __shfl_xor(t, 32);
                    if (fq == 0) xs[wave * 256 + ((ai * 4 + m) * 2 + bj) * 16 + fr] = t;
                }
        asm volatile("s_waitcnt lgkmcnt(0)" ::: "memory");
        __builtin_amdgcn_s_barrier();
#pragma unroll
        for (int bj = 0; bj < 2; ++bj) {
            const int gcol = u.pn * BM + bj * HALF + wc * 32 + 8 * fq;
            const float* gain = nullptr; float scale = 1.f;
            if (gcol < 512) { gain = aq + (gcol & 63); scale = 0.125f; }
            else if (gcol < 1024) gain = ak + (gcol & 63);
            else if (gcol < 1536) gain = nullptr;
            else if (gcol < 2048) { gain = bq + (gcol & 127); scale = 0.125f; }
            else if (gcol < 2560) gain = bk + (gcol & 127);
            f32x4 g0 = {1.f, 1.f, 1.f, 1.f}, g1 = {1.f, 1.f, 1.f, 1.f};
            if (gain) { g0 = *(const f32x4*)gain; g1 = *(const f32x4*)(gain + 4); }
#pragma unroll
            for (int ai = 0; ai < 2; ++ai)
#pragma unroll
                for (int m = 0; m < 4; ++m) {
                    float sc = 1.f;
                    if (gain) {
                        const int slot = ((ai * 4 + m) * 2 + bj) * 16 + fr;
                        sc = rsqrtf((xs[wave * 256 + slot] + xs[(wave ^ 1) * 256 + slot]) * (1.f / 64.f) + EPSN) * scale;
                    }
                    const f32x4 v0 = acc[ai][bj][m][0] * g0 * sc, v1 = acc[ai][bj][m][1] * g1 * sc;
                    u32x4 w; w.x = pack2(v0[0], v0[1]); w.y = pack2(v0[2], v0[3]); w.z = pack2(v1[0], v1[1]); w.w = pack2(v1[2], v1[3]);
                    *(u32x4*)(proj + (size_t)(u.pm * BM + ai * HALF + wr * 64 + m * 16 + fr) * ATT_IN + gcol) = w;
                }
        }
    }
};
struct EpiSgu {
    static constexpr bool PERM = true, AFTER_DRAIN = false;
    bf16_t* zu; bf16_t* zvt; float* ssq; PG8_LAS unsigned char* stg;
    __device__ __forceinline__ void operator()(const f32x4 (&acc)[2][2][4][2], const Unit& u, int wr, int wc, int fr, int fq) const {
        const int wave = wr * 4 + wc, lane = fq * 16 + fr;
        PG8_LAS unsigned short* tl = (PG8_LAS unsigned short*)(stg + wave * 2048);
#pragma unroll
        for (int ai = 0; ai < 2; ++ai)
#pragma unroll
            for (int bj = 0; bj < 2; ++bj) {
                const int gcol = u.pn * BM + bj * HALF + wc * 32 + 8 * fq;
                f32x4 g0[4], g1[4];
#pragma unroll
                for (int m = 0; m < 4; ++m) {
                    const f32x4 a = acc[ai][bj][m][0], b = acc[ai][bj][m][1];
                    g0[m] = (f32x4){gelu_tanh(a[0]), gelu_tanh(a[1]), gelu_tanh(a[2]), gelu_tanh(a[3])};
                    g1[m] = (f32x4){gelu_tanh(b[0]), gelu_tanh(b[1]), gelu_tanh(b[2]), gelu_tanh(b[3])};
                }
                if (gcol < CW) {
#pragma unroll
                    for (int m = 0; m < 4; ++m) {
                        u32x4 w; w.x = pack2(g0[m][0], g0[m][1]); w.y = pack2(g0[m][2], g0[m][3]); w.z = pack2(g1[m][0], g1[m][1]); w.w = pack2(g1[m][2], g1[m][3]);
                        *(u32x4*)(zu + (size_t)(u.pm * BM + ai * HALF + wr * 64 + m * 16 + fr) * CW + gcol) = w;
                    }
                } else {
                    const int vcol = gcol - CW;
#pragma unroll
                    for (int m = 0; m < 4; ++m) {
                        float t = g0[m][0] * g0[m][0] + g0[m][1] * g0[m][1] + g0[m][2] * g0[m][2] + g0[m][3] * g0[m][3]
                                + g1[m][0] * g1[m][0] + g1[m][1] * g1[m][1] + g1[m][2] * g1[m][2] + g1[m][3] * g1[m][3];
                        t += __shfl_xor(t, 16); t += __shfl_xor(t, 32);
                        if (fq == 0) ssq[(size_t)(u.pm * BM + ai * HALF + wr * 64 + m * 16 + fr) * 64 + (vcol >> 5)] = t;
                    }
#pragma unroll
                    for (int h = 0; h < 2; ++h) {
#pragma unroll
                        for (int mm = 0; mm < 2; ++mm) {
                            const int m = 2 * h + mm, rl = 16 * mm + fr;
#pragma unroll
                            for (int j = 0; j < 4; ++j) { tl[(8 * fq + j) * 32 + rl] = f2bf(g0[m][j]); tl[(8 * fq + 4 + j) * 32 + rl] = f2bf(g1[m][j]); }
                        }
                        const int c = lane >> 1, hh = lane & 1;
                        const u32x4 w0 = *(const PG8_LAS u32x4*)(tl + c * 32 + hh * 16), w1 = *(const PG8_LAS u32x4*)(tl + c * 32 + hh * 16 + 8);
                        bf16_t* dst = zvt + ((size_t)(2 * u.pm + ai) * CW + (u.pn * BM - CW) + bj * HALF + wc * 32 + c) * 128 + wr * 64 + 32 * h + hh * 16;
                        *(u32x4*)dst = w0; *(u32x4*)(dst + 8) = w1;
                        asm volatile("" ::: "memory");
                    }
                }
            }
    }
};
struct EpiQ {
    static constexpr bool PERM = true, AFTER_DRAIN = false;
    bf16_t* q;
    __device__ __forceinline__ void operator()(const f32x4 (&acc)[2][2][4][2], const Unit& u, int wr, int wc, int fr, int fq) const {
#pragma unroll
        for (int ai = 0; ai < 2; ++ai)
#pragma unroll
            for (int m = 0; m < 4; ++m)
#pragma unroll
                for (int bj = 0; bj < 2; ++bj) {
                    const f32x4 a = acc[ai][bj][m][0], b = acc[ai][bj][m][1];
                    u32x4 w; w.x = pack2(a[0], a[1]); w.y = pack2(a[2], a[3]); w.z = pack2(b[0], b[1]); w.w = pack2(b[2], b[3]);
                    *(u32x4*)(q + (size_t)(u.pm * BM + ai * HALF + wr * 64 + m * 16 + fr) * 2048 + u.pn * BM + bj * HALF + wc * 32 + 8 * fq) = w;
                }
    }
};
}
DI void run_gemmq_pg8(const Params& p, int l, unsigned char* smem) {
    volatile LAS unsigned* st = (volatile LAS unsigned*)(smem + SMEM_BYTES);
    pg8::XcdOrder S; S.init(NTOK / 256, 2048 / 256, (int)st[0], (int)st[1], (int)st[2], (int)st[3]);
    const pg8::Gemm g{WSP(signed char, WS_XQ), WSP(signed char, WS_W_PQ) + (size_t)l * 2048 * DM, NTOK, 2048, DM, WSP(float, WS_XSC), WSP(float, WS_WQS) + l * 2048};
    pg8::EpiQ E; E.q = WSP(bf16_t, WS_QBUF);
    __syncthreads();
    pg8::gemm_phase<pg8::EpiQ, pg8::XcdOrder, true, true, true>((PG8_LAS unsigned char*)smem, g, S, E);
}
template <int WHICH>
DI void run_gemm_pg8(const Params& p, unsigned char* smem) {
    volatile LAS unsigned* st = (volatile LAS unsigned*)(smem + SMEM_BYTES);
    pg8::XcdOrder S; S.init(NTOK / 256, DM / 256, (int)st[0], (int)st[1], (int)st[2], (int)st[3]);
    pg8::Gemm g;
    pg8::EpiResid<WHICH == 1> E; E.out = WSP(bf16_t, WS_RES);
    if (WHICH == 0) { g = pg8::Gemm{WSP(bf16_t, WS_MIXED), WSP(bf16_t, WS_W_ATTOUT), NTOK, DM, DM, nullptr, nullptr}; E.resid = p.in[0]; }
    else { g = pg8::Gemm{WSP(bf16_t, WS_Z_U), WSP(bf16_t, WS_W_SGUOUT), NTOK, DM, CW, nullptr, nullptr}; E.resid = WSP(bf16_t, WS_RES); }
    __syncthreads();
    pg8::gemm_phase<pg8::EpiResid<WHICH == 1>, pg8::XcdOrder, true, true>((PG8_LAS unsigned char*)smem, g, S, E);
}

DI void run_gemm1_pg8(const Params& p, unsigned char* smem) {
    volatile LAS unsigned* st = (volatile LAS unsigned*)(smem + SMEM_BYTES);
    pg8::XcdOrder S; S.init(NTOK / 256, ATT_IN / 256, (int)st[0], (int)st[1], (int)st[2], (int)st[3]);
    const pg8::Gemm g{WSP(signed char, WS_XQ), WSP(signed char, WS_W_ATTIN), NTOK, ATT_IN, DM, WSP(float, WS_XSC), WSP(float, WS_WAS)};
    pg8::EpiProj E; E.aq = p.in[3]; E.ak = p.in[4]; E.bq = p.in[5]; E.bk = p.in[6]; E.proj = WSP(bf16_t, WS_PROJ); E.xs = (PG8_LAS float*)(smem + PG8_EXTRA);
    __syncthreads();
    pg8::gemm_phase<pg8::EpiProj, pg8::XcdOrder, true, true, true>((PG8_LAS unsigned char*)smem, g, S, E);
}
DI void run_gemm4_pg8(const Params& p, unsigned char* smem) {
    volatile LAS unsigned* st = (volatile LAS unsigned*)(smem + SMEM_BYTES);
    pg8::XcdOrder S; S.init(NTOK / 256, 4096 / 256, (int)st[0], (int)st[1], (int)st[2], (int)st[3]);
    const pg8::Gemm g{WSP(signed char, WS_XQ), WSP(signed char, WS_W_SGUIN), NTOK, 4096, DM, WSP(float, WS_XSC), WSP(float, WS_WSS)};
    pg8::EpiSgu E; E.zu = WSP(bf16_t, WS_Z_U); E.zvt = WSP(bf16_t, WS_Z_VT); E.ssq = WSP(float, WS_SSQ); E.stg = (PG8_LAS unsigned char*)(smem + PG8_EXTRA);
    __syncthreads();
    pg8::gemm_phase<pg8::EpiSgu, pg8::XcdOrder, true, true, true>((PG8_LAS unsigned char*)smem, g, S, E);
}

DI u32 cand_key(float s, int ci) { return (f2ord(s) & ~255u) | (u32)(255 - ci); }
template <int P>
DI void score_half(const bf16x8 (&qf)[8], const unsigned char* skl, int fr, int fh, u32 (&lst)[16]) {
#pragma unroll
    for (int j = 0; j < 16; ++j) lst[j] = 0u;
#pragma unroll 1
    for (int kt = 0; kt < 4; ++kt) {
        f32x16 st;
#pragma unroll
        for (int r = 0; r < 16; ++r) st[r] = 0.f;
        const int row = P * 128 + kt * 32 + fr;
        const unsigned char* skr = skl + row * 256;
#pragma unroll
        for (int ks = 0; ks < 8; ++ks) st = MFMA32(*(const bf16x8*)(skr + (((2 * ks + fh) ^ (row & 15)) << 4)), qf[ks], st);
        u32 ks_[16];
#pragma unroll
        for (int r = 0; r < 16; ++r) ks_[r] = (f2ord(st[r]) & ~127u) | (u32)(127 - (kt * 32 + crow(r, fh)));
        sort16_desc(ks_);
        merge16_desc(lst, ks_);
    }
    u32 other[16];
#pragma unroll
    for (int j = 0; j < 16; ++j) other[j] = (u32)__shfl_xor((int)lst[j], 32);
    merge16_desc(lst, other);
}
DI void run_score(const Params& p, int l, unsigned char* smem) {
    const int tid = otid512(), wave = tid >> 6, lane = tid & 63, fr = lane & 31, fh = lane >> 5;
    int cur_h = -1;
    bf16x8 qa[8], qb[8];
    if ((int)blockIdx.x < 8 * (NTOK / 256)) {
        const int it0 = blockIdx.x;
        const bf16_t* q0 = WSP(bf16_t, WS_QBUF) + (size_t)((it0 >> 3) * 256 + wave * 32 + fr) * 2048 + (it0 & 7) * 256 + 8 * fh;
#pragma unroll
        for (int ks = 0; ks < 8; ++ks) { qa[ks] = *(const bf16x8*)(q0 + 16 * ks); qb[ks] = *(const bf16x8*)(q0 + 128 + 16 * ks); }
    }
#pragma unroll 1
    for (int it = blockIdx.x; it < 8 * (NTOK / 256); it += gridDim.x) {
    const int h = it & 7, oct = it >> 3;
    if (h != cur_h) {
        __syncthreads();
        const bf16_t* skg = WSP(bf16_t, WS_W_SUBK) + ((size_t)l * 16 + h * 2) * 128 * 128;
#pragma unroll
        for (int i = 0; i < 8; ++i) {
            const int idx = wave * 8 + i;
            const int row = 4 * idx + (lane >> 4), cp = lane & 15;
            __builtin_amdgcn_global_load_lds((const unsigned*)(skg + (size_t)row * 128 + ((cp ^ (row & 15)) << 3)), (unsigned*)(smem + idx * 1024 + lane * 16), 16, 0, 0);
        }
        asm volatile("s_waitcnt vmcnt(0)" ::: "memory");
        __syncthreads();
        cur_h = h;
    }
    const int tok = oct * 256 + wave * 32 + fr;
    const unsigned char* skh = smem;
    u32 L0[16], L1[16];
    score_half<0>(qa, skh, fr, fh, L0);
    score_half<1>(qb, skh, fr, fh, L1);
    {
        const int itn = it + gridDim.x < 8 * (NTOK / 256) ? it + gridDim.x : it;
        const bf16_t* qn = WSP(bf16_t, WS_QBUF) + (size_t)((itn >> 3) * 256 + wave * 32 + fr) * 2048 + (itn & 7) * 256 + 8 * fh;
#pragma unroll
        for (int ks = 0; ks < 8; ++ks) { qa[ks] = *(const bf16x8*)(qn + 16 * ks); qb[ks] = *(const bf16x8*)(qn + 128 + 16 * ks); }
    }
    LAS int* slot = (LAS int*)(smem + 65536 + wave * (64 * 132)) + lane * 33;
    float s1[16], s2[16];
#pragma unroll
    for (int j = 0; j < 16; ++j) {
        s1[j] = ord2f(L0[j] & ~127u); s2[j] = ord2f(L1[j] & ~127u);
        slot[j] = 127 - (int)(L0[j] & 127u); slot[16 + j] = 127 - (int)(L1[j] & 127u);
    }
    u32 lst[16];
#pragma unroll
    for (int j = 0; j < 16; ++j) lst[j] = cand_key(s1[0] + s2[j], j);
#pragma unroll
    for (int i = 1; i < 5; ++i) {
        u32 row[16];
#pragma unroll
        for (int j = 0; j < 16; ++j) row[j] = ((i + 1) * (j + 1) <= 16) ? cand_key(s1[i] + s2[j], i * 16 + j) : 0u;
        merge16_desc(lst, row);
    }
#pragma unroll
    for (int i = 5; i < 16; ++i)
#pragma unroll
        for (int j = 0; j < 2; ++j)
            if ((i + 1) * (j + 1) <= 16) top16_insert(lst, cand_key(s1[i] + s2[j], i * 16 + j));
    float pv[16]; float sum = 0.f;
    const float mx = ord2f(lst[0] & ~255u);
#pragma unroll
    for (int j = 0; j < 16; ++j) { pv[j] = __expf(ord2f(lst[j] & ~255u) - mx); sum += pv[j]; }
    const float inv = 1.f / sum;
    int ev[16];
#pragma unroll
    for (int j = 0; j < 16; ++j) {
        const int ci = 255 - (int)(lst[j] & 255u);
        ev[j] = slot[ci >> 4] * 128 + slot[16 + (ci & 15)];
    }
    if (fh == 0) {
        int4* ro = (int4*)(WSP(int, WS_RIDX) + (size_t)tok * 128 + h * 16);
        float4* go = (float4*)(WSP(float, WS_RG) + (size_t)tok * 128 + h * 16);
#pragma unroll
        for (int q = 0; q < 4; ++q) {
            ro[q] = make_int4(ev[4 * q], ev[4 * q + 1], ev[4 * q + 2], ev[4 * q + 3]);
            go[q] = make_float4(pv[4 * q] * inv, pv[4 * q + 1] * inv, pv[4 * q + 2] * inv, pv[4 * q + 3] * inv);
        }
    }
    }
}


#define OSM_THR 8.0f
DI void osm_update(f32x16& s, unsigned vm, float& m, float& lh, float& alpha) {
    float mx = -1e30f;
#pragma unroll
    for (int r = 0; r < 16; ++r) mx = ((vm >> r) & 1u) ? fmaxf(mx, s[r]) : mx;
    mx = fmaxf(mx, __shfl_xor(mx, 32));
    float mn = m; alpha = 1.f;
    if (!__all(mx <= m + OSM_THR)) { mn = fmaxf(m, mx); alpha = __expf(m - mn); }
    float ls = 0.f;
#pragma unroll
    for (int r = 0; r < 16; ++r) { const float pe = ((vm >> r) & 1u) ? __expf(s[r] - mn) : 0.f; s[r] = pe; ls += pe; }
    lh = lh * alpha + ls; m = mn;
}
DI void osm_update_full(f32x16& s, float& m, float& lh, float& alpha) {
    float mx = s[0];
#pragma unroll
    for (int r = 1; r < 16; ++r) mx = fmaxf(mx, s[r]);
    mx = fmaxf(mx, __shfl_xor(mx, 32));
    float mn = m; alpha = 1.f;
    if (!__all(mx <= m + OSM_THR)) { mn = fmaxf(m, mx); alpha = __expf(m - mn); }
    float ls = 0.f;
#pragma unroll
    for (int r = 0; r < 16; ++r) { const float pe = __expf(s[r] - mn); s[r] = pe; ls += pe; }
    lh = lh * alpha + ls; m = mn;
}
DI void tr_quad(const unsigned (&a)[4], unsigned hi_off, bf16x8 (&f)[4]) {
    s16x4 l0, h0, l1, h1, l2, h2, l3, h3;
    const unsigned b0 = a[0] + hi_off, b1 = a[1] + hi_off, b2 = a[2] + hi_off, b3 = a[3] + hi_off;
    asm volatile("ds_read_b64_tr_b16 %0, %8\n\tds_read_b64_tr_b16 %1, %9\n\tds_read_b64_tr_b16 %2, %10\n\tds_read_b64_tr_b16 %3, %11\n\t"
                 "ds_read_b64_tr_b16 %4, %12\n\tds_read_b64_tr_b16 %5, %13\n\tds_read_b64_tr_b16 %6, %14\n\tds_read_b64_tr_b16 %7, %15\n\ts_waitcnt lgkmcnt(0)"
                 : "=&v"(l0), "=&v"(h0), "=&v"(l1), "=&v"(h1), "=&v"(l2), "=&v"(h2), "=&v"(l3), "=&v"(h3)
                 : "v"(a[0]), "v"(b0), "v"(a[1]), "v"(b1), "v"(a[2]), "v"(b2), "v"(a[3]), "v"(b3) : "memory");
    f[0] = __builtin_shufflevector(l0, h0, 0, 1, 2, 3, 4, 5, 6, 7); f[1] = __builtin_shufflevector(l1, h1, 0, 1, 2, 3, 4, 5, 6, 7);
    f[2] = __builtin_shufflevector(l2, h2, 0, 1, 2, 3, 4, 5, 6, 7); f[3] = __builtin_shufflevector(l3, h3, 0, 1, 2, 3, 4, 5, 6, 7);
}

#define QB_BYTES (128 * 256)
#define KB_BYTES (32 * 256)
template <bool WITH_V>
DI void attnB_stage_kv(const bf16_t* __restrict__ kg  , unsigned char* Kd, unsigned char* Vd, int wave, int lane) {
#pragma unroll
    for (int i = 0; i < 2; ++i) {
        const int idx = wave * 2 + i;
        const int key = 4 * idx + (lane >> 4), cp = lane & 15;
        const bf16_t* g = kg + (size_t)key * ATT_IN;
        __builtin_amdgcn_global_load_lds((const unsigned*)(g + ((cp ^ (key & 15)) << 3)), (unsigned*)(Kd + idx * 1024 + lane * 16), 16, 0, 0);
        if (WITH_V) {
            const int cv = ((((cp >> 2) ^ (key & 3)) << 2) | (cp & 3));
            __builtin_amdgcn_global_load_lds((const unsigned*)(g + 512 + (cv << 3)), (unsigned*)(Vd + idx * 1024 + lane * 16), 16, 0, 0);
        }
    }
}
template <int KOFF, bool FULL>
DI void attnB_map(const unsigned char* Kc, const unsigned char* qlp, int ksw, int qsw, int fh, unsigned vm, unsigned vc, int tq,
                  float& m, float& l, f32x16 (&o)[4]) {
    f32x16 st;
#pragma unroll
    for (int r = 0; r < 16; ++r) st[r] = 0.f;
#pragma unroll
    for (int s = 0; s < 4; ++s) {
        const bf16x8 kf = *(const bf16x8*)(Kc + (((KOFF + 2 * s + fh) ^ ksw) << 4));
        const bf16x8 qf = *(const bf16x8*)(qlp + (((KOFF + 2 * s + fh) ^ qsw) << 4));
        st = MFMA32(kf, qf, st);
    }
    float al;
    if (FULL) osm_update_full(st, m, l, al); else osm_update(st, vm, m, l, al);
    if (!__all(al == 1.f)) {
#pragma unroll
        for (int d = 0; d < 4; ++d)
#pragma unroll
            for (int r = 0; r < 16; ++r) o[d][r] *= al;
    }
#pragma unroll
    for (int s = 0; s < 2; ++s) {
        const bf16x8 pf = pack_p(st, s);
        unsigned va[4]; bf16x8 vf[4];
#pragma unroll
        for (int d = 0; d < 4; ++d) va[d] = vc + s * 16 * 256 + ((d ^ tq) << 6);
        tr_quad(va, 8 * 256, vf);
#pragma unroll
        for (int d = 0; d < 4; ++d) o[d] = MFMA32(vf[d], pf, o[d]);
    }
}
DI void ph_attnB_fast(const Params& p, int item, unsigned char* smem) {
    const bf16_t* proj = WSP(bf16_t, WS_PROJ);
    const int tid = otid(), wave = tid >> 6, lane = tid & 63, fr = lane & 31, fh = lane >> 5;
    const int qt = 15 - (item >> 6), bh = item & 63, b = bh >> 2, h = bh & 3;
    const int q0 = qt * 128;
    const float lam = compute_lam(p, lane);
    const size_t rowbase = (size_t)b * SEQ;
    const int qrow = wave * 32 + fr, qpos = q0 + qrow;
    unsigned char* Ql = smem;
    unsigned char* Kl = smem + QB_BYTES;
    unsigned char* Vl = Kl + 2 * KB_BYTES;
    const bf16_t* kbase = proj + rowbase * ATT_IN + 2048 + h * 128;
    __syncthreads();
#pragma unroll
    for (int i = 0; i < 8; ++i) {
        const int idx = wave * 8 + i;
        const int row = 4 * idx + (lane >> 4), cp = lane & 15;
        __builtin_amdgcn_global_load_lds((const unsigned*)(proj + (rowbase + q0 + row) * ATT_IN + 1536 + h * 128 + ((cp ^ (row & 15)) << 3)),
                                         (unsigned*)(Ql + idx * 1024 + lane * 16), 16, 0, 0);
    }
    attnB_stage_kv<true>(kbase, Kl, Vl, wave, lane);
    const unsigned char* qlp = Ql + qrow * 256;
    const int qsw = qrow & 15, ksw = fr & 15;
    const int nkt = (q0 + 128) / 32;
    const int wlast = q0 + wave * 32 + 31;
    f32x16 o1[4], o2[4];
#pragma unroll
    for (int d = 0; d < 4; ++d)
#pragma unroll
        for (int r = 0; r < 16; ++r) { o1[d][r] = 0.f; o2[d][r] = 0.f; }
    float m1 = -1e30f, m2 = -1e30f, l1 = 0.f, l2 = 0.f;
    const int tq = (lane & 15) >> 2;
    const unsigned vrow = (unsigned)(uintptr_t)Vl + (4 * fh + tq) * 256 + (16 * ((lane >> 4) & 1) + 4 * (lane & 3)) * 2;
    asm volatile("s_waitcnt vmcnt(0)" ::: "memory");
    __syncthreads();
    for (int kt = 0; kt < nkt; ++kt) {
        const int cur = kt & 1;
        if (kt + 1 < nkt) attnB_stage_kv<true>(kbase + (size_t)(kt + 1) * 32 * ATT_IN, Kl + (cur ^ 1) * KB_BYTES, Vl + (cur ^ 1) * KB_BYTES, wave, lane);
        if (kt * 32 <= wlast) {
            const unsigned char* Kc = Kl + cur * KB_BYTES + fr * 256;
            const unsigned vc = vrow + cur * KB_BYTES;
            if (kt * 32 + 31 <= wlast - 31) {
                attnB_map<0, true>(Kc, qlp, ksw, qsw, fh, 0xffffu, vc, tq, m1, l1, o1);
                __builtin_amdgcn_sched_barrier(0);
                attnB_map<8, true>(Kc, qlp, ksw, qsw, fh, 0xffffu, vc, tq, m2, l2, o2);
            } else {
                unsigned vm = 0;
#pragma unroll
                for (int r = 0; r < 16; ++r) vm |= ((kt * 32 + crow(r, fh)) <= qpos) ? (1u << r) : 0u;
                attnB_map<0, false>(Kc, qlp, ksw, qsw, fh, vm, vc, tq, m1, l1, o1);
                __builtin_amdgcn_sched_barrier(0);
                attnB_map<8, false>(Kc, qlp, ksw, qsw, fh, vm, vc, tq, m2, l2, o2);
            }
        }
        asm volatile("s_waitcnt vmcnt(0)" ::: "memory");
        __syncthreads();
    }
    l1 += __shfl_xor(l1, 32); l2 += __shfl_xor(l2, 32);
    const float i1 = 1.f / l1, i2 = lam / l2;
    float ss = 0.f;
#pragma unroll
    for (int d = 0; d < 4; ++d)
#pragma unroll
        for (int r = 0; r < 16; ++r) { const float v = o1[d][r] * i1 - o2[d][r] * i2; o1[d][r] = v; ss += v * v; }
    ss += __shfl_xor(ss, 32);
    const float rinv = rsqrtf(ss * (1.f / 128.f) + EPSN) * 0.8f;
    const float* subg = p.in[11];
    bf16_t* op = WSP(bf16_t, WS_MIXED) + (rowbase + qpos) * DM + 512 + h * 128;
#pragma unroll
    for (int d = 0; d < 4; ++d)
#pragma unroll
        for (int g = 0; g < 4; ++g) {
            const int dim = 32 * d + 8 * g + 4 * fh;
            const float4 gg = *(const float4*)(subg + dim);
            uint2 w;
            w.x = pack2(o1[d][4 * g + 0] * rinv * gg.x, o1[d][4 * g + 1] * rinv * gg.y);
            w.y = pack2(o1[d][4 * g + 2] * rinv * gg.z, o1[d][4 * g + 3] * rinv * gg.w);
            *(uint2*)(op + dim) = w;
        }
}

#define KA_PITCH 128
#define VA_PITCH 192
#define WA_BYTES (32 * KA_PITCH + 32 * VA_PITCH)
template <int MODE>
DI void ph_attnA_fast(const Params& p, int item, unsigned char* smem) {
    const bf16_t* proj = WSP(bf16_t, WS_PROJ);
    const int tid = otid(), wave = tid >> 6, lane = tid & 63, fr = lane & 31, fh = lane >> 5;
    const int c = item & 15, h = (item >> 4) & 7, b = item >> 7;
    const size_t rowbase = (size_t)b * SEQ;
    const int qpos = MODE == 0 ? 128 * c + 32 * wave + fr : 16 * (32 * wave + fr) + c;
    const int pmin = MODE == 0 ? 128 * c + 32 * wave : 512 * wave + c, pmax = pmin + (MODE == 0 ? 31 : 496);
    bf16x8 qf[4];
    {
        const bf16_t* qp = proj + (rowbase + qpos) * ATT_IN + h * 64 + 8 * fh;
#pragma unroll
        for (int s = 0; s < 4; ++s) qf[s] = *(const bf16x8*)(qp + 16 * s);
    }
    f32x16 o[2];
#pragma unroll
    for (int d = 0; d < 2; ++d)
#pragma unroll
        for (int r = 0; r < 16; ++r) o[d][r] = 0.f;
    float m = -1e30f, l = 0.f;
    unsigned char* Kl = smem + wave * WA_BYTES;
    unsigned char* Vl = Kl + 32 * KA_PITCH;
    const unsigned vaddr = (unsigned)(uintptr_t)Vl + (4 * fh + ((lane & 15) >> 2)) * VA_PITCH + (16 * ((lane >> 4) & 1) + 4 * (lane & 3)) * 2;
    const int skey = lane >> 3, sc = lane & 7;
    int br = 0, d = MODE == 0 ? 1 : 16, W = MODE == 0 ? 128 : 2048, cls = MODE == 0 ? 0 : (c & 15);
    int j0 = MODE == 0 ? (pmin < 128 ? 0 : pmin - 128) : 0, jhi = MODE == 0 ? pmax : ((pmax - cls) >> 4);
    const bf16_t* kvbase = proj + rowbase * ATT_IN + 512 + h * 64 + sc * 8;
    uint4 rk0, rk1, rk2, rk3, rv0, rv1, rv2, rv3;
#define A_LOAD(i, RK, RV) do { int kp_ = cls + d * (j0 + skey + 8 * (i)); kp_ = kp_ > SEQ - 1 ? SEQ - 1 : kp_; kp_ = kp_ < 0 ? 0 : kp_; \
        const bf16_t* g_ = kvbase + (size_t)kp_ * ATT_IN; RK = *(const uint4*)g_; RV = *(const uint4*)(g_ + 512); } while (0)
#define A_WRITE(i, RK, RV) do { const int key_ = skey + 8 * (i); *(uint4*)(Kl + key_ * KA_PITCH + ((sc ^ ((key_ >> 1) & 7)) << 4)) = RK; \
        *(uint4*)(Vl + key_ * VA_PITCH + sc * 16) = RV; } while (0)
    A_LOAD(0, rk0, rv0); A_LOAD(1, rk1, rv1); A_LOAD(2, rk2, rv2); A_LOAD(3, rk3, rv3);
#pragma unroll 1
    for (;;) {
        A_WRITE(0, rk0, rv0); A_WRITE(1, rk1, rv1); A_WRITE(2, rk2, rv2); A_WRITE(3, rk3, rv3);
        const int cd = d, cW = W, ccls = cls, cj0 = j0;
        bool more = true;
        j0 += 32;
        if (j0 > jhi) {
            ++br;
            if (MODE == 0 || br == 2) more = false;
            else {
                d = 4; W = 512; cls = c & 3;
                const int lo = pmin - cls - W;
                j0 = lo < 0 ? 0 : lo >> 2;
                jhi = (pmax - cls) >> 2;
            }
        }
        A_LOAD(0, rk0, rv0); A_LOAD(1, rk1, rv1); A_LOAD(2, rk2, rv2); A_LOAD(3, rk3, rv3);
        f32x16 st;
#pragma unroll
        for (int r = 0; r < 16; ++r) st[r] = 0.f;
#pragma unroll
        for (int s = 0; s < 4; ++s) {
            const bf16x8 kf = *(const bf16x8*)(Kl + fr * KA_PITCH + (((2 * s + fh) ^ ((fr >> 1) & 7)) << 4));
            st = MFMA32(kf, qf[s], st);
        }
        float al;
        const int kfirst = ccls + cd * cj0, klast = kfirst + cd * 31;
        if (klast <= pmin && pmax - kfirst <= cW) osm_update_full(st, m, l, al);
        else {
            unsigned vm = 0;
#pragma unroll
            for (int r = 0; r < 16; ++r) {
                const int dist = qpos - (ccls + cd * (cj0 + crow(r, fh)));
                vm |= (dist >= 0 && dist <= cW) ? (1u << r) : 0u;
            }
            osm_update(st, vm, m, l, al);
        }
        if (!__all(al == 1.f)) {
#pragma unroll
            for (int dd = 0; dd < 2; ++dd)
#pragma unroll
                for (int r = 0; r < 16; ++r) o[dd][r] *= al;
        }
        {
            unsigned va[4]; bf16x8 vf[4];
            va[0] = vaddr; va[1] = vaddr + 64; va[2] = vaddr + 16 * VA_PITCH; va[3] = vaddr + 16 * VA_PITCH + 64;
            tr_quad(va, 8 * VA_PITCH, vf);
            const bf16x8 p0 = pack_p(st, 0), p1 = pack_p(st, 1);
            o[0] = MFMA32(vf[0], p0, o[0]); o[1] = MFMA32(vf[1], p0, o[1]);
            o[0] = MFMA32(vf[2], p1, o[0]); o[1] = MFMA32(vf[3], p1, o[1]);
        }
        if (!more) break;
    }
    l += __shfl_xor(l, 32);
    bf16_t* op = WSP(bf16_t, WS_MIXED) + (rowbase + qpos) * DM + h * 64;
    float* lsep = WSP(float, WS_LSE1) + (rowbase + qpos) * 8 + h;
    if (MODE == 0) {
        const float il = 1.f / l;
        if (fh == 0) *lsep = m + __logf(l);
#pragma unroll
        for (int dd = 0; dd < 2; ++dd)
#pragma unroll
            for (int g = 0; g < 4; ++g) {
                const int dim = 32 * dd + 8 * g + 4 * fh;
                uint2 w;
                w.x = pack2(o[dd][4 * g + 0] * il, o[dd][4 * g + 1] * il);
                w.y = pack2(o[dd][4 * g + 2] * il, o[dd][4 * g + 3] * il);
                *(uint2*)(op + dim) = w;
            }
    } else {
        const float lse1 = *lsep;
        const float M = fmaxf(m, lse1);
        const float w23 = __expf(m - M), w1 = __expf(lse1 - M);
        const float iden = 1.f / (l * w23 + w1);
        const float a23 = w23 * iden, a1 = w1 * iden;
        uint2 prev[2][4];
#pragma unroll
        for (int dd = 0; dd < 2; ++dd)
#pragma unroll
            for (int g = 0; g < 4; ++g) prev[dd][g] = *(const uint2*)(op + 32 * dd + 8 * g + 4 * fh);
#pragma unroll
        for (int dd = 0; dd < 2; ++dd)
#pragma unroll
            for (int g = 0; g < 4; ++g) {
                const int dim = 32 * dd + 8 * g + 4 * fh;
                const float p0 = __uint_as_float(prev[dd][g].x << 16), p1 = __uint_as_float(prev[dd][g].x & 0xffff0000u);
                const float p2 = __uint_as_float(prev[dd][g].y << 16), p3 = __uint_as_float(prev[dd][g].y & 0xffff0000u);
                uint2 w;
                w.x = pack2(o[dd][4 * g + 0] * a23 + p0 * a1, o[dd][4 * g + 1] * a23 + p1 * a1);
                w.y = pack2(o[dd][4 * g + 2] * a23 + p2 * a1, o[dd][4 * g + 3] * a23 + p3 * a1);
                *(uint2*)(op + dim) = w;
            }
    }
}
#define NITEM_B 1024
#define NITEM_A 2048
DI void ph_attn_fast(const Params& p, int vb, unsigned char* smem) {
    if (vb < NITEM_B) {
        const int item = vb < 512 ? vb : 512 + (1023 - vb);
        ph_attnB_fast(p, item, smem);
    } else ph_attnA_fast<0>(p, vb - NITEM_B, smem);
}


DI void ph_spatial_fast(const Params& p, int item, unsigned char* smem) {
    const int tid = otid(), wave = tid >> 6, lane = tid & 63, fr = lane & 31, fh = lane >> 5;
    const int wm = wave >> 1, wn = wave & 1;
    const int chunk = item >> 3, g = item & 7;
    bf16_t* u = WSP(bf16_t, WS_Z_U);
    const bf16_t* vt = WSP(bf16_t, WS_Z_VT);
    const float* ssq = WSP(float, WS_SSQ);
    const float* wsp = p.in[16] + (size_t)g * 128 * 128;
    float* rinv = (float*)(smem + 66 * 1024);
    unsigned char* Bt = smem + 32768;
    __syncthreads();
    if (tid < 128) {
        const float4* sp = (const float4*)(ssq + (size_t)(chunk * 128 + tid) * 64);
        float sacc = 0.f;
#pragma unroll
        for (int j = 0; j < 16; ++j) { const float4 q = sp[j]; sacc += (q.x + q.y) + (q.z + q.w); }
        rinv[tid] = rsqrtf(sacc * (1.f / CW) + EPSN);
    }
    const size_t vrow0 = (size_t)chunk * CW + g * 256;
    stage_tile(vt, 128, (int)vrow0, 0, Bt, wave, lane);
    stage_tile(vt, 128, (int)vrow0, 64, Bt + 16384, wave, lane);
    __syncthreads();
#pragma unroll
    for (int i = 0; i < 8; ++i) {
        const int id = tid + 256 * i;
        const int t = id >> 4, sc = id & 15;
        const float4 w0 = *(const float4*)(wsp + t * 128 + sc * 8);
        const float4 w1 = *(const float4*)(wsp + t * 128 + sc * 8 + 4);
        const float4 r0 = *(const float4*)(rinv + sc * 8);
        const float4 r1 = *(const float4*)(rinv + sc * 8 + 4);
        const int s0 = sc * 8;
        uint4 o;
        o.x = pack2(s0 + 0 <= t ? w0.x * r0.x : 0.f, s0 + 1 <= t ? w0.y * r0.y : 0.f);
        o.y = pack2(s0 + 2 <= t ? w0.z * r0.z : 0.f, s0 + 3 <= t ? w0.w * r0.w : 0.f);
        o.z = pack2(s0 + 4 <= t ? w1.x * r1.x : 0.f, s0 + 5 <= t ? w1.y * r1.y : 0.f);
        o.w = pack2(s0 + 6 <= t ? w1.z * r1.z : 0.f, s0 + 7 <= t ? w1.w * r1.w : 0.f);
        const int kt = sc >> 3, c = sc & 7;
        *(uint4*)(smem + kt * 16384 + t * 128 + ((c ^ ((t >> 1) & 7)) << 4)) = o;
    }
#pragma unroll 1
    for (int nt = 0; nt < 2; ++nt) {
        asm volatile("s_waitcnt vmcnt(0)" ::: "memory");
        __syncthreads();
        f32x16 acc[2][2];
#pragma unroll
        for (int i = 0; i < 2; ++i)
#pragma unroll
            for (int j = 0; j < 2; ++j)
#pragma unroll
                for (int r = 0; r < 16; ++r) acc[i][j][r] = 0.f;
#pragma unroll
        for (int kt = 0; kt < 2; ++kt)
#pragma unroll
            for (int s = 0; s < 4; ++s) {
                bf16x8 a[2], b[2];
#pragma unroll
                for (int i = 0; i < 2; ++i) {
                    a[i] = lds_frag(smem + kt * 16384, wm * 64 + i * 32 + fr, 2 * s + fh);
                    b[i] = lds_frag(Bt + kt * 16384, wn * 64 + i * 32 + fr, 2 * s + fh);
                }
#pragma unroll
                for (int i = 0; i < 2; ++i)
#pragma unroll
                    for (int j = 0; j < 2; ++j) acc[i][j] = MFMA32(a[i], b[j], acc[i][j]);
            }
        __syncthreads();
        float* st = (float*)(Bt + wave * (32 * 65 * 4));
#pragma unroll
        for (int i = 0; i < 2; ++i) {
#pragma unroll
            for (int j = 0; j < 2; ++j)
#pragma unroll
                for (int r = 0; r < 16; ++r) st[crow(r, fh) * 65 + j * 32 + fr] = acc[i][j][r];
            const int t = wm * 64 + i * 32 + fr;
            const int c0 = g * 256 + nt * 128 + wn * 64 + fh * 32;
            bf16_t* up = u + (size_t)(chunk * 128 + t) * CW + c0;
            const float bias = p.in[17][g * 128 + t];
            const float* gn = p.in[15] + c0;
            uint4 ur[4];
#pragma unroll
            for (int q = 0; q < 4; ++q) ur[q] = ((const uint4*)up)[q];
#pragma unroll
            for (int q = 0; q < 4; ++q) {
                float uf[8]; unpack8(ur[q], uf);
                const float4 g0 = *(const float4*)(gn + 8 * q), g1 = *(const float4*)(gn + 8 * q + 4);
                const float gg[8] = {g0.x, g0.y, g0.z, g0.w, g1.x, g1.y, g1.z, g1.w};
                float ov[8];
#pragma unroll
                for (int e = 0; e < 8; ++e) ov[e] = uf[e] * (st[fr * 65 + fh * 32 + 8 * q + e] * gg[e] + bias);
                uint4 o; o.x = pack2(ov[0], ov[1]); o.y = pack2(ov[2], ov[3]); o.z = pack2(ov[4], ov[5]); o.w = pack2(ov[6], ov[7]);
                ((uint4*)up)[q] = o;
            }
        }
        if (nt == 0) {
            __syncthreads();
            stage_tile(vt, 128, (int)vrow0 + 128, 0, Bt, wave, lane);
            stage_tile(vt, 128, (int)vrow0 + 128, 64, Bt + 16384, wave, lane);
        }
    }
}

#define XB_TMO      128
#define XB_XCNT(j)  (256  + 64 * (j))
#define XB_XSUB(j)  (1280 + 64 * (j))
#define XB_XGEN(j)  (2304 + 64 * (j))
#define XB_TOP      3328
#define XB_TOPGEN   3392
#define XCD_BAR_WORDS 3456
#define XB_SPIN_CAP (1u << 22)
DI unsigned xb_ld(unsigned* p) { return __hip_atomic_load(p, __ATOMIC_RELAXED, __HIP_MEMORY_SCOPE_AGENT); }
DI unsigned xb_add(unsigned* p, unsigned v) { return __hip_atomic_fetch_add(p, v, __ATOMIC_RELAXED, __HIP_MEMORY_SCOPE_AGENT); }
DI unsigned xb_xcc_id() { return (unsigned)__builtin_amdgcn_s_getreg((3 << 11) | 20) & 0xFu; }
#define XB_SPIN(cond, bar) do { unsigned _sp = 0; while (cond) { __builtin_amdgcn_s_sleep(1); \
    if ((++_sp & 255u) == 0u) { if (xb_ld(&(bar)[XB_TMO])) break; if (_sp > XB_SPIN_CAP) { atomicAdd(&(bar)[XB_TMO], 1u); break; } } } } while (0)
struct XcdBarrier { unsigned* bar; unsigned x; volatile LAS unsigned* st; };
DI XcdBarrier xcd_barrier_post(unsigned* bar, volatile LAS unsigned* st) {
    XcdBarrier b; b.bar = bar; b.x = xb_xcc_id(); b.st = st;
    if (threadIdx.x == 0) st[2] = xb_add(&bar[XB_XCNT(b.x)], 1u);
    return b;
}
DI void xcd_barrier_complete(unsigned* bar, unsigned x, unsigned& nloc, unsigned& nx, unsigned& xi) {
    const unsigned G = gridDim.x * gridDim.y * gridDim.z;
    unsigned sum, cnt, mine, below, sp = 0u;
    for (;;) {
        sum = 0u; cnt = 0u; mine = 0u; below = 0u;
#pragma unroll
        for (unsigned j = 0; j < 16; ++j) { const unsigned c = xb_ld(&bar[XB_XCNT(j)]); sum += c; cnt += (c > 0u) ? 1u : 0u; mine = (j == x) ? c : mine; below += (c > 0u && j < x) ? 1u : 0u; }
        if (sum == G) break;
        __builtin_amdgcn_s_sleep(1);
        if ((++sp & 255u) == 0u) { if (xb_ld(&bar[XB_TMO])) break; if (sp > XB_SPIN_CAP) { atomicAdd(&bar[XB_TMO], 1u); break; } }
    }
    nloc = mine > 0u ? mine : 1u; nx = cnt > 0u ? cnt : 1u; xi = below;
}
DI void xcd_barrier(const XcdBarrier& b) {
    asm volatile("s_waitcnt vmcnt(0)" ::: "memory");
    __syncthreads();
    if (threadIdx.x == 0) {
        unsigned* bar = b.bar;
        __builtin_amdgcn_s_waitcnt(0);
        unsigned nloc = b.st[0], nx = b.st[1];
        if (nloc == 0u) { unsigned xi; xcd_barrier_complete(bar, b.x, nloc, nx, xi); b.st[0] = nloc; b.st[1] = nx; b.st[3] = xi; }
        const unsigned old = xb_add(&bar[XB_XSUB(b.x)], 1u);
        const unsigned gen = old / nloc;
        if (old + 1u == (gen + 1u) * nloc) {
            __builtin_amdgcn_fence(__ATOMIC_RELEASE, "agent");
            asm volatile("s_waitcnt vmcnt(0)" ::: "memory");
            const unsigned og = xb_add(&bar[XB_TOP], 1u);
            const unsigned tg = og / nx;
            if (og + 1u == (tg + 1u) * nx) xb_add(&bar[XB_TOPGEN], 1u);
            else XB_SPIN(xb_ld(&bar[XB_TOPGEN]) == tg, bar);
            __builtin_amdgcn_fence(__ATOMIC_ACQUIRE, "agent");
            xb_add(&bar[XB_XGEN(b.x)], 1u);
            asm volatile("s_waitcnt vmcnt(0)" ::: "memory");
        } else {
            XB_SPIN(xb_ld(&bar[XB_XGEN(b.x)]) == gen, bar);
            __builtin_amdgcn_fence(__ATOMIC_ACQUIRE, "agent");
            asm volatile("s_waitcnt vmcnt(0)" ::: "memory");
        }
    }
    __syncthreads();
}

enum { PH_PREP = 0, PH_GEMM1, PH_ATTN, PH_ATTN2, PH_GEMM2,
       PH_NORM_P0, PH_GEMMQ0, PH_SCORE0, PH_PDOWN0, PH_PCOMB0, PH_PUP0, PH_NORM_SGU,
       PH_GEMM4, PH_SPATIAL, PH_GEMM5,
       PH_NORM_P1, PH_GEMMQ1, PH_SCORE1, PH_PDOWN1, PH_PCOMB1, PH_PUP1, PH_COUNT };

__host__ __device__ constexpr int phase_nvb(int ph) {
    switch (ph) {
        case PH_PREP: return PREP_N;
        case PH_GEMM1: return (ATT_IN / 256) * (NTOK / 256);
        case PH_ATTN: return NITEM_B + NITEM_A;
        case PH_ATTN2: return NITEM_A;
        case PH_GEMM2: return (DM / 256) * (NTOK / 256);
        case PH_NORM_P0: case PH_NORM_P1: case PH_NORM_SGU: return NTOK / 16;
        case PH_GEMMQ0: case PH_GEMMQ1: return 16 * (NTOK / 256);
        case PH_SCORE0: case PH_SCORE1: return (NTOK / 32) * 8 / 4;
        case PH_PCOMB0: case PH_PCOMB1: return NTOK / 8;
        case PH_GEMM4: return (4096 / 256) * (NTOK / 256);
        case PH_SPATIAL: return 256 * 8;
        case PH_GEMM5: return (DM / 256) * (NTOK / 256);
    }
    return 0;
}

template <int PH>
DI void run_vb(const Params& p, int vb, unsigned char* smem) {
    if constexpr (PH == PH_PREP) ph_prep(p, vb, smem);
    else if constexpr (PH == PH_ATTN) ph_attn_fast(p, vb, smem);
    else if constexpr (PH == PH_ATTN2) ph_attnA_fast<1>(p, vb, smem);
    else if constexpr (PH == PH_NORM_P0 || PH == PH_NORM_P1) rmsnorm_rows<true, 4>(WSP(bf16_t, WS_RES), p.in[19] + (PH == PH_NORM_P1 ? DM : 0), vb, WSP(signed char, WS_XQ), WSP(float, WS_XSC));
    else if constexpr (PH == PH_PCOMB0 || PH == PH_PCOMB1) ph_peer_comb(p, vb, PH == PH_PCOMB1 ? 1 : 0);
    else if constexpr (PH == PH_NORM_SGU) rmsnorm_rows<true, 4>(WSP(bf16_t, WS_RES), p.in[13], vb, WSP(signed char, WS_XQ), WSP(float, WS_XSC));
    else if constexpr (PH == PH_SPATIAL) ph_spatial_fast(p, vb, smem);
}

template <int PH>
DI void run_phase(const Params& p, unsigned char* smem) {
    if constexpr (PH == PH_PDOWN0 || PH == PH_PDOWN1) run_peer_sliced<false>(p, PH == PH_PDOWN1 ? 1 : 0, smem);
    else if constexpr (PH == PH_PUP0 || PH == PH_PUP1) run_peer_sliced<true>(p, PH == PH_PUP1 ? 1 : 0, smem);
    else if constexpr (PH == PH_SCORE0 || PH == PH_SCORE1) run_score(p, PH == PH_SCORE1 ? 1 : 0, smem);
    else if constexpr (PH == PH_GEMMQ0 || PH == PH_GEMMQ1) run_gemmq_pg8(p, PH == PH_GEMMQ1 ? 1 : 0, smem);
    else if constexpr (PH == PH_GEMM1) run_gemm1_pg8(p, smem);
    else if constexpr (PH == PH_GEMM4) run_gemm4_pg8(p, smem);
    else if constexpr (PH == PH_GEMM2) run_gemm_pg8<0>(p, smem);
    else if constexpr (PH == PH_GEMM5) run_gemm_pg8<1>(p, smem);
    else {
        constexpr int nvb = phase_nvb(PH);
        const int g = threadIdx.x >> 8;
        for (int vb = 2 * blockIdx.x; vb < nvb; vb += 2 * gridDim.x)
            if (vb + g < nvb) run_vb<PH>(p, vb + g, smem + g * GROUP_SMEM);
    }
}

template <int PH>
DI void run_from(const Params& p, unsigned char* smem, cg::grid_group& grid, const XcdBarrier& xb) {
    run_phase<PH>(p, smem);
    if constexpr (PH + 1 < PH_COUNT) {
        if constexpr (PH == 1) grid.sync(); else xcd_barrier(xb);
        run_from<PH + 1>(p, smem, grid, xb);
    }
}

__global__ void __launch_bounds__(NTHREADS, 2) k_mega(Params p) {
    extern __shared__ __attribute__((aligned(16))) unsigned char smem[];
    cg::grid_group grid = cg::this_grid();
    volatile LAS unsigned* st = (volatile LAS unsigned*)(smem + SMEM_BYTES);
    if (threadIdx.x == 0) { st[0] = 0u; st[1] = 0u; st[2] = 0u; st[3] = 0u; }
    __syncthreads();
    const XcdBarrier xb = xcd_barrier_post((unsigned*)(p.ws + WS_CTL), st);
    run_from<0>(p, smem, grid, xb);
}


extern "C" void kernel_launch(void* const* d_in, const int* in_sizes, int n_in, void* d_out, int out_size, void* d_ws, size_t ws_size, hipStream_t stream) {
    if (n_in != 24 || ws_size < WS_NEED || in_sizes[0] != NTOK * DM || out_size != NTOK * DM || in_sizes[22] != 2 * NEXP * DM) {
        fprintf(stderr, "kernel_launch: built for x[16,2048,1024] with 24 inputs and >= 512 MiB of workspace; got n_in %d, in0 %d, out %d, ws %zu: nothing launched\n", n_in, in_sizes[0], out_size, ws_size); return; }
    static int grid_blocks = 0;
    if (!grid_blocks) {
        int dev = 0, cus = 0, per_cu = 0;
        (void)hipGetDevice(&dev);
        (void)hipDeviceGetAttribute(&cus, hipDeviceAttributeMultiprocessorCount, dev);
        (void)hipFuncSetAttribute((const void*)k_mega, hipFuncAttributeMaxDynamicSharedMemorySize, SMEM_ALLOC);
        (void)hipOccupancyMaxActiveBlocksPerMultiprocessor(&per_cu, (const void*)k_mega, NTHREADS, SMEM_ALLOC);
        if (per_cu > 1) per_cu = 1;
        if (per_cu < 1) { fprintf(stderr, "kernel_launch: occupancy query returned %d\n", per_cu); per_cu = 1; }
        grid_blocks = cus * per_cu;
    }
    Params p{};
    for (int i = 0; i < 24; ++i) p.in[i] = (const float*)d_in[i];
    p.out = (float*)d_out;
    p.ws = (unsigned char*)d_ws;
    void* args[] = {&p};
    if (hipMemsetAsync((unsigned char*)d_ws + WS_CTL, 0, XCD_BAR_WORDS * 4, stream) != hipSuccess) { fprintf(stderr, "kernel_launch: memset of the barrier words failed\n"); return; }
    hipError_t e = hipLaunchCooperativeKernel((const void*)k_mega, dim3(grid_blocks), dim3(NTHREADS), args, SMEM_ALLOC, stream);
    if (e != hipSuccess) fprintf(stderr, "cooperative launch failed: %s (grid %d)\n", hipGetErrorString(e), grid_blocks);
}
```

```cpp
#include <hip/hip_runtime.h>
#include <stdint.h>
#include <stdio.h>

#define NTOK   32768
#define DM     1024
#define SEQ    2048
#define NB     16
#define ATT_IN 3072
#define CW     2048
#define NEXP   16384
#define EPSN   1e-6f

typedef unsigned short bf16_t;
typedef unsigned int u32;

#define DI __device__ __forceinline__
#define LAS __attribute__((address_space(3)))

DI int otid() { int t = threadIdx.x & 255; asm volatile("" : "+v"(t)); return t; }
DI int otid512() { int t = threadIdx.x; asm volatile("" : "+v"(t)); return t; }
DI float bf2f(bf16_t v) { return __uint_as_float(((u32)v) << 16); }
typedef __bf16 bf16v2 __attribute__((ext_vector_type(2)));
DI bf16_t f2bf(float f) { const __bf16 h = (__bf16)f; return __builtin_bit_cast(bf16_t, h); }
DI u32 pack2(float lo, float hi) { bf16v2 v; v[0] = (__bf16)lo; v[1] = (__bf16)hi; return __builtin_bit_cast(u32, v); }
DI float gelu_tanh(float x) {
    const float y = 0.7978845608028654f * (x + 0.044715f * x * x * x);
    const float e = __expf(2.f * y);
    const float t = 1.f - 2.f / (e + 1.f);
    return 0.5f * x * (1.f + t);
}
DI float wave_sum(float v) {
#pragma unroll
    for (int o = 1; o < 64; o <<= 1) v += __shfl_xor(v, o);
    return v;
}
DI float wave_max(float v) {
#pragma unroll
    for (int o = 1; o < 64; o <<= 1) v = fmaxf(v, __shfl_xor(v, o));
    return v;
}
DI u32 f2ord(float f) { u32 u = __float_as_uint(f); return (u & 0x80000000u) ? ~u : (u | 0x80000000u); }
DI float ord2f(u32 o) { u32 u = (o & 0x80000000u) ? (o & 0x7fffffffu) : ~o; return __uint_as_float(u); }

#define MiB ((size_t)1 << 20)
#define WS_CTL      ((size_t)0)
#define WS_W_ATTIN  (1 * MiB)
#define WS_W_ATTOUT (7 * MiB)
#define WS_W_SGUIN  (9 * MiB)
#define WS_W_SGUOUT (17 * MiB)
#define WS_W_PQ     (21 * MiB)
#define WS_WQS      (25 * MiB)
#define WS_WAS      (25 * MiB + 64 * 1024)
#define WS_WSS      (25 * MiB + 128 * 1024)
#define WS_W_SUBK   (29 * MiB)
#define WS_DOWN     (32 * MiB)
#define WS_UP       (64 * MiB)
#define WS_DSC      (96 * MiB)
#define WS_USC      (96 * MiB + 128 * 1024)
#define WS_LSE1     (30 * MiB)
#define WS_XQ       (100 * MiB)
#define WS_XSC      (132 * MiB)
#define WS_RES      (160 * MiB)
#define WS_BIG      (224 * MiB)
#define WS_PROJ     (WS_BIG)
#define WS_MIXED    (WS_BIG + 192 * MiB)
#define WS_Z_U      (WS_BIG)
#define WS_Z_VT     (WS_BIG + 128 * MiB)
#define WS_RIDX     (WS_BIG + 32 * MiB)
#define WS_RG       (WS_BIG + 48 * MiB)
#define WS_QBUF     (WS_BIG + 64 * MiB)
#define WS_SSQ      (WS_BIG + 256 * MiB)
#define WS_NEED     (512 * MiB)

struct Params {
    const float* in[24];
    float* out;
    unsigned char* ws;
};

#include <hip/hip_cooperative_groups.h>
namespace cg = cooperative_groups;

#define GROUP_SMEM (68 * 1024)
#define PG8_EXTRA (128 * 1024)
#define SMEM_BYTES (144 * 1024)
#define SMEM_ALLOC (SMEM_BYTES + 16)
#define NTHREADS 512

#define WSP(T, off) ((T*)(p.ws + (off)))


DI void transpose_tile(const float* __restrict__ W, bf16_t* __restrict__ Wt, int K, int N, int t, unsigned char* smem) {
    float* tile = (float*)smem;
    const int tid = otid();
    const int ntn = N / 64;
    const int n0 = (t % ntn) * 64, k0 = (t / ntn) * 64;
    __syncthreads();
    {
        const int n4 = tid & 15, kr = tid >> 4;
#pragma unroll
        for (int i = 0; i < 4; ++i) {
            const int k = kr + 16 * i;
            const float4 v = *(const float4*)(W + (size_t)(k0 + k) * N + n0 + 4 * n4);
            tile[k * 65 + 4 * n4 + 0] = v.x; tile[k * 65 + 4 * n4 + 1] = v.y; tile[k * 65 + 4 * n4 + 2] = v.z; tile[k * 65 + 4 * n4 + 3] = v.w;
        }
    }
    __syncthreads();
    {
        const int n = tid >> 2, kc = tid & 3;
        float v[16];
#pragma unroll
        for (int j = 0; j < 16; ++j) v[j] = tile[(16 * kc + j) * 65 + n];
        uint4 o0, o1;
        o0.x = pack2(v[0], v[1]); o0.y = pack2(v[2], v[3]); o0.z = pack2(v[4], v[5]); o0.w = pack2(v[6], v[7]);
        o1.x = pack2(v[8], v[9]); o1.y = pack2(v[10], v[11]); o1.z = pack2(v[12], v[13]); o1.w = pack2(v[14], v[15]);
        uint4* dst = (uint4*)(Wt + (size_t)(n0 + n) * K + k0 + 16 * kc);
        dst[0] = o0; dst[1] = o1;
    }
}
DI void cvt_chunk(const float* __restrict__ src, bf16_t* __restrict__ dst, int c) {
    const size_t base = (size_t)c * 2048;
#pragma unroll
    for (int i = 0; i < 8; ++i) {
        const size_t idx = base + i * 256 + otid();
        const float4 v = ((const float4*)src)[idx];
        uint2 o; o.x = pack2(v.x, v.y); o.y = pack2(v.z, v.w);
        ((uint2*)dst)[idx] = o;
    }
}
DI int q8(float v) { int i = __float2int_rn(v); i = i > 127 ? 127 : i; i = i < -127 ? -127 : i; return i & 255; }
template <bool IN_BF16, int ROWS>
DI void rmsnorm_rows(const void* __restrict__ x, const float* __restrict__ g, int vb, signed char* xq, float* xsc) {
    const int lane = otid() & 63;
    const int row0 = (vb * 4 + (otid() >> 6)) * ROWS;
    float4 v[ROWS][4];
#pragma unroll
    for (int r = 0; r < ROWS; ++r)
#pragma unroll
        for (int j = 0; j < 4; ++j) {
            if (IN_BF16) { const uint2 w = ((const uint2*)((const bf16_t*)x + (size_t)(row0 + r) * DM))[lane + 64 * j];
                v[r][j] = make_float4(__uint_as_float(w.x << 16), __uint_as_float(w.x & 0xffff0000u), __uint_as_float(w.y << 16), __uint_as_float(w.y & 0xffff0000u)); }
            else v[r][j] = ((const float4*)((const float*)x + (size_t)(row0 + r) * DM))[lane + 64 * j];
        }
    float4 gg[4];
#pragma unroll
    for (int j = 0; j < 4; ++j) gg[j] = ((const float4*)g)[lane + 64 * j];
#pragma unroll
    for (int r = 0; r < ROWS; ++r) {
        float ss = 0.f;
#pragma unroll
        for (int j = 0; j < 4; ++j) ss += v[r][j].x * v[r][j].x + v[r][j].y * v[r][j].y + v[r][j].z * v[r][j].z + v[r][j].w * v[r][j].w;
        ss = wave_sum(ss);
        const float rinv = rsqrtf(ss * (1.f / DM) + EPSN);
        float am = 0.f;
#pragma unroll
        for (int j = 0; j < 4; ++j) {
            v[r][j].x *= rinv * gg[j].x; v[r][j].y *= rinv * gg[j].y; v[r][j].z *= rinv * gg[j].z; v[r][j].w *= rinv * gg[j].w;
            am = fmaxf(am, fmaxf(fmaxf(fabsf(v[r][j].x), fabsf(v[r][j].y)), fmaxf(fabsf(v[r][j].z), fabsf(v[r][j].w))));
        }
        am = wave_max(am);
        const float sc = am > 0.f ? 127.f / am : 0.f;
        u32* qrow = (u32*)(xq + (size_t)(row0 + r) * DM);
#pragma unroll
        for (int j = 0; j < 4; ++j)
            qrow[lane + 64 * j] = (u32)q8(v[r][j].x * sc) | ((u32)q8(v[r][j].y * sc) << 8) | ((u32)q8(v[r][j].z * sc) << 16) | ((u32)q8(v[r][j].w * sc) << 24);
        if (lane == 0) xsc[row0 + r] = am * (1.f / 127.f);
    }
}
#define PREP_T0 48
#define PREP_T1 (PREP_T0 + 16 * 16)
#define PREP_T2 (PREP_T1 + 64)
#define PREP_T3 (PREP_T2 + 16 * 32)
#define PREP_T4 (PREP_T3 + 2 * 32)
#define PREP_C0 (PREP_T4 + 64)
#define PREP_C1 (PREP_C0 + 4096)
#define PREP_C2 (PREP_C1 + 4096)
#define PREP_N  (PREP_C2 + 4096)
template <bool INT8>
DI void fp8_rows(const float* __restrict__ src, unsigned char* __restrict__ dst, float* __restrict__ inv_scale, int vb) {
    const int lane = otid() & 63;
    const int row0 = (vb * 4 + (otid() >> 6)) * 2;
    float4 v[2][4];
#pragma unroll
    for (int r = 0; r < 2; ++r)
#pragma unroll
        for (int j = 0; j < 4; ++j) v[r][j] = ((const float4*)(src + (size_t)(row0 + r) * DM) + lane)[64 * j];
#pragma unroll
    for (int r = 0; r < 2; ++r) {
        const int row = row0 + r;
        float am = 0.f;
#pragma unroll
        for (int j = 0; j < 4; ++j) am = fmaxf(am, fmaxf(fmaxf(fabsf(v[r][j].x), fabsf(v[r][j].y)), fmaxf(fabsf(v[r][j].z), fabsf(v[r][j].w))));
        am = wave_max(am);
        float sc, inv;
        if (INT8) { sc = am > 0.f ? 127.f / am : 0.f; inv = am * (1.f / 127.f); }
        else {
            int e = (int)((__float_as_uint(am) >> 23) & 255u) - 127;
            if (am == 0.f) e = 0;
            e = e < -100 ? -100 : e;
            sc = __uint_as_float((u32)(127 + 7 - e) << 23); inv = __uint_as_float((u32)(127 + e - 7) << 23);
        }
        unsigned char* drow = dst + (size_t)(row >> 14) * NEXP * DM + (size_t)(row & (NEXP - 1)) * 128;
#pragma unroll
        for (int j = 0; j < 4; ++j) {
            const int dim = 4 * (lane + 64 * j);
            u32 w;
            if (INT8) w = (u32)q8(v[r][j].x * sc) | ((u32)q8(v[r][j].y * sc) << 8) | ((u32)q8(v[r][j].z * sc) << 16) | ((u32)q8(v[r][j].w * sc) << 24);
            else { int t = __builtin_amdgcn_cvt_pk_fp8_f32(v[r][j].x * sc, v[r][j].y * sc, 0, false); t = __builtin_amdgcn_cvt_pk_fp8_f32(v[r][j].z * sc, v[r][j].w * sc, t, true); w = (u32)t; }
            *(u32*)(drow + (size_t)(dim >> 7) * NEXP * 128 + (dim & 127)) = w;
        }
        if (lane == 0) inv_scale[row] = inv;
    }
}
DI void wq8_item(const float* __restrict__ W, signed char* __restrict__ Wt, float* __restrict__ wsc, int t, unsigned char* smem, int N) {
    float* red = (float*)smem;
    const int tid = otid(), n = tid & 63, kq = tid >> 6;
    const float* col = W + t * 64 + n;
    float am = 0.f;
#pragma unroll 16
    for (int k = 0; k < 256; ++k) am = fmaxf(am, fabsf(col[(size_t)(kq * 256 + k) * N]));
    __syncthreads();
    red[kq * 64 + n] = am;
    __syncthreads();
    am = fmaxf(fmaxf(red[n], red[64 + n]), fmaxf(red[128 + n], red[192 + n]));
    const float sc = am > 0.f ? 127.f / am : 0.f;
    if (kq == 0) wsc[t * 64 + n] = am * (1.f / 127.f);
    signed char* drow = Wt + (size_t)(t * 64 + n) * 1024;
#pragma unroll 1
    for (int kb = 0; kb < 16; ++kb) {
        const int k0 = kb * 64 + kq * 16;
        u32 w[4];
#pragma unroll
        for (int j = 0; j < 4; ++j) {
            const float* c4 = col + (size_t)(k0 + 4 * j) * N;
            w[j] = (u32)q8(c4[0] * sc) | ((u32)q8(c4[N] * sc) << 8) | ((u32)q8(c4[2 * N] * sc) << 16) | ((u32)q8(c4[3 * N] * sc) << 24);
        }
        *(uint4*)(drow + k0) = make_uint4(w[0], w[1], w[2], w[3]);
    }
}
DI void ph_prep(const Params& p, int vb, unsigned char* smem) {
    if (vb < PREP_T0) wq8_item(p.in[2], WSP(signed char, WS_W_ATTIN), WSP(float, WS_WAS), vb, smem, ATT_IN);
    else if (vb < PREP_T1) transpose_tile(p.in[12], WSP(bf16_t, WS_W_ATTOUT), DM, DM, vb - PREP_T0, smem);
    else if (vb < PREP_T2) wq8_item(p.in[14], WSP(signed char, WS_W_SGUIN), WSP(float, WS_WSS), vb - PREP_T1, smem, 4096);
    else if (vb < PREP_T3) transpose_tile(p.in[18], WSP(bf16_t, WS_W_SGUOUT), CW, DM, vb - PREP_T2, smem);
    else if (vb < PREP_T4) { const int t = vb - PREP_T3, l = t / 32; wq8_item(p.in[20] + (size_t)l * DM * 2048, WSP(signed char, WS_W_PQ) + (size_t)l * 2048 * DM, WSP(float, WS_WQS) + l * 2048, t % 32, smem, 2048); }
    else if (vb < PREP_C0) cvt_chunk(p.in[21], WSP(bf16_t, WS_W_SUBK), vb - PREP_T4);
    else if (vb < PREP_C1) fp8_rows<true>(p.in[22], p.ws + WS_DOWN, WSP(float, WS_DSC), vb - PREP_C0);
    else if (vb < PREP_C2) fp8_rows<false>(p.in[23], p.ws + WS_UP, WSP(float, WS_USC), vb - PREP_C1);
    else rmsnorm_rows<false, 2>(p.in[0], p.in[1], vb - PREP_C2, WSP(signed char, WS_XQ), WSP(float, WS_XSC));
}

DI float compute_lam(const Params& p, int lane) {
    const float a = wave_sum(p.in[7][lane] * p.in[8][lane]);
    const float b = wave_sum(p.in[9][lane] * p.in[10][lane]);
    return __expf(a) - __expf(b) + 0.2f;
}
DI void ce_desc(u32& a, u32& b) { const u32 hi = max(a, b), lo = min(a, b); a = hi; b = lo; }
DI void sort16_desc(u32 (&v)[16]) {
#define SCE(a, b) ce_desc(v[a], v[b]);
    SCE(0,13) SCE(1,12) SCE(2,15) SCE(3,14) SCE(4,8) SCE(5,6) SCE(7,11) SCE(9,10)
    SCE(0,5) SCE(1,7) SCE(2,9) SCE(3,4) SCE(6,13) SCE(8,14) SCE(10,15) SCE(11,12)
    SCE(0,1) SCE(2,3) SCE(4,5) SCE(6,8) SCE(7,9) SCE(10,11) SCE(12,13) SCE(14,15)
    SCE(0,2) SCE(1,3) SCE(4,10) SCE(5,11) SCE(6,7) SCE(8,9) SCE(12,14) SCE(13,15)
    SCE(1,2) SCE(3,12) SCE(4,6) SCE(5,7) SCE(8,10) SCE(9,11) SCE(13,14)
    SCE(1,4) SCE(2,6) SCE(5,8) SCE(7,10) SCE(9,13) SCE(11,14)
    SCE(2,4) SCE(3,6) SCE(9,12) SCE(11,13)
    SCE(3,5) SCE(6,8) SCE(7,9) SCE(10,12)
    SCE(3,4) SCE(5,6) SCE(7,8) SCE(9,10) SCE(11,12)
    SCE(6,7) SCE(8,9)
#undef SCE
}
DI void merge16_desc(u32 (&a)[16], const u32 (&b)[16]) {
#pragma unroll
    for (int i = 0; i < 16; ++i) a[i] = max(a[i], b[15 - i]);
#pragma unroll
    for (int j = 8; j > 0; j >>= 1)
#pragma unroll
        for (int i = 0; i < 16; ++i) { const int l = i ^ j; if (l > i) ce_desc(a[i], a[l]); }
}
DI void top16_insert(u32 (&lst)[16], u32 x) {
#pragma unroll
    for (int j = 0; j < 16; ++j) { const u32 hi = max(lst[j], x); x = min(lst[j], x); lst[j] = hi; }
}
DI void unpack8(const uint4 v, float (&f)[8]) {
    f[0] = __uint_as_float(v.x << 16); f[1] = __uint_as_float(v.x & 0xffff0000u);
    f[2] = __uint_as_float(v.y << 16); f[3] = __uint_as_float(v.y & 0xffff0000u);
    f[4] = __uint_as_float(v.z << 16); f[5] = __uint_as_float(v.z & 0xffff0000u);
    f[6] = __uint_as_float(v.w << 16); f[7] = __uint_as_float(v.w & 0xffff0000u);
}
typedef float f32x2_t __attribute__((ext_vector_type(2)));
DI void unpack16fp8(const uint4 w, float (&f)[16]) {
    f32x2_t t;
    t = __builtin_amdgcn_cvt_pk_f32_fp8((int)w.x, false); f[0] = t[0]; f[1] = t[1];
    t = __builtin_amdgcn_cvt_pk_f32_fp8((int)w.x, true);  f[2] = t[0]; f[3] = t[1];
    t = __builtin_amdgcn_cvt_pk_f32_fp8((int)w.y, false); f[4] = t[0]; f[5] = t[1];
    t = __builtin_amdgcn_cvt_pk_f32_fp8((int)w.y, true);  f[6] = t[0]; f[7] = t[1];
    t = __builtin_amdgcn_cvt_pk_f32_fp8((int)w.z, false); f[8] = t[0]; f[9] = t[1];
    t = __builtin_amdgcn_cvt_pk_f32_fp8((int)w.z, true);  f[10] = t[0]; f[11] = t[1];
    t = __builtin_amdgcn_cvt_pk_f32_fp8((int)w.w, false); f[12] = t[0]; f[13] = t[1];
    t = __builtin_amdgcn_cvt_pk_f32_fp8((int)w.w, true);  f[14] = t[0]; f[15] = t[1];
}
struct PeerPre { int e[16]; uint4 xa, xb; float2 r; };
struct PeerRows { uint4 d[8]; float c[8]; };
template <bool UP>
DI PeerPre peer_prefetch(const Params& p, int tok, int sl, int lane) {
    PeerPre q;
    const int4* rix = (const int4*)(WSP(int, WS_RIDX) + (size_t)tok * 128 + 16 * (lane >> 3));
#pragma unroll
    for (int j = 0; j < 4; ++j) { const int4 t = rix[j]; q.e[4 * j] = t.x; q.e[4 * j + 1] = t.y; q.e[4 * j + 2] = t.z; q.e[4 * j + 3] = t.w; }
    if (UP) {
        const u32 w = *(const u32*)(WSP(bf16_t, WS_RES) + (size_t)tok * DM + sl * 128 + 16 * (lane & 7) + 2 * (lane >> 3));
        q.r = make_float2(__uint_as_float(w << 16), __uint_as_float(w & 0xffff0000u));
    } else {
        q.xa = *(const uint4*)(WSP(signed char, WS_XQ) + (size_t)tok * DM + sl * 128 + 16 * (lane & 7));
    }
    return q;
}
template <int HF, bool UP>
DI void peer_issue_rows(const Params& p, const unsigned char* tab, const PeerPre& q, int tok, int lane, PeerRows& R) {
    const unsigned dco = 16u * (unsigned)(lane & 7);
#pragma unroll
    for (int bi = 0; bi < 8; ++bi) R.d[bi] = *(const uint4*)(tab + ((unsigned)q.e[8 * HF + bi] * 128u + dco));
    if (UP) {
        const float4* cf = (const float4*)(WSP(float, WS_RG) + (size_t)tok * 128 + 16 * (lane >> 3) + 8 * HF);
        const float4 c0 = cf[0], c1 = cf[1];
        R.c[0] = c0.x; R.c[1] = c0.y; R.c[2] = c0.z; R.c[3] = c0.w; R.c[4] = c1.x; R.c[5] = c1.y; R.c[6] = c1.z; R.c[7] = c1.w;
    }
}
template <int HF>
DI void peer_down_half(const PeerPre& q, const PeerRows& R, float (&part)[16]) {
#pragma unroll
    for (int bi = 0; bi < 8; ++bi) {
        int a = __builtin_amdgcn_sdot4((int)R.d[bi].x, (int)q.xa.x, 0, false);
        a = __builtin_amdgcn_sdot4((int)R.d[bi].y, (int)q.xa.y, a, false);
        a = __builtin_amdgcn_sdot4((int)R.d[bi].z, (int)q.xa.z, a, false);
        a = __builtin_amdgcn_sdot4((int)R.d[bi].w, (int)q.xa.w, a, false);
        part[8 * HF + bi] = (float)a;
    }
}
DI void peer_down_fin(const Params& p, const float (&part)[16], int tok, int sl, int lane) {
    const bool b2 = lane & 4, b1 = lane & 2, b0 = lane & 1;
    float r8[8], r4[4], r2[2];
#pragma unroll
    for (int i = 0; i < 8; ++i) { const float snd = b2 ? part[i] : part[i + 8]; const float kp = b2 ? part[i + 8] : part[i]; r8[i] = kp + __shfl_xor(snd, 4); }
#pragma unroll
    for (int i = 0; i < 4; ++i) { const float snd = b1 ? r8[i] : r8[i + 4]; const float kp = b1 ? r8[i + 4] : r8[i]; r4[i] = kp + __shfl_xor(snd, 2); }
#pragma unroll
    for (int i = 0; i < 2; ++i) { const float snd = b0 ? r4[i] : r4[i + 2]; const float kp = b0 ? r4[i + 2] : r4[i]; r2[i] = kp + __shfl_xor(snd, 1); }
    u32* pd = WSP(u32, WS_QBUF) + ((size_t)tok * 8 + sl) * 64;
    pd[lane] = pack2(r2[0], r2[1]);
}
DI void ph_peer_comb(const Params& p, int vb, int l) {
    const int tid = otid(), lane = tid & 63;
    const int tok0 = (vb * 4 + (tid >> 6)) * 2;
    const float* dsc = WSP(float, WS_DSC) + (size_t)l * NEXP;
    const float* usc = WSP(float, WS_USC) + (size_t)l * NEXP;
    u32 w[2][8]; int2 e[2]; float2 g[2]; float xs[2];
#pragma unroll
    for (int r = 0; r < 2; ++r) {
        const int tok = tok0 + r;
        const u32* pd = WSP(u32, WS_QBUF) + (size_t)tok * 8 * 64;
#pragma unroll
        for (int sl = 0; sl < 8; ++sl) w[r][sl] = pd[sl * 64 + lane];
        e[r] = *(const int2*)(WSP(int, WS_RIDX) + (size_t)tok * 128 + 2 * lane);
        g[r] = *(const float2*)(WSP(float, WS_RG) + (size_t)tok * 128 + 2 * lane);
        xs[r] = WSP(float, WS_XSC)[tok];
    }
#pragma unroll
    for (int r = 0; r < 2; ++r) {
        float t0 = 0.f, t1 = 0.f;
#pragma unroll
        for (int sl = 0; sl < 8; ++sl) { t0 += __uint_as_float(w[r][sl] << 16); t1 += __uint_as_float(w[r][sl] & 0xffff0000u); }
        float2 o;
        o.x = g[r].x * gelu_tanh(t0 * dsc[e[r].x] * xs[r]) * usc[e[r].x];
        o.y = g[r].y * gelu_tanh(t1 * dsc[e[r].y] * xs[r]) * usc[e[r].y];
        *(float2*)(WSP(float, WS_RG) + (size_t)(tok0 + r) * 128 + 2 * lane) = o;
    }
}
template <int HF>
DI void peer_up_half(const PeerPre& q, const PeerRows& R, float (&y)[16]) {
#pragma unroll
    for (int bi = 0; bi < 8; ++bi) {
        const float c = R.c[bi];
        float w[16]; unpack16fp8(R.d[bi], w);
#pragma unroll
        for (int i = 0; i < 16; ++i) y[i] += c * w[i];
        asm volatile("" : "+v"(y[0]), "+v"(y[1]), "+v"(y[2]), "+v"(y[3]), "+v"(y[4]), "+v"(y[5]), "+v"(y[6]), "+v"(y[7]), "+v"(y[8]), "+v"(y[9]), "+v"(y[10]), "+v"(y[11]), "+v"(y[12]), "+v"(y[13]), "+v"(y[14]), "+v"(y[15]));
    }
}
DI void peer_up_fin(const Params& p, const PeerPre& q, const float (&y)[16], int tok, int sl, int lane, bool final_layer) {
    const int rg = lane >> 3, dc = lane & 7;
    const bool b5 = lane & 32, b4 = lane & 16, b3 = lane & 8;
    float r8[8], r4[4], r2[2];
#pragma unroll
    for (int i = 0; i < 8; ++i) { const float snd = b5 ? y[i] : y[i + 8]; const float kp = b5 ? y[i + 8] : y[i]; r8[i] = kp + __shfl_xor(snd, 32); }
#pragma unroll
    for (int i = 0; i < 4; ++i) { const float snd = b4 ? r8[i] : r8[i + 4]; const float kp = b4 ? r8[i + 4] : r8[i]; r4[i] = kp + __shfl_xor(snd, 16); }
#pragma unroll
    for (int i = 0; i < 2; ++i) { const float snd = b3 ? r4[i] : r4[i + 2]; const float kp = b3 ? r4[i + 2] : r4[i]; r2[i] = kp + __shfl_xor(snd, 8); }
    float2 v = q.r;
    v.x += r2[0]; v.y += r2[1];
    if (final_layer) *(float2*)(p.out + (size_t)tok * DM + sl * 128 + 16 * dc + 2 * rg) = v;
    else *(u32*)(WSP(bf16_t, WS_RES) + (size_t)tok * DM + sl * 128 + 16 * dc + 2 * rg) = pack2(v.x, v.y);
}
template <bool UP>
DI void run_peer_sliced(const Params& p, int l, unsigned char* smem) {
    volatile LAS unsigned* st = (volatile LAS unsigned*)(smem + SMEM_BYTES);
    const int nloc = (int)st[0], nx = (int)st[1], rank = (int)st[2], xi = (int)st[3];
    const int tid = otid512(), lane = tid & 63, wave = tid >> 6;
    const int stride = nloc * 8;
#pragma unroll 1
    for (int sl = xi; sl < 8; sl += nx) {
        const unsigned char* tab = p.ws + (UP ? WS_UP : WS_DOWN) + (size_t)l * NEXP * DM + (size_t)sl * NEXP * 128;
        int tok = rank * 8 + wave;
        if (tok >= NTOK) continue;
        PeerPre qc = peer_prefetch<UP>(p, tok, sl, lane);
        PeerRows R;
        peer_issue_rows<0, UP>(p, tab, qc, tok, lane, R);
#pragma unroll 1
        for (; tok < NTOK; tok += stride) {
            const int tn = tok + stride < NTOK ? tok + stride : tok;
            const PeerPre qn = peer_prefetch<UP>(p, tn, sl, lane);
            float acc[16];
#pragma unroll
            for (int i = 0; i < 16; ++i) acc[i] = 0.f;
            PeerRows Rn;
            peer_issue_rows<1, UP>(p, tab, qc, tok, lane, Rn);
            __builtin_amdgcn_sched_barrier(0);
            if (UP) peer_up_half<0>(qc, R, acc); else peer_down_half<0>(qc, R, acc);
            __builtin_amdgcn_sched_barrier(0);
            peer_issue_rows<0, UP>(p, tab, qn, tn, lane, R);
            __builtin_amdgcn_sched_barrier(0);
            if (UP) { peer_up_half<1>(qc, Rn, acc); peer_up_fin(p, qc, acc, tok, sl, lane, l == 1); }
            else { peer_down_half<1>(qc, Rn, acc); peer_down_fin(p, acc, tok, sl, lane); }
            __builtin_amdgcn_sched_barrier(0);
            qc = qn;
        }
    }
}


typedef short bf16x8 __attribute__((ext_vector_type(8)));
typedef float f32x16 __attribute__((ext_vector_type(16)));
#define MFMA32(a, b, c) __builtin_amdgcn_mfma_f32_32x32x16_bf16((a), (b), (c), 0, 0, 0)
typedef short s16x4 __attribute__((ext_vector_type(4)));
DI bf16x8 pack_p(const f32x16& pt, int s) {
    uint4 o;
    o.x = pack2(pt[8 * s + 0], pt[8 * s + 1]); o.y = pack2(pt[8 * s + 2], pt[8 * s + 3]);
    o.z = pack2(pt[8 * s + 4], pt[8 * s + 5]); o.w = pack2(pt[8 * s + 6], pt[8 * s + 7]);
    return __builtin_bit_cast(bf16x8, o);
}

DI void stage_tile(const bf16_t* __restrict__ g, int ld, int row0, int k0, unsigned char* lt, int wave, int lane) {
#pragma unroll
    for (int i = 0; i < 4; ++i) {
        const int inst = wave * 4 + i;
        const int row = inst * 8 + (lane >> 3);
        const int c = (lane & 7) ^ ((row >> 1) & 7);
        __builtin_amdgcn_global_load_lds((const unsigned*)(g + (size_t)(row0 + row) * ld + k0 + c * 8),
                                         (unsigned*)(lt + inst * 1024 + lane * 16), 16, 0, 0);
    }
}
DI bf16x8 lds_frag(const unsigned char* lt, int row, int c) {
    return *(const bf16x8*)(lt + row * 128 + ((c ^ ((row >> 1) & 7)) << 4));
}
DI int crow(int r, int fh) { return (r & 3) + 8 * (r >> 2) + 4 * fh; }

namespace pg8 {
#define PG8_LAS __attribute__((address_space(3)))
typedef float f32x4 __attribute__((ext_vector_type(4)));
typedef unsigned u32x4 __attribute__((ext_vector_type(4)));
constexpr int BM = 256, BK = 64, HALF = 128, HTB = HALF * BK * 2  , STAGE_BYTES = 8 * HTB;
__host__ __device__ __forceinline__ int lds_byte(int r, int c) { const int st = (r >> 4) * 2 + (c >> 5), rr = r & 15, cc = c & 31, ob = rr * 64 + cc * 2; return st * 1024 + (ob ^ (((ob >> 9) & 1) << 5)); }
__host__ __device__ __forceinline__ void stage_rc(int b, int& R, int& C) { const int st = b / 1024, sb = b % 1024, swz = sb ^ (((sb >> 9) & 1) << 5); R = (st >> 1) * 16 + swz / 64; C = (st & 1) * 32 + (swz % 64) / 2; }
__host__ __device__ __forceinline__ int perm32(int rho) { const int n = rho >> 4, i = rho & 15; return 8 * (i >> 2) + 4 * n + (i & 3); }
struct Unit { int pm, pn; };
struct Gemm { const void* A; const void* Bt; int M, N, K; const float* rsc; const float* csc; };
struct XcdOrder {
    int ntn, nloc, nx, rank, xi, nown, total;
    __device__ __forceinline__ void init(int nmt, int ntn_, int nloc_, int nx_, int rank_, int xi_) {
        ntn = ntn_; nloc = nloc_; nx = nx_; rank = rank_; xi = xi_; nown = xi < nmt ? (nmt - xi + nx - 1) / nx : 0; total = nown * ntn; }
    __device__ __forceinline__ bool next(int i, Unit& u) const {
        const int t = rank + i * nloc; if (t >= total) return false;
        const int g4 = t / (4 * ntn), r = t - g4 * 4 * ntn;
        const int left = nown - 4 * g4, gs = left < 4 ? left : 4;
        const int nt = r / gs, mi = r - nt * gs;
        u.pm = (4 * g4 + mi) * nx + xi; u.pn = nt; return true;
    }
    __device__ __forceinline__ void a_ready(const Unit&) const {}
    __device__ __forceinline__ void done(const Unit&) const {}
};
typedef int i32x4 __attribute__((ext_vector_type(4)));
template <class Epi, class Sched, bool ALIGN_EPI = false, bool SP2 = false, bool I8 = false>
__device__ __forceinline__ void gemm_phase(PG8_LAS unsigned char* lds, const Gemm g, const Sched& S, const Epi& E) {
    const int tid = otid512(), wid = __builtin_amdgcn_readfirstlane(tid >> 6), lane = tid & 63, wr = wid >> 2, wc = wid & 3, fr = lane & 15, fq = lane >> 4;
    const int K = g.K, KB = I8 ? K : 2 * K  , nt = KB / (BK * 2);
    unsigned voffA[2], voffB[2];
#pragma unroll
    for (int i = 0; i < 2; ++i) { int R, C; stage_rc(tid * 16 + i * 8192, R, C); const int Rb = Epi::PERM ? ((R & ~31) + perm32(R & 31)) : R;
        voffA[i] = (unsigned)(R * KB + C * 2); voffB[i] = (unsigned)(Rb * KB + C * 2); }
    const size_t kstep = (size_t)(BK * 2);
    const size_t hstep = (size_t)HALF * KB;
    const size_t tstep = 2 * hstep;
    const unsigned ldsw = (unsigned)wid * 1024u;
    const int aoff = lds_byte(wr * 64 + fr, fq * 8), boff = lds_byte(wc * 32 + fr, fq * 8);
#define PG8_SA(b, h) (((b) * 2 + (h)) * HTB)
#define PG8_SB(b, h) ((4 + (b) * 2 + (h)) * HTB)
#define PG8_STAGE(bufoff, gbase, voff) do { _Pragma("unroll") for (int _i = 0; _i < 2; ++_i) \
        __builtin_amdgcn_global_load_lds((const unsigned*)((const char*)(gbase) + (voff)[_i]), (PG8_LAS unsigned*)(lds + (bufoff) + ldsw + _i * 8192), 16, 0, 0); } while (0)
#define PG8_LDA(dst, b, h) do { _Pragma("unroll") for (int m = 0; m < 4; ++m) _Pragma("unroll") for (int k = 0; k < 2; ++k) dst[m][k] = *(const PG8_LAS bf16x8*)(lds + PG8_SA(b, h) + aoff + m * 2048 + k * 1024); } while (0)
#define PG8_LDB(dst, b, h) do { _Pragma("unroll") for (int n = 0; n < 2; ++n) _Pragma("unroll") for (int k = 0; k < 2; ++k) dst[n][k] = *(const PG8_LAS bf16x8*)(lds + PG8_SB(b, h) + boff + n * 2048 + k * 1024); } while (0)
#define PG8_MMA(ai, bj, At, Bt) do { __builtin_amdgcn_s_setprio(1); _Pragma("unroll") for (int m = 0; m < 4; ++m) _Pragma("unroll") for (int n = 0; n < 2; ++n) _Pragma("unroll") for (int k = 0; k < 2; ++k) \
        { if constexpr (I8) acc[ai][bj][m][n] = __builtin_bit_cast(f32x4, __builtin_amdgcn_mfma_i32_16x16x64_i8(__builtin_bit_cast(i32x4, Bt[n][k]), __builtin_bit_cast(i32x4, At[m][k]), __builtin_bit_cast(i32x4, acc[ai][bj][m][n]), 0, 0, 0)); \
          else acc[ai][bj][m][n] = __builtin_amdgcn_mfma_f32_16x16x32_bf16(Bt[n][k], At[m][k], acc[ai][bj][m][n], 0, 0, 0); } __builtin_amdgcn_s_setprio(0); } while (0)
#define PG8_WAIT_V(n) asm volatile("s_waitcnt vmcnt(" #n ")" ::: "memory")
#define PG8_WAIT_L(n) asm volatile("s_waitcnt lgkmcnt(" #n ")" ::: "memory")
#define PG8_BAR __builtin_amdgcn_s_barrier()
#define PG8_SCHED __builtin_amdgcn_sched_barrier(0)
    Unit cur, nxt; int ui = 0;
    if (!S.next(0, cur)) return;
    f32x4 acc[2][2][4][2];
#pragma unroll
    for (int a = 0; a < 2; ++a)
#pragma unroll
        for (int b = 0; b < 2; ++b)
#pragma unroll
            for (int m = 0; m < 4; ++m)
#pragma unroll
                for (int n = 0; n < 2; ++n) acc[a][b][m][n] = (f32x4){0.f, 0.f, 0.f, 0.f};
    bf16x8 At[4][2], B0[2][2], B1[2][2];
    const char* cA = (const char*)g.A + (size_t)cur.pm * tstep; const char* cB = (const char*)g.Bt + (size_t)cur.pn * tstep;
    S.a_ready(cur);
    if constexpr (SP2) {
        PG8_STAGE(PG8_SB(0, 0), cB, voffB); PG8_STAGE(PG8_SB(0, 1), cB + hstep, voffB); PG8_STAGE(PG8_SA(0, 0), cA, voffA); PG8_STAGE(PG8_SA(0, 1), cA + hstep, voffA);
        if (wr == 1) PG8_BAR;
        PG8_WAIT_V(2); PG8_BAR;
        PG8_STAGE(PG8_SB(1, 0), cB + kstep, voffB); PG8_STAGE(PG8_SA(1, 0), cA + kstep, voffA); PG8_STAGE(PG8_SB(1, 1), cB + hstep + kstep, voffB);
        PG8_WAIT_V(6); PG8_BAR;
    } else {
        PG8_STAGE(PG8_SB(0, 0), cB, voffB); PG8_STAGE(PG8_SA(0, 0), cA, voffA); PG8_STAGE(PG8_SB(0, 1), cB + hstep, voffB); PG8_STAGE(PG8_SA(0, 1), cA + hstep, voffA);
        if (wr == 1) PG8_BAR;
        PG8_WAIT_V(4); PG8_BAR;
        PG8_STAGE(PG8_SB(1, 0), cB + kstep, voffB); PG8_STAGE(PG8_SA(1, 0), cA + kstep, voffA); PG8_STAGE(PG8_SB(1, 1), cB + hstep + kstep, voffB);
        PG8_WAIT_V(6); PG8_BAR;
    }
    for (;;) {
        const bool has_next = S.next(ui + 1, nxt);
        const char* nA = has_next ? (const char*)g.A + (size_t)nxt.pm * tstep : cA; const char* nB = has_next ? (const char*)g.Bt + (size_t)nxt.pn * tstep : cB;
        for (int t = 0; t < nt; t += 2) {
            const bool last = (t == nt - 2);
            const char* a1 = cA + (size_t)(t + 1) * kstep;
            const char* a2 = last ? nA : cA + (size_t)(t + 2) * kstep; const char* b2 = last ? nB : cB + (size_t)(t + 2) * kstep;
            const char* a3 = a2 + kstep; const char* b3 = b2 + kstep;
            if (last && has_next) S.a_ready(nxt);
            if constexpr (SP2) {
            PG8_LDB(B0, 0, 0); PG8_LDB(B1, 0, 1); PG8_SCHED; PG8_LDA(At, 0, 0); PG8_STAGE(PG8_SA(1, 1), a1 + hstep, voffA);
            PG8_WAIT_V(8); PG8_WAIT_L(0); PG8_BAR; PG8_MMA(0, 0, At, B0); PG8_MMA(0, 1, At, B1); PG8_BAR; PG8_SCHED;
            PG8_LDA(At, 0, 1); PG8_STAGE(PG8_SB(0, 0), b2, voffB); PG8_STAGE(PG8_SB(0, 1), b2 + hstep, voffB); PG8_STAGE(PG8_SA(0, 0), a2, voffA);
            PG8_WAIT_V(8); PG8_WAIT_L(0); PG8_BAR; PG8_MMA(1, 0, At, B0); PG8_MMA(1, 1, At, B1); PG8_BAR; PG8_SCHED;
            PG8_LDB(B0, 1, 0); PG8_LDB(B1, 1, 1); PG8_SCHED; PG8_LDA(At, 1, 0); PG8_STAGE(PG8_SA(0, 1), a2 + hstep, voffA);
            PG8_WAIT_V(8); PG8_WAIT_L(0); PG8_BAR; PG8_MMA(0, 0, At, B0); PG8_MMA(0, 1, At, B1); PG8_BAR; PG8_SCHED;
            PG8_LDA(At, 1, 1); PG8_STAGE(PG8_SB(1, 0), b3, voffB); PG8_STAGE(PG8_SB(1, 1), b3 + hstep, voffB); PG8_STAGE(PG8_SA(1, 0), a3, voffA);
            PG8_WAIT_V(8); PG8_WAIT_L(0); PG8_BAR; PG8_MMA(1, 0, At, B0); PG8_MMA(1, 1, At, B1); PG8_BAR; PG8_SCHED;
            } else {
            PG8_LDB(B0, 0, 0); PG8_SCHED; PG8_LDA(At, 0, 0); PG8_STAGE(PG8_SA(1, 1), a1 + hstep, voffA);
            PG8_WAIT_L(8); PG8_BAR; PG8_WAIT_L(0); PG8_MMA(0, 0, At, B0); PG8_BAR; PG8_SCHED;
            PG8_LDB(B1, 0, 1); PG8_STAGE(PG8_SB(0, 0), b2, voffB);
            PG8_BAR; PG8_WAIT_L(0); PG8_MMA(0, 1, At, B1); PG8_BAR;
            PG8_LDA(At, 0, 1); PG8_STAGE(PG8_SA(0, 0), a2, voffA);
            PG8_BAR; PG8_WAIT_L(0); PG8_MMA(1, 0, At, B0); PG8_BAR; PG8_SCHED;
            PG8_STAGE(PG8_SB(0, 1), b2 + hstep, voffB);
            PG8_WAIT_V(6); PG8_BAR; PG8_MMA(1, 1, At, B1); PG8_BAR;
            PG8_LDB(B0, 1, 0); PG8_SCHED; PG8_LDA(At, 1, 0); PG8_STAGE(PG8_SA(0, 1), a2 + hstep, voffA);
            PG8_WAIT_L(8); PG8_BAR; PG8_WAIT_L(0); PG8_MMA(0, 0, At, B0); PG8_BAR; PG8_SCHED;
            PG8_LDB(B1, 1, 1); PG8_STAGE(PG8_SB(1, 0), b3, voffB);
            PG8_BAR; PG8_WAIT_L(0); PG8_MMA(0, 1, At, B1); PG8_BAR;
            PG8_LDA(At, 1, 1); PG8_STAGE(PG8_SA(1, 0), a3, voffA);
            PG8_BAR; PG8_WAIT_L(0); PG8_MMA(1, 0, At, B0); PG8_BAR; PG8_SCHED;
            PG8_STAGE(PG8_SB(1, 1), b3 + hstep, voffB);
            PG8_WAIT_V(6); PG8_BAR; PG8_MMA(1, 1, At, B1); PG8_BAR;
            }
        }
        if constexpr (ALIGN_EPI) { if (wr == 0) PG8_BAR; }
        if constexpr (I8) {
#pragma unroll
            for (int b = 0; b < 2; ++b) {
                const float* cp = g.csc + cur.pn * BM + b * HALF + wc * 32 + 8 * fq;
                const f32x4 c0 = *(const f32x4*)cp, c1 = *(const f32x4*)(cp + 4);
#pragma unroll
                for (int a = 0; a < 2; ++a)
#pragma unroll
                    for (int m = 0; m < 4; ++m) {
                        const float xs = g.rsc[cur.pm * BM + a * HALF + wr * 64 + m * 16 + fr];
                        acc[a][b][m][0] = __builtin_convertvector(__builtin_bit_cast(i32x4, acc[a][b][m][0]), f32x4) * c0 * xs;
                        acc[a][b][m][1] = __builtin_convertvector(__builtin_bit_cast(i32x4, acc[a][b][m][1]), f32x4) * c1 * xs;
                    }
            }
        }
        if constexpr (!Epi::AFTER_DRAIN) { E(acc, cur, wr, wc, fr, fq); S.done(cur); }
        if (!has_next) break;
#pragma unroll
        for (int a = 0; a < 2; ++a)
#pragma unroll
            for (int b = 0; b < 2; ++b)
#pragma unroll
                for (int m = 0; m < 4; ++m)
#pragma unroll
                    for (int n = 0; n < 2; ++n) acc[a][b][m][n] = (f32x4){0.f, 0.f, 0.f, 0.f};
        cur = nxt; cA = nA; cB = nB; ++ui;
        if constexpr (ALIGN_EPI) { if (wr == 1) PG8_BAR; }
    }
    PG8_WAIT_V(0);
    if constexpr (!ALIGN_EPI) { if (wr == 0) PG8_BAR; }
    PG8_BAR;
    if constexpr (Epi::AFTER_DRAIN) { E.fused(acc, cur, wr, wc, fr, fq, lds, wid, lane); S.done(cur); }
#undef PG8_SA
#undef PG8_SB
#undef PG8_STAGE
#undef PG8_LDA
#undef PG8_LDB
#undef PG8_MMA
#undef PG8_WAIT_V
#undef PG8_WAIT_L
#undef PG8_BAR
#undef PG8_SCHED
}
template <bool RES_BF16>
struct EpiResid {
    static constexpr bool PERM = true, AFTER_DRAIN = false;
    const void* resid; bf16_t* out;
    __device__ __forceinline__ void operator()(const f32x4 (&acc)[2][2][4][2], const Unit& u, int wr, int wc, int fr, int fq) const {
        const size_t base = (size_t)(u.pm * BM + wr * 64 + fr) * DM + u.pn * BM + wc * 32 + 8 * fq;
#pragma unroll
        for (int ai = 0; ai < 2; ++ai) {
            f32x4 rv[4][2][2];
#pragma unroll
            for (int m = 0; m < 4; ++m)
#pragma unroll
                for (int bj = 0; bj < 2; ++bj) {
                    const size_t o = base + (size_t)(ai * HALF + m * 16) * DM + bj * HALF;
                    if constexpr (RES_BF16) {
                        const u32x4 w = *(const u32x4*)((const bf16_t*)resid + o);
                        rv[m][bj][0] = (f32x4){__uint_as_float(w.x << 16), __uint_as_float(w.x & 0xffff0000u), __uint_as_float(w.y << 16), __uint_as_float(w.y & 0xffff0000u)};
                        rv[m][bj][1] = (f32x4){__uint_as_float(w.z << 16), __uint_as_float(w.z & 0xffff0000u), __uint_as_float(w.w << 16), __uint_as_float(w.w & 0xffff0000u)};
                    } else { const float* rp = (const float*)resid + o; rv[m][bj][0] = *(const f32x4*)rp; rv[m][bj][1] = *(const f32x4*)(rp + 4); }
                }
            asm volatile("" ::: "memory");
#pragma unroll
            for (int m = 0; m < 4; ++m)
#pragma unroll
                for (int bj = 0; bj < 2; ++bj) {
                    const f32x4 a = rv[m][bj][0] + acc[ai][bj][m][0], b = rv[m][bj][1] + acc[ai][bj][m][1];
                    u32x4 w; w.x = pack2(a[0], a[1]); w.y = pack2(a[2], a[3]); w.z = pack2(b[0], b[1]); w.w = pack2(b[2], b[3]);
                    *(u32x4*)(out + base + (size_t)(ai * HALF + m * 16) * DM + bj * HALF) = w;
                }
            asm volatile("" ::: "memory");
        }
    }
};
struct EpiProj {
    static constexpr bool PERM = true, AFTER_DRAIN = false;
    const float* aq; const float* ak; const float* bq; const float* bk; bf16_t* proj; PG8_LAS float* xs;
    __device__ __forceinline__ void operator()(const f32x4 (&acc)[2][2][4][2], const Unit& u, int wr, int wc, int fr, int fq) const {
        const int wave = wr * 4 + wc;
#pragma unroll
        for (int ai = 0; ai < 2; ++ai)
#pragma unroll
            for (int m = 0; m < 4; ++m)
#pragma unroll
                for (int bj = 0; bj < 2; ++bj) {
                    const f32x4 a = acc[ai][bj][m][0], b = acc[ai][bj][m][1];
                    float t = a[0] * a[0] + a[1] * a[1] + a[2] * a[2] + a[3] * a[3] + b[0] * b[0] + b[1] * b[1] + b[2] * b[2] + b[3] * b[3];
                    t += __shfl_xor(t, 16); t += __shfl_xor(t, 32);
                    if (fq == 0) xs[wave * 256 + ((ai * 4 + m) * 2 + bj) * 16 + fr] = t;
                }
        asm volatile("s_waitcnt lgkmcnt(0)" ::: "memory");
        __builtin_amdgcn_s_barrier();
#pragma unroll
        for (int bj = 0; bj < 2; ++bj) {
            const int gcol = u.pn * BM + bj * HALF + wc * 32 + 8 * fq;
            const float* gain = nullptr; float scale = 1.f;
            if (gcol < 512) { gain = aq + (gcol & 63); scale = 0.125f; }
            else if (gcol < 1024) gain = ak + (gcol & 63);
            else if (gcol < 1536) gain = nullptr;
            else if (gcol < 2048) { gain = bq + (gcol & 127); scale = 0.125f; }
            else if (gcol < 2560) gain = bk + (gcol & 127);
            f32x4 g0 = {1.f, 1.f, 1.f, 1.f}, g1 = {1.f, 1.f, 1.f, 1.f};
            if (gain) { g0 = *(const f32x4*)gain; g1 = *(const f32x4*)(gain + 4); }
#pragma unroll
            for (int ai = 0; ai < 2; ++ai)
#pragma unroll
                for (int m = 0; m < 4; ++m) {
                    float sc = 1.f;
                    if (gain) {
                        const int slot = ((ai * 4 + m) * 2 + bj) * 16 + fr;
                        sc = rsqrtf((xs[wave * 256 + slot] + xs[(wave ^ 1) * 256 + slot]) * (1.f / 64.f) + EPSN) * scale;
                    }
                    const f32x4 v0 = acc[ai][bj][m][0] * g0 * sc, v1 = acc[ai][bj][m][1] * g1 * sc;
                    u32x4 w; w.x = pack2(v0[0], v0[1]); w.y = pack2(v0[2], v0[3]); w.z = pack2(v1[0], v1[1]); w.w = pack2(v1[2], v1[3]);
                    *(u32x4*)(proj + (size_t)(u.pm * BM + ai * HALF + wr * 64 + m * 16 + fr) * ATT_IN + gcol) = w;
                }
        }
    }
};
struct EpiSgu {
    static constexpr bool PERM = true, AFTER_DRAIN = false;
    bf16_t* zu; bf16_t* zvt; float* ssq; PG8_LAS unsigned char* stg;
    __device__ __forceinline__ void operator()(const f32x4 (&acc)[2][2][4][2], const Unit& u, int wr, int wc, int fr, int fq) const {
        const int wave = wr * 4 + wc, lane = fq * 16 + fr;
        PG8_LAS unsigned short* tl = (PG8_LAS unsigned short*)(stg + wave * 2048);
#pragma unroll
        for (int ai = 0; ai < 2; ++ai)
#pragma unroll
            for (int bj = 0; bj < 2; ++bj) {
                const int gcol = u.pn * BM + bj * HALF + wc * 32 + 8 * fq;
                f32x4 g0[4], g1[4];
#pragma unroll
                for (int m = 0; m < 4; ++m) {
                    const f32x4 a = acc[ai][bj][m][0], b = acc[ai][bj][m][1];
                    g0[m] = (f32x4){gelu_tanh(a[0]), gelu_tanh(a[1]), gelu_tanh(a[2]), gelu_tanh(a[3])};
                    g1[m] = (f32x4){gelu_tanh(b[0]), gelu_tanh(b[1]), gelu_tanh(b[2]), gelu_tanh(b[3])};
                }
                if (gcol < CW) {
#pragma unroll
                    for (int m = 0; m < 4; ++m) {
                        u32x4 w; w.x = pack2(g0[m][0], g0[m][1]); w.y = pack2(g0[m][2], g0[m][3]); w.z = pack2(g1[m][0], g1[m][1]); w.w = pack2(g1[m][2], g1[m][3]);
                        *(u32x4*)(zu + (size_t)(u.pm * BM + ai * HALF + wr * 64 + m * 16 + fr) * CW + gcol) = w;
                    }
                } else {
                    const int vcol = gcol - CW;
#pragma unroll
                    for (int m = 0; m < 4; ++m) {
                        float t = g0[m][0] * g0[m][0] + g0[m][1] * g0[m][1] + g0[m][2] * g0[m][2] + g0[m][3] * g0[m][3]
                                + g1[m][0] * g1[m][0] + g1[m][1] * g1[m][1] + g1[m][2] * g1[m][2] + g1[m][3] * g1[m][3];
                        t += __shfl_xor(t, 16); t += __shfl_xor(t, 32);
                        if (fq == 0) ssq[(size_t)(u.pm * BM + ai * HALF + wr * 64 + m * 16 + fr) * 64 + (vcol >> 5)] = t;
                    }
#pragma unroll
                    for (int h = 0; h < 2; ++h) {
#pragma unroll
                        for (int mm = 0; mm < 2; ++mm) {
                            const int m = 2 * h + mm, rl = 16 * mm + fr;
#pragma unroll
                            for (int j = 0; j < 4; ++j) { tl[(8 * fq + j) * 32 + rl] = f2bf(g0[m][j]); tl[(8 * fq + 4 + j) * 32 + rl] = f2bf(g1[m][j]); }
                        }
                        const int c = lane >> 1, hh = lane & 1;
                        const u32x4 w0 = *(const PG8_LAS u32x4*)(tl + c * 32 + hh * 16), w1 = *(const PG8_LAS u32x4*)(tl + c * 32 + hh * 16 + 8);
                        bf16_t* dst = zvt + ((size_t)(2 * u.pm + ai) * CW + (u.pn * BM - CW) + bj * HALF + wc * 32 + c) * 128 + wr * 64 + 32 * h + hh * 16;
                        *(u32x4*)dst = w0; *(u32x4*)(dst + 8) = w1;
                        asm volatile("" ::: "memory");
                    }
                }
            }
    }
};
struct EpiQ {
    static constexpr bool PERM = true, AFTER_DRAIN = false;
    bf16_t* q;
    __device__ __forceinline__ void operator()(const f32x4 (&acc)[2][2][4][2], const Unit& u, int wr, int wc, int fr, int fq) const {
#pragma unroll
        for (int ai = 0; ai < 2; ++ai)
#pragma unroll
            for (int m = 0; m < 4; ++m)
#pragma unroll
                for (int bj = 0; bj < 2; ++bj) {
                    const f32x4 a = acc[ai][bj][m][0], b = acc[ai][bj][m][1];
                    u32x4 w; w.x = pack2(a[0], a[1]); w.y = pack2(a[2], a[3]); w.z = pack2(b[0], b[1]); w.w = pack2(b[2], b[3]);
                    *(u32x4*)(q + (size_t)(u.pm * BM + ai * HALF + wr * 64 + m * 16 + fr) * 2048 + u.pn * BM + bj * HALF + wc * 32 + 8 * fq) = w;
                }
    }
};
}
DI void run_gemmq_pg8(const Params& p, int l, unsigned char* smem) {
    volatile LAS unsigned* st = (volatile LAS unsigned*)(smem + SMEM_BYTES);
    pg8::XcdOrder S; S.init(NTOK / 256, 2048 / 256, (int)st[0], (int)st[1], (int)st[2], (int)st[3]);
    const pg8::Gemm g{WSP(signed char, WS_XQ), WSP(signed char, WS_W_PQ) + (size_t)l * 2048 * DM, NTOK, 2048, DM, WSP(float, WS_XSC), WSP(float, WS_WQS) + l * 2048};
    pg8::EpiQ E; E.q = WSP(bf16_t, WS_QBUF);
    __syncthreads();
    pg8::gemm_phase<pg8::EpiQ, pg8::XcdOrder, true, true, true>((PG8_LAS unsigned char*)smem, g, S, E);
}
template <int WHICH>
DI void run_gemm_pg8(const Params& p, unsigned char* smem) {
    volatile LAS unsigned* st = (volatile LAS unsigned*)(smem + SMEM_BYTES);
    pg8::XcdOrder S; S.init(NTOK / 256, DM / 256, (int)st[0], (int)st[1], (int)st[2], (int)st[3]);
    pg8::Gemm g;
    pg8::EpiResid<WHICH == 1> E; E.out = WSP(bf16_t, WS_RES);
    if (WHICH == 0) { g = pg8::Gemm{WSP(bf16_t, WS_MIXED), WSP(bf16_t, WS_W_ATTOUT), NTOK, DM, DM, nullptr, nullptr}; E.resid = p.in[0]; }
    else { g = pg8::Gemm{WSP(bf16_t, WS_Z_U), WSP(bf16_t, WS_W_SGUOUT), NTOK, DM, CW, nullptr, nullptr}; E.resid = WSP(bf16_t, WS_RES); }
    __syncthreads();
    pg8::gemm_phase<pg8::EpiResid<WHICH == 1>, pg8::XcdOrder, true, true>((PG8_LAS unsigned char*)smem, g, S, E);
}

DI void run_gemm1_pg8(const Params& p, unsigned char* smem) {
    volatile LAS unsigned* st = (volatile LAS unsigned*)(smem + SMEM_BYTES);
    pg8::XcdOrder S; S.init(NTOK / 256, ATT_IN / 256, (int)st[0], (int)st[1], (int)st[2], (int)st[3]);
    const pg8::Gemm g{WSP(signed char, WS_XQ), WSP(signed char, WS_W_ATTIN), NTOK, ATT_IN, DM, WSP(float, WS_XSC), WSP(float, WS_WAS)};
    pg8::EpiProj E; E.aq = p.in[3]; E.ak = p.in[4]; E.bq = p.in[5]; E.bk = p.in[6]; E.proj = WSP(bf16_t, WS_PROJ); E.xs = (PG8_LAS float*)(smem + PG8_EXTRA);
    __syncthreads();
    pg8::gemm_phase<pg8::EpiProj, pg8::XcdOrder, true, true, true>((PG8_LAS unsigned char*)smem, g, S, E);
}
DI void run_gemm4_pg8(const Params& p, unsigned char* smem) {
    volatile LAS unsigned* st = (volatile LAS unsigned*)(smem + SMEM_BYTES);
    pg8::XcdOrder S; S.init(NTOK / 256, 4096 / 256, (int)st[0], (int)st[1], (int)st[2], (int)st[3]);
    const pg8::Gemm g{WSP(signed char, WS_XQ), WSP(signed char, WS_W_SGUIN), NTOK, 4096, DM, WSP(float, WS_XSC), WSP(float, WS_WSS)};
    pg8::EpiSgu E; E.zu = WSP(bf16_t, WS_Z_U); E.zvt = WSP(bf16_t, WS_Z_VT); E.ssq = WSP(float, WS_SSQ); E.stg = (PG8_LAS unsigned char*)(smem + PG8_EXTRA);
    __syncthreads();
    pg8::gemm_phase<pg8::EpiSgu, pg8::XcdOrder, true, true, true>((PG8_LAS unsigned char*)smem, g, S, E);
}

DI u32 cand_key(float s, int ci) { return (f2ord(s) & ~255u) | (u32)(255 - ci); }
template <int P>
DI void score_half(const bf16x8 (&qf)[8], const unsigned char* skl, int fr, int fh, u32 (&lst)[16]) {
#pragma unroll
    for (int j = 0; j < 16; ++j) lst[j] = 0u;
#pragma unroll 1
    for (int kt = 0; kt < 4; ++kt) {
        f32x16 st;
#pragma unroll
        for (int r = 0; r < 16; ++r) st[r] = 0.f;
        const int row = P * 128 + kt * 32 + fr;
        const unsigned char* skr = skl + row * 256;
#pragma unroll
        for (int ks = 0; ks < 8; ++ks) st = MFMA32(*(const bf16x8*)(skr + (((2 * ks + fh) ^ (row & 15)) << 4)), qf[ks], st);
        u32 ks_[16];
#pragma unroll
        for (int r = 0; r < 16; ++r) ks_[r] = (f2ord(st[r]) & ~127u) | (u32)(127 - (kt * 32 + crow(r, fh)));
        sort16_desc(ks_);
        if (kt == 0) {
#pragma unroll
            for (int j = 0; j < 16; ++j) lst[j] = ks_[j];
        } else merge16_desc(lst, ks_);
    }
    u32 other[16];
#pragma unroll
    for (int j = 0; j < 16; ++j) other[j] = (u32)__shfl_xor((int)lst[j], 32);
    merge16_desc(lst, other);
}
DI void run_score(const Params& p, int l, unsigned char* smem) {
    const int tid = otid512(), wave = tid >> 6, lane = tid & 63, fr = lane & 31, fh = lane >> 5;
    int cur_h = -1;
    bf16x8 qa[8], qb[8];
    if ((int)blockIdx.x < 8 * (NTOK / 256)) {
        const int it0 = blockIdx.x;
        const bf16_t* q0 = WSP(bf16_t, WS_QBUF) + (size_t)((it0 >> 3) * 256 + wave * 32 + fr) * 2048 + (it0 & 7) * 256 + 8 * fh;
#pragma unroll
        for (int ks = 0; ks < 8; ++ks) { qa[ks] = *(const bf16x8*)(q0 + 16 * ks); qb[ks] = *(const bf16x8*)(q0 + 128 + 16 * ks); }
    }
#pragma unroll 1
    for (int it = blockIdx.x; it < 8 * (NTOK / 256); it += gridDim.x) {
    const int h = it & 7, oct = it >> 3;
    if (h != cur_h) {
        __syncthreads();
        const bf16_t* skg = WSP(bf16_t, WS_W_SUBK) + ((size_t)l * 16 + h * 2) * 128 * 128;
#pragma unroll
        for (int i = 0; i < 8; ++i) {
            const int idx = wave * 8 + i;
            const int row = 4 * idx + (lane >> 4), cp = lane & 15;
            __builtin_amdgcn_global_load_lds((const unsigned*)(skg + (size_t)row * 128 + ((cp ^ (row & 15)) << 3)), (unsigned*)(smem + idx * 1024 + lane * 16), 16, 0, 0);
        }
        asm volatile("s_waitcnt vmcnt(0)" ::: "memory");
        __syncthreads();
        cur_h = h;
    }
    const int tok = oct * 256 + wave * 32 + fr;
    const unsigned char* skh = smem;
    u32 L0[16], L1[16];
    score_half<0>(qa, skh, fr, fh, L0);
    score_half<1>(qb, skh, fr, fh, L1);
    {
        const int itn = it + gridDim.x < 8 * (NTOK / 256) ? it + gridDim.x : it;
        const bf16_t* qn = WSP(bf16_t, WS_QBUF) + (size_t)((itn >> 3) * 256 + wave * 32 + fr) * 2048 + (itn & 7) * 256 + 8 * fh;
#pragma unroll
        for (int ks = 0; ks < 8; ++ks) { qa[ks] = *(const bf16x8*)(qn + 16 * ks); qb[ks] = *(const bf16x8*)(qn + 128 + 16 * ks); }
    }
    LAS int* slot = (LAS int*)(smem + 65536 + wave * (64 * 132)) + lane * 33;
    float s1[16], s2[16];
#pragma unroll
    for (int j = 0; j < 16; ++j) {
        s1[j] = ord2f(L0[j] & ~127u); s2[j] = ord2f(L1[j] & ~127u);
        slot[j] = 127 - (int)(L0[j] & 127u); slot[16 + j] = 127 - (int)(L1[j] & 127u);
    }
    u32 lst[16];
#pragma unroll
    for (int j = 0; j < 16; ++j) lst[j] = cand_key(s1[0] + s2[j], j);
#pragma unroll
    for (int i = 1; i < 5; ++i) {
        u32 row[16];
#pragma unroll
        for (int j = 0; j < 16; ++j) row[j] = ((i + 1) * (j + 1) <= 16) ? cand_key(s1[i] + s2[j], i * 16 + j) : 0u;
        merge16_desc(lst, row);
    }
#pragma unroll
    for (int i = 5; i < 16; ++i)
#pragma unroll
        for (int j = 0; j < 2; ++j)
            if ((i + 1) * (j + 1) <= 16) top16_insert(lst, cand_key(s1[i] + s2[j], i * 16 + j));
    float pv[16]; float sum = 0.f;
    const float mx = ord2f(lst[0] & ~255u);
#pragma unroll
    for (int j = 0; j < 16; ++j) { pv[j] = __expf(ord2f(lst[j] & ~255u) - mx); sum += pv[j]; }
    const float inv = 1.f / sum;
    int ev[16];
#pragma unroll
    for (int j = 0; j < 16; ++j) {
        const int ci = 255 - (int)(lst[j] & 255u);
        ev[j] = slot[ci >> 4] * 128 + slot[16 + (ci & 15)];
    }
    if (fh == 0) {
        int4* ro = (int4*)(WSP(int, WS_RIDX) + (size_t)tok * 128 + h * 16);
        float4* go = (float4*)(WSP(float, WS_RG) + (size_t)tok * 128 + h * 16);
#pragma unroll
        for (int q = 0; q < 4; ++q) {
            ro[q] = make_int4(ev[4 * q], ev[4 * q + 1], ev[4 * q + 2], ev[4 * q + 3]);
            go[q] = make_float4(pv[4 * q] * inv, pv[4 * q + 1] * inv, pv[4 * q + 2] * inv, pv[4 * q + 3] * inv);
        }
    }
    }
}


#define OSM_THR 8.0f
DI void osm_update(f32x16& s, unsigned vm, float& m, float& lh, float& alpha) {
    float mx = -1e30f;
#pragma unroll
    for (int r = 0; r < 16; ++r) mx = ((vm >> r) & 1u) ? fmaxf(mx, s[r]) : mx;
    mx = fmaxf(mx, __shfl_xor(mx, 32));
    float mn = m; alpha = 1.f;
    if (!__all(mx <= m + OSM_THR)) { mn = fmaxf(m, mx); alpha = __expf(m - mn); }
    float ls = 0.f;
#pragma unroll
    for (int r = 0; r < 16; ++r) { const float pe = ((vm >> r) & 1u) ? __expf(s[r] - mn) : 0.f; s[r] = pe; ls += pe; }
    lh = lh * alpha + ls; m = mn;
}
DI void osm_update_full(f32x16& s, float& m, float& lh, float& alpha) {
    float mx = s[0];
#pragma unroll
    for (int r = 1; r < 16; ++r) mx = fmaxf(mx, s[r]);
    mx = fmaxf(mx, __shfl_xor(mx, 32));
    float mn = m; alpha = 1.f;
    if (!__all(mx <= m + OSM_THR)) { mn = fmaxf(m, mx); alpha = __expf(m - mn); }
    float ls = 0.f;
#pragma unroll
    for (int r = 0; r < 16; ++r) { const float pe = __expf(s[r] - mn); s[r] = pe; ls += pe; }
    lh = lh * alpha + ls; m = mn;
}
DI void tr_quad(const unsigned (&a)[4], unsigned hi_off, bf16x8 (&f)[4]) {
    s16x4 l0, h0, l1, h1, l2, h2, l3, h3;
    const unsigned b0 = a[0] + hi_off, b1 = a[1] + hi_off, b2 = a[2] + hi_off, b3 = a[3] + hi_off;
    asm volatile("ds_read_b64_tr_b16 %0, %8\n\tds_read_b64_tr_b16 %1, %9\n\tds_read_b64_tr_b16 %2, %10\n\tds_read_b64_tr_b16 %3, %11\n\t"
                 "ds_read_b64_tr_b16 %4, %12\n\tds_read_b64_tr_b16 %5, %13\n\tds_read_b64_tr_b16 %6, %14\n\tds_read_b64_tr_b16 %7, %15\n\ts_waitcnt lgkmcnt(0)"
                 : "=&v"(l0), "=&v"(h0), "=&v"(l1), "=&v"(h1), "=&v"(l2), "=&v"(h2), "=&v"(l3), "=&v"(h3)
                 : "v"(a[0]), "v"(b0), "v"(a[1]), "v"(b1), "v"(a[2]), "v"(b2), "v"(a[3]), "v"(b3) : "memory");
    f[0] = __builtin_shufflevector(l0, h0, 0, 1, 2, 3, 4, 5, 6, 7); f[1] = __builtin_shufflevector(l1, h1, 0, 1, 2, 3, 4, 5, 6, 7);
    f[2] = __builtin_shufflevector(l2, h2, 0, 1, 2, 3, 4, 5, 6, 7); f[3] = __builtin_shufflevector(l3, h3, 0, 1, 2, 3, 4, 5, 6, 7);
}

#define QB_BYTES (128 * 256)
#define KB_BYTES (32 * 256)
template <bool WITH_V>
DI void attnB_stage_kv(const bf16_t* __restrict__ kg  , unsigned char* Kd, unsigned char* Vd, int wave, int lane) {
#pragma unroll
    for (int i = 0; i < 2; ++i) {
        const int idx = wave * 2 + i;
        const int key = 4 * idx + (lane >> 4), cp = lane & 15;
        const bf16_t* g = kg + (size_t)key * ATT_IN;
        __builtin_amdgcn_global_load_lds((const unsigned*)(g + ((cp ^ (key & 15)) << 3)), (unsigned*)(Kd + idx * 1024 + lane * 16), 16, 0, 0);
        if (WITH_V) {
            const int cv = ((((cp >> 2) ^ (key & 3)) << 2) | (cp & 3));
            __builtin_amdgcn_global_load_lds((const unsigned*)(g + 512 + (cv << 3)), (unsigned*)(Vd + idx * 1024 + lane * 16), 16, 0, 0);
        }
    }
}
template <int KOFF, bool FULL>
DI void attnB_map(const unsigned char* Kc, const unsigned char* qlp, int ksw, int qsw, int fh, unsigned vm, unsigned vc, int tq,
                  float& m, float& l, f32x16 (&o)[4]) {
    f32x16 st;
#pragma unroll
    for (int r = 0; r < 16; ++r) st[r] = 0.f;
#pragma unroll
    for (int s = 0; s < 4; ++s) {
        const bf16x8 kf = *(const bf16x8*)(Kc + (((KOFF + 2 * s + fh) ^ ksw) << 4));
        const bf16x8 qf = *(const bf16x8*)(qlp + (((KOFF + 2 * s + fh) ^ qsw) << 4));
        st = MFMA32(kf, qf, st);
    }
    float al;
    if (FULL) osm_update_full(st, m, l, al); else osm_update(st, vm, m, l, al);
    if (!__all(al == 1.f)) {
#pragma unroll
        for (int d = 0; d < 4; ++d)
#pragma unroll
            for (int r = 0; r < 16; ++r) o[d][r] *= al;
    }
#pragma unroll
    for (int s = 0; s < 2; ++s) {
        const bf16x8 pf = pack_p(st, s);
        unsigned va[4]; bf16x8 vf[4];
#pragma unroll
        for (int d = 0; d < 4; ++d) va[d] = vc + s * 16 * 256 + ((d ^ tq) << 6);
        tr_quad(va, 8 * 256, vf);
#pragma unroll
        for (int d = 0; d < 4; ++d) o[d] = MFMA32(vf[d], pf, o[d]);
    }
}
DI void ph_attnB_fast(const Params& p, int item, unsigned char* smem) {
    const bf16_t* proj = WSP(bf16_t, WS_PROJ);
    const int tid = otid(), wave = tid >> 6, lane = tid & 63, fr = lane & 31, fh = lane >> 5;
    const int qt = 15 - (item >> 6), bh = item & 63, b = bh >> 2, h = bh & 3;
    const int q0 = qt * 128;
    const float lam = compute_lam(p, lane);
    const size_t rowbase = (size_t)b * SEQ;
    const int qrow = wave * 32 + fr, qpos = q0 + qrow;
    unsigned char* Ql = smem;
    unsigned char* Kl = smem + QB_BYTES;
    unsigned char* Vl = Kl + 2 * KB_BYTES;
    const bf16_t* kbase = proj + rowbase * ATT_IN + 2048 + h * 128;
    __syncthreads();
#pragma unroll
    for (int i = 0; i < 8; ++i) {
        const int idx = wave * 8 + i;
        const int row = 4 * idx + (lane >> 4), cp = lane & 15;
        __builtin_amdgcn_global_load_lds((const unsigned*)(proj + (rowbase + q0 + row) * ATT_IN + 1536 + h * 128 + ((cp ^ (row & 15)) << 3)),
                                         (unsigned*)(Ql + idx * 1024 + lane * 16), 16, 0, 0);
    }
    attnB_stage_kv<true>(kbase, Kl, Vl, wave, lane);
    const unsigned char* qlp = Ql + qrow * 256;
    const int qsw = qrow & 15, ksw = fr & 15;
    const int nkt = (q0 + 128) / 32;
    const int wlast = q0 + wave * 32 + 31;
    f32x16 o1[4], o2[4];
#pragma unroll
    for (int d = 0; d < 4; ++d)
#pragma unroll
        for (int r = 0; r < 16; ++r) { o1[d][r] = 0.f; o2[d][r] = 0.f; }
    float m1 = -1e30f, m2 = -1e30f, l1 = 0.f, l2 = 0.f;
    const int tq = (lane & 15) >> 2;
    const unsigned vrow = (unsigned)(uintptr_t)Vl + (4 * fh + tq) * 256 + (16 * ((lane >> 4) & 1) + 4 * (lane & 3)) * 2;
    asm volatile("s_waitcnt vmcnt(0)" ::: "memory");
    __syncthreads();
    for (int kt = 0; kt < nkt; ++kt) {
        const int cur = kt & 1;
        if (kt + 1 < nkt) attnB_stage_kv<true>(kbase + (size_t)(kt + 1) * 32 * ATT_IN, Kl + (cur ^ 1) * KB_BYTES, Vl + (cur ^ 1) * KB_BYTES, wave, lane);
        if (kt * 32 <= wlast) {
            const unsigned char* Kc = Kl + cur * KB_BYTES + fr * 256;
            const unsigned vc = vrow + cur * KB_BYTES;
            if (kt * 32 + 31 <= wlast - 31) {
                attnB_map<0, true>(Kc, qlp, ksw, qsw, fh, 0xffffu, vc, tq, m1, l1, o1);
                __builtin_amdgcn_sched_barrier(0);
                attnB_map<8, true>(Kc, qlp, ksw, qsw, fh, 0xffffu, vc, tq, m2, l2, o2);
            } else {
                unsigned vm = 0;
#pragma unroll
                for (int r = 0; r < 16; ++r) vm |= ((kt * 32 + crow(r, fh)) <= qpos) ? (1u << r) : 0u;
                attnB_map<0, false>(Kc, qlp, ksw, qsw, fh, vm, vc, tq, m1, l1, o1);
                __builtin_amdgcn_sched_barrier(0);
                attnB_map<8, false>(Kc, qlp, ksw, qsw, fh, vm, vc, tq, m2, l2, o2);
            }
        }
        asm volatile("s_waitcnt vmcnt(0)" ::: "memory");
        __syncthreads();
    }
    l1 += __shfl_xor(l1, 32); l2 += __shfl_xor(l2, 32);
    const float i1 = 1.f / l1, i2 = lam / l2;
    float ss = 0.f;
#pragma unroll
    for (int d = 0; d < 4; ++d)
#pragma unroll
        for (int r = 0; r < 16; ++r) { const float v = o1[d][r] * i1 - o2[d][r] * i2; o1[d][r] = v; ss += v * v; }
    ss += __shfl_xor(ss, 32);
    const float rinv = rsqrtf(ss * (1.f / 128.f) + EPSN) * 0.8f;
    const float* subg = p.in[11];
    bf16_t* op = WSP(bf16_t, WS_MIXED) + (rowbase + qpos) * DM + 512 + h * 128;
#pragma unroll
    for (int d = 0; d < 4; ++d)
#pragma unroll
        for (int g = 0; g < 4; ++g) {
            const int dim = 32 * d + 8 * g + 4 * fh;
            const float4 gg = *(const float4*)(subg + dim);
            uint2 w;
            w.x = pack2(o1[d][4 * g + 0] * rinv * gg.x, o1[d][4 * g + 1] * rinv * gg.y);
            w.y = pack2(o1[d][4 * g + 2] * rinv * gg.z, o1[d][4 * g + 3] * rinv * gg.w);
            *(uint2*)(op + dim) = w;
        }
}

#define KA_PITCH 128
#define VA_PITCH 192
#define WA_BYTES (32 * KA_PITCH + 32 * VA_PITCH)
template <int MODE>
DI void ph_attnA_fast(const Params& p, int item, unsigned char* smem) {
    const bf16_t* proj = WSP(bf16_t, WS_PROJ);
    const int tid = otid(), wave = tid >> 6, lane = tid & 63, fr = lane & 31, fh = lane >> 5;
    const int c = item & 15, h = (item >> 4) & 7, b = item >> 7;
    const size_t rowbase = (size_t)b * SEQ;
    const int qpos = MODE == 0 ? 128 * c + 32 * wave + fr : 16 * (32 * wave + fr) + c;
    const int pmin = MODE == 0 ? 128 * c + 32 * wave : 512 * wave + c, pmax = pmin + (MODE == 0 ? 31 : 496);
    bf16x8 qf[4];
    {
        const bf16_t* qp = proj + (rowbase + qpos) * ATT_IN + h * 64 + 8 * fh;
#pragma unroll
        for (int s = 0; s < 4; ++s) qf[s] = *(const bf16x8*)(qp + 16 * s);
    }
    f32x16 o[2];
#pragma unroll
    for (int d = 0; d < 2; ++d)
#pragma unroll
        for (int r = 0; r < 16; ++r) o[d][r] = 0.f;
    float m = -1e30f, l = 0.f;
    unsigned char* Kl = smem + wave * WA_BYTES;
    unsigned char* Vl = Kl + 32 * KA_PITCH;
    const unsigned vaddr = (unsigned)(uintptr_t)Vl + (4 * fh + ((lane & 15) >> 2)) * VA_PITCH + (16 * ((lane >> 4) & 1) + 4 * (lane & 3)) * 2;
    const int skey = lane >> 3, sc = lane & 7;
    int br = 0, d = MODE == 0 ? 1 : 16, W = MODE == 0 ? 128 : 2048, cls = MODE == 0 ? 0 : (c & 15);
    int j0 = MODE == 0 ? (pmin < 128 ? 0 : pmin - 128) : 0, jhi = MODE == 0 ? pmax : ((pmax - cls) >> 4);
    const bf16_t* kvbase = proj + rowbase * ATT_IN + 512 + h * 64 + sc * 8;
    uint4 rk0, rk1, rk2, rk3, rv0, rv1, rv2, rv3;
#define A_LOAD(i, RK, RV) do { int kp_ = cls + d * (j0 + skey + 8 * (i)); kp_ = kp_ > SEQ - 1 ? SEQ - 1 : kp_; kp_ = kp_ < 0 ? 0 : kp_; \
        const bf16_t* g_ = kvbase + (size_t)kp_ * ATT_IN; RK = *(const uint4*)g_; RV = *(const uint4*)(g_ + 512); } while (0)
#define A_WRITE(i, RK, RV) do { const int key_ = skey + 8 * (i); *(uint4*)(Kl + key_ * KA_PITCH + ((sc ^ ((key_ >> 1) & 7)) << 4)) = RK; \
        *(uint4*)(Vl + key_ * VA_PITCH + sc * 16) = RV; } while (0)
    A_LOAD(0, rk0, rv0); A_LOAD(1, rk1, rv1); A_LOAD(2, rk2, rv2); A_LOAD(3, rk3, rv3);
#pragma unroll 1
    for (;;) {
        A_WRITE(0, rk0, rv0); A_WRITE(1, rk1, rv1); A_WRITE(2, rk2, rv2); A_WRITE(3, rk3, rv3);
        const int cd = d, cW = W, ccls = cls, cj0 = j0;
        bool more = true;
        j0 += 32;
        if (j0 > jhi) {
            ++br;
            if (MODE == 0 || br == 2) more = false;
            else {
                d = 4; W = 512; cls = c & 3;
                const int lo = pmin - cls - W;
                j0 = lo < 0 ? 0 : lo >> 2;
                jhi = (pmax - cls) >> 2;
            }
        }
        A_LOAD(0, rk0, rv0); A_LOAD(1, rk1, rv1); A_LOAD(2, rk2, rv2); A_LOAD(3, rk3, rv3);
        f32x16 st;
#pragma unroll
        for (int r = 0; r < 16; ++r) st[r] = 0.f;
#pragma unroll
        for (int s = 0; s < 4; ++s) {
            const bf16x8 kf = *(const bf16x8*)(Kl + fr * KA_PITCH + (((2 * s + fh) ^ ((fr >> 1) & 7)) << 4));
            st = MFMA32(kf, qf[s], st);
        }
        float al;
        const int kfirst = ccls + cd * cj0, klast = kfirst + cd * 31;
        if (klast <= pmin && pmax - kfirst <= cW) osm_update_full(st, m, l, al);
        else {
            unsigned vm = 0;
#pragma unroll
            for (int r = 0; r < 16; ++r) {
                const int dist = qpos - (ccls + cd * (cj0 + crow(r, fh)));
                vm |= (dist >= 0 && dist <= cW) ? (1u << r) : 0u;
            }
            osm_update(st, vm, m, l, al);
        }
        if (!__all(al == 1.f)) {
#pragma unroll
            for (int dd = 0; dd < 2; ++dd)
#pragma unroll
                for (int r = 0; r < 16; ++r) o[dd][r] *= al;
        }
        {
            unsigned va[4]; bf16x8 vf[4];
            va[0] = vaddr; va[1] = vaddr + 64; va[2] = vaddr + 16 * VA_PITCH; va[3] = vaddr + 16 * VA_PITCH + 64;
            tr_quad(va, 8 * VA_PITCH, vf);
            const bf16x8 p0 = pack_p(st, 0), p1 = pack_p(st, 1);
            o[0] = MFMA32(vf[0], p0, o[0]); o[1] = MFMA32(vf[1], p0, o[1]);
            o[0] = MFMA32(vf[2], p1, o[0]); o[1] = MFMA32(vf[3], p1, o[1]);
        }
        if (!more) break;
    }
    l += __shfl_xor(l, 32);
    bf16_t* op = WSP(bf16_t, WS_MIXED) + (rowbase + qpos) * DM + h * 64;
    float* lsep = WSP(float, WS_LSE1) + (rowbase + qpos) * 8 + h;
    if (MODE == 0) {
        const float il = 1.f / l;
        if (fh == 0) *lsep = m + __logf(l);
#pragma unroll
        for (int dd = 0; dd < 2; ++dd)
#pragma unroll
            for (int g = 0; g < 4; ++g) {
                const int dim = 32 * dd + 8 * g + 4 * fh;
                uint2 w;
                w.x = pack2(o[dd][4 * g + 0] * il, o[dd][4 * g + 1] * il);
                w.y = pack2(o[dd][4 * g + 2] * il, o[dd][4 * g + 3] * il);
                *(uint2*)(op + dim) = w;
            }
    } else {
        const float lse1 = *lsep;
        const float M = fmaxf(m, lse1);
        const float w23 = __expf(m - M), w1 = __expf(lse1 - M);
        const float iden = 1.f / (l * w23 + w1);
        const float a23 = w23 * iden, a1 = w1 * iden;
        uint2 prev[2][4];
#pragma unroll
        for (int dd = 0; dd < 2; ++dd)
#pragma unroll
            for (int g = 0; g < 4; ++g) prev[dd][g] = *(const uint2*)(op + 32 * dd + 8 * g + 4 * fh);
#pragma unroll
        for (int dd = 0; dd < 2; ++dd)
#pragma unroll
            for (int g = 0; g < 4; ++g) {
                const int dim = 32 * dd + 8 * g + 4 * fh;
                const float p0 = __uint_as_float(prev[dd][g].x << 16), p1 = __uint_as_float(prev[dd][g].x & 0xffff0000u);
                const float p2 = __uint_as_float(prev[dd][g].y << 16), p3 = __uint_as_float(prev[dd][g].y & 0xffff0000u);
                uint2 w;
                w.x = pack2(o[dd][4 * g + 0] * a23 + p0 * a1, o[dd][4 * g + 1] * a23 + p1 * a1);
                w.y = pack2(o[dd][4 * g + 2] * a23 + p2 * a1, o[dd][4 * g + 3] * a23 + p3 * a1);
                *(uint2*)(op + dim) = w;
            }
    }
}
#define NITEM_B 1024
#define NITEM_A 2048
DI void ph_attn_fast(const Params& p, int vb, unsigned char* smem) {
    if (vb < NITEM_B) {
        const int item = vb < 512 ? vb : 512 + (1023 - vb);
        ph_attnB_fast(p, item, smem);
    } else ph_attnA_fast<0>(p, vb - NITEM_B, smem);
}


DI void ph_spatial_fast(const Params& p, int item, unsigned char* smem) {
    const int tid = otid(), wave = tid >> 6, lane = tid & 63, fr = lane & 31, fh = lane >> 5;
    const int wm = wave >> 1, wn = wave & 1;
    const int chunk = item >> 3, g = item & 7;
    bf16_t* u = WSP(bf16_t, WS_Z_U);
    const bf16_t* vt = WSP(bf16_t, WS_Z_VT);
    const float* ssq = WSP(float, WS_SSQ);
    const float* wsp = p.in[16] + (size_t)g * 128 * 128;
    float* rinv = (float*)(smem + 66 * 1024);
    unsigned char* Bt = smem + 32768;
    __syncthreads();
    if (tid < 128) {
        const float4* sp = (const float4*)(ssq + (size_t)(chunk * 128 + tid) * 64);
        float sacc = 0.f;
#pragma unroll
        for (int j = 0; j < 16; ++j) { const float4 q = sp[j]; sacc += (q.x + q.y) + (q.z + q.w); }
        rinv[tid] = rsqrtf(sacc * (1.f / CW) + EPSN);
    }
    const size_t vrow0 = (size_t)chunk * CW + g * 256;
    stage_tile(vt, 128, (int)vrow0, 0, Bt, wave, lane);
    stage_tile(vt, 128, (int)vrow0, 64, Bt + 16384, wave, lane);
    __syncthreads();
#pragma unroll
    for (int i = 0; i < 8; ++i) {
        const int id = tid + 256 * i;
        const int t = id >> 4, sc = id & 15;
        const float4 w0 = *(const float4*)(wsp + t * 128 + sc * 8);
        const float4 w1 = *(const float4*)(wsp + t * 128 + sc * 8 + 4);
        const float4 r0 = *(const float4*)(rinv + sc * 8);
        const float4 r1 = *(const float4*)(rinv + sc * 8 + 4);
        const int s0 = sc * 8;
        uint4 o;
        o.x = pack2(s0 + 0 <= t ? w0.x * r0.x : 0.f, s0 + 1 <= t ? w0.y * r0.y : 0.f);
        o.y = pack2(s0 + 2 <= t ? w0.z * r0.z : 0.f, s0 + 3 <= t ? w0.w * r0.w : 0.f);
        o.z = pack2(s0 + 4 <= t ? w1.x * r1.x : 0.f, s0 + 5 <= t ? w1.y * r1.y : 0.f);
        o.w = pack2(s0 + 6 <= t ? w1.z * r1.z : 0.f, s0 + 7 <= t ? w1.w * r1.w : 0.f);
        const int kt = sc >> 3, c = sc & 7;
        *(uint4*)(smem + kt * 16384 + t * 128 + ((c ^ ((t >> 1) & 7)) << 4)) = o;
    }
#pragma unroll 1
    for (int nt = 0; nt < 2; ++nt) {
        asm volatile("s_waitcnt vmcnt(0)" ::: "memory");
        __syncthreads();
        f32x16 acc[2][2];
#pragma unroll
        for (int i = 0; i < 2; ++i)
#pragma unroll
            for (int j = 0; j < 2; ++j)
#pragma unroll
                for (int r = 0; r < 16; ++r) acc[i][j][r] = 0.f;
#pragma unroll
        for (int kt = 0; kt < 2; ++kt)
#pragma unroll
            for (int s = 0; s < 4; ++s) {
                bf16x8 a[2], b[2];
#pragma unroll
                for (int i = 0; i < 2; ++i) {
                    a[i] = lds_frag(smem + kt * 16384, wm * 64 + i * 32 + fr, 2 * s + fh);
                    b[i] = lds_frag(Bt + kt * 16384, wn * 64 + i * 32 + fr, 2 * s + fh);
                }
#pragma unroll
                for (int i = 0; i < 2; ++i)
#pragma unroll
                    for (int j = 0; j < 2; ++j) acc[i][j] = MFMA32(a[i], b[j], acc[i][j]);
            }
        __syncthreads();
        float* st = (float*)(Bt + wave * (32 * 65 * 4));
#pragma unroll
        for (int i = 0; i < 2; ++i) {
#pragma unroll
            for (int j = 0; j < 2; ++j)
#pragma unroll
                for (int r = 0; r < 16; ++r) st[crow(r, fh) * 65 + j * 32 + fr] = acc[i][j][r];
            const int t = wm * 64 + i * 32 + fr;
            const int c0 = g * 256 + nt * 128 + wn * 64 + fh * 32;
            bf16_t* up = u + (size_t)(chunk * 128 + t) * CW + c0;
            const float bias = p.in[17][g * 128 + t];
            const float* gn = p.in[15] + c0;
            uint4 ur[4];
#pragma unroll
            for (int q = 0; q < 4; ++q) ur[q] = ((const uint4*)up)[q];
#pragma unroll
            for (int q = 0; q < 4; ++q) {
                float uf[8]; unpack8(ur[q], uf);
                const float4 g0 = *(const float4*)(gn + 8 * q), g1 = *(const float4*)(gn + 8 * q + 4);
                const float gg[8] = {g0.x, g0.y, g0.z, g0.w, g1.x, g1.y, g1.z, g1.w};
                float ov[8];
#pragma unroll
                for (int e = 0; e < 8; ++e) ov[e] = uf[e] * (st[fr * 65 + fh * 32 + 8 * q + e] * gg[e] + bias);
                uint4 o; o.x = pack2(ov[0], ov[1]); o.y = pack2(ov[2], ov[3]); o.z = pack2(ov[4], ov[5]); o.w = pack2(ov[6], ov[7]);
                ((uint4*)up)[q] = o;
            }
        }
        if (nt == 0) {
            __syncthreads();
            stage_tile(vt, 128, (int)vrow0 + 128, 0, Bt, wave, lane);
            stage_tile(vt, 128, (int)vrow0 + 128, 64, Bt + 16384, wave, lane);
        }
    }
}

#define XB_TMO      128
#define XB_XCNT(j)  (256  + 64 * (j))
#define XB_XSUB(j)  (1280 + 64 * (j))
#define XB_XGEN(j)  (2304 + 64 * (j))
#define XB_TOP      3328
#define XB_TOPGEN   3392
#define XCD_BAR_WORDS 3456
#define XB_SPIN_CAP (1u << 22)
DI unsigned xb_ld(unsigned* p) { return __hip_atomic_load(p, __ATOMIC_RELAXED, __HIP_MEMORY_SCOPE_AGENT); }
DI unsigned xb_add(unsigned* p, unsigned v) { return __hip_atomic_fetch_add(p, v, __ATOMIC_RELAXED, __HIP_MEMORY_SCOPE_AGENT); }
DI unsigned xb_xcc_id() { return (unsigned)__builtin_amdgcn_s_getreg((3 << 11) | 20) & 0xFu; }
#define XB_SPIN(cond, bar) do { unsigned _sp = 0; while (cond) { __builtin_amdgcn_s_sleep(1); \
    if ((++_sp & 255u) == 0u) { if (xb_ld(&(bar)[XB_TMO])) break; if (_sp > XB_SPIN_CAP) { atomicAdd(&(bar)[XB_TMO], 1u); break; } } } } while (0)
struct XcdBarrier { unsigned* bar; unsigned x; volatile LAS unsigned* st; };
DI XcdBarrier xcd_barrier_post(unsigned* bar, volatile LAS unsigned* st) {
    XcdBarrier b; b.bar = bar; b.x = xb_xcc_id(); b.st = st;
    if (threadIdx.x == 0) st[2] = xb_add(&bar[XB_XCNT(b.x)], 1u);
    return b;
}
DI void xcd_barrier_complete(unsigned* bar, unsigned x, unsigned& nloc, unsigned& nx, unsigned& xi) {
    const unsigned G = gridDim.x * gridDim.y * gridDim.z;
    unsigned sum, cnt, mine, below, sp = 0u;
    for (;;) {
        sum = 0u; cnt = 0u; mine = 0u; below = 0u;
#pragma unroll
        for (unsigned j = 0; j < 16; ++j) { const unsigned c = xb_ld(&bar[XB_XCNT(j)]); sum += c; cnt += (c > 0u) ? 1u : 0u; mine = (j == x) ? c : mine; below += (c > 0u && j < x) ? 1u : 0u; }
        if (sum == G) break;
        __builtin_amdgcn_s_sleep(1);
        if ((++sp & 255u) == 0u) { if (xb_ld(&bar[XB_TMO])) break; if (sp > XB_SPIN_CAP) { atomicAdd(&bar[XB_TMO], 1u); break; } }
    }
    nloc = mine > 0u ? mine : 1u; nx = cnt > 0u ? cnt : 1u; xi = below;
}
DI void xcd_barrier(const XcdBarrier& b) {
    asm volatile("s_waitcnt vmcnt(0)" ::: "memory");
    __syncthreads();
    if (threadIdx.x == 0) {
        unsigned* bar = b.bar;
        __builtin_amdgcn_s_waitcnt(0);
        unsigned nloc = b.st[0], nx = b.st[1];
        if (nloc == 0u) { unsigned xi; xcd_barrier_complete(bar, b.x, nloc, nx, xi); b.st[0] = nloc; b.st[1] = nx; b.st[3] = xi; }
        const unsigned old = xb_add(&bar[XB_XSUB(b.x)], 1u);
        const unsigned gen = old / nloc;
        if (old + 1u == (gen + 1u) * nloc) {
            __builtin_amdgcn_fence(__ATOMIC_RELEASE, "agent");
            asm volatile("s_waitcnt vmcnt(0)" ::: "memory");
            const unsigned og = xb_add(&bar[XB_TOP], 1u);
            const unsigned tg = og / nx;
            if (og + 1u == (tg + 1u) * nx) xb_add(&bar[XB_TOPGEN], 1u);
            else XB_SPIN(xb_ld(&bar[XB_TOPGEN]) == tg, bar);
            __builtin_amdgcn_fence(__ATOMIC_ACQUIRE, "agent");
            xb_add(&bar[XB_XGEN(b.x)], 1u);
            asm volatile("s_waitcnt vmcnt(0)" ::: "memory");
        } else {
            XB_SPIN(xb_ld(&bar[XB_XGEN(b.x)]) == gen, bar);
            __builtin_amdgcn_fence(__ATOMIC_ACQUIRE, "agent");
            asm volatile("s_waitcnt vmcnt(0)" ::: "memory");
        }
    }
    __syncthreads();
}

enum { PH_PREP = 0, PH_GEMM1, PH_ATTN, PH_ATTN2, PH_GEMM2,
       PH_NORM_P0, PH_GEMMQ0, PH_SCORE0, PH_PDOWN0, PH_PCOMB0, PH_PUP0, PH_NORM_SGU,
       PH_GEMM4, PH_SPATIAL, PH_GEMM5,
       PH_NORM_P1, PH_GEMMQ1, PH_SCORE1, PH_PDOWN1, PH_PCOMB1, PH_PUP1, PH_COUNT };

__host__ __device__ constexpr int phase_nvb(int ph) {
    switch (ph) {
        case PH_PREP: return PREP_N;
        case PH_GEMM1: return (ATT_IN / 256) * (NTOK / 256);
        case PH_ATTN: return NITEM_B + NITEM_A;
        case PH_ATTN2: return NITEM_A;
        case PH_GEMM2: return (DM / 256) * (NTOK / 256);
        case PH_NORM_P0: case PH_NORM_P1: case PH_NORM_SGU: return NTOK / 16;
        case PH_GEMMQ0: case PH_GEMMQ1: return 16 * (NTOK / 256);
        case PH_SCORE0: case PH_SCORE1: return (NTOK / 32) * 8 / 4;
        case PH_PCOMB0: case PH_PCOMB1: return NTOK / 8;
        case PH_GEMM4: return (4096 / 256) * (NTOK / 256);
        case PH_SPATIAL: return 256 * 8;
        case PH_GEMM5: return (DM / 256) * (NTOK / 256);
    }
    return 0;
}

template <int PH>
DI void run_vb(const Params& p, int vb, unsigned char* smem) {
    if constexpr (PH == PH_PREP) ph_prep(p, vb, smem);
    else if constexpr (PH == PH_ATTN) ph_attn_fast(p, vb, smem);
    else if constexpr (PH == PH_ATTN2) ph_attnA_fast<1>(p, vb, smem);
    else if constexpr (PH == PH_NORM_P0 || PH == PH_NORM_P1) rmsnorm_rows<true, 4>(WSP(bf16_t, WS_RES), p.in[19] + (PH == PH_NORM_P1 ? DM : 0), vb, WSP(signed char, WS_XQ), WSP(float, WS_XSC));
    else if constexpr (PH == PH_PCOMB0 || PH == PH_PCOMB1) ph_peer_comb(p, vb, PH == PH_PCOMB1 ? 1 : 0);
    else if constexpr (PH == PH_NORM_SGU) rmsnorm_rows<true, 4>(WSP(bf16_t, WS_RES), p.in[13], vb, WSP(signed char, WS_XQ), WSP(float, WS_XSC));
    else if constexpr (PH == PH_SPATIAL) ph_spatial_fast(p, vb, smem);
}

template <int PH>
DI void run_phase(const Params& p, unsigned char* smem) {
    if constexpr (PH == PH_PDOWN0 || PH == PH_PDOWN1) run_peer_sliced<false>(p, PH == PH_PDOWN1 ? 1 : 0, smem);
    else if constexpr (PH == PH_PUP0 || PH == PH_PUP1) run_peer_sliced<true>(p, PH == PH_PUP1 ? 1 : 0, smem);
    else if constexpr (PH == PH_SCORE0 || PH == PH_SCORE1) run_score(p, PH == PH_SCORE1 ? 1 : 0, smem);
    else if constexpr (PH == PH_GEMMQ0 || PH == PH_GEMMQ1) run_gemmq_pg8(p, PH == PH_GEMMQ1 ? 1 : 0, smem);
    else if constexpr (PH == PH_GEMM1) run_gemm1_pg8(p, smem);
    else if constexpr (PH == PH_GEMM4) run_gemm4_pg8(p, smem);
    else if constexpr (PH == PH_GEMM2) run_gemm_pg8<0>(p, smem);
    else if constexpr (PH == PH_GEMM5) run_gemm_pg8<1>(p, smem);
    else {
        constexpr int nvb = phase_nvb(PH);
        const int g = threadIdx.x >> 8;
        for (int vb = 2 * blockIdx.x; vb < nvb; vb += 2 * gridDim.x)
            if (vb + g < nvb) run_vb<PH>(p, vb + g, smem + g * GROUP_SMEM);
    }
}

template <int PH>
DI void run_from(const Params& p, unsigned char* smem, cg::grid_group& grid, const XcdBarrier& xb) {
    run_phase<PH>(p, smem);
    if constexpr (PH + 1 < PH_COUNT) {
        if constexpr (PH == 1) grid.sync(); else xcd_barrier(xb);
        run_from<PH + 1>(p, smem, grid, xb);
    }
}

__global__ void __launch_bounds__(NTHREADS, 2) k_mega(Params p) {
    extern __shared__ __attribute__((aligned(16))) unsigned char smem[];
    cg::grid_group grid = cg::this_grid();
    volatile LAS unsigned* st = (volatile LAS unsigned*)(smem + SMEM_BYTES);
    if (threadIdx.x == 0) { st[0] = 0u; st[1] = 0u; st[2] = 0u; st[3] = 0u; }
    __syncthreads();
    const XcdBarrier xb = xcd_barrier_post((unsigned*)(p.ws + WS_CTL), st);
    run_from<0>(p, smem, grid, xb);
}


extern "C" void kernel_launch(void* const* d_in, const int* in_sizes, int n_in, void* d_out, int out_size, void* d_ws, size_t ws_size, hipStream_t stream) {
    if (n_in != 24 || ws_size < WS_NEED || in_sizes[0] != NTOK * DM || out_size != NTOK * DM || in_sizes[22] != 2 * NEXP * DM) {
        fprintf(stderr, "kernel_launch: built for x[16,2048,1024] with 24 inputs and >= 512 MiB of workspace; got n_in %d, in0 %d, out %d, ws %zu: nothing launched\n", n_in, in_sizes[0], out_size, ws_size); return; }
    static int grid_blocks = 0;
    if (!grid_blocks) {
        int dev = 0, cus = 0, per_cu = 0;
        (void)hipGetDevice(&dev);
        (void)hipDeviceGetAttribute(&cus, hipDeviceAttributeMultiprocessorCount, dev);
        (void)hipFuncSetAttribute((const void*)k_mega, hipFuncAttributeMaxDynamicSharedMemorySize, SMEM_ALLOC);
        (void)hipOccupancyMaxActiveBlocksPerMultiprocessor(&per_cu, (const void*)k_mega, NTHREADS, SMEM_ALLOC);
        if (per_cu > 1) per_cu = 1;
        if (per_cu < 1) { fprintf(stderr, "kernel_launch: occupancy query returned %d\n", per_cu); per_cu = 1; }
        grid_blocks = cus * per_cu;
    }
    Params p{};
    for (int i = 0; i < 24; ++i) p.in[i] = (const float*)d_in[i];
    p.out = (float*)d_out;
    p.ws = (unsigned char*)d_ws;
    void* args[] = {&p};
    if (hipMemsetAsync((unsigned char*)d_ws + WS_CTL, 0, XCD_BAR_WORDS * 4, stream) != hipSuccess) { fprintf(stderr, "kernel_launch: memset of the barrier words failed\n"); return; }
    hipError_t e = hipLaunchCooperativeKernel((const void*)k_mega, dim3(grid_blocks), dim3(NTHREADS), args, SMEM_ALLOC, stream);
    if (e != hipSuccess) fprintf(stderr, "cooperative launch failed: %s (grid %d)\n", hipGetErrorString(e), grid_blocks);
}
```

```cpp
#include <hip/hip_runtime.h>
#include <stdint.h>
#include <stdio.h>

#define NTOK   32768
#define DM     1024
#define SEQ    2048
#define NB     16
#define ATT_IN 3072
#define CW     2048
#define NEXP   16384
#define EPSN   1e-6f

typedef unsigned short bf16_t;
typedef unsigned int u32;

#define DI __device__ __forceinline__
#define LAS __attribute__((address_space(3)))

DI int otid() { int t = threadIdx.x & 255; asm volatile("" : "+v"(t)); return t; }
DI int otid512() { int t = threadIdx.x; asm volatile("" : "+v"(t)); return t; }
DI float bf2f(bf16_t v) { return __uint_as_float(((u32)v) << 16); }
typedef __bf16 bf16v2 __attribute__((ext_vector_type(2)));
DI bf16_t f2bf(float f) { const __bf16 h = (__bf16)f; return __builtin_bit_cast(bf16_t, h); }
DI u32 pack2(float lo, float hi) { bf16v2 v; v[0] = (__bf16)lo; v[1] = (__bf16)hi; return __builtin_bit_cast(u32, v); }
DI float gelu_tanh(float x) {
    const float y = 0.7978845608028654f * (x + 0.044715f * x * x * x);
    const float e = __expf(2.f * y);
    const float t = 1.f - 2.f / (e + 1.f);
    return 0.5f * x * (1.f + t);
}
DI float wave_sum(float v) {
#pragma unroll
    for (int o = 1; o < 64; o <<= 1) v += __shfl_xor(v, o);
    return v;
}
DI float wave_max(float v) {
#pragma unroll
    for (int o = 1; o < 64; o <<= 1) v = fmaxf(v, __shfl_xor(v, o));
    return v;
}
DI u32 f2ord(float f) { u32 u = __float_as_uint(f); return (u & 0x80000000u) ? ~u : (u | 0x80000000u); }
DI float ord2f(u32 o) { u32 u = (o & 0x80000000u) ? (o & 0x7fffffffu) : ~o; return __uint_as_float(u); }

#define MiB ((size_t)1 << 20)
#define WS_CTL      ((size_t)0)
#define WS_W_ATTIN  (1 * MiB)
#define WS_W_ATTOUT (7 * MiB)
#define WS_W_SGUIN  (9 * MiB)
#define WS_W_SGUOUT (17 * MiB)
#define WS_W_PQ     (21 * MiB)
#define WS_WQS      (25 * MiB)
#define WS_WAS      (25 * MiB + 64 * 1024)
#define WS_WSS      (25 * MiB + 128 * 1024)
#define WS_W_SUBK   (29 * MiB)
#define WS_DOWN     (32 * MiB)
#define WS_UP       (64 * MiB)
#define WS_DSC      (96 * MiB)
#define WS_USC      (96 * MiB + 128 * 1024)
#define WS_LSE1     (30 * MiB)
#define WS_XQ       (100 * MiB)
#define WS_XSC      (132 * MiB)
#define WS_RES      (160 * MiB)
#define WS_BIG      (224 * MiB)
#define WS_PROJ     (WS_BIG)
#define WS_MIXED    (WS_BIG + 192 * MiB)
#define WS_Z_U      (WS_BIG)
#define WS_Z_VT     (WS_BIG + 128 * MiB)
#define WS_RIDX     (WS_BIG + 32 * MiB)
#define WS_COEF     (WS_BIG + 40 * MiB)
#define WS_RG       (WS_BIG + 48 * MiB)
#define WS_QBUF     (WS_BIG + 64 * MiB)
#define WS_SSQ      (WS_BIG + 256 * MiB)
#define WS_NEED     (512 * MiB)

struct Params {
    const float* in[24];
    float* out;
    unsigned char* ws;
};

#include <hip/hip_cooperative_groups.h>
namespace cg = cooperative_groups;

#define GROUP_SMEM (68 * 1024)
#define PG8_EXTRA (128 * 1024)
#define SMEM_BYTES (144 * 1024)
#define SMEM_ALLOC (SMEM_BYTES + 16)
#define NTHREADS 512

#define WSP(T, off) ((T*)(p.ws + (off)))


DI void transpose_tile(const float* __restrict__ W, bf16_t* __restrict__ Wt, int K, int N, int t, unsigned char* smem) {
    float* tile = (float*)smem;
    const int tid = otid();
    const int ntn = N / 64;
    const int n0 = (t % ntn) * 64, k0 = (t / ntn) * 64;
    __syncthreads();
    {
        const int n4 = tid & 15, kr = tid >> 4;
#pragma unroll
        for (int i = 0; i < 4; ++i) {
            const int k = kr + 16 * i;
            const float4 v = *(const float4*)(W + (size_t)(k0 + k) * N + n0 + 4 * n4);
            tile[k * 65 + 4 * n4 + 0] = v.x; tile[k * 65 + 4 * n4 + 1] = v.y; tile[k * 65 + 4 * n4 + 2] = v.z; tile[k * 65 + 4 * n4 + 3] = v.w;
        }
    }
    __syncthreads();
    {
        const int n = tid >> 2, kc = tid & 3;
        float v[16];
#pragma unroll
        for (int j = 0; j < 16; ++j) v[j] = tile[(16 * kc + j) * 65 + n];
        uint4 o0, o1;
        o0.x = pack2(v[0], v[1]); o0.y = pack2(v[2], v[3]); o0.z = pack2(v[4], v[5]); o0.w = pack2(v[6], v[7]);
        o1.x = pack2(v[8], v[9]); o1.y = pack2(v[10], v[11]); o1.z = pack2(v[12], v[13]); o1.w = pack2(v[14], v[15]);
        uint4* dst = (uint4*)(Wt + (size_t)(n0 + n) * K + k0 + 16 * kc);
        dst[0] = o0; dst[1] = o1;
    }
}
DI void cvt_chunk(const float* __restrict__ src, bf16_t* __restrict__ dst, int c) {
    const size_t base = (size_t)c * 2048;
#pragma unroll
    for (int i = 0; i < 8; ++i) {
        const size_t idx = base + i * 256 + otid();
        const float4 v = ((const float4*)src)[idx];
        uint2 o; o.x = pack2(v.x, v.y); o.y = pack2(v.z, v.w);
        ((uint2*)dst)[idx] = o;
    }
}
DI int q8(float v) { int i = __float2int_rn(v); i = i > 127 ? 127 : i; i = i < -127 ? -127 : i; return i & 255; }
template <bool IN_BF16, int ROWS>
DI void rmsnorm_rows(const void* __restrict__ x, const float* __restrict__ g, int vb, signed char* xq, float* xsc) {
    const int lane = otid() & 63;
    const int row0 = (vb * 4 + (otid() >> 6)) * ROWS;
    float4 v[ROWS][4];
#pragma unroll
    for (int r = 0; r < ROWS; ++r)
#pragma unroll
        for (int j = 0; j < 4; ++j) {
            if (IN_BF16) { const uint2 w = ((const uint2*)((const bf16_t*)x + (size_t)(row0 + r) * DM))[lane + 64 * j];
                v[r][j] = make_float4(__uint_as_float(w.x << 16), __uint_as_float(w.x & 0xffff0000u), __uint_as_float(w.y << 16), __uint_as_float(w.y & 0xffff0000u)); }
            else v[r][j] = ((const float4*)((const float*)x + (size_t)(row0 + r) * DM))[lane + 64 * j];
        }
    float4 gg[4];
#pragma unroll
    for (int j = 0; j < 4; ++j) gg[j] = ((const float4*)g)[lane + 64 * j];
#pragma unroll
    for (int r = 0; r < ROWS; ++r) {
        float ss = 0.f;
#pragma unroll
        for (int j = 0; j < 4; ++j) ss += v[r][j].x * v[r][j].x + v[r][j].y * v[r][j].y + v[r][j].z * v[r][j].z + v[r][j].w * v[r][j].w;
        ss = wave_sum(ss);
        const float rinv = rsqrtf(ss * (1.f / DM) + EPSN);
        float am = 0.f;
#pragma unroll
        for (int j = 0; j < 4; ++j) {
            v[r][j].x *= rinv * gg[j].x; v[r][j].y *= rinv * gg[j].y; v[r][j].z *= rinv * gg[j].z; v[r][j].w *= rinv * gg[j].w;
            am = fmaxf(am, fmaxf(fmaxf(fabsf(v[r][j].x), fabsf(v[r][j].y)), fmaxf(fabsf(v[r][j].z), fabsf(v[r][j].w))));
        }
        am = wave_max(am);
        const float sc = am > 0.f ? 127.f / am : 0.f;
        u32* qrow = (u32*)(xq + (size_t)(row0 + r) * DM);
#pragma unroll
        for (int j = 0; j < 4; ++j)
            qrow[lane + 64 * j] = (u32)q8(v[r][j].x * sc) | ((u32)q8(v[r][j].y * sc) << 8) | ((u32)q8(v[r][j].z * sc) << 16) | ((u32)q8(v[r][j].w * sc) << 24);
        if (lane == 0) xsc[row0 + r] = am * (1.f / 127.f);
    }
}
#define PREP_T0 48
#define PREP_T1 (PREP_T0 + 16 * 16)
#define PREP_T2 (PREP_T1 + 64)
#define PREP_T3 (PREP_T2 + 16 * 32)
#define PREP_T4 (PREP_T3 + 2 * 32)
#define PREP_C0 (PREP_T4 + 64)
#define PREP_C1 (PREP_C0 + 4096)
#define PREP_C2 (PREP_C1 + 4096)
#define PREP_N  (PREP_C2 + 4096)
template <bool INT8>
DI void fp8_rows(const float* __restrict__ src, unsigned char* __restrict__ dst, float* __restrict__ inv_scale, int vb) {
    const int lane = otid() & 63;
    const int row0 = (vb * 4 + (otid() >> 6)) * 2;
    float4 v[2][4];
#pragma unroll
    for (int r = 0; r < 2; ++r)
#pragma unroll
        for (int j = 0; j < 4; ++j) v[r][j] = ((const float4*)(src + (size_t)(row0 + r) * DM) + lane)[64 * j];
#pragma unroll
    for (int r = 0; r < 2; ++r) {
        const int row = row0 + r;
        float am = 0.f;
#pragma unroll
        for (int j = 0; j < 4; ++j) am = fmaxf(am, fmaxf(fmaxf(fabsf(v[r][j].x), fabsf(v[r][j].y)), fmaxf(fabsf(v[r][j].z), fabsf(v[r][j].w))));
        am = wave_max(am);
        float sc, inv;
        if (INT8) { sc = am > 0.f ? 127.f / am : 0.f; inv = am * (1.f / 127.f); }
        else {
            int e = (int)((__float_as_uint(am) >> 23) & 255u) - 127;
            if (am == 0.f) e = 0;
            e = e < -100 ? -100 : e;
            sc = __uint_as_float((u32)(127 + 7 - e) << 23); inv = __uint_as_float((u32)(127 + e - 7) << 23);
        }
        unsigned char* drow = dst + (size_t)(row >> 14) * NEXP * DM + (size_t)(row & (NEXP - 1)) * 128;
#pragma unroll
        for (int j = 0; j < 4; ++j) {
            const int dim = 4 * (lane + 64 * j);
            u32 w;
            if (INT8) w = (u32)q8(v[r][j].x * sc) | ((u32)q8(v[r][j].y * sc) << 8) | ((u32)q8(v[r][j].z * sc) << 16) | ((u32)q8(v[r][j].w * sc) << 24);
            else { int t = __builtin_amdgcn_cvt_pk_fp8_f32(v[r][j].x * sc, v[r][j].y * sc, 0, false); t = __builtin_amdgcn_cvt_pk_fp8_f32(v[r][j].z * sc, v[r][j].w * sc, t, true); w = (u32)t; }
            *(u32*)(drow + (size_t)(dim >> 7) * NEXP * 128 + (dim & 127)) = w;
        }
        if (lane == 0) inv_scale[row] = inv;
    }
}
DI void wq8_item(const float* __restrict__ W, signed char* __restrict__ Wt, float* __restrict__ wsc, int t, unsigned char* smem, int N) {
    float* red = (float*)smem;
    const int tid = otid(), n = tid & 63, kq = tid >> 6;
    const float* col = W + t * 64 + n;
    float am = 0.f;
#pragma unroll 16
    for (int k = 0; k < 256; ++k) am = fmaxf(am, fabsf(col[(size_t)(kq * 256 + k) * N]));
    __syncthreads();
    red[kq * 64 + n] = am;
    __syncthreads();
    am = fmaxf(fmaxf(red[n], red[64 + n]), fmaxf(red[128 + n], red[192 + n]));
    const float sc = am > 0.f ? 127.f / am : 0.f;
    if (kq == 0) wsc[t * 64 + n] = am * (1.f / 127.f);
    signed char* drow = Wt + (size_t)(t * 64 + n) * 1024;
#pragma unroll 1
    for (int kb = 0; kb < 16; ++kb) {
        const int k0 = kb * 64 + kq * 16;
        u32 w[4];
#pragma unroll
        for (int j = 0; j < 4; ++j) {
            const float* c4 = col + (size_t)(k0 + 4 * j) * N;
            w[j] = (u32)q8(c4[0] * sc) | ((u32)q8(c4[N] * sc) << 8) | ((u32)q8(c4[2 * N] * sc) << 16) | ((u32)q8(c4[3 * N] * sc) << 24);
        }
        *(uint4*)(drow + k0) = make_uint4(w[0], w[1], w[2], w[3]);
    }
}
DI void ph_prep(const Params& p, int vb, unsigned char* smem) {
    if (vb < PREP_T0) wq8_item(p.in[2], WSP(signed char, WS_W_ATTIN), WSP(float, WS_WAS), vb, smem, ATT_IN);
    else if (vb < PREP_T1) transpose_tile(p.in[12], WSP(bf16_t, WS_W_ATTOUT), DM, DM, vb - PREP_T0, smem);
    else if (vb < PREP_T2) wq8_item(p.in[14], WSP(signed char, WS_W_SGUIN), WSP(float, WS_WSS), vb - PREP_T1, smem, 4096);
    else if (vb < PREP_T3) transpose_tile(p.in[18], WSP(bf16_t, WS_W_SGUOUT), CW, DM, vb - PREP_T2, smem);
    else if (vb < PREP_T4) { const int t = vb - PREP_T3, l = t / 32; wq8_item(p.in[20] + (size_t)l * DM * 2048, WSP(signed char, WS_W_PQ) + (size_t)l * 2048 * DM, WSP(float, WS_WQS) + l * 2048, t % 32, smem, 2048); }
    else if (vb < PREP_C0) cvt_chunk(p.in[21], WSP(bf16_t, WS_W_SUBK), vb - PREP_T4);
    else if (vb < PREP_C1) fp8_rows<true>(p.in[22], p.ws + WS_DOWN, WSP(float, WS_DSC), vb - PREP_C0);
    else if (vb < PREP_C2) fp8_rows<false>(p.in[23], p.ws + WS_UP, WSP(float, WS_USC), vb - PREP_C1);
    else rmsnorm_rows<false, 2>(p.in[0], p.in[1], vb - PREP_C2, WSP(signed char, WS_XQ), WSP(float, WS_XSC));
}

DI float compute_lam(const Params& p, int lane) {
    const float a = wave_sum(p.in[7][lane] * p.in[8][lane]);
    const float b = wave_sum(p.in[9][lane] * p.in[10][lane]);
    return __expf(a) - __expf(b) + 0.2f;
}
DI void ce_desc(u32& a, u32& b) { const u32 hi = max(a, b), lo = min(a, b); a = hi; b = lo; }
DI void sort16_desc(u32 (&v)[16]) {
#define SCE(a, b) ce_desc(v[a], v[b]);
    SCE(0,13) SCE(1,12) SCE(2,15) SCE(3,14) SCE(4,8) SCE(5,6) SCE(7,11) SCE(9,10)
    SCE(0,5) SCE(1,7) SCE(2,9) SCE(3,4) SCE(6,13) SCE(8,14) SCE(10,15) SCE(11,12)
    SCE(0,1) SCE(2,3) SCE(4,5) SCE(6,8) SCE(7,9) SCE(10,11) SCE(12,13) SCE(14,15)
    SCE(0,2) SCE(1,3) SCE(4,10) SCE(5,11) SCE(6,7) SCE(8,9) SCE(12,14) SCE(13,15)
    SCE(1,2) SCE(3,12) SCE(4,6) SCE(5,7) SCE(8,10) SCE(9,11) SCE(13,14)
    SCE(1,4) SCE(2,6) SCE(5,8) SCE(7,10) SCE(9,13) SCE(11,14)
    SCE(2,4) SCE(3,6) SCE(9,12) SCE(11,13)
    SCE(3,5) SCE(6,8) SCE(7,9) SCE(10,12)
    SCE(3,4) SCE(5,6) SCE(7,8) SCE(9,10) SCE(11,12)
    SCE(6,7) SCE(8,9)
#undef SCE
}
DI void merge16_desc(u32 (&a)[16], const u32 (&b)[16]) {
#pragma unroll
    for (int i = 0; i < 16; ++i) a[i] = max(a[i], b[15 - i]);
#pragma unroll
    for (int j = 8; j > 0; j >>= 1)
#pragma unroll
        for (int i = 0; i < 16; ++i) { const int l = i ^ j; if (l > i) ce_desc(a[i], a[l]); }
}
DI void top16_insert(u32 (&lst)[16], u32 x) {
#pragma unroll
    for (int j = 0; j < 16; ++j) { const u32 hi = max(lst[j], x); x = min(lst[j], x); lst[j] = hi; }
}
DI void unpack8(const uint4 v, float (&f)[8]) {
    f[0] = __uint_as_float(v.x << 16); f[1] = __uint_as_float(v.x & 0xffff0000u);
    f[2] = __uint_as_float(v.y << 16); f[3] = __uint_as_float(v.y & 0xffff0000u);
    f[4] = __uint_as_float(v.z << 16); f[5] = __uint_as_float(v.z & 0xffff0000u);
    f[6] = __uint_as_float(v.w << 16); f[7] = __uint_as_float(v.w & 0xffff0000u);
}
typedef float f32x2_t __attribute__((ext_vector_type(2)));
DI void unpack16fp8(const uint4 w, float (&f)[16]) {
    f32x2_t t;
    t = __builtin_amdgcn_cvt_pk_f32_fp8((int)w.x, false); f[0] = t[0]; f[1] = t[1];
    t = __builtin_amdgcn_cvt_pk_f32_fp8((int)w.x, true);  f[2] = t[0]; f[3] = t[1];
    t = __builtin_amdgcn_cvt_pk_f32_fp8((int)w.y, false); f[4] = t[0]; f[5] = t[1];
    t = __builtin_amdgcn_cvt_pk_f32_fp8((int)w.y, true);  f[6] = t[0]; f[7] = t[1];
    t = __builtin_amdgcn_cvt_pk_f32_fp8((int)w.z, false); f[8] = t[0]; f[9] = t[1];
    t = __builtin_amdgcn_cvt_pk_f32_fp8((int)w.z, true);  f[10] = t[0]; f[11] = t[1];
    t = __builtin_amdgcn_cvt_pk_f32_fp8((int)w.w, false); f[12] = t[0]; f[13] = t[1];
    t = __builtin_amdgcn_cvt_pk_f32_fp8((int)w.w, true);  f[14] = t[0]; f[15] = t[1];
}
struct PeerPre { int e[16]; uint4 xa, xb; float2 r; };
struct PeerRows { uint4 d[8]; float c[8]; };
template <bool UP>
DI PeerPre peer_prefetch(const Params& p, int tok, int sl, int lane) {
    PeerPre q;
    const uint4* rix = (const uint4*)(WSP(unsigned short, WS_RIDX) + (size_t)tok * 128 + 16 * (lane >> 3));
#pragma unroll
    for (int j = 0; j < 2; ++j) {
        const uint4 t = rix[j];
        q.e[8 * j] = (int)(t.x & 0xffffu); q.e[8 * j + 1] = (int)(t.x >> 16); q.e[8 * j + 2] = (int)(t.y & 0xffffu); q.e[8 * j + 3] = (int)(t.y >> 16);
        q.e[8 * j + 4] = (int)(t.z & 0xffffu); q.e[8 * j + 5] = (int)(t.z >> 16); q.e[8 * j + 6] = (int)(t.w & 0xffffu); q.e[8 * j + 7] = (int)(t.w >> 16);
    }
    if (UP) {
        const u32 w = *(const u32*)(WSP(bf16_t, WS_RES) + (size_t)tok * DM + sl * 128 + 16 * (lane & 7) + 2 * (lane >> 3));
        q.r = make_float2(__uint_as_float(w << 16), __uint_as_float(w & 0xffff0000u));
    } else {
        q.xa = *(const uint4*)(WSP(signed char, WS_XQ) + (size_t)tok * DM + sl * 128 + 16 * (lane & 7));
    }
    return q;
}
template <int HF, bool UP>
DI void peer_issue_rows(const Params& p, const unsigned char* tab, const PeerPre& q, int tok, int lane, PeerRows& R) {
    const unsigned dco = 16u * (unsigned)(lane & 7);
#pragma unroll
    for (int bi = 0; bi < 8; ++bi) R.d[bi] = *(const uint4*)(tab + ((unsigned)q.e[8 * HF + bi] * 128u + dco));
    if (UP) {
        const uint4 cw = *(const uint4*)(WSP(bf16_t, WS_COEF) + (size_t)tok * 128 + 16 * (lane >> 3) + 8 * HF);
        R.c[0] = __uint_as_float(cw.x << 16); R.c[1] = __uint_as_float(cw.x & 0xffff0000u); R.c[2] = __uint_as_float(cw.y << 16); R.c[3] = __uint_as_float(cw.y & 0xffff0000u);
        R.c[4] = __uint_as_float(cw.z << 16); R.c[5] = __uint_as_float(cw.z & 0xffff0000u); R.c[6] = __uint_as_float(cw.w << 16); R.c[7] = __uint_as_float(cw.w & 0xffff0000u);
    }
}
template <int HF>
DI void peer_down_half(const PeerPre& q, const PeerRows& R, float (&part)[16]) {
#pragma unroll
    for (int bi = 0; bi < 8; ++bi) {
        int a = __builtin_amdgcn_sdot4((int)R.d[bi].x, (int)q.xa.x, 0, false);
        a = __builtin_amdgcn_sdot4((int)R.d[bi].y, (int)q.xa.y, a, false);
        a = __builtin_amdgcn_sdot4((int)R.d[bi].z, (int)q.xa.z, a, false);
        a = __builtin_amdgcn_sdot4((int)R.d[bi].w, (int)q.xa.w, a, false);
        part[8 * HF + bi] = (float)a;
    }
}
DI void peer_down_fin(const Params& p, const float (&part)[16], int tok, int sl, int lane) {
    const bool b2 = lane & 4, b1 = lane & 2, b0 = lane & 1;
    float r8[8], r4[4], r2[2];
#pragma unroll
    for (int i = 0; i < 8; ++i) { const float snd = b2 ? part[i] : part[i + 8]; const float kp = b2 ? part[i + 8] : part[i]; r8[i] = kp + __shfl_xor(snd, 4); }
#pragma unroll
    for (int i = 0; i < 4; ++i) { const float snd = b1 ? r8[i] : r8[i + 4]; const float kp = b1 ? r8[i + 4] : r8[i]; r4[i] = kp + __shfl_xor(snd, 2); }
#pragma unroll
    for (int i = 0; i < 2; ++i) { const float snd = b0 ? r4[i] : r4[i + 2]; const float kp = b0 ? r4[i + 2] : r4[i]; r2[i] = kp + __shfl_xor(snd, 1); }
    u32* pd = WSP(u32, WS_QBUF) + ((size_t)tok * 8 + sl) * 64;
    pd[lane] = pack2(r2[0], r2[1]);
}
DI void ph_peer_comb(const Params& p, int vb, int l) {
    const int tid = otid(), lane = tid & 63;
    const int tok0 = (vb * 4 + (tid >> 6)) * 2;
    const float* dsc = WSP(float, WS_DSC) + (size_t)l * NEXP;
    const float* usc = WSP(float, WS_USC) + (size_t)l * NEXP;
    u32 w[2][8]; int2 e[2]; float2 g[2]; float xs[2];
#pragma unroll
    for (int r = 0; r < 2; ++r) {
        const int tok = tok0 + r;
        const u32* pd = WSP(u32, WS_QBUF) + (size_t)tok * 8 * 64;
#pragma unroll
        for (int sl = 0; sl < 8; ++sl) w[r][sl] = pd[sl * 64 + lane];
        { const u32 ew = *(const u32*)(WSP(unsigned short, WS_RIDX) + (size_t)tok * 128 + 2 * lane); e[r] = make_int2((int)(ew & 0xffffu), (int)(ew >> 16)); }
        g[r] = *(const float2*)(WSP(float, WS_RG) + (size_t)tok * 128 + 2 * lane);
        xs[r] = WSP(float, WS_XSC)[tok];
    }
#pragma unroll
    for (int r = 0; r < 2; ++r) {
        float t0 = 0.f, t1 = 0.f;
#pragma unroll
        for (int sl = 0; sl < 8; ++sl) { t0 += __uint_as_float(w[r][sl] << 16); t1 += __uint_as_float(w[r][sl] & 0xffff0000u); }
        float2 o;
        o.x = g[r].x * gelu_tanh(t0 * dsc[e[r].x] * xs[r]) * usc[e[r].x];
        o.y = g[r].y * gelu_tanh(t1 * dsc[e[r].y] * xs[r]) * usc[e[r].y];
        *(u32*)(WSP(bf16_t, WS_COEF) + (size_t)(tok0 + r) * 128 + 2 * lane) = pack2(o.x, o.y);
    }
}
template <int HF>
DI void peer_up_half(const PeerPre& q, const PeerRows& R, float (&y)[16]) {
#pragma unroll
    for (int bi = 0; bi < 8; ++bi) {
        const float c = R.c[bi];
        float w[16]; unpack16fp8(R.d[bi], w);
#pragma unroll
        for (int i = 0; i < 16; ++i) y[i] += c * w[i];
        asm volatile("" : "+v"(y[0]), "+v"(y[1]), "+v"(y[2]), "+v"(y[3]), "+v"(y[4]), "+v"(y[5]), "+v"(y[6]), "+v"(y[7]), "+v"(y[8]), "+v"(y[9]), "+v"(y[10]), "+v"(y[11]), "+v"(y[12]), "+v"(y[13]), "+v"(y[14]), "+v"(y[15]));
    }
}
DI void peer_up_fin(const Params& p, const PeerPre& q, const float (&y)[16], int tok, int sl, int lane, bool final_layer) {
    const int rg = lane >> 3, dc = lane & 7;
    const bool b5 = lane & 32, b4 = lane & 16, b3 = lane & 8;
    float r8[8], r4[4], r2[2];
#pragma unroll
    for (int i = 0; i < 8; ++i) { const float snd = b5 ? y[i] : y[i + 8]; const float kp = b5 ? y[i + 8] : y[i]; r8[i] = kp + __shfl_xor(snd, 32); }
#pragma unroll
    for (int i = 0; i < 4; ++i) { const float snd = b4 ? r8[i] : r8[i + 4]; const float kp = b4 ? r8[i + 4] : r8[i]; r4[i] = kp + __shfl_xor(snd, 16); }
#pragma unroll
    for (int i = 0; i < 2; ++i) { const float snd = b3 ? r4[i] : r4[i + 2]; const float kp = b3 ? r4[i + 2] : r4[i]; r2[i] = kp + __shfl_xor(snd, 8); }
    float2 v = q.r;
    v.x += r2[0]; v.y += r2[1];
    if (final_layer) *(float2*)(p.out + (size_t)tok * DM + sl * 128 + 16 * dc + 2 * rg) = v;
    else *(u32*)(WSP(bf16_t, WS_RES) + (size_t)tok * DM + sl * 128 + 16 * dc + 2 * rg) = pack2(v.x, v.y);
}
template <bool UP>
DI void run_peer_sliced(const Params& p, int l, unsigned char* smem) {
    volatile LAS unsigned* st = (volatile LAS unsigned*)(smem + SMEM_BYTES);
    const int nloc = (int)st[0], nx = (int)st[1], rank = (int)st[2], xi = (int)st[3];
    const int tid = otid512(), lane = tid & 63, wave = tid >> 6;
    const int stride = nloc * 8;
#pragma unroll 1
    for (int sl = xi; sl < 8; sl += nx) {
        const unsigned char* tab = p.ws + (UP ? WS_UP : WS_DOWN) + (size_t)l * NEXP * DM + (size_t)sl * NEXP * 128;
        int tok = rank * 8 + wave;
        if (tok >= NTOK) continue;
        PeerPre qc = peer_prefetch<UP>(p, tok, sl, lane);
        PeerRows R;
        peer_issue_rows<0, UP>(p, tab, qc, tok, lane, R);
#pragma unroll 1
        for (; tok < NTOK; tok += stride) {
            const int tn = tok + stride < NTOK ? tok + stride : tok;
            const PeerPre qn = peer_prefetch<UP>(p, tn, sl, lane);
            float acc[16];
#pragma unroll
            for (int i = 0; i < 16; ++i) acc[i] = 0.f;
            PeerRows Rn;
            peer_issue_rows<1, UP>(p, tab, qc, tok, lane, Rn);
            __builtin_amdgcn_sched_barrier(0);
            if (UP) peer_up_half<0>(qc, R, acc); else peer_down_half<0>(qc, R, acc);
            __builtin_amdgcn_sched_barrier(0);
            peer_issue_rows<0, UP>(p, tab, qn, tn, lane, R);
            __builtin_amdgcn_sched_barrier(0);
            if (UP) { peer_up_half<1>(qc, Rn, acc); peer_up_fin(p, qc, acc, tok, sl, lane, l == 1); }
            else { peer_down_half<1>(qc, Rn, acc); peer_down_fin(p, acc, tok, sl, lane); }
            __builtin_amdgcn_sched_barrier(0);
            qc = qn;
        }
    }
}


typedef short bf16x8 __attribute__((ext_vector_type(8)));
typedef float f32x16 __attribute__((ext_vector_type(16)));
#define MFMA32(a, b, c) __builtin_amdgcn_mfma_f32_32x32x16_bf16((a), (b), (c), 0, 0, 0)
typedef short s16x4 __attribute__((ext_vector_type(4)));
DI bf16x8 pack_p(const f32x16& pt, int s) {
    uint4 o;
    o.x = pack2(pt[8 * s + 0], pt[8 * s + 1]); o.y = pack2(pt[8 * s + 2], pt[8 * s + 3]);
    o.z = pack2(pt[8 * s + 4], pt[8 * s + 5]); o.w = pack2(pt[8 * s + 6], pt[8 * s + 7]);
    return __builtin_bit_cast(bf16x8, o);
}

DI void stage_tile(const bf16_t* __restrict__ g, int ld, int row0, int k0, unsigned char* lt, int wave, int lane) {
#pragma unroll
    for (int i = 0; i < 4; ++i) {
        const int inst = wave * 4 + i;
        const int row = inst * 8 + (lane >> 3);
        const int c = (lane & 7) ^ ((row >> 1) & 7);
        __builtin_amdgcn_global_load_lds((const unsigned*)(g + (size_t)(row0 + row) * ld + k0 + c * 8),
                                         (unsigned*)(lt + inst * 1024 + lane * 16), 16, 0, 0);
    }
}
DI bf16x8 lds_frag(const unsigned char* lt, int row, int c) {
    return *(const bf16x8*)(lt + row * 128 + ((c ^ ((row >> 1) & 7)) << 4));
}
DI int crow(int r, int fh) { return (r & 3) + 8 * (r >> 2) + 4 * fh; }

namespace pg8 {
#define PG8_LAS __attribute__((address_space(3)))
typedef float f32x4 __attribute__((ext_vector_type(4)));
typedef unsigned u32x4 __attribute__((ext_vector_type(4)));
constexpr int BM = 256, BK = 64, HALF = 128, HTB = HALF * BK * 2  , STAGE_BYTES = 8 * HTB;
__host__ __device__ __forceinline__ int lds_byte(int r, int c) { const int st = (r >> 4) * 2 + (c >> 5), rr = r & 15, cc = c & 31, ob = rr * 64 + cc * 2; return st * 1024 + (ob ^ (((ob >> 9) & 1) << 5)); }
__host__ __device__ __forceinline__ void stage_rc(int b, int& R, int& C) { const int st = b / 1024, sb = b % 1024, swz = sb ^ (((sb >> 9) & 1) << 5); R = (st >> 1) * 16 + swz / 64; C = (st & 1) * 32 + (swz % 64) / 2; }
__host__ __device__ __forceinline__ int perm32(int rho) { const int n = rho >> 4, i = rho & 15; return 8 * (i >> 2) + 4 * n + (i & 3); }
struct Unit { int pm, pn; };
struct Gemm { const void* A; const void* Bt; int M, N, K; const float* rsc; const float* csc; };
struct XcdOrder {
    int ntn, nloc, nx, rank, xi, nown, total;
    __device__ __forceinline__ void init(int nmt, int ntn_, int nloc_, int nx_, int rank_, int xi_) {
        ntn = ntn_; nloc = nloc_; nx = nx_; rank = rank_; xi = xi_; nown = xi < nmt ? (nmt - xi + nx - 1) / nx : 0; total = nown * ntn; }
    __device__ __forceinline__ bool next(int i, Unit& u) const {
        const int t = rank + i * nloc; if (t >= total) return false;
        const int g4 = t / (4 * ntn), r = t - g4 * 4 * ntn;
        const int left = nown - 4 * g4, gs = left < 4 ? left : 4;
        const int nt = r / gs, mi = r - nt * gs;
        u.pm = (4 * g4 + mi) * nx + xi; u.pn = nt; return true;
    }
    __device__ __forceinline__ void a_ready(const Unit&) const {}
    __device__ __forceinline__ void done(const Unit&) const {}
};
typedef int i32x4 __attribute__((ext_vector_type(4)));
template <class Epi, class Sched, bool ALIGN_EPI = false, bool SP2 = false, bool I8 = false>
__device__ __forceinline__ void gemm_phase(PG8_LAS unsigned char* lds, const Gemm g, const Sched& S, const Epi& E) {
    const int tid = otid512(), wid = __builtin_amdgcn_readfirstlane(tid >> 6), lane = tid & 63, wr = wid >> 2, wc = wid & 3, fr = lane & 15, fq = lane >> 4;
    const int K = g.K, KB = I8 ? K : 2 * K  , nt = KB / (BK * 2);
    unsigned voffA[2], voffB[2];
#pragma unroll
    for (int i = 0; i < 2; ++i) { int R, C; stage_rc(tid * 16 + i * 8192, R, C); const int Rb = Epi::PERM ? ((R & ~31) + perm32(R & 31)) : R;
        voffA[i] = (unsigned)(R * KB + C * 2); voffB[i] = (unsigned)(Rb * KB + C * 2); }
    const size_t kstep = (size_t)(BK * 2);
    const size_t hstep = (size_t)HALF * KB;
    const size_t tstep = 2 * hstep;
    const unsigned ldsw = (unsigned)wid * 1024u;
    const int aoff = lds_byte(wr * 64 + fr, fq * 8), boff = lds_byte(wc * 32 + fr, fq * 8);
#define PG8_SA(b, h) (((b) * 2 + (h)) * HTB)
#define PG8_SB(b, h) ((4 + (b) * 2 + (h)) * HTB)
#define PG8_STAGE(bufoff, gbase, voff) do { _Pragma("unroll") for (int _i = 0; _i < 2; ++_i) \
        __builtin_amdgcn_global_load_lds((const unsigned*)((const char*)(gbase) + (voff)[_i]), (PG8_LAS unsigned*)(lds + (bufoff) + ldsw + _i * 8192), 16, 0, 0); } while (0)
#define PG8_LDA(dst, b, h) do { _Pragma("unroll") for (int m = 0; m < 4; ++m) _Pragma("unroll") for (int k = 0; k < 2; ++k) dst[m][k] = *(const PG8_LAS bf16x8*)(lds + PG8_SA(b, h) + aoff + m * 2048 + k * 1024); } while (0)
#define PG8_LDB(dst, b, h) do { _Pragma("unroll") for (int n = 0; n < 2; ++n) _Pragma("unroll") for (int k = 0; k < 2; ++k) dst[n][k] = *(const PG8_LAS bf16x8*)(lds + PG8_SB(b, h) + boff + n * 2048 + k * 1024); } while (0)
#define PG8_MMA(ai, bj, At, Bt) do { __builtin_amdgcn_s_setprio(1); _Pragma("unroll") for (int m = 0; m < 4; ++m) _Pragma("unroll") for (int n = 0; n < 2; ++n) _Pragma("unroll") for (int k = 0; k < 2; ++k) \
        { if constexpr (I8) acc[ai][bj][m][n] = __builtin_bit_cast(f32x4, __builtin_amdgcn_mfma_i32_16x16x64_i8(__builtin_bit_cast(i32x4, Bt[n][k]), __builtin_bit_cast(i32x4, At[m][k]), __builtin_bit_cast(i32x4, acc[ai][bj][m][n]), 0, 0, 0)); \
          else acc[ai][bj][m][n] = __builtin_amdgcn_mfma_f32_16x16x32_bf16(Bt[n][k], At[m][k], acc[ai][bj][m][n], 0, 0, 0); } __builtin_amdgcn_s_setprio(0); } while (0)
#define PG8_WAIT_V(n) asm volatile("s_waitcnt vmcnt(" #n ")" ::: "memory")
#define PG8_WAIT_L(n) asm volatile("s_waitcnt lgkmcnt(" #n ")" ::: "memory")
#define PG8_BAR __builtin_amdgcn_s_barrier()
#define PG8_SCHED __builtin_amdgcn_sched_barrier(0)
    Unit cur, nxt; int ui = 0;
    if (!S.next(0, cur)) return;
    f32x4 acc[2][2][4][2];
#pragma unroll
    for (int a = 0; a < 2; ++a)
#pragma unroll
        for (int b = 0; b < 2; ++b)
#pragma unroll
            for (int m = 0; m < 4; ++m)
#pragma unroll
                for (int n = 0; n < 2; ++n) acc[a][b][m][n] = (f32x4){0.f, 0.f, 0.f, 0.f};
    bf16x8 At[4][2], B0[2][2], B1[2][2];
    const char* cA = (const char*)g.A + (size_t)cur.pm * tstep; const char* cB = (const char*)g.Bt + (size_t)cur.pn * tstep;
    S.a_ready(cur);
    if constexpr (SP2) {
        PG8_STAGE(PG8_SB(0, 0), cB, voffB); PG8_STAGE(PG8_SB(0, 1), cB + hstep, voffB); PG8_STAGE(PG8_SA(0, 0), cA, voffA); PG8_STAGE(PG8_SA(0, 1), cA + hstep, voffA);
        if (wr == 1) PG8_BAR;
        PG8_WAIT_V(2); PG8_BAR;
        PG8_STAGE(PG8_SB(1, 0), cB + kstep, voffB); PG8_STAGE(PG8_SA(1, 0), cA + kstep, voffA); PG8_STAGE(PG8_SB(1, 1), cB + hstep + kstep, voffB);
        PG8_WAIT_V(6); PG8_BAR;
    } else {
        PG8_STAGE(PG8_SB(0, 0), cB, voffB); PG8_STAGE(PG8_SA(0, 0), cA, voffA); PG8_STAGE(PG8_SB(0, 1), cB + hstep, voffB); PG8_STAGE(PG8_SA(0, 1), cA + hstep, voffA);
        if (wr == 1) PG8_BAR;
        PG8_WAIT_V(4); PG8_BAR;
        PG8_STAGE(PG8_SB(1, 0), cB + kstep, voffB); PG8_STAGE(PG8_SA(1, 0), cA + kstep, voffA); PG8_STAGE(PG8_SB(1, 1), cB + hstep + kstep, voffB);
        PG8_WAIT_V(6); PG8_BAR;
    }
    for (;;) {
        const bool has_next = S.next(ui + 1, nxt);
        const char* nA = has_next ? (const char*)g.A + (size_t)nxt.pm * tstep : cA; const char* nB = has_next ? (const char*)g.Bt + (size_t)nxt.pn * tstep : cB;
        for (int t = 0; t < nt; t += 2) {
            const bool last = (t == nt - 2);
            const char* a1 = cA + (size_t)(t + 1) * kstep;
            const char* a2 = last ? nA : cA + (size_t)(t + 2) * kstep; const char* b2 = last ? nB : cB + (size_t)(t + 2) * kstep;
            const char* a3 = a2 + kstep; const char* b3 = b2 + kstep;
            if (last && has_next) S.a_ready(nxt);
            if constexpr (SP2) {
            PG8_LDB(B0, 0, 0); PG8_LDB(B1, 0, 1); PG8_SCHED; PG8_LDA(At, 0, 0); PG8_STAGE(PG8_SA(1, 1), a1 + hstep, voffA);
            PG8_WAIT_V(8); PG8_WAIT_L(0); PG8_BAR; PG8_MMA(0, 0, At, B0); PG8_MMA(0, 1, At, B1); PG8_BAR; PG8_SCHED;
            PG8_LDA(At, 0, 1); PG8_STAGE(PG8_SB(0, 0), b2, voffB); PG8_STAGE(PG8_SB(0, 1), b2 + hstep, voffB); PG8_STAGE(PG8_SA(0, 0), a2, voffA);
            PG8_WAIT_V(8); PG8_WAIT_L(0); PG8_BAR; PG8_MMA(1, 0, At, B0); PG8_MMA(1, 1, At, B1); PG8_BAR; PG8_SCHED;
            PG8_LDB(B0, 1, 0); PG8_LDB(B1, 1, 1); PG8_SCHED; PG8_LDA(At, 1, 0); PG8_STAGE(PG8_SA(0, 1), a2 + hstep, voffA);
            PG8_WAIT_V(8); PG8_WAIT_L(0); PG8_BAR; PG8_MMA(0, 0, At, B0); PG8_MMA(0, 1, At, B1); PG8_BAR; PG8_SCHED;
            PG8_LDA(At, 1, 1); PG8_STAGE(PG8_SB(1, 0), b3, voffB); PG8_STAGE(PG8_SB(1, 1), b3 + hstep, voffB); PG8_STAGE(PG8_SA(1, 0), a3, voffA);
            PG8_WAIT_V(8); PG8_WAIT_L(0); PG8_BAR; PG8_MMA(1, 0, At, B0); PG8_MMA(1, 1, At, B1); PG8_BAR; PG8_SCHED;
            } else {
            PG8_LDB(B0, 0, 0); PG8_SCHED; PG8_LDA(At, 0, 0); PG8_STAGE(PG8_SA(1, 1), a1 + hstep, voffA);
            PG8_WAIT_L(8); PG8_BAR; PG8_WAIT_L(0); PG8_MMA(0, 0, At, B0); PG8_BAR; PG8_SCHED;
            PG8_LDB(B1, 0, 1); PG8_STAGE(PG8_SB(0, 0), b2, voffB);
            PG8_BAR; PG8_WAIT_L(0); PG8_MMA(0, 1, At, B1); PG8_BAR;
            PG8_LDA(At, 0, 1); PG8_STAGE(PG8_SA(0, 0), a2, voffA);
            PG8_BAR; PG8_WAIT_L(0); PG8_MMA(1, 0, At, B0); PG8_BAR; PG8_SCHED;
            PG8_STAGE(PG8_SB(0, 1), b2 + hstep, voffB);
            PG8_WAIT_V(6); PG8_BAR; PG8_MMA(1, 1, At, B1); PG8_BAR;
            PG8_LDB(B0, 1, 0); PG8_SCHED; PG8_LDA(At, 1, 0); PG8_STAGE(PG8_SA(0, 1), a2 + hstep, voffA);
            PG8_WAIT_L(8); PG8_BAR; PG8_WAIT_L(0); PG8_MMA(0, 0, At, B0); PG8_BAR; PG8_SCHED;
            PG8_LDB(B1, 1, 1); PG8_STAGE(PG8_SB(1, 0), b3, voffB);
            PG8_BAR; PG8_WAIT_L(0); PG8_MMA(0, 1, At, B1); PG8_BAR;
            PG8_LDA(At, 1, 1); PG8_STAGE(PG8_SA(1, 0), a3, voffA);
            PG8_BAR; PG8_WAIT_L(0); PG8_MMA(1, 0, At, B0); PG8_BAR; PG8_SCHED;
            PG8_STAGE(PG8_SB(1, 1), b3 + hstep, voffB);
            PG8_WAIT_V(6); PG8_BAR; PG8_MMA(1, 1, At, B1); PG8_BAR;
            }
        }
        if constexpr (ALIGN_EPI) { if (wr == 0) PG8_BAR; }
        if constexpr (I8) {
#pragma unroll
            for (int b = 0; b < 2; ++b) {
                const float* cp = g.csc + cur.pn * BM + b * HALF + wc * 32 + 8 * fq;
                const f32x4 c0 = *(const f32x4*)cp, c1 = *(const f32x4*)(cp + 4);
#pragma unroll
                for (int a = 0; a < 2; ++a)
#pragma unroll
                    for (int m = 0; m < 4; ++m) {
                        const float xs = g.rsc[cur.pm * BM + a * HALF + wr * 64 + m * 16 + fr];
                        acc[a][b][m][0] = __builtin_convertvector(__builtin_bit_cast(i32x4, acc[a][b][m][0]), f32x4) * c0 * xs;
                        acc[a][b][m][1] = __builtin_convertvector(__builtin_bit_cast(i32x4, acc[a][b][m][1]), f32x4) * c1 * xs;
                    }
            }
        }
        if constexpr (!Epi::AFTER_DRAIN) { E(acc, cur, wr, wc, fr, fq); S.done(cur); }
        if (!has_next) break;
#pragma unroll
        for (int a = 0; a < 2; ++a)
#pragma unroll
            for (int b = 0; b < 2; ++b)
#pragma unroll
                for (int m = 0; m < 4; ++m)
#pragma unroll
                    for (int n = 0; n < 2; ++n) acc[a][b][m][n] = (f32x4){0.f, 0.f, 0.f, 0.f};
        cur = nxt; cA = nA; cB = nB; ++ui;
        if constexpr (ALIGN_EPI) { if (wr == 1) PG8_BAR; }
    }
    PG8_WAIT_V(0);
    if constexpr (!ALIGN_EPI) { if (wr == 0) PG8_BAR; }
    PG8_BAR;
    if constexpr (Epi::AFTER_DRAIN) { E.fused(acc, cur, wr, wc, fr, fq, lds, wid, lane); S.done(cur); }
#undef PG8_SA
#undef PG8_SB
#undef PG8_STAGE
#undef PG8_LDA
#undef PG8_LDB
#undef PG8_MMA
#undef PG8_WAIT_V
#undef PG8_WAIT_L
#undef PG8_BAR
#undef PG8_SCHED
}
template <bool RES_BF16>
struct EpiResid {
    static constexpr bool PERM = true, AFTER_DRAIN = false;
    const void* resid; bf16_t* out;
    __device__ __forceinline__ void operator()(const f32x4 (&acc)[2][2][4][2], const Unit& u, int wr, int wc, int fr, int fq) const {
        const size_t base = (size_t)(u.pm * BM + wr * 64 + fr) * DM + u.pn * BM + wc * 32 + 8 * fq;
#pragma unroll
        for (int ai = 0; ai < 2; ++ai) {
            f32x4 rv[4][2][2];
#pragma unroll
            for (int m = 0; m < 4; ++m)
#pragma unroll
                for (int bj = 0; bj < 2; ++bj) {
                    const size_t o = base + (size_t)(ai * HALF + m * 16) * DM + bj * HALF;
                    if constexpr (RES_BF16) {
                        const u32x4 w = *(const u32x4*)((const bf16_t*)resid + o);
                        rv[m][bj][0] = (f32x4){__uint_as_float(w.x << 16), __uint_as_float(w.x & 0xffff0000u), __uint_as_float(w.y << 16), __uint_as_float(w.y & 0xffff0000u)};
                        rv[m][bj][1] = (f32x4){__uint_as_float(w.z << 16), __uint_as_float(w.z & 0xffff0000u), __uint_as_float(w.w << 16), __uint_as_float(w.w & 0xffff0000u)};
                    } else { const float* rp = (const float*)resid + o; rv[m][bj][0] = *(const f32x4*)rp; rv[m][bj][1] = *(const f32x4*)(rp + 4); }
                }
            asm volatile("" ::: "memory");
#pragma unroll
            for (int m = 0; m < 4; ++m)
#pragma unroll
                for (int bj = 0; bj < 2; ++bj) {
                    const f32x4 a = rv[m][bj][0] + acc[ai][bj][m][0], b = rv[m][bj][1] + acc[ai][bj][m][1];
                    u32x4 w; w.x = pack2(a[0], a[1]); w.y = pack2(a[2], a[3]); w.z = pack2(b[0], b[1]); w.w = pack2(b[2], b[3]);
                    *(u32x4*)(out + base + (size_t)(ai * HALF + m * 16) * DM + bj * HALF) = w;
                }
            asm volatile("" ::: "memory");
        }
    }
};
struct EpiProj {
    static constexpr bool PERM = true, AFTER_DRAIN = false;
    const float* aq; const float* ak; const float* bq; const float* bk; bf16_t* proj; PG8_LAS float* xs;
    __device__ __forceinline__ void operator()(const f32x4 (&acc)[2][2][4][2], const Unit& u, int wr, int wc, int fr, int fq) const {
        const int wave = wr * 4 + wc;
#pragma unroll
        for (int ai = 0; ai < 2; ++ai)
#pragma unroll
            for (int m = 0; m < 4; ++m)
#pragma unroll
                for (int bj = 0; bj < 2; ++bj) {
                    const f32x4 a = acc[ai][bj][m][0], b = acc[ai][bj][m][1];
                    float t = a[0] * a[0] + a[1] * a[1] + a[2] * a[2] + a[3] * a[3] + b[0] * b[0] + b[1] * b[1] + b[2] * b[2] + b[3] * b[3];
                    t += __shfl_xor(t, 16); t += __shfl_xor(t, 32);
                    if (fq == 0) xs[wave * 256 + ((ai * 4 + m) * 2 + bj) * 16 + fr] = t;
                }
        asm volatile("s_waitcnt lgkmcnt(0)" ::: "memory");
        __builtin_amdgcn_s_barrier();
#pragma unroll
        for (int bj = 0; bj < 2; ++bj) {
            const int gcol = u.pn * BM + bj * HALF + wc * 32 + 8 * fq;
            const float* gain = nullptr; float scale = 1.f;
            if (gcol < 512) { gain = aq + (gcol & 63); scale = 0.125f; }
            else if (gcol < 1024) gain = ak + (gcol & 63);
            else if (gcol < 1536) gain = nullptr;
            else if (gcol < 2048) { gain = bq + (gcol & 127); scale = 0.125f; }
            else if (gcol < 2560) gain = bk + (gcol & 127);
            f32x4 g0 = {1.f, 1.f, 1.f, 1.f}, g1 = {1.f, 1.f, 1.f, 1.f};
            if (gain) { g0 = *(const f32x4*)gain; g1 = *(const f32x4*)(gain + 4); }
#pragma unroll
            for (int ai = 0; ai < 2; ++ai)
#pragma unroll
                for (int m = 0; m < 4; ++m) {
                    float sc = 1.f;
                    if (gain) {
                        const int slot = ((ai * 4 + m) * 2 + bj) * 16 + fr;
                        sc = rsqrtf((xs[wave * 256 + slot] + xs[(wave ^ 1) * 256 + slot]) * (1.f / 64.f) + EPSN) * scale;
                    }
                    const f32x4 v0 = acc[ai][bj][m][0] * g0 * sc, v1 = acc[ai][bj][m][1] * g1 * sc;
                    u32x4 w; w.x = pack2(v0[0], v0[1]); w.y = pack2(v0[2], v0[3]); w.z = pack2(v1[0], v1[1]); w.w = pack2(v1[2], v1[3]);
                    *(u32x4*)(proj + (size_t)(u.pm * BM + ai * HALF + wr * 64 + m * 16 + fr) * ATT_IN + gcol) = w;
                }
        }
    }
};
struct EpiSgu {
    static constexpr bool PERM = true, AFTER_DRAIN = false;
    bf16_t* zu; bf16_t* zvt; float* ssq; PG8_LAS unsigned char* stg;
    __device__ __forceinline__ void operator()(const f32x4 (&acc)[2][2][4][2], const Unit& u, int wr, int wc, int fr, int fq) const {
        const int wave = wr * 4 + wc, lane = fq * 16 + fr;
        PG8_LAS unsigned short* tl = (PG8_LAS unsigned short*)(stg + wave * 2048);
#pragma unroll
        for (int ai = 0; ai < 2; ++ai)
#pragma unroll
            for (int bj = 0; bj < 2; ++bj) {
                const int gcol = u.pn * BM + bj * HALF + wc * 32 + 8 * fq;
                f32x4 g0[4], g1[4];
#pragma unroll
                for (int m = 0; m < 4; ++m) {
                    const f32x4 a = acc[ai][bj][m][0], b = acc[ai][bj][m][1];
                    g0[m] = (f32x4){gelu_tanh(a[0]), gelu_tanh(a[1]), gelu_tanh(a[2]), gelu_tanh(a[3])};
                    g1[m] = (f32x4){gelu_tanh(b[0]), gelu_tanh(b[1]), gelu_tanh(b[2]), gelu_tanh(b[3])};
                }
                if (gcol < CW) {
#pragma unroll
                    for (int m = 0; m < 4; ++m) {
                        u32x4 w; w.x = pack2(g0[m][0], g0[m][1]); w.y = pack2(g0[m][2], g0[m][3]); w.z = pack2(g1[m][0], g1[m][1]); w.w = pack2(g1[m][2], g1[m][3]);
                        *(u32x4*)(zu + (size_t)(u.pm * BM + ai * HALF + wr * 64 + m * 16 + fr) * CW + gcol) = w;
                    }
                } else {
                    const int vcol = gcol - CW;
#pragma unroll
                    for (int m = 0; m < 4; ++m) {
                        float t = g0[m][0] * g0[m][0] + g0[m][1] * g0[m][1] + g0[m][2] * g0[m][2] + g0[m][3] * g0[m][3]
                                + g1[m][0] * g1[m][0] + g1[m][1] * g1[m][1] + g1[m][2] * g1[m][2] + g1[m][3] * g1[m][3];
                        t += __shfl_xor(t, 16); t += __shfl_xor(t, 32);
                        if (fq == 0) ssq[(size_t)(u.pm * BM + ai * HALF + wr * 64 + m * 16 + fr) * 64 + (vcol >> 5)] = t;
                    }
#pragma unroll
                    for (int h = 0; h < 2; ++h) {
#pragma unroll
                        for (int mm = 0; mm < 2; ++mm) {
                            const int m = 2 * h + mm, rl = 16 * mm + fr;
#pragma unroll
                            for (int j = 0; j < 4; ++j) { tl[(8 * fq + j) * 32 + rl] = f2bf(g0[m][j]); tl[(8 * fq + 4 + j) * 32 + rl] = f2bf(g1[m][j]); }
                        }
                        const int c = lane >> 1, hh = lane & 1;
                        const u32x4 w0 = *(const PG8_LAS u32x4*)(tl + c * 32 + hh * 16), w1 = *(const PG8_LAS u32x4*)(tl + c * 32 + hh * 16 + 8);
                        bf16_t* dst = zvt + ((size_t)(2 * u.pm + ai) * CW + (u.pn * BM - CW) + bj * HALF + wc * 32 + c) * 128 + wr * 64 + 32 * h + hh * 16;
                        *(u32x4*)dst = w0; *(u32x4*)(dst + 8) = w1;
                        asm volatile("" ::: "memory");
                    }
                }
            }
    }
};
struct EpiQ {
    static constexpr bool PERM = true, AFTER_DRAIN = false;
    bf16_t* q;
    __device__ __forceinline__ void operator()(const f32x4 (&acc)[2][2][4][2], const Unit& u, int wr, int wc, int fr, int fq) const {
#pragma unroll
        for (int ai = 0; ai < 2; ++ai)
#pragma unroll
            for (int m = 0; m < 4; ++m)
#pragma unroll
                for (int bj = 0; bj < 2; ++bj) {
                    const f32x4 a = acc[ai][bj][m][0], b = acc[ai][bj][m][1];
                    u32x4 w; w.x = pack2(a[0], a[1]); w.y = pack2(a[2], a[3]); w.z = pack2(b[0], b[1]); w.w = pack2(b[2], b[3]);
                    *(u32x4*)(q + (size_t)(u.pm * BM + ai * HALF + wr * 64 + m * 16 + fr) * 2048 + u.pn * BM + bj * HALF + wc * 32 + 8 * fq) = w;
                }
    }
};
}
DI void run_gemmq_pg8(const Params& p, int l, unsigned char* smem) {
    volatile LAS unsigned* st = (volatile LAS unsigned*)(smem + SMEM_BYTES);
    pg8::XcdOrder S; S.init(NTOK / 256, 2048 / 256, (int)st[0], (int)st[1], (int)st[2], (int)st[3]);
    const pg8::Gemm g{WSP(signed char, WS_XQ), WSP(signed char, WS_W_PQ) + (size_t)l * 2048 * DM, NTOK, 2048, DM, WSP(float, WS_XSC), WSP(float, WS_WQS) + l * 2048};
    pg8::EpiQ E; E.q = WSP(bf16_t, WS_QBUF);
    __syncthreads();
    pg8::gemm_phase<pg8::EpiQ, pg8::XcdOrder, true, true, true>((PG8_LAS unsigned char*)smem, g, S, E);
}
template <int WHICH>
DI void run_gemm_pg8(const Params& p, unsigned char* smem) {
    volatile LAS unsigned* st = (volatile LAS unsigned*)(smem + SMEM_BYTES);
    pg8::XcdOrder S; S.init(NTOK / 256, DM / 256, (int)st[0], (int)st[1], (int)st[2], (int)st[3]);
    pg8::Gemm g;
    pg8::EpiResid<WHICH == 1> E; E.out = WSP(bf16_t, WS_RES);
    if (WHICH == 0) { g = pg8::Gemm{WSP(bf16_t, WS_MIXED), WSP(bf16_t, WS_W_ATTOUT), NTOK, DM, DM, nullptr, nullptr}; E.resid = p.in[0]; }
    else { g = pg8::Gemm{WSP(bf16_t, WS_Z_U), WSP(bf16_t, WS_W_SGUOUT), NTOK, DM, CW, nullptr, nullptr}; E.resid = WSP(bf16_t, WS_RES); }
    __syncthreads();
    pg8::gemm_phase<pg8::EpiResid<WHICH == 1>, pg8::XcdOrder, true, true>((PG8_LAS unsigned char*)smem, g, S, E);
}

DI void run_gemm1_pg8(const Params& p, unsigned char* smem) {
    volatile LAS unsigned* st = (volatile LAS unsigned*)(smem + SMEM_BYTES);
    pg8::XcdOrder S; S.init(NTOK / 256, ATT_IN / 256, (int)st[0], (int)st[1], (int)st[2], (int)st[3]);
    const pg8::Gemm g{WSP(signed char, WS_XQ), WSP(signed char, WS_W_ATTIN), NTOK, ATT_IN, DM, WSP(float, WS_XSC), WSP(float, WS_WAS)};
    pg8::EpiProj E; E.aq = p.in[3]; E.ak = p.in[4]; E.bq = p.in[5]; E.bk = p.in[6]; E.proj = WSP(bf16_t, WS_PROJ); E.xs = (PG8_LAS float*)(smem + PG8_EXTRA);
    __syncthreads();
    pg8::gemm_phase<pg8::EpiProj, pg8::XcdOrder, true, true, true>((PG8_LAS unsigned char*)smem, g, S, E);
}
DI void run_gemm4_pg8(const Params& p, unsigned char* smem) {
    volatile LAS unsigned* st = (volatile LAS unsigned*)(smem + SMEM_BYTES);
    pg8::XcdOrder S; S.init(NTOK / 256, 4096 / 256, (int)st[0], (int)st[1], (int)st[2], (int)st[3]);
    const pg8::Gemm g{WSP(signed char, WS_XQ), WSP(signed char, WS_W_SGUIN), NTOK, 4096, DM, WSP(float, WS_XSC), WSP(float, WS_WSS)};
    pg8::EpiSgu E; E.zu = WSP(bf16_t, WS_Z_U); E.zvt = WSP(bf16_t, WS_Z_VT); E.ssq = WSP(float, WS_SSQ); E.stg = (PG8_LAS unsigned char*)(smem + PG8_EXTRA);
    __syncthreads();
    pg8::gemm_phase<pg8::EpiSgu, pg8::XcdOrder, true, true, true>((PG8_LAS unsigned char*)smem, g, S, E);
}

DI u32 cand_key(float s, int ci) { return (f2ord(s) & ~255u) | (u32)(255 - ci); }
template <int P>
DI void score_half(const bf16x8 (&qf)[8], const unsigned char* skl, int fr, int fh, u32 (&lst)[16]) {
#pragma unroll
    for (int j = 0; j < 16; ++j) lst[j] = 0u;
#pragma unroll 1
    for (int kt = 0; kt < 4; ++kt) {
        f32x16 st;
#pragma unroll
        for (int r = 0; r < 16; ++r) st[r] = 0.f;
        const int row = P * 128 + kt * 32 + fr;
        const unsigned char* skr = skl + row * 256;
#pragma unroll
        for (int ks = 0; ks < 8; ++ks) st = MFMA32(*(const bf16x8*)(skr + (((2 * ks + fh) ^ (row & 15)) << 4)), qf[ks], st);
        u32 ks_[16];
#pragma unroll
        for (int r = 0; r < 16; ++r) ks_[r] = (f2ord(st[r]) & ~127u) | (u32)(127 - (kt * 32 + crow(r, fh)));
        sort16_desc(ks_);
        if (kt == 0) {
#pragma unroll
            for (int j = 0; j < 16; ++j) lst[j] = ks_[j];
        } else merge16_desc(lst, ks_);
    }
    u32 other[16];
#pragma unroll
    for (int j = 0; j < 16; ++j) other[j] = (u32)__shfl_xor((int)lst[j], 32);
    merge16_desc(lst, other);
}
DI void run_score(const Params& p, int l, unsigned char* smem) {
    const int tid = otid512(), wave = tid >> 6, lane = tid & 63, fr = lane & 31, fh = lane >> 5;
    int cur_h = -1;
    bf16x8 qa[8], qb[8];
    if ((int)blockIdx.x < 8 * (NTOK / 256)) {
        const int it0 = blockIdx.x;
        const bf16_t* q0 = WSP(bf16_t, WS_QBUF) + (size_t)((it0 >> 3) * 256 + wave * 32 + fr) * 2048 + (it0 & 7) * 256 + 8 * fh;
#pragma unroll
        for (int ks = 0; ks < 8; ++ks) { qa[ks] = *(const bf16x8*)(q0 + 16 * ks); qb[ks] = *(const bf16x8*)(q0 + 128 + 16 * ks); }
    }
#pragma unroll 1
    for (int it = blockIdx.x; it < 8 * (NTOK / 256); it += gridDim.x) {
    const int h = it & 7, oct = it >> 3;
    if (h != cur_h) {
        __syncthreads();
        const bf16_t* skg = WSP(bf16_t, WS_W_SUBK) + ((size_t)l * 16 + h * 2) * 128 * 128;
#pragma unroll
        for (int i = 0; i < 8; ++i) {
            const int idx = wave * 8 + i;
            const int row = 4 * idx + (lane >> 4), cp = lane & 15;
            __builtin_amdgcn_global_load_lds((const unsigned*)(skg + (size_t)row * 128 + ((cp ^ (row & 15)) << 3)), (unsigned*)(smem + idx * 1024 + lane * 16), 16, 0, 0);
        }
        asm volatile("s_waitcnt vmcnt(0)" ::: "memory");
        __syncthreads();
        cur_h = h;
    }
    const int tok = oct * 256 + wave * 32 + fr;
    const unsigned char* skh = smem;
    u32 L0[16], L1[16];
    score_half<0>(qa, skh, fr, fh, L0);
    score_half<1>(qb, skh, fr, fh, L1);
    {
        const int itn = it + gridDim.x < 8 * (NTOK / 256) ? it + gridDim.x : it;
        const bf16_t* qn = WSP(bf16_t, WS_QBUF) + (size_t)((itn >> 3) * 256 + wave * 32 + fr) * 2048 + (itn & 7) * 256 + 8 * fh;
#pragma unroll
        for (int ks = 0; ks < 8; ++ks) { qa[ks] = *(const bf16x8*)(qn + 16 * ks); qb[ks] = *(const bf16x8*)(qn + 128 + 16 * ks); }
    }
    LAS int* slot = (LAS int*)(smem + 65536 + wave * (64 * 132)) + lane * 33;
    float s1[16], s2[16];
#pragma unroll
    for (int j = 0; j < 16; ++j) {
        s1[j] = ord2f(L0[j] & ~127u); s2[j] = ord2f(L1[j] & ~127u);
        slot[j] = 127 - (int)(L0[j] & 127u); slot[16 + j] = 127 - (int)(L1[j] & 127u);
    }
    u32 lst[16];
#pragma unroll
    for (int j = 0; j < 16; ++j) lst[j] = cand_key(s1[0] + s2[j], j);
#pragma unroll
    for (int i = 1; i < 5; ++i) {
        u32 row[16];
#pragma unroll
        for (int j = 0; j < 16; ++j) row[j] = ((i + 1) * (j + 1) <= 16) ? cand_key(s1[i] + s2[j], i * 16 + j) : 0u;
        merge16_desc(lst, row);
    }
#pragma unroll
    for (int i = 5; i < 16; ++i)
#pragma unroll
        for (int j = 0; j < 2; ++j)
            if ((i + 1) * (j + 1) <= 16) top16_insert(lst, cand_key(s1[i] + s2[j], i * 16 + j));
    float pv[16]; float sum = 0.f;
    const float mx = ord2f(lst[0] & ~255u);
#pragma unroll
    for (int j = 0; j < 16; ++j) { pv[j] = __expf(ord2f(lst[j] & ~255u) - mx); sum += pv[j]; }
    const float inv = 1.f / sum;
    int ev[16];
#pragma unroll
    for (int j = 0; j < 16; ++j) {
        const int ci = 255 - (int)(lst[j] & 255u);
        ev[j] = slot[ci >> 4] * 128 + slot[16 + (ci & 15)];
    }
    if (fh == 0) {
        uint4* ro = (uint4*)(WSP(unsigned short, WS_RIDX) + (size_t)tok * 128 + h * 16);
        float4* go = (float4*)(WSP(float, WS_RG) + (size_t)tok * 128 + h * 16);
#pragma unroll
        for (int q = 0; q < 2; ++q)
            ro[q] = make_uint4((u32)ev[8 * q] | ((u32)ev[8 * q + 1] << 16), (u32)ev[8 * q + 2] | ((u32)ev[8 * q + 3] << 16),
                               (u32)ev[8 * q + 4] | ((u32)ev[8 * q + 5] << 16), (u32)ev[8 * q + 6] | ((u32)ev[8 * q + 7] << 16));
#pragma unroll
        for (int q = 0; q < 4; ++q) go[q] = make_float4(pv[4 * q] * inv, pv[4 * q + 1] * inv, pv[4 * q + 2] * inv, pv[4 * q + 3] * inv);
    }
    }
}


#define OSM_THR 8.0f
DI void osm_update(f32x16& s, unsigned vm, float& m, float& lh, float& alpha) {
    float mx = -1e30f;
#pragma unroll
    for (int r = 0; r < 16; ++r) mx = ((vm >> r) & 1u) ? fmaxf(mx, s[r]) : mx;
    mx = fmaxf(mx, __shfl_xor(mx, 32));
    float mn = m; alpha = 1.f;
    if (!__all(mx <= m + OSM_THR)) { mn = fmaxf(m, mx); alpha = __expf(m - mn); }
    float ls = 0.f;
#pragma unroll
    for (int r = 0; r < 16; ++r) { const float pe = ((vm >> r) & 1u) ? __expf(s[r] - mn) : 0.f; s[r] = pe; ls += pe; }
    lh = lh * alpha + ls; m = mn;
}
DI void osm_update_full(f32x16& s, float& m, float& lh, float& alpha) {
    float mx = s[0];
#pragma unroll
    for (int r = 1; r < 16; ++r) mx = fmaxf(mx, s[r]);
    mx = fmaxf(mx, __shfl_xor(mx, 32));
    float mn = m; alpha = 1.f;
    if (!__all(mx <= m + OSM_THR)) { mn = fmaxf(m, mx); alpha = __expf(m - mn); }
    float ls = 0.f;
#pragma unroll
    for (int r = 0; r < 16; ++r) { const float pe = __expf(s[r] - mn); s[r] = pe; ls += pe; }
    lh = lh * alpha + ls; m = mn;
}
DI void tr_quad(const unsigned (&a)[4], unsigned hi_off, bf16x8 (&f)[4]) {
    s16x4 l0, h0, l1, h1, l2, h2, l3, h3;
    const unsigned b0 = a[0] + hi_off, b1 = a[1] + hi_off, b2 = a[2] + hi_off, b3 = a[3] + hi_off;
    asm volatile("ds_read_b64_tr_b16 %0, %8\n\tds_read_b64_tr_b16 %1, %9\n\tds_read_b64_tr_b16 %2, %10\n\tds_read_b64_tr_b16 %3, %11\n\t"
                 "ds_read_b64_tr_b16 %4, %12\n\tds_read_b64_tr_b16 %5, %13\n\tds_read_b64_tr_b16 %6, %14\n\tds_read_b64_tr_b16 %7, %15\n\ts_waitcnt lgkmcnt(0)"
                 : "=&v"(l0), "=&v"(h0), "=&v"(l1), "=&v"(h1), "=&v"(l2), "=&v"(h2), "=&v"(l3), "=&v"(h3)
                 : "v"(a[0]), "v"(b0), "v"(a[1]), "v"(b1), "v"(a[2]), "v"(b2), "v"(a[3]), "v"(b3) : "memory");
    f[0] = __builtin_shufflevector(l0, h0, 0, 1, 2, 3, 4, 5, 6, 7); f[1] = __builtin_shufflevector(l1, h1, 0, 1, 2, 3, 4, 5, 6, 7);
    f[2] = __builtin_shufflevector(l2, h2, 0, 1, 2, 3, 4, 5, 6, 7); f[3] = __builtin_shufflevector(l3, h3, 0, 1, 2, 3, 4, 5, 6, 7);
}

#define QB_BYTES (128 * 256)
#define KB_BYTES (32 * 256)
template <bool WITH_V>
DI void attnB_stage_kv(const bf16_t* __restrict__ kg  , unsigned char* Kd, unsigned char* Vd, int wave, int lane) {
#pragma unroll
    for (int i = 0; i < 2; ++i) {
        const int idx = wave * 2 + i;
        const int key = 4 * idx + (lane >> 4), cp = lane & 15;
        const bf16_t* g = kg + (size_t)key * ATT_IN;
        __builtin_amdgcn_global_load_lds((const unsigned*)(g + ((cp ^ (key & 15)) << 3)), (unsigned*)(Kd + idx * 1024 + lane * 16), 16, 0, 0);
        if (WITH_V) {
            const int cv = ((((cp >> 2) ^ (key & 3)) << 2) | (cp & 3));
            __builtin_amdgcn_global_load_lds((const unsigned*)(g + 512 + (cv << 3)), (unsigned*)(Vd + idx * 1024 + lane * 16), 16, 0, 0);
        }
    }
}
template <int KOFF, bool FULL>
DI void attnB_map(const unsigned char* Kc, const unsigned char* qlp, int ksw, int qsw, int fh, unsigned vm, unsigned vc, int tq,
                  float& m, float& l, f32x16 (&o)[4]) {
    f32x16 st;
#pragma unroll
    for (int r = 0; r < 16; ++r) st[r] = 0.f;
#pragma unroll
    for (int s = 0; s < 4; ++s) {
        const bf16x8 kf = *(const bf16x8*)(Kc + (((KOFF + 2 * s + fh) ^ ksw) << 4));
        const bf16x8 qf = *(const bf16x8*)(qlp + (((KOFF + 2 * s + fh) ^ qsw) << 4));
        st = MFMA32(kf, qf, st);
    }
    float al;
    if (FULL) osm_update_full(st, m, l, al); else osm_update(st, vm, m, l, al);
    if (!__all(al == 1.f)) {
#pragma unroll
        for (int d = 0; d < 4; ++d)
#pragma unroll
            for (int r = 0; r < 16; ++r) o[d][r] *= al;
    }
#pragma unroll
    for (int s = 0; s < 2; ++s) {
        const bf16x8 pf = pack_p(st, s);
        unsigned va[4]; bf16x8 vf[4];
#pragma unroll
        for (int d = 0; d < 4; ++d) va[d] = vc + s * 16 * 256 + ((d ^ tq) << 6);
        tr_quad(va, 8 * 256, vf);
#pragma unroll
        for (int d = 0; d < 4; ++d) o[d] = MFMA32(vf[d], pf, o[d]);
    }
}
DI void ph_attnB_fast(const Params& p, int item, unsigned char* smem) {
    const bf16_t* proj = WSP(bf16_t, WS_PROJ);
    const int tid = otid(), wave = tid >> 6, lane = tid & 63, fr = lane & 31, fh = lane >> 5;
    const int qt = 15 - (item >> 6), bh = item & 63, b = bh >> 2, h = bh & 3;
    const int q0 = qt * 128;
    const float lam = compute_lam(p, lane);
    const size_t rowbase = (size_t)b * SEQ;
    const int qrow = wave * 32 + fr, qpos = q0 + qrow;
    unsigned char* Ql = smem;
    unsigned char* Kl = smem + QB_BYTES;
    unsigned char* Vl = Kl + 2 * KB_BYTES;
    const bf16_t* kbase = proj + rowbase * ATT_IN + 2048 + h * 128;
    __syncthreads();
#pragma unroll
    for (int i = 0; i < 8; ++i) {
        const int idx = wave * 8 + i;
        const int row = 4 * idx + (lane >> 4), cp = lane & 15;
        __builtin_amdgcn_global_load_lds((const unsigned*)(proj + (rowbase + q0 + row) * ATT_IN + 1536 + h * 128 + ((cp ^ (row & 15)) << 3)),
                                         (unsigned*)(Ql + idx * 1024 + lane * 16), 16, 0, 0);
    }
    attnB_stage_kv<true>(kbase, Kl, Vl, wave, lane);
    const unsigned char* qlp = Ql + qrow * 256;
    const int qsw = qrow & 15, ksw = fr & 15;
    const int nkt = (q0 + 128) / 32;
    const int wlast = q0 + wave * 32 + 31;
    f32x16 o1[4], o2[4];
#pragma unroll
    for (int d = 0; d < 4; ++d)
#pragma unroll
        for (int r = 0; r < 16; ++r) { o1[d][r] = 0.f; o2[d][r] = 0.f; }
    float m1 = -1e30f, m2 = -1e30f, l1 = 0.f, l2 = 0.f;
    const int tq = (lane & 15) >> 2;
    const unsigned vrow = (unsigned)(uintptr_t)Vl + (4 * fh + tq) * 256 + (16 * ((lane >> 4) & 1) + 4 * (lane & 3)) * 2;
    asm volatile("s_waitcnt vmcnt(0)" ::: "memory");
    __syncthreads();
    for (int kt = 0; kt < nkt; ++kt) {
        const int cur = kt & 1;
        if (kt + 1 < nkt) attnB_stage_kv<true>(kbase + (size_t)(kt + 1) * 32 * ATT_IN, Kl + (cur ^ 1) * KB_BYTES, Vl + (cur ^ 1) * KB_BYTES, wave, lane);
        if (kt * 32 <= wlast) {
            const unsigned char* Kc = Kl + cur * KB_BYTES + fr * 256;
            const unsigned vc = vrow + cur * KB_BYTES;
            if (kt * 32 + 31 <= wlast - 31) {
                attnB_map<0, true>(Kc, qlp, ksw, qsw, fh, 0xffffu, vc, tq, m1, l1, o1);
                __builtin_amdgcn_sched_barrier(0);
                attnB_map<8, true>(Kc, qlp, ksw, qsw, fh, 0xffffu, vc, tq, m2, l2, o2);
            } else {
                unsigned vm = 0;
#pragma unroll
                for (int r = 0; r < 16; ++r) vm |= ((kt * 32 + crow(r, fh)) <= qpos) ? (1u << r) : 0u;
                attnB_map<0, false>(Kc, qlp, ksw, qsw, fh, vm, vc, tq, m1, l1, o1);
                __builtin_amdgcn_sched_barrier(0);
                attnB_map<8, false>(Kc, qlp, ksw, qsw, fh, vm, vc, tq, m2, l2, o2);
            }
        }
        asm volatile("s_waitcnt vmcnt(0)" ::: "memory");
        __syncthreads();
    }
    l1 += __shfl_xor(l1, 32); l2 += __shfl_xor(l2, 32);
    const float i1 = 1.f / l1, i2 = lam / l2;
    float ss = 0.f;
#pragma unroll
    for (int d = 0; d < 4; ++d)
#pragma unroll
        for (int r = 0; r < 16; ++r) { const float v = o1[d][r] * i1 - o2[d][r] * i2; o1[d][r] = v; ss += v * v; }
    ss += __shfl_xor(ss, 32);
    const float rinv = rsqrtf(ss * (1.f / 128.f) + EPSN) * 0.8f;
    const float* subg = p.in[11];
    bf16_t* op = WSP(bf16_t, WS_MIXED) + (rowbase + qpos) * DM + 512 + h * 128;
#pragma unroll
    for (int d = 0; d < 4; ++d)
#pragma unroll
        for (int g = 0; g < 4; ++g) {
            const int dim = 32 * d + 8 * g + 4 * fh;
            const float4 gg = *(const float4*)(subg + dim);
            uint2 w;
            w.x = pack2(o1[d][4 * g + 0] * rinv * gg.x, o1[d][4 * g + 1] * rinv * gg.y);
            w.y = pack2(o1[d][4 * g + 2] * rinv * gg.z, o1[d][4 * g + 3] * rinv * gg.w);
            *(uint2*)(op + dim) = w;
        }
}

#define KA_PITCH 128
#define VA_PITCH 192
#define WA_BYTES (32 * KA_PITCH + 32 * VA_PITCH)
template <int MODE>
DI void ph_attnA_fast(const Params& p, int item, unsigned char* smem) {
    const bf16_t* proj = WSP(bf16_t, WS_PROJ);
    const int tid = otid(), wave = tid >> 6, lane = tid & 63, fr = lane & 31, fh = lane >> 5;
    const int c = item & 15, h = (item >> 4) & 7, b = item >> 7;
    const size_t rowbase = (size_t)b * SEQ;
    const int qpos = MODE == 0 ? 128 * c + 32 * wave + fr : 16 * (32 * wave + fr) + c;
    const int pmin = MODE == 0 ? 128 * c + 32 * wave : 512 * wave + c, pmax = pmin + (MODE == 0 ? 31 : 496);
    bf16x8 qf[4];
    {
        const bf16_t* qp = proj + (rowbase + qpos) * ATT_IN + h * 64 + 8 * fh;
#pragma unroll
        for (int s = 0; s < 4; ++s) qf[s] = *(const bf16x8*)(qp + 16 * s);
    }
    f32x16 o[2];
#pragma unroll
    for (int d = 0; d < 2; ++d)
#pragma unroll
        for (int r = 0; r < 16; ++r) o[d][r] = 0.f;
    float m = -1e30f, l = 0.f;
    unsigned char* Kl = smem + wave * WA_BYTES;
    unsigned char* Vl = Kl + 32 * KA_PITCH;
    const unsigned vaddr = (unsigned)(uintptr_t)Vl + (4 * fh + ((lane & 15) >> 2)) * VA_PITCH + (16 * ((lane >> 4) & 1) + 4 * (lane & 3)) * 2;
    const int skey = lane >> 3, sc = lane & 7;
    int br = 0, d = MODE == 0 ? 1 : 16, W = MODE == 0 ? 128 : 2048, cls = MODE == 0 ? 0 : (c & 15);
    int j0 = MODE == 0 ? (pmin < 128 ? 0 : pmin - 128) : 0, jhi = MODE == 0 ? pmax : ((pmax - cls) >> 4);
    const bf16_t* kvbase = proj + rowbase * ATT_IN + 512 + h * 64 + sc * 8;
    uint4 rk0, rk1, rk2, rk3, rv0, rv1, rv2, rv3;
#define A_LOAD(i, RK, RV) do { int kp_ = cls + d * (j0 + skey + 8 * (i)); kp_ = kp_ > SEQ - 1 ? SEQ - 1 : kp_; kp_ = kp_ < 0 ? 0 : kp_; \
        const bf16_t* g_ = kvbase + (size_t)kp_ * ATT_IN; RK = *(const uint4*)g_; RV = *(const uint4*)(g_ + 512); } while (0)
#define A_WRITE(i, RK, RV) do { const int key_ = skey + 8 * (i); *(uint4*)(Kl + key_ * KA_PITCH + ((sc ^ ((key_ >> 1) & 7)) << 4)) = RK; \
        *(uint4*)(Vl + key_ * VA_PITCH + sc * 16) = RV; } while (0)
    A_LOAD(0, rk0, rv0); A_LOAD(1, rk1, rv1); A_LOAD(2, rk2, rv2); A_LOAD(3, rk3, rv3);
#pragma unroll 1
    for (;;) {
        A_WRITE(0, rk0, rv0); A_WRITE(1, rk1, rv1); A_WRITE(2, rk2, rv2); A_WRITE(3, rk3, rv3);
        const int cd = d, cW = W, ccls = cls, cj0 = j0;
        bool more = true;
        j0 += 32;
        if (j0 > jhi) {
            ++br;
            if (MODE == 0 || br == 2) more = false;
            else {
                d = 4; W = 512; cls = c & 3;
                const int lo = pmin - cls - W;
                j0 = lo < 0 ? 0 : lo >> 2;
                jhi = (pmax - cls) >> 2;
            }
        }
        A_LOAD(0, rk0, rv0); A_LOAD(1, rk1, rv1); A_LOAD(2, rk2, rv2); A_LOAD(3, rk3, rv3);
        f32x16 st;
#pragma unroll
        for (int r = 0; r < 16; ++r) st[r] = 0.f;
#pragma unroll
        for (int s = 0; s < 4; ++s) {
            const bf16x8 kf = *(const bf16x8*)(Kl + fr * KA_PITCH + (((2 * s + fh) ^ ((fr >> 1) & 7)) << 4));
            st = MFMA32(kf, qf[s], st);
        }
        float al;
        const int kfirst = ccls + cd * cj0, klast = kfirst + cd * 31;
        if (klast <= pmin && pmax - kfirst <= cW) osm_update_full(st, m, l, al);
        else {
            unsigned vm = 0;
#pragma unroll
            for (int r = 0; r < 16; ++r) {
                const int dist = qpos - (ccls + cd * (cj0 + crow(r, fh)));
                vm |= (dist >= 0 && dist <= cW) ? (1u << r) : 0u;
            }
            osm_update(st, vm, m, l, al);
        }
        if (!__all(al == 1.f)) {
#pragma unroll
            for (int dd = 0; dd < 2; ++dd)
#pragma unroll
                for (int r = 0; r < 16; ++r) o[dd][r] *= al;
        }
        {
            unsigned va[4]; bf16x8 vf[4];
            va[0] = vaddr; va[1] = vaddr + 64; va[2] = vaddr + 16 * VA_PITCH; va[3] = vaddr + 16 * VA_PITCH + 64;
            tr_quad(va, 8 * VA_PITCH, vf);
            const bf16x8 p0 = pack_p(st, 0), p1 = pack_p(st, 1);
            o[0] = MFMA32(vf[0], p0, o[0]); o[1] = MFMA32(vf[1], p0, o[1]);
            o[0] = MFMA32(vf[2], p1, o[0]); o[1] = MFMA32(vf[3], p1, o[1]);
        }
        if (!more) break;
    }
    l += __shfl_xor(l, 32);
    bf16_t* op = WSP(bf16_t, WS_MIXED) + (rowbase + qpos) * DM + h * 64;
    float* lsep = WSP(float, WS_LSE1) + (rowbase + qpos) * 8 + h;
    if (MODE == 0) {
        const float il = 1.f / l;
        if (fh == 0) *lsep = m + __logf(l);
#pragma unroll
        for (int dd = 0; dd < 2; ++dd)
#pragma unroll
            for (int g = 0; g < 4; ++g) {
                const int dim = 32 * dd + 8 * g + 4 * fh;
                uint2 w;
                w.x = pack2(o[dd][4 * g + 0] * il, o[dd][4 * g + 1] * il);
                w.y = pack2(o[dd][4 * g + 2] * il, o[dd][4 * g + 3] * il);
                *(uint2*)(op + dim) = w;
            }
    } else {
        const float lse1 = *lsep;
        const float M = fmaxf(m, lse1);
        const float w23 = __expf(m - M), w1 = __expf(lse1 - M);
        const float iden = 1.f / (l * w23 + w1);
        const float a23 = w23 * iden, a1 = w1 * iden;
        uint2 prev[2][4];
#pragma unroll
        for (int dd = 0; dd < 2; ++dd)
#pragma unroll
            for (int g = 0; g < 4; ++g) prev[dd][g] = *(const uint2*)(op + 32 * dd + 8 * g + 4 * fh);
#pragma unroll
        for (int dd = 0; dd < 2; ++dd)
#pragma unroll
            for (int g = 0; g < 4; ++g) {
                const int dim = 32 * dd + 8 * g + 4 * fh;
                const float p0 = __uint_as_float(prev[dd][g].x << 16), p1 = __uint_as_float(prev[dd][g].x & 0xffff0000u);
                const float p2 = __uint_as_float(prev[dd][g].y << 16), p3 = __uint_as_float(prev[dd][g].y & 0xffff0000u);
                uint2 w;
                w.x = pack2(o[dd][4 * g + 0] * a23 + p0 * a1, o[dd][4 * g + 1] * a23 + p1 * a1);
                w.y = pack2(o[dd][4 * g + 2] * a23 + p2 * a1, o[dd][4 * g + 3] * a23 + p3 * a1);
                *(uint2*)(op + dim) = w;
            }
    }
}
#define NITEM_B 1024
#define NITEM_A 2048
DI void ph_attn_fast(const Params& p, int vb, unsigned char* smem) {
    if (vb < NITEM_B) {
        const int item = vb < 512 ? vb : 512 + (1023 - vb);
        ph_attnB_fast(p, item, smem);
    } else ph_attnA_fast<0>(p, vb - NITEM_B, smem);
}


DI void ph_spatial_fast(const Params& p, int item, unsigned char* smem) {
    const int tid = otid(), wave = tid >> 6, lane = tid & 63, fr = lane & 31, fh = lane >> 5;
    const int wm = wave >> 1, wn = wave & 1;
    const int chunk = item >> 3, g = item & 7;
    bf16_t* u = WSP(bf16_t, WS_Z_U);
    const bf16_t* vt = WSP(bf16_t, WS_Z_VT);
    const float* ssq = WSP(float, WS_SSQ);
    const float* wsp = p.in[16] + (size_t)g * 128 * 128;
    float* rinv = (float*)(smem + 66 * 1024);
    unsigned char* Bt = smem + 32768;
    __syncthreads();
    if (tid < 128) {
        const float4* sp = (const float4*)(ssq + (size_t)(chunk * 128 + tid) * 64);
        float sacc = 0.f;
#pragma unroll
        for (int j = 0; j < 16; ++j) { const float4 q = sp[j]; sacc += (q.x + q.y) + (q.z + q.w); }
        rinv[tid] = rsqrtf(sacc * (1.f / CW) + EPSN);
    }
    const size_t vrow0 = (size_t)chunk * CW + g * 256;
    stage_tile(vt, 128, (int)vrow0, 0, Bt, wave, lane);
    stage_tile(vt, 128, (int)vrow0, 64, Bt + 16384, wave, lane);
    __syncthreads();
#pragma unroll
    for (int i = 0; i < 8; ++i) {
        const int id = tid + 256 * i;
        const int t = id >> 4, sc = id & 15;
        const float4 w0 = *(const float4*)(wsp + t * 128 + sc * 8);
        const float4 w1 = *(const float4*)(wsp + t * 128 + sc * 8 + 4);
        const float4 r0 = *(const float4*)(rinv + sc * 8);
        const float4 r1 = *(const float4*)(rinv + sc * 8 + 4);
        const int s0 = sc * 8;
        uint4 o;
        o.x = pack2(s0 + 0 <= t ? w0.x * r0.x : 0.f, s0 + 1 <= t ? w0.y * r0.y : 0.f);
        o.y = pack2(s0 + 2 <= t ? w0.z * r0.z : 0.f, s0 + 3 <= t ? w0.w * r0.w : 0.f);
        o.z = pack2(s0 + 4 <= t ? w1.x * r1.x : 0.f, s0 + 5 <= t ? w1.y * r1.y : 0.f);
        o.w = pack2(s0 + 6 <= t ? w1.z * r1.z : 0.f, s0 + 7 <= t ? w1.w * r1.w : 0.f);
        const int kt = sc >> 3, c = sc & 7;
        *(uint4*)(smem + kt * 16384 + t * 128 + ((c ^ ((t >> 1) & 7)) << 4)) = o;
    }
#pragma unroll 1
    for (int nt = 0; nt < 2; ++nt) {
        asm volatile("s_waitcnt vmcnt(0)" ::: "memory");
        __syncthreads();
        f32x16 acc[2][2];
#pragma unroll
        for (int i = 0; i < 2; ++i)
#pragma unroll
            for (int j = 0; j < 2; ++j)
#pragma unroll
                for (int r = 0; r < 16; ++r) acc[i][j][r] = 0.f;
#pragma unroll
        for (int kt = 0; kt < 2; ++kt)
#pragma unroll
            for (int s = 0; s < 4; ++s) {
                bf16x8 a[2], b[2];
#pragma unroll
                for (int i = 0; i < 2; ++i) {
                    a[i] = lds_frag(smem + kt * 16384, wm * 64 + i * 32 + fr, 2 * s + fh);
                    b[i] = lds_frag(Bt + kt * 16384, wn * 64 + i * 32 + fr, 2 * s + fh);
                }
#pragma unroll
                for (int i = 0; i < 2; ++i)
#pragma unroll
                    for (int j = 0; j < 2; ++j) acc[i][j] = MFMA32(a[i], b[j], acc[i][j]);
            }
        __syncthreads();
        float* st = (float*)(Bt + wave * (32 * 65 * 4));
#pragma unroll
        for (int i = 0; i < 2; ++i) {
#pragma unroll
            for (int j = 0; j < 2; ++j)
#pragma unroll
                for (int r = 0; r < 16; ++r) st[crow(r, fh) * 65 + j * 32 + fr] = acc[i][j][r];
            const int t = wm * 64 + i * 32 + fr;
            const int c0 = g * 256 + nt * 128 + wn * 64 + fh * 32;
            bf16_t* up = u + (size_t)(chunk * 128 + t) * CW + c0;
            const float bias = p.in[17][g * 128 + t];
            const float* gn = p.in[15] + c0;
            uint4 ur[4];
#pragma unroll
            for (int q = 0; q < 4; ++q) ur[q] = ((const uint4*)up)[q];
#pragma unroll
            for (int q = 0; q < 4; ++q) {
                float uf[8]; unpack8(ur[q], uf);
                const float4 g0 = *(const float4*)(gn + 8 * q), g1 = *(const float4*)(gn + 8 * q + 4);
                const float gg[8] = {g0.x, g0.y, g0.z, g0.w, g1.x, g1.y, g1.z, g1.w};
                float ov[8];
#pragma unroll
                for (int e = 0; e < 8; ++e) ov[e] = uf[e] * (st[fr * 65 + fh * 32 + 8 * q + e] * gg[e] + bias);
                uint4 o; o.x = pack2(ov[0], ov[1]); o.y = pack2(ov[2], ov[3]); o.z = pack2(ov[4], ov[5]); o.w = pack2(ov[6], ov[7]);
                ((uint4*)up)[q] = o;
            }
        }
        if (nt == 0) {
            __syncthreads();
            stage_tile(vt, 128, (int)vrow0 + 128, 0, Bt, wave, lane);
            stage_tile(vt, 128, (int)vrow0 + 128, 64, Bt + 16384, wave, lane);
        }
    }
}

#define XB_TMO      128
#define XB_XCNT(j)  (256  + 64 * (j))
#define XB_XSUB(j)  (1280 + 64 * (j))
#define XB_XGEN(j)  (2304 + 64 * (j))
#define XB_TOP      3328
#define XB_TOPGEN   3392
#define XCD_BAR_WORDS 3456
#define XB_SPIN_CAP (1u << 22)
DI unsigned xb_ld(unsigned* p) { return __hip_atomic_load(p, __ATOMIC_RELAXED, __HIP_MEMORY_SCOPE_AGENT); }
DI unsigned xb_add(unsigned* p, unsigned v) { return __hip_atomic_fetch_add(p, v, __ATOMIC_RELAXED, __HIP_MEMORY_SCOPE_AGENT); }
DI unsigned xb_xcc_id() { return (unsigned)__builtin_amdgcn_s_getreg((3 << 11) | 20) & 0xFu; }
#define XB_SPIN(cond, bar) do { unsigned _sp = 0; while (cond) { __builtin_amdgcn_s_sleep(1); \
    if ((++_sp & 255u) == 0u) { if (xb_ld(&(bar)[XB_TMO])) break; if (_sp > XB_SPIN_CAP) { atomicAdd(&(bar)[XB_TMO], 1u); break; } } } } while (0)
struct XcdBarrier { unsigned* bar; unsigned x; volatile LAS unsigned* st; };
DI XcdBarrier xcd_barrier_post(unsigned* bar, volatile LAS unsigned* st) {
    XcdBarrier b; b.bar = bar; b.x = xb_xcc_id(); b.st = st;
    if (threadIdx.x == 0) st[2] = xb_add(&bar[XB_XCNT(b.x)], 1u);
    return b;
}
DI void xcd_barrier_complete(unsigned* bar, unsigned x, unsigned& nloc, unsigned& nx, unsigned& xi) {
    const unsigned G = gridDim.x * gridDim.y * gridDim.z;
    unsigned sum, cnt, mine, below, sp = 0u;
    for (;;) {
        sum = 0u; cnt = 0u; mine = 0u; below = 0u;
#pragma unroll
        for (unsigned j = 0; j < 16; ++j) { const unsigned c = xb_ld(&bar[XB_XCNT(j)]); sum += c; cnt += (c > 0u) ? 1u : 0u; mine = (j == x) ? c : mine; below += (c > 0u && j < x) ? 1u : 0u; }
        if (sum == G) break;
        __builtin_amdgcn_s_sleep(1);
        if ((++sp & 255u) == 0u) { if (xb_ld(&bar[XB_TMO])) break; if (sp > XB_SPIN_CAP) { atomicAdd(&bar[XB_TMO], 1u); break; } }
    }
    nloc = mine > 0u ? mine : 1u; nx = cnt > 0u ? cnt : 1u; xi = below;
}
DI void xcd_barrier(const XcdBarrier& b) {
    asm volatile("s_waitcnt vmcnt(0)" ::: "memory");
    __syncthreads();
    if (threadIdx.x == 0) {
        unsigned* bar = b.bar;
        __builtin_amdgcn_s_waitcnt(0);
        unsigned nloc = b.st[0], nx = b.st[1];
        if (nloc == 0u) { unsigned xi; xcd_barrier_complete(bar, b.x, nloc, nx, xi); b.st[0] = nloc; b.st[1] = nx; b.st[3] = xi; }
        const unsigned old = xb_add(&bar[XB_XSUB(b.x)], 1u);
        const unsigned gen = old / nloc;
        if (old + 1u == (gen + 1u) * nloc) {
            __builtin_amdgcn_fence(__ATOMIC_RELEASE, "agent");
            asm volatile("s_waitcnt vmcnt(0)" ::: "memory");
            const unsigned og = xb_add(&bar[XB_TOP], 1u);
            const unsigned tg = og / nx;
            if (og + 1u == (tg + 1u) * nx) xb_add(&bar[XB_TOPGEN], 1u);
            else XB_SPIN(xb_ld(&bar[XB_TOPGEN]) == tg, bar);
            __builtin_amdgcn_fence(__ATOMIC_ACQUIRE, "agent");
            xb_add(&bar[XB_XGEN(b.x)], 1u);
            asm volatile("s_waitcnt vmcnt(0)" ::: "memory");
        } else {
            XB_SPIN(xb_ld(&bar[XB_XGEN(b.x)]) == gen, bar);
            __builtin_amdgcn_fence(__ATOMIC_ACQUIRE, "agent");
            asm volatile("s_waitcnt vmcnt(0)" ::: "memory");
        }
    }
    __syncthreads();
}

enum { PH_PREP = 0, PH_GEMM1, PH_ATTN, PH_ATTN2, PH_GEMM2,
       PH_NORM_P0, PH_GEMMQ0, PH_SCORE0, PH_PDOWN0, PH_PCOMB0, PH_PUP0, PH_NORM_SGU,
       PH_GEMM4, PH_SPATIAL, PH_GEMM5,
       PH_NORM_P1, PH_GEMMQ1, PH_SCORE1, PH_PDOWN1, PH_PCOMB1, PH_PUP1, PH_COUNT };

__host__ __device__ constexpr int phase_nvb(int ph) {
    switch (ph) {
        case PH_PREP: return PREP_N;
        case PH_GEMM1: return (ATT_IN / 256) * (NTOK / 256);
        case PH_ATTN: return NITEM_B + NITEM_A;
        case PH_ATTN2: return NITEM_A;
        case PH_GEMM2: return (DM / 256) * (NTOK / 256);
        case PH_NORM_P0: case PH_NORM_P1: case PH_NORM_SGU: return NTOK / 16;
        case PH_GEMMQ0: case PH_GEMMQ1: return 16 * (NTOK / 256);
        case PH_SCORE0: case PH_SCORE1: return (NTOK / 32) * 8 / 4;
        case PH_PCOMB0: case PH_PCOMB1: return NTOK / 8;
        case PH_GEMM4: return (4096 / 256) * (NTOK / 256);
        case PH_SPATIAL: return 256 * 8;
        case PH_GEMM5: return (DM / 256) * (NTOK / 256);
    }
    return 0;
}

template <int PH>
DI void run_vb(const Params& p, int vb, unsigned char* smem) {
    if constexpr (PH == PH_PREP) ph_prep(p, vb, smem);
    else if constexpr (PH == PH_ATTN) ph_attn_fast(p, vb, smem);
    else if constexpr (PH == PH_ATTN2) ph_attnA_fast<1>(p, vb, smem);
    else if constexpr (PH == PH_NORM_P0 || PH == PH_NORM_P1) rmsnorm_rows<true, 4>(WSP(bf16_t, WS_RES), p.in[19] + (PH == PH_NORM_P1 ? DM : 0), vb, WSP(signed char, WS_XQ), WSP(float, WS_XSC));
    else if constexpr (PH == PH_PCOMB0 || PH == PH_PCOMB1) ph_peer_comb(p, vb, PH == PH_PCOMB1 ? 1 : 0);
    else if constexpr (PH == PH_NORM_SGU) rmsnorm_rows<true, 4>(WSP(bf16_t, WS_RES), p.in[13], vb, WSP(signed char, WS_XQ), WSP(float, WS_XSC));
    else if constexpr (PH == PH_SPATIAL) ph_spatial_fast(p, vb, smem);
}

template <int PH>
DI void run_phase(const Params& p, unsigned char* smem) {
    if constexpr (PH == PH_PDOWN0 || PH == PH_PDOWN1) run_peer_sliced<false>(p, PH == PH_PDOWN1 ? 1 : 0, smem);
    else if constexpr (PH == PH_PUP0 || PH == PH_PUP1) run_peer_sliced<true>(p, PH == PH_PUP1 ? 1 : 0, smem);
    else if constexpr (PH == PH_SCORE0 || PH == PH_SCORE1) run_score(p, PH == PH_SCORE1 ? 1 : 0, smem);
    else if constexpr (PH == PH_GEMMQ0 || PH == PH_GEMMQ1) run_gemmq_pg8(p, PH == PH_GEMMQ1 ? 1 : 0, smem);
    else if constexpr (PH == PH_GEMM1) run_gemm1_pg8(p, smem);
    else if constexpr (PH == PH_GEMM4) run_gemm4_pg8(p, smem);
    else if constexpr (PH == PH_GEMM2) run_gemm_pg8<0>(p, smem);
    else if constexpr (PH == PH_GEMM5) run_gemm_pg8<1>(p, smem);
    else {
        constexpr int nvb = phase_nvb(PH);
        const int g = threadIdx.x >> 8;
        for (int vb = 2 * blockIdx.x; vb < nvb; vb += 2 * gridDim.x)
            if (vb + g < nvb) run_vb<PH>(p, vb + g, smem + g * GROUP_SMEM);
    }
}

template <int PH>
DI void run_from(const Params& p, unsigned char* smem, cg::grid_group& grid, const XcdBarrier& xb) {
    run_phase<PH>(p, smem);
    if constexpr (PH + 1 < PH_COUNT) {
        if constexpr (PH == 1) grid.sync(); else xcd_barrier(xb);
        run_from<PH + 1>(p, smem, grid, xb);
    }
}

__global__ void __launch_bounds__(NTHREADS, 2) k_mega(Params p) {
    extern __shared__ __attribute__((aligned(16))) unsigned char smem[];
    cg::grid_group grid = cg::this_grid();
    volatile LAS unsigned* st = (volatile LAS unsigned*)(smem + SMEM_BYTES);
    if (threadIdx.x == 0) { st[0] = 0u; st[1] = 0u; st[2] = 0u; st[3] = 0u; }
    __syncthreads();
    const XcdBarrier xb = xcd_barrier_post((unsigned*)(p.ws + WS_CTL), st);
    run_from<0>(p, smem, grid, xb);
}


extern "C" void kernel_launch(void* const* d_in, const int* in_sizes, int n_in, void* d_out, int out_size, void* d_ws, size_t ws_size, hipStream_t stream) {
    if (n_in != 24 || ws_size < WS_NEED || in_sizes[0] != NTOK * DM || out_size != NTOK * DM || in_sizes[22] != 2 * NEXP * DM) {
        fprintf(stderr, "kernel_launch: built for x[16,2048,1024] with 24 inputs and >= 512 MiB of workspace; got n_in %d, in0 %d, out %d, ws %zu: nothing launched\n", n_in, in_sizes[0], out_size, ws_size); return; }
    static int grid_blocks = 0;
    if (!grid_blocks) {
        int dev = 0, cus = 0, per_cu = 0;
        (void)hipGetDevice(&dev);
        (void)hipDeviceGetAttribute(&cus, hipDeviceAttributeMultiprocessorCount, dev);
        (void)hipFuncSetAttribute((const void*)k_mega, hipFuncAttributeMaxDynamicSharedMemorySize, SMEM_ALLOC);
        (void)hipOccupancyMaxActiveBlocksPerMultiprocessor(&per_cu, (const void*)k_mega, NTHREADS, SMEM_ALLOC);
        if (per_cu > 1) per_cu = 1;
        if (per_cu < 1) { fprintf(stderr, "kernel_launch: occupancy query returned %d\n", per_cu); per_cu = 1; }
        grid_blocks = cus * per_cu;
    }
    Params p{};
    for (int i = 0; i < 24; ++i) p.in[i] = (const float*)d_in[i];
    p.out = (float*)d_out;
    p.ws = (unsigned char*)d_ws;
    void* args[] = {&p};
    if (hipMemsetAsync((unsigned char*)d_ws + WS_CTL, 0, XCD_BAR_WORDS * 4, stream) != hipSuccess) { fprintf(stderr, "kernel_launch: memset of the barrier words failed\n"); return; }
    hipError_t e = hipLaunchCooperativeKernel((const void*)k_mega, dim3(grid_blocks), dim3(NTHREADS), args, SMEM_ALLOC, stream);
    if (e != hipSuccess) fprintf(stderr, "cooperative launch failed: %s (grid %d)\n", hipGetErrorString(e), grid_blocks);
}
```

```cpp
#include <hip/hip_runtime.h>
#include <stdint.h>
#include <stdio.h>

#define NTOK   32768
#define DM     1024
#define SEQ    2048
#define NB     16
#define ATT_IN 3072
#define CW     2048
#define NEXP   16384
#define EPSN   1e-6f

typedef unsigned short bf16_t;
typedef unsigned int u32;

#define DI __device__ __forceinline__
#define LAS __attribute__((address_space(3)))

DI int otid() { int t = threadIdx.x & 255; asm volatile("" : "+v"(t)); return t; }
DI int otid512() { int t = threadIdx.x; asm volatile("" : "+v"(t)); return t; }
DI float bf2f(bf16_t v) { return __uint_as_float(((u32)v) << 16); }
typedef __bf16 bf16v2 __attribute__((ext_vector_type(2)));
DI bf16_t f2bf(float f) { const __bf16 h = (__bf16)f; return __builtin_bit_cast(bf16_t, h); }
DI u32 pack2(float lo, float hi) { bf16v2 v; v[0] = (__bf16)lo; v[1] = (__bf16)hi; return __builtin_bit_cast(u32, v); }
DI float gelu_tanh(float x) {
    const float y = 0.7978845608028654f * (x + 0.044715f * x * x * x);
    const float e = __expf(2.f * y);
    const float t = 1.f - 2.f / (e + 1.f);
    return 0.5f * x * (1.f + t);
}
DI float wave_sum(float v) {
#pragma unroll
    for (int o = 1; o < 64; o <<= 1) v += __shfl_xor(v, o);
    return v;
}
DI float wave_max(float v) {
#pragma unroll
    for (int o = 1; o < 64; o <<= 1) v = fmaxf(v, __shfl_xor(v, o));
    return v;
}
DI u32 f2ord(float f) { u32 u = __float_as_uint(f); return (u & 0x80000000u) ? ~u : (u | 0x80000000u); }
DI float ord2f(u32 o) { u32 u = (o & 0x80000000u) ? (o & 0x7fffffffu) : ~o; return __uint_as_float(u); }

#define MiB ((size_t)1 << 20)
#define WS_CTL      ((size_t)0)
#define WS_W_ATTIN  (1 * MiB)
#define WS_W_ATTOUT (7 * MiB)
#define WS_W_SGUIN  (9 * MiB)
#define WS_W_SGUOUT (17 * MiB)
#define WS_W_PQ     (21 * MiB)
#define WS_WQS      (25 * MiB)
#define WS_WAS      (25 * MiB + 64 * 1024)
#define WS_WSS      (25 * MiB + 128 * 1024)
#define WS_W_SUBK   (29 * MiB)
#define WS_DOWN     (32 * MiB)
#define WS_UP       (64 * MiB)
#define WS_DSC      (96 * MiB)
#define WS_USC      (96 * MiB + 128 * 1024)
#define WS_LSE1     (30 * MiB)
#define WS_XQ       (100 * MiB)
#define WS_XSC      (132 * MiB)
#define WS_RES      (160 * MiB)
#define WS_BIG      (224 * MiB)
#define WS_PROJ     (WS_BIG)
#define WS_MIXED    (WS_BIG + 192 * MiB)
#define WS_Z_U      (WS_BIG)
#define WS_Z_VT     (WS_BIG + 128 * MiB)
#define WS_RIDX     (WS_BIG + 32 * MiB)
#define WS_COEF     (WS_BIG + 40 * MiB)
#define WS_RG       (WS_BIG + 48 * MiB)
#define WS_QBUF     (WS_BIG + 64 * MiB)
#define WS_SSQ      (WS_BIG + 256 * MiB)
#define WS_NEED     (512 * MiB)

struct Params {
    const float* in[24];
    float* out;
    unsigned char* ws;
};

#include <hip/hip_cooperative_groups.h>
namespace cg = cooperative_groups;

#define GROUP_SMEM (68 * 1024)
#define PG8_EXTRA (128 * 1024)
#define SMEM_BYTES (144 * 1024)
#define SMEM_ALLOC (SMEM_BYTES + 16)
#define NTHREADS 512

#define WSP(T, off) ((T*)(p.ws + (off)))


DI void transpose_tile(const float* __restrict__ W, bf16_t* __restrict__ Wt, int K, int N, int t, unsigned char* smem) {
    float* tile = (float*)smem;
    const int tid = otid();
    const int ntn = N / 64;
    const int n0 = (t % ntn) * 64, k0 = (t / ntn) * 64;
    __syncthreads();
    {
        const int n4 = tid & 15, kr = tid >> 4;
#pragma unroll
        for (int i = 0; i < 4; ++i) {
            const int k = kr + 16 * i;
            const float4 v = *(const float4*)(W + (size_t)(k0 + k) * N + n0 + 4 * n4);
            tile[k * 65 + 4 * n4 + 0] = v.x; tile[k * 65 + 4 * n4 + 1] = v.y; tile[k * 65 + 4 * n4 + 2] = v.z; tile[k * 65 + 4 * n4 + 3] = v.w;
        }
    }
    __syncthreads();
    {
        const int n = tid >> 2, kc = tid & 3;
        float v[16];
#pragma unroll
        for (int j = 0; j < 16; ++j) v[j] = tile[(16 * kc + j) * 65 + n];
        uint4 o0, o1;
        o0.x = pack2(v[0], v[1]); o0.y = pack2(v[2], v[3]); o0.z = pack2(v[4], v[5]); o0.w = pack2(v[6], v[7]);
        o1.x = pack2(v[8], v[9]); o1.y = pack2(v[10], v[11]); o1.z = pack2(v[12], v[13]); o1.w = pack2(v[14], v[15]);
        uint4* dst = (uint4*)(Wt + (size_t)(n0 + n) * K + k0 + 16 * kc);
        dst[0] = o0; dst[1] = o1;
    }
}
DI void cvt_chunk(const float* __restrict__ src, bf16_t* __restrict__ dst, int c) {
    const size_t base = (size_t)c * 2048;
#pragma unroll
    for (int i = 0; i < 8; ++i) {
        const size_t idx = base + i * 256 + otid();
        const float4 v = ((const float4*)src)[idx];
        uint2 o; o.x = pack2(v.x, v.y); o.y = pack2(v.z, v.w);
        ((uint2*)dst)[idx] = o;
    }
}
DI int q8(float v) { int i = __float2int_rn(v); i = i > 127 ? 127 : i; i = i < -127 ? -127 : i; return i & 255; }
template <bool IN_BF16, int ROWS>
DI void rmsnorm_rows(const void* __restrict__ x, const float* __restrict__ g, int vb, signed char* xq, float* xsc) {
    const int lane = otid() & 63;
    const int row0 = (vb * 4 + (otid() >> 6)) * ROWS;
    float4 v[ROWS][4];
#pragma unroll
    for (int r = 0; r < ROWS; ++r)
#pragma unroll
        for (int j = 0; j < 4; ++j) {
            if (IN_BF16) { const uint2 w = ((const uint2*)((const bf16_t*)x + (size_t)(row0 + r) * DM))[lane + 64 * j];
                v[r][j] = make_float4(__uint_as_float(w.x << 16), __uint_as_float(w.x & 0xffff0000u), __uint_as_float(w.y << 16), __uint_as_float(w.y & 0xffff0000u)); }
            else v[r][j] = ((const float4*)((const float*)x + (size_t)(row0 + r) * DM))[lane + 64 * j];
        }
    float4 gg[4];
#pragma unroll
    for (int j = 0; j < 4; ++j) gg[j] = ((const float4*)g)[lane + 64 * j];
#pragma unroll
    for (int r = 0; r < ROWS; ++r) {
        float ss = 0.f;
#pragma unroll
        for (int j = 0; j < 4; ++j) ss += v[r][j].x * v[r][j].x + v[r][j].y * v[r][j].y + v[r][j].z * v[r][j].z + v[r][j].w * v[r][j].w;
        ss = wave_sum(ss);
        const float rinv = rsqrtf(ss * (1.f / DM) + EPSN);
        float am = 0.f;
#pragma unroll
        for (int j = 0; j < 4; ++j) {
            v[r][j].x *= rinv * gg[j].x; v[r][j].y *= rinv * gg[j].y; v[r][j].z *= rinv * gg[j].z; v[r][j].w *= rinv * gg[j].w;
            am = fmaxf(am, fmaxf(fmaxf(fabsf(v[r][j].x), fabsf(v[r][j].y)), fmaxf(fabsf(v[r][j].z), fabsf(v[r][j].w))));
        }
        am = wave_max(am);
        const float sc = am > 0.f ? 127.f / am : 0.f;
        u32* qrow = (u32*)(xq + (size_t)(row0 + r) * DM);
#pragma unroll
        for (int j = 0; j < 4; ++j)
            qrow[lane + 64 * j] = (u32)q8(v[r][j].x * sc) | ((u32)q8(v[r][j].y * sc) << 8) | ((u32)q8(v[r][j].z * sc) << 16) | ((u32)q8(v[r][j].w * sc) << 24);
        if (lane == 0) xsc[row0 + r] = am * (1.f / 127.f);
    }
}
#define PREP_T0 48
#define PREP_T1 (PREP_T0 + 16 * 16)
#define PREP_T2 (PREP_T1 + 64)
#define PREP_T3 (PREP_T2 + 16 * 32)
#define PREP_T4 (PREP_T3 + 2 * 32)
#define PREP_C0 (PREP_T4 + 64)
#define PREP_C1 (PREP_C0 + 4096)
#define PREP_C2 (PREP_C1 + 4096)
#define PREP_N  (PREP_C2 + 4096)
template <bool INT8>
DI void fp8_rows(const float* __restrict__ src, unsigned char* __restrict__ dst, float* __restrict__ inv_scale, int vb) {
    const int lane = otid() & 63;
    const int row0 = (vb * 4 + (otid() >> 6)) * 2;
    float4 v[2][4];
#pragma unroll
    for (int r = 0; r < 2; ++r)
#pragma unroll
        for (int j = 0; j < 4; ++j) v[r][j] = ((const float4*)(src + (size_t)(row0 + r) * DM) + lane)[64 * j];
#pragma unroll
    for (int r = 0; r < 2; ++r) {
        const int row = row0 + r;
        float am = 0.f;
#pragma unroll
        for (int j = 0; j < 4; ++j) am = fmaxf(am, fmaxf(fmaxf(fabsf(v[r][j].x), fabsf(v[r][j].y)), fmaxf(fabsf(v[r][j].z), fabsf(v[r][j].w))));
        am = wave_max(am);
        float sc, inv;
        if (INT8) { sc = am > 0.f ? 127.f / am : 0.f; inv = am * (1.f / 127.f); }
        else {
            int e = (int)((__float_as_uint(am) >> 23) & 255u) - 127;
            if (am == 0.f) e = 0;
            e = e < -100 ? -100 : e;
            sc = __uint_as_float((u32)(127 + 7 - e) << 23); inv = __uint_as_float((u32)(127 + e - 7) << 23);
        }
        unsigned char* drow = dst + (size_t)(row >> 14) * NEXP * DM + (size_t)(row & (NEXP - 1)) * 128;
#pragma unroll
        for (int j = 0; j < 4; ++j) {
            const int dim = 4 * (lane + 64 * j);
            u32 w;
            if (INT8) w = (u32)q8(v[r][j].x * sc) | ((u32)q8(v[r][j].y * sc) << 8) | ((u32)q8(v[r][j].z * sc) << 16) | ((u32)q8(v[r][j].w * sc) << 24);
            else { int t = __builtin_amdgcn_cvt_pk_fp8_f32(v[r][j].x * sc, v[r][j].y * sc, 0, false); t = __builtin_amdgcn_cvt_pk_fp8_f32(v[r][j].z * sc, v[r][j].w * sc, t, true); w = (u32)t; }
            *(u32*)(drow + (size_t)(dim >> 7) * NEXP * 128 + (dim & 127)) = w;
        }
        if (lane == 0) inv_scale[row] = inv;
    }
}
DI void wq8_item(const float* __restrict__ W, signed char* __restrict__ Wt, float* __restrict__ wsc, int t, unsigned char* smem, int N) {
    float* red = (float*)smem;
    const int tid = otid(), n = tid & 63, kq = tid >> 6;
    const float* col = W + t * 64 + n;
    float am = 0.f;
#pragma unroll 16
    for (int k = 0; k < 256; ++k) am = fmaxf(am, fabsf(col[(size_t)(kq * 256 + k) * N]));
    __syncthreads();
    red[kq * 64 + n] = am;
    __syncthreads();
    am = fmaxf(fmaxf(red[n], red[64 + n]), fmaxf(red[128 + n], red[192 + n]));
    const float sc = am > 0.f ? 127.f / am : 0.f;
    if (kq == 0) wsc[t * 64 + n] = am * (1.f / 127.f);
    signed char* drow = Wt + (size_t)(t * 64 + n) * 1024;
#pragma unroll 1
    for (int kb = 0; kb < 16; ++kb) {
        const int k0 = kb * 64 + kq * 16;
        u32 w[4];
#pragma unroll
        for (int j = 0; j < 4; ++j) {
            const float* c4 = col + (size_t)(k0 + 4 * j) * N;
            w[j] = (u32)q8(c4[0] * sc) | ((u32)q8(c4[N] * sc) << 8) | ((u32)q8(c4[2 * N] * sc) << 16) | ((u32)q8(c4[3 * N] * sc) << 24);
        }
        *(uint4*)(drow + k0) = make_uint4(w[0], w[1], w[2], w[3]);
    }
}
DI void ph_prep(const Params& p, int vb, unsigned char* smem) {
    if (vb < PREP_T0) wq8_item(p.in[2], WSP(signed char, WS_W_ATTIN), WSP(float, WS_WAS), vb, smem, ATT_IN);
    else if (vb < PREP_T1) transpose_tile(p.in[12], WSP(bf16_t, WS_W_ATTOUT), DM, DM, vb - PREP_T0, smem);
    else if (vb < PREP_T2) wq8_item(p.in[14], WSP(signed char, WS_W_SGUIN), WSP(float, WS_WSS), vb - PREP_T1, smem, 4096);
    else if (vb < PREP_T3) transpose_tile(p.in[18], WSP(bf16_t, WS_W_SGUOUT), CW, DM, vb - PREP_T2, smem);
    else if (vb < PREP_T4) { const int t = vb - PREP_T3, l = t / 32; wq8_item(p.in[20] + (size_t)l * DM * 2048, WSP(signed char, WS_W_PQ) + (size_t)l * 2048 * DM, WSP(float, WS_WQS) + l * 2048, t % 32, smem, 2048); }
    else if (vb < PREP_C0) cvt_chunk(p.in[21], WSP(bf16_t, WS_W_SUBK), vb - PREP_T4);
    else if (vb < PREP_C1) fp8_rows<true>(p.in[22], p.ws + WS_DOWN, WSP(float, WS_DSC), vb - PREP_C0);
    else if (vb < PREP_C2) fp8_rows<false>(p.in[23], p.ws + WS_UP, WSP(float, WS_USC), vb - PREP_C1);
    else rmsnorm_rows<false, 2>(p.in[0], p.in[1], vb - PREP_C2, WSP(signed char, WS_XQ), WSP(float, WS_XSC));
}

DI float compute_lam(const Params& p, int lane) {
    const float a = wave_sum(p.in[7][lane] * p.in[8][lane]);
    const float b = wave_sum(p.in[9][lane] * p.in[10][lane]);
    return __expf(a) - __expf(b) + 0.2f;
}
DI void ce_desc(u32& a, u32& b) { const u32 hi = max(a, b), lo = min(a, b); a = hi; b = lo; }
DI void sort16_desc(u32 (&v)[16]) {
#define SCE(a, b) ce_desc(v[a], v[b]);
    SCE(0,13) SCE(1,12) SCE(2,15) SCE(3,14) SCE(4,8) SCE(5,6) SCE(7,11) SCE(9,10)
    SCE(0,5) SCE(1,7) SCE(2,9) SCE(3,4) SCE(6,13) SCE(8,14) SCE(10,15) SCE(11,12)
    SCE(0,1) SCE(2,3) SCE(4,5) SCE(6,8) SCE(7,9) SCE(10,11) SCE(12,13) SCE(14,15)
    SCE(0,2) SCE(1,3) SCE(4,10) SCE(5,11) SCE(6,7) SCE(8,9) SCE(12,14) SCE(13,15)
    SCE(1,2) SCE(3,12) SCE(4,6) SCE(5,7) SCE(8,10) SCE(9,11) SCE(13,14)
    SCE(1,4) SCE(2,6) SCE(5,8) SCE(7,10) SCE(9,13) SCE(11,14)
    SCE(2,4) SCE(3,6) SCE(9,12) SCE(11,13)
    SCE(3,5) SCE(6,8) SCE(7,9) SCE(10,12)
    SCE(3,4) SCE(5,6) SCE(7,8) SCE(9,10) SCE(11,12)
    SCE(6,7) SCE(8,9)
#undef SCE
}
DI void merge16_desc(u32 (&a)[16], const u32 (&b)[16]) {
#pragma unroll
    for (int i = 0; i < 16; ++i) a[i] = max(a[i], b[15 - i]);
#pragma unroll
    for (int j = 8; j > 0; j >>= 1)
#pragma unroll
        for (int i = 0; i < 16; ++i) { const int l = i ^ j; if (l > i) ce_desc(a[i], a[l]); }
}
DI void top16_insert(u32 (&lst)[16], u32 x) {
#pragma unroll
    for (int j = 0; j < 16; ++j) { const u32 hi = max(lst[j], x); x = min(lst[j], x); lst[j] = hi; }
}
DI void unpack8(const uint4 v, float (&f)[8]) {
    f[0] = __uint_as_float(v.x << 16); f[1] = __uint_as_float(v.x & 0xffff0000u);
    f[2] = __uint_as_float(v.y << 16); f[3] = __uint_as_float(v.y & 0xffff0000u);
    f[4] = __uint_as_float(v.z << 16); f[5] = __uint_as_float(v.z & 0xffff0000u);
    f[6] = __uint_as_float(v.w << 16); f[7] = __uint_as_float(v.w & 0xffff0000u);
}
typedef float f32x2_t __attribute__((ext_vector_type(2)));
DI void unpack16fp8(const uint4 w, float (&f)[16]) {
    f32x2_t t;
    t = __builtin_amdgcn_cvt_pk_f32_fp8((int)w.x, false); f[0] = t[0]; f[1] = t[1];
    t = __builtin_amdgcn_cvt_pk_f32_fp8((int)w.x, true);  f[2] = t[0]; f[3] = t[1];
    t = __builtin_amdgcn_cvt_pk_f32_fp8((int)w.y, false); f[4] = t[0]; f[5] = t[1];
    t = __builtin_amdgcn_cvt_pk_f32_fp8((int)w.y, true);  f[6] = t[0]; f[7] = t[1];
    t = __builtin_amdgcn_cvt_pk_f32_fp8((int)w.z, false); f[8] = t[0]; f[9] = t[1];
    t = __builtin_amdgcn_cvt_pk_f32_fp8((int)w.z, true);  f[10] = t[0]; f[11] = t[1];
    t = __builtin_amdgcn_cvt_pk_f32_fp8((int)w.w, false); f[12] = t[0]; f[13] = t[1];
    t = __builtin_amdgcn_cvt_pk_f32_fp8((int)w.w, true);  f[14] = t[0]; f[15] = t[1];
}
struct PeerPre { int e[16]; uint4 xa, c0, c1; float2 r; };
struct PeerRows { uint4 d[8]; float c[8]; };
struct PeerRaw { u32 ids, aux, res; };
typedef unsigned lu32x4 __attribute__((ext_vector_type(4)));
DI uint4 lds_u4(const LAS unsigned char* a) { const lu32x4 v = *(const LAS lu32x4*)a; return make_uint4(v[0], v[1], v[2], v[3]); }
template <bool UP>
DI PeerRaw peer_raw_load(const Params& p, int tok, int sl, int lane) {
    PeerRaw g;
    g.ids = *(const u32*)(WSP(unsigned short, WS_RIDX) + (size_t)tok * 128 + 2 * lane);
    if (UP) {
        g.aux = *(const u32*)(WSP(bf16_t, WS_COEF) + (size_t)tok * 128 + 2 * lane);
        g.res = *(const u32*)(WSP(bf16_t, WS_RES) + (size_t)tok * DM + sl * 128 + 16 * (lane & 7) + 2 * (lane >> 3));
    } else {
        g.aux = *(const u32*)(WSP(signed char, WS_XQ) + (size_t)tok * DM + sl * 128 + 4 * (lane & 31));
        g.res = 0u;
    }
    return g;
}
template <bool UP>
DI PeerPre peer_stage(const PeerRaw& g, int lane, LAS unsigned char* wl) {
    *(LAS u32*)(wl + 4 * lane) = g.ids;
    if (UP) *(LAS u32*)(wl + 256 + 4 * lane) = g.aux; else *(LAS u32*)(wl + 256 + 4 * (lane & 31)) = g.aux;
    PeerPre q;
#pragma unroll
    for (int j = 0; j < 2; ++j) {
        const uint4 t = lds_u4(wl + 32 * (lane >> 3) + 16 * j);
        q.e[8 * j] = (int)(t.x & 0xffffu); q.e[8 * j + 1] = (int)(t.x >> 16); q.e[8 * j + 2] = (int)(t.y & 0xffffu); q.e[8 * j + 3] = (int)(t.y >> 16);
        q.e[8 * j + 4] = (int)(t.z & 0xffffu); q.e[8 * j + 5] = (int)(t.z >> 16); q.e[8 * j + 6] = (int)(t.w & 0xffffu); q.e[8 * j + 7] = (int)(t.w >> 16);
    }
    if (UP) {
        q.c0 = lds_u4(wl + 256 + 32 * (lane >> 3)); q.c1 = lds_u4(wl + 256 + 32 * (lane >> 3) + 16);
        q.r = make_float2(__uint_as_float(g.res << 16), __uint_as_float(g.res & 0xffff0000u));
    } else {
        q.xa = lds_u4(wl + 256 + 16 * (lane & 7));
    }
    return q;
}
template <int HF, bool UP>
DI void peer_issue_rows(const Params& p, const unsigned char* tab, const PeerPre& q, int tok, int lane, PeerRows& R) {
    const unsigned dco = 16u * (unsigned)(lane & 7);
#pragma unroll
    for (int bi = 0; bi < 8; ++bi) R.d[bi] = *(const uint4*)(tab + ((unsigned)q.e[8 * HF + bi] * 128u + dco));
    if (UP) {
        const uint4 cw = HF ? q.c1 : q.c0;
        R.c[0] = __uint_as_float(cw.x << 16); R.c[1] = __uint_as_float(cw.x & 0xffff0000u); R.c[2] = __uint_as_float(cw.y << 16); R.c[3] = __uint_as_float(cw.y & 0xffff0000u);
        R.c[4] = __uint_as_float(cw.z << 16); R.c[5] = __uint_as_float(cw.z & 0xffff0000u); R.c[6] = __uint_as_float(cw.w << 16); R.c[7] = __uint_as_float(cw.w & 0xffff0000u);
    }
}
template <int HF>
DI void peer_down_half(const PeerPre& q, const PeerRows& R, float (&part)[16]) {
#pragma unroll
    for (int bi = 0; bi < 8; ++bi) {
        int a = __builtin_amdgcn_sdot4((int)R.d[bi].x, (int)q.xa.x, 0, false);
        a = __builtin_amdgcn_sdot4((int)R.d[bi].y, (int)q.xa.y, a, false);
        a = __builtin_amdgcn_sdot4((int)R.d[bi].z, (int)q.xa.z, a, false);
        a = __builtin_amdgcn_sdot4((int)R.d[bi].w, (int)q.xa.w, a, false);
        part[8 * HF + bi] = (float)a;
    }
}
DI void peer_down_fin(const Params& p, const float (&part)[16], int tok, int sl, int lane) {
    const bool b2 = lane & 4, b1 = lane & 2, b0 = lane & 1;
    float r8[8], r4[4], r2[2];
#pragma unroll
    for (int i = 0; i < 8; ++i) { const float snd = b2 ? part[i] : part[i + 8]; const float kp = b2 ? part[i + 8] : part[i]; r8[i] = kp + __shfl_xor(snd, 4); }
#pragma unroll
    for (int i = 0; i < 4; ++i) { const float snd = b1 ? r8[i] : r8[i + 4]; const float kp = b1 ? r8[i + 4] : r8[i]; r4[i] = kp + __shfl_xor(snd, 2); }
#pragma unroll
    for (int i = 0; i < 2; ++i) { const float snd = b0 ? r4[i] : r4[i + 2]; const float kp = b0 ? r4[i + 2] : r4[i]; r2[i] = kp + __shfl_xor(snd, 1); }
    u32* pd = WSP(u32, WS_QBUF) + ((size_t)tok * 8 + sl) * 64;
    pd[lane] = pack2(r2[0], r2[1]);
}
DI void ph_peer_comb(const Params& p, int vb, int l) {
    const int tid = otid(), lane = tid & 63;
    const int tok0 = (vb * 4 + (tid >> 6)) * 2;
    const float* dsc = WSP(float, WS_DSC) + (size_t)l * NEXP;
    const float* usc = WSP(float, WS_USC) + (size_t)l * NEXP;
    u32 w[2][8]; int2 e[2]; float2 g[2]; float xs[2];
#pragma unroll
    for (int r = 0; r < 2; ++r) {
        const int tok = tok0 + r;
        const u32* pd = WSP(u32, WS_QBUF) + (size_t)tok * 8 * 64;
#pragma unroll
        for (int sl = 0; sl < 8; ++sl) w[r][sl] = pd[sl * 64 + lane];
        { const u32 ew = *(const u32*)(WSP(unsigned short, WS_RIDX) + (size_t)tok * 128 + 2 * lane); e[r] = make_int2((int)(ew & 0xffffu), (int)(ew >> 16)); }
        g[r] = *(const float2*)(WSP(float, WS_RG) + (size_t)tok * 128 + 2 * lane);
        xs[r] = WSP(float, WS_XSC)[tok];
    }
#pragma unroll
    for (int r = 0; r < 2; ++r) {
        float t0 = 0.f, t1 = 0.f;
#pragma unroll
        for (int sl = 0; sl < 8; ++sl) { t0 += __uint_as_float(w[r][sl] << 16); t1 += __uint_as_float(w[r][sl] & 0xffff0000u); }
        float2 o;
        o.x = g[r].x * gelu_tanh(t0 * dsc[e[r].x] * xs[r]) * usc[e[r].x];
        o.y = g[r].y * gelu_tanh(t1 * dsc[e[r].y] * xs[r]) * usc[e[r].y];
        *(u32*)(WSP(bf16_t, WS_COEF) + (size_t)(tok0 + r) * 128 + 2 * lane) = pack2(o.x, o.y);
    }
}
template <int HF>
DI void peer_up_half(const PeerPre& q, const PeerRows& R, float (&y)[16]) {
#pragma unroll
    for (int bi = 0; bi < 8; ++bi) {
        const float c = R.c[bi];
        float w[16]; unpack16fp8(R.d[bi], w);
#pragma unroll
        for (int i = 0; i < 16; ++i) y[i] += c * w[i];
        asm volatile("" : "+v"(y[0]), "+v"(y[1]), "+v"(y[2]), "+v"(y[3]), "+v"(y[4]), "+v"(y[5]), "+v"(y[6]), "+v"(y[7]), "+v"(y[8]), "+v"(y[9]), "+v"(y[10]), "+v"(y[11]), "+v"(y[12]), "+v"(y[13]), "+v"(y[14]), "+v"(y[15]));
    }
}
DI void peer_up_fin(const Params& p, const PeerPre& q, const float (&y)[16], int tok, int sl, int lane, bool final_layer) {
    const int rg = lane >> 3, dc = lane & 7;
    const bool b5 = lane & 32, b4 = lane & 16, b3 = lane & 8;
    float r8[8], r4[4], r2[2];
#pragma unroll
    for (int i = 0; i < 8; ++i) { const float snd = b5 ? y[i] : y[i + 8]; const float kp = b5 ? y[i + 8] : y[i]; r8[i] = kp + __shfl_xor(snd, 32); }
#pragma unroll
    for (int i = 0; i < 4; ++i) { const float snd = b4 ? r8[i] : r8[i + 4]; const float kp = b4 ? r8[i + 4] : r8[i]; r4[i] = kp + __shfl_xor(snd, 16); }
#pragma unroll
    for (int i = 0; i < 2; ++i) { const float snd = b3 ? r4[i] : r4[i + 2]; const float kp = b3 ? r4[i + 2] : r4[i]; r2[i] = kp + __shfl_xor(snd, 8); }
    float2 v = q.r;
    v.x += r2[0]; v.y += r2[1];
    if (final_layer) *(float2*)(p.out + (size_t)tok * DM + sl * 128 + 16 * dc + 2 * rg) = v;
    else *(u32*)(WSP(bf16_t, WS_RES) + (size_t)tok * DM + sl * 128 + 16 * dc + 2 * rg) = pack2(v.x, v.y);
}
template <bool UP>
DI void run_peer_sliced(const Params& p, int l, unsigned char* smem) {
    volatile LAS unsigned* st = (volatile LAS unsigned*)(smem + SMEM_BYTES);
    const int nloc = (int)st[0], nx = (int)st[1], rank = (int)st[2], xi = (int)st[3];
    const int tid = otid512(), lane = tid & 63, wave = tid >> 6;
    const int stride = nloc * 8;
    LAS unsigned char* wl = (LAS unsigned char*)smem + wave * 512;
#pragma unroll 1
    for (int sl = xi; sl < 8; sl += nx) {
        const unsigned char* tab = p.ws + (UP ? WS_UP : WS_DOWN) + (size_t)l * NEXP * DM + (size_t)sl * NEXP * 128;
        int tok = rank * 8 + wave;
        if (tok >= NTOK) continue;
        PeerPre qc;
        { const PeerRaw g0 = peer_raw_load<UP>(p, tok, sl, lane); qc = peer_stage<UP>(g0, lane, wl); }
        PeerRaw g1 = peer_raw_load<UP>(p, tok + stride < NTOK ? tok + stride : tok, sl, lane);
        PeerRows R;
        peer_issue_rows<0, UP>(p, tab, qc, tok, lane, R);
#pragma unroll 1
        for (; tok < NTOK; tok += stride) {
            const int tn = tok + stride < NTOK ? tok + stride : tok;
            const int tn2 = tn + stride < NTOK ? tn + stride : tn;
            const PeerRaw g2 = peer_raw_load<UP>(p, tn2, sl, lane);
            const PeerPre qn = peer_stage<UP>(g1, lane, wl);
            float acc[16];
#pragma unroll
            for (int i = 0; i < 16; ++i) acc[i] = 0.f;
            PeerRows Rn;
            peer_issue_rows<1, UP>(p, tab, qc, tok, lane, Rn);
            __builtin_amdgcn_sched_barrier(0);
            if (UP) peer_up_half<0>(qc, R, acc); else peer_down_half<0>(qc, R, acc);
            __builtin_amdgcn_sched_barrier(0);
            peer_issue_rows<0, UP>(p, tab, qn, tn, lane, R);
            __builtin_amdgcn_sched_barrier(0);
            if (UP) { peer_up_half<1>(qc, Rn, acc); peer_up_fin(p, qc, acc, tok, sl, lane, l == 1); }
            else { peer_down_half<1>(qc, Rn, acc); peer_down_fin(p, acc, tok, sl, lane); }
            __builtin_amdgcn_sched_barrier(0);
            qc = qn; g1 = g2;
        }
    }
}


typedef short bf16x8 __attribute__((ext_vector_type(8)));
typedef float f32x16 __attribute__((ext_vector_type(16)));
#define MFMA32(a, b, c) __builtin_amdgcn_mfma_f32_32x32x16_bf16((a), (b), (c), 0, 0, 0)
typedef short s16x4 __attribute__((ext_vector_type(4)));
DI bf16x8 pack_p(const f32x16& pt, int s) {
    uint4 o;
    o.x = pack2(pt[8 * s + 0], pt[8 * s + 1]); o.y = pack2(pt[8 * s + 2], pt[8 * s + 3]);
    o.z = pack2(pt[8 * s + 4], pt[8 * s + 5]); o.w = pack2(pt[8 * s + 6], pt[8 * s + 7]);
    return __builtin_bit_cast(bf16x8, o);
}

DI void stage_tile(const bf16_t* __restrict__ g, int ld, int row0, int k0, unsigned char* lt, int wave, int lane) {
#pragma unroll
    for (int i = 0; i < 4; ++i) {
        const int inst = wave * 4 + i;
        const int row = inst * 8 + (lane >> 3);
        const int c = (lane & 7) ^ ((row >> 1) & 7);
        __builtin_amdgcn_global_load_lds((const unsigned*)(g + (size_t)(row0 + row) * ld + k0 + c * 8),
                                         (unsigned*)(lt + inst * 1024 + lane * 16), 16, 0, 0);
    }
}
DI bf16x8 lds_frag(const unsigned char* lt, int row, int c) {
    return *(const bf16x8*)(lt + row * 128 + ((c ^ ((row >> 1) & 7)) << 4));
}
DI int crow(int r, int fh) { return (r & 3) + 8 * (r >> 2) + 4 * fh; }

namespace pg8 {
#define PG8_LAS __attribute__((address_space(3)))
typedef float f32x4 __attribute__((ext_vector_type(4)));
typedef unsigned u32x4 __attribute__((ext_vector_type(4)));
constexpr int BM = 256, BK = 64, HALF = 128, HTB = HALF * BK * 2  , STAGE_BYTES = 8 * HTB;
__host__ __device__ __forceinline__ int lds_byte(int r, int c) { const int st = (r >> 4) * 2 + (c >> 5), rr = r & 15, cc = c & 31, ob = rr * 64 + cc * 2; return st * 1024 + (ob ^ (((ob >> 9) & 1) << 5)); }
__host__ __device__ __forceinline__ void stage_rc(int b, int& R, int& C) { const int st = b / 1024, sb = b % 1024, swz = sb ^ (((sb >> 9) & 1) << 5); R = (st >> 1) * 16 + swz / 64; C = (st & 1) * 32 + (swz % 64) / 2; }
__host__ __device__ __forceinline__ int perm32(int rho) { const int n = rho >> 4, i = rho & 15; return 8 * (i >> 2) + 4 * n + (i & 3); }
struct Unit { int pm, pn; };
struct Gemm { const void* A; const void* Bt; int M, N, K; const float* rsc; const float* csc; };
struct XcdOrder {
    int ntn, nloc, nx, rank, xi, nown, total;
    __device__ __forceinline__ void init(int nmt, int ntn_, int nloc_, int nx_, int rank_, int xi_) {
        ntn = ntn_; nloc = nloc_; nx = nx_; rank = rank_; xi = xi_; nown = xi < nmt ? (nmt - xi + nx - 1) / nx : 0; total = nown * ntn; }
    __device__ __forceinline__ bool next(int i, Unit& u) const {
        const int t = rank + i * nloc; if (t >= total) return false;
        const int g4 = t / (4 * ntn), r = t - g4 * 4 * ntn;
        const int left = nown - 4 * g4, gs = left < 4 ? left : 4;
        const int nt = r / gs, mi = r - nt * gs;
        u.pm = (4 * g4 + mi) * nx + xi; u.pn = nt; return true;
    }
    __device__ __forceinline__ void a_ready(const Unit&) const {}
    __device__ __forceinline__ void done(const Unit&) const {}
};
typedef int i32x4 __attribute__((ext_vector_type(4)));
template <class Epi, class Sched, bool ALIGN_EPI = false, bool SP2 = false, bool I8 = false>
__device__ __forceinline__ void gemm_phase(PG8_LAS unsigned char* lds, const Gemm g, const Sched& S, const Epi& E) {
    const int tid = otid512(), wid = __builtin_amdgcn_readfirstlane(tid >> 6), lane = tid & 63, wr = wid >> 2, wc = wid & 3, fr = lane & 15, fq = lane >> 4;
    const int K = g.K, KB = I8 ? K : 2 * K  , nt = KB / (BK * 2);
    unsigned voffA[2], voffB[2];
#pragma unroll
    for (int i = 0; i < 2; ++i) { int R, C; stage_rc(tid * 16 + i * 8192, R, C); const int Rb = Epi::PERM ? ((R & ~31) + perm32(R & 31)) : R;
        voffA[i] = (unsigned)(R * KB + C * 2); voffB[i] = (unsigned)(Rb * KB + C * 2); }
    const size_t kstep = (size_t)(BK * 2);
    const size_t hstep = (size_t)HALF * KB;
    const size_t tstep = 2 * hstep;
    const unsigned ldsw = (unsigned)wid * 1024u;
    const int aoff = lds_byte(wr * 64 + fr, fq * 8), boff = lds_byte(wc * 32 + fr, fq * 8);
#define PG8_SA(b, h) (((b) * 2 + (h)) * HTB)
#define PG8_SB(b, h) ((4 + (b) * 2 + (h)) * HTB)
#define PG8_STAGE(bufoff, gbase, voff) do { _Pragma("unroll") for (int _i = 0; _i < 2; ++_i) \
        __builtin_amdgcn_global_load_lds((const unsigned*)((const char*)(gbase) + (voff)[_i]), (PG8_LAS unsigned*)(lds + (bufoff) + ldsw + _i * 8192), 16, 0, 0); } while (0)
#define PG8_LDA(dst, b, h) do { _Pragma("unroll") for (int m = 0; m < 4; ++m) _Pragma("unroll") for (int k = 0; k < 2; ++k) dst[m][k] = *(const PG8_LAS bf16x8*)(lds + PG8_SA(b, h) + aoff + m * 2048 + k * 1024); } while (0)
#define PG8_LDB(dst, b, h) do { _Pragma("unroll") for (int n = 0; n < 2; ++n) _Pragma("unroll") for (int k = 0; k < 2; ++k) dst[n][k] = *(const PG8_LAS bf16x8*)(lds + PG8_SB(b, h) + boff + n * 2048 + k * 1024); } while (0)
#define PG8_MMA(ai, bj, At, Bt) do { __builtin_amdgcn_s_setprio(1); _Pragma("unroll") for (int m = 0; m < 4; ++m) _Pragma("unroll") for (int n = 0; n < 2; ++n) _Pragma("unroll") for (int k = 0; k < 2; ++k) \
        { if constexpr (I8) acc[ai][bj][m][n] = __builtin_bit_cast(f32x4, __builtin_amdgcn_mfma_i32_16x16x64_i8(__builtin_bit_cast(i32x4, Bt[n][k]), __builtin_bit_cast(i32x4, At[m][k]), __builtin_bit_cast(i32x4, acc[ai][bj][m][n]), 0, 0, 0)); \
          else acc[ai][bj][m][n] = __builtin_amdgcn_mfma_f32_16x16x32_bf16(Bt[n][k], At[m][k], acc[ai][bj][m][n], 0, 0, 0); } __builtin_amdgcn_s_setprio(0); } while (0)
#define PG8_WAIT_V(n) asm volatile("s_waitcnt vmcnt(" #n ")" ::: "memory")
#define PG8_WAIT_L(n) asm volatile("s_waitcnt lgkmcnt(" #n ")" ::: "memory")
#define PG8_BAR __builtin_amdgcn_s_barrier()
#define PG8_SCHED __builtin_amdgcn_sched_barrier(0)
    Unit cur, nxt; int ui = 0;
    if (!S.next(0, cur)) return;
    f32x4 acc[2][2][4][2];
#pragma unroll
    for (int a = 0; a < 2; ++a)
#pragma unroll
        for (int b = 0; b < 2; ++b)
#pragma unroll
            for (int m = 0; m < 4; ++m)
#pragma unroll
                for (int n = 0; n < 2; ++n) acc[a][b][m][n] = (f32x4){0.f, 0.f, 0.f, 0.f};
    bf16x8 At[4][2], B0[2][2], B1[2][2];
    const char* cA = (const char*)g.A + (size_t)cur.pm * tstep; const char* cB = (const char*)g.Bt + (size_t)cur.pn * tstep;
    S.a_ready(cur);
    if constexpr (SP2) {
        PG8_STAGE(PG8_SB(0, 0), cB, voffB); PG8_STAGE(PG8_SB(0, 1), cB + hstep, voffB); PG8_STAGE(PG8_SA(0, 0), cA, voffA); PG8_STAGE(PG8_SA(0, 1), cA + hstep, voffA);
        if (wr == 1) PG8_BAR;
        PG8_WAIT_V(2); PG8_BAR;
        PG8_STAGE(PG8_SB(1, 0), cB + kstep, voffB); PG8_STAGE(PG8_SA(1, 0), cA + kstep, voffA); PG8_STAGE(PG8_SB(1, 1), cB + hstep + kstep, voffB);
        PG8_WAIT_V(6); PG8_BAR;
    } else {
        PG8_STAGE(PG8_SB(0, 0), cB, voffB); PG8_STAGE(PG8_SA(0, 0), cA, voffA); PG8_STAGE(PG8_SB(0, 1), cB + hstep, voffB); PG8_STAGE(PG8_SA(0, 1), cA + hstep, voffA);
        if (wr == 1) PG8_BAR;
        PG8_WAIT_V(4); PG8_BAR;
        PG8_STAGE(PG8_SB(1, 0), cB + kstep, voffB); PG8_STAGE(PG8_SA(1, 0), cA + kstep, voffA); PG8_STAGE(PG8_SB(1, 1), cB + hstep + kstep, voffB);
        PG8_WAIT_V(6); PG8_BAR;
    }
    for (;;) {
        const bool has_next = S.next(ui + 1, nxt);
        const char* nA = has_next ? (const char*)g.A + (size_t)nxt.pm * tstep : cA; const char* nB = has_next ? (const char*)g.Bt + (size_t)nxt.pn * tstep : cB;
        for (int t = 0; t < nt; t += 2) {
            const bool last = (t == nt - 2);
            const char* a1 = cA + (size_t)(t + 1) * kstep;
            const char* a2 = last ? nA : cA + (size_t)(t + 2) * kstep; const char* b2 = last ? nB : cB + (size_t)(t + 2) * kstep;
            const char* a3 = a2 + kstep; const char* b3 = b2 + kstep;
            if (last && has_next) S.a_ready(nxt);
            if constexpr (SP2) {
            PG8_LDB(B0, 0, 0); PG8_LDB(B1, 0, 1); PG8_SCHED; PG8_LDA(At, 0, 0); PG8_STAGE(PG8_SA(1, 1), a1 + hstep, voffA);
            PG8_WAIT_V(8); PG8_WAIT_L(0); PG8_BAR; PG8_MMA(0, 0, At, B0); PG8_MMA(0, 1, At, B1); PG8_BAR; PG8_SCHED;
            PG8_LDA(At, 0, 1); PG8_STAGE(PG8_SB(0, 0), b2, voffB); PG8_STAGE(PG8_SB(0, 1), b2 + hstep, voffB); PG8_STAGE(PG8_SA(0, 0), a2, voffA);
            PG8_WAIT_V(8); PG8_WAIT_L(0); PG8_BAR; PG8_MMA(1, 0, At, B0); PG8_MMA(1, 1, At, B1); PG8_BAR; PG8_SCHED;
            PG8_LDB(B0, 1, 0); PG8_LDB(B1, 1, 1); PG8_SCHED; PG8_LDA(At, 1, 0); PG8_STAGE(PG8_SA(0, 1), a2 + hstep, voffA);
            PG8_WAIT_V(8); PG8_WAIT_L(0); PG8_BAR; PG8_MMA(0, 0, At, B0); PG8_MMA(0, 1, At, B1); PG8_BAR; PG8_SCHED;
            PG8_LDA(At, 1, 1); PG8_STAGE(PG8_SB(1, 0), b3, voffB); PG8_STAGE(PG8_SB(1, 1), b3 + hstep, voffB); PG8_STAGE(PG8_SA(1, 0), a3, voffA);
            PG8_WAIT_V(8); PG8_WAIT_L(0); PG8_BAR; PG8_MMA(1, 0, At, B0); PG8_MMA(1, 1, At, B1); PG8_BAR; PG8_SCHED;
            } else {
            PG8_LDB(B0, 0, 0); PG8_SCHED; PG8_LDA(At, 0, 0); PG8_STAGE(PG8_SA(1, 1), a1 + hstep, voffA);
            PG8_WAIT_L(8); PG8_BAR; PG8_WAIT_L(0); PG8_MMA(0, 0, At, B0); PG8_BAR; PG8_SCHED;
            PG8_LDB(B1, 0, 1); PG8_STAGE(PG8_SB(0, 0), b2, voffB);
            PG8_BAR; PG8_WAIT_L(0); PG8_MMA(0, 1, At, B1); PG8_BAR;
            PG8_LDA(At, 0, 1); PG8_STAGE(PG8_SA(0, 0), a2, voffA);
            PG8_BAR; PG8_WAIT_L(0); PG8_MMA(1, 0, At, B0); PG8_BAR; PG8_SCHED;
            PG8_STAGE(PG8_SB(0, 1), b2 + hstep, voffB);
            PG8_WAIT_V(6); PG8_BAR; PG8_MMA(1, 1, At, B1); PG8_BAR;
            PG8_LDB(B0, 1, 0); PG8_SCHED; PG8_LDA(At, 1, 0); PG8_STAGE(PG8_SA(0, 1), a2 + hstep, voffA);
            PG8_WAIT_L(8); PG8_BAR; PG8_WAIT_L(0); PG8_MMA(0, 0, At, B0); PG8_BAR; PG8_SCHED;
            PG8_LDB(B1, 1, 1); PG8_STAGE(PG8_SB(1, 0), b3, voffB);
            PG8_BAR; PG8_WAIT_L(0); PG8_MMA(0, 1, At, B1); PG8_BAR;
            PG8_LDA(At, 1, 1); PG8_STAGE(PG8_SA(1, 0), a3, voffA);
            PG8_BAR; PG8_WAIT_L(0); PG8_MMA(1, 0, At, B0); PG8_BAR; PG8_SCHED;
            PG8_STAGE(PG8_SB(1, 1), b3 + hstep, voffB);
            PG8_WAIT_V(6); PG8_BAR; PG8_MMA(1, 1, At, B1); PG8_BAR;
            }
        }
        if constexpr (ALIGN_EPI) { if (wr == 0) PG8_BAR; }
        if constexpr (I8) {
#pragma unroll
            for (int b = 0; b < 2; ++b) {
                const float* cp = g.csc + cur.pn * BM + b * HALF + wc * 32 + 8 * fq;
                const f32x4 c0 = *(const f32x4*)cp, c1 = *(const f32x4*)(cp + 4);
#pragma unroll
                for (int a = 0; a < 2; ++a)
#pragma unroll
                    for (int m = 0; m < 4; ++m) {
                        const float xs = g.rsc[cur.pm * BM + a * HALF + wr * 64 + m * 16 + fr];
                        acc[a][b][m][0] = __builtin_convertvector(__builtin_bit_cast(i32x4, acc[a][b][m][0]), f32x4) * c0 * xs;
                        acc[a][b][m][1] = __builtin_convertvector(__builtin_bit_cast(i32x4, acc[a][b][m][1]), f32x4) * c1 * xs;
                    }
            }
        }
        if constexpr (!Epi::AFTER_DRAIN) { E(acc, cur, wr, wc, fr, fq); S.done(cur); }
        if (!has_next) break;
#pragma unroll
        for (int a = 0; a < 2; ++a)
#pragma unroll
            for (int b = 0; b < 2; ++b)
#pragma unroll
                for (int m = 0; m < 4; ++m)
#pragma unroll
                    for (int n = 0; n < 2; ++n) acc[a][b][m][n] = (f32x4){0.f, 0.f, 0.f, 0.f};
        cur = nxt; cA = nA; cB = nB; ++ui;
        if constexpr (ALIGN_EPI) { if (wr == 1) PG8_BAR; }
    }
    PG8_WAIT_V(0);
    if constexpr (!ALIGN_EPI) { if (wr == 0) PG8_BAR; }
    PG8_BAR;
    if constexpr (Epi::AFTER_DRAIN) { E.fused(acc, cur, wr, wc, fr, fq, lds, wid, lane); S.done(cur); }
#undef PG8_SA
#undef PG8_SB
#undef PG8_STAGE
#undef PG8_LDA
#undef PG8_LDB
#undef PG8_MMA
#undef PG8_WAIT_V
#undef PG8_WAIT_L
#undef PG8_BAR
#undef PG8_SCHED
}
template <bool RES_BF16>
struct EpiResid {
    static constexpr bool PERM = true, AFTER_DRAIN = false;
    const void* resid; bf16_t* out;
    __device__ __forceinline__ void operator()(const f32x4 (&acc)[2][2][4][2], const Unit& u, int wr, int wc, int fr, int fq) const {
        const size_t base = (size_t)(u.pm * BM + wr * 64 + fr) * DM + u.pn * BM + wc * 32 + 8 * fq;
#pragma unroll
        for (int ai = 0; ai < 2; ++ai) {
            f32x4 rv[4][2][2];
#pragma unroll
            for (int m = 0; m < 4; ++m)
#pragma unroll
                for (int bj = 0; bj < 2; ++bj) {
                    const size_t o = base + (size_t)(ai * HALF + m * 16) * DM + bj * HALF;
                    if constexpr (RES_BF16) {
                        const u32x4 w = *(const u32x4*)((const bf16_t*)resid + o);
                        rv[m][bj][0] = (f32x4){__uint_as_float(w.x << 16), __uint_as_float(w.x & 0xffff0000u), __uint_as_float(w.y << 16), __uint_as_float(w.y & 0xffff0000u)};
                        rv[m][bj][1] = (f32x4){__uint_as_float(w.z << 16), __uint_as_float(w.z & 0xffff0000u), __uint_as_float(w.w << 16), __uint_as_float(w.w & 0xffff0000u)};
                    } else { const float* rp = (const float*)resid + o; rv[m][bj][0] = *(const f32x4*)rp; rv[m][bj][1] = *(const f32x4*)(rp + 4); }
                }
            asm volatile("" ::: "memory");
#pragma unroll
            for (int m = 0; m < 4; ++m)
#pragma unroll
                for (int bj = 0; bj < 2; ++bj) {
                    const f32x4 a = rv[m][bj][0] + acc[ai][bj][m][0], b = rv[m][bj][1] + acc[ai][bj][m][1];
                    u32x4 w; w.x = pack2(a[0], a[1]); w.y = pack2(a[2], a[3]); w.z = pack2(b[0], b[1]); w.w = pack2(b[2], b[3]);
                    *(u32x4*)(out + base + (size_t)(ai * HALF + m * 16) * DM + bj * HALF) = w;
                }
            asm volatile("" ::: "memory");
        }
    }
};
struct EpiProj {
    static constexpr bool PERM = true, AFTER_DRAIN = false;
    const float* aq; const float* ak; const float* bq; const float* bk; bf16_t* proj; PG8_LAS float* xs;
    __device__ __forceinline__ void operator()(const f32x4 (&acc)[2][2][4][2], const Unit& u, int wr, int wc, int fr, int fq) const {
        const int wave = wr * 4 + wc;
#pragma unroll
        for (int ai = 0; ai < 2; ++ai)
#pragma unroll
            for (int m = 0; m < 4; ++m)
#pragma unroll
                for (int bj = 0; bj < 2; ++bj) {
                    const f32x4 a = acc[ai][bj][m][0], b = acc[ai][bj][m][1];
                    float t = a[0] * a[0] + a[1] * a[1] + a[2] * a[2] + a[3] * a[3] + b[0] * b[0] + b[1] * b[1] + b[2] * b[2] + b[3] * b[3];
                    t += __shfl_xor(t, 16); t += __shfl_xor(t, 32);
                    if (fq == 0) xs[wave * 256 + ((ai * 4 + m) * 2 + bj) * 16 + fr] = t;
                }
        asm volatile("s_waitcnt lgkmcnt(0)" ::: "memory");
        __builtin_amdgcn_s_barrier();
#pragma unroll
        for (int bj = 0; bj < 2; ++bj) {
            const int gcol = u.pn * BM + bj * HALF + wc * 32 + 8 * fq;
            const float* gain = nullptr; float scale = 1.f;
            if (gcol < 512) { gain = aq + (gcol & 63); scale = 0.125f; }
            else if (gcol < 1024) gain = ak + (gcol & 63);
            else if (gcol < 1536) gain = nullptr;
            else if (gcol < 2048) { gain = bq + (gcol & 127); scale = 0.125f; }
            else if (gcol < 2560) gain = bk + (gcol & 127);
            f32x4 g0 = {1.f, 1.f, 1.f, 1.f}, g1 = {1.f, 1.f, 1.f, 1.f};
            if (gain) { g0 = *(const f32x4*)gain; g1 = *(const f32x4*)(gain + 4); }
#pragma unroll
            for (int ai = 0; ai < 2; ++ai)
#pragma unroll
                for (int m = 0; m < 4; ++m) {
                    float sc = 1.f;
                    if (gain) {
                        const int slot = ((ai * 4 + m) * 2 + bj) * 16 + fr;
                        sc = rsqrtf((xs[wave * 256 + slot] + xs[(wave ^ 1) * 256 + slot]) * (1.f / 64.f) + EPSN) * scale;
                    }
                    const f32x4 v0 = acc[ai][bj][m][0] * g0 * sc, v1 = acc[ai][bj][m][1] * g1 * sc;
                    u32x4 w; w.x = pack2(v0[0], v0[1]); w.y = pack2(v0[2], v0[3]); w.z = pack2(v1[0], v1[1]); w.w = pack2(v1[2], v1[3]);
                    *(u32x4*)(proj + (size_t)(u.pm * BM + ai * HALF + wr * 64 + m * 16 + fr) * ATT_IN + gcol) = w;
                }
        }
    }
};
struct EpiSgu {
    static constexpr bool PERM = true, AFTER_DRAIN = false;
    bf16_t* zu; bf16_t* zvt; float* ssq; PG8_LAS unsigned char* stg;
    __device__ __forceinline__ void operator()(const f32x4 (&acc)[2][2][4][2], const Unit& u, int wr, int wc, int fr, int fq) const {
        const int wave = wr * 4 + wc, lane = fq * 16 + fr;
        PG8_LAS unsigned short* tl = (PG8_LAS unsigned short*)(stg + wave * 2048);
#pragma unroll
        for (int ai = 0; ai < 2; ++ai)
#pragma unroll
            for (int bj = 0; bj < 2; ++bj) {
                const int gcol = u.pn * BM + bj * HALF + wc * 32 + 8 * fq;
                f32x4 g0[4], g1[4];
#pragma unroll
                for (int m = 0; m < 4; ++m) {
                    const f32x4 a = acc[ai][bj][m][0], b = acc[ai][bj][m][1];
                    g0[m] = (f32x4){gelu_tanh(a[0]), gelu_tanh(a[1]), gelu_tanh(a[2]), gelu_tanh(a[3])};
                    g1[m] = (f32x4){gelu_tanh(b[0]), gelu_tanh(b[1]), gelu_tanh(b[2]), gelu_tanh(b[3])};
                }
                if (gcol < CW) {
#pragma unroll
                    for (int m = 0; m < 4; ++m) {
                        u32x4 w; w.x = pack2(g0[m][0], g0[m][1]); w.y = pack2(g0[m][2], g0[m][3]); w.z = pack2(g1[m][0], g1[m][1]); w.w = pack2(g1[m][2], g1[m][3]);
                        *(u32x4*)(zu + (size_t)(u.pm * BM + ai * HALF + wr * 64 + m * 16 + fr) * CW + gcol) = w;
                    }
                } else {
                    const int vcol = gcol - CW;
#pragma unroll
                    for (int m = 0; m < 4; ++m) {
                        float t = g0[m][0] * g0[m][0] + g0[m][1] * g0[m][1] + g0[m][2] * g0[m][2] + g0[m][3] * g0[m][3]
                                + g1[m][0] * g1[m][0] + g1[m][1] * g1[m][1] + g1[m][2] * g1[m][2] + g1[m][3] * g1[m][3];
                        t += __shfl_xor(t, 16); t += __shfl_xor(t, 32);
                        if (fq == 0) ssq[(size_t)(u.pm * BM + ai * HALF + wr * 64 + m * 16 + fr) * 64 + (vcol >> 5)] = t;
                    }
#pragma unroll
                    for (int h = 0; h < 2; ++h) {
#pragma unroll
                        for (int mm = 0; mm < 2; ++mm) {
                            const int m = 2 * h + mm, rl = 16 * mm + fr;
#pragma unroll
                            for (int j = 0; j < 4; ++j) { tl[(8 * fq + j) * 32 + rl] = f2bf(g0[m][j]); tl[(8 * fq + 4 + j) * 32 + rl] = f2bf(g1[m][j]); }
                        }
                        const int c = lane >> 1, hh = lane & 1;
                        const u32x4 w0 = *(const PG8_LAS u32x4*)(tl + c * 32 + hh * 16), w1 = *(const PG8_LAS u32x4*)(tl + c * 32 + hh * 16 + 8);
                        bf16_t* dst = zvt + ((size_t)(2 * u.pm + ai) * CW + (u.pn * BM - CW) + bj * HALF + wc * 32 + c) * 128 + wr * 64 + 32 * h + hh * 16;
                        *(u32x4*)dst = w0; *(u32x4*)(dst + 8) = w1;
                        asm volatile("" ::: "memory");
                    }
                }
            }
    }
};
struct EpiQ {
    static constexpr bool PERM = true, AFTER_DRAIN = false;
    bf16_t* q;
    __device__ __forceinline__ void operator()(const f32x4 (&acc)[2][2][4][2], const Unit& u, int wr, int wc, int fr, int fq) const {
#pragma unroll
        for (int ai = 0; ai < 2; ++ai)
#pragma unroll
            for (int m = 0; m < 4; ++m)
#pragma unroll
                for (int bj = 0; bj < 2; ++bj) {
                    const f32x4 a = acc[ai][bj][m][0], b = acc[ai][bj][m][1];
                    u32x4 w; w.x = pack2(a[0], a[1]); w.y = pack2(a[2], a[3]); w.z = pack2(b[0], b[1]); w.w = pack2(b[2], b[3]);
                    *(u32x4*)(q + (size_t)(u.pm * BM + ai * HALF + wr * 64 + m * 16 + fr) * 2048 + u.pn * BM + bj * HALF + wc * 32 + 8 * fq) = w;
                }
    }
};
}
DI void run_gemmq_pg8(const Params& p, int l, unsigned char* smem) {
    volatile LAS unsigned* st = (volatile LAS unsigned*)(smem + SMEM_BYTES);
    pg8::XcdOrder S; S.init(NTOK / 256, 2048 / 256, (int)st[0], (int)st[1], (int)st[2], (int)st[3]);
    const pg8::Gemm g{WSP(signed char, WS_XQ), WSP(signed char, WS_W_PQ) + (size_t)l * 2048 * DM, NTOK, 2048, DM, WSP(float, WS_XSC), WSP(float, WS_WQS) + l * 2048};
    pg8::EpiQ E; E.q = WSP(bf16_t, WS_QBUF);
    __syncthreads();
    pg8::gemm_phase<pg8::EpiQ, pg8::XcdOrder, true, true, true>((PG8_LAS unsigned char*)smem, g, S, E);
}
template <int WHICH>
DI void run_gemm_pg8(const Params& p, unsigned char* smem) {
    volatile LAS unsigned* st = (volatile LAS unsigned*)(smem + SMEM_BYTES);
    pg8::XcdOrder S; S.init(NTOK / 256, DM / 256, (int)st[0], (int)st[1], (int)st[2], (int)st[3]);
    pg8::Gemm g;
    pg8::EpiResid<WHICH == 1> E; E.out = WSP(bf16_t, WS_RES);
    if (WHICH == 0) { g = pg8::Gemm{WSP(bf16_t, WS_MIXED), WSP(bf16_t, WS_W_ATTOUT), NTOK, DM, DM, nullptr, nullptr}; E.resid = p.in[0]; }
    else { g = pg8::Gemm{WSP(bf16_t, WS_Z_U), WSP(bf16_t, WS_W_SGUOUT), NTOK, DM, CW, nullptr, nullptr}; E.resid = WSP(bf16_t, WS_RES); }
    __syncthreads();
    pg8::gemm_phase<pg8::EpiResid<WHICH == 1>, pg8::XcdOrder, true, true>((PG8_LAS unsigned char*)smem, g, S, E);
}

DI void run_gemm1_pg8(const Params& p, unsigned char* smem) {
    volatile LAS unsigned* st = (volatile LAS unsigned*)(smem + SMEM_BYTES);
    pg8::XcdOrder S; S.init(NTOK / 256, ATT_IN / 256, (int)st[0], (int)st[1], (int)st[2], (int)st[3]);
    const pg8::Gemm g{WSP(signed char, WS_XQ), WSP(signed char, WS_W_ATTIN), NTOK, ATT_IN, DM, WSP(float, WS_XSC), WSP(float, WS_WAS)};
    pg8::EpiProj E; E.aq = p.in[3]; E.ak = p.in[4]; E.bq = p.in[5]; E.bk = p.in[6]; E.proj = WSP(bf16_t, WS_PROJ); E.xs = (PG8_LAS float*)(smem + PG8_EXTRA);
    __syncthreads();
    pg8::gemm_phase<pg8::EpiProj, pg8::XcdOrder, true, true, true>((PG8_LAS unsigned char*)smem, g, S, E);
}
DI void run_gemm4_pg8(const Params& p, unsigned char* smem) {
    volatile LAS unsigned* st = (volatile LAS unsigned*)(smem + SMEM_BYTES);
    pg8::XcdOrder S; S.init(NTOK / 256, 4096 / 256, (int)st[0], (int)st[1], (int)st[2], (int)st[3]);
    const pg8::Gemm g{WSP(signed char, WS_XQ), WSP(signed char, WS_W_SGUIN), NTOK, 4096, DM, WSP(float, WS_XSC), WSP(float, WS_WSS)};
    pg8::EpiSgu E; E.zu = WSP(bf16_t, WS_Z_U); E.zvt = WSP(bf16_t, WS_Z_VT); E.ssq = WSP(float, WS_SSQ); E.stg = (PG8_LAS unsigned char*)(smem + PG8_EXTRA);
    __syncthreads();
    pg8::gemm_phase<pg8::EpiSgu, pg8::XcdOrder, true, true, true>((PG8_LAS unsigned char*)smem, g, S, E);
}

DI u32 cand_key(float s, int ci) { return (f2ord(s) & ~255u) | (u32)(255 - ci); }
template <int P>
DI void score_half(const bf16x8 (&qf)[8], const unsigned char* skl, int fr, int fh, u32 (&lst)[16]) {
#pragma unroll
    for (int j = 0; j < 16; ++j) lst[j] = 0u;
#pragma unroll 1
    for (int kt = 0; kt < 4; ++kt) {
        f32x16 st;
#pragma unroll
        for (int r = 0; r < 16; ++r) st[r] = 0.f;
        const int row = P * 128 + kt * 32 + fr;
        const unsigned char* skr = skl + row * 256;
#pragma unroll
        for (int ks = 0; ks < 8; ++ks) st = MFMA32(*(const bf16x8*)(skr + (((2 * ks + fh) ^ (row & 15)) << 4)), qf[ks], st);
        u32 ks_[16];
#pragma unroll
        for (int r = 0; r < 16; ++r) ks_[r] = (f2ord(st[r]) & ~127u) | (u32)(127 - (kt * 32 + crow(r, fh)));
        sort16_desc(ks_);
        if (kt == 0) {
#pragma unroll
            for (int j = 0; j < 16; ++j) lst[j] = ks_[j];
        } else merge16_desc(lst, ks_);
    }
    u32 other[16];
#pragma unroll
    for (int j = 0; j < 16; ++j) other[j] = (u32)__shfl_xor((int)lst[j], 32);
    merge16_desc(lst, other);
}
DI void run_score(const Params& p, int l, unsigned char* smem) {
    const int tid = otid512(), wave = tid >> 6, lane = tid & 63, fr = lane & 31, fh = lane >> 5;
    int cur_h = -1;
    bf16x8 qa[8], qb[8];
    if ((int)blockIdx.x < 8 * (NTOK / 256)) {
        const int it0 = blockIdx.x;
        const bf16_t* q0 = WSP(bf16_t, WS_QBUF) + (size_t)((it0 >> 3) * 256 + wave * 32 + fr) * 2048 + (it0 & 7) * 256 + 8 * fh;
#pragma unroll
        for (int ks = 0; ks < 8; ++ks) { qa[ks] = *(const bf16x8*)(q0 + 16 * ks); qb[ks] = *(const bf16x8*)(q0 + 128 + 16 * ks); }
    }
#pragma unroll 1
    for (int it = blockIdx.x; it < 8 * (NTOK / 256); it += gridDim.x) {
    const int h = it & 7, oct = it >> 3;
    if (h != cur_h) {
        __syncthreads();
        const bf16_t* skg = WSP(bf16_t, WS_W_SUBK) + ((size_t)l * 16 + h * 2) * 128 * 128;
#pragma unroll
        for (int i = 0; i < 8; ++i) {
            const int idx = wave * 8 + i;
            const int row = 4 * idx + (lane >> 4), cp = lane & 15;
            __builtin_amdgcn_global_load_lds((const unsigned*)(skg + (size_t)row * 128 + ((cp ^ (row & 15)) << 3)), (unsigned*)(smem + idx * 1024 + lane * 16), 16, 0, 0);
        }
        asm volatile("s_waitcnt vmcnt(0)" ::: "memory");
        __syncthreads();
        cur_h = h;
    }
    const int tok = oct * 256 + wave * 32 + fr;
    const unsigned char* skh = smem;
    u32 L0[16], L1[16];
    score_half<0>(qa, skh, fr, fh, L0);
    score_half<1>(qb, skh, fr, fh, L1);
    {
        const int itn = it + gridDim.x < 8 * (NTOK / 256) ? it + gridDim.x : it;
        const bf16_t* qn = WSP(bf16_t, WS_QBUF) + (size_t)((itn >> 3) * 256 + wave * 32 + fr) * 2048 + (itn & 7) * 256 + 8 * fh;
#pragma unroll
        for (int ks = 0; ks < 8; ++ks) { qa[ks] = *(const bf16x8*)(qn + 16 * ks); qb[ks] = *(const bf16x8*)(qn + 128 + 16 * ks); }
    }
    LAS int* slot = (LAS int*)(smem + 65536 + wave * (64 * 132)) + lane * 33;
    float s1[16], s2[16];
#pragma unroll
    for (int j = 0; j < 16; ++j) {
        s1[j] = ord2f(L0[j] & ~127u); s2[j] = ord2f(L1[j] & ~127u);
        slot[j] = 127 - (int)(L0[j] & 127u); slot[16 + j] = 127 - (int)(L1[j] & 127u);
    }
    u32 lst[16];
#pragma unroll
    for (int j = 0; j < 16; ++j) lst[j] = cand_key(s1[0] + s2[j], j);
#pragma unroll
    for (int i = 1; i < 5; ++i) {
        u32 row[16];
#pragma unroll
        for (int j = 0; j < 16; ++j) row[j] = ((i + 1) * (j + 1) <= 16) ? cand_key(s1[i] + s2[j], i * 16 + j) : 0u;
        merge16_desc(lst, row);
    }
#pragma unroll
    for (int i = 5; i < 16; ++i)
#pragma unroll
        for (int j = 0; j < 2; ++j)
            if ((i + 1) * (j + 1) <= 16) top16_insert(lst, cand_key(s1[i] + s2[j], i * 16 + j));
    float pv[16]; float sum = 0.f;
    const float mx = ord2f(lst[0] & ~255u);
#pragma unroll
    for (int j = 0; j < 16; ++j) { pv[j] = __expf(ord2f(lst[j] & ~255u) - mx); sum += pv[j]; }
    const float inv = 1.f / sum;
    int ev[16];
#pragma unroll
    for (int j = 0; j < 16; ++j) {
        const int ci = 255 - (int)(lst[j] & 255u);
        ev[j] = slot[ci >> 4] * 128 + slot[16 + (ci & 15)];
    }
    if (fh == 0) {
        uint4* ro = (uint4*)(WSP(unsigned short, WS_RIDX) + (size_t)tok * 128 + h * 16);
        float4* go = (float4*)(WSP(float, WS_RG) + (size_t)tok * 128 + h * 16);
#pragma unroll
        for (int q = 0; q < 2; ++q)
            ro[q] = make_uint4((u32)ev[8 * q] | ((u32)ev[8 * q + 1] << 16), (u32)ev[8 * q + 2] | ((u32)ev[8 * q + 3] << 16),
                               (u32)ev[8 * q + 4] | ((u32)ev[8 * q + 5] << 16), (u32)ev[8 * q + 6] | ((u32)ev[8 * q + 7] << 16));
#pragma unroll
        for (int q = 0; q < 4; ++q) go[q] = make_float4(pv[4 * q] * inv, pv[4 * q + 1] * inv, pv[4 * q + 2] * inv, pv[4 * q + 3] * inv);
    }
    }
}


#define OSM_THR 8.0f
DI void osm_update(f32x16& s, unsigned vm, float& m, float& lh, float& alpha) {
    float mx = -1e30f;
#pragma unroll
    for (int r = 0; r < 16; ++r) mx = ((vm >> r) & 1u) ? fmaxf(mx, s[r]) : mx;
    mx = fmaxf(mx, __shfl_xor(mx, 32));
    float mn = m; alpha = 1.f;
    if (!__all(mx <= m + OSM_THR)) { mn = fmaxf(m, mx); alpha = __expf(m - mn); }
    float ls = 0.f;
#pragma unroll
    for (int r = 0; r < 16; ++r) { const float pe = ((vm >> r) & 1u) ? __expf(s[r] - mn) : 0.f; s[r] = pe; ls += pe; }
    lh = lh * alpha + ls; m = mn;
}
DI void osm_update_full(f32x16& s, float& m, float& lh, float& alpha) {
    float mx = s[0];
#pragma unroll
    for (int r = 1; r < 16; ++r) mx = fmaxf(mx, s[r]);
    mx = fmaxf(mx, __shfl_xor(mx, 32));
    float mn = m; alpha = 1.f;
    if (!__all(mx <= m + OSM_THR)) { mn = fmaxf(m, mx); alpha = __expf(m - mn); }
    float ls = 0.f;
#pragma unroll
    for (int r = 0; r < 16; ++r) { const float pe = __expf(s[r] - mn); s[r] = pe; ls += pe; }
    lh = lh * alpha + ls; m = mn;
}
DI void tr_quad(const unsigned (&a)[4], unsigned hi_off, bf16x8 (&f)[4]) {
    s16x4 l0, h0, l1, h1, l2, h2, l3, h3;
    const unsigned b0 = a[0] + hi_off, b1 = a[1] + hi_off, b2 = a[2] + hi_off, b3 = a[3] + hi_off;
    asm volatile("ds_read_b64_tr_b16 %0, %8\n\tds_read_b64_tr_b16 %1, %9\n\tds_read_b64_tr_b16 %2, %10\n\tds_read_b64_tr_b16 %3, %11\n\t"
                 "ds_read_b64_tr_b16 %4, %12\n\tds_read_b64_tr_b16 %5, %13\n\tds_read_b64_tr_b16 %6, %14\n\tds_read_b64_tr_b16 %7, %15\n\ts_waitcnt lgkmcnt(0)"
                 : "=&v"(l0), "=&v"(h0), "=&v"(l1), "=&v"(h1), "=&v"(l2), "=&v"(h2), "=&v"(l3), "=&v"(h3)
                 : "v"(a[0]), "v"(b0), "v"(a[1]), "v"(b1), "v"(a[2]), "v"(b2), "v"(a[3]), "v"(b3) : "memory");
    f[0] = __builtin_shufflevector(l0, h0, 0, 1, 2, 3, 4, 5, 6, 7); f[1] = __builtin_shufflevector(l1, h1, 0, 1, 2, 3, 4, 5, 6, 7);
    f[2] = __builtin_shufflevector(l2, h2, 0, 1, 2, 3, 4, 5, 6, 7); f[3] = __builtin_shufflevector(l3, h3, 0, 1, 2, 3, 4, 5, 6, 7);
}

#define QB_BYTES (128 * 256)
#define KB_BYTES (32 * 256)
template <bool WITH_V>
DI void attnB_stage_kv(const bf16_t* __restrict__ kg  , unsigned char* Kd, unsigned char* Vd, int wave, int lane) {
#pragma unroll
    for (int i = 0; i < 2; ++i) {
        const int idx = wave * 2 + i;
        const int key = 4 * idx + (lane >> 4), cp = lane & 15;
        const bf16_t* g = kg + (size_t)key * ATT_IN;
        __builtin_amdgcn_global_load_lds((const unsigned*)(g + ((cp ^ (key & 15)) << 3)), (unsigned*)(Kd + idx * 1024 + lane * 16), 16, 0, 0);
        if (WITH_V) {
            const int cv = ((((cp >> 2) ^ (key & 3)) << 2) | (cp & 3));
            __builtin_amdgcn_global_load_lds((const unsigned*)(g + 512 + (cv << 3)), (unsigned*)(Vd + idx * 1024 + lane * 16), 16, 0, 0);
        }
    }
}
template <int KOFF, bool FULL>
DI void attnB_map(const unsigned char* Kc, const unsigned char* qlp, int ksw, int qsw, int fh, unsigned vm, unsigned vc, int tq,
                  float& m, float& l, f32x16 (&o)[4]) {
    f32x16 st;
#pragma unroll
    for (int r = 0; r < 16; ++r) st[r] = 0.f;
#pragma unroll
    for (int s = 0; s < 4; ++s) {
        const bf16x8 kf = *(const bf16x8*)(Kc + (((KOFF + 2 * s + fh) ^ ksw) << 4));
        const bf16x8 qf = *(const bf16x8*)(qlp + (((KOFF + 2 * s + fh) ^ qsw) << 4));
        st = MFMA32(kf, qf, st);
    }
    float al;
    if (FULL) osm_update_full(st, m, l, al); else osm_update(st, vm, m, l, al);
    if (!__all(al == 1.f)) {
#pragma unroll
        for (int d = 0; d < 4; ++d)
#pragma unroll
            for (int r = 0; r < 16; ++r) o[d][r] *= al;
    }
#pragma unroll
    for (int s = 0; s < 2; ++s) {
        const bf16x8 pf = pack_p(st, s);
        unsigned va[4]; bf16x8 vf[4];
#pragma unroll
        for (int d = 0; d < 4; ++d) va[d] = vc + s * 16 * 256 + ((d ^ tq) << 6);
        tr_quad(va, 8 * 256, vf);
#pragma unroll
        for (int d = 0; d < 4; ++d) o[d] = MFMA32(vf[d], pf, o[d]);
    }
}
DI void ph_attnB_fast(const Params& p, int item, unsigned char* smem) {
    const bf16_t* proj = WSP(bf16_t, WS_PROJ);
    const int tid = otid(), wave = tid >> 6, lane = tid & 63, fr = lane & 31, fh = lane >> 5;
    const int qt = 15 - (item >> 6), bh = item & 63, b = bh >> 2, h = bh & 3;
    const int q0 = qt * 128;
    const float lam = compute_lam(p, lane);
    const size_t rowbase = (size_t)b * SEQ;
    const int qrow = wave * 32 + fr, qpos = q0 + qrow;
    unsigned char* Ql = smem;
    unsigned char* Kl = smem + QB_BYTES;
    unsigned char* Vl = Kl + 2 * KB_BYTES;
    const bf16_t* kbase = proj + rowbase * ATT_IN + 2048 + h * 128;
    __syncthreads();
#pragma unroll
    for (int i = 0; i < 8; ++i) {
        const int idx = wave * 8 + i;
        const int row = 4 * idx + (lane >> 4), cp = lane & 15;
        __builtin_amdgcn_global_load_lds((const unsigned*)(proj + (rowbase + q0 + row) * ATT_IN + 1536 + h * 128 + ((cp ^ (row & 15)) << 3)),
                                         (unsigned*)(Ql + idx * 1024 + lane * 16), 16, 0, 0);
    }
    attnB_stage_kv<true>(kbase, Kl, Vl, wave, lane);
    const unsigned char* qlp = Ql + qrow * 256;
    const int qsw = qrow & 15, ksw = fr & 15;
    const int nkt = (q0 + 128) / 32;
    const int wlast = q0 + wave * 32 + 31;
    f32x16 o1[4], o2[4];
#pragma unroll
    for (int d = 0; d < 4; ++d)
#pragma unroll
        for (int r = 0; r < 16; ++r) { o1[d][r] = 0.f; o2[d][r] = 0.f; }
    float m1 = -1e30f, m2 = -1e30f, l1 = 0.f, l2 = 0.f;
    const int tq = (lane & 15) >> 2;
    const unsigned vrow = (unsigned)(uintptr_t)Vl + (4 * fh + tq) * 256 + (16 * ((lane >> 4) & 1) + 4 * (lane & 3)) * 2;
    asm volatile("s_waitcnt vmcnt(0)" ::: "memory");
    __syncthreads();
    for (int kt = 0; kt < nkt; ++kt) {
        const int cur = kt & 1;
        if (kt + 1 < nkt) attnB_stage_kv<true>(kbase + (size_t)(kt + 1) * 32 * ATT_IN, Kl + (cur ^ 1) * KB_BYTES, Vl + (cur ^ 1) * KB_BYTES, wave, lane);
        if (kt * 32 <= wlast) {
            const unsigned char* Kc = Kl + cur * KB_BYTES + fr * 256;
            const unsigned vc = vrow + cur * KB_BYTES;
            if (kt * 32 + 31 <= wlast - 31) {
                attnB_map<0, true>(Kc, qlp, ksw, qsw, fh, 0xffffu, vc, tq, m1, l1, o1);
                __builtin_amdgcn_sched_barrier(0);
                attnB_map<8, true>(Kc, qlp, ksw, qsw, fh, 0xffffu, vc, tq, m2, l2, o2);
            } else {
                unsigned vm = 0;
#pragma unroll
                for (int r = 0; r < 16; ++r) vm |= ((kt * 32 + crow(r, fh)) <= qpos) ? (1u << r) : 0u;
                attnB_map<0, false>(Kc, qlp, ksw, qsw, fh, vm, vc, tq, m1, l1, o1);
                __builtin_amdgcn_sched_barrier(0);
                attnB_map<8, false>(Kc, qlp, ksw, qsw, fh, vm, vc, tq, m2, l2, o2);
            }
        }
        asm volatile("s_waitcnt vmcnt(0)" ::: "memory");
        __syncthreads();
    }
    l1 += __shfl_xor(l1, 32); l2 += __shfl_xor(l2, 32);
    const float i1 = 1.f / l1, i2 = lam / l2;
    float ss = 0.f;
#pragma unroll
    for (int d = 0; d < 4; ++d)
#pragma unroll
        for (int r = 0; r < 16; ++r) { const float v = o1[d][r] * i1 - o2[d][r] * i2; o1[d][r] = v; ss += v * v; }
    ss += __shfl_xor(ss, 32);
    const float rinv = rsqrtf(ss * (1.f / 128.f) + EPSN) * 0.8f;
    const float* subg = p.in[11];
    bf16_t* op = WSP(bf16_t, WS_MIXED) + (rowbase + qpos) * DM + 512 + h * 128;
#pragma unroll
    for (int d = 0; d < 4; ++d)
#pragma unroll
        for (int g = 0; g < 4; ++g) {
            const int dim = 32 * d + 8 * g + 4 * fh;
            const float4 gg = *(const float4*)(subg + dim);
            uint2 w;
            w.x = pack2(o1[d][4 * g + 0] * rinv * gg.x, o1[d][4 * g + 1] * rinv * gg.y);
            w.y = pack2(o1[d][4 * g + 2] * rinv * gg.z, o1[d][4 * g + 3] * rinv * gg.w);
            *(uint2*)(op + dim) = w;
        }
}

#define KA_PITCH 128
#define VA_PITCH 192
#define WA_BYTES (32 * KA_PITCH + 32 * VA_PITCH)
template <int MODE>
DI void ph_attnA_fast(const Params& p, int item, unsigned char* smem) {
    const bf16_t* proj = WSP(bf16_t, WS_PROJ);
    const int tid = otid(), wave = tid >> 6, lane = tid & 63, fr = lane & 31, fh = lane >> 5;
    const int c = item & 15, h = (item >> 4) & 7, b = item >> 7;
    const size_t rowbase = (size_t)b * SEQ;
    const int qpos = MODE == 0 ? 128 * c + 32 * wave + fr : 16 * (32 * wave + fr) + c;
    const int pmin = MODE == 0 ? 128 * c + 32 * wave : 512 * wave + c, pmax = pmin + (MODE == 0 ? 31 : 496);
    bf16x8 qf[4];
    {
        const bf16_t* qp = proj + (rowbase + qpos) * ATT_IN + h * 64 + 8 * fh;
#pragma unroll
        for (int s = 0; s < 4; ++s) qf[s] = *(const bf16x8*)(qp + 16 * s);
    }
    f32x16 o[2];
#pragma unroll
    for (int d = 0; d < 2; ++d)
#pragma unroll
        for (int r = 0; r < 16; ++r) o[d][r] = 0.f;
    float m = -1e30f, l = 0.f;
    unsigned char* Kl = smem + wave * WA_BYTES;
    unsigned char* Vl = Kl + 32 * KA_PITCH;
    const unsigned vaddr = (unsigned)(uintptr_t)Vl + (4 * fh + ((lane & 15) >> 2)) * VA_PITCH + (16 * ((lane >> 4) & 1) + 4 * (lane & 3)) * 2;
    const int skey = lane >> 3, sc = lane & 7;
    int br = 0, d = MODE == 0 ? 1 : 16, W = MODE == 0 ? 128 : 2048, cls = MODE == 0 ? 0 : (c & 15);
    int j0 = MODE == 0 ? (pmin < 128 ? 0 : pmin - 128) : 0, jhi = MODE == 0 ? pmax : ((pmax - cls) >> 4);
    const bf16_t* kvbase = proj + rowbase * ATT_IN + 512 + h * 64 + sc * 8;
    uint4 rk0, rk1, rk2, rk3, rv0, rv1, rv2, rv3;
#define A_LOAD(i, RK, RV) do { int kp_ = cls + d * (j0 + skey + 8 * (i)); kp_ = kp_ > SEQ - 1 ? SEQ - 1 : kp_; kp_ = kp_ < 0 ? 0 : kp_; \
        const bf16_t* g_ = kvbase + (size_t)kp_ * ATT_IN; RK = *(const uint4*)g_; RV = *(const uint4*)(g_ + 512); } while (0)
#define A_WRITE(i, RK, RV) do { const int key_ = skey + 8 * (i); *(uint4*)(Kl + key_ * KA_PITCH + ((sc ^ ((key_ >> 1) & 7)) << 4)) = RK; \
        *(uint4*)(Vl + key_ * VA_PITCH + sc * 16) = RV; } while (0)
    A_LOAD(0, rk0, rv0); A_LOAD(1, rk1, rv1); A_LOAD(2, rk2, rv2); A_LOAD(3, rk3, rv3);
#pragma unroll 1
    for (;;) {
        A_WRITE(0, rk0, rv0); A_WRITE(1, rk1, rv1); A_WRITE(2, rk2, rv2); A_WRITE(3, rk3, rv3);
        const int cd = d, cW = W, ccls = cls, cj0 = j0;
        bool more = true;
        j0 += 32;
        if (j0 > jhi) {
            ++br;
            if (MODE == 0 || br == 2) more = false;
            else {
                d = 4; W = 512; cls = c & 3;
                const int lo = pmin - cls - W;
                j0 = lo < 0 ? 0 : lo >> 2;
                jhi = (pmax - cls) >> 2;
            }
        }
        A_LOAD(0, rk0, rv0); A_LOAD(1, rk1, rv1); A_LOAD(2, rk2, rv2); A_LOAD(3, rk3, rv3);
        f32x16 st;
#pragma unroll
        for (int r = 0; r < 16; ++r) st[r] = 0.f;
#pragma unroll
        for (int s = 0; s < 4; ++s) {
            const bf16x8 kf = *(const bf16x8*)(Kl + fr * KA_PITCH + (((2 * s + fh) ^ ((fr >> 1) & 7)) << 4));
            st = MFMA32(kf, qf[s], st);
        }
        float al;
        const int kfirst = ccls + cd * cj0, klast = kfirst + cd * 31;
        if (klast <= pmin && pmax - kfirst <= cW) osm_update_full(st, m, l, al);
        else {
            unsigned vm = 0;
#pragma unroll
            for (int r = 0; r < 16; ++r) {
                const int dist = qpos - (ccls + cd * (cj0 + crow(r, fh)));
                vm |= (dist >= 0 && dist <= cW) ? (1u << r) : 0u;
            }
            osm_update(st, vm, m, l, al);
        }
        if (!__all(al == 1.f)) {
#pragma unroll
            for (int dd = 0; dd < 2; ++dd)
#pragma unroll
                for (int r = 0; r < 16; ++r) o[dd][r] *= al;
        }
        {
            unsigned va[4]; bf16x8 vf[4];
            va[0] = vaddr; va[1] = vaddr + 64; va[2] = vaddr + 16 * VA_PITCH; va[3] = vaddr + 16 * VA_PITCH + 64;
            tr_quad(va, 8 * VA_PITCH, vf);
            const bf16x8 p0 = pack_p(st, 0), p1 = pack_p(st, 1);
            o[0] = MFMA32(vf[0], p0, o[0]); o[1] = MFMA32(vf[1], p0, o[1]);
            o[0] = MFMA32(vf[2], p1, o[0]); o[1] = MFMA32(vf[3], p1, o[1]);
        }
        if (!more) break;
    }
    l += __shfl_xor(l, 32);
    bf16_t* op = WSP(bf16_t, WS_MIXED) + (rowbase + qpos) * DM + h * 64;
    float* lsep = WSP(float, WS_LSE1) + (rowbase + qpos) * 8 + h;
    if (MODE == 0) {
        const float il = 1.f / l;
        if (fh == 0) *lsep = m + __logf(l);
#pragma unroll
        for (int dd = 0; dd < 2; ++dd)
#pragma unroll
            for (int g = 0; g < 4; ++g) {
                const int dim = 32 * dd + 8 * g + 4 * fh;
                uint2 w;
                w.x = pack2(o[dd][4 * g + 0] * il, o[dd][4 * g + 1] * il);
                w.y = pack2(o[dd][4 * g + 2] * il, o[dd][4 * g + 3] * il);
                *(uint2*)(op + dim) = w;
            }
    } else {
        const float lse1 = *lsep;
        const float M = fmaxf(m, lse1);
        const float w23 = __expf(m - M), w1 = __expf(lse1 - M);
        const float iden = 1.f / (l * w23 + w1);
        const float a23 = w23 * iden, a1 = w1 * iden;
        uint2 prev[2][4];
#pragma unroll
        for (int dd = 0; dd < 2; ++dd)
#pragma unroll
            for (int g = 0; g < 4; ++g) prev[dd][g] = *(const uint2*)(op + 32 * dd + 8 * g + 4 * fh);
#pragma unroll
        for (int dd = 0; dd < 2; ++dd)
#pragma unroll
            for (int g = 0; g < 4; ++g) {
                const int dim = 32 * dd + 8 * g + 4 * fh;
                const float p0 = __uint_as_float(prev[dd][g].x << 16), p1 = __uint_as_float(prev[dd][g].x & 0xffff0000u);
                const float p2 = __uint_as_float(prev[dd][g].y << 16), p3 = __uint_as_float(prev[dd][g].y & 0xffff0000u);
                uint2 w;
                w.x = pack2(o[dd][4 * g + 0] * a23 + p0 * a1, o[dd][4 * g + 1] * a23 + p1 * a1);
                w.y = pack2(o[dd][4 * g + 2] * a23 + p2 * a1, o[dd][4 * g + 3] * a23 + p3 * a1);
                *(uint2*)(op + dim) = w;
            }
    }
}
#define NITEM_B 1024
#define NITEM_A 2048
DI void ph_attn_fast(const Params& p, int vb, unsigned char* smem) {
    if (vb < NITEM_B) {
        const int item = vb < 512 ? vb : 512 + (1023 - vb);
        ph_attnB_fast(p, item, smem);
    } else ph_attnA_fast<0>(p, vb - NITEM_B, smem);
}


DI void ph_spatial_fast(const Params& p, int item, unsigned char* smem) {
    const int tid = otid(), wave = tid >> 6, lane = tid & 63, fr = lane & 31, fh = lane >> 5;
    const int wm = wave >> 1, wn = wave & 1;
    const int chunk = item >> 3, g = item & 7;
    bf16_t* u = WSP(bf16_t, WS_Z_U);
    const bf16_t* vt = WSP(bf16_t, WS_Z_VT);
    const float* ssq = WSP(float, WS_SSQ);
    const float* wsp = p.in[16] + (size_t)g * 128 * 128;
    float* rinv = (float*)(smem + 66 * 1024);
    unsigned char* Bt = smem + 32768;
    __syncthreads();
    if (tid < 128) {
        const float4* sp = (const float4*)(ssq + (size_t)(chunk * 128 + tid) * 64);
        float sacc = 0.f;
#pragma unroll
        for (int j = 0; j < 16; ++j) { const float4 q = sp[j]; sacc += (q.x + q.y) + (q.z + q.w); }
        rinv[tid] = rsqrtf(sacc * (1.f / CW) + EPSN);
    }
    const size_t vrow0 = (size_t)chunk * CW + g * 256;
    stage_tile(vt, 128, (int)vrow0, 0, Bt, wave, lane);
    stage_tile(vt, 128, (int)vrow0, 64, Bt + 16384, wave, lane);
    __syncthreads();
#pragma unroll
    for (int i = 0; i < 8; ++i) {
        const int id = tid + 256 * i;
        const int t = id >> 4, sc = id & 15;
        const float4 w0 = *(const float4*)(wsp + t * 128 + sc * 8);
        const float4 w1 = *(const float4*)(wsp + t * 128 + sc * 8 + 4);
        const float4 r0 = *(const float4*)(rinv + sc * 8);
        const float4 r1 = *(const float4*)(rinv + sc * 8 + 4);
        const int s0 = sc * 8;
        uint4 o;
        o.x = pack2(s0 + 0 <= t ? w0.x * r0.x : 0.f, s0 + 1 <= t ? w0.y * r0.y : 0.f);
        o.y = pack2(s0 + 2 <= t ? w0.z * r0.z : 0.f, s0 + 3 <= t ? w0.w * r0.w : 0.f);
        o.z = pack2(s0 + 4 <= t ? w1.x * r1.x : 0.f, s0 + 5 <= t ? w1.y * r1.y : 0.f);
        o.w = pack2(s0 + 6 <= t ? w1.z * r1.z : 0.f, s0 + 7 <= t ? w1.w * r1.w : 0.f);
        const int kt = sc >> 3, c = sc & 7;
        *(uint4*)(smem + kt * 16384 + t * 128 + ((c ^ ((t >> 1) & 7)) << 4)) = o;
    }
#pragma unroll 1
    for (int nt = 0; nt < 2; ++nt) {
        asm volatile("s_waitcnt vmcnt(0)" ::: "memory");
        __syncthreads();
        f32x16 acc[2][2];
#pragma unroll
        for (int i = 0; i < 2; ++i)
#pragma unroll
            for (int j = 0; j < 2; ++j)
#pragma unroll
                for (int r = 0; r < 16; ++r) acc[i][j][r] = 0.f;
#pragma unroll
        for (int kt = 0; kt < 2; ++kt)
#pragma unroll
            for (int s = 0; s < 4; ++s) {
                bf16x8 a[2], b[2];
#pragma unroll
                for (int i = 0; i < 2; ++i) {
                    a[i] = lds_frag(smem + kt * 16384, wm * 64 + i * 32 + fr, 2 * s + fh);
                    b[i] = lds_frag(Bt + kt * 16384, wn * 64 + i * 32 + fr, 2 * s + fh);
                }
#pragma unroll
                for (int i = 0; i < 2; ++i)
#pragma unroll
                    for (int j = 0; j < 2; ++j) acc[i][j] = MFMA32(a[i], b[j], acc[i][j]);
            }
        __syncthreads();
        float* st = (float*)(Bt + wave * (32 * 65 * 4));
#pragma unroll
        for (int i = 0; i < 2; ++i) {
#pragma unroll
            for (int j = 0; j < 2; ++j)
#pragma unroll
                for (int r = 0; r < 16; ++r) st[crow(r, fh) * 65 + j * 32 + fr] = acc[i][j][r];
            const int t = wm * 64 + i * 32 + fr;
            const int c0 = g * 256 + nt * 128 + wn * 64 + fh * 32;
            bf16_t* up = u + (size_t)(chunk * 128 + t) * CW + c0;
            const float bias = p.in[17][g * 128 + t];
            const float* gn = p.in[15] + c0;
            uint4 ur[4];
#pragma unroll
            for (int q = 0; q < 4; ++q) ur[q] = ((const uint4*)up)[q];
#pragma unroll
            for (int q = 0; q < 4; ++q) {
                float uf[8]; unpack8(ur[q], uf);
                const float4 g0 = *(const float4*)(gn + 8 * q), g1 = *(const float4*)(gn + 8 * q + 4);
                const float gg[8] = {g0.x, g0.y, g0.z, g0.w, g1.x, g1.y, g1.z, g1.w};
                float ov[8];
#pragma unroll
                for (int e = 0; e < 8; ++e) ov[e] = uf[e] * (st[fr * 65 + fh * 32 + 8 * q + e] * gg[e] + bias);
                uint4 o; o.x = pack2(ov[0], ov[1]); o.y = pack2(ov[2], ov[3]); o.z = pack2(ov[4], ov[5]); o.w = pack2(ov[6], ov[7]);
                ((uint4*)up)[q] = o;
            }
        }
        if (nt == 0) {
            __syncthreads();
            stage_tile(vt, 128, (int)vrow0 + 128, 0, Bt, wave, lane);
            stage_tile(vt, 128, (int)vrow0 + 128, 64, Bt + 16384, wave, lane);
        }
    }
}

#define XB_TMO      128
#define XB_XCNT(j)  (256  + 64 * (j))
#define XB_XSUB(j)  (1280 + 64 * (j))
#define XB_XGEN(j)  (2304 + 64 * (j))
#define XB_TOP      3328
#define XB_TOPGEN   3392
#define XCD_BAR_WORDS 3456
#define XB_SPIN_CAP (1u << 22)
DI unsigned xb_ld(unsigned* p) { return __hip_atomic_load(p, __ATOMIC_RELAXED, __HIP_MEMORY_SCOPE_AGENT); }
DI unsigned xb_add(unsigned* p, unsigned v) { return __hip_atomic_fetch_add(p, v, __ATOMIC_RELAXED, __HIP_MEMORY_SCOPE_AGENT); }
DI unsigned xb_xcc_id() { return (unsigned)__builtin_amdgcn_s_getreg((3 << 11) | 20) & 0xFu; }
#define XB_SPIN(cond, bar) do { unsigned _sp = 0; while (cond) { __builtin_amdgcn_s_sleep(1); \
    if ((++_sp & 255u) == 0u) { if (xb_ld(&(bar)[XB_TMO])) break; if (_sp > XB_SPIN_CAP) { atomicAdd(&(bar)[XB_TMO], 1u); break; } } } } while (0)
struct XcdBarrier { unsigned* bar; unsigned x; volatile LAS unsigned* st; };
DI XcdBarrier xcd_barrier_post(unsigned* bar, volatile LAS unsigned* st) {
    XcdBarrier b; b.bar = bar; b.x = xb_xcc_id(); b.st = st;
    if (threadIdx.x == 0) st[2] = xb_add(&bar[XB_XCNT(b.x)], 1u);
    return b;
}
DI void xcd_barrier_complete(unsigned* bar, unsigned x, unsigned& nloc, unsigned& nx, unsigned& xi) {
    const unsigned G = gridDim.x * gridDim.y * gridDim.z;
    unsigned sum, cnt, mine, below, sp = 0u;
    for (;;) {
        sum = 0u; cnt = 0u; mine = 0u; below = 0u;
#pragma unroll
        for (unsigned j = 0; j < 16; ++j) { const unsigned c = xb_ld(&bar[XB_XCNT(j)]); sum += c; cnt += (c > 0u) ? 1u : 0u; mine = (j == x) ? c : mine; below += (c > 0u && j < x) ? 1u : 0u; }
        if (sum == G) break;
        __builtin_amdgcn_s_sleep(1);
        if ((++sp & 255u) == 0u) { if (xb_ld(&bar[XB_TMO])) break; if (sp > XB_SPIN_CAP) { atomicAdd(&bar[XB_TMO], 1u); break; } }
    }
    nloc = mine > 0u ? mine : 1u; nx = cnt > 0u ? cnt : 1u; xi = below;
}
DI void xcd_barrier(const XcdBarrier& b) {
    asm volatile("s_waitcnt vmcnt(0)" ::: "memory");
    __syncthreads();
    if (threadIdx.x == 0) {
        unsigned* bar = b.bar;
        __builtin_amdgcn_s_waitcnt(0);
        unsigned nloc = b.st[0], nx = b.st[1];
        if (nloc == 0u) { unsigned xi; xcd_barrier_complete(bar, b.x, nloc, nx, xi); b.st[0] = nloc; b.st[1] = nx; b.st[3] = xi; }
        const unsigned old = xb_add(&bar[XB_XSUB(b.x)], 1u);
        const unsigned gen = old / nloc;
        if (old + 1u == (gen + 1u) * nloc) {
            __builtin_amdgcn_fence(__ATOMIC_RELEASE, "agent");
            asm volatile("s_waitcnt vmcnt(0)" ::: "memory");
            const unsigned og = xb_add(&bar[XB_TOP], 1u);
            const unsigned tg = og / nx;
            if (og + 1u == (tg + 1u) * nx) xb_add(&bar[XB_TOPGEN], 1u);
            else XB_SPIN(xb_ld(&bar[XB_TOPGEN]) == tg, bar);
            __builtin_amdgcn_fence(__ATOMIC_ACQUIRE, "agent");
            xb_add(&bar[XB_XGEN(b.x)], 1u);
            asm volatile("s_waitcnt vmcnt(0)" ::: "memory");
        } else {
            XB_SPIN(xb_ld(&bar[XB_XGEN(b.x)]) == gen, bar);
            __builtin_amdgcn_fence(__ATOMIC_ACQUIRE, "agent");
            asm volatile("s_waitcnt vmcnt(0)" ::: "memory");
        }
    }
    __syncthreads();
}

enum { PH_PREP = 0, PH_GEMM1, PH_ATTN, PH_ATTN2, PH_GEMM2,
       PH_NORM_P0, PH_GEMMQ0, PH_SCORE0, PH_PDOWN0, PH_PCOMB0, PH_PUP0, PH_NORM_SGU,
       PH_GEMM4, PH_SPATIAL, PH_GEMM5,
       PH_NORM_P1, PH_GEMMQ1, PH_SCORE1, PH_PDOWN1, PH_PCOMB1, PH_PUP1, PH_COUNT };

__host__ __device__ constexpr int phase_nvb(int ph) {
    switch (ph) {
        case PH_PREP: return PREP_N;
        case PH_GEMM1: return (ATT_IN / 256) * (NTOK / 256);
        case PH_ATTN: return NITEM_B + NITEM_A;
        case PH_ATTN2: return NITEM_A;
        case PH_GEMM2: return (DM / 256) * (NTOK / 256);
        case PH_NORM_P0: case PH_NORM_P1: case PH_NORM_SGU: return NTOK / 16;
        case PH_GEMMQ0: case PH_GEMMQ1: return 16 * (NTOK / 256);
        case PH_SCORE0: case PH_SCORE1: return (NTOK / 32) * 8 / 4;
        case PH_PCOMB0: case PH_PCOMB1: return NTOK / 8;
        case PH_GEMM4: return (4096 / 256) * (NTOK / 256);
        case PH_SPATIAL: return 256 * 8;
        case PH_GEMM5: return (DM / 256) * (NTOK / 256);
    }
    return 0;
}

template <int PH>
DI void run_vb(const Params& p, int vb, unsigned char* smem) {
    if constexpr (PH == PH_PREP) ph_prep(p, vb, smem);
    else if constexpr (PH == PH_ATTN) ph_attn_fast(p, vb, smem);
    else if constexpr (PH == PH_ATTN2) ph_attnA_fast<1>(p, vb, smem);
    else if constexpr (PH == PH_NORM_P0 || PH == PH_NORM_P1) rmsnorm_rows<true, 4>(WSP(bf16_t, WS_RES), p.in[19] + (PH == PH_NORM_P1 ? DM : 0), vb, WSP(signed char, WS_XQ), WSP(float, WS_XSC));
    else if constexpr (PH == PH_PCOMB0 || PH == PH_PCOMB1) ph_peer_comb(p, vb, PH == PH_PCOMB1 ? 1 : 0);
    else if constexpr (PH == PH_NORM_SGU) rmsnorm_rows<true, 4>(WSP(bf16_t, WS_RES), p.in[13], vb, WSP(signed char, WS_XQ), WSP(float, WS_XSC));
    else if constexpr (PH == PH_SPATIAL) ph_spatial_fast(p, vb, smem);
}

template <int PH>
DI void run_phase(const Params& p, unsigned char* smem) {
    if constexpr (PH == PH_PDOWN0 || PH == PH_PDOWN1) run_peer_sliced<false>(p, PH == PH_PDOWN1 ? 1 : 0, smem);
    else if constexpr (PH == PH_PUP0 || PH == PH_PUP1) run_peer_sliced<true>(p, PH == PH_PUP1 ? 1 : 0, smem);
    else if constexpr (PH == PH_SCORE0 || PH == PH_SCORE1) run_score(p, PH == PH_SCORE1 ? 1 : 0, smem);
    else if constexpr (PH == PH_GEMMQ0 || PH == PH_GEMMQ1) run_gemmq_pg8(p, PH == PH_GEMMQ1 ? 1 : 0, smem);
    else if constexpr (PH == PH_GEMM1) run_gemm1_pg8(p, smem);
    else if constexpr (PH == PH_GEMM4) run_gemm4_pg8(p, smem);
    else if constexpr (PH == PH_GEMM2) run_gemm_pg8<0>(p, smem);
    else if constexpr (PH == PH_GEMM5) run_gemm_pg8<1>(p, smem);
    else {
        constexpr int nvb = phase_nvb(PH);
        const int g = threadIdx.x >> 8;
        for (int vb = 2 * blockIdx.x; vb < nvb; vb += 2 * gridDim.x)
            if (vb + g < nvb) run_vb<PH>(p, vb + g, smem + g * GROUP_SMEM);
    }
}

template <int PH>
DI void run_from(const Params& p, unsigned char* smem, cg::grid_group& grid, const XcdBarrier& xb) {
    run_phase<PH>(p, smem);
    if constexpr (PH + 1 < PH_COUNT) {
        if constexpr (PH == 1) grid.sync(); else xcd_barrier(xb);
        run_from<PH + 1>(p, smem, grid, xb);
    }
}

__global__ void __launch_bounds__(NTHREADS, 2) k_mega(Params p) {
    extern __shared__ __attribute__((aligned(16))) unsigned char smem[];
    cg::grid_group grid = cg::this_grid();
    volatile LAS unsigned* st = (volatile LAS unsigned*)(smem + SMEM_BYTES);
    if (threadIdx.x == 0) { st[0] = 0u; st[1] = 0u; st[2] = 0u; st[3] = 0u; }
    __syncthreads();
    const XcdBarrier xb = xcd_barrier_post((unsigned*)(p.ws + WS_CTL), st);
    run_from<0>(p, smem, grid, xb);
}


extern "C" void kernel_launch(void* const* d_in, const int* in_sizes, int n_in, void* d_out, int out_size, void* d_ws, size_t ws_size, hipStream_t stream) {
    if (n_in != 24 || ws_size < WS_NEED || in_sizes[0] != NTOK * DM || out_size != NTOK * DM || in_sizes[22] != 2 * NEXP * DM) {
        fprintf(stderr, "kernel_launch: built for x[16,2048,1024] with 24 inputs and >= 512 MiB of workspace; got n_in %d, in0 %d, out %d, ws %zu: nothing launched\n", n_in, in_sizes[0], out_size, ws_size); return; }
    static int grid_blocks = 0;
    if (!grid_blocks) {
        int dev = 0, cus = 0, per_cu = 0;
        (void)hipGetDevice(&dev);
        (void)hipDeviceGetAttribute(&cus, hipDeviceAttributeMultiprocessorCount, dev);
        (void)hipFuncSetAttribute((const void*)k_mega, hipFuncAttributeMaxDynamicSharedMemorySize, SMEM_ALLOC);
        (void)hipOccupancyMaxActiveBlocksPerMultiprocessor(&per_cu, (const void*)k_mega, NTHREADS, SMEM_ALLOC);
        if (per_cu > 1) per_cu = 1;
        if (per_cu < 1) { fprintf(stderr, "kernel_launch: occupancy query returned %d\n", per_cu); per_cu = 1; }
        grid_blocks = cus * per_cu;
    }
    Params p{};
    for (int i = 0; i < 24; ++i) p.in[i] = (const float*)d_in[i];
    p.out = (float*)d_out;
    p.ws = (unsigned char*)d_ws;
    void* args[] = {&p};
    if (hipMemsetAsync((unsigned char*)d_ws + WS_CTL, 0, XCD_BAR_WORDS * 4, stream) != hipSuccess) { fprintf(stderr, "kernel_launch: memset of the barrier words failed\n"); return; }
    hipError_t e = hipLaunchCooperativeKernel((const void*)k_mega, dim3(grid_blocks), dim3(NTHREADS), args, SMEM_ALLOC, stream);
    if (e != hipSuccess) fprintf(stderr, "cooperative launch failed: %s (grid %d)\n", hipGetErrorString(e), grid_blocks);
}
```

```cpp
#include <hip/hip_runtime.h>
#include <stdint.h>
#include <stdio.h>

#define NTOK   32768
#define DM     1024
#define SEQ    2048
#define NB     16
#define ATT_IN 3072
#define CW     2048
#define NEXP   16384
#define EPSN   1e-6f

typedef unsigned short bf16_t;
typedef unsigned int u32;

#define DI __device__ __forceinline__
#define LAS __attribute__((address_space(3)))

DI int otid() { int t = threadIdx.x & 255; asm volatile("" : "+v"(t)); return t; }
DI int otid512() { int t = threadIdx.x; asm volatile("" : "+v"(t)); return t; }
DI float bf2f(bf16_t v) { return __uint_as_float(((u32)v) << 16); }
typedef __bf16 bf16v2 __attribute__((ext_vector_type(2)));
DI bf16_t f2bf(float f) { const __bf16 h = (__bf16)f; return __builtin_bit_cast(bf16_t, h); }
DI u32 pack2(float lo, float hi) { bf16v2 v; v[0] = (__bf16)lo; v[1] = (__bf16)hi; return __builtin_bit_cast(u32, v); }
DI float gelu_tanh(float x) {
    const float y = 0.7978845608028654f * (x + 0.044715f * x * x * x);
    const float e = __expf(2.f * y);
    const float t = 1.f - 2.f / (e + 1.f);
    return 0.5f * x * (1.f + t);
}
DI float wave_sum(float v) {
#pragma unroll
    for (int o = 1; o < 64; o <<= 1) v += __shfl_xor(v, o);
    return v;
}
DI float wave_max(float v) {
#pragma unroll
    for (int o = 1; o < 64; o <<= 1) v = fmaxf(v, __shfl_xor(v, o));
    return v;
}
DI u32 f2ord(float f) { u32 u = __float_as_uint(f); return (u & 0x80000000u) ? ~u : (u | 0x80000000u); }
DI float ord2f(u32 o) { u32 u = (o & 0x80000000u) ? (o & 0x7fffffffu) : ~o; return __uint_as_float(u); }

#define MiB ((size_t)1 << 20)
#define WS_CTL      ((size_t)0)
#define WS_W_ATTIN  (1 * MiB)
#define WS_W_ATTOUT (7 * MiB)
#define WS_W_SGUIN  (9 * MiB)
#define WS_W_SGUOUT (17 * MiB)
#define WS_W_PQ     (21 * MiB)
#define WS_WQS      (25 * MiB)
#define WS_WAS      (25 * MiB + 64 * 1024)
#define WS_WSS      (25 * MiB + 128 * 1024)
#define WS_W_SUBK   (29 * MiB)
#define WS_DOWN     (32 * MiB)
#define WS_UP       (64 * MiB)
#define WS_DSC      (96 * MiB)
#define WS_USC      (96 * MiB + 128 * 1024)
#define WS_LSE1     (30 * MiB)
#define WS_XQ       (100 * MiB)
#define WS_XSC      (132 * MiB)
#define WS_RES      (160 * MiB)
#define WS_BIG      (224 * MiB)
#define WS_PROJ     (WS_BIG)
#define WS_MIXED    (WS_BIG + 192 * MiB)
#define WS_Z_U      (WS_BIG)
#define WS_Z_VT     (WS_BIG + 128 * MiB)
#define WS_RIDX     (WS_BIG + 32 * MiB)
#define WS_COEF     (WS_BIG + 40 * MiB)
#define WS_RG       (WS_BIG + 48 * MiB)
#define WS_QBUF     (WS_BIG + 64 * MiB)
#define WS_SSQ      (WS_BIG + 256 * MiB)
#define WS_NEED     (512 * MiB)

struct Params {
    const float* in[24];
    float* out;
    unsigned char* ws;
};

#include <hip/hip_cooperative_groups.h>
namespace cg = cooperative_groups;

#define GROUP_SMEM (68 * 1024)
#define PG8_EXTRA (128 * 1024)
#define SMEM_BYTES (144 * 1024)
#define SMEM_ALLOC (SMEM_BYTES + 16)
#define NTHREADS 512

#define WSP(T, off) ((T*)(p.ws + (off)))


DI void transpose_tile(const float* __restrict__ W, bf16_t* __restrict__ Wt, int K, int N, int t, unsigned char* smem) {
    float* tile = (float*)smem;
    const int tid = otid();
    const int ntn = N / 64;
    const int n0 = (t % ntn) * 64, k0 = (t / ntn) * 64;
    __syncthreads();
    {
        const int n4 = tid & 15, kr = tid >> 4;
#pragma unroll
        for (int i = 0; i < 4; ++i) {
            const int k = kr + 16 * i;
            const float4 v = *(const float4*)(W + (size_t)(k0 + k) * N + n0 + 4 * n4);
            tile[k * 65 + 4 * n4 + 0] = v.x; tile[k * 65 + 4 * n4 + 1] = v.y; tile[k * 65 + 4 * n4 + 2] = v.z; tile[k * 65 + 4 * n4 + 3] = v.w;
        }
    }
    __syncthreads();
    {
        const int n = tid >> 2, kc = tid & 3;
        float v[16];
#pragma unroll
        for (int j = 0; j < 16; ++j) v[j] = tile[(16 * kc + j) * 65 + n];
        uint4 o0, o1;
        o0.x = pack2(v[0], v[1]); o0.y = pack2(v[2], v[3]); o0.z = pack2(v[4], v[5]); o0.w = pack2(v[6], v[7]);
        o1.x = pack2(v[8], v[9]); o1.y = pack2(v[10], v[11]); o1.z = pack2(v[12], v[13]); o1.w = pack2(v[14], v[15]);
        uint4* dst = (uint4*)(Wt + (size_t)(n0 + n) * K + k0 + 16 * kc);
        dst[0] = o0; dst[1] = o1;
    }
}
DI void cvt_chunk(const float* __restrict__ src, bf16_t* __restrict__ dst, int c) {
    const size_t base = (size_t)c * 2048;
#pragma unroll
    for (int i = 0; i < 8; ++i) {
        const size_t idx = base + i * 256 + otid();
        const float4 v = ((const float4*)src)[idx];
        uint2 o; o.x = pack2(v.x, v.y); o.y = pack2(v.z, v.w);
        ((uint2*)dst)[idx] = o;
    }
}
DI int q8(float v) { int i = __float2int_rn(v); i = i > 127 ? 127 : i; i = i < -127 ? -127 : i; return i & 255; }
template <bool IN_BF16, int ROWS>
DI void rmsnorm_rows(const void* __restrict__ x, const float* __restrict__ g, int vb, signed char* xq, float* xsc) {
    const int lane = otid() & 63;
    const int row0 = (vb * 4 + (otid() >> 6)) * ROWS;
    float4 v[ROWS][4];
#pragma unroll
    for (int r = 0; r < ROWS; ++r)
#pragma unroll
        for (int j = 0; j < 4; ++j) {
            if (IN_BF16) { const uint2 w = ((const uint2*)((const bf16_t*)x + (size_t)(row0 + r) * DM))[lane + 64 * j];
                v[r][j] = make_float4(__uint_as_float(w.x << 16), __uint_as_float(w.x & 0xffff0000u), __uint_as_float(w.y << 16), __uint_as_float(w.y & 0xffff0000u)); }
            else v[r][j] = ((const float4*)((const float*)x + (size_t)(row0 + r) * DM))[lane + 64 * j];
        }
    float4 gg[4];
#pragma unroll
    for (int j = 0; j < 4; ++j) gg[j] = ((const float4*)g)[lane + 64 * j];
#pragma unroll
    for (int r = 0; r < ROWS; ++r) {
        float ss = 0.f;
#pragma unroll
        for (int j = 0; j < 4; ++j) ss += v[r][j].x * v[r][j].x + v[r][j].y * v[r][j].y + v[r][j].z * v[r][j].z + v[r][j].w * v[r][j].w;
        ss = wave_sum(ss);
        const float rinv = rsqrtf(ss * (1.f / DM) + EPSN);
        float am = 0.f;
#pragma unroll
        for (int j = 0; j < 4; ++j) {
            v[r][j].x *= rinv * gg[j].x; v[r][j].y *= rinv * gg[j].y; v[r][j].z *= rinv * gg[j].z; v[r][j].w *= rinv * gg[j].w;
            am = fmaxf(am, fmaxf(fmaxf(fabsf(v[r][j].x), fabsf(v[r][j].y)), fmaxf(fabsf(v[r][j].z), fabsf(v[r][j].w))));
        }
        am = wave_max(am);
        const float sc = am > 0.f ? 127.f / am : 0.f;
        u32* qrow = (u32*)(xq + (size_t)(row0 + r) * DM);
#pragma unroll
        for (int j = 0; j < 4; ++j)
            qrow[lane + 64 * j] = (u32)q8(v[r][j].x * sc) | ((u32)q8(v[r][j].y * sc) << 8) | ((u32)q8(v[r][j].z * sc) << 16) | ((u32)q8(v[r][j].w * sc) << 24);
        if (lane == 0) xsc[row0 + r] = am * (1.f / 127.f);
    }
}
#define PREP_T0 48
#define PREP_T1 (PREP_T0 + 16 * 16)
#define PREP_T2 (PREP_T1 + 64)
#define PREP_T3 (PREP_T2 + 16 * 32)
#define PREP_T4 (PREP_T3 + 2 * 32)
#define PREP_C0 (PREP_T4 + 64)
#define PREP_C1 (PREP_C0 + 4096)
#define PREP_C2 (PREP_C1 + 4096)
#define PREP_N  (PREP_C2 + 4096)
template <bool INT8>
DI void fp8_rows(const float* __restrict__ src, unsigned char* __restrict__ dst, float* __restrict__ inv_scale, int vb) {
    const int lane = otid() & 63;
    const int row0 = (vb * 4 + (otid() >> 6)) * 2;
    float4 v[2][4];
#pragma unroll
    for (int r = 0; r < 2; ++r)
#pragma unroll
        for (int j = 0; j < 4; ++j) v[r][j] = ((const float4*)(src + (size_t)(row0 + r) * DM) + lane)[64 * j];
#pragma unroll
    for (int r = 0; r < 2; ++r) {
        const int row = row0 + r;
        float am = 0.f;
#pragma unroll
        for (int j = 0; j < 4; ++j) am = fmaxf(am, fmaxf(fmaxf(fabsf(v[r][j].x), fabsf(v[r][j].y)), fmaxf(fabsf(v[r][j].z), fabsf(v[r][j].w))));
        am = wave_max(am);
        float sc, inv;
        if (INT8) { sc = am > 0.f ? 127.f / am : 0.f; inv = am * (1.f / 127.f); }
        else {
            int e = (int)((__float_as_uint(am) >> 23) & 255u) - 127;
            if (am == 0.f) e = 0;
            e = e < -100 ? -100 : e;
            sc = __uint_as_float((u32)(127 + 7 - e) << 23); inv = __uint_as_float((u32)(127 + e - 7) << 23);
        }
        unsigned char* drow = dst + (size_t)(row >> 14) * NEXP * DM + (size_t)(row & (NEXP - 1)) * 128;
#pragma unroll
        for (int j = 0; j < 4; ++j) {
            const int dim = 4 * (lane + 64 * j);
            u32 w;
            if (INT8) w = (u32)q8(v[r][j].x * sc) | ((u32)q8(v[r][j].y * sc) << 8) | ((u32)q8(v[r][j].z * sc) << 16) | ((u32)q8(v[r][j].w * sc) << 24);
            else { int t = __builtin_amdgcn_cvt_pk_fp8_f32(v[r][j].x * sc, v[r][j].y * sc, 0, false); t = __builtin_amdgcn_cvt_pk_fp8_f32(v[r][j].z * sc, v[r][j].w * sc, t, true); w = (u32)t; }
            *(u32*)(drow + (size_t)(dim >> 7) * NEXP * 128 + (dim & 127)) = w;
        }
        if (lane == 0) inv_scale[row] = inv;
    }
}
DI void wq8_item(const float* __restrict__ W, signed char* __restrict__ Wt, float* __restrict__ wsc, int t, unsigned char* smem, int N) {
    float* red = (float*)smem;
    const int tid = otid(), n = tid & 63, kq = tid >> 6;
    const float* col = W + t * 64 + n;
    float am = 0.f;
#pragma unroll 16
    for (int k = 0; k < 256; ++k) am = fmaxf(am, fabsf(col[(size_t)(kq * 256 + k) * N]));
    __syncthreads();
    red[kq * 64 + n] = am;
    __syncthreads();
    am = fmaxf(fmaxf(red[n], red[64 + n]), fmaxf(red[128 + n], red[192 + n]));
    const float sc = am > 0.f ? 127.f / am : 0.f;
    if (kq == 0) wsc[t * 64 + n] = am * (1.f / 127.f);
    signed char* drow = Wt + (size_t)(t * 64 + n) * 1024;
#pragma unroll 1
    for (int kb = 0; kb < 16; ++kb) {
        const int k0 = kb * 64 + kq * 16;
        u32 w[4];
#pragma unroll
        for (int j = 0; j < 4; ++j) {
            const float* c4 = col + (size_t)(k0 + 4 * j) * N;
            w[j] = (u32)q8(c4[0] * sc) | ((u32)q8(c4[N] * sc) << 8) | ((u32)q8(c4[2 * N] * sc) << 16) | ((u32)q8(c4[3 * N] * sc) << 24);
        }
        *(uint4*)(drow + k0) = make_uint4(w[0], w[1], w[2], w[3]);
    }
}
DI void ph_prep(const Params& p, int vb, unsigned char* smem) {
    if (vb < PREP_T0) wq8_item(p.in[2], WSP(signed char, WS_W_ATTIN), WSP(float, WS_WAS), vb, smem, ATT_IN);
    else if (vb < PREP_T1) transpose_tile(p.in[12], WSP(bf16_t, WS_W_ATTOUT), DM, DM, vb - PREP_T0, smem);
    else if (vb < PREP_T2) wq8_item(p.in[14], WSP(signed char, WS_W_SGUIN), WSP(float, WS_WSS), vb - PREP_T1, smem, 4096);
    else if (vb < PREP_T3) transpose_tile(p.in[18], WSP(bf16_t, WS_W_SGUOUT), CW, DM, vb - PREP_T2, smem);
    else if (vb < PREP_T4) { const int t = vb - PREP_T3, l = t / 32; wq8_item(p.in[20] + (size_t)l * DM * 2048, WSP(signed char, WS_W_PQ) + (size_t)l * 2048 * DM, WSP(float, WS_WQS) + l * 2048, t % 32, smem, 2048); }
    else if (vb < PREP_C0) cvt_chunk(p.in[21], WSP(bf16_t, WS_W_SUBK), vb - PREP_T4);
    else if (vb < PREP_C1) fp8_rows<true>(p.in[22], p.ws + WS_DOWN, WSP(float, WS_DSC), vb - PREP_C0);
    else if (vb < PREP_C2) fp8_rows<false>(p.in[23], p.ws + WS_UP, WSP(float, WS_USC), vb - PREP_C1);
    else rmsnorm_rows<false, 2>(p.in[0], p.in[1], vb - PREP_C2, WSP(signed char, WS_XQ), WSP(float, WS_XSC));
}

DI float compute_lam(const Params& p, int lane) {
    const float a = wave_sum(p.in[7][lane] * p.in[8][lane]);
    const float b = wave_sum(p.in[9][lane] * p.in[10][lane]);
    return __expf(a) - __expf(b) + 0.2f;
}
DI void ce_desc(u32& a, u32& b) { const u32 hi = max(a, b), lo = min(a, b); a = hi; b = lo; }
DI void sort16_desc(u32 (&v)[16]) {
#define SCE(a, b) ce_desc(v[a], v[b]);
    SCE(0,13) SCE(1,12) SCE(2,15) SCE(3,14) SCE(4,8) SCE(5,6) SCE(7,11) SCE(9,10)
    SCE(0,5) SCE(1,7) SCE(2,9) SCE(3,4) SCE(6,13) SCE(8,14) SCE(10,15) SCE(11,12)
    SCE(0,1) SCE(2,3) SCE(4,5) SCE(6,8) SCE(7,9) SCE(10,11) SCE(12,13) SCE(14,15)
    SCE(0,2) SCE(1,3) SCE(4,10) SCE(5,11) SCE(6,7) SCE(8,9) SCE(12,14) SCE(13,15)
    SCE(1,2) SCE(3,12) SCE(4,6) SCE(5,7) SCE(8,10) SCE(9,11) SCE(13,14)
    SCE(1,4) SCE(2,6) SCE(5,8) SCE(7,10) SCE(9,13) SCE(11,14)
    SCE(2,4) SCE(3,6) SCE(9,12) SCE(11,13)
    SCE(3,5) SCE(6,8) SCE(7,9) SCE(10,12)
    SCE(3,4) SCE(5,6) SCE(7,8) SCE(9,10) SCE(11,12)
    SCE(6,7) SCE(8,9)
#undef SCE
}
DI void merge16_desc(u32 (&a)[16], const u32 (&b)[16]) {
#pragma unroll
    for (int i = 0; i < 16; ++i) a[i] = max(a[i], b[15 - i]);
#pragma unroll
    for (int j = 8; j > 0; j >>= 1)
#pragma unroll
        for (int i = 0; i < 16; ++i) { const int l = i ^ j; if (l > i) ce_desc(a[i], a[l]); }
}
DI void top16_insert(u32 (&lst)[16], u32 x) {
#pragma unroll
    for (int j = 0; j < 16; ++j) { const u32 hi = max(lst[j], x); x = min(lst[j], x); lst[j] = hi; }
}
DI void unpack8(const uint4 v, float (&f)[8]) {
    f[0] = __uint_as_float(v.x << 16); f[1] = __uint_as_float(v.x & 0xffff0000u);
    f[2] = __uint_as_float(v.y << 16); f[3] = __uint_as_float(v.y & 0xffff0000u);
    f[4] = __uint_as_float(v.z << 16); f[5] = __uint_as_float(v.z & 0xffff0000u);
    f[6] = __uint_as_float(v.w << 16); f[7] = __uint_as_float(v.w & 0xffff0000u);
}
typedef float f32x2_t __attribute__((ext_vector_type(2)));
DI void unpack16fp8(const uint4 w, float (&f)[16]) {
    f32x2_t t;
    t = __builtin_amdgcn_cvt_pk_f32_fp8((int)w.x, false); f[0] = t[0]; f[1] = t[1];
    t = __builtin_amdgcn_cvt_pk_f32_fp8((int)w.x, true);  f[2] = t[0]; f[3] = t[1];
    t = __builtin_amdgcn_cvt_pk_f32_fp8((int)w.y, false); f[4] = t[0]; f[5] = t[1];
    t = __builtin_amdgcn_cvt_pk_f32_fp8((int)w.y, true);  f[6] = t[0]; f[7] = t[1];
    t = __builtin_amdgcn_cvt_pk_f32_fp8((int)w.z, false); f[8] = t[0]; f[9] = t[1];
    t = __builtin_amdgcn_cvt_pk_f32_fp8((int)w.z, true);  f[10] = t[0]; f[11] = t[1];
    t = __builtin_amdgcn_cvt_pk_f32_fp8((int)w.w, false); f[12] = t[0]; f[13] = t[1];
    t = __builtin_amdgcn_cvt_pk_f32_fp8((int)w.w, true);  f[14] = t[0]; f[15] = t[1];
}
struct PeerPre { int e[16]; uint4 xa, c0, c1; float2 r; };
struct PeerRows { uint4 d[8]; float c[8]; };
struct PeerRaw { u32 ids, aux, res; };
typedef unsigned lu32x4 __attribute__((ext_vector_type(4)));
DI uint4 lds_u4(const LAS unsigned char* a) { const lu32x4 v = *(const LAS lu32x4*)a; return make_uint4(v[0], v[1], v[2], v[3]); }
template <bool UP>
DI PeerRaw peer_raw_load(const Params& p, int tok, int sl, int lane) {
    PeerRaw g;
    g.ids = *(const u32*)(WSP(unsigned short, WS_RIDX) + (size_t)tok * 128 + 2 * lane);
    if (UP) {
        g.aux = *(const u32*)(WSP(bf16_t, WS_COEF) + (size_t)tok * 128 + 2 * lane);
        g.res = *(const u32*)(WSP(bf16_t, WS_RES) + (size_t)tok * DM + sl * 128 + 16 * (lane & 7) + 2 * (lane >> 3));
    } else {
        g.aux = *(const u32*)(WSP(signed char, WS_XQ) + (size_t)tok * DM + sl * 128 + 4 * (lane & 31));
        g.res = 0u;
    }
    return g;
}
template <bool UP>
DI PeerPre peer_stage(const PeerRaw& g, int lane, LAS unsigned char* wl) {
    *(LAS u32*)(wl + 4 * lane) = g.ids;
    if (UP) *(LAS u32*)(wl + 256 + 4 * lane) = g.aux; else *(LAS u32*)(wl + 256 + 4 * (lane & 31)) = g.aux;
    PeerPre q;
#pragma unroll
    for (int j = 0; j < 2; ++j) {
        const uint4 t = lds_u4(wl + 32 * (lane >> 3) + 16 * j);
        q.e[8 * j] = (int)(t.x & 0xffffu); q.e[8 * j + 1] = (int)(t.x >> 16); q.e[8 * j + 2] = (int)(t.y & 0xffffu); q.e[8 * j + 3] = (int)(t.y >> 16);
        q.e[8 * j + 4] = (int)(t.z & 0xffffu); q.e[8 * j + 5] = (int)(t.z >> 16); q.e[8 * j + 6] = (int)(t.w & 0xffffu); q.e[8 * j + 7] = (int)(t.w >> 16);
    }
    if (UP) {
        q.c0 = lds_u4(wl + 256 + 32 * (lane >> 3)); q.c1 = lds_u4(wl + 256 + 32 * (lane >> 3) + 16);
        q.r = make_float2(__uint_as_float(g.res << 16), __uint_as_float(g.res & 0xffff0000u));
    } else {
        q.xa = lds_u4(wl + 256 + 16 * (lane & 7));
    }
    return q;
}
template <int HF, bool UP>
DI void peer_issue_rows(const Params& p, const unsigned char* tab, const PeerPre& q, int tok, int lane, PeerRows& R) {
    const unsigned dco = 16u * (unsigned)(lane & 7);
#pragma unroll
    for (int bi = 0; bi < 8; ++bi) R.d[bi] = *(const uint4*)(tab + ((unsigned)q.e[8 * HF + bi] * 128u + dco));
    if (UP) {
        const uint4 cw = HF ? q.c1 : q.c0;
        R.c[0] = __uint_as_float(cw.x << 16); R.c[1] = __uint_as_float(cw.x & 0xffff0000u); R.c[2] = __uint_as_float(cw.y << 16); R.c[3] = __uint_as_float(cw.y & 0xffff0000u);
        R.c[4] = __uint_as_float(cw.z << 16); R.c[5] = __uint_as_float(cw.z & 0xffff0000u); R.c[6] = __uint_as_float(cw.w << 16); R.c[7] = __uint_as_float(cw.w & 0xffff0000u);
    }
}
template <int HF>
DI void peer_down_half(const PeerPre& q, const PeerRows& R, float (&part)[16]) {
#pragma unroll
    for (int bi = 0; bi < 8; ++bi) {
        int a = __builtin_amdgcn_sdot4((int)R.d[bi].x, (int)q.xa.x, 0, false);
        a = __builtin_amdgcn_sdot4((int)R.d[bi].y, (int)q.xa.y, a, false);
        a = __builtin_amdgcn_sdot4((int)R.d[bi].z, (int)q.xa.z, a, false);
        a = __builtin_amdgcn_sdot4((int)R.d[bi].w, (int)q.xa.w, a, false);
        part[8 * HF + bi] = (float)a;
    }
}
DI void peer_down_fin(const Params& p, const float (&part)[16], int tok, int sl, int lane) {
    const bool b2 = lane & 4, b1 = lane & 2, b0 = lane & 1;
    float r8[8], r4[4], r2[2];
#pragma unroll
    for (int i = 0; i < 8; ++i) { const float snd = b2 ? part[i] : part[i + 8]; const float kp = b2 ? part[i + 8] : part[i]; r8[i] = kp + __shfl_xor(snd, 4); }
#pragma unroll
    for (int i = 0; i < 4; ++i) { const float snd = b1 ? r8[i] : r8[i + 4]; const float kp = b1 ? r8[i + 4] : r8[i]; r4[i] = kp + __shfl_xor(snd, 2); }
#pragma unroll
    for (int i = 0; i < 2; ++i) { const float snd = b0 ? r4[i] : r4[i + 2]; const float kp = b0 ? r4[i + 2] : r4[i]; r2[i] = kp + __shfl_xor(snd, 1); }
    u32* pd = WSP(u32, WS_QBUF) + ((size_t)tok * 8 + sl) * 64;
    pd[lane] = pack2(r2[0], r2[1]);
}
DI void ph_peer_comb(const Params& p, int vb, int l) {
    const int tid = otid(), lane = tid & 63;
    const int tok0 = (vb * 4 + (tid >> 6)) * 2;
    const float* dsc = WSP(float, WS_DSC) + (size_t)l * NEXP;
    const float* usc = WSP(float, WS_USC) + (size_t)l * NEXP;
    u32 w[2][8]; int2 e[2]; float2 g[2]; float xs[2];
#pragma unroll
    for (int r = 0; r < 2; ++r) {
        const int tok = tok0 + r;
        const u32* pd = WSP(u32, WS_QBUF) + (size_t)tok * 8 * 64;
#pragma unroll
        for (int sl = 0; sl < 8; ++sl) w[r][sl] = pd[sl * 64 + lane];
        { const u32 ew = *(const u32*)(WSP(unsigned short, WS_RIDX) + (size_t)tok * 128 + 2 * lane); e[r] = make_int2((int)(ew & 0xffffu), (int)(ew >> 16)); }
        g[r] = *(const float2*)(WSP(float, WS_RG) + (size_t)tok * 128 + 2 * lane);
        xs[r] = WSP(float, WS_XSC)[tok];
    }
#pragma unroll
    for (int r = 0; r < 2; ++r) {
        float t0 = 0.f, t1 = 0.f;
#pragma unroll
        for (int sl = 0; sl < 8; ++sl) { t0 += __uint_as_float(w[r][sl] << 16); t1 += __uint_as_float(w[r][sl] & 0xffff0000u); }
        float2 o;
        o.x = g[r].x * gelu_tanh(t0 * dsc[e[r].x] * xs[r]) * usc[e[r].x];
        o.y = g[r].y * gelu_tanh(t1 * dsc[e[r].y] * xs[r]) * usc[e[r].y];
        *(u32*)(WSP(bf16_t, WS_COEF) + (size_t)(tok0 + r) * 128 + 2 * lane) = pack2(o.x, o.y);
    }
}
template <int HF>
DI void peer_up_half(const PeerPre& q, const PeerRows& R, float (&y)[16]) {
#pragma unroll
    for (int bi = 0; bi < 8; ++bi) {
        const float c = R.c[bi];
        float w[16]; unpack16fp8(R.d[bi], w);
#pragma unroll
        for (int i = 0; i < 16; ++i) y[i] += c * w[i];
        asm volatile("" : "+v"(y[0]), "+v"(y[1]), "+v"(y[2]), "+v"(y[3]), "+v"(y[4]), "+v"(y[5]), "+v"(y[6]), "+v"(y[7]), "+v"(y[8]), "+v"(y[9]), "+v"(y[10]), "+v"(y[11]), "+v"(y[12]), "+v"(y[13]), "+v"(y[14]), "+v"(y[15]));
    }
}
DI void peer_up_fin(const Params& p, const PeerPre& q, const float (&y)[16], int tok, int sl, int lane, bool final_layer) {
    const int rg = lane >> 3, dc = lane & 7;
    const bool b5 = lane & 32, b4 = lane & 16, b3 = lane & 8;
    float r8[8], r4[4], r2[2];
#pragma unroll
    for (int i = 0; i < 8; ++i) { const float snd = b5 ? y[i] : y[i + 8]; const float kp = b5 ? y[i + 8] : y[i]; r8[i] = kp + __shfl_xor(snd, 32); }
#pragma unroll
    for (int i = 0; i < 4; ++i) { const float snd = b4 ? r8[i] : r8[i + 4]; const float kp = b4 ? r8[i + 4] : r8[i]; r4[i] = kp + __shfl_xor(snd, 16); }
#pragma unroll
    for (int i = 0; i < 2; ++i) { const float snd = b3 ? r4[i] : r4[i + 2]; const float kp = b3 ? r4[i + 2] : r4[i]; r2[i] = kp + __shfl_xor(snd, 8); }
    float2 v = q.r;
    v.x += r2[0]; v.y += r2[1];
    if (final_layer) *(float2*)(p.out + (size_t)tok * DM + sl * 128 + 16 * dc + 2 * rg) = v;
    else *(u32*)(WSP(bf16_t, WS_RES) + (size_t)tok * DM + sl * 128 + 16 * dc + 2 * rg) = pack2(v.x, v.y);
}
template <bool UP>
DI void run_peer_sliced(const Params& p, int l, unsigned char* smem) {
    volatile LAS unsigned* st = (volatile LAS unsigned*)(smem + SMEM_BYTES);
    const int nloc = (int)st[0], nx = (int)st[1], rank = (int)st[2], xi = (int)st[3];
    const int tid = otid512(), lane = tid & 63, wave = tid >> 6;
    const int stride = nloc * 8;
    LAS unsigned char* wl = (LAS unsigned char*)smem + wave * 512;
#pragma unroll 1
    for (int sl = xi; sl < 8; sl += nx) {
        const unsigned char* tab = p.ws + (UP ? WS_UP : WS_DOWN) + (size_t)l * NEXP * DM + (size_t)sl * NEXP * 128;
        int tok = rank * 8 + wave;
        if (tok >= NTOK) continue;
        PeerPre qc;
        { const PeerRaw g0 = peer_raw_load<UP>(p, tok, sl, lane); qc = peer_stage<UP>(g0, lane, wl); }
        PeerRaw g1 = peer_raw_load<UP>(p, tok + stride < NTOK ? tok + stride : tok, sl, lane);
        PeerRows R;
        peer_issue_rows<0, UP>(p, tab, qc, tok, lane, R);
#pragma unroll 1
        for (; tok < NTOK; tok += stride) {
            const int tn = tok + stride < NTOK ? tok + stride : tok;
            const int tn2 = tn + stride < NTOK ? tn + stride : tn;
            const PeerRaw g2 = peer_raw_load<UP>(p, tn2, sl, lane);
            const PeerPre qn = peer_stage<UP>(g1, lane, wl);
            float acc[16];
#pragma unroll
            for (int i = 0; i < 16; ++i) acc[i] = 0.f;
            PeerRows Rn;
            peer_issue_rows<1, UP>(p, tab, qc, tok, lane, Rn);
            __builtin_amdgcn_sched_barrier(0);
            if (UP) peer_up_half<0>(qc, R, acc); else peer_down_half<0>(qc, R, acc);
            __builtin_amdgcn_sched_barrier(0);
            peer_issue_rows<0, UP>(p, tab, qn, tn, lane, R);
            __builtin_amdgcn_sched_barrier(0);
            if (UP) { peer_up_half<1>(qc, Rn, acc); peer_up_fin(p, qc, acc, tok, sl, lane, l == 1); }
            else { peer_down_half<1>(qc, Rn, acc); peer_down_fin(p, acc, tok, sl, lane); }
            __builtin_amdgcn_sched_barrier(0);
            qc = qn; g1 = g2;
        }
    }
}


typedef short bf16x8 __attribute__((ext_vector_type(8)));
typedef float f32x16 __attribute__((ext_vector_type(16)));
#define MFMA32(a, b, c) __builtin_amdgcn_mfma_f32_32x32x16_bf16((a), (b), (c), 0, 0, 0)
typedef short s16x4 __attribute__((ext_vector_type(4)));
DI bf16x8 pack_p(const f32x16& pt, int s) {
    uint4 o;
    o.x = pack2(pt[8 * s + 0], pt[8 * s + 1]); o.y = pack2(pt[8 * s + 2], pt[8 * s + 3]);
    o.z = pack2(pt[8 * s + 4], pt[8 * s + 5]); o.w = pack2(pt[8 * s + 6], pt[8 * s + 7]);
    return __builtin_bit_cast(bf16x8, o);
}

DI void stage_tile(const bf16_t* __restrict__ g, int ld, int row0, int k0, unsigned char* lt, int wave, int lane) {
#pragma unroll
    for (int i = 0; i < 4; ++i) {
        const int inst = wave * 4 + i;
        const int row = inst * 8 + (lane >> 3);
        const int c = (lane & 7) ^ ((row >> 1) & 7);
        __builtin_amdgcn_global_load_lds((const unsigned*)(g + (size_t)(row0 + row) * ld + k0 + c * 8),
                                         (unsigned*)(lt + inst * 1024 + lane * 16), 16, 0, 0);
    }
}
DI bf16x8 lds_frag(const unsigned char* lt, int row, int c) {
    return *(const bf16x8*)(lt + row * 128 + ((c ^ ((row >> 1) & 7)) << 4));
}
DI int crow(int r, int fh) { return (r & 3) + 8 * (r >> 2) + 4 * fh; }

namespace pg8 {
#define PG8_LAS __attribute__((address_space(3)))
typedef float f32x4 __attribute__((ext_vector_type(4)));
typedef unsigned u32x4 __attribute__((ext_vector_type(4)));
constexpr int BM = 256, BK = 64, HALF = 128, HTB = HALF * BK * 2  , STAGE_BYTES = 8 * HTB;
__host__ __device__ __forceinline__ int lds_byte(int r, int c) { const int st = (r >> 4) * 2 + (c >> 5), rr = r & 15, cc = c & 31, ob = rr * 64 + cc * 2; return st * 1024 + (ob ^ (((ob >> 9) & 1) << 5)); }
__host__ __device__ __forceinline__ void stage_rc(int b, int& R, int& C) { const int st = b / 1024, sb = b % 1024, swz = sb ^ (((sb >> 9) & 1) << 5); R = (st >> 1) * 16 + swz / 64; C = (st & 1) * 32 + (swz % 64) / 2; }
__host__ __device__ __forceinline__ int perm32(int rho) { const int n = rho >> 4, i = rho & 15; return 8 * (i >> 2) + 4 * n + (i & 3); }
struct Unit { int pm, pn; };
struct Gemm { const void* A; const void* Bt; int M, N, K; const float* rsc; const float* csc; };
struct XcdOrder {
    int ntn, nloc, nx, rank, xi, nown, total;
    __device__ __forceinline__ void init(int nmt, int ntn_, int nloc_, int nx_, int rank_, int xi_) {
        ntn = ntn_; nloc = nloc_; nx = nx_; rank = rank_; xi = xi_; nown = xi < nmt ? (nmt - xi + nx - 1) / nx : 0; total = nown * ntn; }
    __device__ __forceinline__ bool next(int i, Unit& u) const {
        const int t = rank + i * nloc; if (t >= total) return false;
        const int g4 = t / (4 * ntn), r = t - g4 * 4 * ntn;
        const int left = nown - 4 * g4, gs = left < 4 ? left : 4;
        const int nt = r / gs, mi = r - nt * gs;
        u.pm = (4 * g4 + mi) * nx + xi; u.pn = nt; return true;
    }
    __device__ __forceinline__ void a_ready(const Unit&) const {}
    __device__ __forceinline__ void done(const Unit&) const {}
};
typedef int i32x4 __attribute__((ext_vector_type(4)));
template <class Epi, class Sched, bool ALIGN_EPI = false, bool SP2 = false, bool I8 = false>
__device__ __forceinline__ void gemm_phase(PG8_LAS unsigned char* lds, const Gemm g, const Sched& S, const Epi& E) {
    const int tid = otid512(), wid = __builtin_amdgcn_readfirstlane(tid >> 6), lane = tid & 63, wr = wid >> 2, wc = wid & 3, fr = lane & 15, fq = lane >> 4;
    const int K = g.K, KB = I8 ? K : 2 * K  , nt = KB / (BK * 2);
    unsigned voffA[2], voffB[2];
#pragma unroll
    for (int i = 0; i < 2; ++i) { int R, C; stage_rc(tid * 16 + i * 8192, R, C); const int Rb = Epi::PERM ? ((R & ~31) + perm32(R & 31)) : R;
        voffA[i] = (unsigned)(R * KB + C * 2); voffB[i] = (unsigned)(Rb * KB + C * 2); }
    const size_t kstep = (size_t)(BK * 2);
    const size_t hstep = (size_t)HALF * KB;
    const size_t tstep = 2 * hstep;
    const unsigned ldsw = (unsigned)wid * 1024u;
    const int aoff = lds_byte(wr * 64 + fr, fq * 8), boff = lds_byte(wc * 32 + fr, fq * 8);
#define PG8_SA(b, h) (((b) * 2 + (h)) * HTB)
#define PG8_SB(b, h) ((4 + (b) * 2 + (h)) * HTB)
#define PG8_STAGE(bufoff, gbase, voff) do { _Pragma("unroll") for (int _i = 0; _i < 2; ++_i) \
        __builtin_amdgcn_global_load_lds((const unsigned*)((const char*)(gbase) + (voff)[_i]), (PG8_LAS unsigned*)(lds + (bufoff) + ldsw + _i * 8192), 16, 0, 0); } while (0)
#define PG8_LDA(dst, b, h) do { _Pragma("unroll") for (int m = 0; m < 4; ++m) _Pragma("unroll") for (int k = 0; k < 2; ++k) dst[m][k] = *(const PG8_LAS bf16x8*)(lds + PG8_SA(b, h) + aoff + m * 2048 + k * 1024); } while (0)
#define PG8_LDB(dst, b, h) do { _Pragma("unroll") for (int n = 0; n < 2; ++n) _Pragma("unroll") for (int k = 0; k < 2; ++k) dst[n][k] = *(const PG8_LAS bf16x8*)(lds + PG8_SB(b, h) + boff + n * 2048 + k * 1024); } while (0)
#define PG8_MMA(ai, bj, At, Bt) do { __builtin_amdgcn_s_setprio(1); _Pragma("unroll") for (int m = 0; m < 4; ++m) _Pragma("unroll") for (int n = 0; n < 2; ++n) _Pragma("unroll") for (int k = 0; k < 2; ++k) \
        { if constexpr (I8) acc[ai][bj][m][n] = __builtin_bit_cast(f32x4, __builtin_amdgcn_mfma_i32_16x16x64_i8(__builtin_bit_cast(i32x4, Bt[n][k]), __builtin_bit_cast(i32x4, At[m][k]), __builtin_bit_cast(i32x4, acc[ai][bj][m][n]), 0, 0, 0)); \
          else acc[ai][bj][m][n] = __builtin_amdgcn_mfma_f32_16x16x32_bf16(Bt[n][k], At[m][k], acc[ai][bj][m][n], 0, 0, 0); } __builtin_amdgcn_s_setprio(0); } while (0)
#define PG8_WAIT_V(n) asm volatile("s_waitcnt vmcnt(" #n ")" ::: "memory")
#define PG8_WAIT_L(n) asm volatile("s_waitcnt lgkmcnt(" #n ")" ::: "memory")
#define PG8_BAR __builtin_amdgcn_s_barrier()
#define PG8_SCHED __builtin_amdgcn_sched_barrier(0)
    Unit cur, nxt; int ui = 0;
    if (!S.next(0, cur)) return;
    f32x4 acc[2][2][4][2];
#pragma unroll
    for (int a = 0; a < 2; ++a)
#pragma unroll
        for (int b = 0; b < 2; ++b)
#pragma unroll
            for (int m = 0; m < 4; ++m)
#pragma unroll
                for (int n = 0; n < 2; ++n) acc[a][b][m][n] = (f32x4){0.f, 0.f, 0.f, 0.f};
    bf16x8 At[4][2], B0[2][2], B1[2][2];
    const char* cA = (const char*)g.A + (size_t)cur.pm * tstep; const char* cB = (const char*)g.Bt + (size_t)cur.pn * tstep;
    S.a_ready(cur);
    if constexpr (SP2) {
        PG8_STAGE(PG8_SB(0, 0), cB, voffB); PG8_STAGE(PG8_SB(0, 1), cB + hstep, voffB); PG8_STAGE(PG8_SA(0, 0), cA, voffA); PG8_STAGE(PG8_SA(0, 1), cA + hstep, voffA);
        if (wr == 1) PG8_BAR;
        PG8_WAIT_V(2); PG8_BAR;
        PG8_STAGE(PG8_SB(1, 0), cB + kstep, voffB); PG8_STAGE(PG8_SA(1, 0), cA + kstep, voffA); PG8_STAGE(PG8_SB(1, 1), cB + hstep + kstep, voffB);
        PG8_WAIT_V(6); PG8_BAR;
    } else {
        PG8_STAGE(PG8_SB(0, 0), cB, voffB); PG8_STAGE(PG8_SA(0, 0), cA, voffA); PG8_STAGE(PG8_SB(0, 1), cB + hstep, voffB); PG8_STAGE(PG8_SA(0, 1), cA + hstep, voffA);
        if (wr == 1) PG8_BAR;
        PG8_WAIT_V(4); PG8_BAR;
        PG8_STAGE(PG8_SB(1, 0), cB + kstep, voffB); PG8_STAGE(PG8_SA(1, 0), cA + kstep, voffA); PG8_STAGE(PG8_SB(1, 1), cB + hstep + kstep, voffB);
        PG8_WAIT_V(6); PG8_BAR;
    }
    for (;;) {
        const bool has_next = S.next(ui + 1, nxt);
        const char* nA = has_next ? (const char*)g.A + (size_t)nxt.pm * tstep : cA; const char* nB = has_next ? (const char*)g.Bt + (size_t)nxt.pn * tstep : cB;
        for (int t = 0; t < nt; t += 2) {
            const bool last = (t == nt - 2);
            const char* a1 = cA + (size_t)(t + 1) * kstep;
            const char* a2 = last ? nA : cA + (size_t)(t + 2) * kstep; const char* b2 = last ? nB : cB + (size_t)(t + 2) * kstep;
            const char* a3 = a2 + kstep; const char* b3 = b2 + kstep;
            if (last && has_next) S.a_ready(nxt);
            if constexpr (SP2) {
            PG8_LDB(B0, 0, 0); PG8_LDB(B1, 0, 1); PG8_SCHED; PG8_LDA(At, 0, 0); PG8_STAGE(PG8_SA(1, 1), a1 + hstep, voffA);
            PG8_WAIT_V(8); PG8_WAIT_L(0); PG8_BAR; PG8_MMA(0, 0, At, B0); PG8_MMA(0, 1, At, B1); PG8_BAR; PG8_SCHED;
            PG8_LDA(At, 0, 1); PG8_STAGE(PG8_SB(0, 0), b2, voffB); PG8_STAGE(PG8_SB(0, 1), b2 + hstep, voffB); PG8_STAGE(PG8_SA(0, 0), a2, voffA);
            PG8_WAIT_V(8); PG8_WAIT_L(0); PG8_BAR; PG8_MMA(1, 0, At, B0); PG8_MMA(1, 1, At, B1); PG8_BAR; PG8_SCHED;
            PG8_LDB(B0, 1, 0); PG8_LDB(B1, 1, 1); PG8_SCHED; PG8_LDA(At, 1, 0); PG8_STAGE(PG8_SA(0, 1), a2 + hstep, voffA);
            PG8_WAIT_V(8); PG8_WAIT_L(0); PG8_BAR; PG8_MMA(0, 0, At, B0); PG8_MMA(0, 1, At, B1); PG8_BAR; PG8_SCHED;
            PG8_LDA(At, 1, 1); PG8_STAGE(PG8_SB(1, 0), b3, voffB); PG8_STAGE(PG8_SB(1, 1), b3 + hstep, voffB); PG8_STAGE(PG8_SA(1, 0), a3, voffA);
            PG8_WAIT_V(8); PG8_WAIT_L(0); PG8_BAR; PG8_MMA(1, 0, At, B0); PG8_MMA(1, 1, At, B1); PG8_BAR; PG8_SCHED;
            } else {
            PG8_LDB(B0, 0, 0); PG8_SCHED; PG8_LDA(At, 0, 0); PG8_STAGE(PG8_SA(1, 1), a1 + hstep, voffA);
            PG8_WAIT_L(8); PG8_BAR; PG8_WAIT_L(0); PG8_MMA(0, 0, At, B0); PG8_BAR; PG8_SCHED;
            PG8_LDB(B1, 0, 1); PG8_STAGE(PG8_SB(0, 0), b2, voffB);
            PG8_BAR; PG8_WAIT_L(0); PG8_MMA(0, 1, At, B1); PG8_BAR;
            PG8_LDA(At, 0, 1); PG8_STAGE(PG8_SA(0, 0), a2, voffA);
            PG8_BAR; PG8_WAIT_L(0); PG8_MMA(1, 0, At, B0); PG8_BAR; PG8_SCHED;
            PG8_STAGE(PG8_SB(0, 1), b2 + hstep, voffB);
            PG8_WAIT_V(6); PG8_BAR; PG8_MMA(1, 1, At, B1); PG8_BAR;
            PG8_LDB(B0, 1, 0); PG8_SCHED; PG8_LDA(At, 1, 0); PG8_STAGE(PG8_SA(0, 1), a2 + hstep, voffA);
            PG8_WAIT_L(8); PG8_BAR; PG8_WAIT_L(0); PG8_MMA(0, 0, At, B0); PG8_BAR; PG8_SCHED;
            PG8_LDB(B1, 1, 1); PG8_STAGE(PG8_SB(1, 0), b3, voffB);
            PG8_BAR; PG8_WAIT_L(0); PG8_MMA(0, 1, At, B1); PG8_BAR;
            PG8_LDA(At, 1, 1); PG8_STAGE(PG8_SA(1, 0), a3, voffA);
            PG8_BAR; PG8_WAIT_L(0); PG8_MMA(1, 0, At, B0); PG8_BAR; PG8_SCHED;
            PG8_STAGE(PG8_SB(1, 1), b3 + hstep, voffB);
            PG8_WAIT_V(6); PG8_BAR; PG8_MMA(1, 1, At, B1); PG8_BAR;
            }
        }
        if constexpr (ALIGN_EPI) { if (wr == 0) PG8_BAR; }
        if constexpr (I8) {
#pragma unroll
            for (int b = 0; b < 2; ++b) {
                const float* cp = g.csc + cur.pn * BM + b * HALF + wc * 32 + 8 * fq;
                const f32x4 c0 = *(const f32x4*)cp, c1 = *(const f32x4*)(cp + 4);
#pragma unroll
                for (int a = 0; a < 2; ++a)
#pragma unroll
                    for (int m = 0; m < 4; ++m) {
                        const float xs = g.rsc[cur.pm * BM + a * HALF + wr * 64 + m * 16 + fr];
                        acc[a][b][m][0] = __builtin_convertvector(__builtin_bit_cast(i32x4, acc[a][b][m][0]), f32x4) * c0 * xs;
                        acc[a][b][m][1] = __builtin_convertvector(__builtin_bit_cast(i32x4, acc[a][b][m][1]), f32x4) * c1 * xs;
                    }
            }
        }
        if constexpr (!Epi::AFTER_DRAIN) { E(acc, cur, wr, wc, fr, fq); S.done(cur); }
        if (!has_next) break;
#pragma unroll
        for (int a = 0; a < 2; ++a)
#pragma unroll
            for (int b = 0; b < 2; ++b)
#pragma unroll
                for (int m = 0; m < 4; ++m)
#pragma unroll
                    for (int n = 0; n < 2; ++n) acc[a][b][m][n] = (f32x4){0.f, 0.f, 0.f, 0.f};
        cur = nxt; cA = nA; cB = nB; ++ui;
        if constexpr (ALIGN_EPI) { if (wr == 1) PG8_BAR; }
    }
    PG8_WAIT_V(0);
    if constexpr (!ALIGN_EPI) { if (wr == 0) PG8_BAR; }
    PG8_BAR;
    if constexpr (Epi::AFTER_DRAIN) { E.fused(acc, cur, wr, wc, fr, fq, lds, wid, lane); S.done(cur); }
#undef PG8_SA
#undef PG8_SB
#undef PG8_STAGE
#undef PG8_LDA
#undef PG8_LDB
#undef PG8_MMA
#undef PG8_WAIT_V
#undef PG8_WAIT_L
#undef PG8_BAR
#undef PG8_SCHED
}
template <bool RES_BF16>
struct EpiResid {
    static constexpr bool PERM = true, AFTER_DRAIN = false;
    const void* resid; bf16_t* out;
    __device__ __forceinline__ void operator()(const f32x4 (&acc)[2][2][4][2], const Unit& u, int wr, int wc, int fr, int fq) const {
        const size_t base = (size_t)(u.pm * BM + wr * 64 + fr) * DM + u.pn * BM + wc * 32 + 8 * fq;
#pragma unroll
        for (int ai = 0; ai < 2; ++ai) {
            f32x4 rv[4][2][2];
#pragma unroll
            for (int m = 0; m < 4; ++m)
#pragma unroll
                for (int bj = 0; bj < 2; ++bj) {
                    const size_t o = base + (size_t)(ai * HALF + m * 16) * DM + bj * HALF;
                    if constexpr (RES_BF16) {
                        const u32x4 w = *(const u32x4*)((const bf16_t*)resid + o);
                        rv[m][bj][0] = (f32x4){__uint_as_float(w.x << 16), __uint_as_float(w.x & 0xffff0000u), __uint_as_float(w.y << 16), __uint_as_float(w.y & 0xffff0000u)};
                        rv[m][bj][1] = (f32x4){__uint_as_float(w.z << 16), __uint_as_float(w.z & 0xffff0000u), __uint_as_float(w.w << 16), __uint_as_float(w.w & 0xffff0000u)};
                    } else { const float* rp = (const float*)resid + o; rv[m][bj][0] = *(const f32x4*)rp; rv[m][bj][1] = *(const f32x4*)(rp + 4); }
                }
            asm volatile("" ::: "memory");
#pragma unroll
            for (int m = 0; m < 4; ++m)
#pragma unroll
                for (int bj = 0; bj < 2; ++bj) {
                    const f32x4 a = rv[m][bj][0] + acc[ai][bj][m][0], b = rv[m][bj][1] + acc[ai][bj][m][1];
                    u32x4 w; w.x = pack2(a[0], a[1]); w.y = pack2(a[2], a[3]); w.z = pack2(b[0], b[1]); w.w = pack2(b[2], b[3]);
                    *(u32x4*)(out + base + (size_t)(ai * HALF + m * 16) * DM + bj * HALF) = w;
                }
            asm volatile("" ::: "memory");
        }
    }
};
struct EpiProj {
    static constexpr bool PERM = true, AFTER_DRAIN = false;
    const float* aq; const float* ak; const float* bq; const float* bk; bf16_t* proj; PG8_LAS float* xs;
    __device__ __forceinline__ void operator()(const f32x4 (&acc)[2][2][4][2], const Unit& u, int wr, int wc, int fr, int fq) const {
        const int wave = wr * 4 + wc;
#pragma unroll
        for (int ai = 0; ai < 2; ++ai)
#pragma unroll
            for (int m = 0; m < 4; ++m)
#pragma unroll
                for (int bj = 0; bj < 2; ++bj) {
                    const f32x4 a = acc[ai][bj][m][0], b = acc[ai][bj][m][1];
                    float t = a[0] * a[0] + a[1] * a[1] + a[2] * a[2] + a[3] * a[3] + b[0] * b[0] + b[1] * b[1] + b[2] * b[2] + b[3] * b[3];
                    t += __shfl_xor(t, 16); t += __shfl_xor(t, 32);
                    if (fq == 0) xs[wave * 256 + ((ai * 4 + m) * 2 + bj) * 16 + fr] = t;
                }
        asm volatile("s_waitcnt lgkmcnt(0)" ::: "memory");
        __builtin_amdgcn_s_barrier();
#pragma unroll
        for (int bj = 0; bj < 2; ++bj) {
            const int gcol = u.pn * BM + bj * HALF + wc * 32 + 8 * fq;
            const float* gain = nullptr; float scale = 1.f;
            if (gcol < 512) { gain = aq + (gcol & 63); scale = 0.125f; }
            else if (gcol < 1024) gain = ak + (gcol & 63);
            else if (gcol < 1536) gain = nullptr;
            else if (gcol < 2048) { gain = bq + (gcol & 127); scale = 0.125f; }
            else if (gcol < 2560) gain = bk + (gcol & 127);
            f32x4 g0 = {1.f, 1.f, 1.f, 1.f}, g1 = {1.f, 1.f, 1.f, 1.f};
            if (gain) { g0 = *(const f32x4*)gain; g1 = *(const f32x4*)(gain + 4); }
#pragma unroll
            for (int ai = 0; ai < 2; ++ai)
#pragma unroll
                for (int m = 0; m < 4; ++m) {
                    float sc = 1.f;
                    if (gain) {
                        const int slot = ((ai * 4 + m) * 2 + bj) * 16 + fr;
                        sc = rsqrtf((xs[wave * 256 + slot] + xs[(wave ^ 1) * 256 + slot]) * (1.f / 64.f) + EPSN) * scale;
                    }
                    const f32x4 v0 = acc[ai][bj][m][0] * g0 * sc, v1 = acc[ai][bj][m][1] * g1 * sc;
                    u32x4 w; w.x = pack2(v0[0], v0[1]); w.y = pack2(v0[2], v0[3]); w.z = pack2(v1[0], v1[1]); w.w = pack2(v1[2], v1[3]);
                    *(u32x4*)(proj + (size_t)(u.pm * BM + ai * HALF + wr * 64 + m * 16 + fr) * ATT_IN + gcol) = w;
                }
        }
    }
};
struct EpiSgu {
    static constexpr bool PERM = true, AFTER_DRAIN = false;
    bf16_t* zu; bf16_t* zvt; float* ssq; PG8_LAS unsigned char* stg;
    __device__ __forceinline__ void operator()(const f32x4 (&acc)[2][2][4][2], const Unit& u, int wr, int wc, int fr, int fq) const {
        const int wave = wr * 4 + wc, lane = fq * 16 + fr;
        PG8_LAS unsigned short* tl = (PG8_LAS unsigned short*)(stg + wave * 2048);
#pragma unroll
        for (int ai = 0; ai < 2; ++ai)
#pragma unroll
            for (int bj = 0; bj < 2; ++bj) {
                const int gcol = u.pn * BM + bj * HALF + wc * 32 + 8 * fq;
                f32x4 g0[4], g1[4];
#pragma unroll
                for (int m = 0; m < 4; ++m) {
                    const f32x4 a = acc[ai][bj][m][0], b = acc[ai][bj][m][1];
                    g0[m] = (f32x4){gelu_tanh(a[0]), gelu_tanh(a[1]), gelu_tanh(a[2]), gelu_tanh(a[3])};
                    g1[m] = (f32x4){gelu_tanh(b[0]), gelu_tanh(b[1]), gelu_tanh(b[2]), gelu_tanh(b[3])};
                }
                if (gcol < CW) {
#pragma unroll
                    for (int m = 0; m < 4; ++m) {
                        u32x4 w; w.x = pack2(g0[m][0], g0[m][1]); w.y = pack2(g0[m][2], g0[m][3]); w.z = pack2(g1[m][0], g1[m][1]); w.w = pack2(g1[m][2], g1[m][3]);
                        *(u32x4*)(zu + (size_t)(u.pm * BM + ai * HALF + wr * 64 + m * 16 + fr) * CW + gcol) = w;
                    }
                } else {
                    const int vcol = gcol - CW;
#pragma unroll
                    for (int m = 0; m < 4; ++m) {
                        float t = g0[m][0] * g0[m][0] + g0[m][1] * g0[m][1] + g0[m][2] * g0[m][2] + g0[m][3] * g0[m][3]
                                + g1[m][0] * g1[m][0] + g1[m][1] * g1[m][1] + g1[m][2] * g1[m][2] + g1[m][3] * g1[m][3];
                        t += __shfl_xor(t, 16); t += __shfl_xor(t, 32);
                        if (fq == 0) ssq[(size_t)(u.pm * BM + ai * HALF + wr * 64 + m * 16 + fr) * 64 + (vcol >> 5)] = t;
                    }
#pragma unroll
                    for (int h = 0; h < 2; ++h) {
#pragma unroll
                        for (int mm = 0; mm < 2; ++mm) {
                            const int m = 2 * h + mm, rl = 16 * mm + fr;
#pragma unroll
                            for (int j = 0; j < 4; ++j) { tl[(8 * fq + j) * 32 + rl] = f2bf(g0[m][j]); tl[(8 * fq + 4 + j) * 32 + rl] = f2bf(g1[m][j]); }
                        }
                        const int c = lane >> 1, hh = lane & 1;
                        const u32x4 w0 = *(const PG8_LAS u32x4*)(tl + c * 32 + hh * 16), w1 = *(const PG8_LAS u32x4*)(tl + c * 32 + hh * 16 + 8);
                        bf16_t* dst = zvt + ((size_t)(2 * u.pm + ai) * CW + (u.pn * BM - CW) + bj * HALF + wc * 32 + c) * 128 + wr * 64 + 32 * h + hh * 16;
                        *(u32x4*)dst = w0; *(u32x4*)(dst + 8) = w1;
                        asm volatile("" ::: "memory");
                    }
                }
            }
    }
};
struct EpiQ {
    static constexpr bool PERM = true, AFTER_DRAIN = false;
    bf16_t* q;
    __device__ __forceinline__ void operator()(const f32x4 (&acc)[2][2][4][2], const Unit& u, int wr, int wc, int fr, int fq) const {
#pragma unroll
        for (int ai = 0; ai < 2; ++ai)
#pragma unroll
            for (int m = 0; m < 4; ++m)
#pragma unroll
                for (int bj = 0; bj < 2; ++bj) {
                    const f32x4 a = acc[ai][bj][m][0], b = acc[ai][bj][m][1];
                    u32x4 w; w.x = pack2(a[0], a[1]); w.y = pack2(a[2], a[3]); w.z = pack2(b[0], b[1]); w.w = pack2(b[2], b[3]);
                    *(u32x4*)(q + (size_t)(u.pm * BM + ai * HALF + wr * 64 + m * 16 + fr) * 2048 + u.pn * BM + bj * HALF + wc * 32 + 8 * fq) = w;
                }
    }
};
}
DI void run_gemmq_pg8(const Params& p, int l, unsigned char* smem) {
    volatile LAS unsigned* st = (volatile LAS unsigned*)(smem + SMEM_BYTES);
    pg8::XcdOrder S; S.init(NTOK / 256, 2048 / 256, (int)st[0], (int)st[1], (int)st[2], (int)st[3]);
    const pg8::Gemm g{WSP(signed char, WS_XQ), WSP(signed char, WS_W_PQ) + (size_t)l * 2048 * DM, NTOK, 2048, DM, WSP(float, WS_XSC), WSP(float, WS_WQS) + l * 2048};
    pg8::EpiQ E; E.q = WSP(bf16_t, WS_QBUF);
    __syncthreads();
    pg8::gemm_phase<pg8::EpiQ, pg8::XcdOrder, true, true, true>((PG8_LAS unsigned char*)smem, g, S, E);
}
template <int WHICH>
DI void run_gemm_pg8(const Params& p, unsigned char* smem) {
    volatile LAS unsigned* st = (volatile LAS unsigned*)(smem + SMEM_BYTES);
    pg8::XcdOrder S; S.init(NTOK / 256, DM / 256, (int)st[0], (int)st[1], (int)st[2], (int)st[3]);
    pg8::Gemm g;
    pg8::EpiResid<WHICH == 1> E; E.out = WSP(bf16_t, WS_RES);
    if (WHICH == 0) { g = pg8::Gemm{WSP(bf16_t, WS_MIXED), WSP(bf16_t, WS_W_ATTOUT), NTOK, DM, DM, nullptr, nullptr}; E.resid = p.in[0]; }
    else { g = pg8::Gemm{WSP(bf16_t, WS_Z_U), WSP(bf16_t, WS_W_SGUOUT), NTOK, DM, CW, nullptr, nullptr}; E.resid = WSP(bf16_t, WS_RES); }
    __syncthreads();
    pg8::gemm_phase<pg8::EpiResid<WHICH == 1>, pg8::XcdOrder, true, true>((PG8_LAS unsigned char*)smem, g, S, E);
}

DI void run_gemm1_pg8(const Params& p, unsigned char* smem) {
    volatile LAS unsigned* st = (volatile LAS unsigned*)(smem + SMEM_BYTES);
    pg8::XcdOrder S; S.init(NTOK / 256, ATT_IN / 256, (int)st[0], (int)st[1], (int)st[2], (int)st[3]);
    const pg8::Gemm g{WSP(signed char, WS_XQ), WSP(signed char, WS_W_ATTIN), NTOK, ATT_IN, DM, WSP(float, WS_XSC), WSP(float, WS_WAS)};
    pg8::EpiProj E; E.aq = p.in[3]; E.ak = p.in[4]; E.bq = p.in[5]; E.bk = p.in[6]; E.proj = WSP(bf16_t, WS_PROJ); E.xs = (PG8_LAS float*)(smem + PG8_EXTRA);
    __syncthreads();
    pg8::gemm_phase<pg8::EpiProj, pg8::XcdOrder, true, true, true>((PG8_LAS unsigned char*)smem, g, S, E);
}
DI void run_gemm4_pg8(const Params& p, unsigned char* smem) {
    volatile LAS unsigned* st = (volatile LAS unsigned*)(smem + SMEM_BYTES);
    pg8::XcdOrder S; S.init(NTOK / 256, 4096 / 256, (int)st[0], (int)st[1], (int)st[2], (int)st[3]);
    const pg8::Gemm g{WSP(signed char, WS_XQ), WSP(signed char, WS_W_SGUIN), NTOK, 4096, DM, WSP(float, WS_XSC), WSP(float, WS_WSS)};
    pg8::EpiSgu E; E.zu = WSP(bf16_t, WS_Z_U); E.zvt = WSP(bf16_t, WS_Z_VT); E.ssq = WSP(float, WS_SSQ); E.stg = (PG8_LAS unsigned char*)(smem + PG8_EXTRA);
    __syncthreads();
    pg8::gemm_phase<pg8::EpiSgu, pg8::XcdOrder, true, true, true>((PG8_LAS unsigned char*)smem, g, S, E);
}

DI u32 cand_key(float s, int ci) { return (f2ord(s) & ~255u) | (u32)(255 - ci); }
template <int P>
DI void score_half(const bf16x8 (&qf)[8], const unsigned char* skl, int fr, int fh, u32 (&lst)[16]) {
#pragma unroll
    for (int j = 0; j < 16; ++j) lst[j] = 0u;
#pragma unroll 1
    for (int kt = 0; kt < 4; ++kt) {
        f32x16 st;
#pragma unroll
        for (int r = 0; r < 16; ++r) st[r] = 0.f;
        const int row = P * 128 + kt * 32 + fr;
        const unsigned char* skr = skl + row * 256;
#pragma unroll
        for (int ks = 0; ks < 8; ++ks) st = MFMA32(*(const bf16x8*)(skr + (((2 * ks + fh) ^ (row & 15)) << 4)), qf[ks], st);
        u32 ks_[16];
#pragma unroll
        for (int r = 0; r < 16; ++r) ks_[r] = (f2ord(st[r]) & ~127u) | (u32)(127 - (kt * 32 + crow(r, fh)));
        sort16_desc(ks_);
        if (kt == 0) {
#pragma unroll
            for (int j = 0; j < 16; ++j) lst[j] = ks_[j];
        } else merge16_desc(lst, ks_);
    }
    u32 other[16];
#pragma unroll
    for (int j = 0; j < 16; ++j) other[j] = (u32)__shfl_xor((int)lst[j], 32);
    merge16_desc(lst, other);
}
DI void run_score(const Params& p, int l, unsigned char* smem) {
    const int tid = otid512(), wave = tid >> 6, lane = tid & 63, fr = lane & 31, fh = lane >> 5;
    int cur_h = -1;
    bf16x8 qa[8], qb[8];
    if ((int)blockIdx.x < 8 * (NTOK / 256)) {
        const int it0 = blockIdx.x;
        const bf16_t* q0 = WSP(bf16_t, WS_QBUF) + (size_t)((it0 >> 3) * 256 + wave * 32 + fr) * 2048 + (it0 & 7) * 256 + 8 * fh;
#pragma unroll
        for (int ks = 0; ks < 8; ++ks) { qa[ks] = *(const bf16x8*)(q0 + 16 * ks); qb[ks] = *(const bf16x8*)(q0 + 128 + 16 * ks); }
    }
#pragma unroll 1
    for (int it = blockIdx.x; it < 8 * (NTOK / 256); it += gridDim.x) {
    const int h = it & 7, oct = it >> 3;
    if (h != cur_h) {
        __syncthreads();
        const bf16_t* skg = WSP(bf16_t, WS_W_SUBK) + ((size_t)l * 16 + h * 2) * 128 * 128;
#pragma unroll
        for (int i = 0; i < 8; ++i) {
            const int idx = wave * 8 + i;
            const int row = 4 * idx + (lane >> 4), cp = lane & 15;
            __builtin_amdgcn_global_load_lds((const unsigned*)(skg + (size_t)row * 128 + ((cp ^ (row & 15)) << 3)), (unsigned*)(smem + idx * 1024 + lane * 16), 16, 0, 0);
        }
        asm volatile("s_waitcnt vmcnt(0)" ::: "memory");
        __syncthreads();
        cur_h = h;
    }
    const int tok = oct * 256 + wave * 32 + fr;
    const unsigned char* skh = smem;
    u32 L0[16], L1[16];
    score_half<0>(qa, skh, fr, fh, L0);
    score_half<1>(qb, skh, fr, fh, L1);
    {
        const int itn = it + gridDim.x < 8 * (NTOK / 256) ? it + gridDim.x : it;
        const bf16_t* qn = WSP(bf16_t, WS_QBUF) + (size_t)((itn >> 3) * 256 + wave * 32 + fr) * 2048 + (itn & 7) * 256 + 8 * fh;
#pragma unroll
        for (int ks = 0; ks < 8; ++ks) { qa[ks] = *(const bf16x8*)(qn + 16 * ks); qb[ks] = *(const bf16x8*)(qn + 128 + 16 * ks); }
    }
    LAS int* slot = (LAS int*)(smem + 65536 + wave * (64 * 132)) + lane * 33;
    float s1[16], s2[16];
#pragma unroll
    for (int j = 0; j < 16; ++j) {
        s1[j] = ord2f(L0[j] & ~127u); s2[j] = ord2f(L1[j] & ~127u);
        slot[j] = 127 - (int)(L0[j] & 127u); slot[16 + j] = 127 - (int)(L1[j] & 127u);
    }
    u32 lst[16];
#pragma unroll
    for (int j = 0; j < 16; ++j) lst[j] = cand_key(s1[0] + s2[j], j);
#pragma unroll
    for (int i = 1; i < 5; ++i) {
        u32 row[16];
#pragma unroll
        for (int j = 0; j < 16; ++j) row[j] = ((i + 1) * (j + 1) <= 16) ? cand_key(s1[i] + s2[j], i * 16 + j) : 0u;
        merge16_desc(lst, row);
    }
#pragma unroll
    for (int i = 5; i < 16; ++i)
#pragma unroll
        for (int j = 0; j < 2; ++j)
            if ((i + 1) * (j + 1) <= 16) top16_insert(lst, cand_key(s1[i] + s2[j], i * 16 + j));
    float pv[16]; float sum = 0.f;
    const float mx = ord2f(lst[0] & ~255u);
#pragma unroll
    for (int j = 0; j < 16; ++j) { pv[j] = __expf(ord2f(lst[j] & ~255u) - mx); sum += pv[j]; }
    const float inv = 1.f / sum;
    int ev[16];
#pragma unroll
    for (int j = 0; j < 16; ++j) {
        const int ci = 255 - (int)(lst[j] & 255u);
        ev[j] = slot[ci >> 4] * 128 + slot[16 + (ci & 15)];
    }
    if (fh == 0) {
        uint4* ro = (uint4*)(WSP(unsigned short, WS_RIDX) + (size_t)tok * 128 + h * 16);
        float4* go = (float4*)(WSP(float, WS_RG) + (size_t)tok * 128 + h * 16);
#pragma unroll
        for (int q = 0; q < 2; ++q)
            ro[q] = make_uint4((u32)ev[8 * q] | ((u32)ev[8 * q + 1] << 16), (u32)ev[8 * q + 2] | ((u32)ev[8 * q + 3] << 16),
                               (u32)ev[8 * q + 4] | ((u32)ev[8 * q + 5] << 16), (u32)ev[8 * q + 6] | ((u32)ev[8 * q + 7] << 16));
#pragma unroll
        for (int q = 0; q < 4; ++q) go[q] = make_float4(pv[4 * q] * inv, pv[4 * q + 1] * inv, pv[4 * q + 2] * inv, pv[4 * q + 3] * inv);
    }
    }
}


#define OSM_THR 8.0f
DI void osm_update(f32x16& s, unsigned vm, float& m, float& lh, float& alpha) {
    float mx = -1e30f;
#pragma unroll
    for (int r = 0; r < 16; ++r) mx = ((vm >> r) & 1u) ? fmaxf(mx, s[r]) : mx;
    mx = fmaxf(mx, __shfl_xor(mx, 32));
    float mn = m; alpha = 1.f;
    if (!__all(mx <= m + OSM_THR)) { mn = fmaxf(m, mx); alpha = __expf(m - mn); }
    float ls = 0.f;
#pragma unroll
    for (int r = 0; r < 16; ++r) { const float pe = ((vm >> r) & 1u) ? __expf(s[r] - mn) : 0.f; s[r] = pe; ls += pe; }
    lh = lh * alpha + ls; m = mn;
}
DI void osm_update_full(f32x16& s, float& m, float& lh, float& alpha) {
    float mx = s[0];
#pragma unroll
    for (int r = 1; r < 16; ++r) mx = fmaxf(mx, s[r]);
    mx = fmaxf(mx, __shfl_xor(mx, 32));
    float mn = m; alpha = 1.f;
    if (!__all(mx <= m + OSM_THR)) { mn = fmaxf(m, mx); alpha = __expf(m - mn); }
    float ls = 0.f;
#pragma unroll
    for (int r = 0; r < 16; ++r) { const float pe = __expf(s[r] - mn); s[r] = pe; ls += pe; }
    lh = lh * alpha + ls; m = mn;
}
DI void tr_quad(const unsigned (&a)[4], unsigned hi_off, bf16x8 (&f)[4]) {
    s16x4 l0, h0, l1, h1, l2, h2, l3, h3;
    const unsigned b0 = a[0] + hi_off, b1 = a[1] + hi_off, b2 = a[2] + hi_off, b3 = a[3] + hi_off;
    asm volatile("ds_read_b64_tr_b16 %0, %8\n\tds_read_b64_tr_b16 %1, %9\n\tds_read_b64_tr_b16 %2, %10\n\tds_read_b64_tr_b16 %3, %11\n\t"
                 "ds_read_b64_tr_b16 %4, %12\n\tds_read_b64_tr_b16 %5, %13\n\tds_read_b64_tr_b16 %6, %14\n\tds_read_b64_tr_b16 %7, %15\n\ts_waitcnt lgkmcnt(0)"
                 : "=&v"(l0), "=&v"(h0), "=&v"(l1), "=&v"(h1), "=&v"(l2), "=&v"(h2), "=&v"(l3), "=&v"(h3)
                 : "v"(a[0]), "v"(b0), "v"(a[1]), "v"(b1), "v"(a[2]), "v"(b2), "v"(a[3]), "v"(b3) : "memory");
    f[0] = __builtin_shufflevector(l0, h0, 0, 1, 2, 3, 4, 5, 6, 7); f[1] = __builtin_shufflevector(l1, h1, 0, 1, 2, 3, 4, 5, 6, 7);
    f[2] = __builtin_shufflevector(l2, h2, 0, 1, 2, 3, 4, 5, 6, 7); f[3] = __builtin_shufflevector(l3, h3, 0, 1, 2, 3, 4, 5, 6, 7);
}

#define QB_BYTES (128 * 256)
#define KB_BYTES (32 * 256)
template <bool WITH_V>
DI void attnB_stage_kv(const bf16_t* __restrict__ kg  , unsigned char* Kd, unsigned char* Vd, int wave, int lane) {
#pragma unroll
    for (int i = 0; i < 2; ++i) {
        const int idx = wave * 2 + i;
        const int key = 4 * idx + (lane >> 4), cp = lane & 15;
        const bf16_t* g = kg + (size_t)key * ATT_IN;
        __builtin_amdgcn_global_load_lds((const unsigned*)(g + ((cp ^ (key & 15)) << 3)), (unsigned*)(Kd + idx * 1024 + lane * 16), 16, 0, 0);
        if (WITH_V) {
            const int cv = ((((cp >> 2) ^ (key & 3)) << 2) | (cp & 3));
            __builtin_amdgcn_global_load_lds((const unsigned*)(g + 512 + (cv << 3)), (unsigned*)(Vd + idx * 1024 + lane * 16), 16, 0, 0);
        }
    }
}
template <int KOFF, bool FULL>
DI void attnB_map(const unsigned char* Kc, const unsigned char* qlp, int ksw, int qsw, int fh, unsigned vm, unsigned vc, int tq,
                  float& m, float& l, f32x16 (&o)[4]) {
    f32x16 st;
#pragma unroll
    for (int r = 0; r < 16; ++r) st[r] = 0.f;
#pragma unroll
    for (int s = 0; s < 4; ++s) {
        const bf16x8 kf = *(const bf16x8*)(Kc + (((KOFF + 2 * s + fh) ^ ksw) << 4));
        const bf16x8 qf = *(const bf16x8*)(qlp + (((KOFF + 2 * s + fh) ^ qsw) << 4));
        st = MFMA32(kf, qf, st);
    }
    float al;
    if (FULL) osm_update_full(st, m, l, al); else osm_update(st, vm, m, l, al);
    if (!__all(al == 1.f)) {
#pragma unroll
        for (int d = 0; d < 4; ++d)
#pragma unroll
            for (int r = 0; r < 16; ++r) o[d][r] *= al;
    }
#pragma unroll
    for (int s = 0; s < 2; ++s) {
        const bf16x8 pf = pack_p(st, s);
        unsigned va[4]; bf16x8 vf[4];
#pragma unroll
        for (int d = 0; d < 4; ++d) va[d] = vc + s * 16 * 256 + ((d ^ tq) << 6);
        tr_quad(va, 8 * 256, vf);
#pragma unroll
        for (int d = 0; d < 4; ++d) o[d] = MFMA32(vf[d], pf, o[d]);
    }
}
DI void ph_attnB_fast(const Params& p, int item, unsigned char* smem) {
    const bf16_t* proj = WSP(bf16_t, WS_PROJ);
    const int tid = otid(), wave = tid >> 6, lane = tid & 63, fr = lane & 31, fh = lane >> 5;
    const int qt = 15 - (item >> 6), bh = item & 63, b = bh >> 2, h = bh & 3;
    const int q0 = qt * 128;
    const float lam = compute_lam(p, lane);
    const size_t rowbase = (size_t)b * SEQ;
    const int qrow = wave * 32 + fr, qpos = q0 + qrow;
    unsigned char* Ql = smem;
    unsigned char* Kl = smem + QB_BYTES;
    unsigned char* Vl = Kl + 2 * KB_BYTES;
    const bf16_t* kbase = proj + rowbase * ATT_IN + 2048 + h * 128;
    __syncthreads();
#pragma unroll
    for (int i = 0; i < 8; ++i) {
        const int idx = wave * 8 + i;
        const int row = 4 * idx + (lane >> 4), cp = lane & 15;
        __builtin_amdgcn_global_load_lds((const unsigned*)(proj + (rowbase + q0 + row) * ATT_IN + 1536 + h * 128 + ((cp ^ (row & 15)) << 3)),
                                         (unsigned*)(Ql + idx * 1024 + lane * 16), 16, 0, 0);
    }
    attnB_stage_kv<true>(kbase, Kl, Vl, wave, lane);
    const unsigned char* qlp = Ql + qrow * 256;
    const int qsw = qrow & 15, ksw = fr & 15;
    const int nkt = (q0 + 128) / 32;
    const int wlast = q0 + wave * 32 + 31;
    f32x16 o1[4], o2[4];
#pragma unroll
    for (int d = 0; d < 4; ++d)
#pragma unroll
        for (int r = 0; r < 16; ++r) { o1[d][r] = 0.f; o2[d][r] = 0.f; }
    float m1 = -1e30f, m2 = -1e30f, l1 = 0.f, l2 = 0.f;
    const int tq = (lane & 15) >> 2;
    const unsigned vrow = (unsigned)(uintptr_t)Vl + (4 * fh + tq) * 256 + (16 * ((lane >> 4) & 1) + 4 * (lane & 3)) * 2;
    asm volatile("s_waitcnt vmcnt(0)" ::: "memory");
    __syncthreads();
    for (int kt = 0; kt < nkt; ++kt) {
        const int cur = kt & 1;
        if (kt + 1 < nkt) attnB_stage_kv<true>(kbase + (size_t)(kt + 1) * 32 * ATT_IN, Kl + (cur ^ 1) * KB_BYTES, Vl + (cur ^ 1) * KB_BYTES, wave, lane);
        if (kt * 32 <= wlast) {
            const unsigned char* Kc = Kl + cur * KB_BYTES + fr * 256;
            const unsigned vc = vrow + cur * KB_BYTES;
            if (kt * 32 + 31 <= wlast - 31) {
                attnB_map<0, true>(Kc, qlp, ksw, qsw, fh, 0xffffu, vc, tq, m1, l1, o1);
                __builtin_amdgcn_sched_barrier(0);
                attnB_map<8, true>(Kc, qlp, ksw, qsw, fh, 0xffffu, vc, tq, m2, l2, o2);
            } else {
                unsigned vm = 0;
#pragma unroll
                for (int r = 0; r < 16; ++r) vm |= ((kt * 32 + crow(r, fh)) <= qpos) ? (1u << r) : 0u;
                attnB_map<0, false>(Kc, qlp, ksw, qsw, fh, vm, vc, tq, m1, l1, o1);
                __builtin_amdgcn_sched_barrier(0);
                attnB_map<8, false>(Kc, qlp, ksw, qsw, fh, vm, vc, tq, m2, l2, o2);
            }
        }
        asm volatile("s_waitcnt vmcnt(0)" ::: "memory");
        __syncthreads();
    }
    l1 += __shfl_xor(l1, 32); l2 += __shfl_xor(l2, 32);
    const float i1 = 1.f / l1, i2 = lam / l2;
    float ss = 0.f;
#pragma unroll
    for (int d = 0; d < 4; ++d)
#pragma unroll
        for (int r = 0; r < 16; ++r) { const float v = o1[d][r] * i1 - o2[d][r] * i2; o1[d][r] = v; ss += v * v; }
    ss += __shfl_xor(ss, 32);
    const float rinv = rsqrtf(ss * (1.f / 128.f) + EPSN) * 0.8f;
    const float* subg = p.in[11];
    bf16_t* op = WSP(bf16_t, WS_MIXED) + (rowbase + qpos) * DM + 512 + h * 128;
#pragma unroll
    for (int d = 0; d < 4; ++d)
#pragma unroll
        for (int g = 0; g < 4; ++g) {
            const int dim = 32 * d + 8 * g + 4 * fh;
            const float4 gg = *(const float4*)(subg + dim);
            uint2 w;
            w.x = pack2(o1[d][4 * g + 0] * rinv * gg.x, o1[d][4 * g + 1] * rinv * gg.y);
            w.y = pack2(o1[d][4 * g + 2] * rinv * gg.z, o1[d][4 * g + 3] * rinv * gg.w);
            *(uint2*)(op + dim) = w;
        }
}

#define KA_PITCH 128
#define VA_PITCH 192
#define WA_BYTES (32 * KA_PITCH + 32 * VA_PITCH)
template <int MODE>
DI void ph_attnA_fast(const Params& p, int item, unsigned char* smem) {
    const bf16_t* proj = WSP(bf16_t, WS_PROJ);
    const int tid = otid(), wave = tid >> 6, lane = tid & 63, fr = lane & 31, fh = lane >> 5;
    const int c = item & 15, h = (item >> 4) & 7, b = item >> 7;
    const size_t rowbase = (size_t)b * SEQ;
    const int qpos = MODE == 0 ? 128 * c + 32 * wave + fr : 16 * (32 * wave + fr) + c;
    const int pmin = MODE == 0 ? 128 * c + 32 * wave : 512 * wave + c, pmax = pmin + (MODE == 0 ? 31 : 496);
    bf16x8 qf[4];
    {
        const bf16_t* qp = proj + (rowbase + qpos) * ATT_IN + h * 64 + 8 * fh;
#pragma unroll
        for (int s = 0; s < 4; ++s) qf[s] = *(const bf16x8*)(qp + 16 * s);
    }
    f32x16 o[2];
#pragma unroll
    for (int d = 0; d < 2; ++d)
#pragma unroll
        for (int r = 0; r < 16; ++r) o[d][r] = 0.f;
    float m = -1e30f, l = 0.f;
    unsigned char* Kl = smem + wave * WA_BYTES;
    unsigned char* Vl = Kl + 32 * KA_PITCH;
    const unsigned vaddr = (unsigned)(uintptr_t)Vl + (4 * fh + ((lane & 15) >> 2)) * VA_PITCH + (16 * ((lane >> 4) & 1) + 4 * (lane & 3)) * 2;
    const int skey = lane >> 3, sc = lane & 7;
    int br = 0, d = MODE == 0 ? 1 : 16, W = MODE == 0 ? 128 : 2048, cls = MODE == 0 ? 0 : (c & 15);
    int j0 = MODE == 0 ? (pmin < 128 ? 0 : pmin - 128) : 0, jhi = MODE == 0 ? pmax : ((pmax - cls) >> 4);
    const bf16_t* kvbase = proj + rowbase * ATT_IN + 512 + h * 64 + sc * 8;
    uint4 rk0, rk1, rk2, rk3, rv0, rv1, rv2, rv3;
#define A_LOAD(i, RK, RV) do { int kp_ = cls + d * (j0 + skey + 8 * (i)); kp_ = kp_ > SEQ - 1 ? SEQ - 1 : kp_; kp_ = kp_ < 0 ? 0 : kp_; \
        const bf16_t* g_ = kvbase + (size_t)kp_ * ATT_IN; RK = *(const uint4*)g_; RV = *(const uint4*)(g_ + 512); } while (0)
#define A_WRITE(i, RK, RV) do { const int key_ = skey + 8 * (i); *(uint4*)(Kl + key_ * KA_PITCH + ((sc ^ ((key_ >> 1) & 7)) << 4)) = RK; \
        *(uint4*)(Vl + key_ * VA_PITCH + sc * 16) = RV; } while (0)
    A_LOAD(0, rk0, rv0); A_LOAD(1, rk1, rv1); A_LOAD(2, rk2, rv2); A_LOAD(3, rk3, rv3);
#pragma unroll 1
    for (;;) {
        A_WRITE(0, rk0, rv0); A_WRITE(1, rk1, rv1); A_WRITE(2, rk2, rv2); A_WRITE(3, rk3, rv3);
        const int cd = d, cW = W, ccls = cls, cj0 = j0;
        bool more = true;
        j0 += 32;
        if (j0 > jhi) {
            ++br;
            if (MODE == 0 || br == 2) more = false;
            else {
                d = 4; W = 512; cls = c & 3;
                const int lo = pmin - cls - W;
                j0 = lo < 0 ? 0 : lo >> 2;
                jhi = (pmax - cls) >> 2;
            }
        }
        A_LOAD(0, rk0, rv0); A_LOAD(1, rk1, rv1); A_LOAD(2, rk2, rv2); A_LOAD(3, rk3, rv3);
        f32x16 st;
#pragma unroll
        for (int r = 0; r < 16; ++r) st[r] = 0.f;
#pragma unroll
        for (int s = 0; s < 4; ++s) {
            const bf16x8 kf = *(const bf16x8*)(Kl + fr * KA_PITCH + (((2 * s + fh) ^ ((fr >> 1) & 7)) << 4));
            st = MFMA32(kf, qf[s], st);
        }
        float al;
        const int kfirst = ccls + cd * cj0, klast = kfirst + cd * 31;
        if (klast <= pmin && pmax - kfirst <= cW) osm_update_full(st, m, l, al);
        else {
            unsigned vm = 0;
#pragma unroll
            for (int r = 0; r < 16; ++r) {
                const int dist = qpos - (ccls + cd * (cj0 + crow(r, fh)));
                vm |= (dist >= 0 && dist <= cW) ? (1u << r) : 0u;
            }
            osm_update(st, vm, m, l, al);
        }
        if (!__all(al == 1.f)) {
#pragma unroll
            for (int dd = 0; dd < 2; ++dd)
#pragma unroll
                for (int r = 0; r < 16; ++r) o[dd][r] *= al;
        }
        {
            unsigned va[4]; bf16x8 vf[4];
            va[0] = vaddr; va[1] = vaddr + 64; va[2] = vaddr + 16 * VA_PITCH; va[3] = vaddr + 16 * VA_PITCH + 64;
            tr_quad(va, 8 * VA_PITCH, vf);
            const bf16x8 p0 = pack_p(st, 0), p1 = pack_p(st, 1);
            o[0] = MFMA32(vf[0], p0, o[0]); o[1] = MFMA32(vf[1], p0, o[1]);
            o[0] = MFMA32(vf[2], p1, o[0]); o[1] = MFMA32(vf[3], p1, o[1]);
        }
        if (!more) break;
    }
    l += __shfl_xor(l, 32);
    bf16_t* op = WSP(bf16_t, WS_MIXED) + (rowbase + qpos) * DM + h * 64;
    float* lsep = WSP(float, WS_LSE1) + (rowbase + qpos) * 8 + h;
    if (MODE == 0) {
        const float il = 1.f / l;
        if (fh == 0) *lsep = m + __logf(l);
#pragma unroll
        for (int dd = 0; dd < 2; ++dd)
#pragma unroll
            for (int g = 0; g < 4; ++g) {
                const int dim = 32 * dd + 8 * g + 4 * fh;
                uint2 w;
                w.x = pack2(o[dd][4 * g + 0] * il, o[dd][4 * g + 1] * il);
                w.y = pack2(o[dd][4 * g + 2] * il, o[dd][4 * g + 3] * il);
                *(uint2*)(op + dim) = w;
            }
    } else {
        const float lse1 = *lsep;
        const float M = fmaxf(m, lse1);
        const float w23 = __expf(m - M), w1 = __expf(lse1 - M);
        const float iden = 1.f / (l * w23 + w1);
        const float a23 = w23 * iden, a1 = w1 * iden;
        uint2 prev[2][4];
#pragma unroll
        for (int dd = 0; dd < 2; ++dd)
#pragma unroll
            for (int g = 0; g < 4; ++g) prev[dd][g] = *(const uint2*)(op + 32 * dd + 8 * g + 4 * fh);
#pragma unroll
        for (int dd = 0; dd < 2; ++dd)
#pragma unroll
            for (int g = 0; g < 4; ++g) {
                const int dim = 32 * dd + 8 * g + 4 * fh;
                const float p0 = __uint_as_float(prev[dd][g].x << 16), p1 = __uint_as_float(prev[dd][g].x & 0xffff0000u);
                const float p2 = __uint_as_float(prev[dd][g].y << 16), p3 = __uint_as_float(prev[dd][g].y & 0xffff0000u);
                uint2 w;
                w.x = pack2(o[dd][4 * g + 0] * a23 + p0 * a1, o[dd][4 * g + 1] * a23 + p1 * a1);
                w.y = pack2(o[dd][4 * g + 2] * a23 + p2 * a1, o[dd][4 * g + 3] * a23 + p3 * a1);
                *(uint2*)(op + dim) = w;
            }
    }
}
#define NITEM_B 1024
#define NITEM_A 2048
DI void ph_attn_fast(const Params& p, int vb, unsigned char* smem) {
    if (vb < NITEM_B) {
        const int item = vb < 512 ? vb : 512 + (1023 - vb);
        ph_attnB_fast(p, item, smem);
    } else ph_attnA_fast<0>(p, vb - NITEM_B, smem);
}


DI void ph_spatial_fast(const Params& p, int item, unsigned char* smem) {
    const int tid = otid(), wave = tid >> 6, lane = tid & 63, fr = lane & 31, fh = lane >> 5;
    const int wm = wave >> 1, wn = wave & 1;
    const int chunk = item >> 3, g = item & 7;
    bf16_t* u = WSP(bf16_t, WS_Z_U);
    const bf16_t* vt = WSP(bf16_t, WS_Z_VT);
    const float* ssq = WSP(float, WS_SSQ);
    const float* wsp = p.in[16] + (size_t)g * 128 * 128;
    float* rinv = (float*)(smem + 66 * 1024);
    unsigned char* Bt = smem + 32768;
    __syncthreads();
    if (tid < 128) {
        const float4* sp = (const float4*)(ssq + (size_t)(chunk * 128 + tid) * 64);
        float sacc = 0.f;
#pragma unroll
        for (int j = 0; j < 16; ++j) { const float4 q = sp[j]; sacc += (q.x + q.y) + (q.z + q.w); }
        rinv[tid] = rsqrtf(sacc * (1.f / CW) + EPSN);
    }
    const size_t vrow0 = (size_t)chunk * CW + g * 256;
    stage_tile(vt, 128, (int)vrow0, 0, Bt, wave, lane);
    stage_tile(vt, 128, (int)vrow0, 64, Bt + 16384, wave, lane);
    __syncthreads();
#pragma unroll
    for (int i = 0; i < 8; ++i) {
        const int id = tid + 256 * i;
        const int t = id >> 4, sc = id & 15;
        const float4 w0 = *(const float4*)(wsp + t * 128 + sc * 8);
        const float4 w1 = *(const float4*)(wsp + t * 128 + sc * 8 + 4);
        const float4 r0 = *(const float4*)(rinv + sc * 8);
        const float4 r1 = *(const float4*)(rinv + sc * 8 + 4);
        const int s0 = sc * 8;
        uint4 o;
        o.x = pack2(s0 + 0 <= t ? w0.x * r0.x : 0.f, s0 + 1 <= t ? w0.y * r0.y : 0.f);
        o.y = pack2(s0 + 2 <= t ? w0.z * r0.z : 0.f, s0 + 3 <= t ? w0.w * r0.w : 0.f);
        o.z = pack2(s0 + 4 <= t ? w1.x * r1.x : 0.f, s0 + 5 <= t ? w1.y * r1.y : 0.f);
        o.w = pack2(s0 + 6 <= t ? w1.z * r1.z : 0.f, s0 + 7 <= t ? w1.w * r1.w : 0.f);
        const int kt = sc >> 3, c = sc & 7;
        *(uint4*)(smem + kt * 16384 + t * 128 + ((c ^ ((t >> 1) & 7)) << 4)) = o;
    }
#pragma unroll 1
    for (int nt = 0; nt < 2; ++nt) {
        asm volatile("s_waitcnt vmcnt(0)" ::: "memory");
        __syncthreads();
        uint4 ur[2][4];
#pragma unroll
        for (int i = 0; i < 2; ++i) {
            const uint4* upl = (const uint4*)(u + (size_t)(chunk * 128 + wm * 64 + i * 32 + fr) * CW + g * 256 + nt * 128 + wn * 64 + fh * 32);
#pragma unroll
            for (int q = 0; q < 4; ++q) ur[i][q] = upl[q];
        }
        f32x16 acc[2][2];
#pragma unroll
        for (int i = 0; i < 2; ++i)
#pragma unroll
            for (int j = 0; j < 2; ++j)
#pragma unroll
                for (int r = 0; r < 16; ++r) acc[i][j][r] = 0.f;
#pragma unroll
        for (int kt = 0; kt < 2; ++kt)
#pragma unroll
            for (int s = 0; s < 4; ++s) {
                bf16x8 a[2], b[2];
#pragma unroll
                for (int i = 0; i < 2; ++i) {
                    a[i] = lds_frag(smem + kt * 16384, wm * 64 + i * 32 + fr, 2 * s + fh);
                    b[i] = lds_frag(Bt + kt * 16384, wn * 64 + i * 32 + fr, 2 * s + fh);
                }
#pragma unroll
                for (int i = 0; i < 2; ++i)
#pragma unroll
                    for (int j = 0; j < 2; ++j) acc[i][j] = MFMA32(a[i], b[j], acc[i][j]);
            }
        __syncthreads();
        float* st = (float*)(Bt + wave * (32 * 65 * 4));
#pragma unroll
        for (int i = 0; i < 2; ++i) {
#pragma unroll
            for (int j = 0; j < 2; ++j)
#pragma unroll
                for (int r = 0; r < 16; ++r) st[crow(r, fh) * 65 + j * 32 + fr] = acc[i][j][r];
            const int t = wm * 64 + i * 32 + fr;
            const int c0 = g * 256 + nt * 128 + wn * 64 + fh * 32;
            bf16_t* up = u + (size_t)(chunk * 128 + t) * CW + c0;
            const float bias = p.in[17][g * 128 + t];
            const float* gn = p.in[15] + c0;
#pragma unroll
            for (int q = 0; q < 4; ++q) {
                float uf[8]; unpack8(ur[i][q], uf);
                const float4 g0 = *(const float4*)(gn + 8 * q), g1 = *(const float4*)(gn + 8 * q + 4);
                const float gg[8] = {g0.x, g0.y, g0.z, g0.w, g1.x, g1.y, g1.z, g1.w};
                float ov[8];
#pragma unroll
                for (int e = 0; e < 8; ++e) ov[e] = uf[e] * (st[fr * 65 + fh * 32 + 8 * q + e] * gg[e] + bias);
                uint4 o; o.x = pack2(ov[0], ov[1]); o.y = pack2(ov[2], ov[3]); o.z = pack2(ov[4], ov[5]); o.w = pack2(ov[6], ov[7]);
                ((uint4*)up)[q] = o;
            }
        }
        if (nt == 0) {
            __syncthreads();
            stage_tile(vt, 128, (int)vrow0 + 128, 0, Bt, wave, lane);
            stage_tile(vt, 128, (int)vrow0 + 128, 64, Bt + 16384, wave, lane);
        }
    }
}

#define XB_TMO      128
#define XB_XCNT(j)  (256  + 64 * (j))
#define XB_XSUB(j)  (1280 + 64 * (j))
#define XB_XGEN(j)  (2304 + 64 * (j))
#define XB_TOP      3328
#define XB_TOPGEN   3392
#define XCD_BAR_WORDS 3456
#define XB_SPIN_CAP (1u << 22)
DI unsigned xb_ld(unsigned* p) { return __hip_atomic_load(p, __ATOMIC_RELAXED, __HIP_MEMORY_SCOPE_AGENT); }
DI unsigned xb_add(unsigned* p, unsigned v) { return __hip_atomic_fetch_add(p, v, __ATOMIC_RELAXED, __HIP_MEMORY_SCOPE_AGENT); }
DI unsigned xb_xcc_id() { return (unsigned)__builtin_amdgcn_s_getreg((3 << 11) | 20) & 0xFu; }
#define XB_SPIN(cond, bar) do { unsigned _sp = 0; while (cond) { __builtin_amdgcn_s_sleep(1); \
    if ((++_sp & 255u) == 0u) { if (xb_ld(&(bar)[XB_TMO])) break; if (_sp > XB_SPIN_CAP) { atomicAdd(&(bar)[XB_TMO], 1u); break; } } } } while (0)
struct XcdBarrier { unsigned* bar; unsigned x; volatile LAS unsigned* st; };
DI XcdBarrier xcd_barrier_post(unsigned* bar, volatile LAS unsigned* st) {
    XcdBarrier b; b.bar = bar; b.x = xb_xcc_id(); b.st = st;
    if (threadIdx.x == 0) st[2] = xb_add(&bar[XB_XCNT(b.x)], 1u);
    return b;
}
DI void xcd_barrier_complete(unsigned* bar, unsigned x, unsigned& nloc, unsigned& nx, unsigned& xi) {
    const unsigned G = gridDim.x * gridDim.y * gridDim.z;
    unsigned sum, cnt, mine, below, sp = 0u;
    for (;;) {
        sum = 0u; cnt = 0u; mine = 0u; below = 0u;
#pragma unroll
        for (unsigned j = 0; j < 16; ++j) { const unsigned c = xb_ld(&bar[XB_XCNT(j)]); sum += c; cnt += (c > 0u) ? 1u : 0u; mine = (j == x) ? c : mine; below += (c > 0u && j < x) ? 1u : 0u; }
        if (sum == G) break;
        __builtin_amdgcn_s_sleep(1);
        if ((++sp & 255u) == 0u) { if (xb_ld(&bar[XB_TMO])) break; if (sp > XB_SPIN_CAP) { atomicAdd(&bar[XB_TMO], 1u); break; } }
    }
    nloc = mine > 0u ? mine : 1u; nx = cnt > 0u ? cnt : 1u; xi = below;
}
DI void xcd_barrier(const XcdBarrier& b) {
    asm volatile("s_waitcnt vmcnt(0)" ::: "memory");
    __syncthreads();
    if (threadIdx.x == 0) {
        unsigned* bar = b.bar;
        __builtin_amdgcn_s_waitcnt(0);
        unsigned nloc = b.st[0], nx = b.st[1];
        if (nloc == 0u) { unsigned xi; xcd_barrier_complete(bar, b.x, nloc, nx, xi); b.st[0] = nloc; b.st[1] = nx; b.st[3] = xi; }
        const unsigned old = xb_add(&bar[XB_XSUB(b.x)], 1u);
        const unsigned gen = old / nloc;
        if (old + 1u == (gen + 1u) * nloc) {
            __builtin_amdgcn_fence(__ATOMIC_RELEASE, "agent");
            asm volatile("s_waitcnt vmcnt(0)" ::: "memory");
            const unsigned og = xb_add(&bar[XB_TOP], 1u);
            const unsigned tg = og / nx;
            if (og + 1u == (tg + 1u) * nx) xb_add(&bar[XB_TOPGEN], 1u);
            else XB_SPIN(xb_ld(&bar[XB_TOPGEN]) == tg, bar);
            __builtin_amdgcn_fence(__ATOMIC_ACQUIRE, "agent");
            xb_add(&bar[XB_XGEN(b.x)], 1u);
            asm volatile("s_waitcnt vmcnt(0)" ::: "memory");
        } else {
            XB_SPIN(xb_ld(&bar[XB_XGEN(b.x)]) == gen, bar);
            __builtin_amdgcn_fence(__ATOMIC_ACQUIRE, "agent");
            asm volatile("s_waitcnt vmcnt(0)" ::: "memory");
        }
    }
    __syncthreads();
}

enum { PH_PREP = 0, PH_GEMM1, PH_ATTN, PH_ATTN2, PH_GEMM2,
       PH_NORM_P0, PH_GEMMQ0, PH_SCORE0, PH_PDOWN0, PH_PCOMB0, PH_PUP0, PH_NORM_SGU,
       PH_GEMM4, PH_SPATIAL, PH_GEMM5,
       PH_NORM_P1, PH_GEMMQ1, PH_SCORE1, PH_PDOWN1, PH_PCOMB1, PH_PUP1, PH_COUNT };

__host__ __device__ constexpr int phase_nvb(int ph) {
    switch (ph) {
        case PH_PREP: return PREP_N;
        case PH_GEMM1: return (ATT_IN / 256) * (NTOK / 256);
        case PH_ATTN: return NITEM_B + NITEM_A;
        case PH_ATTN2: return NITEM_A;
        case PH_GEMM2: return (DM / 256) * (NTOK / 256);
        case PH_NORM_P0: case PH_NORM_P1: case PH_NORM_SGU: return NTOK / 16;
        case PH_GEMMQ0: case PH_GEMMQ1: return 16 * (NTOK / 256);
        case PH_SCORE0: case PH_SCORE1: return (NTOK / 32) * 8 / 4;
        case PH_PCOMB0: case PH_PCOMB1: return NTOK / 8;
        case PH_GEMM4: return (4096 / 256) * (NTOK / 256);
        case PH_SPATIAL: return 256 * 8;
        case PH_GEMM5: return (DM / 256) * (NTOK / 256);
    }
    return 0;
}

template <int PH>
DI void run_vb(const Params& p, int vb, unsigned char* smem) {
    if constexpr (PH == PH_PREP) ph_prep(p, vb, smem);
    else if constexpr (PH == PH_ATTN) ph_attn_fast(p, vb, smem);
    else if constexpr (PH == PH_ATTN2) ph_attnA_fast<1>(p, vb, smem);
    else if constexpr (PH == PH_NORM_P0 || PH == PH_NORM_P1) rmsnorm_rows<true, 4>(WSP(bf16_t, WS_RES), p.in[19] + (PH == PH_NORM_P1 ? DM : 0), vb, WSP(signed char, WS_XQ), WSP(float, WS_XSC));
    else if constexpr (PH == PH_PCOMB0 || PH == PH_PCOMB1) ph_peer_comb(p, vb, PH == PH_PCOMB1 ? 1 : 0);
    else if constexpr (PH == PH_NORM_SGU) rmsnorm_rows<true, 4>(WSP(bf16_t, WS_RES), p.in[13], vb, WSP(signed char, WS_XQ), WSP(float, WS_XSC));
    else if constexpr (PH == PH_SPATIAL) ph_spatial_fast(p, vb, smem);
}

template <int PH>
DI void run_phase(const Params& p, unsigned char* smem) {
    if constexpr (PH == PH_PDOWN0 || PH == PH_PDOWN1) run_peer_sliced<false>(p, PH == PH_PDOWN1 ? 1 : 0, smem);
    else if constexpr (PH == PH_PUP0 || PH == PH_PUP1) run_peer_sliced<true>(p, PH == PH_PUP1 ? 1 : 0, smem);
    else if constexpr (PH == PH_SCORE0 || PH == PH_SCORE1) run_score(p, PH == PH_SCORE1 ? 1 : 0, smem);
    else if constexpr (PH == PH_GEMMQ0 || PH == PH_GEMMQ1) run_gemmq_pg8(p, PH == PH_GEMMQ1 ? 1 : 0, smem);
    else if constexpr (PH == PH_GEMM1) run_gemm1_pg8(p, smem);
    else if constexpr (PH == PH_GEMM4) run_gemm4_pg8(p, smem);
    else if constexpr (PH == PH_GEMM2) run_gemm_pg8<0>(p, smem);
    else if constexpr (PH == PH_GEMM5) run_gemm_pg8<1>(p, smem);
    else {
        constexpr int nvb = phase_nvb(PH);
        const int g = threadIdx.x >> 8;
        for (int vb = 2 * blockIdx.x; vb < nvb; vb += 2 * gridDim.x)
            if (vb + g < nvb) run_vb<PH>(p, vb + g, smem + g * GROUP_SMEM);
    }
}

template <int PH>
DI void run_from(const Params& p, unsigned char* smem, cg::grid_group& grid, const XcdBarrier& xb) {
    run_phase<PH>(p, smem);
    if constexpr (PH + 1 < PH_COUNT) {
        if constexpr (PH == 1) grid.sync(); else xcd_barrier(xb);
        run_from<PH + 1>(p, smem, grid, xb);
    }
}

__global__ void __launch_bounds__(NTHREADS, 2) k_mega(Params p) {
    extern __shared__ __attribute__((aligned(16))) unsigned char smem[];
    cg::grid_group grid = cg::this_grid();
    volatile LAS unsigned* st = (volatile LAS unsigned*)(smem + SMEM_BYTES);
    if (threadIdx.x == 0) { st[0] = 0u; st[1] = 0u; st[2] = 0u; st[3] = 0u; }
    __syncthreads();
    const XcdBarrier xb = xcd_barrier_post((unsigned*)(p.ws + WS_CTL), st);
    run_from<0>(p, smem, grid, xb);
}


extern "C" void kernel_launch(void* const* d_in, const int* in_sizes, int n_in, void* d_out, int out_size, void* d_ws, size_t ws_size, hipStream_t stream) {
    if (n_in != 24 || ws_size < WS_NEED || in_sizes[0] != NTOK * DM || out_size != NTOK * DM || in_sizes[22] != 2 * NEXP * DM) {
        fprintf(stderr, "kernel_launch: built for x[16,2048,1024] with 24 inputs and >= 512 MiB of workspace; got n_in %d, in0 %d, out %d, ws %zu: nothing launched\n", n_in, in_sizes[0], out_size, ws_size); return; }
    static int grid_blocks = 0;
    if (!grid_blocks) {
        int dev = 0, cus = 0, per_cu = 0;
        (void)hipGetDevice(&dev);
        (void)hipDeviceGetAttribute(&cus, hipDeviceAttributeMultiprocessorCount, dev);
        (void)hipFuncSetAttribute((const void*)k_mega, hipFuncAttributeMaxDynamicSharedMemorySize, SMEM_ALLOC);
        (void)hipOccupancyMaxActiveBlocksPerMultiprocessor(&per_cu, (const void*)k_mega, NTHREADS, SMEM_ALLOC);
        if (per_cu > 1) per_cu = 1;
        if (per_cu < 1) { fprintf(stderr, "kernel_launch: occupancy query returned %d\n", per_cu); per_cu = 1; }
        grid_blocks = cus * per_cu;
    }
    Params p{};
    for (int i = 0; i < 24; ++i) p.in[i] = (const float*)d_in[i];
    p.out = (float*)d_out;
    p.ws = (unsigned char*)d_ws;
    void* args[] = {&p};
    if (hipMemsetAsync((unsigned char*)d_ws + WS_CTL, 0, XCD_BAR_WORDS * 4, stream) != hipSuccess) { fprintf(stderr, "kernel_launch: memset of the barrier words failed\n"); return; }
    hipError_t e = hipLaunchCooperativeKernel((const void*)k_mega, dim3(grid_blocks), dim3(NTHREADS), args, SMEM_ALLOC, stream);
    if (e != hipSuccess) fprintf(stderr, "cooperative launch failed: %s (grid %d)\n", hipGetErrorString(e), grid_blocks);
}
```

```cpp
#include <hip/hip_runtime.h>
#include <stdint.h>
#include <stdio.h>

#define NTOK   32768
#define DM     1024
#define SEQ    2048
#define NB     16
#define ATT_IN 3072
#define CW     2048
#define NEXP   16384
#define EPSN   1e-6f

typedef unsigned short bf16_t;
typedef unsigned int u32;

#define DI __device__ __forceinline__
#define LAS __attribute__((address_space(3)))

DI int otid() { int t = threadIdx.x & 255; asm volatile("" : "+v"(t)); return t; }
DI int otid512() { int t = threadIdx.x; asm volatile("" : "+v"(t)); return t; }
DI float bf2f(bf16_t v) { return __uint_as_float(((u32)v) << 16); }
typedef __bf16 bf16v2 __attribute__((ext_vector_type(2)));
DI bf16_t f2bf(float f) { const __bf16 h = (__bf16)f; return __builtin_bit_cast(bf16_t, h); }
DI u32 pack2(float lo, float hi) { bf16v2 v; v[0] = (__bf16)lo; v[1] = (__bf16)hi; return __builtin_bit_cast(u32, v); }
DI float gelu_tanh(float x) {
    const float u = x * x;
    const float a = x * (2.3022081986432715f + 0.10294323980486315f * u);
    const float e = __builtin_amdgcn_exp2f(a);
    const float r = __builtin_amdgcn_rcpf(e + 1.f);
    return x - x * r;
}
#define WDPP(x, ctrl) __int_as_float(__builtin_amdgcn_update_dpp(__float_as_int(x), __float_as_int(x), (ctrl), 0xF, 0xF, false))
DI float wave_sum(float v) {
    v += WDPP(v, 0xB1); v += WDPP(v, 0x4E); v += WDPP(v, 0x141); v += WDPP(v, 0x140);
    { const auto sw = __builtin_amdgcn_permlane16_swap(__float_as_uint(v), __float_as_uint(v), false, false); v = __uint_as_float(sw[0]) + __uint_as_float(sw[1]); }
    { const auto sw = __builtin_amdgcn_permlane32_swap(__float_as_uint(v), __float_as_uint(v), false, false); v = __uint_as_float(sw[0]) + __uint_as_float(sw[1]); }
    return v;
}
DI float wave_max(float v) {
    v = fmaxf(v, WDPP(v, 0xB1)); v = fmaxf(v, WDPP(v, 0x4E)); v = fmaxf(v, WDPP(v, 0x141)); v = fmaxf(v, WDPP(v, 0x140));
    { const auto sw = __builtin_amdgcn_permlane16_swap(__float_as_uint(v), __float_as_uint(v), false, false); v = fmaxf(__uint_as_float(sw[0]), __uint_as_float(sw[1])); }
    { const auto sw = __builtin_amdgcn_permlane32_swap(__float_as_uint(v), __float_as_uint(v), false, false); v = fmaxf(__uint_as_float(sw[0]), __uint_as_float(sw[1])); }
    return v;
}
DI float xor32_max(float v) { const auto sw = __builtin_amdgcn_permlane32_swap(__float_as_uint(v), __float_as_uint(v), false, false); return fmaxf(__uint_as_float(sw[0]), __uint_as_float(sw[1])); }
DI float xor32_add(float v) { const auto sw = __builtin_amdgcn_permlane32_swap(__float_as_uint(v), __float_as_uint(v), false, false); return __uint_as_float(sw[0]) + __uint_as_float(sw[1]); }
DI float xor16_add(float v) { const auto sw = __builtin_amdgcn_permlane16_swap(__float_as_uint(v), __float_as_uint(v), false, false); return __uint_as_float(sw[0]) + __uint_as_float(sw[1]); }
DI u32 f2ord(float f) { const u32 u = __float_as_uint(f); return u ^ ((u32)((int)u >> 31) | 0x80000000u); }
DI float ord2f(u32 o) { return __uint_as_float(o ^ (~(u32)((int)o >> 31) | 0x80000000u)); }

#define MiB ((size_t)1 << 20)
#define WS_CTL      ((size_t)0)
#define WS_W_ATTIN  (1 * MiB)
#define WS_W_ATTOUT (7 * MiB)
#define WS_W_SGUIN  (9 * MiB)
#define WS_W_SGUOUT (17 * MiB)
#define WS_W_PQ     (21 * MiB)
#define WS_WQS      (25 * MiB)
#define WS_WAS      (25 * MiB + 64 * 1024)
#define WS_WSS      (25 * MiB + 128 * 1024)
#define WS_W_SUBK   (29 * MiB)
#define WS_DOWN     (32 * MiB)
#define WS_UP       (64 * MiB)
#define WS_DSC      (96 * MiB)
#define WS_USC      (96 * MiB + 128 * 1024)
#define WS_LSE1     (30 * MiB)
#define WS_XQ       (100 * MiB)
#define WS_XSC      (132 * MiB)
#define WS_RES      (160 * MiB)
#define WS_BIG      (224 * MiB)
#define WS_PROJ     (WS_BIG)
#define WS_MIXED    (WS_BIG + 192 * MiB)
#define WS_Z_U      (WS_BIG)
#define WS_Z_VT     (WS_BIG + 128 * MiB)
#define WS_RIDX     (WS_BIG + 32 * MiB)
#define WS_COEF     (WS_BIG + 40 * MiB)
#define WS_RG       (WS_BIG + 48 * MiB)
#define WS_QBUF     (WS_BIG + 64 * MiB)
#define WS_SSQ      (WS_BIG + 256 * MiB)
#define WS_NEED     (512 * MiB)

struct Params {
    const float* in[24];
    float* out;
    unsigned char* ws;
};

#include <hip/hip_cooperative_groups.h>
namespace cg = cooperative_groups;

#define GROUP_SMEM (68 * 1024)
#define PG8_EXTRA (128 * 1024)
#define PG8_SCALES (144 * 1024)
#define SMEM_BYTES (150 * 1024)
#define SMEM_ALLOC (SMEM_BYTES + 16)
#define NTHREADS 512

#define WSP(T, off) ((T*)(p.ws + (off)))


DI void transpose_tile(const float* __restrict__ W, bf16_t* __restrict__ Wt, int K, int N, int t, unsigned char* smem) {
    float* tile = (float*)smem;
    const int tid = otid();
    const int ntn = N / 64;
    const int n0 = (t % ntn) * 64, k0 = (t / ntn) * 64;
    __syncthreads();
    {
        const int n4 = tid & 15, kr = tid >> 4;
#pragma unroll
        for (int i = 0; i < 4; ++i) {
            const int k = kr + 16 * i;
            const float4 v = *(const float4*)(W + (size_t)(k0 + k) * N + n0 + 4 * n4);
            tile[k * 65 + 4 * n4 + 0] = v.x; tile[k * 65 + 4 * n4 + 1] = v.y; tile[k * 65 + 4 * n4 + 2] = v.z; tile[k * 65 + 4 * n4 + 3] = v.w;
        }
    }
    __syncthreads();
    {
        const int n = tid >> 2, kc = tid & 3;
        float v[16];
#pragma unroll
        for (int j = 0; j < 16; ++j) v[j] = tile[(16 * kc + j) * 65 + n];
        uint4 o0, o1;
        o0.x = pack2(v[0], v[1]); o0.y = pack2(v[2], v[3]); o0.z = pack2(v[4], v[5]); o0.w = pack2(v[6], v[7]);
        o1.x = pack2(v[8], v[9]); o1.y = pack2(v[10], v[11]); o1.z = pack2(v[12], v[13]); o1.w = pack2(v[14], v[15]);
        uint4* dst = (uint4*)(Wt + (size_t)(n0 + n) * K + k0 + 16 * kc);
        dst[0] = o0; dst[1] = o1;
    }
}
DI void cvt_chunk(const float* __restrict__ src, bf16_t* __restrict__ dst, int c) {
    const size_t base = (size_t)c * 2048;
#pragma unroll
    for (int i = 0; i < 8; ++i) {
        const size_t idx = base + i * 256 + otid();
        const float4 v = ((const float4*)src)[idx];
        uint2 o; o.x = pack2(v.x, v.y); o.y = pack2(v.z, v.w);
        ((uint2*)dst)[idx] = o;
    }
}
DI int q8(float v) { int i = __float2int_rn(v); i = i > 127 ? 127 : i; i = i < -127 ? -127 : i; return i & 255; }
template <bool IN_BF16, int ROWS>
DI void rmsnorm_rows(const void* __restrict__ x, const float* __restrict__ g, int vb, signed char* xq, float* xsc) {
    const int lane = otid() & 63;
    const int row0 = (vb * 4 + (otid() >> 6)) * ROWS;
    float4 v[ROWS][4];
#pragma unroll
    for (int r = 0; r < ROWS; ++r)
#pragma unroll
        for (int j = 0; j < 4; ++j) {
            if (IN_BF16) { const uint2 w = ((const uint2*)((const bf16_t*)x + (size_t)(row0 + r) * DM))[lane + 64 * j];
                v[r][j] = make_float4(__uint_as_float(w.x << 16), __uint_as_float(w.x & 0xffff0000u), __uint_as_float(w.y << 16), __uint_as_float(w.y & 0xffff0000u)); }
            else v[r][j] = ((const float4*)((const float*)x + (size_t)(row0 + r) * DM))[lane + 64 * j];
        }
    float4 gg[4];
#pragma unroll
    for (int j = 0; j < 4; ++j) gg[j] = ((const float4*)g)[lane + 64 * j];
#pragma unroll
    for (int r = 0; r < ROWS; ++r) {
        float ss = 0.f;
#pragma unroll
        for (int j = 0; j < 4; ++j) ss += v[r][j].x * v[r][j].x + v[r][j].y * v[r][j].y + v[r][j].z * v[r][j].z + v[r][j].w * v[r][j].w;
        ss = wave_sum(ss);
        const float rinv = rsqrtf(ss * (1.f / DM) + EPSN);
        float am = 0.f;
#pragma unroll
        for (int j = 0; j < 4; ++j) {
            v[r][j].x *= rinv * gg[j].x; v[r][j].y *= rinv * gg[j].y; v[r][j].z *= rinv * gg[j].z; v[r][j].w *= rinv * gg[j].w;
            am = fmaxf(am, fmaxf(fmaxf(fabsf(v[r][j].x), fabsf(v[r][j].y)), fmaxf(fabsf(v[r][j].z), fabsf(v[r][j].w))));
        }
        am = wave_max(am);
        const float sc = am > 0.f ? 127.f / am : 0.f;
        u32* qrow = (u32*)(xq + (size_t)(row0 + r) * DM);
#pragma unroll
        for (int j = 0; j < 4; ++j)
            qrow[lane + 64 * j] = (u32)q8(v[r][j].x * sc) | ((u32)q8(v[r][j].y * sc) << 8) | ((u32)q8(v[r][j].z * sc) << 16) | ((u32)q8(v[r][j].w * sc) << 24);
        if (lane == 0) xsc[row0 + r] = am * (1.f / 127.f);
    }
}
#define PREP_T0 192
#define PREP_T1 (PREP_T0 + 16 * 16)
#define PREP_T2 (PREP_T1 + 256)
#define PREP_T3 (PREP_T2 + 16 * 32)
#define PREP_T4 (PREP_T3 + 2 * 128)
#define PREP_C0 (PREP_T4 + 64)
#define PREP_C1 (PREP_C0 + 4096)
#define PREP_C2 (PREP_C1 + 4096)
#define PREP_N  (PREP_C2 + 4096)
template <bool INT8>
DI void fp8_rows(const float* __restrict__ src, unsigned char* __restrict__ dst, float* __restrict__ inv_scale, int vb) {
    const int lane = otid() & 63;
    const int row0 = (vb * 4 + (otid() >> 6)) * 2;
    float4 v[2][4];
#pragma unroll
    for (int r = 0; r < 2; ++r)
#pragma unroll
        for (int j = 0; j < 4; ++j) v[r][j] = ((const float4*)(src + (size_t)(row0 + r) * DM) + lane)[64 * j];
#pragma unroll
    for (int r = 0; r < 2; ++r) {
        const int row = row0 + r;
        float am = 0.f;
#pragma unroll
        for (int j = 0; j < 4; ++j) am = fmaxf(am, fmaxf(fmaxf(fabsf(v[r][j].x), fabsf(v[r][j].y)), fmaxf(fabsf(v[r][j].z), fabsf(v[r][j].w))));
        am = wave_max(am);
        float sc, inv;
        if (INT8) { sc = am > 0.f ? 127.f / am : 0.f; inv = am * (1.f / 127.f); }
        else {
            int e = (int)((__float_as_uint(am) >> 23) & 255u) - 127;
            if (am == 0.f) e = 0;
            e = e < -100 ? -100 : e;
            sc = __uint_as_float((u32)(127 + 7 - e) << 23); inv = __uint_as_float((u32)(127 + e - 7) << 23);
        }
        unsigned char* drow = dst + (size_t)(row >> 14) * NEXP * DM + (size_t)(row & (NEXP - 1)) * 128;
#pragma unroll
        for (int j = 0; j < 4; ++j) {
            const int dim = 4 * (lane + 64 * j);
            u32 w;
            if (INT8) w = (u32)q8(v[r][j].x * sc) | ((u32)q8(v[r][j].y * sc) << 8) | ((u32)q8(v[r][j].z * sc) << 16) | ((u32)q8(v[r][j].w * sc) << 24);
            else { int t = __builtin_amdgcn_cvt_pk_fp8_f32(v[r][j].x * sc, v[r][j].y * sc, 0, false); t = __builtin_amdgcn_cvt_pk_fp8_f32(v[r][j].z * sc, v[r][j].w * sc, t, true); w = (u32)t; }
            *(u32*)(drow + (size_t)(dim >> 7) * NEXP * 128 + (dim & 127)) = w;
        }
        if (lane == 0) inv_scale[row] = inv;
    }
}
DI void wq8_item(const float* __restrict__ W, signed char* __restrict__ Wt, float* __restrict__ wsc, int t, unsigned char* smem, int N) {
    float* red = (float*)smem;
    const int tid = otid(), n = tid & 15, kq = tid >> 4;
    const float* col = W + t * 16 + n + (size_t)(kq * 64) * N;
    float am = 0.f;
#pragma unroll 16
    for (int k = 0; k < 64; ++k) am = fmaxf(am, fabsf(col[(size_t)k * N]));
    __syncthreads();
    red[kq * 16 + n] = am;
    __syncthreads();
#pragma unroll
    for (int j = 0; j < 16; ++j) am = fmaxf(am, red[j * 16 + n]);
    const float sc = am > 0.f ? 127.f / am : 0.f;
    if (kq == 0) wsc[t * 16 + n] = am * (1.f / 127.f);
    signed char* drow = Wt + (size_t)(t * 16 + n) * 1024 + kq * 64;
#pragma unroll 1
    for (int kb = 0; kb < 4; ++kb) {
        u32 w[4];
#pragma unroll
        for (int j = 0; j < 4; ++j) {
            const float* c4 = col + (size_t)(kb * 16 + 4 * j) * N;
            w[j] = (u32)q8(c4[0] * sc) | ((u32)q8(c4[N] * sc) << 8) | ((u32)q8(c4[2 * N] * sc) << 16) | ((u32)q8(c4[3 * N] * sc) << 24);
        }
        *(uint4*)(drow + kb * 16) = make_uint4(w[0], w[1], w[2], w[3]);
    }
}
DI void ph_prep(const Params& p, int vb, unsigned char* smem) {
    if (vb < PREP_T0) wq8_item(p.in[2], WSP(signed char, WS_W_ATTIN), WSP(float, WS_WAS), vb, smem, ATT_IN);
    else if (vb < PREP_T1) transpose_tile(p.in[12], WSP(bf16_t, WS_W_ATTOUT), DM, DM, vb - PREP_T0, smem);
    else if (vb < PREP_T2) wq8_item(p.in[14], WSP(signed char, WS_W_SGUIN), WSP(float, WS_WSS), vb - PREP_T1, smem, 4096);
    else if (vb < PREP_T3) transpose_tile(p.in[18], WSP(bf16_t, WS_W_SGUOUT), CW, DM, vb - PREP_T2, smem);
    else if (vb < PREP_T4) { const int t = vb - PREP_T3, l = t / 128; wq8_item(p.in[20] + (size_t)l * DM * 2048, WSP(signed char, WS_W_PQ) + (size_t)l * 2048 * DM, WSP(float, WS_WQS) + l * 2048, t % 128, smem, 2048); }
    else if (vb < PREP_C0) cvt_chunk(p.in[21], WSP(bf16_t, WS_W_SUBK), vb - PREP_T4);
    else if (vb < PREP_C1) fp8_rows<true>(p.in[22], p.ws + WS_DOWN, WSP(float, WS_DSC), vb - PREP_C0);
    else if (vb < PREP_C2) fp8_rows<false>(p.in[23], p.ws + WS_UP, WSP(float, WS_USC), vb - PREP_C1);
    else rmsnorm_rows<false, 2>(p.in[0], p.in[1], vb - PREP_C2, WSP(signed char, WS_XQ), WSP(float, WS_XSC));
}

DI float compute_lam(const Params& p, int lane) {
    const float a = wave_sum(p.in[7][lane] * p.in[8][lane]);
    const float b = wave_sum(p.in[9][lane] * p.in[10][lane]);
    return __expf(a) - __expf(b) + 0.2f;
}
DI void ce_desc(u32& a, u32& b) { const u32 hi = max(a, b), lo = min(a, b); a = hi; b = lo; }
DI void sort16_desc(u32 (&v)[16]) {
#define SCE(a, b) ce_desc(v[a], v[b]);
    SCE(0,13) SCE(1,12) SCE(2,15) SCE(3,14) SCE(4,8) SCE(5,6) SCE(7,11) SCE(9,10)
    SCE(0,5) SCE(1,7) SCE(2,9) SCE(3,4) SCE(6,13) SCE(8,14) SCE(10,15) SCE(11,12)
    SCE(0,1) SCE(2,3) SCE(4,5) SCE(6,8) SCE(7,9) SCE(10,11) SCE(12,13) SCE(14,15)
    SCE(0,2) SCE(1,3) SCE(4,10) SCE(5,11) SCE(6,7) SCE(8,9) SCE(12,14) SCE(13,15)
    SCE(1,2) SCE(3,12) SCE(4,6) SCE(5,7) SCE(8,10) SCE(9,11) SCE(13,14)
    SCE(1,4) SCE(2,6) SCE(5,8) SCE(7,10) SCE(9,13) SCE(11,14)
    SCE(2,4) SCE(3,6) SCE(9,12) SCE(11,13)
    SCE(3,5) SCE(6,8) SCE(7,9) SCE(10,12)
    SCE(3,4) SCE(5,6) SCE(7,8) SCE(9,10) SCE(11,12)
    SCE(6,7) SCE(8,9)
#undef SCE
}
DI void merge16_desc(u32 (&a)[16], const u32 (&b)[16]) {
#pragma unroll
    for (int i = 0; i < 16; ++i) a[i] = max(a[i], b[15 - i]);
#pragma unroll
    for (int j = 8; j > 0; j >>= 1)
#pragma unroll
        for (int i = 0; i < 16; ++i) { const int l = i ^ j; if (l > i) ce_desc(a[i], a[l]); }
}
DI void top16_insert(u32 (&lst)[16], u32 x) {
#pragma unroll
    for (int j = 0; j < 16; ++j) { const u32 hi = max(lst[j], x); x = min(lst[j], x); lst[j] = hi; }
}
DI void unpack8(const uint4 v, float (&f)[8]) {
    f[0] = __uint_as_float(v.x << 16); f[1] = __uint_as_float(v.x & 0xffff0000u);
    f[2] = __uint_as_float(v.y << 16); f[3] = __uint_as_float(v.y & 0xffff0000u);
    f[4] = __uint_as_float(v.z << 16); f[5] = __uint_as_float(v.z & 0xffff0000u);
    f[6] = __uint_as_float(v.w << 16); f[7] = __uint_as_float(v.w & 0xffff0000u);
}
typedef float f32x2_t __attribute__((ext_vector_type(2)));
DI void unpack16fp8(const uint4 w, float (&f)[16]) {
    f32x2_t t;
    t = __builtin_amdgcn_cvt_pk_f32_fp8((int)w.x, false); f[0] = t[0]; f[1] = t[1];
    t = __builtin_amdgcn_cvt_pk_f32_fp8((int)w.x, true);  f[2] = t[0]; f[3] = t[1];
    t = __builtin_amdgcn_cvt_pk_f32_fp8((int)w.y, false); f[4] = t[0]; f[5] = t[1];
    t = __builtin_amdgcn_cvt_pk_f32_fp8((int)w.y, true);  f[6] = t[0]; f[7] = t[1];
    t = __builtin_amdgcn_cvt_pk_f32_fp8((int)w.z, false); f[8] = t[0]; f[9] = t[1];
    t = __builtin_amdgcn_cvt_pk_f32_fp8((int)w.z, true);  f[10] = t[0]; f[11] = t[1];
    t = __builtin_amdgcn_cvt_pk_f32_fp8((int)w.w, false); f[12] = t[0]; f[13] = t[1];
    t = __builtin_amdgcn_cvt_pk_f32_fp8((int)w.w, true);  f[14] = t[0]; f[15] = t[1];
}
struct PeerPre { int e[16]; uint4 xa, c0, c1; float2 r; };
struct PeerRows { uint4 d[8]; float c[8]; };
struct PeerRaw { u32 ids, aux, res; };
typedef unsigned lu32x4 __attribute__((ext_vector_type(4)));
DI uint4 lds_u4(const LAS unsigned char* a) { const lu32x4 v = *(const LAS lu32x4*)a; return make_uint4(v[0], v[1], v[2], v[3]); }
template <bool UP>
DI PeerRaw peer_raw_load(const Params& p, int tok, int sl, int lane) {
    PeerRaw g;
    g.ids = *(const u32*)(WSP(unsigned short, WS_RIDX) + (size_t)tok * 128 + 2 * lane);
    if (UP) {
        g.aux = *(const u32*)(WSP(bf16_t, WS_COEF) + (size_t)tok * 128 + 2 * lane);
        g.res = *(const u32*)(WSP(bf16_t, WS_RES) + (size_t)tok * DM + sl * 128 + 16 * (lane & 7) + 2 * (lane >> 3));
    } else {
        g.aux = *(const u32*)(WSP(signed char, WS_XQ) + (size_t)tok * DM + sl * 128 + 4 * (lane & 31));
        g.res = 0u;
    }
    return g;
}
template <bool UP>
DI PeerPre peer_stage(const PeerRaw& g, int lane, LAS unsigned char* wl) {
    *(LAS u32*)(wl + 4 * lane) = g.ids;
    if (UP) *(LAS u32*)(wl + 256 + 4 * lane) = g.aux; else *(LAS u32*)(wl + 256 + 4 * (lane & 31)) = g.aux;
    PeerPre q;
#pragma unroll
    for (int j = 0; j < 2; ++j) {
        const uint4 t = lds_u4(wl + 32 * (lane >> 3) + 16 * j);
        q.e[8 * j] = (int)(t.x & 0xffffu); q.e[8 * j + 1] = (int)(t.x >> 16); q.e[8 * j + 2] = (int)(t.y & 0xffffu); q.e[8 * j + 3] = (int)(t.y >> 16);
        q.e[8 * j + 4] = (int)(t.z & 0xffffu); q.e[8 * j + 5] = (int)(t.z >> 16); q.e[8 * j + 6] = (int)(t.w & 0xffffu); q.e[8 * j + 7] = (int)(t.w >> 16);
    }
    if (UP) {
        q.c0 = lds_u4(wl + 256 + 32 * (lane >> 3)); q.c1 = lds_u4(wl + 256 + 32 * (lane >> 3) + 16);
        q.r = make_float2(__uint_as_float(g.res << 16), __uint_as_float(g.res & 0xffff0000u));
    } else {
        q.xa = lds_u4(wl + 256 + 16 * (lane & 7));
    }
    return q;
}
template <int HF, bool UP>
DI void peer_issue_rows(const Params& p, const unsigned char* tab, const PeerPre& q, int tok, int lane, PeerRows& R) {
    const unsigned dco = 16u * (unsigned)(lane & 7);
#pragma unroll
    for (int bi = 0; bi < 8; ++bi) R.d[bi] = *(const uint4*)(tab + ((unsigned)q.e[8 * HF + bi] * 128u + dco));
    if (UP) {
        const uint4 cw = HF ? q.c1 : q.c0;
        R.c[0] = __uint_as_float(cw.x << 16); R.c[1] = __uint_as_float(cw.x & 0xffff0000u); R.c[2] = __uint_as_float(cw.y << 16); R.c[3] = __uint_as_float(cw.y & 0xffff0000u);
        R.c[4] = __uint_as_float(cw.z << 16); R.c[5] = __uint_as_float(cw.z & 0xffff0000u); R.c[6] = __uint_as_float(cw.w << 16); R.c[7] = __uint_as_float(cw.w & 0xffff0000u);
    }
}
template <int HF>
DI void peer_down_half(const PeerPre& q, const PeerRows& R, float (&part)[16]) {
#pragma unroll
    for (int bi = 0; bi < 8; ++bi) {
        int a = __builtin_amdgcn_sdot4((int)R.d[bi].x, (int)q.xa.x, 0, false);
        a = __builtin_amdgcn_sdot4((int)R.d[bi].y, (int)q.xa.y, a, false);
        a = __builtin_amdgcn_sdot4((int)R.d[bi].z, (int)q.xa.z, a, false);
        a = __builtin_amdgcn_sdot4((int)R.d[bi].w, (int)q.xa.w, a, false);
        part[8 * HF + bi] = __int_as_float(a);
    }
}
#define DPP_MOV(old, src, ctrl, bank) __builtin_amdgcn_update_dpp((old), (src), (ctrl), 0xF, (bank), false)
DI void peer_down_fin(const Params& p, const float (&part)[16], int tok, int sl, int lane) {
    const bool b2 = lane & 4, b1 = lane & 2, b0 = lane & 1;
    int r8[8], r4[4], r2[2];
#pragma unroll
    for (int i = 0; i < 8; ++i) {
        const int lo = __float_as_int(part[i]), hi = __float_as_int(part[i + 8]);
        int g = DPP_MOV(lo, lo, 0x104, 0x5);
        g = DPP_MOV(g, hi, 0x114, 0xA);
        r8[i] = (b2 ? hi : lo) + g;
    }
#pragma unroll
    for (int i = 0; i < 4; ++i) { const int snd = b1 ? r8[i] : r8[i + 4]; const int kp = b1 ? r8[i + 4] : r8[i]; r4[i] = kp + DPP_MOV(snd, snd, 0x4E, 0xF); }
#pragma unroll
    for (int i = 0; i < 2; ++i) { const int snd = b0 ? r4[i] : r4[i + 2]; const int kp = b0 ? r4[i + 2] : r4[i]; r2[i] = kp + DPP_MOV(snd, snd, 0xB1, 0xF); }
    u32* pd = WSP(u32, WS_QBUF) + ((size_t)tok * 8 + sl) * 64;
    pd[lane] = pack2((float)r2[0], (float)r2[1]);
}
DI void ph_peer_comb(const Params& p, int vb, int l) {
    const int tid = otid(), lane = tid & 63;
    const int tok0 = (vb * 4 + (tid >> 6)) * 2;
    const float* dsc = WSP(float, WS_DSC) + (size_t)l * NEXP;
    const float* usc = WSP(float, WS_USC) + (size_t)l * NEXP;
    u32 w[2][8]; int2 e[2]; float2 g[2]; float xs[2];
#pragma unroll
    for (int r = 0; r < 2; ++r) {
        const int tok = tok0 + r;
        const u32* pd = WSP(u32, WS_QBUF) + (size_t)tok * 8 * 64;
#pragma unroll
        for (int sl = 0; sl < 8; ++sl) w[r][sl] = pd[sl * 64 + lane];
        { const u32 ew = *(const u32*)(WSP(unsigned short, WS_RIDX) + (size_t)tok * 128 + 2 * lane); e[r] = make_int2((int)(ew & 0xffffu), (int)(ew >> 16)); }
        g[r] = *(const float2*)(WSP(float, WS_RG) + (size_t)tok * 128 + 2 * lane);
        xs[r] = WSP(float, WS_XSC)[tok];
    }
#pragma unroll
    for (int r = 0; r < 2; ++r) {
        float t0 = 0.f, t1 = 0.f;
#pragma unroll
        for (int sl = 0; sl < 8; ++sl) { t0 += __uint_as_float(w[r][sl] << 16); t1 += __uint_as_float(w[r][sl] & 0xffff0000u); }
        float2 o;
        o.x = g[r].x * gelu_tanh(t0 * dsc[e[r].x] * xs[r]) * usc[e[r].x];
        o.y = g[r].y * gelu_tanh(t1 * dsc[e[r].y] * xs[r]) * usc[e[r].y];
        *(u32*)(WSP(bf16_t, WS_COEF) + (size_t)(tok0 + r) * 128 + 2 * lane) = pack2(o.x, o.y);
    }
}
template <int HF>
DI void peer_up_half(const PeerPre& q, const PeerRows& R, f32x2_t (&y)[8]) {
#pragma unroll
    for (int bi = 0; bi < 8; ++bi) {
        const f32x2_t c2 = {R.c[bi], R.c[bi]};
        const uint4 w = R.d[bi];
        y[0] = __builtin_amdgcn_cvt_pk_f32_fp8((int)w.x, false) * c2 + y[0]; y[1] = __builtin_amdgcn_cvt_pk_f32_fp8((int)w.x, true) * c2 + y[1];
        y[2] = __builtin_amdgcn_cvt_pk_f32_fp8((int)w.y, false) * c2 + y[2]; y[3] = __builtin_amdgcn_cvt_pk_f32_fp8((int)w.y, true) * c2 + y[3];
        y[4] = __builtin_amdgcn_cvt_pk_f32_fp8((int)w.z, false) * c2 + y[4]; y[5] = __builtin_amdgcn_cvt_pk_f32_fp8((int)w.z, true) * c2 + y[5];
        y[6] = __builtin_amdgcn_cvt_pk_f32_fp8((int)w.w, false) * c2 + y[6]; y[7] = __builtin_amdgcn_cvt_pk_f32_fp8((int)w.w, true) * c2 + y[7];
        asm volatile("" : "+v"(y[0]), "+v"(y[1]), "+v"(y[2]), "+v"(y[3]), "+v"(y[4]), "+v"(y[5]), "+v"(y[6]), "+v"(y[7]));
    }
}
DI void peer_up_fin(const Params& p, const PeerPre& q, const f32x2_t (&y2)[8], int tok, int sl, int lane, bool final_layer) {
    float y[16];
#pragma unroll
    for (int i = 0; i < 8; ++i) { y[2 * i] = y2[i][0]; y[2 * i + 1] = y2[i][1]; }
    const int rg = lane >> 3, dc = lane & 7;
    const bool b5 = lane & 32, b4 = lane & 16, b3 = lane & 8;
    float r8[8], r4[4], r2[2];
#pragma unroll
    for (int i = 0; i < 8; ++i) { const auto sw = __builtin_amdgcn_permlane32_swap(__float_as_uint(y[i]), __float_as_uint(y[i + 8]), false, false); r8[i] = __uint_as_float(sw[0]) + __uint_as_float(sw[1]); }
#pragma unroll
    for (int i = 0; i < 4; ++i) { const auto sw = __builtin_amdgcn_permlane16_swap(__float_as_uint(r8[i]), __float_as_uint(r8[i + 4]), false, false); r4[i] = __uint_as_float(sw[0]) + __uint_as_float(sw[1]); }
#pragma unroll
    for (int i = 0; i < 2; ++i) { const float snd = b3 ? r4[i] : r4[i + 2]; const float kp = b3 ? r4[i + 2] : r4[i]; r2[i] = kp + __int_as_float(DPP_MOV(__float_as_int(snd), __float_as_int(snd), 0x128, 0xF)); }
    float2 v = q.r;
    v.x += r2[0]; v.y += r2[1];
    if (final_layer) *(float2*)(p.out + (size_t)tok * DM + sl * 128 + 16 * dc + 2 * rg) = v;
    else *(u32*)(WSP(bf16_t, WS_RES) + (size_t)tok * DM + sl * 128 + 16 * dc + 2 * rg) = pack2(v.x, v.y);
}
template <bool UP>
DI void run_peer_sliced(const Params& p, int l, unsigned char* smem) {
    volatile LAS unsigned* st = (volatile LAS unsigned*)(smem + SMEM_BYTES);
    const int nloc = (int)st[0], nx = (int)st[1], rank = (int)st[2], xi = (int)st[3];
    const int tid = otid512(), lane = tid & 63, wave = tid >> 6;
    const int stride = nloc * 8;
    LAS unsigned char* wl = (LAS unsigned char*)smem + wave * 512;
#pragma unroll 1
    for (int sl = xi; sl < 8; sl += nx) {
        const unsigned char* tab = p.ws + (UP ? WS_UP : WS_DOWN) + (size_t)l * NEXP * DM + (size_t)sl * NEXP * 128;
        int tok = rank * 8 + wave;
        if (tok >= NTOK) continue;
        PeerPre qa, qb;
        { const PeerRaw g0 = peer_raw_load<UP>(p, tok, sl, lane); qa = peer_stage<UP>(g0, lane, wl); }
        PeerRaw ga = peer_raw_load<UP>(p, tok + stride < NTOK ? tok + stride : tok, sl, lane), gb;
        PeerRows R;
        peer_issue_rows<0, UP>(p, tab, qa, tok, lane, R);
#define PEER_STEP(QC, QN, GA, GB) do { \
            const int tn = tok + stride < NTOK ? tok + stride : tok; \
            const int tn2 = tn + stride < NTOK ? tn + stride : tn; \
            GB = peer_raw_load<UP>(p, tn2, sl, lane);                       \
            QN = peer_stage<UP>(GA, lane, wl);                              \
            float acc[16]; f32x2_t accu[8]; \
            _Pragma("unroll") for (int i = 0; i < 16; ++i) acc[i] = 0.f; \
            _Pragma("unroll") for (int i = 0; i < 8; ++i) accu[i] = (f32x2_t){0.f, 0.f}; \
            PeerRows Rn; \
            peer_issue_rows<1, UP>(p, tab, QC, tok, lane, Rn);              \
            __builtin_amdgcn_sched_barrier(0); \
            if (UP) peer_up_half<0>(QC, R, accu); else peer_down_half<0>(QC, R, acc);     \
            __builtin_amdgcn_sched_barrier(0); \
            peer_issue_rows<0, UP>(p, tab, QN, tn, lane, R);                \
            __builtin_amdgcn_sched_barrier(0); \
            if (UP) { peer_up_half<1>(QC, Rn, accu); peer_up_fin(p, QC, accu, tok, sl, lane, l == 1); } \
            else { peer_down_half<1>(QC, Rn, acc); peer_down_fin(p, acc, tok, sl, lane); } \
            __builtin_amdgcn_sched_barrier(0); \
            tok += stride; \
        } while (0)
#pragma unroll 1
        for (;;) {
            PEER_STEP(qa, qb, ga, gb);
            if (tok >= NTOK) break;
            PEER_STEP(qb, qa, gb, ga);
            if (tok >= NTOK) break;
        }
#undef PEER_STEP
    }
}


typedef short bf16x8 __attribute__((ext_vector_type(8)));
typedef float f32x16 __attribute__((ext_vector_type(16)));
#define MFMA32(a, b, c) __builtin_amdgcn_mfma_f32_32x32x16_bf16((a), (b), (c), 0, 0, 0)
typedef short s16x4 __attribute__((ext_vector_type(4)));
DI bf16x8 pack_p(const f32x16& pt, int s) {
    uint4 o;
    o.x = pack2(pt[8 * s + 0], pt[8 * s + 1]); o.y = pack2(pt[8 * s + 2], pt[8 * s + 3]);
    o.z = pack2(pt[8 * s + 4], pt[8 * s + 5]); o.w = pack2(pt[8 * s + 6], pt[8 * s + 7]);
    return __builtin_bit_cast(bf16x8, o);
}

DI void stage_tile(const bf16_t* __restrict__ g, int ld, int row0, int k0, unsigned char* lt, int wave, int lane) {
#pragma unroll
    for (int i = 0; i < 4; ++i) {
        const int inst = wave * 4 + i;
        const int row = inst * 8 + (lane >> 3);
        const int c = (lane & 7) ^ ((row >> 1) & 7);
        __builtin_amdgcn_global_load_lds((const unsigned*)(g + (size_t)(row0 + row) * ld + k0 + c * 8),
                                         (unsigned*)(lt + inst * 1024 + lane * 16), 16, 0, 0);
    }
}
DI bf16x8 lds_frag(const unsigned char* lt, int row, int c) {
    return *(const bf16x8*)(lt + row * 128 + ((c ^ ((row >> 1) & 7)) << 4));
}
DI int crow(int r, int fh) { return (r & 3) + 8 * (r >> 2) + 4 * fh; }

namespace pg8 {
#define PG8_LAS __attribute__((address_space(3)))
typedef float f32x4 __attribute__((ext_vector_type(4)));
typedef unsigned u32x4 __attribute__((ext_vector_type(4)));
constexpr int BM = 256, BK = 64, HALF = 128, HTB = HALF * BK * 2  , STAGE_BYTES = 8 * HTB;
__host__ __device__ __forceinline__ int lds_byte(int r, int c) { const int st = (r >> 4) * 2 + (c >> 5), rr = r & 15, cc = c & 31, ob = rr * 64 + cc * 2; return st * 1024 + (ob ^ (((ob >> 9) & 1) << 5)); }
__host__ __device__ __forceinline__ void stage_rc(int b, int& R, int& C) { const int st = b / 1024, sb = b % 1024, swz = sb ^ (((sb >> 9) & 1) << 5); R = (st >> 1) * 16 + swz / 64; C = (st & 1) * 32 + (swz % 64) / 2; }
__host__ __device__ __forceinline__ int perm32(int rho) { const int n = rho >> 4, i = rho & 15; return 8 * (i >> 2) + 4 * n + (i & 3); }
struct Unit { int pm, pn; };
struct Gemm { const void* A; const void* Bt; int M, N, K; const float* rsc; const float* csc; };
struct XcdOrder {
    int ntn, nloc, nx, rank, xi, nown, total;
    __device__ __forceinline__ void init(int nmt, int ntn_, int nloc_, int nx_, int rank_, int xi_) {
        ntn = ntn_; nloc = nloc_; nx = nx_; rank = rank_; xi = xi_; nown = xi < nmt ? (nmt - xi + nx - 1) / nx : 0; total = nown * ntn; }
    __device__ __forceinline__ bool next(int i, Unit& u) const {
        const int t = rank + i * nloc; if (t >= total) return false;
        const int g4 = t / (4 * ntn), r = t - g4 * 4 * ntn;
        const int left = nown - 4 * g4, gs = left < 4 ? left : 4;
        const int nt = r / gs, mi = r - nt * gs;
        u.pm = (4 * g4 + mi) * nx + xi; u.pn = nt; return true;
    }
    __device__ __forceinline__ void a_ready(const Unit&) const {}
    __device__ __forceinline__ void done(const Unit&) const {}
};
typedef int i32x4 __attribute__((ext_vector_type(4)));
template <class Epi, class Sched, bool ALIGN_EPI = false, bool SP2 = false, bool I8 = false>
__device__ __forceinline__ void gemm_phase(PG8_LAS unsigned char* lds, const Gemm g, const Sched& S, const Epi& E) {
    const int tid = otid512(), wid = __builtin_amdgcn_readfirstlane(tid >> 6), lane = tid & 63, wr = wid >> 2, wc = wid & 3, fr = lane & 15, fq = lane >> 4;
    const int K = g.K, KB = I8 ? K : 2 * K  , nt = KB / (BK * 2);
    unsigned voffA[2], voffB[2];
#pragma unroll
    for (int i = 0; i < 2; ++i) { int R, C; stage_rc(tid * 16 + i * 8192, R, C); const int Rb = Epi::PERM ? ((R & ~31) + perm32(R & 31)) : R;
        voffA[i] = (unsigned)(R * KB + C * 2); voffB[i] = (unsigned)(Rb * KB + C * 2); }
    const size_t kstep = (size_t)(BK * 2);
    const size_t hstep = (size_t)HALF * KB;
    const size_t tstep = 2 * hstep;
    const unsigned ldsw = (unsigned)wid * 1024u;
    const int aoff = lds_byte(wr * 64 + fr, fq * 8), boff = lds_byte(wc * 32 + fr, fq * 8);
#define PG8_SA(b, h) (((b) * 2 + (h)) * HTB)
#define PG8_SB(b, h) ((4 + (b) * 2 + (h)) * HTB)
#define PG8_STAGE(bufoff, gbase, voff) do { _Pragma("unroll") for (int _i = 0; _i < 2; ++_i) \
        __builtin_amdgcn_global_load_lds((const unsigned*)((const char*)(gbase) + (voff)[_i]), (PG8_LAS unsigned*)(lds + (bufoff) + ldsw + _i * 8192), 16, 0, 0); } while (0)
#define PG8_LDA(dst, b, h) do { _Pragma("unroll") for (int m = 0; m < 4; ++m) _Pragma("unroll") for (int k = 0; k < 2; ++k) dst[m][k] = *(const PG8_LAS bf16x8*)(lds + PG8_SA(b, h) + aoff + m * 2048 + k * 1024); } while (0)
#define PG8_LDB(dst, b, h) do { _Pragma("unroll") for (int n = 0; n < 2; ++n) _Pragma("unroll") for (int k = 0; k < 2; ++k) dst[n][k] = *(const PG8_LAS bf16x8*)(lds + PG8_SB(b, h) + boff + n * 2048 + k * 1024); } while (0)
#define PG8_MMA(ai, bj, At, Bt) do { __builtin_amdgcn_s_setprio(1); _Pragma("unroll") for (int m = 0; m < 4; ++m) _Pragma("unroll") for (int n = 0; n < 2; ++n) _Pragma("unroll") for (int k = 0; k < 2; ++k) \
        { if constexpr (I8) acc[ai][bj][m][n] = __builtin_bit_cast(f32x4, __builtin_amdgcn_mfma_i32_16x16x64_i8(__builtin_bit_cast(i32x4, Bt[n][k]), __builtin_bit_cast(i32x4, At[m][k]), __builtin_bit_cast(i32x4, acc[ai][bj][m][n]), 0, 0, 0)); \
          else acc[ai][bj][m][n] = __builtin_amdgcn_mfma_f32_16x16x32_bf16(Bt[n][k], At[m][k], acc[ai][bj][m][n], 0, 0, 0); } __builtin_amdgcn_s_setprio(0); } while (0)
#define PG8_WAIT_V(n) asm volatile("s_waitcnt vmcnt(" #n ")" ::: "memory")
#define PG8_WAIT_L(n) asm volatile("s_waitcnt lgkmcnt(" #n ")" ::: "memory")
#define PG8_BAR __builtin_amdgcn_s_barrier()
#define PG8_SCHED __builtin_amdgcn_sched_barrier(0)
    Unit cur, nxt; int ui = 0;
    if (!S.next(0, cur)) return;
    if constexpr (I8) { for (int i_ = 0; i_ < (S.rank % 3) * 4; ++i_) __builtin_amdgcn_s_sleep(56); }
    int sb = 0;
#define PG8_SCALE_FETCH(u, buf) do { if constexpr (I8) { if (wid < 2) { const int ln_ = otid512() & 63;     \
        const float* src_ = wid == 0 ? g.rsc + (u).pm * BM : g.csc + (u).pn * BM; \
        __builtin_amdgcn_global_load_lds((const unsigned*)(src_ + ln_ * 4), (PG8_LAS unsigned*)(lds + PG8_SCALES + (buf) * 2048 + wid * 1024 + ln_ * 16), 16, 0, 0); } } } while (0)
    PG8_SCALE_FETCH(cur, 0);
    f32x4 acc[2][2][4][2];
#pragma unroll
    for (int a = 0; a < 2; ++a)
#pragma unroll
        for (int b = 0; b < 2; ++b)
#pragma unroll
            for (int m = 0; m < 4; ++m)
#pragma unroll
                for (int n = 0; n < 2; ++n) acc[a][b][m][n] = (f32x4){0.f, 0.f, 0.f, 0.f};
    bf16x8 At[4][2], B0[2][2], B1[2][2];
    const char* cA = (const char*)g.A + (size_t)cur.pm * tstep; const char* cB = (const char*)g.Bt + (size_t)cur.pn * tstep;
    S.a_ready(cur);
    if constexpr (SP2) {
        PG8_STAGE(PG8_SB(0, 0), cB, voffB); PG8_STAGE(PG8_SB(0, 1), cB + hstep, voffB); PG8_STAGE(PG8_SA(0, 0), cA, voffA); PG8_STAGE(PG8_SA(0, 1), cA + hstep, voffA);
        if (wr == 1) PG8_BAR;
        PG8_WAIT_V(2); PG8_BAR;
        PG8_STAGE(PG8_SB(1, 0), cB + kstep, voffB); PG8_STAGE(PG8_SA(1, 0), cA + kstep, voffA); PG8_STAGE(PG8_SB(1, 1), cB + hstep + kstep, voffB);
        PG8_WAIT_V(6); PG8_BAR;
    } else {
        PG8_STAGE(PG8_SB(0, 0), cB, voffB); PG8_STAGE(PG8_SA(0, 0), cA, voffA); PG8_STAGE(PG8_SB(0, 1), cB + hstep, voffB); PG8_STAGE(PG8_SA(0, 1), cA + hstep, voffA);
        if (wr == 1) PG8_BAR;
        PG8_WAIT_V(4); PG8_BAR;
        PG8_STAGE(PG8_SB(1, 0), cB + kstep, voffB); PG8_STAGE(PG8_SA(1, 0), cA + kstep, voffA); PG8_STAGE(PG8_SB(1, 1), cB + hstep + kstep, voffB);
        PG8_WAIT_V(6); PG8_BAR;
    }
    for (;;) {
        const bool has_next = S.next(ui + 1, nxt);
        const int sbn = sb == 2 ? 0 : sb + 1;
        if (has_next) PG8_SCALE_FETCH(nxt, sbn);
        const char* nA = has_next ? (const char*)g.A + (size_t)nxt.pm * tstep : cA; const char* nB = has_next ? (const char*)g.Bt + (size_t)nxt.pn * tstep : cB;
        for (int t = 0; t < nt; t += 2) {
            const bool last = (t == nt - 2);
            const char* a1 = cA + (size_t)(t + 1) * kstep;
            const char* a2 = last ? nA : cA + (size_t)(t + 2) * kstep; const char* b2 = last ? nB : cB + (size_t)(t + 2) * kstep;
            const char* a3 = a2 + kstep; const char* b3 = b2 + kstep;
            if (last && has_next) S.a_ready(nxt);
            if constexpr (SP2) {
            PG8_LDB(B0, 0, 0); PG8_LDB(B1, 0, 1); PG8_SCHED; PG8_LDA(At, 0, 0); PG8_STAGE(PG8_SA(1, 1), a1 + hstep, voffA);
            PG8_WAIT_V(8); PG8_WAIT_L(0); PG8_BAR; PG8_MMA(0, 0, At, B0); PG8_MMA(0, 1, At, B1); PG8_BAR; PG8_SCHED;
            PG8_LDA(At, 0, 1); PG8_STAGE(PG8_SB(0, 0), b2, voffB); PG8_STAGE(PG8_SB(0, 1), b2 + hstep, voffB); PG8_STAGE(PG8_SA(0, 0), a2, voffA);
            PG8_WAIT_V(8); PG8_WAIT_L(0); PG8_BAR; PG8_MMA(1, 0, At, B0); PG8_MMA(1, 1, At, B1); PG8_BAR; PG8_SCHED;
            PG8_LDB(B0, 1, 0); PG8_LDB(B1, 1, 1); PG8_SCHED; PG8_LDA(At, 1, 0); PG8_STAGE(PG8_SA(0, 1), a2 + hstep, voffA);
            PG8_WAIT_V(8); PG8_WAIT_L(0); PG8_BAR; PG8_MMA(0, 0, At, B0); PG8_MMA(0, 1, At, B1); PG8_BAR; PG8_SCHED;
            PG8_LDA(At, 1, 1); PG8_STAGE(PG8_SB(1, 0), b3, voffB); PG8_STAGE(PG8_SB(1, 1), b3 + hstep, voffB); PG8_STAGE(PG8_SA(1, 0), a3, voffA);
            PG8_WAIT_V(8); PG8_WAIT_L(0); PG8_BAR; PG8_MMA(1, 0, At, B0); PG8_MMA(1, 1, At, B1); PG8_BAR; PG8_SCHED;
            } else {
            PG8_LDB(B0, 0, 0); PG8_SCHED; PG8_LDA(At, 0, 0); PG8_STAGE(PG8_SA(1, 1), a1 + hstep, voffA);
            PG8_WAIT_L(8); PG8_BAR; PG8_WAIT_L(0); PG8_MMA(0, 0, At, B0); PG8_BAR; PG8_SCHED;
            PG8_LDB(B1, 0, 1); PG8_STAGE(PG8_SB(0, 0), b2, voffB);
            PG8_BAR; PG8_WAIT_L(0); PG8_MMA(0, 1, At, B1); PG8_BAR;
            PG8_LDA(At, 0, 1); PG8_STAGE(PG8_SA(0, 0), a2, voffA);
            PG8_BAR; PG8_WAIT_L(0); PG8_MMA(1, 0, At, B0); PG8_BAR; PG8_SCHED;
            PG8_STAGE(PG8_SB(0, 1), b2 + hstep, voffB);
            PG8_WAIT_V(6); PG8_BAR; PG8_MMA(1, 1, At, B1); PG8_BAR;
            PG8_LDB(B0, 1, 0); PG8_SCHED; PG8_LDA(At, 1, 0); PG8_STAGE(PG8_SA(0, 1), a2 + hstep, voffA);
            PG8_WAIT_L(8); PG8_BAR; PG8_WAIT_L(0); PG8_MMA(0, 0, At, B0); PG8_BAR; PG8_SCHED;
            PG8_LDB(B1, 1, 1); PG8_STAGE(PG8_SB(1, 0), b3, voffB);
            PG8_BAR; PG8_WAIT_L(0); PG8_MMA(0, 1, At, B1); PG8_BAR;
            PG8_LDA(At, 1, 1); PG8_STAGE(PG8_SA(1, 0), a3, voffA);
            PG8_BAR; PG8_WAIT_L(0); PG8_MMA(1, 0, At, B0); PG8_BAR; PG8_SCHED;
            PG8_STAGE(PG8_SB(1, 1), b3 + hstep, voffB);
            PG8_WAIT_V(6); PG8_BAR; PG8_MMA(1, 1, At, B1); PG8_BAR;
            }
        }
        if constexpr (ALIGN_EPI) { if (wr == 0) PG8_BAR; }
        if constexpr (I8) {
            const PG8_LAS float* scl = (const PG8_LAS float*)(lds + PG8_SCALES + sb * 2048);
#pragma unroll
            for (int b = 0; b < 2; ++b) {
                const PG8_LAS float* cp = scl + 256 + b * HALF + wc * 32 + 8 * fq;
                const f32x4 c0 = *(const PG8_LAS f32x4*)cp, c1 = *(const PG8_LAS f32x4*)(cp + 4);
#pragma unroll
                for (int a = 0; a < 2; ++a)
#pragma unroll
                    for (int m = 0; m < 4; ++m) {
                        const float xs = scl[a * HALF + wr * 64 + m * 16 + fr];
                        acc[a][b][m][0] = __builtin_convertvector(__builtin_bit_cast(i32x4, acc[a][b][m][0]), f32x4) * c0 * xs;
                        acc[a][b][m][1] = __builtin_convertvector(__builtin_bit_cast(i32x4, acc[a][b][m][1]), f32x4) * c1 * xs;
                    }
            }
        }
        if constexpr (!Epi::AFTER_DRAIN) { E(acc, cur, wr, wc, fr, fq); S.done(cur); }
        if (!has_next) break;
#pragma unroll
        for (int a = 0; a < 2; ++a)
#pragma unroll
            for (int b = 0; b < 2; ++b)
#pragma unroll
                for (int m = 0; m < 4; ++m)
#pragma unroll
                    for (int n = 0; n < 2; ++n) acc[a][b][m][n] = (f32x4){0.f, 0.f, 0.f, 0.f};
        cur = nxt; cA = nA; cB = nB; ++ui; sb = sbn;
        if constexpr (ALIGN_EPI) { if (wr == 1) PG8_BAR; }
    }
    PG8_WAIT_V(0);
    if constexpr (!ALIGN_EPI) { if (wr == 0) PG8_BAR; }
    PG8_BAR;
    if constexpr (Epi::AFTER_DRAIN) { E.fused(acc, cur, wr, wc, fr, fq, lds, wid, lane); S.done(cur); }
#undef PG8_SA
#undef PG8_SB
#undef PG8_STAGE
#undef PG8_LDA
#undef PG8_LDB
#undef PG8_MMA
#undef PG8_WAIT_V
#undef PG8_WAIT_L
#undef PG8_BAR
#undef PG8_SCHED
#undef PG8_SCALE_FETCH
}
template <bool RES_BF16>
struct EpiResid {
    static constexpr bool PERM = true, AFTER_DRAIN = false;
    const void* resid; bf16_t* out;
    __device__ __forceinline__ void operator()(const f32x4 (&acc)[2][2][4][2], const Unit& u, int wr, int wc, int fr, int fq) const {
        const size_t base = (size_t)(u.pm * BM + wr * 64 + fr) * DM + u.pn * BM + wc * 32 + 8 * fq;
#pragma unroll
        for (int ai = 0; ai < 2; ++ai) {
            f32x4 rv[4][2][2];
#pragma unroll
            for (int m = 0; m < 4; ++m)
#pragma unroll
                for (int bj = 0; bj < 2; ++bj) {
                    const size_t o = base + (size_t)(ai * HALF + m * 16) * DM + bj * HALF;
                    if constexpr (RES_BF16) {
                        const u32x4 w = *(const u32x4*)((const bf16_t*)resid + o);
                        rv[m][bj][0] = (f32x4){__uint_as_float(w.x << 16), __uint_as_float(w.x & 0xffff0000u), __uint_as_float(w.y << 16), __uint_as_float(w.y & 0xffff0000u)};
                        rv[m][bj][1] = (f32x4){__uint_as_float(w.z << 16), __uint_as_float(w.z & 0xffff0000u), __uint_as_float(w.w << 16), __uint_as_float(w.w & 0xffff0000u)};
                    } else { const float* rp = (const float*)resid + o; rv[m][bj][0] = *(const f32x4*)rp; rv[m][bj][1] = *(const f32x4*)(rp + 4); }
                }
            asm volatile("" ::: "memory");
#pragma unroll
            for (int m = 0; m < 4; ++m)
#pragma unroll
                for (int bj = 0; bj < 2; ++bj) {
                    const f32x4 a = rv[m][bj][0] + acc[ai][bj][m][0], b = rv[m][bj][1] + acc[ai][bj][m][1];
                    u32x4 w; w.x = pack2(a[0], a[1]); w.y = pack2(a[2], a[3]); w.z = pack2(b[0], b[1]); w.w = pack2(b[2], b[3]);
                    *(u32x4*)(out + base + (size_t)(ai * HALF + m * 16) * DM + bj * HALF) = w;
                }
            asm volatile("" ::: "memory");
        }
    }
};
struct EpiProj {
    static constexpr bool PERM = true, AFTER_DRAIN = false;
    const float* aq; const float* ak; const float* bq; const float* bk; bf16_t* proj; PG8_LAS float* xs;
    __device__ __forceinline__ void operator()(const f32x4 (&acc)[2][2][4][2], const Unit& u, int wr, int wc, int fr, int fq) const {
        const int wave = wr * 4 + wc;
#pragma unroll
        for (int ai = 0; ai < 2; ++ai)
#pragma unroll
            for (int m = 0; m < 4; ++m)
#pragma unroll
                for (int bj = 0; bj < 2; ++bj) {
                    const f32x4 a = acc[ai][bj][m][0], b = acc[ai][bj][m][1];
                    float t = a[0] * a[0] + a[1] * a[1] + a[2] * a[2] + a[3] * a[3] + b[0] * b[0] + b[1] * b[1] + b[2] * b[2] + b[3] * b[3];
                    t = xor32_add(xor16_add(t));
                    if (fq == 0) xs[wave * 256 + ((ai * 4 + m) * 2 + bj) * 16 + fr] = t;
                }
        asm volatile("s_waitcnt lgkmcnt(0)" ::: "memory");
        __builtin_amdgcn_s_barrier();
#pragma unroll
        for (int bj = 0; bj < 2; ++bj) {
            const int gcol = u.pn * BM + bj * HALF + wc * 32 + 8 * fq;
            const float* gain = nullptr; float scale = 1.f;
            if (gcol < 512) { gain = aq + (gcol & 63); scale = 0.125f; }
            else if (gcol < 1024) gain = ak + (gcol & 63);
            else if (gcol < 1536) gain = nullptr;
            else if (gcol < 2048) { gain = bq + (gcol & 127); scale = 0.125f; }
            else if (gcol < 2560) gain = bk + (gcol & 127);
            f32x4 g0 = {1.f, 1.f, 1.f, 1.f}, g1 = {1.f, 1.f, 1.f, 1.f};
            if (gain) { g0 = *(const f32x4*)gain; g1 = *(const f32x4*)(gain + 4); }
#pragma unroll
            for (int ai = 0; ai < 2; ++ai)
#pragma unroll
                for (int m = 0; m < 4; ++m) {
                    float sc = 1.f;
                    if (gain) {
                        const int slot = ((ai * 4 + m) * 2 + bj) * 16 + fr;
                        sc = rsqrtf((xs[wave * 256 + slot] + xs[(wave ^ 1) * 256 + slot]) * (1.f / 64.f) + EPSN) * scale;
                    }
                    const f32x4 v0 = acc[ai][bj][m][0] * g0 * sc, v1 = acc[ai][bj][m][1] * g1 * sc;
                    u32x4 w; w.x = pack2(v0[0], v0[1]); w.y = pack2(v0[2], v0[3]); w.z = pack2(v1[0], v1[1]); w.w = pack2(v1[2], v1[3]);
                    *(u32x4*)(proj + (size_t)(u.pm * BM + ai * HALF + wr * 64 + m * 16 + fr) * ATT_IN + gcol) = w;
                }
        }
    }
};
__device__ __forceinline__ f32x4 gelu_tanh4(const f32x4 x) {
    const f32x4 u = x * x;
    const f32x4 a = x * (u * 0.10294323980486315f + 2.3022081986432715f);
    f32x4 e = {__builtin_amdgcn_exp2f(a[0]), __builtin_amdgcn_exp2f(a[1]), __builtin_amdgcn_exp2f(a[2]), __builtin_amdgcn_exp2f(a[3])};
    e = e + 1.f;
    const f32x4 r = {__builtin_amdgcn_rcpf(e[0]), __builtin_amdgcn_rcpf(e[1]), __builtin_amdgcn_rcpf(e[2]), __builtin_amdgcn_rcpf(e[3])};
    return x - x * r;
}
struct EpiSgu {
    static constexpr bool PERM = true, AFTER_DRAIN = false;
    bf16_t* zu; bf16_t* zvt; float* ssq; PG8_LAS unsigned char* stg;
    __device__ __forceinline__ void operator()(const f32x4 (&acc)[2][2][4][2], const Unit& u, int wr, int wc, int fr, int fq) const {
        const int wave = wr * 4 + wc, lane = fq * 16 + fr;
        PG8_LAS unsigned short* tl = (PG8_LAS unsigned short*)(stg + wave * 2048);
#pragma unroll
        for (int ai = 0; ai < 2; ++ai)
#pragma unroll
            for (int bj = 0; bj < 2; ++bj) {
                const int gcol = u.pn * BM + bj * HALF + wc * 32 + 8 * fq;
                f32x4 g0[4], g1[4];
#pragma unroll
                for (int m = 0; m < 4; ++m) {
                    const f32x4 a = acc[ai][bj][m][0], b = acc[ai][bj][m][1];
                    g0[m] = gelu_tanh4(a);
                    g1[m] = gelu_tanh4(b);
                }
                if (gcol < CW) {
#pragma unroll
                    for (int m = 0; m < 4; ++m) {
                        u32x4 w; w.x = pack2(g0[m][0], g0[m][1]); w.y = pack2(g0[m][2], g0[m][3]); w.z = pack2(g1[m][0], g1[m][1]); w.w = pack2(g1[m][2], g1[m][3]);
                        *(u32x4*)(zu + (size_t)(u.pm * BM + ai * HALF + wr * 64 + m * 16 + fr) * CW + gcol) = w;
                    }
                } else {
                    const int vcol = gcol - CW;
#pragma unroll
                    for (int m = 0; m < 4; ++m) {
                        float t = g0[m][0] * g0[m][0] + g0[m][1] * g0[m][1] + g0[m][2] * g0[m][2] + g0[m][3] * g0[m][3]
                                + g1[m][0] * g1[m][0] + g1[m][1] * g1[m][1] + g1[m][2] * g1[m][2] + g1[m][3] * g1[m][3];
                        t = xor32_add(xor16_add(t));
                        if (fq == 0) ssq[(size_t)(u.pm * BM + ai * HALF + wr * 64 + m * 16 + fr) * 64 + (vcol >> 5)] = t;
                    }
#pragma unroll
                    for (int h = 0; h < 2; ++h) {
#pragma unroll
                        for (int mm = 0; mm < 2; ++mm) {
                            const int m = 2 * h + mm, rl = 16 * mm + fr;
#pragma unroll
                            for (int j = 0; j < 4; ++j) { tl[(8 * fq + j) * 32 + rl] = f2bf(g0[m][j]); tl[(8 * fq + 4 + j) * 32 + rl] = f2bf(g1[m][j]); }
                        }
                        const int c = lane >> 1, hh = lane & 1;
                        const u32x4 w0 = *(const PG8_LAS u32x4*)(tl + c * 32 + hh * 16), w1 = *(const PG8_LAS u32x4*)(tl + c * 32 + hh * 16 + 8);
                        bf16_t* dst = zvt + ((size_t)(2 * u.pm + ai) * CW + (u.pn * BM - CW) + bj * HALF + wc * 32 + c) * 128 + wr * 64 + 32 * h + hh * 16;
                        *(u32x4*)dst = w0; *(u32x4*)(dst + 8) = w1;
                        asm volatile("" ::: "memory");
                    }
                }
            }
    }
};
struct EpiQ {
    static constexpr bool PERM = true, AFTER_DRAIN = false;
    bf16_t* q;
    __device__ __forceinline__ void operator()(const f32x4 (&acc)[2][2][4][2], const Unit& u, int wr, int wc, int fr, int fq) const {
#pragma unroll
        for (int ai = 0; ai < 2; ++ai)
#pragma unroll
            for (int m = 0; m < 4; ++m)
#pragma unroll
                for (int bj = 0; bj < 2; ++bj) {
                    const f32x4 a = acc[ai][bj][m][0], b = acc[ai][bj][m][1];
                    u32x4 w; w.x = pack2(a[0], a[1]); w.y = pack2(a[2], a[3]); w.z = pack2(b[0], b[1]); w.w = pack2(b[2], b[3]);
                    *(u32x4*)(q + (size_t)(u.pm * BM + ai * HALF + wr * 64 + m * 16 + fr) * 2048 + u.pn * BM + bj * HALF + wc * 32 + 8 * fq) = w;
                }
    }
};
}
DI void run_gemmq_pg8(const Params& p, int l, unsigned char* smem) {
    volatile LAS unsigned* st = (volatile LAS unsigned*)(smem + SMEM_BYTES);
    pg8::XcdOrder S; S.init(NTOK / 256, 2048 / 256, (int)st[0], (int)st[1], (int)st[2], (int)st[3]);
    const pg8::Gemm g{WSP(signed char, WS_XQ), WSP(signed char, WS_W_PQ) + (size_t)l * 2048 * DM, NTOK, 2048, DM, WSP(float, WS_XSC), WSP(float, WS_WQS) + l * 2048};
    pg8::EpiQ E; E.q = WSP(bf16_t, WS_QBUF);
    __syncthreads();
    pg8::gemm_phase<pg8::EpiQ, pg8::XcdOrder, true, true, true>((PG8_LAS unsigned char*)smem, g, S, E);
}
template <int WHICH>
DI void run_gemm_pg8(const Params& p, unsigned char* smem) {
    volatile LAS unsigned* st = (volatile LAS unsigned*)(smem + SMEM_BYTES);
    pg8::XcdOrder S; S.init(NTOK / 256, DM / 256, (int)st[0], (int)st[1], (int)st[2], (int)st[3]);
    pg8::Gemm g;
    pg8::EpiResid<WHICH == 1> E; E.out = WSP(bf16_t, WS_RES);
    if (WHICH == 0) { g = pg8::Gemm{WSP(bf16_t, WS_MIXED), WSP(bf16_t, WS_W_ATTOUT), NTOK, DM, DM, nullptr, nullptr}; E.resid = p.in[0]; }
    else { g = pg8::Gemm{WSP(bf16_t, WS_Z_U), WSP(bf16_t, WS_W_SGUOUT), NTOK, DM, CW, nullptr, nullptr}; E.resid = WSP(bf16_t, WS_RES); }
    __syncthreads();
    pg8::gemm_phase<pg8::EpiResid<WHICH == 1>, pg8::XcdOrder, true, true>((PG8_LAS unsigned char*)smem, g, S, E);
}

DI void run_gemm1_pg8(const Params& p, unsigned char* smem) {
    volatile LAS unsigned* st = (volatile LAS unsigned*)(smem + SMEM_BYTES);
    pg8::XcdOrder S; S.init(NTOK / 256, ATT_IN / 256, (int)st[0], (int)st[1], (int)st[2], (int)st[3]);
    const pg8::Gemm g{WSP(signed char, WS_XQ), WSP(signed char, WS_W_ATTIN), NTOK, ATT_IN, DM, WSP(float, WS_XSC), WSP(float, WS_WAS)};
    pg8::EpiProj E; E.aq = p.in[3]; E.ak = p.in[4]; E.bq = p.in[5]; E.bk = p.in[6]; E.proj = WSP(bf16_t, WS_PROJ); E.xs = (PG8_LAS float*)(smem + PG8_EXTRA);
    __syncthreads();
    pg8::gemm_phase<pg8::EpiProj, pg8::XcdOrder, true, true, true>((PG8_LAS unsigned char*)smem, g, S, E);
}
DI void run_gemm4_pg8(const Params& p, unsigned char* smem) {
    volatile LAS unsigned* st = (volatile LAS unsigned*)(smem + SMEM_BYTES);
    pg8::XcdOrder S; S.init(NTOK / 256, 4096 / 256, (int)st[0], (int)st[1], (int)st[2], (int)st[3]);
    const pg8::Gemm g{WSP(signed char, WS_XQ), WSP(signed char, WS_W_SGUIN), NTOK, 4096, DM, WSP(float, WS_XSC), WSP(float, WS_WSS)};
    pg8::EpiSgu E; E.zu = WSP(bf16_t, WS_Z_U); E.zvt = WSP(bf16_t, WS_Z_VT); E.ssq = WSP(float, WS_SSQ); E.stg = (PG8_LAS unsigned char*)(smem + PG8_EXTRA);
    __syncthreads();
    pg8::gemm_phase<pg8::EpiSgu, pg8::XcdOrder, true, true, true>((PG8_LAS unsigned char*)smem, g, S, E);
}

DI u32 cand_key(float s, int ci) { return (f2ord(s) & ~255u) | (u32)(255 - ci); }
template <int P>
DI void score_half(const bf16x8 (&qf)[8], const unsigned char* skl, int fr, int fh, u32 (&lst)[16]) {
#pragma unroll
    for (int j = 0; j < 16; ++j) lst[j] = 0u;
#pragma unroll 1
    for (int kt = 0; kt < 4; ++kt) {
        f32x16 st;
#pragma unroll
        for (int r = 0; r < 16; ++r) st[r] = 0.f;
        const int row = P * 128 + kt * 32 + fr;
        const unsigned char* skr = skl + row * 256;
#pragma unroll
        for (int ks = 0; ks < 8; ++ks) st = MFMA32(*(const bf16x8*)(skr + (((2 * ks + fh) ^ (row & 15)) << 4)), qf[ks], st);
        u32 ks_[16];
#pragma unroll
        for (int r = 0; r < 16; ++r) ks_[r] = (f2ord(st[r]) & ~127u) | (u32)(127 - (kt * 32 + crow(r, fh)));
        sort16_desc(ks_);
        if (kt == 0) {
#pragma unroll
            for (int j = 0; j < 16; ++j) lst[j] = ks_[j];
        } else merge16_desc(lst, ks_);
    }
    u32 other[16];
#pragma unroll
    for (int j = 0; j < 16; ++j) other[j] = (u32)__shfl_xor((int)lst[j], 32);
    merge16_desc(lst, other);
}
DI void run_score(const Params& p, int l, unsigned char* smem) {
    const int tid = otid512(), wave = tid >> 6, lane = tid & 63, fr = lane & 31, fh = lane >> 5;
    int cur_h = -1;
    bf16x8 qa[8], qb[8];
    if ((int)blockIdx.x < 8 * (NTOK / 256)) {
        const int it0 = blockIdx.x;
        const bf16_t* q0 = WSP(bf16_t, WS_QBUF) + (size_t)((it0 >> 3) * 256 + wave * 32 + fr) * 2048 + (it0 & 7) * 256 + 8 * fh;
#pragma unroll
        for (int ks = 0; ks < 8; ++ks) { qa[ks] = *(const bf16x8*)(q0 + 16 * ks); qb[ks] = *(const bf16x8*)(q0 + 128 + 16 * ks); }
    }
#pragma unroll 1
    for (int it = blockIdx.x; it < 8 * (NTOK / 256); it += gridDim.x) {
    const int h = it & 7, oct = it >> 3;
    if (h != cur_h) {
        __syncthreads();
        const bf16_t* skg = WSP(bf16_t, WS_W_SUBK) + ((size_t)l * 16 + h * 2) * 128 * 128;
#pragma unroll
        for (int i = 0; i < 8; ++i) {
            const int idx = wave * 8 + i;
            const int row = 4 * idx + (lane >> 4), cp = lane & 15;
            __builtin_amdgcn_global_load_lds((const unsigned*)(skg + (size_t)row * 128 + ((cp ^ (row & 15)) << 3)), (unsigned*)(smem + idx * 1024 + lane * 16), 16, 0, 0);
        }
        asm volatile("s_waitcnt vmcnt(0)" ::: "memory");
        __syncthreads();
        cur_h = h;
    }
    const int tok = oct * 256 + wave * 32 + fr;
    const unsigned char* skh = smem;
    u32 L0[16], L1[16];
    score_half<0>(qa, skh, fr, fh, L0);
    score_half<1>(qb, skh, fr, fh, L1);
    {
        const int itn = it + gridDim.x < 8 * (NTOK / 256) ? it + gridDim.x : it;
        const bf16_t* qn = WSP(bf16_t, WS_QBUF) + (size_t)((itn >> 3) * 256 + wave * 32 + fr) * 2048 + (itn & 7) * 256 + 8 * fh;
#pragma unroll
        for (int ks = 0; ks < 8; ++ks) { qa[ks] = *(const bf16x8*)(qn + 16 * ks); qb[ks] = *(const bf16x8*)(qn + 128 + 16 * ks); }
    }
    LAS int* slot = (LAS int*)(smem + 65536 + wave * (64 * 132)) + lane * 33;
    float s1[16], s2[16];
#pragma unroll
    for (int j = 0; j < 16; ++j) {
        s1[j] = ord2f(L0[j] & ~127u); s2[j] = ord2f(L1[j] & ~127u);
        slot[j] = 127 - (int)(L0[j] & 127u); slot[16 + j] = 127 - (int)(L1[j] & 127u);
    }
    u32 lst[16];
    const u32 fh16 = (u32)fh << 4;
#define S1E(t) (fh ? s1[2 * (t) + 1] : s1[2 * (t)])
    {
        const float sa = S1E(0);
#pragma unroll
        for (int j = 0; j < 16; ++j) {
            const u32 k = (f2ord(sa + s2[j]) & ~255u) | ((u32)(255 - j) - fh16);
            lst[j] = (j < 8) ? k : (fh ? 0u : k);
        }
    }
    {
        const float sa = S1E(1), sb = S1E(2);
        u32 row[16];
#pragma unroll
        for (int j = 0; j < 16; ++j) row[j] = 0u;
#pragma unroll
        for (int j = 0; j < 5; ++j) { const u32 k = (f2ord(sa + s2[j]) & ~255u) | ((u32)(255 - 32 - j) - fh16); row[j] = (j < 4) ? k : (fh ? 0u : k); }
        merge16_desc(lst, row);
    }
    {
        const float sb = S1E(2), sc = S1E(3);
        u32 row[16];
#pragma unroll
        for (int j = 0; j < 16; ++j) row[j] = 0u;
#pragma unroll
        for (int j = 0; j < 3; ++j) { const u32 k = (f2ord(sb + s2[j]) & ~255u) | ((u32)(255 - 64 - j) - fh16); row[j] = (j < 2) ? k : (fh ? 0u : k); }
#pragma unroll
        for (int j = 0; j < 2; ++j) row[3 + j] = (f2ord(sc + s2[j]) & ~255u) | ((u32)(255 - 96 - j) - fh16);
#pragma unroll
        for (int t = 4; t < 8; ++t) row[1 + t] = (f2ord(S1E(t) + s2[0]) & ~255u) | ((u32)(255 - 32 * t) - fh16);
        sort16_desc(row);
        merge16_desc(lst, row);
    }
#undef S1E
#pragma unroll
    for (int i = 0; i < 8; ++i) {
        const u32 oh = (u32)__shfl_xor((int)lst[15 - i], 32), ol = (u32)__shfl_xor((int)lst[i], 32);
        lst[i] = max(lst[i], oh); lst[15 - i] = max(lst[15 - i], ol);
    }
#pragma unroll
    for (int j = 8; j > 0; j >>= 1)
#pragma unroll
        for (int i = 0; i < 16; ++i) { const int l2 = i ^ j; if (l2 > i) ce_desc(lst[i], lst[l2]); }
    float pv[16]; float sum = 0.f;
    const float mx = ord2f(lst[0] & ~255u);
#pragma unroll
    for (int j = 0; j < 16; ++j) { pv[j] = __expf(ord2f(lst[j] & ~255u) - mx); sum += pv[j]; }
    const float inv = 1.f / sum;
    int ev[16];
#pragma unroll
    for (int j = 0; j < 16; ++j) {
        const int ci = 255 - (int)(lst[j] & 255u);
        ev[j] = slot[ci >> 4] * 128 + slot[16 + (ci & 15)];
    }
    if (fh == 0) {
        uint4* ro = (uint4*)(WSP(unsigned short, WS_RIDX) + (size_t)tok * 128 + h * 16);
        float4* go = (float4*)(WSP(float, WS_RG) + (size_t)tok * 128 + h * 16);
#pragma unroll
        for (int q = 0; q < 2; ++q)
            ro[q] = make_uint4((u32)ev[8 * q] | ((u32)ev[8 * q + 1] << 16), (u32)ev[8 * q + 2] | ((u32)ev[8 * q + 3] << 16),
                               (u32)ev[8 * q + 4] | ((u32)ev[8 * q + 5] << 16), (u32)ev[8 * q + 6] | ((u32)ev[8 * q + 7] << 16));
#pragma unroll
        for (int q = 0; q < 4; ++q) go[q] = make_float4(pv[4 * q] * inv, pv[4 * q + 1] * inv, pv[4 * q + 2] * inv, pv[4 * q + 3] * inv);
    }
    }
}


#define OSM_THR 8.0f
typedef float f32x8v __attribute__((ext_vector_type(8)));
typedef float f32x4v __attribute__((ext_vector_type(4)));
typedef float f32x2v __attribute__((ext_vector_type(2)));
DI void osm_update(f32x16& s, unsigned vm, float& m, float& lh, float& alpha) {
    float mx = -1e30f;
#pragma unroll
    for (int r = 0; r < 16; ++r) mx = ((vm >> r) & 1u) ? fmaxf(mx, s[r]) : mx;
    mx = fmaxf(mx, __shfl_xor(mx, 32));
    float mn = m; alpha = 1.f;
    if (!__all(mx <= m + OSM_THR)) { mn = fmaxf(m, mx); alpha = __expf(m - mn); }
    const f32x16 t = s * 1.4426950408889634f + (-mn * 1.4426950408889634f);
#pragma unroll
    for (int r = 0; r < 16; ++r) s[r] = ((vm >> r) & 1u) ? __builtin_amdgcn_exp2f(t[r]) : 0.f;
    const f32x8v h8 = s.lo + s.hi; const f32x4v h4 = h8.lo + h8.hi; const f32x2v h2 = h4.lo + h4.hi;
    lh = lh * alpha + (h2.x + h2.y); m = mn;
}
DI void osm_update_full(f32x16& s, float& m, float& lh, float& alpha) {
    float mx = s[0];
#pragma unroll
    for (int r = 1; r < 16; ++r) mx = fmaxf(mx, s[r]);
    mx = fmaxf(mx, __shfl_xor(mx, 32));
    float mn = m; alpha = 1.f;
    if (!__all(mx <= m + OSM_THR)) { mn = fmaxf(m, mx); alpha = __expf(m - mn); }
    const f32x16 t = s * 1.4426950408889634f + (-mn * 1.4426950408889634f);
#pragma unroll
    for (int r = 0; r < 16; ++r) s[r] = __builtin_amdgcn_exp2f(t[r]);
    const f32x8v h8 = s.lo + s.hi; const f32x4v h4 = h8.lo + h8.hi; const f32x2v h2 = h4.lo + h4.hi;
    lh = lh * alpha + (h2.x + h2.y); m = mn;
}
DI void tr_quad(const unsigned (&a)[4], unsigned hi_off, bf16x8 (&f)[4]) {
    s16x4 l0, h0, l1, h1, l2, h2, l3, h3;
    const unsigned b0 = a[0] + hi_off, b1 = a[1] + hi_off, b2 = a[2] + hi_off, b3 = a[3] + hi_off;
    asm volatile("ds_read_b64_tr_b16 %0, %8\n\tds_read_b64_tr_b16 %1, %9\n\tds_read_b64_tr_b16 %2, %10\n\tds_read_b64_tr_b16 %3, %11\n\t"
                 "ds_read_b64_tr_b16 %4, %12\n\tds_read_b64_tr_b16 %5, %13\n\tds_read_b64_tr_b16 %6, %14\n\tds_read_b64_tr_b16 %7, %15\n\ts_waitcnt lgkmcnt(0)"
                 : "=&v"(l0), "=&v"(h0), "=&v"(l1), "=&v"(h1), "=&v"(l2), "=&v"(h2), "=&v"(l3), "=&v"(h3)
                 : "v"(a[0]), "v"(b0), "v"(a[1]), "v"(b1), "v"(a[2]), "v"(b2), "v"(a[3]), "v"(b3) : "memory");
    f[0] = __builtin_shufflevector(l0, h0, 0, 1, 2, 3, 4, 5, 6, 7); f[1] = __builtin_shufflevector(l1, h1, 0, 1, 2, 3, 4, 5, 6, 7);
    f[2] = __builtin_shufflevector(l2, h2, 0, 1, 2, 3, 4, 5, 6, 7); f[3] = __builtin_shufflevector(l3, h3, 0, 1, 2, 3, 4, 5, 6, 7);
}

#define QB_BYTES (128 * 256)
#define KB_BYTES (32 * 256)
template <bool WITH_V>
DI void attnB_stage_kv(const bf16_t* __restrict__ kg  , unsigned char* Kd, unsigned char* Vd, int wave, int lane) {
#pragma unroll
    for (int i = 0; i < 2; ++i) {
        const int idx = wave * 2 + i;
        const int key = 4 * idx + (lane >> 4), cp = lane & 15;
        const bf16_t* g = kg + (size_t)key * ATT_IN;
        __builtin_amdgcn_global_load_lds((const unsigned*)(g + ((cp ^ (key & 15)) << 3)), (unsigned*)(Kd + idx * 1024 + lane * 16), 16, 0, 0);
        if (WITH_V) {
            const int cv = ((((cp >> 2) ^ (key & 3)) << 2) | (cp & 3));
            __builtin_amdgcn_global_load_lds((const unsigned*)(g + 512 + (cv << 3)), (unsigned*)(Vd + idx * 1024 + lane * 16), 16, 0, 0);
        }
    }
}
template <int KOFF, bool FULL>
DI void attnB_map(const unsigned char* Kc, const unsigned char* qlp, int ksw, int qsw, int fh, unsigned vm, unsigned vc, int tq,
                  float& m, float& l, f32x16 (&o)[4]) {
    f32x16 st;
#pragma unroll
    for (int r = 0; r < 16; ++r) st[r] = 0.f;
#pragma unroll
    for (int s = 0; s < 4; ++s) {
        const bf16x8 kf = *(const bf16x8*)(Kc + (((KOFF + 2 * s + fh) ^ ksw) << 4));
        const bf16x8 qf = *(const bf16x8*)(qlp + (((KOFF + 2 * s + fh) ^ qsw) << 4));
        st = MFMA32(kf, qf, st);
    }
    float al;
    if (FULL) osm_update_full(st, m, l, al); else osm_update(st, vm, m, l, al);
    if (!__all(al == 1.f)) {
#pragma unroll
        for (int d = 0; d < 4; ++d)
#pragma unroll
            for (int r = 0; r < 16; ++r) o[d][r] *= al;
    }
#pragma unroll
    for (int s = 0; s < 2; ++s) {
        const bf16x8 pf = pack_p(st, s);
        unsigned va[4]; bf16x8 vf[4];
#pragma unroll
        for (int d = 0; d < 4; ++d) va[d] = vc + s * 16 * 256 + ((d ^ tq) << 6);
        tr_quad(va, 8 * 256, vf);
#pragma unroll
        for (int d = 0; d < 4; ++d) o[d] = MFMA32(vf[d], pf, o[d]);
    }
}
DI void ph_attnB_fast(const Params& p, int item, unsigned char* smem) {
    const bf16_t* proj = WSP(bf16_t, WS_PROJ);
    const int tid = otid(), wave = tid >> 6, lane = tid & 63, fr = lane & 31, fh = lane >> 5;
    const int qt = 15 - (item >> 6), bh = item & 63, b = bh >> 2, h = bh & 3;
    const int q0 = qt * 128;
    const float lam = compute_lam(p, lane);
    const size_t rowbase = (size_t)b * SEQ;
    const int qrow = wave * 32 + fr, qpos = q0 + qrow;
    unsigned char* Ql = smem;
    unsigned char* Kl = smem + QB_BYTES;
    unsigned char* Vl = Kl + 2 * KB_BYTES;
    const bf16_t* kbase = proj + rowbase * ATT_IN + 2048 + h * 128;
    __syncthreads();
#pragma unroll
    for (int i = 0; i < 8; ++i) {
        const int idx = wave * 8 + i;
        const int row = 4 * idx + (lane >> 4), cp = lane & 15;
        __builtin_amdgcn_global_load_lds((const unsigned*)(proj + (rowbase + q0 + row) * ATT_IN + 1536 + h * 128 + ((cp ^ (row & 15)) << 3)),
                                         (unsigned*)(Ql + idx * 1024 + lane * 16), 16, 0, 0);
    }
    attnB_stage_kv<true>(kbase, Kl, Vl, wave, lane);
    const unsigned char* qlp = Ql + qrow * 256;
    const int qsw = qrow & 15, ksw = fr & 15;
    const int nkt = (q0 + 128) / 32;
    const int wlast = q0 + wave * 32 + 31;
    f32x16 o1[4], o2[4];
#pragma unroll
    for (int d = 0; d < 4; ++d)
#pragma unroll
        for (int r = 0; r < 16; ++r) { o1[d][r] = 0.f; o2[d][r] = 0.f; }
    float m1 = -1e30f, m2 = -1e30f, l1 = 0.f, l2 = 0.f;
    const int tq = (lane & 15) >> 2;
    const unsigned vrow = (unsigned)(uintptr_t)Vl + (4 * fh + tq) * 256 + (16 * ((lane >> 4) & 1) + 4 * (lane & 3)) * 2;
    asm volatile("s_waitcnt vmcnt(0)" ::: "memory");
    __syncthreads();
    for (int kt = 0; kt < nkt; ++kt) {
        const int cur = kt & 1;
        if (kt + 1 < nkt) attnB_stage_kv<true>(kbase + (size_t)(kt + 1) * 32 * ATT_IN, Kl + (cur ^ 1) * KB_BYTES, Vl + (cur ^ 1) * KB_BYTES, wave, lane);
        if (kt * 32 <= wlast) {
            const unsigned char* Kc = Kl + cur * KB_BYTES + fr * 256;
            const unsigned vc = vrow + cur * KB_BYTES;
            if (kt * 32 + 31 <= wlast - 31) {
                attnB_map<0, true>(Kc, qlp, ksw, qsw, fh, 0xffffu, vc, tq, m1, l1, o1);
                __builtin_amdgcn_sched_barrier(0);
                attnB_map<8, true>(Kc, qlp, ksw, qsw, fh, 0xffffu, vc, tq, m2, l2, o2);
            } else {
                unsigned vm = 0;
#pragma unroll
                for (int r = 0; r < 16; ++r) vm |= ((kt * 32 + crow(r, fh)) <= qpos) ? (1u << r) : 0u;
                attnB_map<0, false>(Kc, qlp, ksw, qsw, fh, vm, vc, tq, m1, l1, o1);
                __builtin_amdgcn_sched_barrier(0);
                attnB_map<8, false>(Kc, qlp, ksw, qsw, fh, vm, vc, tq, m2, l2, o2);
            }
        }
        asm volatile("s_waitcnt vmcnt(0)" ::: "memory");
        __syncthreads();
    }
    l1 = xor32_add(l1); l2 = xor32_add(l2);
    const float i1 = 1.f / l1, i2 = lam / l2;
    float ss = 0.f;
#pragma unroll
    for (int d = 0; d < 4; ++d)
#pragma unroll
        for (int r = 0; r < 16; ++r) { const float v = o1[d][r] * i1 - o2[d][r] * i2; o1[d][r] = v; ss += v * v; }
    ss = xor32_add(ss);
    const float rinv = rsqrtf(ss * (1.f / 128.f) + EPSN) * 0.8f;
    const float* subg = p.in[11];
    bf16_t* op = WSP(bf16_t, WS_MIXED) + (rowbase + qpos) * DM + 512 + h * 128;
#pragma unroll
    for (int d = 0; d < 4; ++d)
#pragma unroll
        for (int g = 0; g < 4; ++g) {
            const int dim = 32 * d + 8 * g + 4 * fh;
            const float4 gg = *(const float4*)(subg + dim);
            uint2 w;
            w.x = pack2(o1[d][4 * g + 0] * rinv * gg.x, o1[d][4 * g + 1] * rinv * gg.y);
            w.y = pack2(o1[d][4 * g + 2] * rinv * gg.z, o1[d][4 * g + 3] * rinv * gg.w);
            *(uint2*)(op + dim) = w;
        }
}

#define KA_PITCH 128
#define VA_PITCH 192
#define WA_BYTES (32 * KA_PITCH + 32 * VA_PITCH)
template <int MODE>
DI void ph_attnA_fast(const Params& p, int item, unsigned char* smem) {
    const bf16_t* proj = WSP(bf16_t, WS_PROJ);
    const int tid = otid(), wave = tid >> 6, lane = tid & 63, fr = lane & 31, fh = lane >> 5;
    const int c = item & 15, h = (item >> 4) & 7, b = item >> 7;
    const size_t rowbase = (size_t)b * SEQ;
    const int qpos = MODE == 0 ? 128 * c + 32 * wave + fr : 16 * (32 * wave + fr) + c;
    const int pmin = MODE == 0 ? 128 * c + 32 * wave : 512 * wave + c, pmax = pmin + (MODE == 0 ? 31 : 496);
    bf16x8 qf[4];
    {
        const bf16_t* qp = proj + (rowbase + qpos) * ATT_IN + h * 64 + 8 * fh;
#pragma unroll
        for (int s = 0; s < 4; ++s) qf[s] = *(const bf16x8*)(qp + 16 * s);
    }
    f32x16 o[2];
#pragma unroll
    for (int d = 0; d < 2; ++d)
#pragma unroll
        for (int r = 0; r < 16; ++r) o[d][r] = 0.f;
    float m = -1e30f, l = 0.f;
    unsigned char* Kl = smem + wave * WA_BYTES;
    unsigned char* Vl = Kl + 32 * KA_PITCH;
    const unsigned vaddr = (unsigned)(uintptr_t)Vl + (4 * fh + ((lane & 15) >> 2)) * VA_PITCH + (16 * ((lane >> 4) & 1) + 4 * (lane & 3)) * 2;
    const int skey = lane >> 3, sc = lane & 7;
    int br = 0, d = MODE == 0 ? 1 : 16, W = MODE == 0 ? 128 : 2048, cls = MODE == 0 ? 0 : (c & 15);
    int j0 = MODE == 0 ? (pmin < 128 ? 0 : pmin - 128) : 0, jhi = MODE == 0 ? pmax : ((pmax - cls) >> 4);
    const bf16_t* kvbase = proj + rowbase * ATT_IN + 512 + h * 64 + sc * 8;
    uint4 rk0, rk1, rk2, rk3, rv0, rv1, rv2, rv3;
#define A_LOAD(i, RK, RV) do { int kp_ = cls + d * (j0 + skey + 8 * (i)); kp_ = kp_ > SEQ - 1 ? SEQ - 1 : kp_; kp_ = kp_ < 0 ? 0 : kp_; \
        const bf16_t* g_ = kvbase + (size_t)kp_ * ATT_IN; RK = *(const uint4*)g_; RV = *(const uint4*)(g_ + 512); } while (0)
#define A_WRITE(i, RK, RV) do { const int key_ = skey + 8 * (i); *(uint4*)(Kl + key_ * KA_PITCH + ((sc ^ ((key_ >> 1) & 7)) << 4)) = RK; \
        *(uint4*)(Vl + key_ * VA_PITCH + sc * 16) = RV; } while (0)
    A_LOAD(0, rk0, rv0); A_LOAD(1, rk1, rv1); A_LOAD(2, rk2, rv2); A_LOAD(3, rk3, rv3);
#pragma unroll 1
    for (;;) {
        A_WRITE(0, rk0, rv0); A_WRITE(1, rk1, rv1); A_WRITE(2, rk2, rv2); A_WRITE(3, rk3, rv3);
        const int cd = d, cW = W, ccls = cls, cj0 = j0;
        bool more = true;
        j0 += 32;
        if (j0 > jhi) {
            ++br;
            if (MODE == 0 || br == 2) more = false;
            else {
                d = 4; W = 512; cls = c & 3;
                const int lo = pmin - cls - W;
                j0 = lo < 0 ? 0 : lo >> 2;
                jhi = (pmax - cls) >> 2;
            }
        }
        A_LOAD(0, rk0, rv0); A_LOAD(1, rk1, rv1); A_LOAD(2, rk2, rv2); A_LOAD(3, rk3, rv3);
        f32x16 st;
#pragma unroll
        for (int r = 0; r < 16; ++r) st[r] = 0.f;
#pragma unroll
        for (int s = 0; s < 4; ++s) {
            const bf16x8 kf = *(const bf16x8*)(Kl + fr * KA_PITCH + (((2 * s + fh) ^ ((fr >> 1) & 7)) << 4));
            st = MFMA32(kf, qf[s], st);
        }
        float al;
        const int kfirst = ccls + cd * cj0, klast = kfirst + cd * 31;
        if (klast <= pmin && pmax - kfirst <= cW) osm_update_full(st, m, l, al);
        else {
            unsigned vm = 0;
#pragma unroll
            for (int r = 0; r < 16; ++r) {
                const int dist = qpos - (ccls + cd * (cj0 + crow(r, fh)));
                vm |= (dist >= 0 && dist <= cW) ? (1u << r) : 0u;
            }
            osm_update(st, vm, m, l, al);
        }
        if (!__all(al == 1.f)) {
#pragma unroll
            for (int dd = 0; dd < 2; ++dd)
#pragma unroll
                for (int r = 0; r < 16; ++r) o[dd][r] *= al;
        }
        {
            unsigned va[4]; bf16x8 vf[4];
            va[0] = vaddr; va[1] = vaddr + 64; va[2] = vaddr + 16 * VA_PITCH; va[3] = vaddr + 16 * VA_PITCH + 64;
            tr_quad(va, 8 * VA_PITCH, vf);
            const bf16x8 p0 = pack_p(st, 0), p1 = pack_p(st, 1);
            o[0] = MFMA32(vf[0], p0, o[0]); o[1] = MFMA32(vf[1], p0, o[1]);
            o[0] = MFMA32(vf[2], p1, o[0]); o[1] = MFMA32(vf[3], p1, o[1]);
        }
        if (!more) break;
    }
    l = xor32_add(l);
    bf16_t* op = WSP(bf16_t, WS_MIXED) + (rowbase + qpos) * DM + h * 64;
    float* lsep = WSP(float, WS_LSE1) + (rowbase + qpos) * 8 + h;
    if (MODE == 0) {
        const float il = 1.f / l;
        if (fh == 0) *lsep = m + __logf(l);
#pragma unroll
        for (int dd = 0; dd < 2; ++dd)
#pragma unroll
            for (int g = 0; g < 4; ++g) {
                const int dim = 32 * dd + 8 * g + 4 * fh;
                uint2 w;
                w.x = pack2(o[dd][4 * g + 0] * il, o[dd][4 * g + 1] * il);
                w.y = pack2(o[dd][4 * g + 2] * il, o[dd][4 * g + 3] * il);
                *(uint2*)(op + dim) = w;
            }
    } else {
        const float lse1 = *lsep;
        const float M = fmaxf(m, lse1);
        const float w23 = __expf(m - M), w1 = __expf(lse1 - M);
        const float iden = 1.f / (l * w23 + w1);
        const float a23 = w23 * iden, a1 = w1 * iden;
        uint2 prev[2][4];
#pragma unroll
        for (int dd = 0; dd < 2; ++dd)
#pragma unroll
            for (int g = 0; g < 4; ++g) prev[dd][g] = *(const uint2*)(op + 32 * dd + 8 * g + 4 * fh);
#pragma unroll
        for (int dd = 0; dd < 2; ++dd)
#pragma unroll
            for (int g = 0; g < 4; ++g) {
                const int dim = 32 * dd + 8 * g + 4 * fh;
                const float p0 = __uint_as_float(prev[dd][g].x << 16), p1 = __uint_as_float(prev[dd][g].x & 0xffff0000u);
                const float p2 = __uint_as_float(prev[dd][g].y << 16), p3 = __uint_as_float(prev[dd][g].y & 0xffff0000u);
                uint2 w;
                w.x = pack2(o[dd][4 * g + 0] * a23 + p0 * a1, o[dd][4 * g + 1] * a23 + p1 * a1);
                w.y = pack2(o[dd][4 * g + 2] * a23 + p2 * a1, o[dd][4 * g + 3] * a23 + p3 * a1);
                *(uint2*)(op + dim) = w;
            }
    }
}
#define NITEM_B 1024
#define NITEM_A 2048
DI void ph_attn_fast(const Params& p, int vb, unsigned char* smem) {
    if (vb < NITEM_B) {
        const int item = vb < 512 ? vb : 512 + (1023 - vb);
        ph_attnB_fast(p, item, smem);
    } else ph_attnA_fast<0>(p, vb - NITEM_B, smem);
}


DI void ph_spatial_fast(const Params& p, int item, unsigned char* smem) {
    const int tid = otid(), wave = tid >> 6, lane = tid & 63, fr = lane & 31, fh = lane >> 5;
    const int wm = wave >> 1, wn = wave & 1;
    const int chunk = item >> 3, g = item & 7;
    bf16_t* u = WSP(bf16_t, WS_Z_U);
    const bf16_t* vt = WSP(bf16_t, WS_Z_VT);
    const float* ssq = WSP(float, WS_SSQ);
    const float* wsp = p.in[16] + (size_t)g * 128 * 128;
    float* rinv = (float*)(smem + 66 * 1024);
    unsigned char* Bt = smem + 32768;
    __syncthreads();
    if (tid < 128) {
        const float4* sp = (const float4*)(ssq + (size_t)(chunk * 128 + tid) * 64);
        float sacc = 0.f;
#pragma unroll
        for (int j = 0; j < 16; ++j) { const float4 q = sp[j]; sacc += (q.x + q.y) + (q.z + q.w); }
        rinv[tid] = rsqrtf(sacc * (1.f / CW) + EPSN);
    }
    const size_t vrow0 = (size_t)chunk * CW + g * 256;
    stage_tile(vt, 128, (int)vrow0, 0, Bt, wave, lane);
    stage_tile(vt, 128, (int)vrow0, 64, Bt + 16384, wave, lane);
    __syncthreads();
#pragma unroll
    for (int i = 0; i < 8; ++i) {
        const int id = tid + 256 * i;
        const int t = id >> 4, sc = id & 15;
        const float4 w0 = *(const float4*)(wsp + t * 128 + sc * 8);
        const float4 w1 = *(const float4*)(wsp + t * 128 + sc * 8 + 4);
        const float4 r0 = *(const float4*)(rinv + sc * 8);
        const float4 r1 = *(const float4*)(rinv + sc * 8 + 4);
        const int s0 = sc * 8;
        uint4 o;
        o.x = pack2(s0 + 0 <= t ? w0.x * r0.x : 0.f, s0 + 1 <= t ? w0.y * r0.y : 0.f);
        o.y = pack2(s0 + 2 <= t ? w0.z * r0.z : 0.f, s0 + 3 <= t ? w0.w * r0.w : 0.f);
        o.z = pack2(s0 + 4 <= t ? w1.x * r1.x : 0.f, s0 + 5 <= t ? w1.y * r1.y : 0.f);
        o.w = pack2(s0 + 6 <= t ? w1.z * r1.z : 0.f, s0 + 7 <= t ? w1.w * r1.w : 0.f);
        const int kt = sc >> 3, c = sc & 7;
        *(uint4*)(smem + kt * 16384 + t * 128 + ((c ^ ((t >> 1) & 7)) << 4)) = o;
    }
#pragma unroll 1
    for (int nt = 0; nt < 2; ++nt) {
        asm volatile("s_waitcnt vmcnt(0)" ::: "memory");
        __syncthreads();
        uint4 ur[2][4];
#pragma unroll
        for (int i = 0; i < 2; ++i) {
            const uint4* upl = (const uint4*)(u + (size_t)(chunk * 128 + wm * 64 + i * 32 + fr) * CW + g * 256 + nt * 128 + wn * 64 + fh * 32);
#pragma unroll
            for (int q = 0; q < 4; ++q) ur[i][q] = upl[q];
        }
        f32x16 acc[2][2];
#pragma unroll
        for (int i = 0; i < 2; ++i)
#pragma unroll
            for (int j = 0; j < 2; ++j)
#pragma unroll
                for (int r = 0; r < 16; ++r) acc[i][j][r] = 0.f;
#pragma unroll
        for (int kt = 0; kt < 2; ++kt)
#pragma unroll
            for (int s = 0; s < 4; ++s) {
                bf16x8 a[2], b[2];
#pragma unroll
                for (int i = 0; i < 2; ++i) {
                    a[i] = lds_frag(smem + kt * 16384, wm * 64 + i * 32 + fr, 2 * s + fh);
                    b[i] = lds_frag(Bt + kt * 16384, wn * 64 + i * 32 + fr, 2 * s + fh);
                }
#pragma unroll
                for (int i = 0; i < 2; ++i)
#pragma unroll
                    for (int j = 0; j < 2; ++j) acc[i][j] = MFMA32(a[i], b[j], acc[i][j]);
            }
        __syncthreads();
        float* st = (float*)(Bt + wave * (32 * 65 * 4));
#pragma unroll
        for (int i = 0; i < 2; ++i) {
#pragma unroll
            for (int j = 0; j < 2; ++j)
#pragma unroll
                for (int r = 0; r < 16; ++r) st[crow(r, fh) * 65 + j * 32 + fr] = acc[i][j][r];
            const int t = wm * 64 + i * 32 + fr;
            const int c0 = g * 256 + nt * 128 + wn * 64 + fh * 32;
            bf16_t* up = u + (size_t)(chunk * 128 + t) * CW + c0;
            const float bias = p.in[17][g * 128 + t];
            const float* gn = p.in[15] + c0;
#pragma unroll
            for (int q = 0; q < 4; ++q) {
                float uf[8]; unpack8(ur[i][q], uf);
                const float4 g0 = *(const float4*)(gn + 8 * q), g1 = *(const float4*)(gn + 8 * q + 4);
                const float gg[8] = {g0.x, g0.y, g0.z, g0.w, g1.x, g1.y, g1.z, g1.w};
                float ov[8];
#pragma unroll
                for (int e = 0; e < 8; ++e) ov[e] = uf[e] * (st[fr * 65 + fh * 32 + 8 * q + e] * gg[e] + bias);
                uint4 o; o.x = pack2(ov[0], ov[1]); o.y = pack2(ov[2], ov[3]); o.z = pack2(ov[4], ov[5]); o.w = pack2(ov[6], ov[7]);
                ((uint4*)up)[q] = o;
            }
        }
        if (nt == 0) {
            __syncthreads();
            stage_tile(vt, 128, (int)vrow0 + 128, 0, Bt, wave, lane);
            stage_tile(vt, 128, (int)vrow0 + 128, 64, Bt + 16384, wave, lane);
        }
    }
}

#define XB_TMO      128
#define XB_XCNT(j)  (256  + 64 * (j))
#define XB_XSUB(j)  (1280 + 64 * (j))
#define XB_XGEN(j)  (2304 + 64 * (j))
#define XB_TOP      3328
#define XB_TOPGEN   3392
#define XCD_BAR_WORDS 3456
#define XB_SPIN_CAP (1u << 22)
DI unsigned xb_ld(unsigned* p) { return __hip_atomic_load(p, __ATOMIC_RELAXED, __HIP_MEMORY_SCOPE_AGENT); }
DI unsigned xb_add(unsigned* p, unsigned v) { return __hip_atomic_fetch_add(p, v, __ATOMIC_RELAXED, __HIP_MEMORY_SCOPE_AGENT); }
DI unsigned xb_xcc_id() { return (unsigned)__builtin_amdgcn_s_getreg((3 << 11) | 20) & 0xFu; }
#define XB_SPIN(cond, bar) do { unsigned _sp = 0; while (cond) { __builtin_amdgcn_s_sleep(1); \
    if ((++_sp & 255u) == 0u) { if (xb_ld(&(bar)[XB_TMO])) break; if (_sp > XB_SPIN_CAP) { atomicAdd(&(bar)[XB_TMO], 1u); break; } } } } while (0)
struct XcdBarrier { unsigned* bar; unsigned x; volatile LAS unsigned* st; };
DI XcdBarrier xcd_barrier_post(unsigned* bar, volatile LAS unsigned* st) {
    XcdBarrier b; b.bar = bar; b.x = xb_xcc_id(); b.st = st;
    if (threadIdx.x == 0) st[2] = xb_add(&bar[XB_XCNT(b.x)], 1u);
    return b;
}
DI void xcd_barrier_complete(unsigned* bar, unsigned x, unsigned& nloc, unsigned& nx, unsigned& xi) {
    const unsigned G = gridDim.x * gridDim.y * gridDim.z;
    unsigned sum, cnt, mine, below, sp = 0u;
    for (;;) {
        sum = 0u; cnt = 0u; mine = 0u; below = 0u;
#pragma unroll
        for (unsigned j = 0; j < 16; ++j) { const unsigned c = xb_ld(&bar[XB_XCNT(j)]); sum += c; cnt += (c > 0u) ? 1u : 0u; mine = (j == x) ? c : mine; below += (c > 0u && j < x) ? 1u : 0u; }
        if (sum == G) break;
        __builtin_amdgcn_s_sleep(1);
        if ((++sp & 255u) == 0u) { if (xb_ld(&bar[XB_TMO])) break; if (sp > XB_SPIN_CAP) { atomicAdd(&bar[XB_TMO], 1u); break; } }
    }
    nloc = mine > 0u ? mine : 1u; nx = cnt > 0u ? cnt : 1u; xi = below;
}
DI void xcd_barrier(const XcdBarrier& b) {
    asm volatile("s_waitcnt vmcnt(0)" ::: "memory");
    __syncthreads();
    if (threadIdx.x == 0) {
        unsigned* bar = b.bar;
        __builtin_amdgcn_s_waitcnt(0);
        unsigned nloc = b.st[0], nx = b.st[1];
        if (nloc == 0u) { unsigned xi; xcd_barrier_complete(bar, b.x, nloc, nx, xi); b.st[0] = nloc; b.st[1] = nx; b.st[3] = xi; }
        const unsigned old = xb_add(&bar[XB_XSUB(b.x)], 1u);
        const unsigned gen = old / nloc;
        if (old + 1u == (gen + 1u) * nloc) {
            __builtin_amdgcn_fence(__ATOMIC_RELEASE, "agent");
            asm volatile("s_waitcnt vmcnt(0)" ::: "memory");
            const unsigned og = xb_add(&bar[XB_TOP], 1u);
            const unsigned tg = og / nx;
            if (og + 1u == (tg + 1u) * nx) xb_add(&bar[XB_TOPGEN], 1u);
            else XB_SPIN(xb_ld(&bar[XB_TOPGEN]) == tg, bar);
            __builtin_amdgcn_fence(__ATOMIC_ACQUIRE, "agent");
            xb_add(&bar[XB_XGEN(b.x)], 1u);
            asm volatile("s_waitcnt vmcnt(0)" ::: "memory");
        } else {
            XB_SPIN(xb_ld(&bar[XB_XGEN(b.x)]) == gen, bar);
            __builtin_amdgcn_fence(__ATOMIC_ACQUIRE, "agent");
            asm volatile("s_waitcnt vmcnt(0)" ::: "memory");
        }
    }
    __syncthreads();
}

enum { PH_PREP = 0, PH_GEMM1, PH_ATTN, PH_ATTN2, PH_GEMM2,
       PH_NORM_P0, PH_GEMMQ0, PH_SCORE0, PH_PDOWN0, PH_PCOMB0, PH_PUP0, PH_NORM_SGU,
       PH_GEMM4, PH_SPATIAL, PH_GEMM5,
       PH_NORM_P1, PH_GEMMQ1, PH_SCORE1, PH_PDOWN1, PH_PCOMB1, PH_PUP1, PH_COUNT };

__host__ __device__ constexpr int phase_nvb(int ph) {
    switch (ph) {
        case PH_PREP: return PREP_N;
        case PH_GEMM1: return (ATT_IN / 256) * (NTOK / 256);
        case PH_ATTN: return NITEM_B + NITEM_A;
        case PH_ATTN2: return NITEM_A;
        case PH_GEMM2: return (DM / 256) * (NTOK / 256);
        case PH_NORM_P0: case PH_NORM_P1: case PH_NORM_SGU: return NTOK / 16;
        case PH_GEMMQ0: case PH_GEMMQ1: return 16 * (NTOK / 256);
        case PH_SCORE0: case PH_SCORE1: return (NTOK / 32) * 8 / 4;
        case PH_PCOMB0: case PH_PCOMB1: return NTOK / 8;
        case PH_GEMM4: return (4096 / 256) * (NTOK / 256);
        case PH_SPATIAL: return 256 * 8;
        case PH_GEMM5: return (DM / 256) * (NTOK / 256);
    }
    return 0;
}

template <int PH>
DI void run_vb(const Params& p, int vb, unsigned char* smem) {
    if constexpr (PH == PH_PREP) ph_prep(p, vb, smem);
    else if constexpr (PH == PH_ATTN) ph_attn_fast(p, vb, smem);
    else if constexpr (PH == PH_ATTN2) ph_attnA_fast<1>(p, vb, smem);
    else if constexpr (PH == PH_NORM_P0 || PH == PH_NORM_P1) rmsnorm_rows<true, 4>(WSP(bf16_t, WS_RES), p.in[19] + (PH == PH_NORM_P1 ? DM : 0), vb, WSP(signed char, WS_XQ), WSP(float, WS_XSC));
    else if constexpr (PH == PH_PCOMB0 || PH == PH_PCOMB1) ph_peer_comb(p, vb, PH == PH_PCOMB1 ? 1 : 0);
    else if constexpr (PH == PH_NORM_SGU) rmsnorm_rows<true, 4>(WSP(bf16_t, WS_RES), p.in[13], vb, WSP(signed char, WS_XQ), WSP(float, WS_XSC));
    else if constexpr (PH == PH_SPATIAL) ph_spatial_fast(p, vb, smem);
}

template <int PH>
DI void run_phase(const Params& p, unsigned char* smem) {
    if constexpr (PH == PH_PDOWN0 || PH == PH_PDOWN1) run_peer_sliced<false>(p, PH == PH_PDOWN1 ? 1 : 0, smem);
    else if constexpr (PH == PH_PUP0 || PH == PH_PUP1) run_peer_sliced<true>(p, PH == PH_PUP1 ? 1 : 0, smem);
    else if constexpr (PH == PH_SCORE0 || PH == PH_SCORE1) run_score(p, PH == PH_SCORE1 ? 1 : 0, smem);
    else if constexpr (PH == PH_GEMMQ0 || PH == PH_GEMMQ1) run_gemmq_pg8(p, PH == PH_GEMMQ1 ? 1 : 0, smem);
    else if constexpr (PH == PH_GEMM1) run_gemm1_pg8(p, smem);
    else if constexpr (PH == PH_GEMM4) run_gemm4_pg8(p, smem);
    else if constexpr (PH == PH_GEMM2) run_gemm_pg8<0>(p, smem);
    else if constexpr (PH == PH_GEMM5) run_gemm_pg8<1>(p, smem);
    else {
        constexpr int nvb = phase_nvb(PH);
        const int g = threadIdx.x >> 8;
        if constexpr (PH == PH_SPATIAL) { for (int i_ = 0; i_ < (int)(blockIdx.x % 3) * 4; ++i_) __builtin_amdgcn_s_sleep(56); }
        for (int vb = 2 * blockIdx.x; vb < nvb; vb += 2 * gridDim.x)
            if (vb + g < nvb) run_vb<PH>(p, vb + g, smem + g * GROUP_SMEM);
    }
}

template <int PH>
DI void run_from(const Params& p, unsigned char* smem, cg::grid_group& grid, const XcdBarrier& xb) {
    run_phase<PH>(p, smem);
    if constexpr (PH + 1 < PH_COUNT) {
        if constexpr (PH == 1) grid.sync(); else xcd_barrier(xb);
        run_from<PH + 1>(p, smem, grid, xb);
    }
}

__global__ void __launch_bounds__(NTHREADS, 2) k_mega(Params p) {
    extern __shared__ __attribute__((aligned(16))) unsigned char smem[];
    cg::grid_group grid = cg::this_grid();
    volatile LAS unsigned* st = (volatile LAS unsigned*)(smem + SMEM_BYTES);
    if (threadIdx.x == 0) { st[0] = 0u; st[1] = 0u; st[2] = 0u; st[3] = 0u; }
    __syncthreads();
    const XcdBarrier xb = xcd_barrier_post((unsigned*)(p.ws + WS_CTL), st);
    run_from<0>(p, smem, grid, xb);
}


extern "C" void kernel_launch(void* const* d_in, const int* in_sizes, int n_in, void* d_out, int out_size, void* d_ws, size_t ws_size, hipStream_t stream) {
    if (n_in != 24 || ws_size < WS_NEED || in_sizes[0] != NTOK * DM || out_size != NTOK * DM || in_sizes[22] != 2 * NEXP * DM) {
        fprintf(stderr, "kernel_launch: built for x[16,2048,1024] with 24 inputs and >= 512 MiB of workspace; got n_in %d, in0 %d, out %d, ws %zu: nothing launched\n", n_in, in_sizes[0], out_size, ws_size); return; }
    static int grid_blocks = 0;
    if (!grid_blocks) {
        int dev = 0, cus = 0, per_cu = 0;
        (void)hipGetDevice(&dev);
        (void)hipDeviceGetAttribute(&cus, hipDeviceAttributeMultiprocessorCount, dev);
        (void)hipFuncSetAttribute((const void*)k_mega, hipFuncAttributeMaxDynamicSharedMemorySize, SMEM_ALLOC);
        (void)hipOccupancyMaxActiveBlocksPerMultiprocessor(&per_cu, (const void*)k_mega, NTHREADS, SMEM_ALLOC);
        if (per_cu > 1) per_cu = 1;
        if (per_cu < 1) { fprintf(stderr, "kernel_launch: occupancy query returned %d\n", per_cu); per_cu = 1; }
        grid_blocks = cus * per_cu;
    }
    Params p{};
    for (int i = 0; i < 24; ++i) p.in[i] = (const float*)d_in[i];
    p.out = (float*)d_out;
    p.ws = (unsigned char*)d_ws;
    void* args[] = {&p};
    if (hipMemsetAsync((unsigned char*)d_ws + WS_CTL, 0, XCD_BAR_WORDS * 4, stream) != hipSuccess) { fprintf(stderr, "kernel_launch: memset of the barrier words failed\n"); return; }
    hipError_t e = hipLaunchCooperativeKernel((const void*)k_mega, dim3(grid_blocks), dim3(NTHREADS), args, SMEM_ALLOC, stream);
    if (e != hipSuccess) fprintf(stderr, "cooperative launch failed: %s (grid %d)\n", hipGetErrorString(e), grid_blocks);
}
```
